# Optimizing an MI355X kernel written in HIP

```python
import jax, jax.numpy as jnp
from jax import lax
import numpy as np

D_MODEL = 1024
BATCH = 8
SEQ = 2048
DEPTH = 4
DEC_BATCH = 2
DEC_SEQ = 16384
PAST_LEN = 128

N_MIXERS = 2
EXPAND = 2
D_INNER = EXPAND * D_MODEL
N_RWKV_LAYERS = (DEPTH + N_MIXERS - 1) // N_MIXERS
N_MLA_LAYERS = DEPTH // N_MIXERS

RWKV_HEAD = 64
RWKV_HEADS = D_INNER // RWKV_HEAD
DECAY_LORA = 64
ICL_LORA = 64
LN_X_EPS = 64e-5
RWKV_COL_STREAMS = ((0, D_INNER), (2, D_INNER), (3, D_INNER), (5, D_INNER),
                    (1, 2 * DECAY_LORA), (4, 2 * ICL_LORA))
RWKV_IN_COLS = 4 * D_INNER + 2 * DECAY_LORA + 2 * ICL_LORA

MLA_HEADS = 16
QK_NOPE = 128
QK_ROPE = 64
V_HEAD = 128
QK_HEAD = QK_NOPE + QK_ROPE
Q_LORA = 384
KV_LORA = 256
ROPE_THETA = 10000.0
Q_BLOCK = 128
MLA_IN_COLS = Q_LORA + KV_LORA + QK_ROPE + D_INNER

NORM_EPS = 1e-6

kernel_name = "rwkv7_mla_interleaved_bidir_encoder"


def rmsnorm(x, g):
    xf = x.astype(jnp.float32)
    y = xf * lax.rsqrt(jnp.mean(xf * xf, axis=-1, keepdims=True) + NORM_EPS) * g.astype(jnp.float32)
    return y.astype(x.dtype)


def _wkv_step(S, inp):
    r, w, k, v, kk, b = inp
    sa = jnp.einsum('bhvk,bhk->bhv', S, -kk)
    S = S * w[:, :, None, :] + sa[..., None] * b[:, :, None, :] + v[..., None] * k[:, :, None, :]
    return S, jnp.einsum('bhvk,bhk->bhv', S, r)


def rwkv_mixer(h, mu, w_in, w0, w2, a0, a2, k_k, k_a, r_k, lnx_g, lnx_b, w_out):
    B, T, _ = h.shape
    prev = jnp.pad(h[:, :-1], ((0, 0), (1, 0), (0, 0)))
    nxt = jnp.pad(h[:, 1:], ((0, 0), (0, 1), (0, 0)))
    xx = 0.5 * (prev + nxt) - h
    mu_cols = jnp.concatenate(
        [jnp.broadcast_to(mu[s][:, None], (D_MODEL, wd)) for s, wd in RWKV_COL_STREAMS], axis=1)
    w_eff = jnp.concatenate([w_in, mu_cols * w_in], axis=0)
    proj = (jnp.concatenate([h, xx], axis=-1) @ w_eff).astype(jnp.float32)
    E = D_INNER
    r, k, v, g, wl, al = jnp.split(proj, [E, 2 * E, 3 * E, 4 * E, 4 * E + 2 * DECAY_LORA], axis=-1)
    wl = wl.reshape(B, T, 2, DECAY_LORA)
    al = al.reshape(B, T, 2, ICL_LORA)
    w_pre = w0.astype(jnp.float32) + jnp.einsum('btdl,dle->btde', jnp.tanh(wl), w2.astype(jnp.float32))
    decay = jnp.exp(-jnp.exp(-jax.nn.softplus(-w_pre) - 0.5))
    a = jax.nn.sigmoid(a0.astype(jnp.float32) + jnp.einsum('btdl,dle->btde', al, a2.astype(jnp.float32)))
    kk = (k * k_k).reshape(B, T, RWKV_HEADS, RWKV_HEAD)
    kk = kk / jnp.maximum(jnp.sqrt(jnp.sum(kk * kk, axis=-1, keepdims=True)), 1e-12)
    kk = kk.reshape(B, T, E)
    k_dir = k[:, :, None, :] * (1.0 + (a - 1.0) * k_a)
    b_dir = kk[:, :, None, :] * a

    def tm(z):
        return z.reshape(B, T, RWKV_HEADS, RWKV_HEAD).transpose(1, 0, 2, 3)

    r_t, v_t, kk_t = tm(r), tm(v), tm(kk)
    S0 = jnp.zeros((B, RWKV_HEADS, RWKV_HEAD, RWKV_HEAD), jnp.float32)
    _, y_f = lax.scan(_wkv_step, S0, (r_t, tm(decay[:, :, 0]), tm(k_dir[:, :, 0]), v_t, kk_t, tm(b_dir[:, :, 0])))
    _, y_b = lax.scan(_wkv_step, S0, (r_t, tm(decay[:, :, 1]), tm(k_dir[:, :, 1]), v_t, kk_t, tm(b_dir[:, :, 1])),
                      reverse=True)
    y = (y_f + y_b).transpose(1, 0, 2, 3)
    mean = jnp.mean(y, axis=-1, keepdims=True)
    var = jnp.mean(jnp.square(y - mean), axis=-1, keepdims=True)
    y = ((y - mean) * lax.rsqrt(var + LN_X_EPS)).reshape(B, T, E) * lnx_g + lnx_b
    rk = (r[:, :, None, :] * k_dir).reshape(B, T, 2, RWKV_HEADS, RWKV_HEAD) * r_k.astype(jnp.float32)
    bonus = jnp.sum(rk, axis=(2, 4))[..., None] * v.reshape(B, T, RWKV_HEADS, RWKV_HEAD)
    out = (y + bonus.reshape(B, T, E)) * jax.nn.silu(g)
    return (out @ w_out).astype(h.dtype)


def _rope(x, cos, sin):
    xf = x.astype(jnp.float32)
    x1, x2 = jnp.split(xf, 2, axis=-1)
    return jnp.concatenate([x1 * cos - x2 * sin, x2 * cos + x1 * sin], axis=-1).astype(x.dtype)


def mla_mixer(h, w_in, q_norm_g, kv_norm_g, w_uq, w_ukv, w_out):
    B, T, _ = h.shape
    proj = h @ w_in
    c_q, c_kv, k_pe, g = jnp.split(proj, [Q_LORA, Q_LORA + KV_LORA, Q_LORA + KV_LORA + QK_ROPE], axis=-1)
    q = (rmsnorm(c_q, q_norm_g) @ w_uq).reshape(B, T, MLA_HEADS, QK_HEAD)
    kv = (rmsnorm(c_kv, kv_norm_g) @ w_ukv).reshape(B, T, MLA_HEADS, QK_NOPE + V_HEAD)
    q_nope, q_pe = jnp.split(q, [QK_NOPE], axis=-1)
    k_nope, v = jnp.split(kv, [QK_NOPE], axis=-1)
    inv_freq = 1.0 / (ROPE_THETA ** (jnp.arange(0, QK_ROPE, 2, dtype=jnp.float32) / QK_ROPE))
    ang = jnp.arange(T, dtype=jnp.float32)[:, None] * inv_freq[None, :]
    cos, sin = jnp.cos(ang)[:, None, :], jnp.sin(ang)[:, None, :]
    q_pe = _rope(q_pe, cos, sin)
    k_pe = _rope(k_pe[:, :, None, :], cos, sin)
    q = jnp.concatenate([q_nope, q_pe], axis=-1) * (QK_HEAD ** -0.5)
    k = jnp.concatenate([k_nope, jnp.broadcast_to(k_pe, (B, T, MLA_HEADS, QK_ROPE))], axis=-1)
    nb = T // Q_BLOCK
    qb = q.reshape(B, nb, Q_BLOCK, MLA_HEADS, QK_HEAD).transpose(1, 0, 2, 3, 4)

    def attend(q_blk):
        s = jnp.einsum('bqhd,bkhd->bhqk', q_blk, k, preferred_element_type=jnp.float32)
        p = jax.nn.softmax(s, axis=-1).astype(v.dtype)
        return jnp.einsum('bhqk,bkhd->bqhd', p, v)

    o = lax.map(attend, qb)
    o = o.transpose(1, 0, 2, 3, 4).reshape(B, T, MLA_HEADS * V_HEAD)
    return ((o * jax.nn.silu(g)) @ w_out).astype(h.dtype)


def trunk(x, ln_g, final_g, rw_mu, rw_in, rw_w0, rw_w2, rw_a0, rw_a2, rw_kk, rw_ka, rw_rk,
          rw_lnx_g, rw_lnx_b, rw_out, ml_in, ml_qn, ml_kvn, ml_uq, ml_ukv, ml_out):
    for i in range(DEPTH):
        h = rmsnorm(x, ln_g[i])
        j = i // N_MIXERS
        if i % N_MIXERS == 0:
            x = x + rwkv_mixer(h, rw_mu[j], rw_in[j], rw_w0[j], rw_w2[j], rw_a0[j], rw_a2[j],
                               rw_kk[j], rw_ka[j], rw_rk[j], rw_lnx_g[j], rw_lnx_b[j], rw_out[j])
        else:
            x = x + mla_mixer(h, ml_in[j], ml_qn[j], ml_kvn[j], ml_uq[j], ml_ukv[j], ml_out[j])
    return rmsnorm(x, final_g)


def setup_inputs(seed: int = 0) -> dict:
    key = jax.random.key(seed)
    ks = jax.random.split(key, 24)
    f32 = jnp.float32

    def nrm(k, shape, s):
        return jax.random.normal(k, shape, f32) * s

    NA, NB, E = N_RWKV_LAYERS, N_MLA_LAYERS, D_INNER
    return {
        "x_prompt": nrm(ks[0], (BATCH, SEQ, D_MODEL), 1.0),
        "x_sample": nrm(ks[1], (DEC_BATCH, DEC_SEQ, D_MODEL), 1.0),
        "ln_g": 1.0 + nrm(ks[2], (DEPTH, D_MODEL), 0.02),
        "final_g": 1.0 + nrm(ks[3], (D_MODEL,), 0.02),
        "rw_mu": jax.random.uniform(ks[4], (NA, 6, D_MODEL), f32),
        "rw_in": nrm(ks[5], (NA, D_MODEL, RWKV_IN_COLS), D_MODEL ** -0.5),
        "rw_w0": jax.random.uniform(ks[6], (NA, 2, E), f32, minval=-6.5, maxval=-1.0),
        "rw_w2": nrm(ks[7], (NA, 2, DECAY_LORA, E), 0.1 * DECAY_LORA ** -0.5),
        "rw_a0": nrm(ks[8], (NA, 2, E), 0.1),
        "rw_a2": nrm(ks[9], (NA, 2, ICL_LORA, E), 0.5 * ICL_LORA ** -0.5),
        "rw_kk": 0.85 + nrm(ks[10], (NA, E), 0.05),
        "rw_ka": 1.0 + nrm(ks[11], (NA, E), 0.05),
        "rw_rk": nrm(ks[12], (NA, RWKV_HEADS, RWKV_HEAD), 0.05),
        "rw_lnx_g": 1.0 + nrm(ks[13], (NA, E), 0.02),
        "rw_lnx_b": nrm(ks[14], (NA, E), 0.02),
        "rw_out": nrm(ks[15], (NA, E, D_MODEL), E ** -0.5),
        "ml_in": nrm(ks[16], (NB, D_MODEL, MLA_IN_COLS), D_MODEL ** -0.5),
        "ml_qn": 1.0 + nrm(ks[17], (NB, Q_LORA), 0.02),
        "ml_kvn": 1.0 + nrm(ks[18], (NB, KV_LORA), 0.02),
        "ml_uq": nrm(ks[19], (NB, Q_LORA, MLA_HEADS * QK_HEAD), Q_LORA ** -0.5),
        "ml_ukv": nrm(ks[20], (NB, KV_LORA, MLA_HEADS * (QK_NOPE + V_HEAD)), KV_LORA ** -0.5),
        "ml_out": nrm(ks[21], (NB, E, D_MODEL), E ** -0.5),
    }


def reference(x_prompt, x_sample, ln_g, final_g, rw_mu, rw_in, rw_w0, rw_w2, rw_a0, rw_a2,
              rw_kk, rw_ka, rw_rk, rw_lnx_g, rw_lnx_b, rw_out, ml_in, ml_qn, ml_kvn, ml_uq,
              ml_ukv, ml_out):
    y_prompt = trunk(x_prompt, ln_g, final_g, rw_mu, rw_in, rw_w0, rw_w2, rw_a0, rw_a2, rw_kk, rw_ka,
                     rw_rk, rw_lnx_g, rw_lnx_b, rw_out, ml_in, ml_qn, ml_kvn, ml_uq, ml_ukv, ml_out)
    y_sample = trunk(x_sample, ln_g, final_g, rw_mu, rw_in, rw_w0, rw_w2, rw_a0, rw_a2, rw_kk, rw_ka,
                     rw_rk, rw_lnx_g, rw_lnx_b, rw_out, ml_in, ml_qn, ml_kvn, ml_uq, ml_ukv, ml_out)
    return (y_prompt, y_sample)
```

```cpp
#include <hip/hip_runtime.h>
#include <hip/hip_bf16.h>
#include <hip/hip_cooperative_groups.h>
#include <cstdio>
namespace cg = cooperative_groups;

#ifndef MEGA
#define MEGA 1
#endif

typedef unsigned short u16;
using bf16x8 = __attribute__((ext_vector_type(8))) short;
using s16x4  = __attribute__((ext_vector_type(4))) short;
using f32x16 = __attribute__((ext_vector_type(16))) float;
using f32x4  = __attribute__((ext_vector_type(4))) float;
using u32x4  = __attribute__((ext_vector_type(4))) unsigned;
using u32x2  = __attribute__((ext_vector_type(2))) unsigned;
#define DEV __device__ __forceinline__
#define SBAR() __builtin_amdgcn_sched_barrier(0)

constexpr int DM = 1024, EI = 2048, GT = 16384;
constexpr int NTOK = 49152;
constexpr int RW_N = 8448, ML_N = 2752, ML_NP = 2816;
constexpr int SHM_BYTES = 98304;

constexpr size_t alup(size_t x) { return (x + 255) / 256 * 256; }
constexpr size_t O_WRWIN  = 0;
constexpr size_t O_WRWOUT = O_WRWIN  + alup((size_t)2 * RW_N * DM * 2);
constexpr size_t O_WMLIN  = O_WRWOUT + alup((size_t)2 * DM * EI * 2);
constexpr size_t O_WUQ    = O_WMLIN  + alup((size_t)2 * ML_NP * DM * 2);
constexpr size_t O_WUKV   = O_WUQ    + alup((size_t)2 * 3072 * 384 * 2);
constexpr size_t O_WMLOUT = O_WUKV   + alup((size_t)2 * 4096 * 256 * 2);
constexpr size_t O_COS    = O_WMLOUT + alup((size_t)2 * DM * EI * 2);
constexpr size_t O_SIN    = O_COS    + alup((size_t)16384 * 32 * 4);
constexpr size_t O_HBUF   = O_SIN    + alup((size_t)16384 * 32 * 4);
constexpr size_t O_R0     = O_HBUF   + alup((size_t)GT * DM * 2);
constexpr size_t SZ_E = (size_t)GT * EI * 2;
constexpr size_t O_SG   = O_R0;
constexpr size_t O_RB   = O_SG + SZ_E;
constexpr size_t O_KB   = O_RB + SZ_E;
constexpr size_t O_VB   = O_KB + SZ_E;
constexpr size_t O_YF   = O_VB + SZ_E;
constexpr size_t O_YB   = O_YF + SZ_E;
constexpr size_t O_TWL  = O_YB + SZ_E;
constexpr size_t O_AL   = O_TWL + alup((size_t)GT * 128 * 2);
constexpr size_t O_BON  = O_AL  + alup((size_t)GT * 128 * 2);
constexpr size_t O_RW_END = O_BON + alup((size_t)GT * 64 * 4);
constexpr size_t O_CQKV = O_SG + SZ_E;
constexpr size_t O_CQN  = O_CQKV + alup((size_t)GT * 704 * 4);
constexpr size_t O_CKVN = O_CQN  + alup((size_t)GT * 384 * 2);
constexpr size_t O_KPE  = O_CKVN + alup((size_t)GT * 256 * 2);
constexpr size_t O_Q    = O_KPE  + alup((size_t)GT * 64 * 2);
constexpr size_t O_KV   = O_Q    + alup((size_t)GT * 3072 * 2);
constexpr size_t O_ML_END = O_KV + alup((size_t)GT * 4096 * 2);
constexpr size_t O_FLAG = O_RW_END > O_ML_END ? O_RW_END : O_ML_END;
constexpr size_t WS_NEED = O_FLAG + 256;

struct P {
  const float* x_prompt; const float* x_sample; const float* ln_g; const float* final_g;
  const float* rw_mu; const float* rw_in; const float* rw_w0; const float* rw_w2; const float* rw_a0; const float* rw_a2;
  const float* rw_kk; const float* rw_ka; const float* rw_rk; const float* rw_lnx_g; const float* rw_lnx_b; const float* rw_out;
  const float* ml_in; const float* ml_qn; const float* ml_kvn; const float* ml_uq; const float* ml_ukv; const float* ml_out;
  float* out; char* ws;
};

typedef __attribute__((ext_vector_type(2))) __bf16 bf16x2_t;
typedef __attribute__((ext_vector_type(2))) float f32x2_t;
DEV unsigned cvtpk(float lo, float hi) { f32x2_t v = {lo, hi}; bf16x2_t b = __builtin_convertvector(v, bf16x2_t); return __builtin_bit_cast(unsigned, b); }
DEV float bf2f(u16 x) { return __uint_as_float(((unsigned)x) << 16); }
DEV float bflo(unsigned x) { return __uint_as_float(x << 16); }
DEV float bfhi(unsigned x) { return __uint_as_float(x & 0xffff0000u); }
DEV u16 f2bf(float x) { __bf16 b = (__bf16)x; return __builtin_bit_cast(u16, b); }
DEV float wsum(float v) {
#pragma unroll
  for (int o = 32; o >= 1; o >>= 1) v += __shfl_xor(v, o, 64);
  return v;
}
DEV float siluf(float x) { return x / (1.f + __expf(-x)); }
DEV int crow(int r, int hi) { return (r & 3) + 8 * (r >> 2) + 4 * hi; }
DEV int ltid() { int t = threadIdx.x; asm volatile("" : "+v"(t)); return t; }
DEV void lds_wait() { asm volatile("s_waitcnt lgkmcnt(0)" ::: "memory"); }

DEV void convert_T(const float* __restrict__ src, u16* __restrict__ dst, int K, int N, int Npad, char* lds_) {
  float* lds = (float*)lds_;
  const int tid = ltid(), tk = K / 64, tn = Npad / 64;
  for (int t = blockIdx.x; t < tk * tn; t += gridDim.x) {
    const int k0 = (t % tk) * 64, n0 = (t / tk) * 64;
    __syncthreads();
#pragma unroll
    for (int i = 0; i < 2; ++i) {
      const int kr = (tid >> 4) + i * 32, c = (tid & 15) * 4;
      float4 v = make_float4(0.f, 0.f, 0.f, 0.f);
      if (n0 + c < N) v = *(const float4*)(src + (long)(k0 + kr) * N + n0 + c);
      lds[kr * 65 + c + 0] = v.x; lds[kr * 65 + c + 1] = v.y; lds[kr * 65 + c + 2] = v.z; lds[kr * 65 + c + 3] = v.w;
    }
    __syncthreads();
    const int n = tid >> 3, kc = (tid & 7) * 8;
    u32x4 w;
    w[0] = cvtpk(lds[(kc + 0) * 65 + n], lds[(kc + 1) * 65 + n]);
    w[1] = cvtpk(lds[(kc + 2) * 65 + n], lds[(kc + 3) * 65 + n]);
    w[2] = cvtpk(lds[(kc + 4) * 65 + n], lds[(kc + 5) * 65 + n]);
    w[3] = cvtpk(lds[(kc + 6) * 65 + n], lds[(kc + 7) * 65 + n]);
    *(u32x4*)(dst + (long)(n0 + n) * K + k0 + kc) = w;
  }
}

DEV void init_phase(const P& p, char* lds) {
  for (int j = 0; j < 2; ++j) {
    convert_T(p.rw_in  + (size_t)j * DM * RW_N, (u16*)(p.ws + O_WRWIN)  + (size_t)j * RW_N * DM, DM, RW_N, RW_N, lds);
    convert_T(p.rw_out + (size_t)j * EI * DM,   (u16*)(p.ws + O_WRWOUT) + (size_t)j * DM * EI,   EI, DM, DM, lds);
    convert_T(p.ml_in  + (size_t)j * DM * ML_N, (u16*)(p.ws + O_WMLIN)  + (size_t)j * ML_NP * DM, DM, ML_N, ML_NP, lds);
    convert_T(p.ml_uq  + (size_t)j * 384 * 3072, (u16*)(p.ws + O_WUQ)   + (size_t)j * 3072 * 384, 384, 3072, 3072, lds);
    convert_T(p.ml_ukv + (size_t)j * 256 * 4096, (u16*)(p.ws + O_WUKV)  + (size_t)j * 4096 * 256, 256, 4096, 4096, lds);
    convert_T(p.ml_out + (size_t)j * EI * DM,   (u16*)(p.ws + O_WMLOUT) + (size_t)j * DM * EI,   EI, DM, DM, lds);
  }
  float* ct = (float*)(p.ws + O_COS); float* st = (float*)(p.ws + O_SIN);
  const int tid_ = ltid();
  for (int i = blockIdx.x * 512 + tid_; i < 16384 * 32; i += gridDim.x * 512) {
    const int pos = i >> 5, j = i & 31;
    const float invf = 1.0f / powf(10000.0f, (float)(2 * j) / 64.0f);
    const float ang = (float)pos * invf;
    const double a = (double)ang;
    const double n = rint(a * 0.15915494309189535);
    const float r = (float)(a - n * 6.283185307179586);
    ct[i] = cosf(r); st[i] = sinf(r);
  }
}

DEV void rms_phase(const float* __restrict__ x, const float* __restrict__ g, u16* __restrict__ hout) {
  const int tid_ = ltid(); const int lane = tid_ & 63, wid = tid_ >> 6;
  for (int tok = blockIdx.x * 8 + wid; tok < GT; tok += gridDim.x * 8) {
    const float4* xr = (const float4*)(x + (size_t)tok * DM);
    float4 v[4]; float ss = 0.f;
#pragma unroll
    for (int i = 0; i < 4; ++i) { v[i] = xr[lane + i * 64]; ss += v[i].x * v[i].x + v[i].y * v[i].y + v[i].z * v[i].z + v[i].w * v[i].w; }
    ss = wsum(ss);
    const float sc = rsqrtf(ss * (1.f / DM) + 1e-6f);
#pragma unroll
    for (int i = 0; i < 4; ++i) {
      const float4 gg = ((const float4*)g)[lane + i * 64];
      u32x2 w; w[0] = cvtpk(v[i].x * sc * gg.x, v[i].y * sc * gg.y); w[1] = cvtpk(v[i].z * sc * gg.z, v[i].w * sc * gg.w);
      *(u32x2*)(hout + (size_t)tok * DM + (lane + i * 64) * 4) = w;
    }
  }
}

DEV void final_phase(float* __restrict__ x, const float* __restrict__ g) {
  const int tid_ = ltid(); const int lane = tid_ & 63, wid = tid_ >> 6;
  for (int tok = blockIdx.x * 8 + wid; tok < NTOK; tok += gridDim.x * 8) {
    float4* xr = (float4*)(x + (size_t)tok * DM);
    float4 v[4]; float ss = 0.f;
#pragma unroll
    for (int i = 0; i < 4; ++i) { v[i] = xr[lane + i * 64]; ss += v[i].x * v[i].x + v[i].y * v[i].y + v[i].z * v[i].z + v[i].w * v[i].w; }
    ss = wsum(ss);
    const float sc = rsqrtf(ss * (1.f / DM) + 1e-6f);
#pragma unroll
    for (int i = 0; i < 4; ++i) {
      const float4 gg = ((const float4*)g)[lane + i * 64];
      float4 ov = make_float4(v[i].x * sc * gg.x, v[i].y * sc * gg.y, v[i].z * sc * gg.z, v[i].w * sc * gg.w);
      xr[lane + i * 64] = ov;
    }
  }
}

#define GSWZ(row, c16) ((row) * 128 + ((((c16) ^ ((row) >> 1)) & 7) << 4))
constexpr int LOAD_PLAIN = 0, LOAD_LERP = 1;
constexpr int EPI_RWKV = 0, EPI_RES = 1, EPI_MLAIN = 2, EPI_BF16 = 3;
struct GemmP {
  const u16* A; int lda; const u16* Bt; int K; int NT;
  const float* mu;
  int T;
  u16* o0; u16* o1; u16* o2; u16* o3; u16* o4; u16* o5;
  int ldc;
  float* of; const float* xin; float* xout;
};

template <int LOAD, int EPI>
DEV void gemm_phase(const GemmP& g, char* lds) {
  const int tid = ltid(), wid = tid >> 6, lane = tid & 63, r32 = lane & 31, hi = lane >> 5;
  const int wm = wid >> 1, wn = wid & 1;
  char* sA = lds; char* sB = lds + 65536;
  const int nk = g.K / 64, ntiles = 64 * g.NT;
  const int c16 = tid & 7, rowb = tid >> 3;
  for (int t = blockIdx.x; t < ntiles; t += gridDim.x) {
    const int mt = t & 63, nt = t >> 6, m0 = mt * 256, n0 = nt * 128;
    f32x16 acc[2][2] = {};
    bf16x8 ra[4], rb[2];
    const float* mup = nullptr;
    if constexpr (LOAD == LOAD_LERP) {
      const int s = nt < 16 ? 0 : nt < 32 ? 2 : nt < 48 ? 3 : nt < 64 ? 5 : nt == 64 ? 1 : 4;
      mup = g.mu + s * DM;
    }
    auto gload = [&](int kt) {
      const int k0 = kt * 64 + c16 * 8;
#pragma unroll
      for (int i = 0; i < 4; ++i) {
        const int row = rowb + i * 64; const size_t tok = (size_t)(m0 + row);
        if constexpr (LOAD == LOAD_PLAIN) {
          ra[i] = *(const bf16x8*)(g.A + tok * g.lda + k0);
        } else {
          const int pos = (int)(tok % (size_t)g.T);
          const u32x4 c = *(const u32x4*)(g.A + tok * DM + k0);
          u32x4 pv = {0u, 0u, 0u, 0u}, nx = {0u, 0u, 0u, 0u};
          if (pos > 0) pv = *(const u32x4*)(g.A + (tok - 1) * DM + k0);
          if (pos < g.T - 1) nx = *(const u32x4*)(g.A + (tok + 1) * DM + k0);
          const float4 m0v = *(const float4*)(mup + k0), m1v = *(const float4*)(mup + k0 + 4);
          const float mu[8] = {m0v.x, m0v.y, m0v.z, m0v.w, m1v.x, m1v.y, m1v.z, m1v.w};
          u32x4 o;
#pragma unroll
          for (int e = 0; e < 4; ++e) {
            const float h0 = bflo(c[e]), h1 = bfhi(c[e]);
            const float x0 = 0.5f * (bflo(pv[e]) + bflo(nx[e])) - h0, x1 = 0.5f * (bfhi(pv[e]) + bfhi(nx[e])) - h1;
            o[e] = cvtpk(h0 + mu[2 * e] * x0, h1 + mu[2 * e + 1] * x1);
          }
          ra[i] = *(bf16x8*)&o;
        }
      }
#pragma unroll
      for (int i = 0; i < 2; ++i) {
        const int row = rowb + i * 64;
        rb[i] = *(const bf16x8*)(g.Bt + (size_t)(n0 + row) * g.K + k0);
      }
    };
    auto swrite = [&](int b) {
#pragma unroll
      for (int i = 0; i < 4; ++i) { const int row = rowb + i * 64; *(bf16x8*)(sA + b * 32768 + GSWZ(row, c16)) = ra[i]; }
#pragma unroll
      for (int i = 0; i < 2; ++i) { const int row = rowb + i * 64; *(bf16x8*)(sB + b * 16384 + GSWZ(row, c16)) = rb[i]; }
    };
    gload(0); swrite(0); __syncthreads();
    for (int kt = 0; kt < nk; ++kt) {
      const int b = kt & 1;
      if (kt + 1 < nk) gload(kt + 1);
      const char* a_ = sA + b * 32768; const char* b_ = sB + b * 16384;
#pragma unroll
      for (int ks = 0; ks < 4; ++ks) {
        bf16x8 af[2], bfr[2];
#pragma unroll
        for (int mi = 0; mi < 2; ++mi) { const int row = wm * 64 + mi * 32 + r32; af[mi] = *(const bf16x8*)(a_ + GSWZ(row, ks * 2 + hi)); }
#pragma unroll
        for (int ni = 0; ni < 2; ++ni) { const int row = wn * 64 + ni * 32 + r32; bfr[ni] = *(const bf16x8*)(b_ + GSWZ(row, ks * 2 + hi)); }
#pragma unroll
        for (int mi = 0; mi < 2; ++mi)
#pragma unroll
          for (int ni = 0; ni < 2; ++ni) acc[mi][ni] = __builtin_amdgcn_mfma_f32_32x32x16_bf16(af[mi], bfr[ni], acc[mi][ni], 0, 0, 0);
      }
      if (kt + 1 < nk) swrite(b ^ 1);
      __syncthreads();
    }
#pragma unroll
    for (int mi = 0; mi < 2; ++mi)
#pragma unroll
      for (int ni = 0; ni < 2; ++ni)
#pragma unroll
        for (int r = 0; r < 16; ++r) {
          const size_t m = (size_t)(m0 + wm * 64 + mi * 32 + crow(r, hi));
          const int nl = wn * 64 + ni * 32 + r32, n = n0 + nl;
          const float v = acc[mi][ni][r];
          if constexpr (EPI == EPI_RWKV) {
            if (nt < 64) {
              const int which = nt >> 4, col = (nt & 15) * 128 + nl;
              u16* dst = which == 0 ? g.o0 : which == 1 ? g.o1 : which == 2 ? g.o2 : g.o3;
              dst[m * EI + col] = f2bf(which == 3 ? siluf(v) : v);
            } else if (nt == 64) g.o4[m * 128 + nl] = f2bf(tanhf(v));
            else g.o5[m * 128 + nl] = f2bf(v);
          } else if constexpr (EPI == EPI_RES) {
            g.xout[m * DM + n] = g.xin[m * DM + n] + v;
          } else if constexpr (EPI == EPI_MLAIN) {
            if (n < 704) g.of[m * 704 + n] = v;
            else if (n < ML_N) g.o0[m * EI + (n - 704)] = f2bf(siluf(v));
          } else {
            g.o0[m * g.ldc + n] = f2bf(v);
          }
        }
  }
}

struct ScanP {
  const u16 *r, *k, *v, *twl, *al; u16 *yf, *yb; float* bonus;
  const float *w0, *w2, *a0, *a2, *kk, *ka, *rk;
  int nseq, T;
};
DEV void scan_phase(const ScanP& s, char* lds_) {
  const int tid = ltid(), wid = tid >> 6, lane = tid & 63, c16 = lane & 15, quad = lane >> 4;
  float* lw = (float*)(lds_ + wid * 9472);
  float* la = lw + 1024;
  float* sv = la + 1024;
  const int nchain = s.nseq * 64;
  for (int chain = blockIdx.x * 8 + wid; chain < nchain; chain += gridDim.x * 8) {
    const int d = chain & 1, h = (chain >> 1) & 31, b = chain >> 6;
    const int ch = h * 64 + lane;
    const float w0v = s.w0[d * EI + ch], a0v = s.a0[d * EI + ch], kkp = s.kk[ch], kap = s.ka[ch], rkp = s.rk[ch];
    bf16x8 bw[2][4], ba[2][4];
#pragma unroll
    for (int ksp = 0; ksp < 2; ++ksp)
#pragma unroll
      for (int nt = 0; nt < 4; ++nt) {
        u32x4 pw, pa;
#pragma unroll
        for (int e = 0; e < 4; ++e) {
          const int l0 = ksp * 32 + quad * 8 + 2 * e;
          const size_t i0 = ((size_t)(d * 64 + l0)) * EI + h * 64 + nt * 16 + c16;
          pw[e] = cvtpk(s.w2[i0], s.w2[i0 + EI]); pa[e] = cvtpk(s.a2[i0], s.a2[i0 + EI]);
        }
        bw[ksp][nt] = *(bf16x8*)&pw; ba[ksp][nt] = *(bf16x8*)&pa;
      }
    float S[64];
#pragma unroll
    for (int j = 0; j < 64; ++j) S[j] = 0.f;
    u16* yout = d ? s.yb : s.yf;
    const size_t sb = (size_t)b * s.T;
    const int nchunk = s.T / 16;
    for (int cc = 0; cc < nchunk; ++cc) {
      const int c0 = d ? (s.T - 16 - cc * 16) : cc * 16;
      {
        const size_t trow = (sb + c0 + c16) * 128 + d * 64 + quad * 8;
        const bf16x8 aw0 = *(const bf16x8*)(s.twl + trow), aw1 = *(const bf16x8*)(s.twl + trow + 32);
        const bf16x8 aa0 = *(const bf16x8*)(s.al + trow),  aa1 = *(const bf16x8*)(s.al + trow + 32);
#pragma unroll
        for (int nt = 0; nt < 4; ++nt) {
          f32x4 cw = {0.f, 0.f, 0.f, 0.f}, ca = {0.f, 0.f, 0.f, 0.f};
          cw = __builtin_amdgcn_mfma_f32_16x16x32_bf16(aw0, bw[0][nt], cw, 0, 0, 0);
          cw = __builtin_amdgcn_mfma_f32_16x16x32_bf16(aw1, bw[1][nt], cw, 0, 0, 0);
          ca = __builtin_amdgcn_mfma_f32_16x16x32_bf16(aa0, ba[0][nt], ca, 0, 0, 0);
          ca = __builtin_amdgcn_mfma_f32_16x16x32_bf16(aa1, ba[1][nt], ca, 0, 0, 0);
#pragma unroll
          for (int jj = 0; jj < 4; ++jj) { lw[(quad * 4 + jj) * 64 + nt * 16 + c16] = cw[jj]; la[(quad * 4 + jj) * 64 + nt * 16 + c16] = ca[jj]; }
        }
        lds_wait();
      }
      for (int tt = 0; tt < 16; ++tt) {
        const int tl = d ? 15 - tt : tt;
        const size_t tok = sb + c0 + tl;
        const float wp = lw[tl * 64 + lane] + w0v, ap = la[tl * 64 + lane] + a0v;
        const float sgw = 1.f / (1.f + __expf(-wp));
        const float wdec = __expf(-0.6065306597126334f * sgw);
        const float a = 1.f / (1.f + __expf(-ap));
        const float kx = bf2f(s.k[tok * EI + ch]), rx = bf2f(s.r[tok * EI + ch]), vx = bf2f(s.v[tok * EI + ch]);
        const float kkv = kx * kkp;
        const float n2 = wsum(kkv * kkv);
        const float kkn = kkv / fmaxf(sqrtf(n2), 1e-12f);
        const float kd = kx * (1.f + (a - 1.f) * kap);
        const float bb = kkn * a;
        const float bon = wsum(rx * kd * rkp);
        if (lane == 0) s.bonus[(tok * 32 + h) * 2 + d] = bon;
        sv[lane] = wdec; sv[64 + lane] = kd; sv[128 + lane] = -kkn; sv[192 + lane] = bb; sv[256 + lane] = rx;
        lds_wait();
        float sa = 0.f;
#pragma unroll
        for (int j4 = 0; j4 < 16; ++j4) {
          const float4 q = ((const float4*)(sv + 128))[j4];
          sa += S[4 * j4] * q.x; sa += S[4 * j4 + 1] * q.y; sa += S[4 * j4 + 2] * q.z; sa += S[4 * j4 + 3] * q.w;
        }
        float y = 0.f;
#pragma unroll
        for (int j4 = 0; j4 < 16; ++j4) {
          const float4 w4 = ((const float4*)(sv))[j4], k4 = ((const float4*)(sv + 64))[j4], b4 = ((const float4*)(sv + 192))[j4], r4 = ((const float4*)(sv + 256))[j4];
          S[4 * j4]     = S[4 * j4]     * w4.x + sa * b4.x + vx * k4.x; y += S[4 * j4]     * r4.x;
          S[4 * j4 + 1] = S[4 * j4 + 1] * w4.y + sa * b4.y + vx * k4.y; y += S[4 * j4 + 1] * r4.y;
          S[4 * j4 + 2] = S[4 * j4 + 2] * w4.z + sa * b4.z + vx * k4.z; y += S[4 * j4 + 2] * r4.z;
          S[4 * j4 + 3] = S[4 * j4 + 3] * w4.w + sa * b4.w + vx * k4.w; y += S[4 * j4 + 3] * r4.w;
        }
        yout[tok * EI + ch] = f2bf(y);
        lds_wait();
      }
    }
  }
}

DEV void post_phase(u16* __restrict__ yf, const u16* __restrict__ yb, const u16* __restrict__ v, const u16* __restrict__ sg,
                    const float* __restrict__ bonus, const float* __restrict__ lg, const float* __restrict__ lb) {
  const int tid_ = ltid(); const int lane = tid_ & 63, wid = tid_ >> 6;
  for (int tok = blockIdx.x * 8 + wid; tok < GT; tok += gridDim.x * 8) {
    for (int h = 0; h < 32; ++h) {
      const int ch = h * 64 + lane; const size_t i = (size_t)tok * EI + ch;
      const float y = bf2f(yf[i]) + bf2f(yb[i]);
      const float mean = wsum(y) * (1.f / 64.f);
      const float dd = y - mean;
      const float var = wsum(dd * dd) * (1.f / 64.f);
      const float yn = dd * rsqrtf(var + 64e-5f) * lg[ch] + lb[ch];
      const float bon = bonus[((size_t)tok * 32 + h) * 2] + bonus[((size_t)tok * 32 + h) * 2 + 1];
      yf[i] = f2bf((yn + bon * bf2f(v[i])) * bf2f(sg[i]));
    }
  }
}

DEV void mla_mid_phase(const float* __restrict__ cqkv, const float* __restrict__ qn, const float* __restrict__ kvn,
                       const float* __restrict__ ct, const float* __restrict__ st,
                       u16* __restrict__ cqn, u16* __restrict__ ckvn, u16* __restrict__ kpe, int T) {
  const int tid_ = ltid(); const int lane = tid_ & 63, wid = tid_ >> 6;
  for (int tok = blockIdx.x * 8 + wid; tok < GT; tok += gridDim.x * 8) {
    const float* row = cqkv + (size_t)tok * 704;
    float q[6], ss = 0.f;
#pragma unroll
    for (int i = 0; i < 6; ++i) { q[i] = row[lane + i * 64]; ss += q[i] * q[i]; }
    ss = wsum(ss); float sc = rsqrtf(ss * (1.f / 384.f) + 1e-6f);
#pragma unroll
    for (int i = 0; i < 6; ++i) cqn[(size_t)tok * 384 + lane + i * 64] = f2bf(q[i] * sc * qn[lane + i * 64]);
    float c[4]; ss = 0.f;
#pragma unroll
    for (int i = 0; i < 4; ++i) { c[i] = row[384 + lane + i * 64]; ss += c[i] * c[i]; }
    ss = wsum(ss); sc = rsqrtf(ss * (1.f / 256.f) + 1e-6f);
#pragma unroll
    for (int i = 0; i < 4; ++i) ckvn[(size_t)tok * 256 + lane + i * 64] = f2bf(c[i] * sc * kvn[lane + i * 64]);
    const float x = row[640 + lane];
    const float xo = __shfl_xor(x, 32, 64);
    const int pos = tok % T, j = lane & 31;
    const float cs = ct[pos * 32 + j], sn = st[pos * 32 + j];
    const float o = lane < 32 ? x * cs - xo * sn : x * cs + xo * sn;
    kpe[(size_t)tok * 64 + lane] = f2bf(o);
  }
}

constexpr int SHM_V = 16384, SHM_K = 16384, SHM_KP = 8192;
#define KSWZ(row, colB) ((row) * 256 + ((colB) ^ (((row) & 7) << 4)))
#define KPSWZ(row, colB) ((row) * 128 + ((colB) ^ (((row) & 7) << 4)))
constexpr float ATT_SCALE = 0.07216878364870322f;
DEV void partialSM(f32x16& p0, f32x16& p1, float& m_reg, float& mn, float& alpha) {
  constexpr float C = ATT_SCALE * 1.4426950408889634f;
  float pmax = p0[0];
#pragma unroll
  for (int r = 1; r < 16; ++r) pmax = fmaxf(pmax, p0[r]);
#pragma unroll
  for (int r = 0; r < 16; ++r) pmax = fmaxf(pmax, p1[r]);
  { auto rr = __builtin_amdgcn_permlane32_swap(__float_as_uint(pmax), __float_as_uint(pmax), false, false);
    pmax = fmaxf(__uint_as_float(rr[0]), __uint_as_float(rr[1])); }
  mn = fmaxf(m_reg, pmax); alpha = __builtin_amdgcn_exp2f((m_reg - mn) * C); m_reg = mn;
  const float mnC = -mn * C;
#pragma unroll
  for (int r = 0; r < 16; ++r) p0[r] = __builtin_amdgcn_exp2f(fmaf(p0[r], C, mnC));
#pragma unroll
  for (int r = 0; r < 16; ++r) p1[r] = __builtin_amdgcn_exp2f(fmaf(p1[r], C, mnC));
}
DEV void finishSM(f32x16& p0, f32x16& p1, float alpha, float& l_reg, bf16x8& pa0, bf16x8& pa1, bf16x8& pa2, bf16x8& pa3) {
  float ps = 0;
#pragma unroll
  for (int r = 0; r < 16; ++r) ps += p0[r];
#pragma unroll
  for (int r = 0; r < 16; ++r) ps += p1[r];
  { auto rr = __builtin_amdgcn_permlane32_swap(__float_as_uint(ps), __float_as_uint(ps), false, false);
    ps = __uint_as_float(rr[0]) + __uint_as_float(rr[1]); }
  l_reg = l_reg * alpha + ps;
#define PK4(PP, BASE, OUT) do { unsigned a0 = cvtpk(PP[BASE + 0], PP[BASE + 1]), a1 = cvtpk(PP[BASE + 2], PP[BASE + 3]);   \
    unsigned b0 = cvtpk(PP[BASE + 4], PP[BASE + 5]), b1 = cvtpk(PP[BASE + 6], PP[BASE + 7]);                              \
    auto r0 = __builtin_amdgcn_permlane32_swap(a0, b0, false, false); auto r1 = __builtin_amdgcn_permlane32_swap(a1, b1, false, false); \
    u32x4 w = {r0[0], r1[0], r0[1], r1[1]}; OUT = *reinterpret_cast<bf16x8*>(&w); } while (0)
  PK4(p0, 0, pa0); PK4(p0, 8, pa1); PK4(p1, 0, pa2); PK4(p1, 8, pa3);
#undef PK4
}
DEV int v_st(int k, int c) { const int kk = (k & ~0xC) | ((k & 4) << 1) | ((k & 8) >> 1); return ((kk >> 3) * 4 + (c >> 5)) * 512 + ((kk & 7) * 32 + (c & 31)) * 2; }
DEV int v_rd_base(int lane) { return ((lane & 3) << 3) | (((lane >> 2) & 3) << 6) | (((lane >> 4) & 1) << 5) | (((lane >> 5) & 1) << 8); }
constexpr int v_rd_off(int d0, int ks, int half) { return d0 * 512 + ks * 4096 + half * 2048; }
template <int OFF> DEV s16x4 tr_read(int vb) {
  s16x4 r; asm volatile("ds_read_b64_tr_b16 %0, %1 offset:%2" : "=&v"(r) : "v"(vb), "i"(OFF) : "memory"); return r;
}
template <int D0> DEV void pv_one(f32x16& od, int vb, bf16x8 pa0, bf16x8 pa1, bf16x8 pa2, bf16x8 pa3) {
  const s16x4 l0 = tr_read<v_rd_off(D0, 0, 0)>(vb), h0 = tr_read<v_rd_off(D0, 0, 1)>(vb), l1 = tr_read<v_rd_off(D0, 1, 0)>(vb), h1 = tr_read<v_rd_off(D0, 1, 1)>(vb);
  const s16x4 l2 = tr_read<v_rd_off(D0, 2, 0)>(vb), h2 = tr_read<v_rd_off(D0, 2, 1)>(vb), l3 = tr_read<v_rd_off(D0, 3, 0)>(vb), h3 = tr_read<v_rd_off(D0, 3, 1)>(vb);
  asm volatile("s_waitcnt lgkmcnt(0)" ::: "memory"); SBAR();
#define PK(L, H) (bf16x8){L[0], L[1], L[2], L[3], H[0], H[1], H[2], H[3]}
  od = __builtin_amdgcn_mfma_f32_32x32x16_bf16(pa0, PK(l0, h0), od, 0, 0, 0);
  od = __builtin_amdgcn_mfma_f32_32x32x16_bf16(pa1, PK(l1, h1), od, 0, 0, 0);
  od = __builtin_amdgcn_mfma_f32_32x32x16_bf16(pa2, PK(l2, h2), od, 0, 0, 0);
  od = __builtin_amdgcn_mfma_f32_32x32x16_bf16(pa3, PK(l3, h3), od, 0, 0, 0);
#undef PK
}

struct AttnP { const u16* q; const u16* kv; const u16* kpe; u16* sg; const float* ct; const float* st; int nseq, T; };
DEV void attn_phase(const AttnP& a, char* lds) {
  const int tid = ltid(), wid = tid >> 6, lane = tid & 63, r32 = lane & 31, hi = lane >> 5;
  char* V_lds = lds; char* K_lds = lds + 2 * SHM_V; char* KP_lds = lds + 2 * SHM_V + 2 * SHM_K;
  float* wsc = (float*)(lds + 2 * SHM_V + 2 * SHM_K + 2 * SHM_KP) + wid * 64; float* li_l = wsc; float* al_l = wsc + 32;
  const int nqb = a.T / 256, nitems = a.nseq * 16 * nqb, NT = a.T / 64;
  const int sr = tid >> 4, sc = (tid & 15) * 8, vst0 = v_st(sr, sc), vst1 = v_st(32 + sr, sc);
  const int pr = tid >> 3, pc = (tid & 7) * 8;
  const int vb0 = (int)(uintptr_t)V_lds + v_rd_base(lane);
  int kad[4], kpd[4];
#pragma unroll
  for (int q = 0; q < 4; ++q) { kad[q] = KSWZ(r32, q * 32 + hi * 16); kpd[q] = KPSWZ(r32, q * 32 + hi * 16); }
  for (int it = blockIdx.x; it < nitems; it += gridDim.x) {
    const int qb = it % nqb, h = (it / nqb) & 15, b = it / (nqb * 16);
    const size_t sbase = (size_t)b * a.T;
    const int pos = qb * 256 + wid * 32 + r32;
    bf16x8 qr[12];
    {
      const u16* Qw = a.q + (sbase + pos) * 3072 + h * 192 + hi * 8;
#pragma unroll
      for (int d0 = 0; d0 < 12; ++d0) qr[d0] = *(const bf16x8*)(Qw + d0 * 16);
#pragma unroll
      for (int dd = 0; dd < 2; ++dd) {
        const int j0 = dd * 16 + hi * 8;
        const float4 c0 = *(const float4*)(a.ct + pos * 32 + j0), c1 = *(const float4*)(a.ct + pos * 32 + j0 + 4);
        const float4 s0 = *(const float4*)(a.st + pos * 32 + j0), s1 = *(const float4*)(a.st + pos * 32 + j0 + 4);
        const float cs[8] = {c0.x, c0.y, c0.z, c0.w, c1.x, c1.y, c1.z, c1.w};
        const float sn[8] = {s0.x, s0.y, s0.z, s0.w, s1.x, s1.y, s1.z, s1.w};
        u32x4 x1 = *(u32x4*)&qr[8 + dd], x2 = *(u32x4*)&qr[10 + dd], y1, y2;
#pragma unroll
        for (int e = 0; e < 4; ++e) {
          const float a0 = bflo(x1[e]), a1 = bfhi(x1[e]), b0 = bflo(x2[e]), b1 = bfhi(x2[e]);
          y1[e] = cvtpk(a0 * cs[2 * e] - b0 * sn[2 * e], a1 * cs[2 * e + 1] - b1 * sn[2 * e + 1]);
          y2[e] = cvtpk(b0 * cs[2 * e] + a0 * sn[2 * e], b1 * cs[2 * e + 1] + a1 * sn[2 * e + 1]);
        }
        qr[8 + dd] = *(bf16x8*)&y1; qr[10 + dd] = *(bf16x8*)&y2;
      }
    }
    float m_reg = -1e30f, l_reg = 0.f; f32x16 o[4] = {};
    bf16x8 vs0, vs1, ks0, ks1, kp0;
    const u16* kvh = a.kv + sbase * 4096 + h * 256;
    const u16* kph = a.kpe + sbase * 64;
    const unsigned voff = (unsigned)(sr * 8192 + sc * 2), poff = (unsigned)(pr * 128 + pc * 2);
#define SLOAD(k0) do { const char* bK0 = (const char*)kvh + (size_t)(k0) * 8192; const char* bK1 = bK0 + 32 * 8192; const char* bP = (const char*)kph + (size_t)(k0) * 128; \
    vs0 = *(const bf16x8*)(bK0 + voff + 256); vs1 = *(const bf16x8*)(bK1 + voff + 256); \
    ks0 = *(const bf16x8*)(bK0 + voff); ks1 = *(const bf16x8*)(bK1 + voff); \
    kp0 = *(const bf16x8*)(bP + poff); } while (0)
#define SWRITE(bb) do { *(bf16x8*)(V_lds + (bb) * SHM_V + vst0) = vs0; *(bf16x8*)(V_lds + (bb) * SHM_V + vst1) = vs1; \
    *(bf16x8*)(K_lds + (bb) * SHM_K + KSWZ(sr, sc * 2)) = ks0; *(bf16x8*)(K_lds + (bb) * SHM_K + KSWZ(32 + sr, sc * 2)) = ks1; \
    *(bf16x8*)(KP_lds + (bb) * SHM_KP + KPSWZ(pr, pc * 2)) = kp0; } while (0)
    __syncthreads();
    SLOAD(0); SWRITE(0); __syncthreads();
    for (int j = 0; j < NT; ++j) {
      const int bb = j & 1;
      f32x16 p0 = {}, p1 = {};
      {
        const char* Ks = K_lds + bb * SHM_K; const char* Kp = KP_lds + bb * SHM_KP;
#pragma unroll
        for (int d0 = 0; d0 < 8; ++d0) {
          const bf16x8 b0 = *(const bf16x8*)(Ks + kad[d0 & 3] + (d0 >> 2) * 128), b1 = *(const bf16x8*)(Ks + kad[d0 & 3] + (d0 >> 2) * 128 + 8192);
          p0 = __builtin_amdgcn_mfma_f32_32x32x16_bf16(b0, qr[d0], p0, 0, 0, 0);
          p1 = __builtin_amdgcn_mfma_f32_32x32x16_bf16(b1, qr[d0], p1, 0, 0, 0); }
#pragma unroll
        for (int d0 = 0; d0 < 4; ++d0) {
          const bf16x8 b0 = *(const bf16x8*)(Kp + kpd[d0]), b1 = *(const bf16x8*)(Kp + kpd[d0] + 4096);
          p0 = __builtin_amdgcn_mfma_f32_32x32x16_bf16(b0, qr[8 + d0], p0, 0, 0, 0);
          p1 = __builtin_amdgcn_mfma_f32_32x32x16_bf16(b1, qr[8 + d0], p1, 0, 0, 0); }
      }
      float mn, alpha;
      partialSM(p0, p1, m_reg, mn, alpha);
      if (__any(alpha < 1.f)) {
        if (hi == 0) al_l[r32] = alpha;
        lds_wait();
#pragma unroll
        for (int dd = 0; dd < 4; ++dd)
#pragma unroll
          for (int r = 0; r < 16; ++r) o[dd][r] *= al_l[crow(r, hi)];
      }
      bf16x8 pa0, pa1, pa2, pa3;
      finishSM(p0, p1, alpha, l_reg, pa0, pa1, pa2, pa3); SBAR();
      if (j + 1 < NT) SLOAD((j + 1) * 64);
      SBAR();
      const int vb = vb0 + bb * SHM_V;
      pv_one<0>(o[0], vb, pa0, pa1, pa2, pa3); pv_one<1>(o[1], vb, pa0, pa1, pa2, pa3);
      pv_one<2>(o[2], vb, pa0, pa1, pa2, pa3); pv_one<3>(o[3], vb, pa0, pa1, pa2, pa3);
      if (j + 1 < NT) SWRITE(bb ^ 1);
      __syncthreads();
    }
#undef SLOAD
#undef SWRITE
    {
      int t2 = threadIdx.x; asm volatile("" : "+v"(t2));
      const int wid2 = t2 >> 6, r2 = t2 & 31, hi2 = (t2 >> 5) & 1;
      float* li2 = (float*)(lds + 2 * SHM_V + 2 * SHM_K + 2 * SHM_KP) + wid2 * 64;
      if (hi2 == 0) li2[r2] = l_reg;
      lds_wait();
      u16* Ow = a.sg + (sbase + qb * 256 + wid2 * 32) * EI + h * 128 + r2;
#pragma unroll
      for (int r = 0; r < 16; ++r) {
        const int orow = crow(r, hi2);
        const float rl = __builtin_amdgcn_rcpf(li2[orow]);
#pragma unroll
        for (int d0 = 0; d0 < 4; ++d0) {
          u16* pp = Ow + (size_t)orow * EI + d0 * 32;
          *pp = f2bf(o[d0][r] * rl * bf2f(*pp));
        }
      }
    }
  }
}

struct Grp { const float* xin0; float* xres; int nseq, T; };
DEV Grp get_group(const P& p, int g) {
  Grp r;
  r.xin0 = g == 0 ? p.x_prompt : p.x_sample + (size_t)(g - 1) * GT * DM;
  r.xres = p.out + (size_t)g * GT * DM;
  r.nseq = g == 0 ? 8 : 1; r.T = g == 0 ? 2048 : 16384;
  return r;
}
template <int LT, int ph>
DEV void run_phase(const P& p, int g, int layer, char* lds) {
  const Grp G = get_group(p, g);
  const int j = layer >> 1;
  const float* xin = layer == 0 ? G.xin0 : G.xres;
  char* ws = p.ws; asm volatile("" : "+s"(ws));
  u16* hbuf = (u16*)(ws + O_HBUF);
  u16* sg = (u16*)(ws + O_SG);
  if constexpr (LT == 0) {
    u16 *rb = (u16*)(ws + O_RB), *kb = (u16*)(ws + O_KB), *vb = (u16*)(ws + O_VB), *yf = (u16*)(ws + O_YF), *yb = (u16*)(ws + O_YB);
    u16 *twl = (u16*)(ws + O_TWL), *al = (u16*)(ws + O_AL); float* bon = (float*)(ws + O_BON);
    if constexpr (ph == 0) rms_phase(xin, p.ln_g + layer * DM, hbuf);
    else if constexpr (ph == 1) {
      GemmP q{}; q.A = hbuf; q.lda = DM; q.Bt = (const u16*)(ws + O_WRWIN) + (size_t)j * RW_N * DM; q.K = DM; q.NT = 66;
      q.mu = p.rw_mu + (size_t)j * 6 * DM; q.T = G.T; q.o0 = rb; q.o1 = kb; q.o2 = vb; q.o3 = sg; q.o4 = twl; q.o5 = al;
      gemm_phase<LOAD_LERP, EPI_RWKV>(q, lds);
    } else if constexpr (ph == 2) {
      ScanP s{}; s.r = rb; s.k = kb; s.v = vb; s.twl = twl; s.al = al; s.yf = yf; s.yb = yb; s.bonus = bon;
      s.w0 = p.rw_w0 + (size_t)j * 2 * EI; s.w2 = p.rw_w2 + (size_t)j * 2 * 64 * EI; s.a0 = p.rw_a0 + (size_t)j * 2 * EI; s.a2 = p.rw_a2 + (size_t)j * 2 * 64 * EI;
      s.kk = p.rw_kk + (size_t)j * EI; s.ka = p.rw_ka + (size_t)j * EI; s.rk = p.rw_rk + (size_t)j * EI; s.nseq = G.nseq; s.T = G.T;
      scan_phase(s, lds);
    } else if constexpr (ph == 3) post_phase(yf, yb, vb, sg, bon, p.rw_lnx_g + (size_t)j * EI, p.rw_lnx_b + (size_t)j * EI);
    else {
      GemmP q{}; q.A = yf; q.lda = EI; q.Bt = (const u16*)(ws + O_WRWOUT) + (size_t)j * DM * EI; q.K = EI; q.NT = 8; q.xin = xin; q.xout = G.xres;
      gemm_phase<LOAD_PLAIN, EPI_RES>(q, lds);
    }
  } else {
    float* cqkv = (float*)(ws + O_CQKV); u16 *cqn = (u16*)(ws + O_CQN), *ckvn = (u16*)(ws + O_CKVN), *kpe = (u16*)(ws + O_KPE), *qq = (u16*)(ws + O_Q), *kv = (u16*)(ws + O_KV);
    const float* ct = (const float*)(ws + O_COS); const float* st = (const float*)(ws + O_SIN);
    if constexpr (ph == 0) rms_phase(xin, p.ln_g + layer * DM, hbuf);
    else if constexpr (ph == 1) {
      GemmP q{}; q.A = hbuf; q.lda = DM; q.Bt = (const u16*)(ws + O_WMLIN) + (size_t)j * ML_NP * DM; q.K = DM; q.NT = 22; q.of = cqkv; q.o0 = sg;
      gemm_phase<LOAD_PLAIN, EPI_MLAIN>(q, lds);
    } else if constexpr (ph == 2) mla_mid_phase(cqkv, p.ml_qn + j * 384, p.ml_kvn + j * 256, ct, st, cqn, ckvn, kpe, G.T);
    else if constexpr (ph == 3) {
      GemmP q{}; q.A = cqn; q.lda = 384; q.Bt = (const u16*)(ws + O_WUQ) + (size_t)j * 3072 * 384; q.K = 384; q.NT = 24; q.o0 = qq; q.ldc = 3072;
      gemm_phase<LOAD_PLAIN, EPI_BF16>(q, lds);
      GemmP r{}; r.A = ckvn; r.lda = 256; r.Bt = (const u16*)(ws + O_WUKV) + (size_t)j * 4096 * 256; r.K = 256; r.NT = 32; r.o0 = kv; r.ldc = 4096;
      gemm_phase<LOAD_PLAIN, EPI_BF16>(r, lds);
    } else if constexpr (ph == 4) {
      AttnP a{}; a.q = qq; a.kv = kv; a.kpe = kpe; a.sg = sg; a.ct = ct; a.st = st; a.nseq = G.nseq; a.T = G.T;
      attn_phase(a, lds);
    } else {
      GemmP q{}; q.A = sg; q.lda = EI; q.Bt = (const u16*)(ws + O_WMLOUT) + (size_t)j * DM * EI; q.K = EI; q.NT = 8; q.xin = xin; q.xout = G.xres;
      gemm_phase<LOAD_PLAIN, EPI_RES>(q, lds);
    }
  }
}


template <int LT, int PH>
__global__ __launch_bounds__(512) void k_phase(P p, int g, int layer) {
  extern __shared__ __attribute__((aligned(16))) char lds[];
  if constexpr (LT == 2) { if constexpr (PH == 0) init_phase(p, lds); else final_phase(p.out, p.final_g); }
  else run_phase<LT, PH>(p, g, layer, lds);
}

#if MEGA
__global__ __launch_bounds__(512) void k_mega(P p) {
  extern __shared__ __attribute__((aligned(16))) char lds[];
  cg::grid_group grid = cg::this_grid();
  init_phase(p, lds);
  grid.sync();
  for (int g = 0; g < 3; ++g)
    for (int layer = 0; layer < 4; ++layer) {
      if ((layer & 1) == 0) {
        run_phase<0, 0>(p, g, layer, lds); grid.sync(); run_phase<0, 1>(p, g, layer, lds); grid.sync(); run_phase<0, 2>(p, g, layer, lds); grid.sync();
        run_phase<0, 3>(p, g, layer, lds); grid.sync(); run_phase<0, 4>(p, g, layer, lds); grid.sync();
      } else {
        run_phase<1, 0>(p, g, layer, lds); grid.sync(); run_phase<1, 1>(p, g, layer, lds); grid.sync(); run_phase<1, 2>(p, g, layer, lds); grid.sync();
        run_phase<1, 3>(p, g, layer, lds); grid.sync(); run_phase<1, 4>(p, g, layer, lds); grid.sync(); run_phase<1, 5>(p, g, layer, lds); grid.sync();
      }
    }
  final_phase(p.out, p.final_g);
}
#endif

extern "C" void kernel_launch(void* const* d_in, const int* in_sizes, int n_in, void* d_out, int out_size, void* d_ws, size_t ws_size, hipStream_t stream) {
  if (n_in != 22 || ws_size < WS_NEED) { fprintf(stderr, "kernel_launch: bad args n_in %d ws %zu need %zu\n", n_in, ws_size, WS_NEED); return; }
  P p{};
  const float** f = (const float**)&p;
  for (int i = 0; i < 22; ++i) f[i] = (const float*)d_in[i];
  p.out = (float*)d_out; p.ws = (char*)d_ws;
#if MEGA
  static int grid_blocks = 0;
  if (!grid_blocks) {
    hipFuncSetAttribute((const void*)k_mega, hipFuncAttributeMaxDynamicSharedMemorySize, SHM_BYTES);
    int dev = 0, cus = 0, per_cu = 0;
    hipGetDevice(&dev);
    hipDeviceGetAttribute(&cus, hipDeviceAttributeMultiprocessorCount, dev);
    hipOccupancyMaxActiveBlocksPerMultiprocessor(&per_cu, k_mega, 512, SHM_BYTES);
    if (per_cu > 1) per_cu = 1;
    grid_blocks = cus * per_cu;
  }
  void* args[] = {&p};
  hipError_t e = hipLaunchCooperativeKernel((void*)k_mega, dim3(grid_blocks), dim3(512), args, SHM_BYTES, stream);
  if (e != hipSuccess) fprintf(stderr, "cooperative launch failed: %s (grid %d)\n", hipGetErrorString(e), grid_blocks);
#else
  const int NB = 256;
#define LAUNCH(LT, PH, g, layer) do { static int inited = 0; if (!inited) { hipFuncSetAttribute((const void*)k_phase<LT, PH>, hipFuncAttributeMaxDynamicSharedMemorySize, SHM_BYTES); inited = 1; } \
    hipLaunchKernelGGL((k_phase<LT, PH>), dim3(NB), dim3(512), SHM_BYTES, stream, p, g, layer); } while (0)
  LAUNCH(2, 0, 0, 0);
  for (int g = 0; g < 3; ++g)
    for (int layer = 0; layer < 4; ++layer) {
      if ((layer & 1) == 0) { LAUNCH(0, 0, g, layer); LAUNCH(0, 1, g, layer); LAUNCH(0, 2, g, layer); LAUNCH(0, 3, g, layer); LAUNCH(0, 4, g, layer); }
      else { LAUNCH(1, 0, g, layer); LAUNCH(1, 1, g, layer); LAUNCH(1, 2, g, layer); LAUNCH(1, 3, g, layer); LAUNCH(1, 4, g, layer); LAUNCH(1, 5, g, layer); }
    }
  LAUNCH(2, 1, 0, 0);
#endif
}
```

```cpp
#include <hip/hip_runtime.h>
#include <hip/hip_bf16.h>
#include <hip/hip_cooperative_groups.h>
#include <cstdio>
namespace cg = cooperative_groups;

#ifndef MEGA
#define MEGA 1
#endif

typedef unsigned short u16;
using bf16x8 = __attribute__((ext_vector_type(8))) short;
using s16x4  = __attribute__((ext_vector_type(4))) short;
using f32x16 = __attribute__((ext_vector_type(16))) float;
using f32x4  = __attribute__((ext_vector_type(4))) float;
using u32x4  = __attribute__((ext_vector_type(4))) unsigned;
using u32x2  = __attribute__((ext_vector_type(2))) unsigned;
#define DEV __device__ __forceinline__
#define SBAR() __builtin_amdgcn_sched_barrier(0)

constexpr int DM = 1024, EI = 2048, GT = 16384;
constexpr int NTOK = 49152;
constexpr int RW_N = 8448, ML_N = 2752, ML_NP = 2816;
constexpr int SHM_BYTES = 106496;

constexpr size_t alup(size_t x) { return (x + 255) / 256 * 256; }
constexpr size_t O_WRWIN  = 0;
constexpr size_t O_WRWOUT = O_WRWIN  + alup((size_t)2 * RW_N * DM * 2);
constexpr size_t O_WMLIN  = O_WRWOUT + alup((size_t)2 * DM * EI * 2);
constexpr size_t O_WUQ    = O_WMLIN  + alup((size_t)2 * ML_NP * DM * 2);
constexpr size_t O_WUKV   = O_WUQ    + alup((size_t)2 * 3072 * 384 * 2);
constexpr size_t O_WMLOUT = O_WUKV   + alup((size_t)2 * 4096 * 256 * 2);
constexpr size_t O_COS    = O_WMLOUT + alup((size_t)2 * DM * EI * 2);
constexpr size_t O_SIN    = O_COS    + alup((size_t)16384 * 32 * 4);
constexpr size_t O_HBUF   = O_SIN    + alup((size_t)16384 * 32 * 4);
constexpr size_t O_R0     = O_HBUF   + alup((size_t)GT * DM * 2);
constexpr size_t SZ_E = (size_t)GT * EI * 2;
constexpr size_t O_SG   = O_R0;
constexpr size_t O_RB   = O_SG + SZ_E;
constexpr size_t O_KB   = O_RB + SZ_E;
constexpr size_t O_VB   = O_KB + SZ_E;
constexpr size_t O_YF   = O_VB + SZ_E;
constexpr size_t O_YB   = O_YF + SZ_E;
constexpr size_t O_TWL  = O_YB + SZ_E;
constexpr size_t O_AL   = O_TWL + alup((size_t)GT * 128 * 2);
constexpr size_t O_BON  = O_AL  + alup((size_t)GT * 128 * 2);
constexpr size_t O_RW_END = O_BON + alup((size_t)GT * 64 * 4);
constexpr size_t O_CQKV = O_SG + SZ_E;
constexpr size_t O_CQN  = O_CQKV + alup((size_t)GT * 704 * 4);
constexpr size_t O_CKVN = O_CQN  + alup((size_t)GT * 384 * 2);
constexpr size_t O_KPE  = O_CKVN + alup((size_t)GT * 256 * 2);
constexpr size_t O_Q    = O_KPE  + alup((size_t)GT * 64 * 2);
constexpr size_t O_KV   = O_Q    + alup((size_t)GT * 3072 * 2);
constexpr size_t O_ML_END = O_KV + alup((size_t)GT * 4096 * 2);
constexpr size_t O_FLAG = O_RW_END > O_ML_END ? O_RW_END : O_ML_END;
constexpr size_t WS_NEED = O_FLAG + 256;

struct P {
  const float* x_prompt; const float* x_sample; const float* ln_g; const float* final_g;
  const float* rw_mu; const float* rw_in; const float* rw_w0; const float* rw_w2; const float* rw_a0; const float* rw_a2;
  const float* rw_kk; const float* rw_ka; const float* rw_rk; const float* rw_lnx_g; const float* rw_lnx_b; const float* rw_out;
  const float* ml_in; const float* ml_qn; const float* ml_kvn; const float* ml_uq; const float* ml_ukv; const float* ml_out;
  float* out; char* ws;
};

typedef __attribute__((ext_vector_type(2))) __bf16 bf16x2_t;
typedef __attribute__((ext_vector_type(2))) float f32x2_t;
DEV unsigned cvtpk(float lo, float hi) { f32x2_t v = {lo, hi}; bf16x2_t b = __builtin_convertvector(v, bf16x2_t); return __builtin_bit_cast(unsigned, b); }
DEV float bf2f(u16 x) { return __uint_as_float(((unsigned)x) << 16); }
DEV float bflo(unsigned x) { return __uint_as_float(x << 16); }
DEV float bfhi(unsigned x) { return __uint_as_float(x & 0xffff0000u); }
DEV u16 f2bf(float x) { __bf16 b = (__bf16)x; return __builtin_bit_cast(u16, b); }
DEV float wsum(float v) {
#pragma unroll
  for (int o = 32; o >= 1; o >>= 1) v += __shfl_xor(v, o, 64);
  return v;
}
DEV float siluf(float x) { return x / (1.f + __expf(-x)); }
DEV int crow(int r, int hi) { return (r & 3) + 8 * (r >> 2) + 4 * hi; }
DEV int ltid() { int t = threadIdx.x; asm volatile("" : "+v"(t)); return t; }
template <typename T> DEV T gld(size_t base, unsigned off) { return *(const __attribute__((address_space(1))) T*)(base + off); }
template <typename T> DEV void gst(size_t base, unsigned off, T v) { *(__attribute__((address_space(1))) T*)(base + off) = v; }
DEV void lds_wait() { asm volatile("s_waitcnt lgkmcnt(0)" ::: "memory"); }

DEV void convert_T(const float* __restrict__ src, u16* __restrict__ dst, int K, int N, int Npad, char* lds_) {
  float* lds = (float*)lds_;
  const int tid = ltid(), tk = K / 64, tn = Npad / 64;
  for (int t = blockIdx.x; t < tk * tn; t += gridDim.x) {
    const int k0 = (t % tk) * 64, n0 = (t / tk) * 64;
    __syncthreads();
#pragma unroll
    for (int i = 0; i < 2; ++i) {
      const int kr = (tid >> 4) + i * 32, c = (tid & 15) * 4;
      float4 v = make_float4(0.f, 0.f, 0.f, 0.f);
      if (n0 + c < N) v = *(const float4*)(src + (long)(k0 + kr) * N + n0 + c);
      lds[kr * 65 + c + 0] = v.x; lds[kr * 65 + c + 1] = v.y; lds[kr * 65 + c + 2] = v.z; lds[kr * 65 + c + 3] = v.w;
    }
    __syncthreads();
    const int n = tid >> 3, kc = (tid & 7) * 8;
    u32x4 w;
    w[0] = cvtpk(lds[(kc + 0) * 65 + n], lds[(kc + 1) * 65 + n]);
    w[1] = cvtpk(lds[(kc + 2) * 65 + n], lds[(kc + 3) * 65 + n]);
    w[2] = cvtpk(lds[(kc + 4) * 65 + n], lds[(kc + 5) * 65 + n]);
    w[3] = cvtpk(lds[(kc + 6) * 65 + n], lds[(kc + 7) * 65 + n]);
    *(u32x4*)(dst + (long)(n0 + n) * K + k0 + kc) = w;
  }
}

DEV void init_phase(const P& p, char* lds) {
  for (int j = 0; j < 2; ++j) {
    convert_T(p.rw_in  + (size_t)j * DM * RW_N, (u16*)(p.ws + O_WRWIN)  + (size_t)j * RW_N * DM, DM, RW_N, RW_N, lds);
    convert_T(p.rw_out + (size_t)j * EI * DM,   (u16*)(p.ws + O_WRWOUT) + (size_t)j * DM * EI,   EI, DM, DM, lds);
    convert_T(p.ml_in  + (size_t)j * DM * ML_N, (u16*)(p.ws + O_WMLIN)  + (size_t)j * ML_NP * DM, DM, ML_N, ML_NP, lds);
    convert_T(p.ml_uq  + (size_t)j * 384 * 3072, (u16*)(p.ws + O_WUQ)   + (size_t)j * 3072 * 384, 384, 3072, 3072, lds);
    convert_T(p.ml_ukv + (size_t)j * 256 * 4096, (u16*)(p.ws + O_WUKV)  + (size_t)j * 4096 * 256, 256, 4096, 4096, lds);
    convert_T(p.ml_out + (size_t)j * EI * DM,   (u16*)(p.ws + O_WMLOUT) + (size_t)j * DM * EI,   EI, DM, DM, lds);
  }
  float* ct = (float*)(p.ws + O_COS); float* st = (float*)(p.ws + O_SIN);
  const int tid_ = ltid();
  for (int i = blockIdx.x * 512 + tid_; i < 16384 * 32; i += gridDim.x * 512) {
    const int pos = i >> 5, j = i & 31;
    const float invf = 1.0f / powf(10000.0f, (float)(2 * j) / 64.0f);
    const float ang = (float)pos * invf;
    const double a = (double)ang;
    const double n = rint(a * 0.15915494309189535);
    const float r = (float)(a - n * 6.283185307179586);
    ct[i] = cosf(r); st[i] = sinf(r);
  }
}

DEV void rms_phase(const float* __restrict__ x, const float* __restrict__ g, u16* __restrict__ hout) {
  const int tid_ = ltid(); const int lane = tid_ & 63, wid = __builtin_amdgcn_readfirstlane(tid_ >> 6);
  for (int tok = blockIdx.x * 8 + wid; tok < GT; tok += gridDim.x * 8) {
    const float4* xr = (const float4*)(x + (size_t)tok * DM);
    float4 v[4]; float ss = 0.f;
#pragma unroll
    for (int i = 0; i < 4; ++i) { v[i] = xr[lane + i * 64]; ss += v[i].x * v[i].x + v[i].y * v[i].y + v[i].z * v[i].z + v[i].w * v[i].w; }
    ss = wsum(ss);
    const float sc = rsqrtf(ss * (1.f / DM) + 1e-6f);
#pragma unroll
    for (int i = 0; i < 4; ++i) {
      const float4 gg = ((const float4*)g)[lane + i * 64];
      u32x2 w; w[0] = cvtpk(v[i].x * sc * gg.x, v[i].y * sc * gg.y); w[1] = cvtpk(v[i].z * sc * gg.z, v[i].w * sc * gg.w);
      *(u32x2*)(hout + (size_t)tok * DM + (lane + i * 64) * 4) = w;
    }
  }
}

DEV void final_phase(float* __restrict__ x, const float* __restrict__ g) {
  const int tid_ = ltid(); const int lane = tid_ & 63, wid = __builtin_amdgcn_readfirstlane(tid_ >> 6);
  for (int tok = blockIdx.x * 8 + wid; tok < NTOK; tok += gridDim.x * 8) {
    float4* xr = (float4*)(x + (size_t)tok * DM);
    float4 v[4]; float ss = 0.f;
#pragma unroll
    for (int i = 0; i < 4; ++i) { v[i] = xr[lane + i * 64]; ss += v[i].x * v[i].x + v[i].y * v[i].y + v[i].z * v[i].z + v[i].w * v[i].w; }
    ss = wsum(ss);
    const float sc = rsqrtf(ss * (1.f / DM) + 1e-6f);
#pragma unroll
    for (int i = 0; i < 4; ++i) {
      const float4 gg = ((const float4*)g)[lane + i * 64];
      float4 ov = make_float4(v[i].x * sc * gg.x, v[i].y * sc * gg.y, v[i].z * sc * gg.z, v[i].w * sc * gg.w);
      xr[lane + i * 64] = ov;
    }
  }
}

#define GSWZ(row, c16) ((row) * 128 + ((((c16) ^ ((row) >> 1)) & 7) << 4))
constexpr int LOAD_PLAIN = 0, LOAD_LERP = 1;
constexpr int EPI_RWKV = 0, EPI_RES = 1, EPI_MLAIN = 2, EPI_BF16 = 3;
struct GemmP {
  const u16* A; int lda; const u16* Bt; int K; int NT;
  const float* mu;
  int T;
  u16* o0; u16* o1; u16* o2; u16* o3; u16* o4; u16* o5;
  int ldc;
  float* of; const float* xin; float* xout;
};

template <int LOAD, int EPI>
DEV void gemm_phase(const GemmP& g, char* lds) {
  const int tid = ltid(), wid = tid >> 6, lane = tid & 63, r32 = lane & 31, hi = lane >> 5;
  const int wm = wid >> 1, wn = wid & 1;
  char* sA = lds; char* sB = lds + 65536;
  const int nk = g.K / 64, ntiles = 64 * g.NT;
  const int c16 = tid & 7, rowb = tid >> 3;
  for (int t = blockIdx.x; t < ntiles; t += gridDim.x) {
    const int mt = t & 63, nt = t >> 6, m0 = mt * 256, n0 = nt * 128;
    f32x16 acc[2][2] = {};
    bf16x8 ra[4], rb[2];
    const float* mup = nullptr;
    if constexpr (LOAD == LOAD_LERP) {
      const int s = nt < 16 ? 0 : nt < 32 ? 2 : nt < 48 ? 3 : nt < 64 ? 5 : nt == 64 ? 1 : 4;
      mup = g.mu + s * DM;
    }
    auto gload = [&](int kt) {
      const int k0 = kt * 64 + c16 * 8;
#pragma unroll
      for (int i = 0; i < 4; ++i) {
        const int row = rowb + i * 64; const size_t tok = (size_t)(m0 + row);
        if constexpr (LOAD == LOAD_PLAIN) {
          ra[i] = *(const bf16x8*)(g.A + tok * g.lda + k0);
        } else {
          const int pos = (int)(tok % (size_t)g.T);
          const u32x4 c = *(const u32x4*)(g.A + tok * DM + k0);
          u32x4 pv = {0u, 0u, 0u, 0u}, nx = {0u, 0u, 0u, 0u};
          if (pos > 0) pv = *(const u32x4*)(g.A + (tok - 1) * DM + k0);
          if (pos < g.T - 1) nx = *(const u32x4*)(g.A + (tok + 1) * DM + k0);
          const float4 m0v = *(const float4*)(mup + k0), m1v = *(const float4*)(mup + k0 + 4);
          const float mu[8] = {m0v.x, m0v.y, m0v.z, m0v.w, m1v.x, m1v.y, m1v.z, m1v.w};
          u32x4 o;
#pragma unroll
          for (int e = 0; e < 4; ++e) {
            const float h0 = bflo(c[e]), h1 = bfhi(c[e]);
            const float x0 = 0.5f * (bflo(pv[e]) + bflo(nx[e])) - h0, x1 = 0.5f * (bfhi(pv[e]) + bfhi(nx[e])) - h1;
            o[e] = cvtpk(h0 + mu[2 * e] * x0, h1 + mu[2 * e + 1] * x1);
          }
          ra[i] = *(bf16x8*)&o;
        }
      }
#pragma unroll
      for (int i = 0; i < 2; ++i) {
        const int row = rowb + i * 64;
        rb[i] = *(const bf16x8*)(g.Bt + (size_t)(n0 + row) * g.K + k0);
      }
    };
    auto swrite = [&](int b) {
#pragma unroll
      for (int i = 0; i < 4; ++i) { const int row = rowb + i * 64; *(bf16x8*)(sA + b * 32768 + GSWZ(row, c16)) = ra[i]; }
#pragma unroll
      for (int i = 0; i < 2; ++i) { const int row = rowb + i * 64; *(bf16x8*)(sB + b * 16384 + GSWZ(row, c16)) = rb[i]; }
    };
    gload(0); swrite(0); __syncthreads();
    for (int kt = 0; kt < nk; ++kt) {
      const int b = kt & 1;
      if (kt + 1 < nk) gload(kt + 1);
      const char* a_ = sA + b * 32768; const char* b_ = sB + b * 16384;
#pragma unroll
      for (int ks = 0; ks < 4; ++ks) {
        bf16x8 af[2], bfr[2];
#pragma unroll
        for (int mi = 0; mi < 2; ++mi) { const int row = wm * 64 + mi * 32 + r32; af[mi] = *(const bf16x8*)(a_ + GSWZ(row, ks * 2 + hi)); }
#pragma unroll
        for (int ni = 0; ni < 2; ++ni) { const int row = wn * 64 + ni * 32 + r32; bfr[ni] = *(const bf16x8*)(b_ + GSWZ(row, ks * 2 + hi)); }
#pragma unroll
        for (int mi = 0; mi < 2; ++mi)
#pragma unroll
          for (int ni = 0; ni < 2; ++ni) acc[mi][ni] = __builtin_amdgcn_mfma_f32_32x32x16_bf16(af[mi], bfr[ni], acc[mi][ni], 0, 0, 0);
      }
      if (kt + 1 < nk) swrite(b ^ 1);
      __syncthreads();
    }
#pragma unroll
    for (int mi = 0; mi < 2; ++mi)
#pragma unroll
      for (int ni = 0; ni < 2; ++ni)
#pragma unroll
        for (int r = 0; r < 16; ++r) {
          const size_t m = (size_t)(m0 + wm * 64 + mi * 32 + crow(r, hi));
          const int nl = wn * 64 + ni * 32 + r32, n = n0 + nl;
          const float v = acc[mi][ni][r];
          if constexpr (EPI == EPI_RWKV) {
            if (nt < 64) {
              const int which = nt >> 4, col = (nt & 15) * 128 + nl;
              u16* dst = which == 0 ? g.o0 : which == 1 ? g.o1 : which == 2 ? g.o2 : g.o3;
              dst[m * EI + col] = f2bf(which == 3 ? siluf(v) : v);
            } else if (nt == 64) g.o4[m * 128 + nl] = f2bf(tanhf(v));
            else g.o5[m * 128 + nl] = f2bf(v);
          } else if constexpr (EPI == EPI_RES) {
            g.xout[m * DM + n] = g.xin[m * DM + n] + v;
          } else if constexpr (EPI == EPI_MLAIN) {
            if (n < 704) g.of[m * 704 + n] = v;
            else if (n < ML_N) g.o0[m * EI + (n - 704)] = f2bf(siluf(v));
          } else {
            g.o0[m * g.ldc + n] = f2bf(v);
          }
        }
  }
}

struct ScanP {
  const u16 *r, *k, *v, *twl, *al; u16 *yf, *yb; float* bonus;
  const float *w0, *w2, *a0, *a2, *kk, *ka, *rk;
  int nseq, T;
};
template <int CTRL> DEV float dppf(float x) {
  return __int_as_float(__builtin_amdgcn_update_dpp(0, __float_as_int(x), CTRL, 0xF, 0xF, false));
}
DEV float row_prefix16(float x) {
  x += dppf<0x111>(x); x += dppf<0x112>(x); x += dppf<0x114>(x); x += dppf<0x118>(x); return x;
}
DEV float row_total16(float x) {
  x += dppf<0x128>(x); x += dppf<0x124>(x); x += dppf<0x122>(x); x += dppf<0x121>(x); return x;
}
DEV bf16x8 pack8(float a0, float a1, float a2, float a3, float a4, float a5, float a6, float a7) {
  u32x4 w = {cvtpk(a0, a1), cvtpk(a2, a3), cvtpk(a4, a5), cvtpk(a6, a7)}; return *(bf16x8*)&w;
}
constexpr int SC_BKT = 0, SC_UVT = 5120, SC_AKM = 10240, SC_RR = 10752, SC_ABF = 11776, SC_Z = 12800, SC_PRM = 17152, SC_AW = 18944, SC_AA = 27136, SC_T = 35328, SC_WAVE = 51712;
DEV void scan_phase(const ScanP& s, char* lds_) {
  const int tid = ltid(), wid = __builtin_amdgcn_readfirstlane(tid >> 6), lane = tid & 63, c16 = lane & 15, q = lane >> 4;
  if (wid >= 2) return;
  char* wl = lds_ + wid * SC_WAVE;
  u16* bkt = (u16*)(wl + SC_BKT); u16* uvt = (u16*)(wl + SC_UVT); u16* akm = (u16*)(wl + SC_AKM); u16* rr = (u16*)(wl + SC_RR);
  float* abf = (float*)(wl + SC_ABF); float* zl = (float*)(wl + SC_Z); float* prm = (float*)(wl + SC_PRM); float* p15l = prm + 320;
  const int nchain = s.nseq * 64;
  for (int chain = wid * gridDim.x + blockIdx.x; chain < nchain; chain += 2 * gridDim.x) {
    const int d = chain & 1, h = (chain >> 1) & 31, b = chain >> 6;
    {
      const int ch = h * 64 + lane;
      lds_wait();
      prm[lane] = s.w0[d * EI + ch]; prm[64 + lane] = s.a0[d * EI + ch]; prm[128 + lane] = s.kk[ch]; prm[192 + lane] = s.ka[ch]; prm[256 + lane] = s.rk[ch];
      lds_wait();
    }
    bf16x8* awl = (bf16x8*)(wl + SC_AW); bf16x8* aal = (bf16x8*)(wl + SC_AA);
#pragma unroll
    for (int ks = 0; ks < 2; ++ks)
#pragma unroll
      for (int mt = 0; mt < 4; ++mt) {
        u32x4 pw, pa;
#pragma unroll
        for (int e = 0; e < 4; ++e) {
          const int l0 = ks * 32 + q * 8 + 2 * e;
          const size_t i0 = ((size_t)(d * 64 + l0)) * EI + h * 64 + mt * 16 + c16;
          pw[e] = cvtpk(s.w2[i0], s.w2[i0 + EI]); pa[e] = cvtpk(s.a2[i0], s.a2[i0 + EI]);
        }
        awl[(ks * 4 + mt) * 64 + lane] = *(bf16x8*)&pw; aal[(ks * 4 + mt) * 64 + lane] = *(bf16x8*)&pa;
      }
    lds_wait();
    const unsigned rowi = (unsigned)(d ? 15 - c16 : c16);
    const unsigned off_tw = rowi * 256u + (unsigned)(d * 128 + q * 16);
    const unsigned off_kr = rowi * 4096u + (unsigned)(h * 128 + q * 8);
    const unsigned off_v  = (unsigned)(h * 128 + lane * 2);
    unsigned off_y[4];
#pragma unroll
    for (int r = 0; r < 4; ++r) off_y[r] = (unsigned)(d ? 15 - (4 * q + r) : 4 * q + r) * 4096u + (unsigned)(h * 128 + c16 * 2);
    const unsigned off_b = rowi * 256u + (unsigned)((h * 2 + d) * 4);
    f32x4* Tl = (f32x4*)(wl + SC_T);
#pragma unroll
    for (int m = 0; m < 16; ++m) Tl[m * 64 + lane] = f32x4{0.f, 0.f, 0.f, 0.f};
    u16* yout = d ? s.yb : s.yf;
    const size_t sb = (size_t)b * s.T;
    const int nchunk = s.T / 16;
    for (int cc = 0; cc < nchunk; ++cc) {
      const int c0 = d ? (s.T - 16 - cc * 16) : cc * 16;
      const size_t t0 = sb + c0;
      size_t b_tw = (size_t)s.twl + t0 * 256, b_al = (size_t)s.al + t0 * 256, b_k = (size_t)s.k + t0 * 4096, b_r = (size_t)s.r + t0 * 4096;
      size_t b_v = (size_t)s.v + t0 * 4096, b_y = (size_t)yout + t0 * 4096, b_bon = (size_t)s.bonus + t0 * 256;
      asm volatile("" : "+s"(b_tw), "+s"(b_al), "+s"(b_k), "+s"(b_r), "+s"(b_v), "+s"(b_y), "+s"(b_bon));
      const bf16x8 tw0 = gld<bf16x8>(b_tw, off_tw), tw1 = gld<bf16x8>(b_tw, off_tw + 64);
      const bf16x8 ta0 = gld<bf16x8>(b_al, off_tw), ta1 = gld<bf16x8>(b_al, off_tw + 64);
      float n2 = 0.f;
#pragma unroll
      for (int mt = 0; mt < 4; ++mt) {
        const float4 kkp = *(const float4*)(prm + 128 + mt * 16 + q * 4);
        const u32x2 kr_ = gld<u32x2>(b_k, off_kr + mt * 32);
        const float t0 = bflo(kr_[0]) * kkp.x, t1 = bfhi(kr_[0]) * kkp.y, t2 = bflo(kr_[1]) * kkp.z, t3 = bfhi(kr_[1]) * kkp.w;
        n2 += t0 * t0 + t1 * t1 + t2 * t2 + t3 * t3;
      }
      n2 += __shfl_xor(n2, 16, 64); n2 += __shfl_xor(n2, 32, 64);
      const float invn = 1.f / fmaxf(sqrtf(n2), 1e-12f);
      float bon = 0.f;
      bf16x8 ktf[2], btf[2], kdf[2], rtf[2];
#pragma unroll
      for (int ks = 0; ks < 2; ++ks) {
        float ktl[8], btl[8], kdl[8], rtl[8];
#pragma unroll
        for (int mh = 0; mh < 2; ++mh) {
          const int mt = 2 * ks + mh;
          f32x4 cw = {0.f, 0.f, 0.f, 0.f}, ca = {0.f, 0.f, 0.f, 0.f};
          cw = __builtin_amdgcn_mfma_f32_16x16x32_bf16(awl[(0 * 4 + mt) * 64 + lane], tw0, cw, 0, 0, 0);
          cw = __builtin_amdgcn_mfma_f32_16x16x32_bf16(awl[(1 * 4 + mt) * 64 + lane], tw1, cw, 0, 0, 0);
          ca = __builtin_amdgcn_mfma_f32_16x16x32_bf16(aal[(0 * 4 + mt) * 64 + lane], ta0, ca, 0, 0, 0);
          ca = __builtin_amdgcn_mfma_f32_16x16x32_bf16(aal[(1 * 4 + mt) * 64 + lane], ta1, ca, 0, 0, 0);
          const float4 w0p = *(const float4*)(prm + mt * 16 + q * 4), a0p = *(const float4*)(prm + 64 + mt * 16 + q * 4);
          const float4 kkp = *(const float4*)(prm + 128 + mt * 16 + q * 4), kap = *(const float4*)(prm + 192 + mt * 16 + q * 4), rkp = *(const float4*)(prm + 256 + mt * 16 + q * 4);
          const float w0a[4] = {w0p.x, w0p.y, w0p.z, w0p.w}, a0a[4] = {a0p.x, a0p.y, a0p.z, a0p.w};
          const float kka[4] = {kkp.x, kkp.y, kkp.z, kkp.w}, kaa[4] = {kap.x, kap.y, kap.z, kap.w}, rka[4] = {rkp.x, rkp.y, rkp.z, rkp.w};
          const u32x2 kr_ = gld<u32x2>(b_k, off_kr + mt * 32), rr_ = gld<u32x2>(b_r, off_kr + mt * 32);
          const float kxa[4] = {bflo(kr_[0]), bfhi(kr_[0]), bflo(kr_[1]), bfhi(kr_[1])};
          const float rxa[4] = {bflo(rr_[0]), bfhi(rr_[0]), bflo(rr_[1]), bfhi(rr_[1])};
          float4 p15v;
#pragma unroll
          for (int e = 0; e < 4; ++e) {
            const float wp = cw[e] + w0a[e], ap = ca[e] + a0a[e];
            const float ee = 0.6065306597126334f / (1.f + __expf(-wp));
            const float a = 1.f / (1.f + __expf(-ap));
            const float kkn = kxa[e] * kka[e] * invn;
            const float kd = kxa[e] * (1.f + (a - 1.f) * kaa[e]);
            const float bb = kkn * a;
            bon += rxa[e] * kd * rka[e];
            const float Ei = row_prefix16(ee), Et = row_total16(ee);
            const float pm = __expf(-Ei), pp = __expf(Ei), pm1 = __expf(ee - Ei);
            ktl[mh * 4 + e] = kkn * pm1; btl[mh * 4 + e] = bb * pp; kdl[mh * 4 + e] = kd * pp; rtl[mh * 4 + e] = rxa[e] * pm;
            ((float*)&p15v)[e] = __expf(-Et);
            const int j = mt * 16 + q * 4 + e;
            bkt[j * 40 + c16] = f2bf(btl[mh * 4 + e]); bkt[j * 40 + 16 + c16] = f2bf(kdl[mh * 4 + e]);
          }
          if (c16 == 0) *(float4*)(p15l + mt * 16 + q * 4) = p15v;
          SBAR();
        }
        ktf[ks] = pack8(ktl[0], ktl[1], ktl[2], ktl[3], ktl[4], ktl[5], ktl[6], ktl[7]);
        btf[ks] = pack8(btl[0], btl[1], btl[2], btl[3], btl[4], btl[5], btl[6], btl[7]);
        kdf[ks] = pack8(kdl[0], kdl[1], kdl[2], kdl[3], kdl[4], kdl[5], kdl[6], kdl[7]);
        rtf[ks] = pack8(rtl[0], rtl[1], rtl[2], rtl[3], rtl[4], rtl[5], rtl[6], rtl[7]);
      }
      bon += __shfl_xor(bon, 16, 64); bon += __shfl_xor(bon, 32, 64);
      if (q == 0) gst<float>(b_bon, off_b, bon);
      SBAR();
      {
        u16 vv[16];
#pragma unroll
        for (int ss = 0; ss < 16; ++ss) vv[ss] = gld<u16>(b_v + (size_t)(d ? 15 - ss : ss) * 4096, off_v);
        u32x4 w0v, w1v;
#pragma unroll
        for (int e = 0; e < 4; ++e) { w0v[e] = (unsigned)vv[2 * e] | ((unsigned)vv[2 * e + 1] << 16); w1v[e] = (unsigned)vv[8 + 2 * e] | ((unsigned)vv[8 + 2 * e + 1] << 16); }
        *(u32x4*)(uvt + lane * 40 + 16) = w0v; *(u32x4*)(uvt + lane * 40 + 24) = w1v;
      }
      SBAR();
      {
        f32x4 AB = {0.f, 0.f, 0.f, 0.f}, AK = AB, RB = AB, RK = AB;
#pragma unroll
        for (int ks = 0; ks < 2; ++ks) {
          AB = __builtin_amdgcn_mfma_f32_16x16x32_bf16(ktf[ks], btf[ks], AB, 0, 0, 0);
          AK = __builtin_amdgcn_mfma_f32_16x16x32_bf16(ktf[ks], kdf[ks], AK, 0, 0, 0);
          RB = __builtin_amdgcn_mfma_f32_16x16x32_bf16(rtf[ks], btf[ks], RB, 0, 0, 0);
          RK = __builtin_amdgcn_mfma_f32_16x16x32_bf16(rtf[ks], kdf[ks], RK, 0, 0, 0);
        }
#pragma unroll
        for (int r = 0; r < 4; ++r) {
          const int i = 4 * q + r;
          const bool lo = c16 < i, le = c16 <= i;
          abf[i * 16 + c16] = lo ? AB[r] : 0.f;
          akm[i * 16 + c16] = f2bf(lo ? AK[r] : 0.f);
          rr[i * 32 + c16] = f2bf(le ? RB[r] : 0.f);
          rr[i * 32 + 16 + c16] = f2bf(le ? RK[r] : 0.f);
        }
      }
      bf16x8 Tf[2][4];
#pragma unroll
      for (int ks = 0; ks < 2; ++ks)
#pragma unroll
        for (int nt = 0; nt < 4; ++nt) {
          const f32x4 ta = Tl[((2 * ks) * 4 + nt) * 64 + lane], tb = Tl[((2 * ks + 1) * 4 + nt) * 64 + lane];
          Tf[ks][nt] = pack8(ta[0], ta[1], ta[2], ta[3], tb[0], tb[1], tb[2], tb[3]);
        }
      lds_wait();
      {
        bf16x8 akf = {0, 0, 0, 0, 0, 0, 0, 0};
        if (q < 2) akf = *(const bf16x8*)(akm + c16 * 16 + q * 8);
#pragma unroll
        for (int nt = 0; nt < 4; ++nt) {
          f32x4 z = {0.f, 0.f, 0.f, 0.f};
          z = __builtin_amdgcn_mfma_f32_16x16x32_bf16(ktf[0], Tf[0][nt], z, 0, 0, 0);
          z = __builtin_amdgcn_mfma_f32_16x16x32_bf16(ktf[1], Tf[1][nt], z, 0, 0, 0);
          const bf16x8 vf = *(const bf16x8*)(uvt + (nt * 16 + c16) * 40 + 16 + (q & 1) * 8);
          z = __builtin_amdgcn_mfma_f32_16x16x32_bf16(akf, vf, z, 0, 0, 0);
#pragma unroll
          for (int r = 0; r < 4; ++r) zl[(4 * q + r) * 68 + nt * 16 + c16] = z[r];
        }
      }
      lds_wait();
      SBAR();
      {
        float U[16];
#pragma unroll
        for (int i = 0; i < 16; ++i) {
          float acc = -zl[i * 68 + lane];
#pragma unroll
          for (int s4 = 0; s4 < (i + 3) / 4; ++s4) {
            const float4 a4 = *(const float4*)(abf + i * 16 + s4 * 4);
            if (s4 * 4 + 0 < i) acc -= a4.x * U[s4 * 4 + 0];
            if (s4 * 4 + 1 < i) acc -= a4.y * U[s4 * 4 + 1];
            if (s4 * 4 + 2 < i) acc -= a4.z * U[s4 * 4 + 2];
            if (s4 * 4 + 3 < i) acc -= a4.w * U[s4 * 4 + 3];
          }
          U[i] = acc;
          if ((i & 3) == 3) SBAR();
        }
        *(bf16x8*)(uvt + lane * 40) = pack8(U[0], U[1], U[2], U[3], U[4], U[5], U[6], U[7]);
        *(bf16x8*)(uvt + lane * 40 + 8) = pack8(U[8], U[9], U[10], U[11], U[12], U[13], U[14], U[15]);
      }
      lds_wait();
      SBAR();
      {
        const bf16x8 rrf = *(const bf16x8*)(rr + c16 * 32 + q * 8);
        bf16x8 uvf[4];
#pragma unroll
        for (int nt = 0; nt < 4; ++nt) uvf[nt] = *(const bf16x8*)(uvt + (nt * 16 + c16) * 40 + q * 8);
#pragma unroll
        for (int nt = 0; nt < 4; ++nt) {
          f32x4 y = {0.f, 0.f, 0.f, 0.f};
          y = __builtin_amdgcn_mfma_f32_16x16x32_bf16(rtf[0], Tf[0][nt], y, 0, 0, 0);
          y = __builtin_amdgcn_mfma_f32_16x16x32_bf16(rtf[1], Tf[1][nt], y, 0, 0, 0);
          y = __builtin_amdgcn_mfma_f32_16x16x32_bf16(rrf, uvf[nt], y, 0, 0, 0);
#pragma unroll
          for (int r = 0; r < 4; ++r) gst<u16>(b_y, off_y[r] + nt * 32, f2bf(y[r]));
        }
#pragma unroll
        for (int mt = 0; mt < 4; ++mt) {
          const bf16x8 bkf = *(const bf16x8*)(bkt + (mt * 16 + c16) * 40 + q * 8);
          const float4 pq = *(const float4*)(p15l + mt * 16 + q * 4);
#pragma unroll
          for (int nt = 0; nt < 4; ++nt) {
            f32x4 t = __builtin_amdgcn_mfma_f32_16x16x32_bf16(bkf, uvf[nt], Tl[(mt * 4 + nt) * 64 + lane], 0, 0, 0);
            t[0] *= pq.x; t[1] *= pq.y; t[2] *= pq.z; t[3] *= pq.w;
            Tl[(mt * 4 + nt) * 64 + lane] = t;
          }
        }
      }
      lds_wait();
    }
  }
}

DEV void post_phase(u16* __restrict__ yf, const u16* __restrict__ yb, const u16* __restrict__ v, const u16* __restrict__ sg,
                    const float* __restrict__ bonus, const float* __restrict__ lg, const float* __restrict__ lb) {
  const int tid_ = ltid(); const int lane = tid_ & 63, wid = __builtin_amdgcn_readfirstlane(tid_ >> 6);
  for (int tok = blockIdx.x * 8 + wid; tok < GT; tok += gridDim.x * 8) {
    for (int h = 0; h < 32; ++h) {
      const int ch = h * 64 + lane; const size_t i = (size_t)tok * EI + ch;
      const float y = bf2f(yf[i]) + bf2f(yb[i]);
      const float mean = wsum(y) * (1.f / 64.f);
      const float dd = y - mean;
      const float var = wsum(dd * dd) * (1.f / 64.f);
      const float yn = dd * rsqrtf(var + 64e-5f) * lg[ch] + lb[ch];
      const float bon = bonus[((size_t)tok * 32 + h) * 2] + bonus[((size_t)tok * 32 + h) * 2 + 1];
      yf[i] = f2bf((yn + bon * bf2f(v[i])) * bf2f(sg[i]));
    }
  }
}

DEV void mla_mid_phase(const float* __restrict__ cqkv, const float* __restrict__ qn, const float* __restrict__ kvn,
                       const float* __restrict__ ct, const float* __restrict__ st,
                       u16* __restrict__ cqn, u16* __restrict__ ckvn, u16* __restrict__ kpe, int T) {
  const int tid_ = ltid(); const int lane = tid_ & 63, wid = __builtin_amdgcn_readfirstlane(tid_ >> 6);
  for (int tok = blockIdx.x * 8 + wid; tok < GT; tok += gridDim.x * 8) {
    const float* row = cqkv + (size_t)tok * 704;
    float q[6], ss = 0.f;
#pragma unroll
    for (int i = 0; i < 6; ++i) { q[i] = row[lane + i * 64]; ss += q[i] * q[i]; }
    ss = wsum(ss); float sc = rsqrtf(ss * (1.f / 384.f) + 1e-6f);
#pragma unroll
    for (int i = 0; i < 6; ++i) cqn[(size_t)tok * 384 + lane + i * 64] = f2bf(q[i] * sc * qn[lane + i * 64]);
    float c[4]; ss = 0.f;
#pragma unroll
    for (int i = 0; i < 4; ++i) { c[i] = row[384 + lane + i * 64]; ss += c[i] * c[i]; }
    ss = wsum(ss); sc = rsqrtf(ss * (1.f / 256.f) + 1e-6f);
#pragma unroll
    for (int i = 0; i < 4; ++i) ckvn[(size_t)tok * 256 + lane + i * 64] = f2bf(c[i] * sc * kvn[lane + i * 64]);
    const float x = row[640 + lane];
    const float xo = __shfl_xor(x, 32, 64);
    const int pos = tok % T, j = lane & 31;
    const float cs = ct[pos * 32 + j], sn = st[pos * 32 + j];
    const float o = lane < 32 ? x * cs - xo * sn : x * cs + xo * sn;
    kpe[(size_t)tok * 64 + lane] = f2bf(o);
  }
}

constexpr int SHM_V = 16384, SHM_K = 16384, SHM_KP = 8192;
#define KSWZ(row, colB) ((row) * 256 + ((colB) ^ (((row) & 7) << 4)))
#define KPSWZ(row, colB) ((row) * 128 + ((colB) ^ (((row) & 7) << 4)))
constexpr float ATT_SCALE = 0.07216878364870322f;
DEV void partialSM(f32x16& p0, f32x16& p1, float& m_reg, float& mn, float& alpha) {
  constexpr float C = ATT_SCALE * 1.4426950408889634f;
  float pmax = p0[0];
#pragma unroll
  for (int r = 1; r < 16; ++r) pmax = fmaxf(pmax, p0[r]);
#pragma unroll
  for (int r = 0; r < 16; ++r) pmax = fmaxf(pmax, p1[r]);
  { auto rr = __builtin_amdgcn_permlane32_swap(__float_as_uint(pmax), __float_as_uint(pmax), false, false);
    pmax = fmaxf(__uint_as_float(rr[0]), __uint_as_float(rr[1])); }
  mn = fmaxf(m_reg, pmax); alpha = __builtin_amdgcn_exp2f((m_reg - mn) * C); m_reg = mn;
  const float mnC = -mn * C;
#pragma unroll
  for (int r = 0; r < 16; ++r) p0[r] = __builtin_amdgcn_exp2f(fmaf(p0[r], C, mnC));
#pragma unroll
  for (int r = 0; r < 16; ++r) p1[r] = __builtin_amdgcn_exp2f(fmaf(p1[r], C, mnC));
}
DEV void finishSM(f32x16& p0, f32x16& p1, float alpha, float& l_reg, bf16x8& pa0, bf16x8& pa1, bf16x8& pa2, bf16x8& pa3) {
  float ps = 0;
#pragma unroll
  for (int r = 0; r < 16; ++r) ps += p0[r];
#pragma unroll
  for (int r = 0; r < 16; ++r) ps += p1[r];
  { auto rr = __builtin_amdgcn_permlane32_swap(__float_as_uint(ps), __float_as_uint(ps), false, false);
    ps = __uint_as_float(rr[0]) + __uint_as_float(rr[1]); }
  l_reg = l_reg * alpha + ps;
#define PK4(PP, BASE, OUT) do { unsigned a0 = cvtpk(PP[BASE + 0], PP[BASE + 1]), a1 = cvtpk(PP[BASE + 2], PP[BASE + 3]);   \
    unsigned b0 = cvtpk(PP[BASE + 4], PP[BASE + 5]), b1 = cvtpk(PP[BASE + 6], PP[BASE + 7]);                              \
    auto r0 = __builtin_amdgcn_permlane32_swap(a0, b0, false, false); auto r1 = __builtin_amdgcn_permlane32_swap(a1, b1, false, false); \
    u32x4 w = {r0[0], r1[0], r0[1], r1[1]}; OUT = *reinterpret_cast<bf16x8*>(&w); } while (0)
  PK4(p0, 0, pa0); PK4(p0, 8, pa1); PK4(p1, 0, pa2); PK4(p1, 8, pa3);
#undef PK4
}
DEV int v_st(int k, int c) { const int kk = (k & ~0xC) | ((k & 4) << 1) | ((k & 8) >> 1); return ((kk >> 3) * 4 + (c >> 5)) * 512 + ((kk & 7) * 32 + (c & 31)) * 2; }
DEV int v_rd_base(int lane) { return ((lane & 3) << 3) | (((lane >> 2) & 3) << 6) | (((lane >> 4) & 1) << 5) | (((lane >> 5) & 1) << 8); }
constexpr int v_rd_off(int d0, int ks, int half) { return d0 * 512 + ks * 4096 + half * 2048; }
template <int OFF> DEV s16x4 tr_read(int vb) {
  s16x4 r; asm volatile("ds_read_b64_tr_b16 %0, %1 offset:%2" : "=&v"(r) : "v"(vb), "i"(OFF) : "memory"); return r;
}
template <int D0> DEV void pv_one(f32x16& od, int vb, bf16x8 pa0, bf16x8 pa1, bf16x8 pa2, bf16x8 pa3) {
  const s16x4 l0 = tr_read<v_rd_off(D0, 0, 0)>(vb), h0 = tr_read<v_rd_off(D0, 0, 1)>(vb), l1 = tr_read<v_rd_off(D0, 1, 0)>(vb), h1 = tr_read<v_rd_off(D0, 1, 1)>(vb);
  const s16x4 l2 = tr_read<v_rd_off(D0, 2, 0)>(vb), h2 = tr_read<v_rd_off(D0, 2, 1)>(vb), l3 = tr_read<v_rd_off(D0, 3, 0)>(vb), h3 = tr_read<v_rd_off(D0, 3, 1)>(vb);
  asm volatile("s_waitcnt lgkmcnt(0)" ::: "memory"); SBAR();
#define PK(L, H) (bf16x8){L[0], L[1], L[2], L[3], H[0], H[1], H[2], H[3]}
  od = __builtin_amdgcn_mfma_f32_32x32x16_bf16(pa0, PK(l0, h0), od, 0, 0, 0);
  od = __builtin_amdgcn_mfma_f32_32x32x16_bf16(pa1, PK(l1, h1), od, 0, 0, 0);
  od = __builtin_amdgcn_mfma_f32_32x32x16_bf16(pa2, PK(l2, h2), od, 0, 0, 0);
  od = __builtin_amdgcn_mfma_f32_32x32x16_bf16(pa3, PK(l3, h3), od, 0, 0, 0);
#undef PK
}

struct AttnP { const u16* q; const u16* kv; const u16* kpe; u16* sg; const float* ct; const float* st; int nseq, T; };
DEV void attn_phase(const AttnP& a, char* lds) {
  const int tid = ltid(), wid = tid >> 6, lane = tid & 63, r32 = lane & 31, hi = lane >> 5;
  char* V_lds = lds; char* K_lds = lds + 2 * SHM_V; char* KP_lds = lds + 2 * SHM_V + 2 * SHM_K;
  float* wsc = (float*)(lds + 2 * SHM_V + 2 * SHM_K + 2 * SHM_KP) + wid * 64; float* li_l = wsc; float* al_l = wsc + 32;
  const int nqb = a.T / 256, nitems = a.nseq * 16 * nqb, NT = a.T / 64;
  const int sr = tid >> 4, sc = (tid & 15) * 8, vst0 = v_st(sr, sc), vst1 = v_st(32 + sr, sc);
  const int pr = tid >> 3, pc = (tid & 7) * 8;
  const int vb0 = (int)(uintptr_t)V_lds + v_rd_base(lane);
  int kad[4], kpd[4];
#pragma unroll
  for (int q = 0; q < 4; ++q) { kad[q] = KSWZ(r32, q * 32 + hi * 16); kpd[q] = KPSWZ(r32, q * 32 + hi * 16); }
  for (int it = blockIdx.x; it < nitems; it += gridDim.x) {
    const int qb = it % nqb, h = (it / nqb) & 15, b = it / (nqb * 16);
    const size_t sbase = (size_t)b * a.T;
    const int pos = qb * 256 + wid * 32 + r32;
    bf16x8 qr[12];
    {
      const u16* Qw = a.q + (sbase + pos) * 3072 + h * 192 + hi * 8;
#pragma unroll
      for (int d0 = 0; d0 < 12; ++d0) qr[d0] = *(const bf16x8*)(Qw + d0 * 16);
#pragma unroll
      for (int dd = 0; dd < 2; ++dd) {
        const int j0 = dd * 16 + hi * 8;
        const float4 c0 = *(const float4*)(a.ct + pos * 32 + j0), c1 = *(const float4*)(a.ct + pos * 32 + j0 + 4);
        const float4 s0 = *(const float4*)(a.st + pos * 32 + j0), s1 = *(const float4*)(a.st + pos * 32 + j0 + 4);
        const float cs[8] = {c0.x, c0.y, c0.z, c0.w, c1.x, c1.y, c1.z, c1.w};
        const float sn[8] = {s0.x, s0.y, s0.z, s0.w, s1.x, s1.y, s1.z, s1.w};
        u32x4 x1 = *(u32x4*)&qr[8 + dd], x2 = *(u32x4*)&qr[10 + dd], y1, y2;
#pragma unroll
        for (int e = 0; e < 4; ++e) {
          const float a0 = bflo(x1[e]), a1 = bfhi(x1[e]), b0 = bflo(x2[e]), b1 = bfhi(x2[e]);
          y1[e] = cvtpk(a0 * cs[2 * e] - b0 * sn[2 * e], a1 * cs[2 * e + 1] - b1 * sn[2 * e + 1]);
          y2[e] = cvtpk(b0 * cs[2 * e] + a0 * sn[2 * e], b1 * cs[2 * e + 1] + a1 * sn[2 * e + 1]);
        }
        qr[8 + dd] = *(bf16x8*)&y1; qr[10 + dd] = *(bf16x8*)&y2;
      }
    }
    float m_reg = -1e30f, l_reg = 0.f; f32x16 o[4] = {};
    bf16x8 vs0, vs1, ks0, ks1, kp0;
    const u16* kvh = a.kv + sbase * 4096 + h * 256;
    const u16* kph = a.kpe + sbase * 64;
    const unsigned voff = (unsigned)(sr * 8192 + sc * 2), poff = (unsigned)(pr * 128 + pc * 2);
#define SLOAD(k0) do { const char* bK0 = (const char*)kvh + (size_t)(k0) * 8192; const char* bK1 = bK0 + 32 * 8192; const char* bP = (const char*)kph + (size_t)(k0) * 128; \
    vs0 = *(const bf16x8*)(bK0 + voff + 256); vs1 = *(const bf16x8*)(bK1 + voff + 256); \
    ks0 = *(const bf16x8*)(bK0 + voff); ks1 = *(const bf16x8*)(bK1 + voff); \
    kp0 = *(const bf16x8*)(bP + poff); } while (0)
#define SWRITE(bb) do { *(bf16x8*)(V_lds + (bb) * SHM_V + vst0) = vs0; *(bf16x8*)(V_lds + (bb) * SHM_V + vst1) = vs1; \
    *(bf16x8*)(K_lds + (bb) * SHM_K + KSWZ(sr, sc * 2)) = ks0; *(bf16x8*)(K_lds + (bb) * SHM_K + KSWZ(32 + sr, sc * 2)) = ks1; \
    *(bf16x8*)(KP_lds + (bb) * SHM_KP + KPSWZ(pr, pc * 2)) = kp0; } while (0)
    __syncthreads();
    SLOAD(0); SWRITE(0); __syncthreads();
    for (int j = 0; j < NT; ++j) {
      const int bb = j & 1;
      f32x16 p0 = {}, p1 = {};
      {
        const char* Ks = K_lds + bb * SHM_K; const char* Kp = KP_lds + bb * SHM_KP;
#pragma unroll
        for (int d0 = 0; d0 < 8; ++d0) {
          const bf16x8 b0 = *(const bf16x8*)(Ks + kad[d0 & 3] + (d0 >> 2) * 128), b1 = *(const bf16x8*)(Ks + kad[d0 & 3] + (d0 >> 2) * 128 + 8192);
          p0 = __builtin_amdgcn_mfma_f32_32x32x16_bf16(b0, qr[d0], p0, 0, 0, 0);
          p1 = __builtin_amdgcn_mfma_f32_32x32x16_bf16(b1, qr[d0], p1, 0, 0, 0); }
#pragma unroll
        for (int d0 = 0; d0 < 4; ++d0) {
          const bf16x8 b0 = *(const bf16x8*)(Kp + kpd[d0]), b1 = *(const bf16x8*)(Kp + kpd[d0] + 4096);
          p0 = __builtin_amdgcn_mfma_f32_32x32x16_bf16(b0, qr[8 + d0], p0, 0, 0, 0);
          p1 = __builtin_amdgcn_mfma_f32_32x32x16_bf16(b1, qr[8 + d0], p1, 0, 0, 0); }
      }
      float mn, alpha;
      partialSM(p0, p1, m_reg, mn, alpha);
      if (__any(alpha < 1.f)) {
        if (hi == 0) al_l[r32] = alpha;
        lds_wait();
#pragma unroll
        for (int dd = 0; dd < 4; ++dd)
#pragma unroll
          for (int r = 0; r < 16; ++r) o[dd][r] *= al_l[crow(r, hi)];
      }
      bf16x8 pa0, pa1, pa2, pa3;
      finishSM(p0, p1, alpha, l_reg, pa0, pa1, pa2, pa3); SBAR();
      if (j + 1 < NT) SLOAD((j + 1) * 64);
      SBAR();
      const int vb = vb0 + bb * SHM_V;
      pv_one<0>(o[0], vb, pa0, pa1, pa2, pa3); pv_one<1>(o[1], vb, pa0, pa1, pa2, pa3);
      pv_one<2>(o[2], vb, pa0, pa1, pa2, pa3); pv_one<3>(o[3], vb, pa0, pa1, pa2, pa3);
      if (j + 1 < NT) SWRITE(bb ^ 1);
      __syncthreads();
    }
#undef SLOAD
#undef SWRITE
    {
      int t2 = threadIdx.x; asm volatile("" : "+v"(t2));
      const int wid2 = t2 >> 6, r2 = t2 & 31, hi2 = (t2 >> 5) & 1;
      float* li2 = (float*)(lds + 2 * SHM_V + 2 * SHM_K + 2 * SHM_KP) + wid2 * 64;
      if (hi2 == 0) li2[r2] = l_reg;
      lds_wait();
      u16* Ow = a.sg + (sbase + qb * 256 + wid2 * 32) * EI + h * 128 + r2;
#pragma unroll
      for (int r = 0; r < 16; ++r) {
        const int orow = crow(r, hi2);
        const float rl = __builtin_amdgcn_rcpf(li2[orow]);
#pragma unroll
        for (int d0 = 0; d0 < 4; ++d0) {
          u16* pp = Ow + (size_t)orow * EI + d0 * 32;
          *pp = f2bf(o[d0][r] * rl * bf2f(*pp));
        }
      }
    }
  }
}

struct Grp { const float* xin0; float* xres; int nseq, T; };
DEV Grp get_group(const P& p, int g) {
  Grp r;
  r.xin0 = g == 0 ? p.x_prompt : p.x_sample + (size_t)(g - 1) * GT * DM;
  r.xres = p.out + (size_t)g * GT * DM;
  r.nseq = g == 0 ? 8 : 1; r.T = g == 0 ? 2048 : 16384;
  return r;
}
template <int LT, int ph>
DEV void run_phase(const P& p, int g, int layer, char* lds) {
  const Grp G = get_group(p, g);
  const int j = layer >> 1;
  const float* xin = layer == 0 ? G.xin0 : G.xres;
  size_t zoff = 0; asm volatile("" : "+s"(zoff));
  char* ws = p.ws + zoff;
  u16* hbuf = (u16*)(ws + O_HBUF);
  u16* sg = (u16*)(ws + O_SG);
  if constexpr (LT == 0) {
    u16 *rb = (u16*)(ws + O_RB), *kb = (u16*)(ws + O_KB), *vb = (u16*)(ws + O_VB), *yf = (u16*)(ws + O_YF), *yb = (u16*)(ws + O_YB);
    u16 *twl = (u16*)(ws + O_TWL), *al = (u16*)(ws + O_AL); float* bon = (float*)(ws + O_BON);
    if constexpr (ph == 0) rms_phase(xin, p.ln_g + layer * DM, hbuf);
    else if constexpr (ph == 1) {
      GemmP q{}; q.A = hbuf; q.lda = DM; q.Bt = (const u16*)(ws + O_WRWIN) + (size_t)j * RW_N * DM; q.K = DM; q.NT = 66;
      q.mu = p.rw_mu + (size_t)j * 6 * DM; q.T = G.T; q.o0 = rb; q.o1 = kb; q.o2 = vb; q.o3 = sg; q.o4 = twl; q.o5 = al;
      gemm_phase<LOAD_LERP, EPI_RWKV>(q, lds);
    } else if constexpr (ph == 2) {
      ScanP s{}; s.r = rb; s.k = kb; s.v = vb; s.twl = twl; s.al = al; s.yf = yf; s.yb = yb; s.bonus = bon;
      s.w0 = p.rw_w0 + (size_t)j * 2 * EI; s.w2 = p.rw_w2 + (size_t)j * 2 * 64 * EI; s.a0 = p.rw_a0 + (size_t)j * 2 * EI; s.a2 = p.rw_a2 + (size_t)j * 2 * 64 * EI;
      s.kk = p.rw_kk + (size_t)j * EI; s.ka = p.rw_ka + (size_t)j * EI; s.rk = p.rw_rk + (size_t)j * EI; s.nseq = G.nseq; s.T = G.T;
      scan_phase(s, lds);
    } else if constexpr (ph == 3) post_phase(yf, yb, vb, sg, bon, p.rw_lnx_g + (size_t)j * EI, p.rw_lnx_b + (size_t)j * EI);
    else {
      GemmP q{}; q.A = yf; q.lda = EI; q.Bt = (const u16*)(ws + O_WRWOUT) + (size_t)j * DM * EI; q.K = EI; q.NT = 8; q.xin = xin; q.xout = G.xres;
      gemm_phase<LOAD_PLAIN, EPI_RES>(q, lds);
    }
  } else {
    float* cqkv = (float*)(ws + O_CQKV); u16 *cqn = (u16*)(ws + O_CQN), *ckvn = (u16*)(ws + O_CKVN), *kpe = (u16*)(ws + O_KPE), *qq = (u16*)(ws + O_Q), *kv = (u16*)(ws + O_KV);
    const float* ct = (const float*)(ws + O_COS); const float* st = (const float*)(ws + O_SIN);
    if constexpr (ph == 0) rms_phase(xin, p.ln_g + layer * DM, hbuf);
    else if constexpr (ph == 1) {
      GemmP q{}; q.A = hbuf; q.lda = DM; q.Bt = (const u16*)(ws + O_WMLIN) + (size_t)j * ML_NP * DM; q.K = DM; q.NT = 22; q.of = cqkv; q.o0 = sg;
      gemm_phase<LOAD_PLAIN, EPI_MLAIN>(q, lds);
    } else if constexpr (ph == 2) mla_mid_phase(cqkv, p.ml_qn + j * 384, p.ml_kvn + j * 256, ct, st, cqn, ckvn, kpe, G.T);
    else if constexpr (ph == 3) {
      GemmP q{}; q.A = cqn; q.lda = 384; q.Bt = (const u16*)(ws + O_WUQ) + (size_t)j * 3072 * 384; q.K = 384; q.NT = 24; q.o0 = qq; q.ldc = 3072;
      gemm_phase<LOAD_PLAIN, EPI_BF16>(q, lds);
      GemmP r{}; r.A = ckvn; r.lda = 256; r.Bt = (const u16*)(ws + O_WUKV) + (size_t)j * 4096 * 256; r.K = 256; r.NT = 32; r.o0 = kv; r.ldc = 4096;
      gemm_phase<LOAD_PLAIN, EPI_BF16>(r, lds);
    } else if constexpr (ph == 4) {
      AttnP a{}; a.q = qq; a.kv = kv; a.kpe = kpe; a.sg = sg; a.ct = ct; a.st = st; a.nseq = G.nseq; a.T = G.T;
      attn_phase(a, lds);
    } else {
      GemmP q{}; q.A = sg; q.lda = EI; q.Bt = (const u16*)(ws + O_WMLOUT) + (size_t)j * DM * EI; q.K = EI; q.NT = 8; q.xin = xin; q.xout = G.xres;
      gemm_phase<LOAD_PLAIN, EPI_RES>(q, lds);
    }
  }
}


template <int LT, int PH>
__global__ __launch_bounds__(512) void k_phase(P p, int g, int layer) {
  extern __shared__ __attribute__((aligned(16))) char lds[];
  if constexpr (LT == 2) { if constexpr (PH == 0) init_phase(p, lds); else final_phase(p.out, p.final_g); }
  else run_phase<LT, PH>(p, g, layer, lds);
}

#if MEGA
__global__ __launch_bounds__(512) void k_mega(P p) {
  extern __shared__ __attribute__((aligned(16))) char lds[];
  cg::grid_group grid = cg::this_grid();
  init_phase(p, lds);
  grid.sync();
  for (int g = 0; g < 3; ++g)
    for (int layer = 0; layer < 4; ++layer) {
      if ((layer & 1) == 0) {
        run_phase<0, 0>(p, g, layer, lds); grid.sync(); run_phase<0, 1>(p, g, layer, lds); grid.sync(); run_phase<0, 2>(p, g, layer, lds); grid.sync();
        run_phase<0, 3>(p, g, layer, lds); grid.sync(); run_phase<0, 4>(p, g, layer, lds); grid.sync();
      } else {
        run_phase<1, 0>(p, g, layer, lds); grid.sync(); run_phase<1, 1>(p, g, layer, lds); grid.sync(); run_phase<1, 2>(p, g, layer, lds); grid.sync();
        run_phase<1, 3>(p, g, layer, lds); grid.sync(); run_phase<1, 4>(p, g, layer, lds); grid.sync(); run_phase<1, 5>(p, g, layer, lds); grid.sync();
      }
    }
  final_phase(p.out, p.final_g);
}
#endif

extern "C" void kernel_launch(void* const* d_in, const int* in_sizes, int n_in, void* d_out, int out_size, void* d_ws, size_t ws_size, hipStream_t stream) {
  if (n_in != 22 || ws_size < WS_NEED) { fprintf(stderr, "kernel_launch: bad args n_in %d ws %zu need %zu\n", n_in, ws_size, WS_NEED); return; }
  P p{};
  const float** f = (const float**)&p;
  for (int i = 0; i < 22; ++i) f[i] = (const float*)d_in[i];
  p.out = (float*)d_out; p.ws = (char*)d_ws;
#if MEGA
  static int grid_blocks = 0;
  if (!grid_blocks) {
    hipFuncSetAttribute((const void*)k_mega, hipFuncAttributeMaxDynamicSharedMemorySize, SHM_BYTES);
    int dev = 0, cus = 0, per_cu = 0;
    hipGetDevice(&dev);
    hipDeviceGetAttribute(&cus, hipDeviceAttributeMultiprocessorCount, dev);
    hipOccupancyMaxActiveBlocksPerMultiprocessor(&per_cu, k_mega, 512, SHM_BYTES);
    if (per_cu > 1) per_cu = 1;
    grid_blocks = cus * per_cu;
  }
  void* args[] = {&p};
  hipError_t e = hipLaunchCooperativeKernel((void*)k_mega, dim3(grid_blocks), dim3(512), args, SHM_BYTES, stream);
  if (e != hipSuccess) fprintf(stderr, "cooperative launch failed: %s (grid %d)\n", hipGetErrorString(e), grid_blocks);
#else
  const int NB = 256;
#define LAUNCH(LT, PH, g, layer) do { static int inited = 0; if (!inited) { hipFuncSetAttribute((const void*)k_phase<LT, PH>, hipFuncAttributeMaxDynamicSharedMemorySize, SHM_BYTES); inited = 1; } \
    hipLaunchKernelGGL((k_phase<LT, PH>), dim3(NB), dim3(512), SHM_BYTES, stream, p, g, layer); } while (0)
  LAUNCH(2, 0, 0, 0);
  for (int g = 0; g < 3; ++g)
    for (int layer = 0; layer < 4; ++layer) {
      if ((layer & 1) == 0) { LAUNCH(0, 0, g, layer); LAUNCH(0, 1, g, layer); LAUNCH(0, 2, g, layer); LAUNCH(0, 3, g, layer); LAUNCH(0, 4, g, layer); }
      else { LAUNCH(1, 0, g, layer); LAUNCH(1, 1, g, layer); LAUNCH(1, 2, g, layer); LAUNCH(1, 3, g, layer); LAUNCH(1, 4, g, layer); LAUNCH(1, 5, g, layer); }
    }
  LAUNCH(2, 1, 0, 0);
#endif
}
```

```cpp
#include <hip/hip_runtime.h>
#include <hip/hip_bf16.h>
#include <hip/hip_cooperative_groups.h>
#include <cstdio>
namespace cg = cooperative_groups;

#ifndef REP_GEMM
#define REP_GEMM 1
#endif
#ifndef REP_ATTN
#define REP_ATTN 1
#endif
#ifndef REP_SCAN
#define REP_SCAN 1
#endif
#ifndef MEGA
#define MEGA 1
#endif

typedef unsigned short u16;
using bf16x8 = __attribute__((ext_vector_type(8))) short;
using s16x4  = __attribute__((ext_vector_type(4))) short;
using f32x16 = __attribute__((ext_vector_type(16))) float;
using f32x4  = __attribute__((ext_vector_type(4))) float;
using u32x4  = __attribute__((ext_vector_type(4))) unsigned;
using u32x2  = __attribute__((ext_vector_type(2))) unsigned;
#define DEV __device__ __forceinline__
#define SBAR() __builtin_amdgcn_sched_barrier(0)

constexpr int DM = 1024, EI = 2048, GT = 16384;
constexpr int NTOK = 49152;
constexpr int RW_N = 8448, ML_N = 2752, ML_NP = 2816;
constexpr int SHM_BYTES = 122880;

constexpr size_t alup(size_t x) { return (x + 255) / 256 * 256; }
constexpr size_t O_WRWIN  = 0;
constexpr size_t O_WRWOUT = O_WRWIN  + alup((size_t)2 * RW_N * DM * 2);
constexpr size_t O_WMLIN  = O_WRWOUT + alup((size_t)2 * DM * EI * 2);
constexpr size_t O_WUQ    = O_WMLIN  + alup((size_t)2 * ML_NP * DM * 2);
constexpr size_t O_WUKV   = O_WUQ    + alup((size_t)2 * 3072 * 384 * 2);
constexpr size_t O_WMLOUT = O_WUKV   + alup((size_t)2 * 4096 * 256 * 2);
constexpr size_t O_COS    = O_WMLOUT + alup((size_t)2 * DM * EI * 2);
constexpr size_t O_SIN    = O_COS    + alup((size_t)16384 * 32 * 4);
constexpr size_t O_HBUF   = O_SIN    + alup((size_t)16384 * 32 * 4);
constexpr size_t O_R0     = O_HBUF   + alup((size_t)GT * DM * 2);
constexpr size_t SZ_E = (size_t)GT * EI * 2;
constexpr size_t O_SG   = O_R0;
constexpr size_t O_RB   = O_SG + SZ_E;
constexpr size_t O_KB   = O_RB + SZ_E;
constexpr size_t O_VB   = O_KB + SZ_E;
constexpr size_t O_YF   = O_VB + SZ_E;
constexpr size_t O_YB   = O_YF + SZ_E;
constexpr size_t O_TWL  = O_YB + SZ_E;
constexpr size_t O_AL   = O_TWL + alup((size_t)GT * 128 * 2);
constexpr size_t O_BON  = O_AL  + alup((size_t)GT * 128 * 2);
constexpr size_t O_RW_END = O_BON + alup((size_t)GT * 64 * 4);
constexpr size_t O_CQKV = O_SG + SZ_E;
constexpr size_t O_CQN  = O_CQKV + alup((size_t)GT * 704 * 4);
constexpr size_t O_CKVN = O_CQN  + alup((size_t)GT * 384 * 2);
constexpr size_t O_KPE  = O_CKVN + alup((size_t)GT * 256 * 2);
constexpr size_t O_Q    = O_KPE  + alup((size_t)GT * 64 * 2);
constexpr size_t O_KV   = O_Q    + alup((size_t)GT * 3072 * 2);
constexpr size_t O_ML_END = O_KV + alup((size_t)GT * 4096 * 2);
constexpr size_t O_FLAG = O_RW_END > O_ML_END ? O_RW_END : O_ML_END;
constexpr size_t WS_NEED = O_FLAG + 256;

struct P {
  const float* x_prompt; const float* x_sample; const float* ln_g; const float* final_g;
  const float* rw_mu; const float* rw_in; const float* rw_w0; const float* rw_w2; const float* rw_a0; const float* rw_a2;
  const float* rw_kk; const float* rw_ka; const float* rw_rk; const float* rw_lnx_g; const float* rw_lnx_b; const float* rw_out;
  const float* ml_in; const float* ml_qn; const float* ml_kvn; const float* ml_uq; const float* ml_ukv; const float* ml_out;
  float* out; char* ws;
};

typedef __attribute__((ext_vector_type(2))) __bf16 bf16x2_t;
typedef __attribute__((ext_vector_type(2))) float f32x2_t;
DEV unsigned cvtpk(float lo, float hi) { f32x2_t v = {lo, hi}; bf16x2_t b = __builtin_convertvector(v, bf16x2_t); return __builtin_bit_cast(unsigned, b); }
DEV float bf2f(u16 x) { return __uint_as_float(((unsigned)x) << 16); }
DEV float bflo(unsigned x) { return __uint_as_float(x << 16); }
DEV float bfhi(unsigned x) { return __uint_as_float(x & 0xffff0000u); }
DEV u16 f2bf(float x) { __bf16 b = (__bf16)x; return __builtin_bit_cast(u16, b); }
DEV float wsum(float v) {
#pragma unroll
  for (int o = 32; o >= 1; o >>= 1) v += __shfl_xor(v, o, 64);
  return v;
}
DEV float siluf(float x) { return x / (1.f + __expf(-x)); }
DEV int crow(int r, int hi) { return (r & 3) + 8 * (r >> 2) + 4 * hi; }
DEV int ltid() { int t = threadIdx.x; asm volatile("" : "+v"(t)); return t; }
template <typename T> DEV T gld(size_t base, unsigned off) { return *(const __attribute__((address_space(1))) T*)(base + off); }
template <typename T> DEV void gst(size_t base, unsigned off, T v) { *(__attribute__((address_space(1))) T*)(base + off) = v; }
DEV void lds_wait() { asm volatile("s_waitcnt lgkmcnt(0)" ::: "memory"); }

DEV void convert_T(const float* __restrict__ src, u16* __restrict__ dst, int K, int N, int Npad, char* lds_) {
  float* lds = (float*)lds_;
  const int tid = ltid(), tk = K / 64, tn = Npad / 64;
  for (int t = blockIdx.x; t < tk * tn; t += gridDim.x) {
    const int k0 = (t % tk) * 64, n0 = (t / tk) * 64;
    __syncthreads();
#pragma unroll
    for (int i = 0; i < 2; ++i) {
      const int kr = (tid >> 4) + i * 32, c = (tid & 15) * 4;
      float4 v = make_float4(0.f, 0.f, 0.f, 0.f);
      if (n0 + c < N) v = *(const float4*)(src + (long)(k0 + kr) * N + n0 + c);
      lds[kr * 65 + c + 0] = v.x; lds[kr * 65 + c + 1] = v.y; lds[kr * 65 + c + 2] = v.z; lds[kr * 65 + c + 3] = v.w;
    }
    __syncthreads();
    const int n = tid >> 3, kc = (tid & 7) * 8;
    u32x4 w;
    w[0] = cvtpk(lds[(kc + 0) * 65 + n], lds[(kc + 1) * 65 + n]);
    w[1] = cvtpk(lds[(kc + 2) * 65 + n], lds[(kc + 3) * 65 + n]);
    w[2] = cvtpk(lds[(kc + 4) * 65 + n], lds[(kc + 5) * 65 + n]);
    w[3] = cvtpk(lds[(kc + 6) * 65 + n], lds[(kc + 7) * 65 + n]);
    *(u32x4*)(dst + (long)(n0 + n) * K + k0 + kc) = w;
  }
}

DEV void init_phase(const P& p, char* lds) {
  for (int j = 0; j < 2; ++j) {
    convert_T(p.rw_in  + (size_t)j * DM * RW_N, (u16*)(p.ws + O_WRWIN)  + (size_t)j * RW_N * DM, DM, RW_N, RW_N, lds);
    convert_T(p.rw_out + (size_t)j * EI * DM,   (u16*)(p.ws + O_WRWOUT) + (size_t)j * DM * EI,   EI, DM, DM, lds);
    convert_T(p.ml_in  + (size_t)j * DM * ML_N, (u16*)(p.ws + O_WMLIN)  + (size_t)j * ML_NP * DM, DM, ML_N, ML_NP, lds);
    convert_T(p.ml_uq  + (size_t)j * 384 * 3072, (u16*)(p.ws + O_WUQ)   + (size_t)j * 3072 * 384, 384, 3072, 3072, lds);
    convert_T(p.ml_ukv + (size_t)j * 256 * 4096, (u16*)(p.ws + O_WUKV)  + (size_t)j * 4096 * 256, 256, 4096, 4096, lds);
    convert_T(p.ml_out + (size_t)j * EI * DM,   (u16*)(p.ws + O_WMLOUT) + (size_t)j * DM * EI,   EI, DM, DM, lds);
  }
  float* ct = (float*)(p.ws + O_COS); float* st = (float*)(p.ws + O_SIN);
  const int tid_ = ltid();
  for (int i = blockIdx.x * 512 + tid_; i < 16384 * 32; i += gridDim.x * 512) {
    const int pos = i >> 5, j = i & 31;
    const float invf = 1.0f / powf(10000.0f, (float)(2 * j) / 64.0f);
    const float ang = (float)pos * invf;
    const double a = (double)ang;
    const double n = rint(a * 0.15915494309189535);
    const float r = (float)(a - n * 6.283185307179586);
    ct[i] = cosf(r); st[i] = sinf(r);
  }
}

DEV void rms_phase(const float* __restrict__ x, const float* __restrict__ g, u16* __restrict__ hout) {
  const int tid_ = ltid(); const int lane = tid_ & 63, wid = __builtin_amdgcn_readfirstlane(tid_ >> 6);
  for (int tok = blockIdx.x * 8 + wid; tok < GT; tok += gridDim.x * 8) {
    const float4* xr = (const float4*)(x + (size_t)tok * DM);
    float4 v[4]; float ss = 0.f;
#pragma unroll
    for (int i = 0; i < 4; ++i) { v[i] = xr[lane + i * 64]; ss += v[i].x * v[i].x + v[i].y * v[i].y + v[i].z * v[i].z + v[i].w * v[i].w; }
    ss = wsum(ss);
    const float sc = rsqrtf(ss * (1.f / DM) + 1e-6f);
#pragma unroll
    for (int i = 0; i < 4; ++i) {
      const float4 gg = ((const float4*)g)[lane + i * 64];
      u32x2 w; w[0] = cvtpk(v[i].x * sc * gg.x, v[i].y * sc * gg.y); w[1] = cvtpk(v[i].z * sc * gg.z, v[i].w * sc * gg.w);
      *(u32x2*)(hout + (size_t)tok * DM + (lane + i * 64) * 4) = w;
    }
  }
}

DEV void final_phase(float* __restrict__ x, const float* __restrict__ g) {
  const int tid_ = ltid(); const int lane = tid_ & 63, wid = __builtin_amdgcn_readfirstlane(tid_ >> 6);
  for (int tok = blockIdx.x * 8 + wid; tok < NTOK; tok += gridDim.x * 8) {
    float4* xr = (float4*)(x + (size_t)tok * DM);
    float4 v[4]; float ss = 0.f;
#pragma unroll
    for (int i = 0; i < 4; ++i) { v[i] = xr[lane + i * 64]; ss += v[i].x * v[i].x + v[i].y * v[i].y + v[i].z * v[i].z + v[i].w * v[i].w; }
    ss = wsum(ss);
    const float sc = rsqrtf(ss * (1.f / DM) + 1e-6f);
#pragma unroll
    for (int i = 0; i < 4; ++i) {
      const float4 gg = ((const float4*)g)[lane + i * 64];
      float4 ov = make_float4(v[i].x * sc * gg.x, v[i].y * sc * gg.y, v[i].z * sc * gg.z, v[i].w * sc * gg.w);
      xr[lane + i * 64] = ov;
    }
  }
}

#define GSWZ(row, c16) ((row) * 128 + ((((c16) ^ ((row) >> 1)) & 7) << 4))
constexpr int LOAD_PLAIN = 0, LOAD_LERP = 1;
constexpr int EPI_RWKV = 0, EPI_RES = 1, EPI_MLAIN = 2, EPI_BF16 = 3;
struct GemmP {
  const u16* A; int lda; const u16* Bt; int K; int NT;
  const float* mu;
  int T;
  u16* o0; u16* o1; u16* o2; u16* o3; u16* o4; u16* o5;
  int ldc;
  float* of; const float* xin; float* xout; int dry;
};

template <int LOAD, int EPI>
DEV void gemm_phase(const GemmP& g, char* lds) {
  const int tid = ltid(), wid = tid >> 6, lane = tid & 63, r32 = lane & 31, hi = lane >> 5;
  const int wm = wid >> 1, wn = wid & 1;
  char* sA = lds; char* sB = lds + 65536;
  const int nk = g.K / 64, ntiles = 64 * g.NT;
  const int c16 = tid & 7, rowb = tid >> 3;
  for (int t = blockIdx.x; t < ntiles; t += gridDim.x) {
    const int mt = t & 63, nt = t >> 6, m0 = mt * 256, n0 = nt * 128;
    f32x16 acc[2][2] = {};
    bf16x8 ra[4], rb[2];
    const float* mup = nullptr;
    if constexpr (LOAD == LOAD_LERP) {
      const int s = nt < 16 ? 0 : nt < 32 ? 2 : nt < 48 ? 3 : nt < 64 ? 5 : nt == 64 ? 1 : 4;
      mup = g.mu + s * DM;
    }
    auto gload = [&](int kt) {
      const int k0 = kt * 64 + c16 * 8;
#pragma unroll
      for (int i = 0; i < 4; ++i) {
        const int row = rowb + i * 64; const size_t tok = (size_t)(m0 + row);
        if constexpr (LOAD == LOAD_PLAIN) {
          ra[i] = *(const bf16x8*)(g.A + tok * g.lda + k0);
        } else {
          const int pos = (int)(tok % (size_t)g.T);
          const u32x4 c = *(const u32x4*)(g.A + tok * DM + k0);
          u32x4 pv = {0u, 0u, 0u, 0u}, nx = {0u, 0u, 0u, 0u};
          if (pos > 0) pv = *(const u32x4*)(g.A + (tok - 1) * DM + k0);
          if (pos < g.T - 1) nx = *(const u32x4*)(g.A + (tok + 1) * DM + k0);
          const float4 m0v = *(const float4*)(mup + k0), m1v = *(const float4*)(mup + k0 + 4);
          const float mu[8] = {m0v.x, m0v.y, m0v.z, m0v.w, m1v.x, m1v.y, m1v.z, m1v.w};
          u32x4 o;
#pragma unroll
          for (int e = 0; e < 4; ++e) {
            const float h0 = bflo(c[e]), h1 = bfhi(c[e]);
            const float x0 = 0.5f * (bflo(pv[e]) + bflo(nx[e])) - h0, x1 = 0.5f * (bfhi(pv[e]) + bfhi(nx[e])) - h1;
            o[e] = cvtpk(h0 + mu[2 * e] * x0, h1 + mu[2 * e + 1] * x1);
          }
          ra[i] = *(bf16x8*)&o;
        }
      }
#pragma unroll
      for (int i = 0; i < 2; ++i) {
        const int row = rowb + i * 64;
        rb[i] = *(const bf16x8*)(g.Bt + (size_t)(n0 + row) * g.K + k0);
      }
    };
    auto swrite = [&](int b) {
#pragma unroll
      for (int i = 0; i < 4; ++i) { const int row = rowb + i * 64; *(bf16x8*)(sA + b * 32768 + GSWZ(row, c16)) = ra[i]; }
#pragma unroll
      for (int i = 0; i < 2; ++i) { const int row = rowb + i * 64; *(bf16x8*)(sB + b * 16384 + GSWZ(row, c16)) = rb[i]; }
    };
    gload(0); swrite(0); __syncthreads();
    for (int kt = 0; kt < nk; ++kt) {
      const int b = kt & 1;
      if (kt + 1 < nk) gload(kt + 1);
      const char* a_ = sA + b * 32768; const char* b_ = sB + b * 16384;
#pragma unroll
      for (int ks = 0; ks < 4; ++ks) {
        bf16x8 af[2], bfr[2];
#pragma unroll
        for (int mi = 0; mi < 2; ++mi) { const int row = wm * 64 + mi * 32 + r32; af[mi] = *(const bf16x8*)(a_ + GSWZ(row, ks * 2 + hi)); }
#pragma unroll
        for (int ni = 0; ni < 2; ++ni) { const int row = wn * 64 + ni * 32 + r32; bfr[ni] = *(const bf16x8*)(b_ + GSWZ(row, ks * 2 + hi)); }
#pragma unroll
        for (int mi = 0; mi < 2; ++mi)
#pragma unroll
          for (int ni = 0; ni < 2; ++ni) acc[mi][ni] = __builtin_amdgcn_mfma_f32_32x32x16_bf16(af[mi], bfr[ni], acc[mi][ni], 0, 0, 0);
      }
      if (kt + 1 < nk) swrite(b ^ 1);
      __syncthreads();
    }
    if (!g.dry)
#pragma unroll
    for (int mi = 0; mi < 2; ++mi)
#pragma unroll
      for (int ni = 0; ni < 2; ++ni)
#pragma unroll
        for (int r = 0; r < 16; ++r) {
          const size_t m = (size_t)(m0 + wm * 64 + mi * 32 + crow(r, hi));
          const int nl = wn * 64 + ni * 32 + r32, n = n0 + nl;
          const float v = acc[mi][ni][r];
          if constexpr (EPI == EPI_RWKV) {
            if (nt < 64) {
              const int which = nt >> 4, col = (nt & 15) * 128 + nl;
              u16* dst = which == 0 ? g.o0 : which == 1 ? g.o1 : which == 2 ? g.o2 : g.o3;
              dst[m * EI + col] = f2bf(which == 3 ? siluf(v) : v);
            } else if (nt == 64) g.o4[m * 128 + nl] = f2bf(tanhf(v));
            else g.o5[m * 128 + nl] = f2bf(v);
          } else if constexpr (EPI == EPI_RES) {
            g.xout[m * DM + n] = g.xin[m * DM + n] + v;
          } else if constexpr (EPI == EPI_MLAIN) {
            if (n < 704) g.of[m * 704 + n] = v;
            else if (n < ML_N) g.o0[m * EI + (n - 704)] = f2bf(siluf(v));
          } else {
            g.o0[m * g.ldc + n] = f2bf(v);
          }
        }
  }
}

struct ScanP {
  const u16 *r, *k, *v, *twl, *al; u16 *yf, *yb; float* bonus;
  const float *w0, *w2, *a0, *a2, *kk, *ka, *rk;
  int nseq, T;
  float* tbuf; int nseg;
};
template <int CTRL> DEV float dppf(float x) {
  return __int_as_float(__builtin_amdgcn_update_dpp(0, __float_as_int(x), CTRL, 0xF, 0xF, false));
}
DEV float row_prefix16(float x) {
  x += dppf<0x111>(x); x += dppf<0x112>(x); x += dppf<0x114>(x); x += dppf<0x118>(x); return x;
}
DEV float row_total16(float x) {
  x += dppf<0x128>(x); x += dppf<0x124>(x); x += dppf<0x122>(x); x += dppf<0x121>(x); return x;
}
DEV bf16x8 pack8(float a0, float a1, float a2, float a3, float a4, float a5, float a6, float a7) {
  u32x4 w = {cvtpk(a0, a1), cvtpk(a2, a3), cvtpk(a4, a5), cvtpk(a6, a7)}; return *(bf16x8*)&w;
}
constexpr int SC_BKT = 0, SC_UVT = 5120, SC_AKM = 10240, SC_RR = 10752, SC_ABF = 11776, SC_Z = 12800, SC_PRM = 17152, SC_AW = 18944, SC_AA = 27136, SC_T = 35328, SC_PRE = 51712, SC_KR = 55808, SC_WAVE = 59904;
DEV void scan_phase(const ScanP& s, char* lds_, const int pass) {
  const int tid = ltid(), wid = __builtin_amdgcn_readfirstlane(tid >> 6), lane = tid & 63, c16 = lane & 15, q = lane >> 4;
  if (wid >= 2) return;
  char* wl = lds_ + wid * SC_WAVE;
  u16* bkt = (u16*)(wl + SC_BKT); u16* uvt = (u16*)(wl + SC_UVT); u16* akm = (u16*)(wl + SC_AKM); u16* rr = (u16*)(wl + SC_RR);
  float* abf = (float*)(wl + SC_ABF); float* zl = (float*)(wl + SC_Z); float* prm = (float*)(wl + SC_PRM); float* p15l = prm + 320;
  const int nchain = s.nseq * 64, nseg = s.nseg;
  const int nitems = pass == 0 ? nchain * nseg * 2 : nchain * nseg;
  for (int item = wid * gridDim.x + blockIdx.x; item < nitems; item += 2 * gridDim.x) {
    const int kind = pass == 0 ? 1 + (item & 1) : 0;
    const int cs = pass == 0 ? item >> 1 : item;
    const int seg = cs % nseg, chain = cs / nseg;
    const int d = chain & 1, h = (chain >> 1) & 31, b = chain >> 6;
    {
      const int ch = h * 64 + lane;
      lds_wait();
      prm[lane] = s.w0[d * EI + ch]; prm[64 + lane] = s.a0[d * EI + ch]; prm[128 + lane] = s.kk[ch]; prm[192 + lane] = s.ka[ch]; prm[256 + lane] = s.rk[ch];
      lds_wait();
    }
    bf16x8* awl = (bf16x8*)(wl + SC_AW); bf16x8* aal = (bf16x8*)(wl + SC_AA);
#pragma unroll
    for (int ks = 0; ks < 2; ++ks)
#pragma unroll
      for (int mt = 0; mt < 4; ++mt) {
        u32x4 pw, pa;
#pragma unroll
        for (int e = 0; e < 4; ++e) {
          const int l0 = ks * 32 + q * 8 + 2 * e;
          const size_t i0 = ((size_t)(d * 64 + l0)) * EI + h * 64 + mt * 16 + c16;
          pw[e] = cvtpk(s.w2[i0], s.w2[i0 + EI]); pa[e] = cvtpk(s.a2[i0], s.a2[i0 + EI]);
        }
        awl[(ks * 4 + mt) * 64 + lane] = *(bf16x8*)&pw; aal[(ks * 4 + mt) * 64 + lane] = *(bf16x8*)&pa;
      }
    lds_wait();
    const unsigned rowi = (unsigned)(d ? 15 - c16 : c16);
    const unsigned off_tw = rowi * 256u + (unsigned)(d * 128 + q * 16);
    const unsigned off_kr = rowi * 4096u + (unsigned)(h * 128 + q * 8);
    const unsigned off_v  = (unsigned)(h * 128 + lane * 2);
    const unsigned off_y0 = (unsigned)(d ? 15 - 4 * q : 4 * q) * 4096u + (unsigned)(h * 128 + c16 * 2);
    const int ystep = d ? -4096 : 4096;
    const unsigned off_b = rowi * 256u + (unsigned)((h * 2 + d) * 4);
    f32x4* Tl = (f32x4*)(wl + SC_T);
#pragma unroll
    for (int m = 0; m < 16; ++m) {
      f32x4 t0v = {0.f, 0.f, 0.f, 0.f};
      if (kind == 2) {
        const int mt = m >> 2, nt = m & 3;
        if (mt == nt) { t0v[0] = (4 * q + 0 == c16) ? 1.f : 0.f; t0v[1] = (4 * q + 1 == c16) ? 1.f : 0.f; t0v[2] = (4 * q + 2 == c16) ? 1.f : 0.f; t0v[3] = (4 * q + 3 == c16) ? 1.f : 0.f; }
      } else if (kind == 0 && nseg > 1) {
        t0v = *(const f32x4*)(s.tbuf + ((size_t)cs * 2) * 4096 + (m * 64 + lane) * 4);
      }
      Tl[m * 64 + lane] = t0v;
    }
    u16* yout = d ? s.yb : s.yf;
    const size_t sb = (size_t)b * s.T;
    const int cps = s.T / 16 / nseg, cbeg = seg * cps, cend = cbeg + cps;
    bf16x8 n_tw0, n_tw1, n_ta0, n_ta1; u32x2 n_k[4], n_r[4];
#define SCAN_LOAD(CC) do { const int c0n = d ? (s.T - 16 - (CC) * 16) : (CC) * 16; const size_t t0n = sb + c0n; \
      size_t p_tw = (size_t)s.twl + t0n * 256, p_al = (size_t)s.al + t0n * 256, p_k = (size_t)s.k + t0n * 4096, p_r = (size_t)s.r + t0n * 4096 ; \
      asm volatile("" : "+s"(p_tw), "+s"(p_al), "+s"(p_k), "+s"(p_r)); \
      n_tw0 = gld<bf16x8>(p_tw, off_tw); n_tw1 = gld<bf16x8>(p_tw, off_tw + 64); n_ta0 = gld<bf16x8>(p_al, off_tw); n_ta1 = gld<bf16x8>(p_al, off_tw + 64); \
      _Pragma("unroll") for (int mt = 0; mt < 4; ++mt) { n_k[mt] = gld<u32x2>(p_k, off_kr + mt * 32); n_r[mt] = gld<u32x2>(p_r, off_kr + mt * 32); } } while (0)
    SCAN_LOAD(cbeg);
    for (int cc = cbeg; cc < cend; ++cc) {
      const int c0 = d ? (s.T - 16 - cc * 16) : cc * 16;
      const size_t t0 = sb + c0;
      size_t b_y = (size_t)yout + t0 * 4096, b_bon = (size_t)s.bonus + t0 * 256;
      asm volatile("" : "+s"(b_y), "+s"(b_bon));
      size_t b_v = (size_t)s.v + t0 * 4096; asm volatile("" : "+s"(b_v));
      u32x2 n_v[4];
#pragma unroll
      for (int mt = 0; mt < 4; ++mt) n_v[mt] = gld<u32x2>(b_v, off_kr + mt * 32);
      {
        f32x4* wpl = (f32x4*)zl; f32x4* apl = (f32x4*)(wl + SC_PRE);
#pragma unroll
        for (int mt = 0; mt < 4; ++mt) {
          f32x4 cw = {0.f, 0.f, 0.f, 0.f}, ca = {0.f, 0.f, 0.f, 0.f};
          cw = __builtin_amdgcn_mfma_f32_16x16x32_bf16(awl[(0 * 4 + mt) * 64 + lane], n_tw0, cw, 0, 0, 0);
          cw = __builtin_amdgcn_mfma_f32_16x16x32_bf16(awl[(1 * 4 + mt) * 64 + lane], n_tw1, cw, 0, 0, 0);
          ca = __builtin_amdgcn_mfma_f32_16x16x32_bf16(aal[(0 * 4 + mt) * 64 + lane], n_ta0, ca, 0, 0, 0);
          ca = __builtin_amdgcn_mfma_f32_16x16x32_bf16(aal[(1 * 4 + mt) * 64 + lane], n_ta1, ca, 0, 0, 0);
          wpl[mt * 64 + lane] = cw; apl[mt * 64 + lane] = ca;
        }
      }
      float n2 = 0.f;
#pragma unroll
      for (int mt = 0; mt < 4; ++mt) {
        const float4 kkp = *(const float4*)(prm + 128 + mt * 16 + q * 4);
        const float t0 = bflo(n_k[mt][0]) * kkp.x, t1 = bfhi(n_k[mt][0]) * kkp.y, t2 = bflo(n_k[mt][1]) * kkp.z, t3 = bfhi(n_k[mt][1]) * kkp.w;
        n2 += t0 * t0 + t1 * t1 + t2 * t2 + t3 * t3;
      }
      n2 += __shfl_xor(n2, 16, 64); n2 += __shfl_xor(n2, 32, 64);
      const float invn = __builtin_amdgcn_rsqf(fmaxf(n2, 1e-24f));
      float bon = 0.f;
      bf16x8 ktf[2], btf[2], kdf[2], rtf[2];
#pragma unroll
      for (int ks = 0; ks < 2; ++ks) {
        float ktl[8], btl[8], kdl[8], rtl[8];
#pragma unroll
        for (int mh = 0; mh < 2; ++mh) {
          const int mt = 2 * ks + mh;
          const f32x4 cw = ((const f32x4*)zl)[mt * 64 + lane], ca = ((const f32x4*)(wl + SC_PRE))[mt * 64 + lane];
          const float4 w0p = *(const float4*)(prm + mt * 16 + q * 4), a0p = *(const float4*)(prm + 64 + mt * 16 + q * 4);
          const float4 kkp = *(const float4*)(prm + 128 + mt * 16 + q * 4), kap = *(const float4*)(prm + 192 + mt * 16 + q * 4), rkp = *(const float4*)(prm + 256 + mt * 16 + q * 4);
          const float w0a[4] = {w0p.x, w0p.y, w0p.z, w0p.w}, a0a[4] = {a0p.x, a0p.y, a0p.z, a0p.w};
          const float kka[4] = {kkp.x, kkp.y, kkp.z, kkp.w}, kaa[4] = {kap.x, kap.y, kap.z, kap.w}, rka[4] = {rkp.x, rkp.y, rkp.z, rkp.w};
          const u32x2 kr_ = n_k[mt], rr_ = n_r[mt];
          const float kxa[4] = {bflo(kr_[0]), bfhi(kr_[0]), bflo(kr_[1]), bfhi(kr_[1])};
          const float rxa[4] = {bflo(rr_[0]), bfhi(rr_[0]), bflo(rr_[1]), bfhi(rr_[1])};
          float4 p15v;
#pragma unroll
          for (int e = 0; e < 4; ++e) {
            const float wp = cw[e] + w0a[e], ap = ca[e] + a0a[e];
            const float ee = 0.6065306597126334f * __builtin_amdgcn_rcpf(1.f + __expf(-wp));
            const float a = __builtin_amdgcn_rcpf(1.f + __expf(-ap));
            const float kkn = kxa[e] * kka[e] * invn;
            const float kd = kxa[e] * (1.f + (a - 1.f) * kaa[e]);
            const float bb = kkn * a;
            bon += rxa[e] * kd * rka[e];
            const float Ei = row_prefix16(ee), Et = row_total16(ee);
            const float pm = __expf(-Ei), pp = __builtin_amdgcn_rcpf(pm), pm1 = __expf(ee - Ei);
            ktl[mh * 4 + e] = kkn * pm1; btl[mh * 4 + e] = bb * pp; kdl[mh * 4 + e] = kd * pp; rtl[mh * 4 + e] = rxa[e] * pm;
            ((float*)&p15v)[e] = __expf(-Et);
            const int j = mt * 16 + q * 4 + e;
            bkt[j * 40 + c16] = f2bf(btl[mh * 4 + e]); bkt[j * 40 + 16 + c16] = f2bf(kdl[mh * 4 + e]);
          }
          if (c16 == 0) *(float4*)(p15l + mt * 16 + q * 4) = p15v;
          SBAR();
        }
        ktf[ks] = pack8(ktl[0], ktl[1], ktl[2], ktl[3], ktl[4], ktl[5], ktl[6], ktl[7]);
        btf[ks] = pack8(btl[0], btl[1], btl[2], btl[3], btl[4], btl[5], btl[6], btl[7]);
        kdf[ks] = pack8(kdl[0], kdl[1], kdl[2], kdl[3], kdl[4], kdl[5], kdl[6], kdl[7]);
        rtf[ks] = pack8(rtl[0], rtl[1], rtl[2], rtl[3], rtl[4], rtl[5], rtl[6], rtl[7]);
      }
      bon += __shfl_xor(bon, 16, 64); bon += __shfl_xor(bon, 32, 64);
      if (q == 0 && kind == 0) gst<float>(b_bon, off_b, bon);
      SBAR();
      SBAR();
#pragma unroll
      for (int mt = 0; mt < 4; ++mt) {
        const int vb_ = (mt * 16 + q * 4) * 40 + 16 + c16;
        const unsigned v0_ = kind == 2 ? 0u : n_v[mt][0], v1_ = kind == 2 ? 0u : n_v[mt][1];
        uvt[vb_] = (u16)(v0_ & 0xffffu); uvt[vb_ + 40] = (u16)(v0_ >> 16);
        uvt[vb_ + 80] = (u16)(v1_ & 0xffffu); uvt[vb_ + 120] = (u16)(v1_ >> 16);
      }
      { const int cn = cc + 1 < cend ? cc + 1 : cc; SCAN_LOAD(cn); }
      SBAR();
      {
        f32x4 AB = {0.f, 0.f, 0.f, 0.f}, AK = AB, RB = AB, RK = AB;
#pragma unroll
        for (int ks = 0; ks < 2; ++ks) {
          AB = __builtin_amdgcn_mfma_f32_16x16x32_bf16(ktf[ks], btf[ks], AB, 0, 0, 0);
          AK = __builtin_amdgcn_mfma_f32_16x16x32_bf16(ktf[ks], kdf[ks], AK, 0, 0, 0);
          RB = __builtin_amdgcn_mfma_f32_16x16x32_bf16(rtf[ks], btf[ks], RB, 0, 0, 0);
          RK = __builtin_amdgcn_mfma_f32_16x16x32_bf16(rtf[ks], kdf[ks], RK, 0, 0, 0);
        }
#pragma unroll
        for (int r = 0; r < 4; ++r) {
          const int i = 4 * q + r;
          const bool lo = c16 < i, le = c16 <= i;
          abf[i * 16 + c16] = lo ? AB[r] : 0.f;
          akm[i * 16 + c16] = f2bf(lo ? AK[r] : 0.f);
          rr[i * 32 + c16] = f2bf(le ? RB[r] : 0.f);
          rr[i * 32 + 16 + c16] = f2bf(le ? RK[r] : 0.f);
        }
      }
#define TFRAG(ks, nt, OUT) do { const f32x4 ta_ = Tl[((2 * (ks)) * 4 + (nt)) * 64 + lane], tb_ = Tl[((2 * (ks) + 1) * 4 + (nt)) * 64 + lane]; \
        OUT = pack8(ta_[0], ta_[1], ta_[2], ta_[3], tb_[0], tb_[1], tb_[2], tb_[3]); } while (0)
      lds_wait();
      {
        bf16x8 akf = {0, 0, 0, 0, 0, 0, 0, 0};
        if (q < 2) akf = *(const bf16x8*)(akm + c16 * 16 + q * 8);
#pragma unroll
        for (int nt = 0; nt < 4; ++nt) {
          f32x4 z = {0.f, 0.f, 0.f, 0.f};
          bf16x8 tf0, tf1; TFRAG(0, nt, tf0); TFRAG(1, nt, tf1);
          z = __builtin_amdgcn_mfma_f32_16x16x32_bf16(ktf[0], tf0, z, 0, 0, 0);
          z = __builtin_amdgcn_mfma_f32_16x16x32_bf16(ktf[1], tf1, z, 0, 0, 0);
          const bf16x8 vf = *(const bf16x8*)(uvt + (nt * 16 + c16) * 40 + 16 + (q & 1) * 8);
          z = __builtin_amdgcn_mfma_f32_16x16x32_bf16(akf, vf, z, 0, 0, 0);
#pragma unroll
          for (int r = 0; r < 4; ++r) zl[(4 * q + r) * 68 + nt * 16 + c16] = z[r];
        }
      }
      lds_wait();
      SBAR();
      {
        float U[16];
#pragma unroll
        for (int i = 0; i < 16; ++i) {
          float acc = -zl[i * 68 + lane];
#pragma unroll
          for (int s4 = 0; s4 < (i + 3) / 4; ++s4) {
            const float4 a4 = *(const float4*)(abf + i * 16 + s4 * 4);
            if (s4 * 4 + 0 < i) acc -= a4.x * U[s4 * 4 + 0];
            if (s4 * 4 + 1 < i) acc -= a4.y * U[s4 * 4 + 1];
            if (s4 * 4 + 2 < i) acc -= a4.z * U[s4 * 4 + 2];
            if (s4 * 4 + 3 < i) acc -= a4.w * U[s4 * 4 + 3];
          }
          U[i] = acc;
          if ((i & 3) == 3) SBAR();
        }
        *(bf16x8*)(uvt + lane * 40) = pack8(U[0], U[1], U[2], U[3], U[4], U[5], U[6], U[7]);
        *(bf16x8*)(uvt + lane * 40 + 8) = pack8(U[8], U[9], U[10], U[11], U[12], U[13], U[14], U[15]);
      }
      lds_wait();
      SBAR();
      {
        const bf16x8 rrf = *(const bf16x8*)(rr + c16 * 32 + q * 8);
        bf16x8 uvf[4];
#pragma unroll
        for (int nt = 0; nt < 4; ++nt) uvf[nt] = *(const bf16x8*)(uvt + (nt * 16 + c16) * 40 + q * 8);
#pragma unroll
        for (int nt = 0; nt < 4; ++nt) {
          f32x4 y = {0.f, 0.f, 0.f, 0.f};
          bf16x8 tf0, tf1; TFRAG(0, nt, tf0); TFRAG(1, nt, tf1);
          y = __builtin_amdgcn_mfma_f32_16x16x32_bf16(rtf[0], tf0, y, 0, 0, 0);
          y = __builtin_amdgcn_mfma_f32_16x16x32_bf16(rtf[1], tf1, y, 0, 0, 0);
          y = __builtin_amdgcn_mfma_f32_16x16x32_bf16(rrf, uvf[nt], y, 0, 0, 0);
#pragma unroll
          for (int r = 0; r < 4; ++r) { if (kind == 0) gst<u16>(b_y, off_y0 + (unsigned)(r * ystep) + nt * 32, f2bf(y[r])); }
        }
#pragma unroll
        for (int mt = 0; mt < 4; ++mt) {
          const bf16x8 bkf = *(const bf16x8*)(bkt + (mt * 16 + c16) * 40 + q * 8);
          const float4 pq = *(const float4*)(p15l + mt * 16 + q * 4);
#pragma unroll
          for (int nt = 0; nt < 4; ++nt) {
            f32x4 t = __builtin_amdgcn_mfma_f32_16x16x32_bf16(bkf, uvf[nt], Tl[(mt * 4 + nt) * 64 + lane], 0, 0, 0);
            t[0] *= pq.x; t[1] *= pq.y; t[2] *= pq.z; t[3] *= pq.w;
            Tl[(mt * 4 + nt) * 64 + lane] = t;
          }
        }
      }
      lds_wait();
    }
    if (pass == 0) {
      float* dst = s.tbuf + ((size_t)cs * 2 + (kind - 1)) * 4096;
#pragma unroll
      for (int m = 0; m < 16; ++m) *(f32x4*)(dst + (m * 64 + lane) * 4) = Tl[m * 64 + lane];
    }
  }
}

DEV void scan_combine_phase(const ScanP& s, char* lds_) {
  const int tid = ltid(), wid = __builtin_amdgcn_readfirstlane(tid >> 6), lane = tid & 63, c16 = lane & 15, q = lane >> 4;
  if (wid >= 2) return;
  float* til = (float*)(lds_ + wid * 16384);
  const int nchain = s.nseq * 64, nseg = s.nseg;
  for (int chain = wid * gridDim.x + blockIdx.x; chain < nchain; chain += 2 * gridDim.x) {
    f32x4 T[16];
#pragma unroll
    for (int m = 0; m < 16; ++m) T[m] = f32x4{0.f, 0.f, 0.f, 0.f};
    for (int seg = 0; seg < nseg; ++seg) {
      float* tn = s.tbuf + ((size_t)(chain * nseg + seg) * 2) * 4096; const float* ti = tn + 4096;
      lds_wait();
#pragma unroll
      for (int m = 0; m < 16; ++m) *(f32x4*)(til + (m * 64 + lane) * 4) = *(const f32x4*)(ti + (m * 64 + lane) * 4);
      lds_wait();
      f32x4 Tn[16];
#pragma unroll
      for (int m = 0; m < 16; ++m) Tn[m] = *(const f32x4*)(tn + (m * 64 + lane) * 4);
#pragma unroll
      for (int nt = 0; nt < 4; ++nt) {
        bf16x8 bh[2], bl[2];
#pragma unroll
        for (int ks = 0; ks < 2; ++ks) {
          const f32x4 ta = T[(2 * ks) * 4 + nt], tb = T[(2 * ks + 1) * 4 + nt];
          const float x[8] = {ta[0], ta[1], ta[2], ta[3], tb[0], tb[1], tb[2], tb[3]};
          float hf[8], lf[8];
#pragma unroll
          for (int e = 0; e < 8; ++e) { hf[e] = bf2f(f2bf(x[e])); lf[e] = x[e] - hf[e]; }
          bh[ks] = pack8(hf[0], hf[1], hf[2], hf[3], hf[4], hf[5], hf[6], hf[7]);
          bl[ks] = pack8(lf[0], lf[1], lf[2], lf[3], lf[4], lf[5], lf[6], lf[7]);
        }
#pragma unroll
        for (int mt = 0; mt < 4; ++mt) {
          f32x4 acc = Tn[mt * 4 + nt];
#pragma unroll
          for (int ks = 0; ks < 2; ++ks) {
            float x[8];
#pragma unroll
            for (int e = 0; e < 8; ++e) x[e] = til[((mt * 4 + 2 * ks + (e >> 2)) * 64 + ((c16 >> 2) & 3) * 16 + 4 * q + (e & 3)) * 4 + (c16 & 3)];
            float hf[8], lf[8];
#pragma unroll
            for (int e = 0; e < 8; ++e) { hf[e] = bf2f(f2bf(x[e])); lf[e] = x[e] - hf[e]; }
            const bf16x8 ah = pack8(hf[0], hf[1], hf[2], hf[3], hf[4], hf[5], hf[6], hf[7]);
            const bf16x8 al = pack8(lf[0], lf[1], lf[2], lf[3], lf[4], lf[5], lf[6], lf[7]);
            acc = __builtin_amdgcn_mfma_f32_16x16x32_bf16(ah, bh[ks], acc, 0, 0, 0);
            acc = __builtin_amdgcn_mfma_f32_16x16x32_bf16(ah, bl[ks], acc, 0, 0, 0);
            acc = __builtin_amdgcn_mfma_f32_16x16x32_bf16(al, bh[ks], acc, 0, 0, 0);
          }
          Tn[mt * 4 + nt] = acc;
        }
      }
#pragma unroll
      for (int m = 0; m < 16; ++m) { *(f32x4*)(tn + (m * 64 + lane) * 4) = T[m]; T[m] = Tn[m]; }
    }
  }
}

DEV void post_phase(u16* __restrict__ yf, const u16* __restrict__ yb, const u16* __restrict__ v, const u16* __restrict__ sg,
                    const float* __restrict__ bonus, const float* __restrict__ lg, const float* __restrict__ lb) {
  const int tid_ = ltid(); const int lane = tid_ & 63, wid = __builtin_amdgcn_readfirstlane(tid_ >> 6);
  for (int tok = blockIdx.x * 8 + wid; tok < GT; tok += gridDim.x * 8) {
    for (int h = 0; h < 32; ++h) {
      const int ch = h * 64 + lane; const size_t i = (size_t)tok * EI + ch;
      const float y = bf2f(yf[i]) + bf2f(yb[i]);
      const float mean = wsum(y) * (1.f / 64.f);
      const float dd = y - mean;
      const float var = wsum(dd * dd) * (1.f / 64.f);
      const float yn = dd * rsqrtf(var + 64e-5f) * lg[ch] + lb[ch];
      const float bon = bonus[((size_t)tok * 32 + h) * 2] + bonus[((size_t)tok * 32 + h) * 2 + 1];
      yf[i] = f2bf((yn + bon * bf2f(v[i])) * bf2f(sg[i]));
    }
  }
}

DEV void mla_mid_phase(const float* __restrict__ cqkv, const float* __restrict__ qn, const float* __restrict__ kvn,
                       const float* __restrict__ ct, const float* __restrict__ st,
                       u16* __restrict__ cqn, u16* __restrict__ ckvn, u16* __restrict__ kpe, int T) {
  const int tid_ = ltid(); const int lane = tid_ & 63, wid = __builtin_amdgcn_readfirstlane(tid_ >> 6);
  for (int tok = blockIdx.x * 8 + wid; tok < GT; tok += gridDim.x * 8) {
    const float* row = cqkv + (size_t)tok * 704;
    float q[6], ss = 0.f;
#pragma unroll
    for (int i = 0; i < 6; ++i) { q[i] = row[lane + i * 64]; ss += q[i] * q[i]; }
    ss = wsum(ss); float sc = rsqrtf(ss * (1.f / 384.f) + 1e-6f);
#pragma unroll
    for (int i = 0; i < 6; ++i) cqn[(size_t)tok * 384 + lane + i * 64] = f2bf(q[i] * sc * qn[lane + i * 64]);
    float c[4]; ss = 0.f;
#pragma unroll
    for (int i = 0; i < 4; ++i) { c[i] = row[384 + lane + i * 64]; ss += c[i] * c[i]; }
    ss = wsum(ss); sc = rsqrtf(ss * (1.f / 256.f) + 1e-6f);
#pragma unroll
    for (int i = 0; i < 4; ++i) ckvn[(size_t)tok * 256 + lane + i * 64] = f2bf(c[i] * sc * kvn[lane + i * 64]);
    const float x = row[640 + lane];
    const float xo = __shfl_xor(x, 32, 64);
    const int pos = tok % T, j = lane & 31;
    const float cs = ct[pos * 32 + j], sn = st[pos * 32 + j];
    const float o = lane < 32 ? x * cs - xo * sn : x * cs + xo * sn;
    kpe[(size_t)tok * 64 + lane] = f2bf(o);
  }
}

constexpr int SHM_V = 16384, SHM_K = 16384, SHM_KP = 8192;
#define KSWZ(row, colB) ((row) * 256 + ((colB) ^ (((row) & 7) << 4)))
#define KPSWZ(row, colB) ((row) * 128 + ((colB) ^ (((row) & 7) << 4)))
constexpr float ATT_SCALE = 0.07216878364870322f;
DEV void partialSM(f32x16& p0, f32x16& p1, float& m_reg, float& mn, float& alpha) {
  constexpr float C = ATT_SCALE * 1.4426950408889634f;
  float pmax = p0[0];
#pragma unroll
  for (int r = 1; r < 16; ++r) pmax = fmaxf(pmax, p0[r]);
#pragma unroll
  for (int r = 0; r < 16; ++r) pmax = fmaxf(pmax, p1[r]);
  { auto rr = __builtin_amdgcn_permlane32_swap(__float_as_uint(pmax), __float_as_uint(pmax), false, false);
    pmax = fmaxf(__uint_as_float(rr[0]), __uint_as_float(rr[1])); }
  mn = fmaxf(m_reg, pmax); alpha = __builtin_amdgcn_exp2f((m_reg - mn) * C); m_reg = mn;
  const float mnC = -mn * C;
#pragma unroll
  for (int r = 0; r < 16; ++r) p0[r] = __builtin_amdgcn_exp2f(fmaf(p0[r], C, mnC));
#pragma unroll
  for (int r = 0; r < 16; ++r) p1[r] = __builtin_amdgcn_exp2f(fmaf(p1[r], C, mnC));
}
DEV void finishSM(f32x16& p0, f32x16& p1, float alpha, float& l_reg, bf16x8& pa0, bf16x8& pa1, bf16x8& pa2, bf16x8& pa3) {
  float ps = 0;
#pragma unroll
  for (int r = 0; r < 16; ++r) ps += p0[r];
#pragma unroll
  for (int r = 0; r < 16; ++r) ps += p1[r];
  { auto rr = __builtin_amdgcn_permlane32_swap(__float_as_uint(ps), __float_as_uint(ps), false, false);
    ps = __uint_as_float(rr[0]) + __uint_as_float(rr[1]); }
  l_reg = l_reg * alpha + ps;
#define PK4(PP, BASE, OUT) do { unsigned a0 = cvtpk(PP[BASE + 0], PP[BASE + 1]), a1 = cvtpk(PP[BASE + 2], PP[BASE + 3]);   \
    unsigned b0 = cvtpk(PP[BASE + 4], PP[BASE + 5]), b1 = cvtpk(PP[BASE + 6], PP[BASE + 7]);                              \
    auto r0 = __builtin_amdgcn_permlane32_swap(a0, b0, false, false); auto r1 = __builtin_amdgcn_permlane32_swap(a1, b1, false, false); \
    u32x4 w = {r0[0], r1[0], r0[1], r1[1]}; OUT = *reinterpret_cast<bf16x8*>(&w); } while (0)
  PK4(p0, 0, pa0); PK4(p0, 8, pa1); PK4(p1, 0, pa2); PK4(p1, 8, pa3);
#undef PK4
}
DEV int v_st(int k, int c) { const int kk = (k & ~0xC) | ((k & 4) << 1) | ((k & 8) >> 1); return ((kk >> 3) * 4 + (c >> 5)) * 512 + ((kk & 7) * 32 + (c & 31)) * 2; }
DEV int v_rd_base(int lane) { return ((lane & 3) << 3) | (((lane >> 2) & 3) << 6) | (((lane >> 4) & 1) << 5) | (((lane >> 5) & 1) << 8); }
constexpr int v_rd_off(int d0, int ks, int half) { return d0 * 512 + ks * 4096 + half * 2048; }
template <int OFF> DEV s16x4 tr_read(int vb) {
  s16x4 r; asm volatile("ds_read_b64_tr_b16 %0, %1 offset:%2" : "=&v"(r) : "v"(vb), "i"(OFF) : "memory"); return r;
}
template <int D0> DEV void pv_one(f32x16& od, int vb, bf16x8 pa0, bf16x8 pa1, bf16x8 pa2, bf16x8 pa3) {
  const s16x4 l0 = tr_read<v_rd_off(D0, 0, 0)>(vb), h0 = tr_read<v_rd_off(D0, 0, 1)>(vb), l1 = tr_read<v_rd_off(D0, 1, 0)>(vb), h1 = tr_read<v_rd_off(D0, 1, 1)>(vb);
  const s16x4 l2 = tr_read<v_rd_off(D0, 2, 0)>(vb), h2 = tr_read<v_rd_off(D0, 2, 1)>(vb), l3 = tr_read<v_rd_off(D0, 3, 0)>(vb), h3 = tr_read<v_rd_off(D0, 3, 1)>(vb);
  asm volatile("s_waitcnt lgkmcnt(0)" ::: "memory"); SBAR();
#define PK(L, H) (bf16x8){L[0], L[1], L[2], L[3], H[0], H[1], H[2], H[3]}
  od = __builtin_amdgcn_mfma_f32_32x32x16_bf16(pa0, PK(l0, h0), od, 0, 0, 0);
  od = __builtin_amdgcn_mfma_f32_32x32x16_bf16(pa1, PK(l1, h1), od, 0, 0, 0);
  od = __builtin_amdgcn_mfma_f32_32x32x16_bf16(pa2, PK(l2, h2), od, 0, 0, 0);
  od = __builtin_amdgcn_mfma_f32_32x32x16_bf16(pa3, PK(l3, h3), od, 0, 0, 0);
#undef PK
}

struct AttnP { const u16* q; const u16* kv; const u16* kpe; u16* sg; const float* ct; const float* st; int nseq, T; int dry; };
DEV void attn_phase(const AttnP& a, char* lds) {
  const int tid = ltid(), wid = tid >> 6, lane = tid & 63, r32 = lane & 31, hi = lane >> 5;
  char* V_lds = lds; char* K_lds = lds + 2 * SHM_V; char* KP_lds = lds + 2 * SHM_V + 2 * SHM_K;
  float* wsc = (float*)(lds + 2 * SHM_V + 2 * SHM_K + 2 * SHM_KP) + wid * 64; float* li_l = wsc; float* al_l = wsc + 32;
  const int nqb = a.T / 256, nitems = a.nseq * 16 * nqb, NT = a.T / 64;
  const int sr = tid >> 4, sc = (tid & 15) * 8, vst0 = v_st(sr, sc), vst1 = v_st(32 + sr, sc);
  const int pr = tid >> 3, pc = (tid & 7) * 8;
  const int vb0 = (int)(uintptr_t)V_lds + v_rd_base(lane);
  int kad[4], kpd[4];
#pragma unroll
  for (int q = 0; q < 4; ++q) { kad[q] = KSWZ(r32, q * 32 + hi * 16); kpd[q] = KPSWZ(r32, q * 32 + hi * 16); }
  for (int it = blockIdx.x; it < nitems; it += gridDim.x) {
    const int qb = it % nqb, h = (it / nqb) & 15, b = it / (nqb * 16);
    const size_t sbase = (size_t)b * a.T;
    const int pos = qb * 256 + wid * 32 + r32;
    bf16x8 qr[12];
    {
      const u16* Qw = a.q + (sbase + pos) * 3072 + h * 192 + hi * 8;
#pragma unroll
      for (int d0 = 0; d0 < 12; ++d0) qr[d0] = *(const bf16x8*)(Qw + d0 * 16);
#pragma unroll
      for (int dd = 0; dd < 2; ++dd) {
        const int j0 = dd * 16 + hi * 8;
        const float4 c0 = *(const float4*)(a.ct + pos * 32 + j0), c1 = *(const float4*)(a.ct + pos * 32 + j0 + 4);
        const float4 s0 = *(const float4*)(a.st + pos * 32 + j0), s1 = *(const float4*)(a.st + pos * 32 + j0 + 4);
        const float cs[8] = {c0.x, c0.y, c0.z, c0.w, c1.x, c1.y, c1.z, c1.w};
        const float sn[8] = {s0.x, s0.y, s0.z, s0.w, s1.x, s1.y, s1.z, s1.w};
        u32x4 x1 = *(u32x4*)&qr[8 + dd], x2 = *(u32x4*)&qr[10 + dd], y1, y2;
#pragma unroll
        for (int e = 0; e < 4; ++e) {
          const float a0 = bflo(x1[e]), a1 = bfhi(x1[e]), b0 = bflo(x2[e]), b1 = bfhi(x2[e]);
          y1[e] = cvtpk(a0 * cs[2 * e] - b0 * sn[2 * e], a1 * cs[2 * e + 1] - b1 * sn[2 * e + 1]);
          y2[e] = cvtpk(b0 * cs[2 * e] + a0 * sn[2 * e], b1 * cs[2 * e + 1] + a1 * sn[2 * e + 1]);
        }
        qr[8 + dd] = *(bf16x8*)&y1; qr[10 + dd] = *(bf16x8*)&y2;
      }
    }
    float m_reg = -1e30f, l_reg = 0.f; f32x16 o[4] = {};
    bf16x8 vs0, vs1, ks0, ks1, kp0;
    const u16* kvh = a.kv + sbase * 4096 + h * 256;
    const u16* kph = a.kpe + sbase * 64;
    const unsigned voff = (unsigned)(sr * 8192 + sc * 2), poff = (unsigned)(pr * 128 + pc * 2);
#define SLOAD(k0) do { const char* bK0 = (const char*)kvh + (size_t)(k0) * 8192; const char* bK1 = bK0 + 32 * 8192; const char* bP = (const char*)kph + (size_t)(k0) * 128; \
    vs0 = *(const bf16x8*)(bK0 + voff + 256); vs1 = *(const bf16x8*)(bK1 + voff + 256); \
    ks0 = *(const bf16x8*)(bK0 + voff); ks1 = *(const bf16x8*)(bK1 + voff); \
    kp0 = *(const bf16x8*)(bP + poff); } while (0)
#define SWRITE(bb) do { *(bf16x8*)(V_lds + (bb) * SHM_V + vst0) = vs0; *(bf16x8*)(V_lds + (bb) * SHM_V + vst1) = vs1; \
    *(bf16x8*)(K_lds + (bb) * SHM_K + KSWZ(sr, sc * 2)) = ks0; *(bf16x8*)(K_lds + (bb) * SHM_K + KSWZ(32 + sr, sc * 2)) = ks1; \
    *(bf16x8*)(KP_lds + (bb) * SHM_KP + KPSWZ(pr, pc * 2)) = kp0; } while (0)
    __syncthreads();
    SLOAD(0); SWRITE(0); __syncthreads();
    for (int j = 0; j < NT; ++j) {
      const int bb = j & 1;
      if (j + 1 < NT) SLOAD((j + 1) * 64);
      SBAR();
      f32x16 p0 = {}, p1 = {};
      {
        const char* Ks = K_lds + bb * SHM_K; const char* Kp = KP_lds + bb * SHM_KP;
#pragma unroll
        for (int d0 = 0; d0 < 8; ++d0) {
          const bf16x8 b0 = *(const bf16x8*)(Ks + kad[d0 & 3] + (d0 >> 2) * 128), b1 = *(const bf16x8*)(Ks + kad[d0 & 3] + (d0 >> 2) * 128 + 8192);
          p0 = __builtin_amdgcn_mfma_f32_32x32x16_bf16(b0, qr[d0], p0, 0, 0, 0);
          p1 = __builtin_amdgcn_mfma_f32_32x32x16_bf16(b1, qr[d0], p1, 0, 0, 0); }
#pragma unroll
        for (int d0 = 0; d0 < 4; ++d0) {
          const bf16x8 b0 = *(const bf16x8*)(Kp + kpd[d0]), b1 = *(const bf16x8*)(Kp + kpd[d0] + 4096);
          p0 = __builtin_amdgcn_mfma_f32_32x32x16_bf16(b0, qr[8 + d0], p0, 0, 0, 0);
          p1 = __builtin_amdgcn_mfma_f32_32x32x16_bf16(b1, qr[8 + d0], p1, 0, 0, 0); }
      }
      float mn, alpha;
      partialSM(p0, p1, m_reg, mn, alpha);
      if (__any(alpha < 1.f)) {
        if (hi == 0) al_l[r32] = alpha;
        lds_wait();
#pragma unroll
        for (int dd = 0; dd < 4; ++dd)
#pragma unroll
          for (int r = 0; r < 16; ++r) o[dd][r] *= al_l[crow(r, hi)];
      }
      bf16x8 pa0, pa1, pa2, pa3;
      finishSM(p0, p1, alpha, l_reg, pa0, pa1, pa2, pa3); SBAR();
      const int vb = vb0 + bb * SHM_V;
      pv_one<0>(o[0], vb, pa0, pa1, pa2, pa3); pv_one<1>(o[1], vb, pa0, pa1, pa2, pa3);
      pv_one<2>(o[2], vb, pa0, pa1, pa2, pa3); pv_one<3>(o[3], vb, pa0, pa1, pa2, pa3);
      if (j + 1 < NT) SWRITE(bb ^ 1);
      __syncthreads();
    }
#undef SLOAD
#undef SWRITE
    {
      int t2 = threadIdx.x; asm volatile("" : "+v"(t2));
      const int wid2 = t2 >> 6, r2 = t2 & 31, hi2 = (t2 >> 5) & 1;
      float* li2 = (float*)(lds + 2 * SHM_V + 2 * SHM_K + 2 * SHM_KP) + wid2 * 64;
      if (hi2 == 0) li2[r2] = l_reg;
      lds_wait();
      u16* Ow = a.sg + (sbase + qb * 256 + wid2 * 32) * EI + h * 128 + r2;
#pragma unroll
      for (int r = 0; r < 16; ++r) {
        const int orow = crow(r, hi2);
        const float rl = __builtin_amdgcn_rcpf(li2[orow]);
#pragma unroll
        for (int d0 = 0; d0 < 4; ++d0) {
          u16* pp = Ow + (size_t)orow * EI + d0 * 32;
          if (!a.dry) *pp = f2bf(o[d0][r] * rl * bf2f(*pp));
        }
      }
    }
  }
}

#if MEGA
#define GRID_SYNC() cg::this_grid().sync()
#else
#define GRID_SYNC() do {} while (0)
#endif
struct Grp { const float* xin0; float* xres; int nseq, T; };
DEV Grp get_group(const P& p, int g) {
  Grp r;
  r.xin0 = g == 0 ? p.x_prompt : p.x_sample + (size_t)(g - 1) * GT * DM;
  r.xres = p.out + (size_t)g * GT * DM;
  r.nseq = g == 0 ? 8 : 1; r.T = g == 0 ? 2048 : 16384;
  return r;
}
template <int LT, int ph>
DEV void run_phase(const P& p, int g, int layer, char* lds) {
  const Grp G = get_group(p, g);
  const int j = layer >> 1;
  const float* xin = layer == 0 ? G.xin0 : G.xres;
  size_t zoff = 0; asm volatile("" : "+s"(zoff));
  char* ws = p.ws + zoff;
  u16* hbuf = (u16*)(ws + O_HBUF);
  u16* sg = (u16*)(ws + O_SG);
  if constexpr (LT == 0) {
    u16 *rb = (u16*)(ws + O_RB), *kb = (u16*)(ws + O_KB), *vb = (u16*)(ws + O_VB), *yf = (u16*)(ws + O_YF), *yb = (u16*)(ws + O_YB);
    u16 *twl = (u16*)(ws + O_TWL), *al = (u16*)(ws + O_AL); float* bon = (float*)(ws + O_BON);
    if constexpr (ph == 0) rms_phase(xin, p.ln_g + layer * DM, hbuf);
    else if constexpr (ph == 1) {
      GemmP q{}; q.A = hbuf; q.lda = DM; q.Bt = (const u16*)(ws + O_WRWIN) + (size_t)j * RW_N * DM; q.K = DM; q.NT = 66;
      q.mu = p.rw_mu + (size_t)j * 6 * DM; q.T = G.T; q.o0 = rb; q.o1 = kb; q.o2 = vb; q.o3 = sg; q.o4 = twl; q.o5 = al;
      for (int rep = 1; rep < REP_GEMM; ++rep) { q.dry = (gridDim.x != 12345); gemm_phase<LOAD_LERP, EPI_RWKV>(q, lds); } q.dry = 0;
      gemm_phase<LOAD_LERP, EPI_RWKV>(q, lds);
    } else if constexpr (ph == 2) {
      ScanP s{}; s.r = rb; s.k = kb; s.v = vb; s.twl = twl; s.al = al; s.yf = yf; s.yb = yb; s.bonus = bon;
      s.w0 = p.rw_w0 + (size_t)j * 2 * EI; s.w2 = p.rw_w2 + (size_t)j * 2 * 64 * EI; s.a0 = p.rw_a0 + (size_t)j * 2 * EI; s.a2 = p.rw_a2 + (size_t)j * 2 * 64 * EI;
      s.kk = p.rw_kk + (size_t)j * EI; s.ka = p.rw_ka + (size_t)j * EI; s.rk = p.rw_rk + (size_t)j * EI; s.nseq = G.nseq; s.T = G.T;
      s.tbuf = (float*)hbuf;
      if (G.T > 2048) {
        s.nseg = 16;
        scan_phase(s, lds, 0); GRID_SYNC();
        scan_combine_phase(s, lds); GRID_SYNC();
        scan_phase(s, lds, 1);
      } else { s.nseg = 1; scan_phase(s, lds, 1); }
    } else if constexpr (ph == 3) post_phase(yf, yb, vb, sg, bon, p.rw_lnx_g + (size_t)j * EI, p.rw_lnx_b + (size_t)j * EI);
    else {
      GemmP q{}; q.A = yf; q.lda = EI; q.Bt = (const u16*)(ws + O_WRWOUT) + (size_t)j * DM * EI; q.K = EI; q.NT = 8; q.xin = xin; q.xout = G.xres;
      for (int rep = 1; rep < REP_GEMM; ++rep) { q.dry = (gridDim.x != 12345); gemm_phase<LOAD_PLAIN, EPI_RES>(q, lds); } q.dry = 0;
      gemm_phase<LOAD_PLAIN, EPI_RES>(q, lds);
    }
  } else {
    float* cqkv = (float*)(ws + O_CQKV); u16 *cqn = (u16*)(ws + O_CQN), *ckvn = (u16*)(ws + O_CKVN), *kpe = (u16*)(ws + O_KPE), *qq = (u16*)(ws + O_Q), *kv = (u16*)(ws + O_KV);
    const float* ct = (const float*)(ws + O_COS); const float* st = (const float*)(ws + O_SIN);
    if constexpr (ph == 0) rms_phase(xin, p.ln_g + layer * DM, hbuf);
    else if constexpr (ph == 1) {
      GemmP q{}; q.A = hbuf; q.lda = DM; q.Bt = (const u16*)(ws + O_WMLIN) + (size_t)j * ML_NP * DM; q.K = DM; q.NT = 22; q.of = cqkv; q.o0 = sg;
      for (int rep = 1; rep < REP_GEMM; ++rep) { q.dry = (gridDim.x != 12345); gemm_phase<LOAD_PLAIN, EPI_MLAIN>(q, lds); } q.dry = 0;
      gemm_phase<LOAD_PLAIN, EPI_MLAIN>(q, lds);
    } else if constexpr (ph == 2) mla_mid_phase(cqkv, p.ml_qn + j * 384, p.ml_kvn + j * 256, ct, st, cqn, ckvn, kpe, G.T);
    else if constexpr (ph == 3) {
      GemmP q{}; q.A = cqn; q.lda = 384; q.Bt = (const u16*)(ws + O_WUQ) + (size_t)j * 3072 * 384; q.K = 384; q.NT = 24; q.o0 = qq; q.ldc = 3072;
      for (int rep = 1; rep < REP_GEMM; ++rep) { q.dry = (gridDim.x != 12345); gemm_phase<LOAD_PLAIN, EPI_BF16>(q, lds); } q.dry = 0;
      gemm_phase<LOAD_PLAIN, EPI_BF16>(q, lds);
      GemmP r{}; r.A = ckvn; r.lda = 256; r.Bt = (const u16*)(ws + O_WUKV) + (size_t)j * 4096 * 256; r.K = 256; r.NT = 32; r.o0 = kv; r.ldc = 4096;
      for (int rep = 1; rep < REP_GEMM; ++rep) { r.dry = (gridDim.x != 12345); gemm_phase<LOAD_PLAIN, EPI_BF16>(r, lds); } r.dry = 0;
      gemm_phase<LOAD_PLAIN, EPI_BF16>(r, lds);
    } else if constexpr (ph == 4) {
      AttnP a{}; a.q = qq; a.kv = kv; a.kpe = kpe; a.sg = sg; a.ct = ct; a.st = st; a.nseq = G.nseq; a.T = G.T;
      for (int rep = 1; rep < REP_ATTN; ++rep) { a.dry = (gridDim.x != 12345); attn_phase(a, lds); } a.dry = 0;
      attn_phase(a, lds);
    } else {
      GemmP q{}; q.A = sg; q.lda = EI; q.Bt = (const u16*)(ws + O_WMLOUT) + (size_t)j * DM * EI; q.K = EI; q.NT = 8; q.xin = xin; q.xout = G.xres;
      for (int rep = 1; rep < REP_GEMM; ++rep) { q.dry = (gridDim.x != 12345); gemm_phase<LOAD_PLAIN, EPI_RES>(q, lds); } q.dry = 0;
      gemm_phase<LOAD_PLAIN, EPI_RES>(q, lds);
    }
  }
}


template <int LT, int PH>
__global__ __launch_bounds__(512) void k_phase(P p, int g, int layer) {
  extern __shared__ __attribute__((aligned(16))) char lds[];
  if constexpr (LT == 2) { if constexpr (PH == 0) init_phase(p, lds); else final_phase(p.out, p.final_g); }
  else run_phase<LT, PH>(p, g, layer, lds);
}

#if MEGA
__global__ __launch_bounds__(512) void k_mega(P p) {
  extern __shared__ __attribute__((aligned(16))) char lds[];
  cg::grid_group grid = cg::this_grid();
  init_phase(p, lds);
  grid.sync();
  for (int g = 0; g < 3; ++g)
    for (int layer = 0; layer < 4; ++layer) {
      if ((layer & 1) == 0) {
        run_phase<0, 0>(p, g, layer, lds); grid.sync(); run_phase<0, 1>(p, g, layer, lds); grid.sync(); run_phase<0, 2>(p, g, layer, lds); grid.sync();
        run_phase<0, 3>(p, g, layer, lds); grid.sync(); run_phase<0, 4>(p, g, layer, lds); grid.sync();
      } else {
        run_phase<1, 0>(p, g, layer, lds); grid.sync(); run_phase<1, 1>(p, g, layer, lds); grid.sync(); run_phase<1, 2>(p, g, layer, lds); grid.sync();
        run_phase<1, 3>(p, g, layer, lds); grid.sync(); run_phase<1, 4>(p, g, layer, lds); grid.sync(); run_phase<1, 5>(p, g, layer, lds); grid.sync();
      }
    }
  final_phase(p.out, p.final_g);
}
#endif

extern "C" void kernel_launch(void* const* d_in, const int* in_sizes, int n_in, void* d_out, int out_size, void* d_ws, size_t ws_size, hipStream_t stream) {
  if (n_in != 22 || ws_size < WS_NEED) { fprintf(stderr, "kernel_launch: bad args n_in %d ws %zu need %zu\n", n_in, ws_size, WS_NEED); return; }
  P p{};
  const float** f = (const float**)&p;
  for (int i = 0; i < 22; ++i) f[i] = (const float*)d_in[i];
  p.out = (float*)d_out; p.ws = (char*)d_ws;
#if MEGA
  static int grid_blocks = 0;
  if (!grid_blocks) {
    hipFuncSetAttribute((const void*)k_mega, hipFuncAttributeMaxDynamicSharedMemorySize, SHM_BYTES);
    int dev = 0, cus = 0, per_cu = 0;
    hipGetDevice(&dev);
    hipDeviceGetAttribute(&cus, hipDeviceAttributeMultiprocessorCount, dev);
    hipOccupancyMaxActiveBlocksPerMultiprocessor(&per_cu, k_mega, 512, SHM_BYTES);
    if (per_cu > 1) per_cu = 1;
    grid_blocks = cus * per_cu;
  }
  void* args[] = {&p};
  hipError_t e = hipLaunchCooperativeKernel((void*)k_mega, dim3(grid_blocks), dim3(512), args, SHM_BYTES, stream);
  if (e != hipSuccess) fprintf(stderr, "cooperative launch failed: %s (grid %d)\n", hipGetErrorString(e), grid_blocks);
#else
  const int NB = 256;
#define LAUNCH(LT, PH, g, layer) do { static int inited = 0; if (!inited) { hipFuncSetAttribute((const void*)k_phase<LT, PH>, hipFuncAttributeMaxDynamicSharedMemorySize, SHM_BYTES); inited = 1; } \
    hipLaunchKernelGGL((k_phase<LT, PH>), dim3(NB), dim3(512), SHM_BYTES, stream, p, g, layer); } while (0)
  LAUNCH(2, 0, 0, 0);
  for (int g = 0; g < 3; ++g)
    for (int layer = 0; layer < 4; ++layer) {
      if ((layer & 1) == 0) { LAUNCH(0, 0, g, layer); LAUNCH(0, 1, g, layer); LAUNCH(0, 2, g, layer); LAUNCH(0, 3, g, layer); LAUNCH(0, 4, g, layer); }
      else { LAUNCH(1, 0, g, layer); LAUNCH(1, 1, g, layer); LAUNCH(1, 2, g, layer); LAUNCH(1, 3, g, layer); LAUNCH(1, 4, g, layer); LAUNCH(1, 5, g, layer); }
    }
  LAUNCH(2, 1, 0, 0);
#endif
}
```

```cpp
#include <hip/hip_runtime.h>
#include <hip/hip_bf16.h>
#include <hip/hip_cooperative_groups.h>
#include <cstdio>
namespace cg = cooperative_groups;

#ifndef REP_GEMM
#define REP_GEMM 1
#endif
#ifndef REP_ATTN
#define REP_ATTN 1
#endif
#ifndef REP_SCAN
#define REP_SCAN 1
#endif
#ifndef MEGA
#define MEGA 1
#endif

typedef unsigned short u16;
using bf16x8 = __attribute__((ext_vector_type(8))) short;
using s16x4  = __attribute__((ext_vector_type(4))) short;
using f32x16 = __attribute__((ext_vector_type(16))) float;
using f32x4  = __attribute__((ext_vector_type(4))) float;
using u32x4  = __attribute__((ext_vector_type(4))) unsigned;
using u32x2  = __attribute__((ext_vector_type(2))) unsigned;
#define DEV __device__ __forceinline__
#define SBAR() __builtin_amdgcn_sched_barrier(0)

constexpr int DM = 1024, EI = 2048, GT = 16384;
constexpr int NTOK = 49152;
constexpr int RW_N = 8448, ML_N = 2752, ML_NP = 2816;
constexpr int SHM_BYTES = 122880;

constexpr size_t alup(size_t x) { return (x + 255) / 256 * 256; }
constexpr size_t O_WRWIN  = 0;
constexpr size_t O_WRWOUT = O_WRWIN  + alup((size_t)2 * RW_N * DM * 2);
constexpr size_t O_WMLIN  = O_WRWOUT + alup((size_t)2 * DM * EI * 2);
constexpr size_t O_WUQ    = O_WMLIN  + alup((size_t)2 * ML_NP * DM * 2);
constexpr size_t O_WUKV   = O_WUQ    + alup((size_t)2 * 3072 * 384 * 2);
constexpr size_t O_WMLOUT = O_WUKV   + alup((size_t)2 * 4096 * 256 * 2);
constexpr size_t O_COS    = O_WMLOUT + alup((size_t)2 * DM * EI * 2);
constexpr size_t O_SIN    = O_COS    + alup((size_t)16384 * 32 * 4);
constexpr size_t O_HBUF   = O_SIN    + alup((size_t)16384 * 32 * 4);
constexpr size_t O_R0     = O_HBUF   + alup((size_t)GT * DM * 2);
constexpr size_t SZ_E = (size_t)GT * EI * 2;
constexpr size_t O_SG   = O_R0;
constexpr size_t O_RB   = O_SG + SZ_E;
constexpr size_t O_KB   = O_RB + SZ_E;
constexpr size_t O_VB   = O_KB + SZ_E;
constexpr size_t O_YF   = O_VB + SZ_E;
constexpr size_t O_YB   = O_YF + SZ_E;
constexpr size_t O_TWL  = O_YB + SZ_E;
constexpr size_t O_AL   = O_TWL + alup((size_t)GT * 128 * 2);
constexpr size_t O_BON  = O_AL  + alup((size_t)GT * 128 * 2);
constexpr size_t O_RW_END = O_BON + alup((size_t)GT * 64 * 4);
constexpr size_t O_CQKV = O_SG + SZ_E;
constexpr size_t O_CQN  = O_CQKV + alup((size_t)GT * 704 * 4);
constexpr size_t O_CKVN = O_CQN  + alup((size_t)GT * 384 * 2);
constexpr size_t O_KPE  = O_CKVN + alup((size_t)GT * 256 * 2);
constexpr size_t O_Q    = O_KPE  + alup((size_t)GT * 64 * 2);
constexpr size_t O_KV   = O_Q    + alup((size_t)GT * 3072 * 2);
constexpr size_t O_ML_END = O_KV + alup((size_t)GT * 4096 * 2);
constexpr size_t O_FLAG = O_RW_END > O_ML_END ? O_RW_END : O_ML_END;
constexpr size_t O_BAR = O_FLAG + 256;
constexpr size_t WS_NEED = O_BAR + 16384;

struct P {
  const float* x_prompt; const float* x_sample; const float* ln_g; const float* final_g;
  const float* rw_mu; const float* rw_in; const float* rw_w0; const float* rw_w2; const float* rw_a0; const float* rw_a2;
  const float* rw_kk; const float* rw_ka; const float* rw_rk; const float* rw_lnx_g; const float* rw_lnx_b; const float* rw_out;
  const float* ml_in; const float* ml_qn; const float* ml_kvn; const float* ml_uq; const float* ml_ukv; const float* ml_out;
  float* out; char* ws;
};

typedef __attribute__((ext_vector_type(2))) __bf16 bf16x2_t;
typedef __attribute__((ext_vector_type(2))) float f32x2_t;
DEV unsigned cvtpk(float lo, float hi) { f32x2_t v = {lo, hi}; bf16x2_t b = __builtin_convertvector(v, bf16x2_t); return __builtin_bit_cast(unsigned, b); }
DEV float bf2f(u16 x) { return __uint_as_float(((unsigned)x) << 16); }
DEV float bflo(unsigned x) { return __uint_as_float(x << 16); }
DEV float bfhi(unsigned x) { return __uint_as_float(x & 0xffff0000u); }
DEV u16 f2bf(float x) { __bf16 b = (__bf16)x; return __builtin_bit_cast(u16, b); }
DEV float wsum(float v) {
#pragma unroll
  for (int o = 32; o >= 1; o >>= 1) v += __shfl_xor(v, o, 64);
  return v;
}
DEV float siluf(float x) { return x / (1.f + __expf(-x)); }
DEV int crow(int r, int hi) { return (r & 3) + 8 * (r >> 2) + 4 * hi; }
DEV int ltid() { int t = threadIdx.x; asm volatile("" : "+v"(t)); return t; }
template <typename T> DEV T gld(size_t base, unsigned off) { return *(const __attribute__((address_space(1))) T*)(base + off); }
template <typename T> DEV void gst(size_t base, unsigned off, T v) { *(__attribute__((address_space(1))) T*)(base + off) = v; }
DEV void lds_wait() { asm volatile("s_waitcnt lgkmcnt(0)" ::: "memory"); }


#define XB_TMO      128
#define XB_XCNT(j)  (256  + 64 * (j))
#define XB_XSUB(j)  (1280 + 64 * (j))
#define XB_XGEN(j)  (2304 + 64 * (j))
#define XB_TOP      3328
#define XB_TOPGEN   3392
#define XCD_BAR_WORDS 3456
#define XB_SPIN_CAP (1u << 22)
#define LAS __attribute__((address_space(3)))
DEV unsigned xb_ld(unsigned* p)              { return __hip_atomic_load(p, __ATOMIC_RELAXED, __HIP_MEMORY_SCOPE_AGENT); }
DEV unsigned xb_add(unsigned* p, unsigned v) { return __hip_atomic_fetch_add(p, v, __ATOMIC_RELAXED, __HIP_MEMORY_SCOPE_AGENT); }
DEV unsigned xb_xcc_id() { return (unsigned)__builtin_amdgcn_s_getreg((3 << 11) | 20) & 0xFu; }
#define XB_SPIN(cond, bar) do { unsigned _sp = 0; while (cond) { __builtin_amdgcn_s_sleep(1); \
    if ((++_sp & 255u) == 0u) { if (xb_ld(&(bar)[XB_TMO])) break; if (_sp > XB_SPIN_CAP) { atomicAdd(&(bar)[XB_TMO], 1u); break; } } } } while (0)
struct XcdBarrier { unsigned* bar; unsigned x; volatile LAS unsigned* st; };
DEV void xcd_barrier_complete(unsigned* bar, unsigned x, unsigned& nloc, unsigned& nx) {
  const unsigned G = gridDim.x * gridDim.y * gridDim.z;
  unsigned sum, cnt, mine, sp = 0u;
  for (;;) {
    sum = 0u; cnt = 0u; mine = 0u;
#pragma unroll
    for (unsigned j = 0; j < 16; ++j) { const unsigned c = xb_ld(&bar[XB_XCNT(j)]); sum += c; cnt += (c > 0u) ? 1u : 0u; mine = (j == x) ? c : mine; }
    if (sum == G) break;
    __builtin_amdgcn_s_sleep(1);
    if ((++sp & 255u) == 0u) { if (xb_ld(&bar[XB_TMO])) break; if (sp > XB_SPIN_CAP) { atomicAdd(&bar[XB_TMO], 1u); break; } }
  }
  nloc = mine > 0u ? mine : 1u; nx = cnt > 0u ? cnt : 1u;
}
DEV void xcd_barrier(const XcdBarrier& b) {
  asm volatile("s_waitcnt vmcnt(0)" ::: "memory");
  __syncthreads();
  if (threadIdx.x == 0) {
    unsigned* bar = b.bar;
    __builtin_amdgcn_s_waitcnt(0);
    unsigned nloc = b.st[0], nx = b.st[1];
    if (nloc == 0u) { xcd_barrier_complete(bar, b.x, nloc, nx); b.st[0] = nloc; b.st[1] = nx; }
    const unsigned old = xb_add(&bar[XB_XSUB(b.x)], 1u);
    const unsigned gen = old / nloc;
    if (old + 1u == (gen + 1u) * nloc) {
      __builtin_amdgcn_fence(__ATOMIC_RELEASE, "agent");
      asm volatile("s_waitcnt vmcnt(0)" ::: "memory");
      const unsigned og = xb_add(&bar[XB_TOP], 1u);
      const unsigned tg = og / nx;
      if (og + 1u == (tg + 1u) * nx) xb_add(&bar[XB_TOPGEN], 1u);
      else XB_SPIN(xb_ld(&bar[XB_TOPGEN]) == tg, bar);
      __builtin_amdgcn_fence(__ATOMIC_ACQUIRE, "agent");
      xb_add(&bar[XB_XGEN(b.x)], 1u);
      asm volatile("s_waitcnt vmcnt(0)" ::: "memory");
    } else {
      XB_SPIN(xb_ld(&bar[XB_XGEN(b.x)]) == gen, bar);
      __builtin_amdgcn_fence(__ATOMIC_ACQUIRE, "agent");
      asm volatile("s_waitcnt vmcnt(0)" ::: "memory");
    }
  }
  __syncthreads();
}
DEV void gsync(const P& p, char* lds) {
  XcdBarrier b; b.bar = (unsigned*)(p.ws + O_BAR); b.x = xb_xcc_id(); b.st = (volatile LAS unsigned*)(lds + SHM_BYTES - 16);
  xcd_barrier(b);
}

DEV void convert_T(const float* __restrict__ src, u16* __restrict__ dst, int K, int N, int Npad, char* lds_) {
  float* lds = (float*)lds_;
  const int tid = ltid(), tk = K / 64, tn = Npad / 64;
  for (int t = blockIdx.x; t < tk * tn; t += gridDim.x) {
    const int k0 = (t % tk) * 64, n0 = (t / tk) * 64;
    __syncthreads();
#pragma unroll
    for (int i = 0; i < 2; ++i) {
      const int kr = (tid >> 4) + i * 32, c = (tid & 15) * 4;
      float4 v = make_float4(0.f, 0.f, 0.f, 0.f);
      if (n0 + c < N) v = *(const float4*)(src + (long)(k0 + kr) * N + n0 + c);
      lds[kr * 65 + c + 0] = v.x; lds[kr * 65 + c + 1] = v.y; lds[kr * 65 + c + 2] = v.z; lds[kr * 65 + c + 3] = v.w;
    }
    __syncthreads();
    const int n = tid >> 3, kc = (tid & 7) * 8;
    u32x4 w;
    w[0] = cvtpk(lds[(kc + 0) * 65 + n], lds[(kc + 1) * 65 + n]);
    w[1] = cvtpk(lds[(kc + 2) * 65 + n], lds[(kc + 3) * 65 + n]);
    w[2] = cvtpk(lds[(kc + 4) * 65 + n], lds[(kc + 5) * 65 + n]);
    w[3] = cvtpk(lds[(kc + 6) * 65 + n], lds[(kc + 7) * 65 + n]);
    *(u32x4*)(dst + (long)(n0 + n) * K + k0 + kc) = w;
  }
}

DEV void init_phase(const P& p, char* lds) {
  for (int j = 0; j < 2; ++j) {
    convert_T(p.rw_in  + (size_t)j * DM * RW_N, (u16*)(p.ws + O_WRWIN)  + (size_t)j * RW_N * DM, DM, RW_N, RW_N, lds);
    convert_T(p.rw_out + (size_t)j * EI * DM,   (u16*)(p.ws + O_WRWOUT) + (size_t)j * DM * EI,   EI, DM, DM, lds);
    convert_T(p.ml_in  + (size_t)j * DM * ML_N, (u16*)(p.ws + O_WMLIN)  + (size_t)j * ML_NP * DM, DM, ML_N, ML_NP, lds);
    convert_T(p.ml_uq  + (size_t)j * 384 * 3072, (u16*)(p.ws + O_WUQ)   + (size_t)j * 3072 * 384, 384, 3072, 3072, lds);
    convert_T(p.ml_ukv + (size_t)j * 256 * 4096, (u16*)(p.ws + O_WUKV)  + (size_t)j * 4096 * 256, 256, 4096, 4096, lds);
    convert_T(p.ml_out + (size_t)j * EI * DM,   (u16*)(p.ws + O_WMLOUT) + (size_t)j * DM * EI,   EI, DM, DM, lds);
  }
  float* ct = (float*)(p.ws + O_COS); float* st = (float*)(p.ws + O_SIN);
  const int tid_ = ltid();
  for (int i = blockIdx.x * 512 + tid_; i < 16384 * 32; i += gridDim.x * 512) {
    const int pos = i >> 5, j = i & 31;
    const float invf = 1.0f / powf(10000.0f, (float)(2 * j) / 64.0f);
    const float ang = (float)pos * invf;
    const double a = (double)ang;
    const double n = rint(a * 0.15915494309189535);
    const float r = (float)(a - n * 6.283185307179586);
    ct[i] = cosf(r); st[i] = sinf(r);
  }
}

DEV void rms_phase(const float* __restrict__ x, const float* __restrict__ g, u16* __restrict__ hout) {
  const int tid_ = ltid(); const int lane = tid_ & 63, wid = __builtin_amdgcn_readfirstlane(tid_ >> 6);
  for (int tok = blockIdx.x * 8 + wid; tok < GT; tok += gridDim.x * 8) {
    const float4* xr = (const float4*)(x + (size_t)tok * DM);
    float4 v[4]; float ss = 0.f;
#pragma unroll
    for (int i = 0; i < 4; ++i) { v[i] = xr[lane + i * 64]; ss += v[i].x * v[i].x + v[i].y * v[i].y + v[i].z * v[i].z + v[i].w * v[i].w; }
    ss = wsum(ss);
    const float sc = rsqrtf(ss * (1.f / DM) + 1e-6f);
#pragma unroll
    for (int i = 0; i < 4; ++i) {
      const float4 gg = ((const float4*)g)[lane + i * 64];
      u32x2 w; w[0] = cvtpk(v[i].x * sc * gg.x, v[i].y * sc * gg.y); w[1] = cvtpk(v[i].z * sc * gg.z, v[i].w * sc * gg.w);
      *(u32x2*)(hout + (size_t)tok * DM + (lane + i * 64) * 4) = w;
    }
  }
}

DEV void final_phase(float* __restrict__ x, const float* __restrict__ g) {
  const int tid_ = ltid(); const int lane = tid_ & 63, wid = __builtin_amdgcn_readfirstlane(tid_ >> 6);
  for (int tok = blockIdx.x * 8 + wid; tok < NTOK; tok += gridDim.x * 8) {
    float4* xr = (float4*)(x + (size_t)tok * DM);
    float4 v[4]; float ss = 0.f;
#pragma unroll
    for (int i = 0; i < 4; ++i) { v[i] = xr[lane + i * 64]; ss += v[i].x * v[i].x + v[i].y * v[i].y + v[i].z * v[i].z + v[i].w * v[i].w; }
    ss = wsum(ss);
    const float sc = rsqrtf(ss * (1.f / DM) + 1e-6f);
#pragma unroll
    for (int i = 0; i < 4; ++i) {
      const float4 gg = ((const float4*)g)[lane + i * 64];
      float4 ov = make_float4(v[i].x * sc * gg.x, v[i].y * sc * gg.y, v[i].z * sc * gg.z, v[i].w * sc * gg.w);
      xr[lane + i * 64] = ov;
    }
  }
}

#define GSWZ(row, c16) ((row) * 128 + ((((c16) ^ ((row) >> 1)) & 7) << 4))
constexpr int LOAD_PLAIN = 0, LOAD_LERP = 1;
constexpr int EPI_RWKV = 0, EPI_RES = 1, EPI_MLAIN = 2, EPI_BF16 = 3;
struct GemmP {
  const u16* A; int lda; const u16* Bt; int K; int NT;
  const float* mu;
  int T;
  u16* o0; u16* o1; u16* o2; u16* o3; u16* o4; u16* o5;
  int ldc;
  float* of; const float* xin; float* xout; int dry;
};

template <int LOAD, int EPI>
DEV void gemm_phase(const GemmP& g, char* lds) {
  const int tid = ltid(), wid = tid >> 6, lane = tid & 63, r32 = lane & 31, hi = lane >> 5;
  const int wm = wid >> 1, wn = wid & 1;
  char* sA = lds; char* sB = lds + 65536;
  const int nk = g.K / 64, ntiles = 64 * g.NT;
  const int c16 = tid & 7, rowb = tid >> 3;
  for (int t = blockIdx.x; t < ntiles; t += gridDim.x) {
    const int mt = t & 63, nt = t >> 6, m0 = mt * 256, n0 = nt * 128;
    f32x16 acc[2][2] = {};
    bf16x8 ra[4], rb[2];
    const float* mup = nullptr;
    if constexpr (LOAD == LOAD_LERP) {
      const int s = nt < 16 ? 0 : nt < 32 ? 2 : nt < 48 ? 3 : nt < 64 ? 5 : nt == 64 ? 1 : 4;
      mup = g.mu + s * DM;
    }
    auto gload = [&](int kt) {
      const int k0 = kt * 64 + c16 * 8;
#pragma unroll
      for (int i = 0; i < 4; ++i) {
        const int row = rowb + i * 64; const size_t tok = (size_t)(m0 + row);
        if constexpr (LOAD == LOAD_PLAIN) {
          ra[i] = *(const bf16x8*)(g.A + tok * g.lda + k0);
        } else {
          const int pos = (int)(tok % (size_t)g.T);
          const u32x4 c = *(const u32x4*)(g.A + tok * DM + k0);
          u32x4 pv = {0u, 0u, 0u, 0u}, nx = {0u, 0u, 0u, 0u};
          if (pos > 0) pv = *(const u32x4*)(g.A + (tok - 1) * DM + k0);
          if (pos < g.T - 1) nx = *(const u32x4*)(g.A + (tok + 1) * DM + k0);
          const float4 m0v = *(const float4*)(mup + k0), m1v = *(const float4*)(mup + k0 + 4);
          const float mu[8] = {m0v.x, m0v.y, m0v.z, m0v.w, m1v.x, m1v.y, m1v.z, m1v.w};
          u32x4 o;
#pragma unroll
          for (int e = 0; e < 4; ++e) {
            const float h0 = bflo(c[e]), h1 = bfhi(c[e]);
            const float x0 = 0.5f * (bflo(pv[e]) + bflo(nx[e])) - h0, x1 = 0.5f * (bfhi(pv[e]) + bfhi(nx[e])) - h1;
            o[e] = cvtpk(h0 + mu[2 * e] * x0, h1 + mu[2 * e + 1] * x1);
          }
          ra[i] = *(bf16x8*)&o;
        }
      }
#pragma unroll
      for (int i = 0; i < 2; ++i) {
        const int row = rowb + i * 64;
        rb[i] = *(const bf16x8*)(g.Bt + (size_t)(n0 + row) * g.K + k0);
      }
    };
    auto swrite = [&](int b) {
#pragma unroll
      for (int i = 0; i < 4; ++i) { const int row = rowb + i * 64; *(bf16x8*)(sA + b * 32768 + GSWZ(row, c16)) = ra[i]; }
#pragma unroll
      for (int i = 0; i < 2; ++i) { const int row = rowb + i * 64; *(bf16x8*)(sB + b * 16384 + GSWZ(row, c16)) = rb[i]; }
    };
    gload(0); swrite(0); __syncthreads();
    for (int kt = 0; kt < nk; ++kt) {
      const int b = kt & 1;
      if (kt + 1 < nk) gload(kt + 1);
      const char* a_ = sA + b * 32768; const char* b_ = sB + b * 16384;
#pragma unroll
      for (int ks = 0; ks < 4; ++ks) {
        bf16x8 af[2], bfr[2];
#pragma unroll
        for (int mi = 0; mi < 2; ++mi) { const int row = wm * 64 + mi * 32 + r32; af[mi] = *(const bf16x8*)(a_ + GSWZ(row, ks * 2 + hi)); }
#pragma unroll
        for (int ni = 0; ni < 2; ++ni) { const int row = wn * 64 + ni * 32 + r32; bfr[ni] = *(const bf16x8*)(b_ + GSWZ(row, ks * 2 + hi)); }
#pragma unroll
        for (int mi = 0; mi < 2; ++mi)
#pragma unroll
          for (int ni = 0; ni < 2; ++ni) acc[mi][ni] = __builtin_amdgcn_mfma_f32_32x32x16_bf16(af[mi], bfr[ni], acc[mi][ni], 0, 0, 0);
      }
      if (kt + 1 < nk) swrite(b ^ 1);
      __syncthreads();
    }
    if (!g.dry)
#pragma unroll
    for (int mi = 0; mi < 2; ++mi)
#pragma unroll
      for (int ni = 0; ni < 2; ++ni)
#pragma unroll
        for (int r = 0; r < 16; ++r) {
          const size_t m = (size_t)(m0 + wm * 64 + mi * 32 + crow(r, hi));
          const int nl = wn * 64 + ni * 32 + r32, n = n0 + nl;
          const float v = acc[mi][ni][r];
          if constexpr (EPI == EPI_RWKV) {
            if (nt < 64) {
              const int which = nt >> 4, col = (nt & 15) * 128 + nl;
              u16* dst = which == 0 ? g.o0 : which == 1 ? g.o1 : which == 2 ? g.o2 : g.o3;
              dst[m * EI + col] = f2bf(which == 3 ? siluf(v) : v);
            } else if (nt == 64) g.o4[m * 128 + nl] = f2bf(tanhf(v));
            else g.o5[m * 128 + nl] = f2bf(v);
          } else if constexpr (EPI == EPI_RES) {
            g.xout[m * DM + n] = g.xin[m * DM + n] + v;
          } else if constexpr (EPI == EPI_MLAIN) {
            if (n < 704) g.of[m * 704 + n] = v;
            else if (n < ML_N) g.o0[m * EI + (n - 704)] = f2bf(siluf(v));
          } else {
            g.o0[m * g.ldc + n] = f2bf(v);
          }
        }
  }
}

struct ScanP {
  const u16 *r, *k, *v, *twl, *al; u16 *yf, *yb; float* bonus;
  const float *w0, *w2, *a0, *a2, *kk, *ka, *rk;
  int nseq, T;
  float* tbuf; int nseg;
};
template <int CTRL> DEV float dppf(float x) {
  return __int_as_float(__builtin_amdgcn_update_dpp(0, __float_as_int(x), CTRL, 0xF, 0xF, false));
}
DEV float row_prefix16(float x) {
  x += dppf<0x111>(x); x += dppf<0x112>(x); x += dppf<0x114>(x); x += dppf<0x118>(x); return x;
}
DEV float row_total16(float x) {
  x += dppf<0x128>(x); x += dppf<0x124>(x); x += dppf<0x122>(x); x += dppf<0x121>(x); return x;
}
DEV bf16x8 pack8(float a0, float a1, float a2, float a3, float a4, float a5, float a6, float a7) {
  u32x4 w = {cvtpk(a0, a1), cvtpk(a2, a3), cvtpk(a4, a5), cvtpk(a6, a7)}; return *(bf16x8*)&w;
}
constexpr int SC_BKT = 0, SC_UVT = 5120, SC_AKM = 10240, SC_RR = 10752, SC_ABF = 11776, SC_Z = 12800, SC_PRM = 17152, SC_AW = 18944, SC_AA = 27136, SC_T = 35328, SC_PRE = 51712, SC_KR = 55808, SC_WAVE = 59904;
DEV void scan_phase(const ScanP& s, char* lds_, const int pass) {
  const int tid = ltid(), wid = __builtin_amdgcn_readfirstlane(tid >> 6), lane = tid & 63, c16 = lane & 15, q = lane >> 4;
  if (wid >= 2) return;
  char* wl = lds_ + wid * SC_WAVE;
  u16* bkt = (u16*)(wl + SC_BKT); u16* uvt = (u16*)(wl + SC_UVT); u16* akm = (u16*)(wl + SC_AKM); u16* rr = (u16*)(wl + SC_RR);
  float* abf = (float*)(wl + SC_ABF); float* zl = (float*)(wl + SC_Z); float* prm = (float*)(wl + SC_PRM); float* p15l = prm + 320;
  const int nchain = s.nseq * 64, nseg = s.nseg;
  const int nitems = pass == 0 ? nchain * nseg * 2 : nchain * nseg;
  for (int item = wid * gridDim.x + blockIdx.x; item < nitems; item += 2 * gridDim.x) {
    const int kind = pass == 0 ? 1 + (item & 1) : 0;
    const int cs = pass == 0 ? item >> 1 : item;
    const int seg = cs % nseg, chain = cs / nseg;
    const int d = chain & 1, h = (chain >> 1) & 31, b = chain >> 6;
    {
      const int ch = h * 64 + lane;
      lds_wait();
      prm[lane] = s.w0[d * EI + ch]; prm[64 + lane] = s.a0[d * EI + ch]; prm[128 + lane] = s.kk[ch]; prm[192 + lane] = s.ka[ch]; prm[256 + lane] = s.rk[ch];
      lds_wait();
    }
    bf16x8* awl = (bf16x8*)(wl + SC_AW); bf16x8* aal = (bf16x8*)(wl + SC_AA);
#pragma unroll
    for (int ks = 0; ks < 2; ++ks)
#pragma unroll
      for (int mt = 0; mt < 4; ++mt) {
        u32x4 pw, pa;
#pragma unroll
        for (int e = 0; e < 4; ++e) {
          const int l0 = ks * 32 + q * 8 + 2 * e;
          const size_t i0 = ((size_t)(d * 64 + l0)) * EI + h * 64 + mt * 16 + c16;
          pw[e] = cvtpk(s.w2[i0], s.w2[i0 + EI]); pa[e] = cvtpk(s.a2[i0], s.a2[i0 + EI]);
        }
        awl[(ks * 4 + mt) * 64 + lane] = *(bf16x8*)&pw; aal[(ks * 4 + mt) * 64 + lane] = *(bf16x8*)&pa;
      }
    lds_wait();
    const unsigned rowi = (unsigned)(d ? 15 - c16 : c16);
    const unsigned off_tw = rowi * 256u + (unsigned)(q * 16);
    const unsigned off_kr = rowi * 4096u + (unsigned)(h * 128 + q * 8);
    const unsigned off_v  = (unsigned)(h * 128 + lane * 2);
    const unsigned off_y0 = (unsigned)(d ? 15 - 4 * q : 4 * q) * 4096u + (unsigned)(h * 128 + c16 * 2);
    const int ystep = d ? -4096 : 4096;
    f32x4* Tl = (f32x4*)(wl + SC_T);
#pragma unroll
    for (int m = 0; m < 16; ++m) {
      f32x4 t0v = {0.f, 0.f, 0.f, 0.f};
      if (kind == 2) {
        const int mt = m >> 2, nt = m & 3;
        if (mt == nt) { t0v[0] = (4 * q + 0 == c16) ? 1.f : 0.f; t0v[1] = (4 * q + 1 == c16) ? 1.f : 0.f; t0v[2] = (4 * q + 2 == c16) ? 1.f : 0.f; t0v[3] = (4 * q + 3 == c16) ? 1.f : 0.f; }
      } else if (kind == 0 && nseg > 1) {
        t0v = *(const f32x4*)(s.tbuf + ((size_t)cs * 2) * 4096 + (m * 64 + lane) * 4);
      }
      Tl[m * 64 + lane] = t0v;
    }
    u16* yout = d ? s.yb : s.yf;
    const size_t sb = (size_t)b * s.T;
    const int cps = s.T / 16 / nseg, cbeg = seg * cps, cend = cbeg + cps;
    bf16x8 n_tw0, n_tw1, n_ta0, n_ta1; u32x2 n_k[4], n_r[4];
#define SCAN_LOAD(CC) do { const int c0n = d ? (s.T - 16 - (CC) * 16) : (CC) * 16; const size_t t0n = sb + c0n; \
      size_t p_tw = (size_t)s.twl + t0n * 256 + d * 128, p_al = (size_t)s.al + t0n * 256 + d * 128, p_k = (size_t)s.k + t0n * 4096, p_r = (size_t)s.r + t0n * 4096 ; \
      asm volatile("" : "+s"(p_tw), "+s"(p_al), "+s"(p_k), "+s"(p_r)); \
      n_tw0 = gld<bf16x8>(p_tw, off_tw); n_tw1 = gld<bf16x8>(p_tw, off_tw + 64); n_ta0 = gld<bf16x8>(p_al, off_tw); n_ta1 = gld<bf16x8>(p_al, off_tw + 64); \
      _Pragma("unroll") for (int mt = 0; mt < 4; ++mt) { n_k[mt] = gld<u32x2>(p_k, off_kr + mt * 32); n_r[mt] = gld<u32x2>(p_r, off_kr + mt * 32); } } while (0)
    SCAN_LOAD(cbeg);
    for (int cc = cbeg; cc < cend; ++cc) {
      const int c0 = d ? (s.T - 16 - cc * 16) : cc * 16;
      const size_t t0 = sb + c0;
      size_t b_y = (size_t)yout + t0 * 4096, b_bon = (size_t)s.bonus + t0 * 256 + (h * 2 + d) * 4;
      asm volatile("" : "+s"(b_y), "+s"(b_bon));
      size_t b_v = (size_t)s.v + t0 * 4096; asm volatile("" : "+s"(b_v));
      u32x2 n_v[4];
#pragma unroll
      for (int mt = 0; mt < 4; ++mt) n_v[mt] = gld<u32x2>(b_v, off_kr + mt * 32);
      {
        f32x4* wpl = (f32x4*)zl; f32x4* apl = (f32x4*)(wl + SC_PRE);
#pragma unroll
        for (int mt = 0; mt < 4; ++mt) {
          f32x4 cw = {0.f, 0.f, 0.f, 0.f}, ca = {0.f, 0.f, 0.f, 0.f};
          cw = __builtin_amdgcn_mfma_f32_16x16x32_bf16(awl[(0 * 4 + mt) * 64 + lane], n_tw0, cw, 0, 0, 0);
          cw = __builtin_amdgcn_mfma_f32_16x16x32_bf16(awl[(1 * 4 + mt) * 64 + lane], n_tw1, cw, 0, 0, 0);
          ca = __builtin_amdgcn_mfma_f32_16x16x32_bf16(aal[(0 * 4 + mt) * 64 + lane], n_ta0, ca, 0, 0, 0);
          ca = __builtin_amdgcn_mfma_f32_16x16x32_bf16(aal[(1 * 4 + mt) * 64 + lane], n_ta1, ca, 0, 0, 0);
          wpl[mt * 64 + lane] = cw; apl[mt * 64 + lane] = ca;
        }
      }
      float n2 = 0.f;
#pragma unroll
      for (int mt = 0; mt < 4; ++mt) {
        const float4 kkp = *(const float4*)(prm + 128 + mt * 16 + q * 4);
        const float t0 = bflo(n_k[mt][0]) * kkp.x, t1 = bfhi(n_k[mt][0]) * kkp.y, t2 = bflo(n_k[mt][1]) * kkp.z, t3 = bfhi(n_k[mt][1]) * kkp.w;
        n2 += t0 * t0 + t1 * t1 + t2 * t2 + t3 * t3;
      }
      n2 += __shfl_xor(n2, 16, 64); n2 += __shfl_xor(n2, 32, 64);
      const float invn = __builtin_amdgcn_rsqf(fmaxf(n2, 1e-24f));
      float bon = 0.f;
      bf16x8 ktf[2], btf[2], kdf[2], rtf[2];
#pragma unroll
      for (int ks = 0; ks < 2; ++ks) {
        float ktl[8], btl[8], kdl[8], rtl[8];
#pragma unroll
        for (int mh = 0; mh < 2; ++mh) {
          const int mt = 2 * ks + mh;
          const f32x4 cw = ((const f32x4*)zl)[mt * 64 + lane], ca = ((const f32x4*)(wl + SC_PRE))[mt * 64 + lane];
          const float4 w0p = *(const float4*)(prm + mt * 16 + q * 4), a0p = *(const float4*)(prm + 64 + mt * 16 + q * 4);
          const float4 kkp = *(const float4*)(prm + 128 + mt * 16 + q * 4), kap = *(const float4*)(prm + 192 + mt * 16 + q * 4), rkp = *(const float4*)(prm + 256 + mt * 16 + q * 4);
          const float w0a[4] = {w0p.x, w0p.y, w0p.z, w0p.w}, a0a[4] = {a0p.x, a0p.y, a0p.z, a0p.w};
          const float kka[4] = {kkp.x, kkp.y, kkp.z, kkp.w}, kaa[4] = {kap.x, kap.y, kap.z, kap.w}, rka[4] = {rkp.x, rkp.y, rkp.z, rkp.w};
          const u32x2 kr_ = n_k[mt], rr_ = n_r[mt];
          const float kxa[4] = {bflo(kr_[0]), bfhi(kr_[0]), bflo(kr_[1]), bfhi(kr_[1])};
          const float rxa[4] = {bflo(rr_[0]), bfhi(rr_[0]), bflo(rr_[1]), bfhi(rr_[1])};
          float4 p15v;
#pragma unroll
          for (int e = 0; e < 4; ++e) {
            const float wp = cw[e] + w0a[e], ap = ca[e] + a0a[e];
            const float ee = 0.6065306597126334f * __builtin_amdgcn_rcpf(1.f + __expf(-wp));
            const float a = __builtin_amdgcn_rcpf(1.f + __expf(-ap));
            const float kkn = kxa[e] * kka[e] * invn;
            const float kd = kxa[e] * (1.f + (a - 1.f) * kaa[e]);
            const float bb = kkn * a;
            bon += rxa[e] * kd * rka[e];
            const float Ei = row_prefix16(ee), Et = row_total16(ee);
            const float pm = __expf(-Ei), pp = __builtin_amdgcn_rcpf(pm), pm1 = __expf(ee - Ei);
            ktl[mh * 4 + e] = kkn * pm1; btl[mh * 4 + e] = bb * pp; kdl[mh * 4 + e] = kd * pp; rtl[mh * 4 + e] = rxa[e] * pm;
            ((float*)&p15v)[e] = __expf(-Et);
            const int j = mt * 16 + q * 4 + e;
            bkt[j * 40 + c16] = f2bf(btl[mh * 4 + e]); bkt[j * 40 + 16 + c16] = f2bf(kdl[mh * 4 + e]);
          }
          if (c16 == 0) *(float4*)(p15l + mt * 16 + q * 4) = p15v;
          SBAR();
        }
        ktf[ks] = pack8(ktl[0], ktl[1], ktl[2], ktl[3], ktl[4], ktl[5], ktl[6], ktl[7]);
        btf[ks] = pack8(btl[0], btl[1], btl[2], btl[3], btl[4], btl[5], btl[6], btl[7]);
        kdf[ks] = pack8(kdl[0], kdl[1], kdl[2], kdl[3], kdl[4], kdl[5], kdl[6], kdl[7]);
        rtf[ks] = pack8(rtl[0], rtl[1], rtl[2], rtl[3], rtl[4], rtl[5], rtl[6], rtl[7]);
      }
      bon += __shfl_xor(bon, 16, 64); bon += __shfl_xor(bon, 32, 64);
      if (q == 0 && kind == 0) gst<float>(b_bon, off_tw, bon);
      SBAR();
      SBAR();
#pragma unroll
      for (int mt = 0; mt < 4; ++mt) {
        const int vb_ = (mt * 16 + q * 4) * 40 + 16 + c16;
        const unsigned v0_ = kind == 2 ? 0u : n_v[mt][0], v1_ = kind == 2 ? 0u : n_v[mt][1];
        uvt[vb_] = (u16)(v0_ & 0xffffu); uvt[vb_ + 40] = (u16)(v0_ >> 16);
        uvt[vb_ + 80] = (u16)(v1_ & 0xffffu); uvt[vb_ + 120] = (u16)(v1_ >> 16);
      }
      { const int cn = cc + 1 < cend ? cc + 1 : cc; SCAN_LOAD(cn); }
      SBAR();
      {
        f32x4 AB = {0.f, 0.f, 0.f, 0.f}, AK = AB, RB = AB, RK = AB;
        int qm = q; asm volatile("" : "+v"(qm));
#pragma unroll
        for (int ks = 0; ks < 2; ++ks) {
          AB = __builtin_amdgcn_mfma_f32_16x16x32_bf16(ktf[ks], btf[ks], AB, 0, 0, 0);
          AK = __builtin_amdgcn_mfma_f32_16x16x32_bf16(ktf[ks], kdf[ks], AK, 0, 0, 0);
          RB = __builtin_amdgcn_mfma_f32_16x16x32_bf16(rtf[ks], btf[ks], RB, 0, 0, 0);
          RK = __builtin_amdgcn_mfma_f32_16x16x32_bf16(rtf[ks], kdf[ks], RK, 0, 0, 0);
        }
#pragma unroll
        for (int r = 0; r < 4; ++r) {
          const int i = 4 * qm + r;
          const bool lo = c16 < i, le = c16 <= i;
          abf[i * 16 + c16] = lo ? AB[r] : 0.f;
          akm[i * 16 + c16] = f2bf(lo ? AK[r] : 0.f);
          rr[i * 32 + c16] = f2bf(le ? RB[r] : 0.f);
          rr[i * 32 + 16 + c16] = f2bf(le ? RK[r] : 0.f);
        }
      }
#define TFRAG(ks, nt, OUT) do { const f32x4 ta_ = Tl[((2 * (ks)) * 4 + (nt)) * 64 + lane], tb_ = Tl[((2 * (ks) + 1) * 4 + (nt)) * 64 + lane]; \
        OUT = pack8(ta_[0], ta_[1], ta_[2], ta_[3], tb_[0], tb_[1], tb_[2], tb_[3]); } while (0)
      lds_wait();
      {
        bf16x8 akf = {0, 0, 0, 0, 0, 0, 0, 0};
        if (q < 2) akf = *(const bf16x8*)(akm + c16 * 16 + q * 8);
#pragma unroll
        for (int nt = 0; nt < 4; ++nt) {
          f32x4 z = {0.f, 0.f, 0.f, 0.f};
          bf16x8 tf0, tf1; TFRAG(0, nt, tf0); TFRAG(1, nt, tf1);
          z = __builtin_amdgcn_mfma_f32_16x16x32_bf16(ktf[0], tf0, z, 0, 0, 0);
          z = __builtin_amdgcn_mfma_f32_16x16x32_bf16(ktf[1], tf1, z, 0, 0, 0);
          const bf16x8 vf = *(const bf16x8*)(uvt + (nt * 16 + c16) * 40 + 16 + (q & 1) * 8);
          z = __builtin_amdgcn_mfma_f32_16x16x32_bf16(akf, vf, z, 0, 0, 0);
#pragma unroll
          for (int r = 0; r < 4; ++r) zl[(4 * q + r) * 68 + nt * 16 + c16] = z[r];
        }
      }
      lds_wait();
      SBAR();
      {
        float U[16];
#pragma unroll
        for (int i = 0; i < 16; ++i) {
          float acc = -zl[i * 68 + lane];
#pragma unroll
          for (int s4 = 0; s4 < (i + 3) / 4; ++s4) {
            const float4 a4 = *(const float4*)(abf + i * 16 + s4 * 4);
            if (s4 * 4 + 0 < i) acc -= a4.x * U[s4 * 4 + 0];
            if (s4 * 4 + 1 < i) acc -= a4.y * U[s4 * 4 + 1];
            if (s4 * 4 + 2 < i) acc -= a4.z * U[s4 * 4 + 2];
            if (s4 * 4 + 3 < i) acc -= a4.w * U[s4 * 4 + 3];
          }
          U[i] = acc;
          if ((i & 3) == 3) SBAR();
        }
        *(bf16x8*)(uvt + lane * 40) = pack8(U[0], U[1], U[2], U[3], U[4], U[5], U[6], U[7]);
        *(bf16x8*)(uvt + lane * 40 + 8) = pack8(U[8], U[9], U[10], U[11], U[12], U[13], U[14], U[15]);
      }
      lds_wait();
      SBAR();
      {
        const bf16x8 rrf = *(const bf16x8*)(rr + c16 * 32 + q * 8);
        bf16x8 uvf[4];
#pragma unroll
        for (int nt = 0; nt < 4; ++nt) uvf[nt] = *(const bf16x8*)(uvt + (nt * 16 + c16) * 40 + q * 8);
#pragma unroll
        for (int nt = 0; nt < 4; ++nt) {
          f32x4 y = {0.f, 0.f, 0.f, 0.f};
          bf16x8 tf0, tf1; TFRAG(0, nt, tf0); TFRAG(1, nt, tf1);
          y = __builtin_amdgcn_mfma_f32_16x16x32_bf16(rtf[0], tf0, y, 0, 0, 0);
          y = __builtin_amdgcn_mfma_f32_16x16x32_bf16(rtf[1], tf1, y, 0, 0, 0);
          y = __builtin_amdgcn_mfma_f32_16x16x32_bf16(rrf, uvf[nt], y, 0, 0, 0);
#pragma unroll
          for (int r = 0; r < 4; ++r) { if (kind == 0) gst<u16>(b_y, off_y0 + (unsigned)(r * ystep) + nt * 32, f2bf(y[r])); }
        }
#pragma unroll
        for (int mt = 0; mt < 4; ++mt) {
          const bf16x8 bkf = *(const bf16x8*)(bkt + (mt * 16 + c16) * 40 + q * 8);
          const float4 pq = *(const float4*)(p15l + mt * 16 + q * 4);
#pragma unroll
          for (int nt = 0; nt < 4; ++nt) {
            f32x4 t = __builtin_amdgcn_mfma_f32_16x16x32_bf16(bkf, uvf[nt], Tl[(mt * 4 + nt) * 64 + lane], 0, 0, 0);
            t[0] *= pq.x; t[1] *= pq.y; t[2] *= pq.z; t[3] *= pq.w;
            Tl[(mt * 4 + nt) * 64 + lane] = t;
          }
        }
      }
      lds_wait();
    }
    if (pass == 0) {
      float* dst = s.tbuf + ((size_t)cs * 2 + (kind - 1)) * 4096;
#pragma unroll
      for (int m = 0; m < 16; ++m) *(f32x4*)(dst + (m * 64 + lane) * 4) = Tl[m * 64 + lane];
    }
  }
}

DEV void scan_combine_phase(const ScanP& s, char* lds_) {
  const int tid = ltid(), wid = __builtin_amdgcn_readfirstlane(tid >> 6), lane = tid & 63, c16 = lane & 15, q = lane >> 4;
  if (wid >= 2) return;
  float* til = (float*)(lds_ + wid * 16384);
  const int nchain = s.nseq * 64, nseg = s.nseg;
  for (int chain = wid * gridDim.x + blockIdx.x; chain < nchain; chain += 2 * gridDim.x) {
    f32x4 T[16];
#pragma unroll
    for (int m = 0; m < 16; ++m) T[m] = f32x4{0.f, 0.f, 0.f, 0.f};
    for (int seg = 0; seg < nseg; ++seg) {
      float* tn = s.tbuf + ((size_t)(chain * nseg + seg) * 2) * 4096; const float* ti = tn + 4096;
      lds_wait();
#pragma unroll
      for (int m = 0; m < 16; ++m) *(f32x4*)(til + (m * 64 + lane) * 4) = *(const f32x4*)(ti + (m * 64 + lane) * 4);
      lds_wait();
      f32x4 Tn[16];
#pragma unroll
      for (int m = 0; m < 16; ++m) Tn[m] = *(const f32x4*)(tn + (m * 64 + lane) * 4);
#pragma unroll
      for (int nt = 0; nt < 4; ++nt) {
        bf16x8 bh[2], bl[2];
#pragma unroll
        for (int ks = 0; ks < 2; ++ks) {
          const f32x4 ta = T[(2 * ks) * 4 + nt], tb = T[(2 * ks + 1) * 4 + nt];
          const float x[8] = {ta[0], ta[1], ta[2], ta[3], tb[0], tb[1], tb[2], tb[3]};
          float hf[8], lf[8];
#pragma unroll
          for (int e = 0; e < 8; ++e) { hf[e] = bf2f(f2bf(x[e])); lf[e] = x[e] - hf[e]; }
          bh[ks] = pack8(hf[0], hf[1], hf[2], hf[3], hf[4], hf[5], hf[6], hf[7]);
          bl[ks] = pack8(lf[0], lf[1], lf[2], lf[3], lf[4], lf[5], lf[6], lf[7]);
        }
#pragma unroll
        for (int mt = 0; mt < 4; ++mt) {
          f32x4 acc = Tn[mt * 4 + nt];
#pragma unroll
          for (int ks = 0; ks < 2; ++ks) {
            float x[8];
#pragma unroll
            for (int e = 0; e < 8; ++e) x[e] = til[((mt * 4 + 2 * ks + (e >> 2)) * 64 + ((c16 >> 2) & 3) * 16 + 4 * q + (e & 3)) * 4 + (c16 & 3)];
            float hf[8], lf[8];
#pragma unroll
            for (int e = 0; e < 8; ++e) { hf[e] = bf2f(f2bf(x[e])); lf[e] = x[e] - hf[e]; }
            const bf16x8 ah = pack8(hf[0], hf[1], hf[2], hf[3], hf[4], hf[5], hf[6], hf[7]);
            const bf16x8 al = pack8(lf[0], lf[1], lf[2], lf[3], lf[4], lf[5], lf[6], lf[7]);
            acc = __builtin_amdgcn_mfma_f32_16x16x32_bf16(ah, bh[ks], acc, 0, 0, 0);
            acc = __builtin_amdgcn_mfma_f32_16x16x32_bf16(ah, bl[ks], acc, 0, 0, 0);
            acc = __builtin_amdgcn_mfma_f32_16x16x32_bf16(al, bh[ks], acc, 0, 0, 0);
          }
          Tn[mt * 4 + nt] = acc;
        }
      }
#pragma unroll
      for (int m = 0; m < 16; ++m) { *(f32x4*)(tn + (m * 64 + lane) * 4) = T[m]; T[m] = Tn[m]; }
    }
  }
}

DEV void post_phase(u16* __restrict__ yf, const u16* __restrict__ yb, const u16* __restrict__ v, const u16* __restrict__ sg,
                    const float* __restrict__ bonus, const float* __restrict__ lg, const float* __restrict__ lb) {
  const int tid_ = ltid(); const int lane = tid_ & 63, wid = __builtin_amdgcn_readfirstlane(tid_ >> 6);
  for (int tok = blockIdx.x * 8 + wid; tok < GT; tok += gridDim.x * 8) {
#pragma unroll
    for (int it = 0; it < 4; ++it) {
      const int ch0 = it * 512 + lane * 8, h = ch0 >> 6; const size_t i = (size_t)tok * EI + ch0;
      const u32x4 a = *(const u32x4*)(yf + i), bq = *(const u32x4*)(yb + i), vv = *(const u32x4*)(v + i), gg = *(const u32x4*)(sg + i);
      const float2 bo = *(const float2*)(bonus + ((size_t)tok * 32 + h) * 2);
      float y[8]; float sum = 0.f;
#pragma unroll
      for (int e = 0; e < 4; ++e) { y[2 * e] = bflo(a[e]) + bflo(bq[e]); y[2 * e + 1] = bfhi(a[e]) + bfhi(bq[e]); sum += y[2 * e] + y[2 * e + 1]; }
      sum += __shfl_xor(sum, 1, 64); sum += __shfl_xor(sum, 2, 64); sum += __shfl_xor(sum, 4, 64);
      const float mean = sum * (1.f / 64.f);
      float var = 0.f;
#pragma unroll
      for (int e = 0; e < 8; ++e) { y[e] -= mean; var += y[e] * y[e]; }
      var += __shfl_xor(var, 1, 64); var += __shfl_xor(var, 2, 64); var += __shfl_xor(var, 4, 64);
      const float rs = rsqrtf(var * (1.f / 64.f) + 64e-5f), bon = bo.x + bo.y;
      const float4 g0 = *(const float4*)(lg + ch0), g1 = *(const float4*)(lg + ch0 + 4), b0 = *(const float4*)(lb + ch0), b1 = *(const float4*)(lb + ch0 + 4);
      const float ga[8] = {g0.x, g0.y, g0.z, g0.w, g1.x, g1.y, g1.z, g1.w}, ba[8] = {b0.x, b0.y, b0.z, b0.w, b1.x, b1.y, b1.z, b1.w};
      u32x4 o;
#pragma unroll
      for (int e = 0; e < 4; ++e) {
        const float o0 = (y[2 * e] * rs * ga[2 * e] + ba[2 * e] + bon * bflo(vv[e])) * bflo(gg[e]);
        const float o1 = (y[2 * e + 1] * rs * ga[2 * e + 1] + ba[2 * e + 1] + bon * bfhi(vv[e])) * bfhi(gg[e]);
        o[e] = cvtpk(o0, o1);
      }
      *(u32x4*)(yf + i) = o;
    }
  }
}

DEV void mla_mid_phase(const float* __restrict__ cqkv, const float* __restrict__ qn, const float* __restrict__ kvn,
                       const float* __restrict__ ct, const float* __restrict__ st,
                       u16* __restrict__ cqn, u16* __restrict__ ckvn, u16* __restrict__ kpe, int T) {
  const int tid_ = ltid(); const int lane = tid_ & 63, wid = __builtin_amdgcn_readfirstlane(tid_ >> 6);
  for (int tok = blockIdx.x * 8 + wid; tok < GT; tok += gridDim.x * 8) {
    const float* row = cqkv + (size_t)tok * 704;
    float q[6], ss = 0.f;
#pragma unroll
    for (int i = 0; i < 6; ++i) { q[i] = row[lane + i * 64]; ss += q[i] * q[i]; }
    ss = wsum(ss); float sc = rsqrtf(ss * (1.f / 384.f) + 1e-6f);
#pragma unroll
    for (int i = 0; i < 6; ++i) cqn[(size_t)tok * 384 + lane + i * 64] = f2bf(q[i] * sc * qn[lane + i * 64]);
    float c[4]; ss = 0.f;
#pragma unroll
    for (int i = 0; i < 4; ++i) { c[i] = row[384 + lane + i * 64]; ss += c[i] * c[i]; }
    ss = wsum(ss); sc = rsqrtf(ss * (1.f / 256.f) + 1e-6f);
#pragma unroll
    for (int i = 0; i < 4; ++i) ckvn[(size_t)tok * 256 + lane + i * 64] = f2bf(c[i] * sc * kvn[lane + i * 64]);
    const float x = row[640 + lane];
    const float xo = __shfl_xor(x, 32, 64);
    const int pos = tok % T, j = lane & 31;
    const float cs = ct[pos * 32 + j], sn = st[pos * 32 + j];
    const float o = lane < 32 ? x * cs - xo * sn : x * cs + xo * sn;
    kpe[(size_t)tok * 64 + lane] = f2bf(o);
  }
}

constexpr int SHM_V = 16384, SHM_K = 16384, SHM_KP = 8192;
#define KSWZ(row, colB) ((row) * 256 + ((colB) ^ (((row) & 7) << 4)))
#define KPSWZ(row, colB) ((row) * 128 + ((colB) ^ (((row) & 7) << 4)))
constexpr float ATT_SCALE = 0.07216878364870322f;
DEV void partialSM(f32x16& p0, f32x16& p1, float& m_reg, float& mn, float& alpha) {
  constexpr float C = ATT_SCALE * 1.4426950408889634f;
  float pmax = p0[0];
#pragma unroll
  for (int r = 1; r < 16; ++r) pmax = fmaxf(pmax, p0[r]);
#pragma unroll
  for (int r = 0; r < 16; ++r) pmax = fmaxf(pmax, p1[r]);
  { auto rr = __builtin_amdgcn_permlane32_swap(__float_as_uint(pmax), __float_as_uint(pmax), false, false);
    pmax = fmaxf(__uint_as_float(rr[0]), __uint_as_float(rr[1])); }
  mn = fmaxf(m_reg, pmax); alpha = __builtin_amdgcn_exp2f((m_reg - mn) * C); m_reg = mn;
  const float mnC = -mn * C;
#pragma unroll
  for (int r = 0; r < 16; ++r) p0[r] = __builtin_amdgcn_exp2f(fmaf(p0[r], C, mnC));
#pragma unroll
  for (int r = 0; r < 16; ++r) p1[r] = __builtin_amdgcn_exp2f(fmaf(p1[r], C, mnC));
}
DEV void finishSM(f32x16& p0, f32x16& p1, float alpha, float& l_reg, bf16x8& pa0, bf16x8& pa1, bf16x8& pa2, bf16x8& pa3) {
  float ps = 0;
#pragma unroll
  for (int r = 0; r < 16; ++r) ps += p0[r];
#pragma unroll
  for (int r = 0; r < 16; ++r) ps += p1[r];
  { auto rr = __builtin_amdgcn_permlane32_swap(__float_as_uint(ps), __float_as_uint(ps), false, false);
    ps = __uint_as_float(rr[0]) + __uint_as_float(rr[1]); }
  l_reg = l_reg * alpha + ps;
#define PK4(PP, BASE, OUT) do { unsigned a0 = cvtpk(PP[BASE + 0], PP[BASE + 1]), a1 = cvtpk(PP[BASE + 2], PP[BASE + 3]);   \
    unsigned b0 = cvtpk(PP[BASE + 4], PP[BASE + 5]), b1 = cvtpk(PP[BASE + 6], PP[BASE + 7]);                              \
    auto r0 = __builtin_amdgcn_permlane32_swap(a0, b0, false, false); auto r1 = __builtin_amdgcn_permlane32_swap(a1, b1, false, false); \
    u32x4 w = {r0[0], r1[0], r0[1], r1[1]}; OUT = *reinterpret_cast<bf16x8*>(&w); } while (0)
  PK4(p0, 0, pa0); PK4(p0, 8, pa1); PK4(p1, 0, pa2); PK4(p1, 8, pa3);
#undef PK4
}
DEV int v_st(int k, int c) { const int kk = (k & ~0xC) | ((k & 4) << 1) | ((k & 8) >> 1); return ((kk >> 3) * 4 + (c >> 5)) * 512 + ((kk & 7) * 32 + (c & 31)) * 2; }
DEV int v_rd_base(int lane) { return ((lane & 3) << 3) | (((lane >> 2) & 3) << 6) | (((lane >> 4) & 1) << 5) | (((lane >> 5) & 1) << 8); }
constexpr int v_rd_off(int d0, int ks, int half) { return d0 * 512 + ks * 4096 + half * 2048; }
template <int OFF> DEV s16x4 tr_read(int vb) {
  s16x4 r; asm volatile("ds_read_b64_tr_b16 %0, %1 offset:%2" : "=&v"(r) : "v"(vb), "i"(OFF) : "memory"); return r;
}
template <int D0> DEV void pv_one(f32x16& od, int vb, bf16x8 pa0, bf16x8 pa1, bf16x8 pa2, bf16x8 pa3) {
  const s16x4 l0 = tr_read<v_rd_off(D0, 0, 0)>(vb), h0 = tr_read<v_rd_off(D0, 0, 1)>(vb), l1 = tr_read<v_rd_off(D0, 1, 0)>(vb), h1 = tr_read<v_rd_off(D0, 1, 1)>(vb);
  const s16x4 l2 = tr_read<v_rd_off(D0, 2, 0)>(vb), h2 = tr_read<v_rd_off(D0, 2, 1)>(vb), l3 = tr_read<v_rd_off(D0, 3, 0)>(vb), h3 = tr_read<v_rd_off(D0, 3, 1)>(vb);
  asm volatile("s_waitcnt lgkmcnt(0)" ::: "memory"); SBAR();
#define PK(L, H) (bf16x8){L[0], L[1], L[2], L[3], H[0], H[1], H[2], H[3]}
  od = __builtin_amdgcn_mfma_f32_32x32x16_bf16(pa0, PK(l0, h0), od, 0, 0, 0);
  od = __builtin_amdgcn_mfma_f32_32x32x16_bf16(pa1, PK(l1, h1), od, 0, 0, 0);
  od = __builtin_amdgcn_mfma_f32_32x32x16_bf16(pa2, PK(l2, h2), od, 0, 0, 0);
  od = __builtin_amdgcn_mfma_f32_32x32x16_bf16(pa3, PK(l3, h3), od, 0, 0, 0);
#undef PK
}

struct AttnP { const u16* q; const u16* kv; const u16* kpe; u16* sg; const float* ct; const float* st; int nseq, T; int dry; };
DEV void attn_phase(const AttnP& a, char* lds) {
  const int tid = ltid(), wid = tid >> 6, lane = tid & 63, r32 = lane & 31, hi = lane >> 5;
  char* V_lds = lds; char* K_lds = lds + 2 * SHM_V; char* KP_lds = lds + 2 * SHM_V + 2 * SHM_K;
  float* wsc = (float*)(lds + 2 * SHM_V + 2 * SHM_K + 2 * SHM_KP) + wid * 64; float* li_l = wsc; float* al_l = wsc + 32;
  const int nqb = a.T / 256, nitems = a.nseq * 16 * nqb, NT = a.T / 64;
  const int sr = tid >> 4, sc = (tid & 15) * 8, vst0 = v_st(sr, sc), vst1 = v_st(32 + sr, sc);
  const int pr = tid >> 3, pc = (tid & 7) * 8;
  const int vb0 = (int)(uintptr_t)V_lds + v_rd_base(lane);
  int kad[4], kpd[4];
#pragma unroll
  for (int q = 0; q < 4; ++q) { kad[q] = KSWZ(r32, q * 32 + hi * 16); kpd[q] = KPSWZ(r32, q * 32 + hi * 16); }
  for (int it = blockIdx.x; it < nitems; it += gridDim.x) {
    const int qb = it % nqb, h = (it / nqb) & 15, b = it / (nqb * 16);
    const size_t sbase = (size_t)b * a.T;
    const int pos = qb * 256 + wid * 32 + r32;
    bf16x8 qr[12];
    {
      const u16* Qw = a.q + (sbase + pos) * 3072 + h * 192 + hi * 8;
#pragma unroll
      for (int d0 = 0; d0 < 12; ++d0) qr[d0] = *(const bf16x8*)(Qw + d0 * 16);
#pragma unroll
      for (int dd = 0; dd < 2; ++dd) {
        const int j0 = dd * 16 + hi * 8;
        const float4 c0 = *(const float4*)(a.ct + pos * 32 + j0), c1 = *(const float4*)(a.ct + pos * 32 + j0 + 4);
        const float4 s0 = *(const float4*)(a.st + pos * 32 + j0), s1 = *(const float4*)(a.st + pos * 32 + j0 + 4);
        const float cs[8] = {c0.x, c0.y, c0.z, c0.w, c1.x, c1.y, c1.z, c1.w};
        const float sn[8] = {s0.x, s0.y, s0.z, s0.w, s1.x, s1.y, s1.z, s1.w};
        u32x4 x1 = *(u32x4*)&qr[8 + dd], x2 = *(u32x4*)&qr[10 + dd], y1, y2;
#pragma unroll
        for (int e = 0; e < 4; ++e) {
          const float a0 = bflo(x1[e]), a1 = bfhi(x1[e]), b0 = bflo(x2[e]), b1 = bfhi(x2[e]);
          y1[e] = cvtpk(a0 * cs[2 * e] - b0 * sn[2 * e], a1 * cs[2 * e + 1] - b1 * sn[2 * e + 1]);
          y2[e] = cvtpk(b0 * cs[2 * e] + a0 * sn[2 * e], b1 * cs[2 * e + 1] + a1 * sn[2 * e + 1]);
        }
        qr[8 + dd] = *(bf16x8*)&y1; qr[10 + dd] = *(bf16x8*)&y2;
      }
    }
    float m_reg = -1e30f, l_reg = 0.f; f32x16 o[4] = {};
    bf16x8 vs0, vs1, ks0, ks1, kp0;
    const u16* kvh = a.kv + sbase * 4096 + h * 256;
    const u16* kph = a.kpe + sbase * 64;
    const unsigned voff = (unsigned)(sr * 8192 + sc * 2), poff = (unsigned)(pr * 128 + pc * 2);
#define SLOAD(k0) do { const char* bK0 = (const char*)kvh + (size_t)(k0) * 8192; const char* bK1 = bK0 + 32 * 8192; const char* bP = (const char*)kph + (size_t)(k0) * 128; \
    vs0 = *(const bf16x8*)(bK0 + voff + 256); vs1 = *(const bf16x8*)(bK1 + voff + 256); \
    ks0 = *(const bf16x8*)(bK0 + voff); ks1 = *(const bf16x8*)(bK1 + voff); \
    kp0 = *(const bf16x8*)(bP + poff); } while (0)
#define SWRITE(bb) do { *(bf16x8*)(V_lds + (bb) * SHM_V + vst0) = vs0; *(bf16x8*)(V_lds + (bb) * SHM_V + vst1) = vs1; \
    *(bf16x8*)(K_lds + (bb) * SHM_K + KSWZ(sr, sc * 2)) = ks0; *(bf16x8*)(K_lds + (bb) * SHM_K + KSWZ(32 + sr, sc * 2)) = ks1; \
    *(bf16x8*)(KP_lds + (bb) * SHM_KP + KPSWZ(pr, pc * 2)) = kp0; } while (0)
    __syncthreads();
    SLOAD(0); SWRITE(0); __syncthreads();
    for (int j = 0; j < NT; ++j) {
      const int bb = j & 1;
      if (j + 1 < NT) SLOAD((j + 1) * 64);
      SBAR();
      f32x16 p0 = {}, p1 = {};
      {
        const char* Ks = K_lds + bb * SHM_K; const char* Kp = KP_lds + bb * SHM_KP;
#pragma unroll
        for (int d0 = 0; d0 < 8; ++d0) {
          const bf16x8 b0 = *(const bf16x8*)(Ks + kad[d0 & 3] + (d0 >> 2) * 128), b1 = *(const bf16x8*)(Ks + kad[d0 & 3] + (d0 >> 2) * 128 + 8192);
          p0 = __builtin_amdgcn_mfma_f32_32x32x16_bf16(b0, qr[d0], p0, 0, 0, 0);
          p1 = __builtin_amdgcn_mfma_f32_32x32x16_bf16(b1, qr[d0], p1, 0, 0, 0); }
#pragma unroll
        for (int d0 = 0; d0 < 4; ++d0) {
          const bf16x8 b0 = *(const bf16x8*)(Kp + kpd[d0]), b1 = *(const bf16x8*)(Kp + kpd[d0] + 4096);
          p0 = __builtin_amdgcn_mfma_f32_32x32x16_bf16(b0, qr[8 + d0], p0, 0, 0, 0);
          p1 = __builtin_amdgcn_mfma_f32_32x32x16_bf16(b1, qr[8 + d0], p1, 0, 0, 0); }
      }
      float mn, alpha;
      partialSM(p0, p1, m_reg, mn, alpha);
      if (__any(alpha < 1.f)) {
        if (hi == 0) al_l[r32] = alpha;
        lds_wait();
#pragma unroll
        for (int dd = 0; dd < 4; ++dd)
#pragma unroll
          for (int r = 0; r < 16; ++r) o[dd][r] *= al_l[crow(r, hi)];
      }
      bf16x8 pa0, pa1, pa2, pa3;
      finishSM(p0, p1, alpha, l_reg, pa0, pa1, pa2, pa3); SBAR();
      const int vb = vb0 + bb * SHM_V;
      pv_one<0>(o[0], vb, pa0, pa1, pa2, pa3); pv_one<1>(o[1], vb, pa0, pa1, pa2, pa3);
      pv_one<2>(o[2], vb, pa0, pa1, pa2, pa3); pv_one<3>(o[3], vb, pa0, pa1, pa2, pa3);
      if (j + 1 < NT) SWRITE(bb ^ 1);
      __syncthreads();
    }
#undef SLOAD
#undef SWRITE
    {
      int t2 = threadIdx.x; asm volatile("" : "+v"(t2));
      const int wid2 = t2 >> 6, r2 = t2 & 31, hi2 = (t2 >> 5) & 1;
      float* li2 = (float*)(lds + 2 * SHM_V + 2 * SHM_K + 2 * SHM_KP) + wid2 * 64;
      if (hi2 == 0) li2[r2] = l_reg;
      lds_wait();
      u16* Ow = a.sg + (sbase + qb * 256 + wid2 * 32) * EI + h * 128 + r2;
#pragma unroll
      for (int r = 0; r < 16; ++r) {
        const int orow = crow(r, hi2);
        const float rl = __builtin_amdgcn_rcpf(li2[orow]);
#pragma unroll
        for (int d0 = 0; d0 < 4; ++d0) {
          u16* pp = Ow + (size_t)orow * EI + d0 * 32;
          if (!a.dry) *pp = f2bf(o[d0][r] * rl * bf2f(*pp));
        }
      }
    }
  }
}

#if MEGA
#define GRID_SYNC() gsync(p, lds)
#else
#define GRID_SYNC() do {} while (0)
#endif
struct Grp { const float* xin0; float* xres; int nseq, T; };
DEV Grp get_group(const P& p, int g) {
  Grp r;
  r.xin0 = g == 0 ? p.x_prompt : p.x_sample + (size_t)(g - 1) * GT * DM;
  r.xres = p.out + (size_t)g * GT * DM;
  r.nseq = g == 0 ? 8 : 1; r.T = g == 0 ? 2048 : 16384;
  return r;
}
template <int LT, int ph>
DEV void run_phase(const P& p, int g, int layer, char* lds) {
  const Grp G = get_group(p, g);
  const int j = layer >> 1;
  const float* xin = layer == 0 ? G.xin0 : G.xres;
  size_t zoff = 0; asm volatile("" : "+s"(zoff));
  char* ws = p.ws + zoff;
  u16* hbuf = (u16*)(ws + O_HBUF);
  u16* sg = (u16*)(ws + O_SG);
  if constexpr (LT == 0) {
    u16 *rb = (u16*)(ws + O_RB), *kb = (u16*)(ws + O_KB), *vb = (u16*)(ws + O_VB), *yf = (u16*)(ws + O_YF), *yb = (u16*)(ws + O_YB);
    u16 *twl = (u16*)(ws + O_TWL), *al = (u16*)(ws + O_AL); float* bon = (float*)(ws + O_BON);
    if constexpr (ph == 0) rms_phase(xin, p.ln_g + layer * DM, hbuf);
    else if constexpr (ph == 1) {
      GemmP q{}; q.A = hbuf; q.lda = DM; q.Bt = (const u16*)(ws + O_WRWIN) + (size_t)j * RW_N * DM; q.K = DM; q.NT = 66;
      q.mu = p.rw_mu + (size_t)j * 6 * DM; q.T = G.T; q.o0 = rb; q.o1 = kb; q.o2 = vb; q.o3 = sg; q.o4 = twl; q.o5 = al;
      for (int rep = 1; rep < REP_GEMM; ++rep) { q.dry = (gridDim.x != 12345); gemm_phase<LOAD_LERP, EPI_RWKV>(q, lds); } q.dry = 0;
      gemm_phase<LOAD_LERP, EPI_RWKV>(q, lds);
    } else if constexpr (ph == 2) {
      ScanP s{}; s.r = rb; s.k = kb; s.v = vb; s.twl = twl; s.al = al; s.yf = yf; s.yb = yb; s.bonus = bon;
      s.w0 = p.rw_w0 + (size_t)j * 2 * EI; s.w2 = p.rw_w2 + (size_t)j * 2 * 64 * EI; s.a0 = p.rw_a0 + (size_t)j * 2 * EI; s.a2 = p.rw_a2 + (size_t)j * 2 * 64 * EI;
      s.kk = p.rw_kk + (size_t)j * EI; s.ka = p.rw_ka + (size_t)j * EI; s.rk = p.rw_rk + (size_t)j * EI; s.nseq = G.nseq; s.T = G.T;
      s.tbuf = (float*)hbuf;
      if (G.T > 2048) {
        s.nseg = 16;
        scan_phase(s, lds, 0); GRID_SYNC();
        scan_combine_phase(s, lds); GRID_SYNC();
        scan_phase(s, lds, 1);
      } else { s.nseg = 1; scan_phase(s, lds, 1); }
    } else if constexpr (ph == 3) post_phase(yf, yb, vb, sg, bon, p.rw_lnx_g + (size_t)j * EI, p.rw_lnx_b + (size_t)j * EI);
    else {
      GemmP q{}; q.A = yf; q.lda = EI; q.Bt = (const u16*)(ws + O_WRWOUT) + (size_t)j * DM * EI; q.K = EI; q.NT = 8; q.xin = xin; q.xout = G.xres;
      for (int rep = 1; rep < REP_GEMM; ++rep) { q.dry = (gridDim.x != 12345); gemm_phase<LOAD_PLAIN, EPI_RES>(q, lds); } q.dry = 0;
      gemm_phase<LOAD_PLAIN, EPI_RES>(q, lds);
    }
  } else {
    float* cqkv = (float*)(ws + O_CQKV); u16 *cqn = (u16*)(ws + O_CQN), *ckvn = (u16*)(ws + O_CKVN), *kpe = (u16*)(ws + O_KPE), *qq = (u16*)(ws + O_Q), *kv = (u16*)(ws + O_KV);
    const float* ct = (const float*)(ws + O_COS); const float* st = (const float*)(ws + O_SIN);
    if constexpr (ph == 0) rms_phase(xin, p.ln_g + layer * DM, hbuf);
    else if constexpr (ph == 1) {
      GemmP q{}; q.A = hbuf; q.lda = DM; q.Bt = (const u16*)(ws + O_WMLIN) + (size_t)j * ML_NP * DM; q.K = DM; q.NT = 22; q.of = cqkv; q.o0 = sg;
      for (int rep = 1; rep < REP_GEMM; ++rep) { q.dry = (gridDim.x != 12345); gemm_phase<LOAD_PLAIN, EPI_MLAIN>(q, lds); } q.dry = 0;
      gemm_phase<LOAD_PLAIN, EPI_MLAIN>(q, lds);
    } else if constexpr (ph == 2) mla_mid_phase(cqkv, p.ml_qn + j * 384, p.ml_kvn + j * 256, ct, st, cqn, ckvn, kpe, G.T);
    else if constexpr (ph == 3) {
      GemmP q{}; q.A = cqn; q.lda = 384; q.Bt = (const u16*)(ws + O_WUQ) + (size_t)j * 3072 * 384; q.K = 384; q.NT = 24; q.o0 = qq; q.ldc = 3072;
      for (int rep = 1; rep < REP_GEMM; ++rep) { q.dry = (gridDim.x != 12345); gemm_phase<LOAD_PLAIN, EPI_BF16>(q, lds); } q.dry = 0;
      gemm_phase<LOAD_PLAIN, EPI_BF16>(q, lds);
      GemmP r{}; r.A = ckvn; r.lda = 256; r.Bt = (const u16*)(ws + O_WUKV) + (size_t)j * 4096 * 256; r.K = 256; r.NT = 32; r.o0 = kv; r.ldc = 4096;
      for (int rep = 1; rep < REP_GEMM; ++rep) { r.dry = (gridDim.x != 12345); gemm_phase<LOAD_PLAIN, EPI_BF16>(r, lds); } r.dry = 0;
      gemm_phase<LOAD_PLAIN, EPI_BF16>(r, lds);
    } else if constexpr (ph == 4) {
      AttnP a{}; a.q = qq; a.kv = kv; a.kpe = kpe; a.sg = sg; a.ct = ct; a.st = st; a.nseq = G.nseq; a.T = G.T;
      for (int rep = 1; rep < REP_ATTN; ++rep) { a.dry = (gridDim.x != 12345); attn_phase(a, lds); } a.dry = 0;
      attn_phase(a, lds);
    } else {
      GemmP q{}; q.A = sg; q.lda = EI; q.Bt = (const u16*)(ws + O_WMLOUT) + (size_t)j * DM * EI; q.K = EI; q.NT = 8; q.xin = xin; q.xout = G.xres;
      for (int rep = 1; rep < REP_GEMM; ++rep) { q.dry = (gridDim.x != 12345); gemm_phase<LOAD_PLAIN, EPI_RES>(q, lds); } q.dry = 0;
      gemm_phase<LOAD_PLAIN, EPI_RES>(q, lds);
    }
  }
}


template <int LT, int PH>
__global__ __launch_bounds__(512) void k_phase(P p, int g, int layer) {
  extern __shared__ __attribute__((aligned(16))) char lds[];
  if constexpr (LT == 2) { if constexpr (PH == 0) init_phase(p, lds); else final_phase(p.out, p.final_g); }
  else run_phase<LT, PH>(p, g, layer, lds);
}

#if MEGA
__global__ __launch_bounds__(512) void k_mega(P p) {
  extern __shared__ __attribute__((aligned(16))) char lds[];
  cg::grid_group grid = cg::this_grid();
  {
    unsigned* bar = (unsigned*)(p.ws + O_BAR);
    if (blockIdx.x == 0) for (int i = threadIdx.x; i < XCD_BAR_WORDS; i += 512) bar[i] = 0u;
    if (threadIdx.x == 0) { volatile LAS unsigned* st = (volatile LAS unsigned*)(lds + SHM_BYTES - 16); st[0] = 0u; st[1] = 0u; }
  }
  init_phase(p, lds);
  grid.sync();
  if (threadIdx.x == 0) (void)xb_add(&((unsigned*)(p.ws + O_BAR))[XB_XCNT(xb_xcc_id())], 1u);
  for (int g = 0; g < 3; ++g)
    for (int layer = 0; layer < 4; ++layer) {
      if ((layer & 1) == 0) {
        run_phase<0, 0>(p, g, layer, lds); gsync(p, lds); run_phase<0, 1>(p, g, layer, lds); gsync(p, lds); run_phase<0, 2>(p, g, layer, lds); gsync(p, lds);
        run_phase<0, 3>(p, g, layer, lds); gsync(p, lds); run_phase<0, 4>(p, g, layer, lds); gsync(p, lds);
      } else {
        run_phase<1, 0>(p, g, layer, lds); gsync(p, lds); run_phase<1, 1>(p, g, layer, lds); gsync(p, lds); run_phase<1, 2>(p, g, layer, lds); gsync(p, lds);
        run_phase<1, 3>(p, g, layer, lds); gsync(p, lds); run_phase<1, 4>(p, g, layer, lds); gsync(p, lds); run_phase<1, 5>(p, g, layer, lds); gsync(p, lds);
      }
    }
  final_phase(p.out, p.final_g);
}
#endif

extern "C" void kernel_launch(void* const* d_in, const int* in_sizes, int n_in, void* d_out, int out_size, void* d_ws, size_t ws_size, hipStream_t stream) {
  if (n_in != 22 || ws_size < WS_NEED) { fprintf(stderr, "kernel_launch: bad args n_in %d ws %zu need %zu\n", n_in, ws_size, WS_NEED); return; }
  P p{};
  const float** f = (const float**)&p;
  for (int i = 0; i < 22; ++i) f[i] = (const float*)d_in[i];
  p.out = (float*)d_out; p.ws = (char*)d_ws;
#if MEGA
  static int grid_blocks = 0;
  if (!grid_blocks) {
    hipFuncSetAttribute((const void*)k_mega, hipFuncAttributeMaxDynamicSharedMemorySize, SHM_BYTES);
    int dev = 0, cus = 0, per_cu = 0;
    hipGetDevice(&dev);
    hipDeviceGetAttribute(&cus, hipDeviceAttributeMultiprocessorCount, dev);
    hipOccupancyMaxActiveBlocksPerMultiprocessor(&per_cu, k_mega, 512, SHM_BYTES);
    if (per_cu > 1) per_cu = 1;
    grid_blocks = cus * per_cu;
  }
  void* args[] = {&p};
  hipError_t e = hipLaunchCooperativeKernel((void*)k_mega, dim3(grid_blocks), dim3(512), args, SHM_BYTES, stream);
  if (e != hipSuccess) fprintf(stderr, "cooperative launch failed: %s (grid %d)\n", hipGetErrorString(e), grid_blocks);
#else
  const int NB = 256;
#define LAUNCH(LT, PH, g, layer) do { static int inited = 0; if (!inited) { hipFuncSetAttribute((const void*)k_phase<LT, PH>, hipFuncAttributeMaxDynamicSharedMemorySize, SHM_BYTES); inited = 1; } \
    hipLaunchKernelGGL((k_phase<LT, PH>), dim3(NB), dim3(512), SHM_BYTES, stream, p, g, layer); } while (0)
  LAUNCH(2, 0, 0, 0);
  for (int g = 0; g < 3; ++g)
    for (int layer = 0; layer < 4; ++layer) {
      if ((layer & 1) == 0) { LAUNCH(0, 0, g, layer); LAUNCH(0, 1, g, layer); LAUNCH(0, 2, g, layer); LAUNCH(0, 3, g, layer); LAUNCH(0, 4, g, layer); }
      else { LAUNCH(1, 0, g, layer); LAUNCH(1, 1, g, layer); LAUNCH(1, 2, g, layer); LAUNCH(1, 3, g, layer); LAUNCH(1, 4, g, layer); LAUNCH(1, 5, g, layer); }
    }
  LAUNCH(2, 1, 0, 0);
#endif
}
```

```cpp
#include <hip/hip_runtime.h>
#include <hip/hip_bf16.h>
#include <hip/hip_cooperative_groups.h>
#include <cstdio>
namespace cg = cooperative_groups;

#ifndef REP_GEMM
#define REP_GEMM 1
#endif
#ifndef REP_ATTN
#define REP_ATTN 1
#endif
#ifndef REP_SCAN
#define REP_SCAN 1
#endif
#ifndef MEGA
#define MEGA 1
#endif

typedef unsigned short u16;
using bf16x8 = __attribute__((ext_vector_type(8))) short;
using s16x4  = __attribute__((ext_vector_type(4))) short;
using f32x16 = __attribute__((ext_vector_type(16))) float;
using f32x4  = __attribute__((ext_vector_type(4))) float;
using u32x4  = __attribute__((ext_vector_type(4))) unsigned;
using u32x2  = __attribute__((ext_vector_type(2))) unsigned;
#define DEV __device__ __forceinline__
#define SBAR() __builtin_amdgcn_sched_barrier(0)

constexpr int DM = 1024, EI = 2048, GT = 16384;
constexpr int NTOK = 49152;
constexpr int RW_N = 8448, ML_N = 2752, ML_NP = 2816;
constexpr int SHM_BYTES = 158720;

constexpr size_t alup(size_t x) { return (x + 255) / 256 * 256; }
constexpr size_t O_WRWIN  = 0;
constexpr size_t O_WRWOUT = O_WRWIN  + alup((size_t)2 * RW_N * DM * 2);
constexpr size_t O_WMLIN  = O_WRWOUT + alup((size_t)2 * DM * EI * 2);
constexpr size_t O_WUQ    = O_WMLIN  + alup((size_t)2 * ML_NP * DM * 2);
constexpr size_t O_WUKV   = O_WUQ    + alup((size_t)2 * 3072 * 384 * 2);
constexpr size_t O_WMLOUT = O_WUKV   + alup((size_t)2 * 4096 * 256 * 2);
constexpr size_t O_COS    = O_WMLOUT + alup((size_t)2 * DM * EI * 2);
constexpr size_t O_SIN    = O_COS    + alup((size_t)16384 * 32 * 4);
constexpr size_t O_HBUF   = O_SIN    + alup((size_t)16384 * 32 * 4);
constexpr size_t O_R0     = O_HBUF   + alup((size_t)GT * DM * 2);
constexpr size_t SZ_E = (size_t)GT * EI * 2;
constexpr size_t O_SG   = O_R0;
constexpr size_t O_RB   = O_SG + SZ_E;
constexpr size_t O_KB   = O_RB + SZ_E;
constexpr size_t O_VB   = O_KB + SZ_E;
constexpr size_t O_YF   = O_VB + SZ_E;
constexpr size_t O_YB   = O_YF + SZ_E;
constexpr size_t O_TWL  = O_YB + SZ_E;
constexpr size_t O_AL   = O_TWL + alup((size_t)GT * 128 * 2);
constexpr size_t O_BON  = O_AL  + alup((size_t)GT * 128 * 2);
constexpr size_t O_RW_END = O_BON + alup((size_t)GT * 64 * 4);
constexpr size_t O_CQKV = O_SG + SZ_E;
constexpr size_t O_CQN  = O_CQKV + alup((size_t)GT * 704 * 4);
constexpr size_t O_CKVN = O_CQN  + alup((size_t)GT * 384 * 2);
constexpr size_t O_KPE  = O_CKVN + alup((size_t)GT * 256 * 2);
constexpr size_t O_Q    = O_KPE  + alup((size_t)GT * 64 * 2);
constexpr size_t O_KV   = O_Q    + alup((size_t)GT * 3072 * 2);
constexpr size_t O_ML_END = O_KV + alup((size_t)GT * 4096 * 2);
constexpr size_t O_FLAG = O_RW_END > O_ML_END ? O_RW_END : O_ML_END;
constexpr size_t O_BAR = O_FLAG + 256;
constexpr size_t WS_NEED = O_BAR + 16384;

struct P {
  const float* x_prompt; const float* x_sample; const float* ln_g; const float* final_g;
  const float* rw_mu; const float* rw_in; const float* rw_w0; const float* rw_w2; const float* rw_a0; const float* rw_a2;
  const float* rw_kk; const float* rw_ka; const float* rw_rk; const float* rw_lnx_g; const float* rw_lnx_b; const float* rw_out;
  const float* ml_in; const float* ml_qn; const float* ml_kvn; const float* ml_uq; const float* ml_ukv; const float* ml_out;
  float* out; char* ws;
};

typedef __attribute__((ext_vector_type(2))) __bf16 bf16x2_t;
typedef __attribute__((ext_vector_type(2))) float f32x2_t;
DEV unsigned cvtpk(float lo, float hi) { f32x2_t v = {lo, hi}; bf16x2_t b = __builtin_convertvector(v, bf16x2_t); return __builtin_bit_cast(unsigned, b); }
DEV float bf2f(u16 x) { return __uint_as_float(((unsigned)x) << 16); }
DEV float bflo(unsigned x) { return __uint_as_float(x << 16); }
DEV float bfhi(unsigned x) { return __uint_as_float(x & 0xffff0000u); }
DEV u16 f2bf(float x) { __bf16 b = (__bf16)x; return __builtin_bit_cast(u16, b); }
DEV float wsum(float v) {
#pragma unroll
  for (int o = 32; o >= 1; o >>= 1) v += __shfl_xor(v, o, 64);
  return v;
}
DEV float siluf(float x) { return x / (1.f + __expf(-x)); }
DEV int crow(int r, int hi) { return (r & 3) + 8 * (r >> 2) + 4 * hi; }
DEV int ltid() { int t = threadIdx.x; asm volatile("" : "+v"(t)); return t; }
template <typename T> DEV T gld(size_t base, unsigned off) { return *(const __attribute__((address_space(1))) T*)(base + off); }
template <typename T> DEV void gst(size_t base, unsigned off, T v) { *(__attribute__((address_space(1))) T*)(base + off) = v; }
DEV void lds_wait() { asm volatile("s_waitcnt lgkmcnt(0)" ::: "memory"); }


#define XB_TMO      128
#define XB_XCNT(j)  (256  + 64 * (j))
#define XB_XSUB(j)  (1280 + 64 * (j))
#define XB_XGEN(j)  (2304 + 64 * (j))
#define XB_TOP      3328
#define XB_TOPGEN   3392
#define XCD_BAR_WORDS 3456
#define XB_SPIN_CAP (1u << 22)
#define LAS __attribute__((address_space(3)))
DEV unsigned xb_ld(unsigned* p)              { return __hip_atomic_load(p, __ATOMIC_RELAXED, __HIP_MEMORY_SCOPE_AGENT); }
DEV unsigned xb_add(unsigned* p, unsigned v) { return __hip_atomic_fetch_add(p, v, __ATOMIC_RELAXED, __HIP_MEMORY_SCOPE_AGENT); }
DEV unsigned xb_xcc_id() { return (unsigned)__builtin_amdgcn_s_getreg((3 << 11) | 20) & 0xFu; }
#define XB_SPIN(cond, bar) do { unsigned _sp = 0; while (cond) { __builtin_amdgcn_s_sleep(1); \
    if ((++_sp & 255u) == 0u) { if (xb_ld(&(bar)[XB_TMO])) break; if (_sp > XB_SPIN_CAP) { atomicAdd(&(bar)[XB_TMO], 1u); break; } } } } while (0)
struct XcdBarrier { unsigned* bar; unsigned x; volatile LAS unsigned* st; };
DEV void xcd_barrier_complete(unsigned* bar, unsigned x, unsigned& nloc, unsigned& nx) {
  const unsigned G = gridDim.x * gridDim.y * gridDim.z;
  unsigned sum, cnt, mine, sp = 0u;
  for (;;) {
    sum = 0u; cnt = 0u; mine = 0u;
#pragma unroll
    for (unsigned j = 0; j < 16; ++j) { const unsigned c = xb_ld(&bar[XB_XCNT(j)]); sum += c; cnt += (c > 0u) ? 1u : 0u; mine = (j == x) ? c : mine; }
    if (sum == G) break;
    __builtin_amdgcn_s_sleep(1);
    if ((++sp & 255u) == 0u) { if (xb_ld(&bar[XB_TMO])) break; if (sp > XB_SPIN_CAP) { atomicAdd(&bar[XB_TMO], 1u); break; } }
  }
  nloc = mine > 0u ? mine : 1u; nx = cnt > 0u ? cnt : 1u;
}
DEV void xcd_barrier(const XcdBarrier& b) {
  asm volatile("s_waitcnt vmcnt(0)" ::: "memory");
  __syncthreads();
  if (threadIdx.x == 0) {
    unsigned* bar = b.bar;
    __builtin_amdgcn_s_waitcnt(0);
    unsigned nloc = b.st[0], nx = b.st[1];
    if (nloc == 0u) { xcd_barrier_complete(bar, b.x, nloc, nx); b.st[0] = nloc; b.st[1] = nx; }
    const unsigned old = xb_add(&bar[XB_XSUB(b.x)], 1u);
    const unsigned gen = old / nloc;
    if (old + 1u == (gen + 1u) * nloc) {
      __builtin_amdgcn_fence(__ATOMIC_RELEASE, "agent");
      asm volatile("s_waitcnt vmcnt(0)" ::: "memory");
      const unsigned og = xb_add(&bar[XB_TOP], 1u);
      const unsigned tg = og / nx;
      if (og + 1u == (tg + 1u) * nx) xb_add(&bar[XB_TOPGEN], 1u);
      else XB_SPIN(xb_ld(&bar[XB_TOPGEN]) == tg, bar);
      __builtin_amdgcn_fence(__ATOMIC_ACQUIRE, "agent");
      xb_add(&bar[XB_XGEN(b.x)], 1u);
      asm volatile("s_waitcnt vmcnt(0)" ::: "memory");
    } else {
      XB_SPIN(xb_ld(&bar[XB_XGEN(b.x)]) == gen, bar);
      __builtin_amdgcn_fence(__ATOMIC_ACQUIRE, "agent");
      asm volatile("s_waitcnt vmcnt(0)" ::: "memory");
    }
  }
  __syncthreads();
}
DEV void gsync(const P& p, char* lds) {
  XcdBarrier b; b.bar = (unsigned*)(p.ws + O_BAR); b.x = xb_xcc_id(); b.st = (volatile LAS unsigned*)(lds + SHM_BYTES - 16);
  xcd_barrier(b);
}

DEV void convert_T(const float* __restrict__ src, u16* __restrict__ dst, int K, int N, int Npad, char* lds_) {
  float* lds = (float*)lds_;
  const int tid = ltid(), tk = K / 64, tn = Npad / 64;
  for (int t = blockIdx.x; t < tk * tn; t += gridDim.x) {
    const int k0 = (t % tk) * 64, n0 = (t / tk) * 64;
    __syncthreads();
#pragma unroll
    for (int i = 0; i < 2; ++i) {
      const int kr = (tid >> 4) + i * 32, c = (tid & 15) * 4;
      float4 v = make_float4(0.f, 0.f, 0.f, 0.f);
      if (n0 + c < N) v = *(const float4*)(src + (long)(k0 + kr) * N + n0 + c);
      lds[kr * 65 + c + 0] = v.x; lds[kr * 65 + c + 1] = v.y; lds[kr * 65 + c + 2] = v.z; lds[kr * 65 + c + 3] = v.w;
    }
    __syncthreads();
    const int n = tid >> 3, kc = (tid & 7) * 8;
    u32x4 w;
    w[0] = cvtpk(lds[(kc + 0) * 65 + n], lds[(kc + 1) * 65 + n]);
    w[1] = cvtpk(lds[(kc + 2) * 65 + n], lds[(kc + 3) * 65 + n]);
    w[2] = cvtpk(lds[(kc + 4) * 65 + n], lds[(kc + 5) * 65 + n]);
    w[3] = cvtpk(lds[(kc + 6) * 65 + n], lds[(kc + 7) * 65 + n]);
    *(u32x4*)(dst + (long)(n0 + n) * K + k0 + kc) = w;
  }
}

DEV void init_phase(const P& p, char* lds) {
  for (int j = 0; j < 2; ++j) {
    convert_T(p.rw_in  + (size_t)j * DM * RW_N, (u16*)(p.ws + O_WRWIN)  + (size_t)j * RW_N * DM, DM, RW_N, RW_N, lds);
    convert_T(p.rw_out + (size_t)j * EI * DM,   (u16*)(p.ws + O_WRWOUT) + (size_t)j * DM * EI,   EI, DM, DM, lds);
    convert_T(p.ml_in  + (size_t)j * DM * ML_N, (u16*)(p.ws + O_WMLIN)  + (size_t)j * ML_NP * DM, DM, ML_N, ML_NP, lds);
    convert_T(p.ml_uq  + (size_t)j * 384 * 3072, (u16*)(p.ws + O_WUQ)   + (size_t)j * 3072 * 384, 384, 3072, 3072, lds);
    convert_T(p.ml_ukv + (size_t)j * 256 * 4096, (u16*)(p.ws + O_WUKV)  + (size_t)j * 4096 * 256, 256, 4096, 4096, lds);
    convert_T(p.ml_out + (size_t)j * EI * DM,   (u16*)(p.ws + O_WMLOUT) + (size_t)j * DM * EI,   EI, DM, DM, lds);
  }
  float* ct = (float*)(p.ws + O_COS); float* st = (float*)(p.ws + O_SIN);
  const int tid_ = ltid();
  for (int i = blockIdx.x * 512 + tid_; i < 16384 * 32; i += gridDim.x * 512) {
    const int pos = i >> 5, j = i & 31;
    const float invf = 1.0f / powf(10000.0f, (float)(2 * j) / 64.0f);
    const float ang = (float)pos * invf;
    const double a = (double)ang;
    const double n = rint(a * 0.15915494309189535);
    const float r = (float)(a - n * 6.283185307179586);
    ct[i] = cosf(r); st[i] = sinf(r);
  }
}

DEV void rms_phase(const float* __restrict__ x, const float* __restrict__ g, u16* __restrict__ hout) {
  const int tid_ = ltid(); const int lane = tid_ & 63, wid = __builtin_amdgcn_readfirstlane(tid_ >> 6);
  for (int tok = blockIdx.x * 8 + wid; tok < GT; tok += gridDim.x * 8) {
    const float4* xr = (const float4*)(x + (size_t)tok * DM);
    float4 v[4]; float ss = 0.f;
#pragma unroll
    for (int i = 0; i < 4; ++i) { v[i] = xr[lane + i * 64]; ss += v[i].x * v[i].x + v[i].y * v[i].y + v[i].z * v[i].z + v[i].w * v[i].w; }
    ss = wsum(ss);
    const float sc = rsqrtf(ss * (1.f / DM) + 1e-6f);
#pragma unroll
    for (int i = 0; i < 4; ++i) {
      const float4 gg = ((const float4*)g)[lane + i * 64];
      u32x2 w; w[0] = cvtpk(v[i].x * sc * gg.x, v[i].y * sc * gg.y); w[1] = cvtpk(v[i].z * sc * gg.z, v[i].w * sc * gg.w);
      *(u32x2*)(hout + (size_t)tok * DM + (lane + i * 64) * 4) = w;
    }
  }
}

DEV void final_phase(float* __restrict__ x, const float* __restrict__ g) {
  const int tid_ = ltid(); const int lane = tid_ & 63, wid = __builtin_amdgcn_readfirstlane(tid_ >> 6);
  for (int tok = blockIdx.x * 8 + wid; tok < NTOK; tok += gridDim.x * 8) {
    float4* xr = (float4*)(x + (size_t)tok * DM);
    float4 v[4]; float ss = 0.f;
#pragma unroll
    for (int i = 0; i < 4; ++i) { v[i] = xr[lane + i * 64]; ss += v[i].x * v[i].x + v[i].y * v[i].y + v[i].z * v[i].z + v[i].w * v[i].w; }
    ss = wsum(ss);
    const float sc = rsqrtf(ss * (1.f / DM) + 1e-6f);
#pragma unroll
    for (int i = 0; i < 4; ++i) {
      const float4 gg = ((const float4*)g)[lane + i * 64];
      float4 ov = make_float4(v[i].x * sc * gg.x, v[i].y * sc * gg.y, v[i].z * sc * gg.z, v[i].w * sc * gg.w);
      xr[lane + i * 64] = ov;
    }
  }
}

#define GSWZ(row, c16) ((row) * 128 + ((((c16) ^ ((row) >> 1)) & 7) << 4))
constexpr int LOAD_PLAIN = 0, LOAD_LERP = 1;
constexpr int EPI_RWKV = 0, EPI_RES = 1, EPI_MLAIN = 2, EPI_BF16 = 3;
struct GemmP {
  const u16* A; int lda; const u16* Bt; int K; int NT;
  const float* mu;
  int T;
  u16* o0; u16* o1; u16* o2; u16* o3; u16* o4; u16* o5;
  int ldc;
  float* of; const float* xin; float* xout; int dry;
};

template <int LOAD, int EPI>
DEV void gemm_phase(const GemmP& g, char* lds) {
  const int tid = ltid(), wid = tid >> 6, lane = tid & 63, r32 = lane & 31, hi = lane >> 5;
  const int wm = wid >> 1, wn = wid & 1;
  char* sA = lds; char* sB = lds + 65536;
  const int nk = g.K / 64, ntiles = 64 * g.NT;
  const int c16 = tid & 7, rowb = tid >> 3;
  for (int t = blockIdx.x; t < ntiles; t += gridDim.x) {
    const int mt = t & 63, nt = t >> 6, m0 = mt * 256, n0 = nt * 128;
    f32x16 acc[2][2] = {};
    bf16x8 ra[4], rb[2];
    const float* mup = nullptr;
    if constexpr (LOAD == LOAD_LERP) {
      const int s = nt < 16 ? 0 : nt < 32 ? 2 : nt < 48 ? 3 : nt < 64 ? 5 : nt == 64 ? 1 : 4;
      mup = g.mu + s * DM;
    }
    auto gload = [&](int kt) {
      const int k0 = kt * 64 + c16 * 8;
#pragma unroll
      for (int i = 0; i < 4; ++i) {
        const int row = rowb + i * 64; const size_t tok = (size_t)(m0 + row);
        if constexpr (LOAD == LOAD_PLAIN) {
          ra[i] = *(const bf16x8*)(g.A + tok * g.lda + k0);
        } else {
          const int pos = (int)(tok % (size_t)g.T);
          const u32x4 c = *(const u32x4*)(g.A + tok * DM + k0);
          u32x4 pv = {0u, 0u, 0u, 0u}, nx = {0u, 0u, 0u, 0u};
          if (pos > 0) pv = *(const u32x4*)(g.A + (tok - 1) * DM + k0);
          if (pos < g.T - 1) nx = *(const u32x4*)(g.A + (tok + 1) * DM + k0);
          const float4 m0v = *(const float4*)(mup + k0), m1v = *(const float4*)(mup + k0 + 4);
          const float mu[8] = {m0v.x, m0v.y, m0v.z, m0v.w, m1v.x, m1v.y, m1v.z, m1v.w};
          u32x4 o;
#pragma unroll
          for (int e = 0; e < 4; ++e) {
            const float h0 = bflo(c[e]), h1 = bfhi(c[e]);
            const float x0 = 0.5f * (bflo(pv[e]) + bflo(nx[e])) - h0, x1 = 0.5f * (bfhi(pv[e]) + bfhi(nx[e])) - h1;
            o[e] = cvtpk(h0 + mu[2 * e] * x0, h1 + mu[2 * e + 1] * x1);
          }
          ra[i] = *(bf16x8*)&o;
        }
      }
#pragma unroll
      for (int i = 0; i < 2; ++i) {
        const int row = rowb + i * 64;
        rb[i] = *(const bf16x8*)(g.Bt + (size_t)(n0 + row) * g.K + k0);
      }
    };
    auto swrite = [&](int b) {
#pragma unroll
      for (int i = 0; i < 4; ++i) { const int row = rowb + i * 64; *(bf16x8*)(sA + b * 32768 + GSWZ(row, c16)) = ra[i]; }
#pragma unroll
      for (int i = 0; i < 2; ++i) { const int row = rowb + i * 64; *(bf16x8*)(sB + b * 16384 + GSWZ(row, c16)) = rb[i]; }
    };
    gload(0); swrite(0); __syncthreads();
    for (int kt = 0; kt < nk; ++kt) {
      const int b = kt & 1;
      if (kt + 1 < nk) gload(kt + 1);
      const char* a_ = sA + b * 32768; const char* b_ = sB + b * 16384;
#pragma unroll
      for (int ks = 0; ks < 4; ++ks) {
        bf16x8 af[2], bfr[2];
#pragma unroll
        for (int mi = 0; mi < 2; ++mi) { const int row = wm * 64 + mi * 32 + r32; af[mi] = *(const bf16x8*)(a_ + GSWZ(row, ks * 2 + hi)); }
#pragma unroll
        for (int ni = 0; ni < 2; ++ni) { const int row = wn * 64 + ni * 32 + r32; bfr[ni] = *(const bf16x8*)(b_ + GSWZ(row, ks * 2 + hi)); }
#pragma unroll
        for (int mi = 0; mi < 2; ++mi)
#pragma unroll
          for (int ni = 0; ni < 2; ++ni) acc[mi][ni] = __builtin_amdgcn_mfma_f32_32x32x16_bf16(af[mi], bfr[ni], acc[mi][ni], 0, 0, 0);
      }
      if (kt + 1 < nk) swrite(b ^ 1);
      __syncthreads();
    }
    if (!g.dry)
#pragma unroll
    for (int mi = 0; mi < 2; ++mi)
#pragma unroll
      for (int ni = 0; ni < 2; ++ni)
#pragma unroll
        for (int r = 0; r < 16; ++r) {
          const size_t m = (size_t)(m0 + wm * 64 + mi * 32 + crow(r, hi));
          const int nl = wn * 64 + ni * 32 + r32, n = n0 + nl;
          const float v = acc[mi][ni][r];
          if constexpr (EPI == EPI_RWKV) {
            if (nt < 64) {
              const int which = nt >> 4, col = (nt & 15) * 128 + nl;
              u16* dst = which == 0 ? g.o0 : which == 1 ? g.o1 : which == 2 ? g.o2 : g.o3;
              dst[m * EI + col] = f2bf(which == 3 ? siluf(v) : v);
            } else if (nt == 64) g.o4[m * 128 + nl] = f2bf(tanhf(v));
            else g.o5[m * 128 + nl] = f2bf(v);
          } else if constexpr (EPI == EPI_RES) {
            g.xout[m * DM + n] = g.xin[m * DM + n] + v;
          } else if constexpr (EPI == EPI_MLAIN) {
            if (n < 704) g.of[m * 704 + n] = v;
            else if (n < ML_N) g.o0[m * EI + (n - 704)] = f2bf(siluf(v));
          } else {
            g.o0[m * g.ldc + n] = f2bf(v);
          }
        }
  }
}

struct ScanP {
  const u16 *r, *k, *v, *twl, *al; u16 *yf, *yb; float* bonus;
  const float *w0, *w2, *a0, *a2, *kk, *ka, *rk;
  int nseq, T;
  float* tbuf; int nseg;
};
template <int CTRL> DEV float dppf(float x) {
  return __int_as_float(__builtin_amdgcn_update_dpp(0, __float_as_int(x), CTRL, 0xF, 0xF, false));
}
DEV float row_prefix16(float x) {
  x += dppf<0x111>(x); x += dppf<0x112>(x); x += dppf<0x114>(x); x += dppf<0x118>(x); return x;
}
DEV float row_total16(float x) {
  x += dppf<0x128>(x); x += dppf<0x124>(x); x += dppf<0x122>(x); x += dppf<0x121>(x); return x;
}
DEV bf16x8 pack8(float a0, float a1, float a2, float a3, float a4, float a5, float a6, float a7) {
  u32x4 w = {cvtpk(a0, a1), cvtpk(a2, a3), cvtpk(a4, a5), cvtpk(a6, a7)}; return *(bf16x8*)&w;
}
constexpr int SC_BKT = 0, SC_UVT = 5120, SC_AKM = 10240, SC_RR = 10752, SC_ABF = 11776, SC_Z = 12800, SC_PRM = 17152, SC_T = 18944, SC_WAVE = 35328;
constexpr int SC_PRE = SC_UVT;
constexpr int SC_SHARED_AW = 4 * SC_WAVE;
constexpr int SC_NW = 4;
DEV void scan_phase(const ScanP& s, char* lds_, const int pass) {
  const int tid = ltid(), wid = __builtin_amdgcn_readfirstlane(tid >> 6), lane = tid & 63, c16 = lane & 15, q = lane >> 4;
  const int nchain = s.nseq * 64, nseg = s.nseg;
  const int ipc = pass == 0 ? nseg * 2 : nseg;
  const bool shared = nchain <= (int)gridDim.x;
  const int nsb = shared ? (int)gridDim.x / nchain : 1, sbi = shared ? (int)blockIdx.x / nchain : 0;
  const int nwv = shared ? SC_NW : 2;
  if (shared && sbi >= nsb) return;
  char* wl = lds_ + (wid & 3) * SC_WAVE;
  u16* bkt = (u16*)(wl + SC_BKT); u16* uvt = (u16*)(wl + SC_UVT); u16* akm = (u16*)(wl + SC_AKM); u16* rr = (u16*)(wl + SC_RR);
  float* abf = (float*)(wl + SC_ABF); float* zl = (float*)(wl + SC_Z); float* prm = (float*)(wl + SC_PRM); float* p15l = prm + 320;
  bf16x8* awl = (bf16x8*)(shared ? lds_ + SC_SHARED_AW : lds_ + (2 + (wid & 1)) * SC_WAVE); bf16x8* aal = awl + 512;
#define SCAN_LOAD_W(CHAIN, F0, F1) do { const int d_ = (CHAIN) & 1, h_ = ((CHAIN) >> 1) & 31; \
    for (int f = (F0); f < (F1); ++f) { const int ks = f >> 2, mt = f & 3; u32x4 pw, pa; \
      _Pragma("unroll") for (int e = 0; e < 4; ++e) { const int l0 = ks * 32 + q * 8 + 2 * e; \
        const size_t i0 = ((size_t)(d_ * 64 + l0)) * EI + h_ * 64 + mt * 16 + c16; \
        pw[e] = cvtpk(s.w2[i0], s.w2[i0 + EI]); pa[e] = cvtpk(s.a2[i0], s.a2[i0 + EI]); } \
      awl[f * 64 + lane] = *(bf16x8*)&pw; aal[f * 64 + lane] = *(bf16x8*)&pa; } } while (0)
  if (shared) {
    const int chain_b = (int)blockIdx.x % nchain;
    SCAN_LOAD_W(chain_b, wid, wid + 1);
    __syncthreads();
  }
  if (wid >= nwv) return;
  const int nrounds = shared ? (ipc + nsb * SC_NW - 1) / (nsb * SC_NW) : (nchain + 2 * (int)gridDim.x - 1) / (2 * (int)gridDim.x);
  for (int round = 0; round < nrounds; ++round) {
    const int chain = shared ? (int)blockIdx.x % nchain : (round * 2 + wid) * (int)gridDim.x + (int)blockIdx.x;
    const int it = shared ? sbi * SC_NW + wid + round * nsb * SC_NW : 0;
    if (chain >= nchain || it >= ipc) continue;
    const int kind = pass == 0 ? 1 + (it & 1) : 0;
    const int seg = pass == 0 ? it >> 1 : it;
    const int cs = chain * nseg + seg;
    const int d = chain & 1, h = (chain >> 1) & 31, b = chain >> 6;
    {
      const int ch = h * 64 + lane;
      lds_wait();
      prm[lane] = s.w0[d * EI + ch]; prm[64 + lane] = s.a0[d * EI + ch]; prm[128 + lane] = s.kk[ch]; prm[192 + lane] = s.ka[ch]; prm[256 + lane] = s.rk[ch];
      lds_wait();
    }
    if (!shared) { SCAN_LOAD_W(chain, 0, 8); lds_wait(); }
    const unsigned rowi = (unsigned)(d ? 15 - c16 : c16);
    const unsigned off_tw = rowi * 256u + (unsigned)(q * 16);
    const unsigned off_kr = rowi * 4096u + (unsigned)(h * 128 + q * 8);
    const unsigned off_v  = (unsigned)(h * 128 + lane * 2);
    const unsigned off_y0 = (unsigned)(d ? 15 - 4 * q : 4 * q) * 4096u + (unsigned)(h * 128 + c16 * 2);
    const int ystep = d ? -4096 : 4096;
    f32x4* Tl = (f32x4*)(wl + SC_T);
#pragma unroll
    for (int m = 0; m < 16; ++m) {
      f32x4 t0v = {0.f, 0.f, 0.f, 0.f};
      if (kind == 2) {
        const int mt = m >> 2, nt = m & 3;
        if (mt == nt) { t0v[0] = (4 * q + 0 == c16) ? 1.f : 0.f; t0v[1] = (4 * q + 1 == c16) ? 1.f : 0.f; t0v[2] = (4 * q + 2 == c16) ? 1.f : 0.f; t0v[3] = (4 * q + 3 == c16) ? 1.f : 0.f; }
      } else if (kind == 0 && nseg > 1) {
        t0v = *(const f32x4*)(s.tbuf + ((size_t)cs * 2) * 4096 + (m * 64 + lane) * 4);
      }
      Tl[m * 64 + lane] = t0v;
    }
    u16* yout = d ? s.yb : s.yf;
    const size_t sb = (size_t)b * s.T;
    const int cps = s.T / 16 / nseg, cbeg = seg * cps, cend = cbeg + cps;
    bf16x8 n_tw0, n_tw1, n_ta0, n_ta1; u32x2 n_k[4], n_r[4];
#define SCAN_LOAD(CC) do { const int c0n = d ? (s.T - 16 - (CC) * 16) : (CC) * 16; const size_t t0n = sb + c0n; \
      size_t p_tw = (size_t)s.twl + t0n * 256 + d * 128, p_al = (size_t)s.al + t0n * 256 + d * 128, p_k = (size_t)s.k + t0n * 4096, p_r = (size_t)s.r + t0n * 4096 ; \
      asm volatile("" : "+s"(p_tw), "+s"(p_al), "+s"(p_k), "+s"(p_r)); \
      n_tw0 = gld<bf16x8>(p_tw, off_tw); n_tw1 = gld<bf16x8>(p_tw, off_tw + 64); n_ta0 = gld<bf16x8>(p_al, off_tw); n_ta1 = gld<bf16x8>(p_al, off_tw + 64); \
      _Pragma("unroll") for (int mt = 0; mt < 4; ++mt) { n_k[mt] = gld<u32x2>(p_k, off_kr + mt * 32); n_r[mt] = gld<u32x2>(p_r, off_kr + mt * 32); } } while (0)
    SCAN_LOAD(cbeg);
    for (int cc = cbeg; cc < cend; ++cc) {
      const int c0 = d ? (s.T - 16 - cc * 16) : cc * 16;
      const size_t t0 = sb + c0;
      size_t b_y = (size_t)yout + t0 * 4096, b_bon = (size_t)s.bonus + t0 * 256 + (h * 2 + d) * 4;
      asm volatile("" : "+s"(b_y), "+s"(b_bon));
      size_t b_v = (size_t)s.v + t0 * 4096; asm volatile("" : "+s"(b_v));
      u32x2 n_v[4];
#pragma unroll
      for (int mt = 0; mt < 4; ++mt) n_v[mt] = gld<u32x2>(b_v, off_kr + mt * 32);
      {
        f32x4* wpl = (f32x4*)zl; f32x4* apl = (f32x4*)(wl + SC_PRE);
#pragma unroll
        for (int mt = 0; mt < 4; ++mt) {
          f32x4 cw = {0.f, 0.f, 0.f, 0.f}, ca = {0.f, 0.f, 0.f, 0.f};
          cw = __builtin_amdgcn_mfma_f32_16x16x32_bf16(awl[(0 * 4 + mt) * 64 + lane], n_tw0, cw, 0, 0, 0);
          cw = __builtin_amdgcn_mfma_f32_16x16x32_bf16(awl[(1 * 4 + mt) * 64 + lane], n_tw1, cw, 0, 0, 0);
          ca = __builtin_amdgcn_mfma_f32_16x16x32_bf16(aal[(0 * 4 + mt) * 64 + lane], n_ta0, ca, 0, 0, 0);
          ca = __builtin_amdgcn_mfma_f32_16x16x32_bf16(aal[(1 * 4 + mt) * 64 + lane], n_ta1, ca, 0, 0, 0);
          wpl[mt * 64 + lane] = cw; apl[mt * 64 + lane] = ca;
        }
      }
      float n2 = 0.f;
#pragma unroll
      for (int mt = 0; mt < 4; ++mt) {
        const float4 kkp = *(const float4*)(prm + 128 + mt * 16 + q * 4);
        const float t0 = bflo(n_k[mt][0]) * kkp.x, t1 = bfhi(n_k[mt][0]) * kkp.y, t2 = bflo(n_k[mt][1]) * kkp.z, t3 = bfhi(n_k[mt][1]) * kkp.w;
        n2 += t0 * t0 + t1 * t1 + t2 * t2 + t3 * t3;
      }
      n2 += __shfl_xor(n2, 16, 64); n2 += __shfl_xor(n2, 32, 64);
      const float invn = __builtin_amdgcn_rsqf(fmaxf(n2, 1e-24f));
      float bon = 0.f;
      bf16x8 ktf[2], btf[2], kdf[2], rtf[2];
#pragma unroll
      for (int ks = 0; ks < 2; ++ks) {
        float ktl[8], btl[8], kdl[8], rtl[8];
#pragma unroll
        for (int mh = 0; mh < 2; ++mh) {
          const int mt = 2 * ks + mh;
          const f32x4 cw = ((const f32x4*)zl)[mt * 64 + lane], ca = ((const f32x4*)(wl + SC_PRE))[mt * 64 + lane];
          const float4 w0p = *(const float4*)(prm + mt * 16 + q * 4), a0p = *(const float4*)(prm + 64 + mt * 16 + q * 4);
          const float4 kkp = *(const float4*)(prm + 128 + mt * 16 + q * 4), kap = *(const float4*)(prm + 192 + mt * 16 + q * 4), rkp = *(const float4*)(prm + 256 + mt * 16 + q * 4);
          const float w0a[4] = {w0p.x, w0p.y, w0p.z, w0p.w}, a0a[4] = {a0p.x, a0p.y, a0p.z, a0p.w};
          const float kka[4] = {kkp.x, kkp.y, kkp.z, kkp.w}, kaa[4] = {kap.x, kap.y, kap.z, kap.w}, rka[4] = {rkp.x, rkp.y, rkp.z, rkp.w};
          const u32x2 kr_ = n_k[mt], rr_ = n_r[mt];
          const float kxa[4] = {bflo(kr_[0]), bfhi(kr_[0]), bflo(kr_[1]), bfhi(kr_[1])};
          const float rxa[4] = {bflo(rr_[0]), bfhi(rr_[0]), bflo(rr_[1]), bfhi(rr_[1])};
          float4 p15v;
#pragma unroll
          for (int e = 0; e < 4; ++e) {
            const float wp = cw[e] + w0a[e], ap = ca[e] + a0a[e];
            const float ee = 0.6065306597126334f * __builtin_amdgcn_rcpf(1.f + __expf(-wp));
            const float a = __builtin_amdgcn_rcpf(1.f + __expf(-ap));
            const float kkn = kxa[e] * kka[e] * invn;
            const float kd = kxa[e] * (1.f + (a - 1.f) * kaa[e]);
            const float bb = kkn * a;
            bon += rxa[e] * kd * rka[e];
            const float Ei = row_prefix16(ee), Et = row_total16(ee);
            const float pm = __expf(-Ei), pp = __builtin_amdgcn_rcpf(pm), pm1 = __expf(ee - Ei);
            ktl[mh * 4 + e] = kkn * pm1; btl[mh * 4 + e] = bb * pp; kdl[mh * 4 + e] = kd * pp; rtl[mh * 4 + e] = rxa[e] * pm;
            ((float*)&p15v)[e] = __expf(-Et);
            const int j = mt * 16 + q * 4 + e;
            bkt[j * 40 + c16] = f2bf(btl[mh * 4 + e]); bkt[j * 40 + 16 + c16] = f2bf(kdl[mh * 4 + e]);
          }
          if (c16 == 0) *(float4*)(p15l + mt * 16 + q * 4) = p15v;
          SBAR();
        }
        ktf[ks] = pack8(ktl[0], ktl[1], ktl[2], ktl[3], ktl[4], ktl[5], ktl[6], ktl[7]);
        btf[ks] = pack8(btl[0], btl[1], btl[2], btl[3], btl[4], btl[5], btl[6], btl[7]);
        kdf[ks] = pack8(kdl[0], kdl[1], kdl[2], kdl[3], kdl[4], kdl[5], kdl[6], kdl[7]);
        rtf[ks] = pack8(rtl[0], rtl[1], rtl[2], rtl[3], rtl[4], rtl[5], rtl[6], rtl[7]);
      }
      bon += __shfl_xor(bon, 16, 64); bon += __shfl_xor(bon, 32, 64);
      if (q == 0 && kind == 0) gst<float>(b_bon, off_tw, bon);
      SBAR();
      SBAR();
#pragma unroll
      for (int mt = 0; mt < 4; ++mt) {
        const int vb_ = (mt * 16 + q * 4) * 40 + 16 + c16;
        const unsigned v0_ = kind == 2 ? 0u : n_v[mt][0], v1_ = kind == 2 ? 0u : n_v[mt][1];
        uvt[vb_] = (u16)(v0_ & 0xffffu); uvt[vb_ + 40] = (u16)(v0_ >> 16);
        uvt[vb_ + 80] = (u16)(v1_ & 0xffffu); uvt[vb_ + 120] = (u16)(v1_ >> 16);
      }
      { const int cn = cc + 1 < cend ? cc + 1 : cc; SCAN_LOAD(cn); }
      SBAR();
      {
        f32x4 AB = {0.f, 0.f, 0.f, 0.f}, AK = AB, RB = AB, RK = AB;
        int qm = q; asm volatile("" : "+v"(qm));
#pragma unroll
        for (int ks = 0; ks < 2; ++ks) {
          AB = __builtin_amdgcn_mfma_f32_16x16x32_bf16(ktf[ks], btf[ks], AB, 0, 0, 0);
          AK = __builtin_amdgcn_mfma_f32_16x16x32_bf16(ktf[ks], kdf[ks], AK, 0, 0, 0);
          RB = __builtin_amdgcn_mfma_f32_16x16x32_bf16(rtf[ks], btf[ks], RB, 0, 0, 0);
          RK = __builtin_amdgcn_mfma_f32_16x16x32_bf16(rtf[ks], kdf[ks], RK, 0, 0, 0);
        }
#pragma unroll
        for (int r = 0; r < 4; ++r) {
          const int i = 4 * qm + r;
          const bool lo = c16 < i, le = c16 <= i;
          abf[i * 16 + c16] = lo ? AB[r] : 0.f;
          akm[i * 16 + c16] = f2bf(lo ? AK[r] : 0.f);
          rr[i * 32 + c16] = f2bf(le ? RB[r] : 0.f);
          rr[i * 32 + 16 + c16] = f2bf(le ? RK[r] : 0.f);
        }
      }
#define TFRAG(ks, nt, OUT) do { const f32x4 ta_ = Tl[((2 * (ks)) * 4 + (nt)) * 64 + lane], tb_ = Tl[((2 * (ks) + 1) * 4 + (nt)) * 64 + lane]; \
        OUT = pack8(ta_[0], ta_[1], ta_[2], ta_[3], tb_[0], tb_[1], tb_[2], tb_[3]); } while (0)
      lds_wait();
      {
        bf16x8 akf = {0, 0, 0, 0, 0, 0, 0, 0};
        if (q < 2) akf = *(const bf16x8*)(akm + c16 * 16 + q * 8);
#pragma unroll
        for (int nt = 0; nt < 4; ++nt) {
          f32x4 z = {0.f, 0.f, 0.f, 0.f};
          bf16x8 tf0, tf1; TFRAG(0, nt, tf0); TFRAG(1, nt, tf1);
          z = __builtin_amdgcn_mfma_f32_16x16x32_bf16(ktf[0], tf0, z, 0, 0, 0);
          z = __builtin_amdgcn_mfma_f32_16x16x32_bf16(ktf[1], tf1, z, 0, 0, 0);
          const bf16x8 vf = *(const bf16x8*)(uvt + (nt * 16 + c16) * 40 + 16 + (q & 1) * 8);
          z = __builtin_amdgcn_mfma_f32_16x16x32_bf16(akf, vf, z, 0, 0, 0);
#pragma unroll
          for (int r = 0; r < 4; ++r) zl[(4 * q + r) * 68 + nt * 16 + c16] = z[r];
        }
      }
      lds_wait();
      SBAR();
      {
        float U[16];
#pragma unroll
        for (int i = 0; i < 16; ++i) {
          float acc = -zl[i * 68 + lane];
#pragma unroll
          for (int s4 = 0; s4 < (i + 3) / 4; ++s4) {
            const float4 a4 = *(const float4*)(abf + i * 16 + s4 * 4);
            if (s4 * 4 + 0 < i) acc -= a4.x * U[s4 * 4 + 0];
            if (s4 * 4 + 1 < i) acc -= a4.y * U[s4 * 4 + 1];
            if (s4 * 4 + 2 < i) acc -= a4.z * U[s4 * 4 + 2];
            if (s4 * 4 + 3 < i) acc -= a4.w * U[s4 * 4 + 3];
          }
          U[i] = acc;
          if ((i & 3) == 3) SBAR();
        }
        *(bf16x8*)(uvt + lane * 40) = pack8(U[0], U[1], U[2], U[3], U[4], U[5], U[6], U[7]);
        *(bf16x8*)(uvt + lane * 40 + 8) = pack8(U[8], U[9], U[10], U[11], U[12], U[13], U[14], U[15]);
      }
      lds_wait();
      SBAR();
      {
        const bf16x8 rrf = *(const bf16x8*)(rr + c16 * 32 + q * 8);
        bf16x8 uvf[4];
#pragma unroll
        for (int nt = 0; nt < 4; ++nt) uvf[nt] = *(const bf16x8*)(uvt + (nt * 16 + c16) * 40 + q * 8);
#pragma unroll
        for (int nt = 0; nt < 4; ++nt) {
          f32x4 y = {0.f, 0.f, 0.f, 0.f};
          bf16x8 tf0, tf1; TFRAG(0, nt, tf0); TFRAG(1, nt, tf1);
          y = __builtin_amdgcn_mfma_f32_16x16x32_bf16(rtf[0], tf0, y, 0, 0, 0);
          y = __builtin_amdgcn_mfma_f32_16x16x32_bf16(rtf[1], tf1, y, 0, 0, 0);
          y = __builtin_amdgcn_mfma_f32_16x16x32_bf16(rrf, uvf[nt], y, 0, 0, 0);
#pragma unroll
          for (int r = 0; r < 4; ++r) { if (kind == 0) gst<u16>(b_y, off_y0 + (unsigned)(r * ystep) + nt * 32, f2bf(y[r])); }
        }
#pragma unroll
        for (int mt = 0; mt < 4; ++mt) {
          const bf16x8 bkf = *(const bf16x8*)(bkt + (mt * 16 + c16) * 40 + q * 8);
          const float4 pq = *(const float4*)(p15l + mt * 16 + q * 4);
#pragma unroll
          for (int nt = 0; nt < 4; ++nt) {
            f32x4 t = __builtin_amdgcn_mfma_f32_16x16x32_bf16(bkf, uvf[nt], Tl[(mt * 4 + nt) * 64 + lane], 0, 0, 0);
            t[0] *= pq.x; t[1] *= pq.y; t[2] *= pq.z; t[3] *= pq.w;
            Tl[(mt * 4 + nt) * 64 + lane] = t;
          }
        }
      }
      lds_wait();
    }
    if (pass == 0) {
      float* dst = s.tbuf + ((size_t)cs * 2 + (kind - 1)) * 4096;
#pragma unroll
      for (int m = 0; m < 16; ++m) *(f32x4*)(dst + (m * 64 + lane) * 4) = Tl[m * 64 + lane];
    }
  }
}

DEV void scan_combine_phase(const ScanP& s, char* lds_) {
  const int tid = ltid(), wid = __builtin_amdgcn_readfirstlane(tid >> 6), lane = tid & 63, c16 = lane & 15, q = lane >> 4;
  if (wid >= 2) return;
  float* til = (float*)(lds_ + wid * 16384);
  const int nchain = s.nseq * 64, nseg = s.nseg;
  for (int chain = wid * gridDim.x + blockIdx.x; chain < nchain; chain += 2 * gridDim.x) {
    f32x4 T[16];
#pragma unroll
    for (int m = 0; m < 16; ++m) T[m] = f32x4{0.f, 0.f, 0.f, 0.f};
    for (int seg = 0; seg < nseg; ++seg) {
      float* tn = s.tbuf + ((size_t)(chain * nseg + seg) * 2) * 4096; const float* ti = tn + 4096;
      lds_wait();
#pragma unroll
      for (int m = 0; m < 16; ++m) *(f32x4*)(til + (m * 64 + lane) * 4) = *(const f32x4*)(ti + (m * 64 + lane) * 4);
      lds_wait();
      f32x4 Tn[16];
#pragma unroll
      for (int m = 0; m < 16; ++m) Tn[m] = *(const f32x4*)(tn + (m * 64 + lane) * 4);
#pragma unroll
      for (int nt = 0; nt < 4; ++nt) {
        bf16x8 bh[2], bl[2];
#pragma unroll
        for (int ks = 0; ks < 2; ++ks) {
          const f32x4 ta = T[(2 * ks) * 4 + nt], tb = T[(2 * ks + 1) * 4 + nt];
          const float x[8] = {ta[0], ta[1], ta[2], ta[3], tb[0], tb[1], tb[2], tb[3]};
          float hf[8], lf[8];
#pragma unroll
          for (int e = 0; e < 8; ++e) { hf[e] = bf2f(f2bf(x[e])); lf[e] = x[e] - hf[e]; }
          bh[ks] = pack8(hf[0], hf[1], hf[2], hf[3], hf[4], hf[5], hf[6], hf[7]);
          bl[ks] = pack8(lf[0], lf[1], lf[2], lf[3], lf[4], lf[5], lf[6], lf[7]);
        }
#pragma unroll
        for (int mt = 0; mt < 4; ++mt) {
          f32x4 acc = Tn[mt * 4 + nt];
#pragma unroll
          for (int ks = 0; ks < 2; ++ks) {
            float x[8];
#pragma unroll
            for (int e = 0; e < 8; ++e) x[e] = til[((mt * 4 + 2 * ks + (e >> 2)) * 64 + ((c16 >> 2) & 3) * 16 + 4 * q + (e & 3)) * 4 + (c16 & 3)];
            float hf[8], lf[8];
#pragma unroll
            for (int e = 0; e < 8; ++e) { hf[e] = bf2f(f2bf(x[e])); lf[e] = x[e] - hf[e]; }
            const bf16x8 ah = pack8(hf[0], hf[1], hf[2], hf[3], hf[4], hf[5], hf[6], hf[7]);
            const bf16x8 al = pack8(lf[0], lf[1], lf[2], lf[3], lf[4], lf[5], lf[6], lf[7]);
            acc = __builtin_amdgcn_mfma_f32_16x16x32_bf16(ah, bh[ks], acc, 0, 0, 0);
            acc = __builtin_amdgcn_mfma_f32_16x16x32_bf16(ah, bl[ks], acc, 0, 0, 0);
            acc = __builtin_amdgcn_mfma_f32_16x16x32_bf16(al, bh[ks], acc, 0, 0, 0);
          }
          Tn[mt * 4 + nt] = acc;
        }
      }
#pragma unroll
      for (int m = 0; m < 16; ++m) { *(f32x4*)(tn + (m * 64 + lane) * 4) = T[m]; T[m] = Tn[m]; }
    }
  }
}

DEV void post_phase(u16* __restrict__ yf, const u16* __restrict__ yb, const u16* __restrict__ v, const u16* __restrict__ sg,
                    const float* __restrict__ bonus, const float* __restrict__ lg, const float* __restrict__ lb) {
  const int tid_ = ltid(); const int lane = tid_ & 63, wid = __builtin_amdgcn_readfirstlane(tid_ >> 6);
  for (int tok = blockIdx.x * 8 + wid; tok < GT; tok += gridDim.x * 8) {
#pragma unroll
    for (int it = 0; it < 4; ++it) {
      const int ch0 = it * 512 + lane * 8, h = ch0 >> 6; const size_t i = (size_t)tok * EI + ch0;
      const u32x4 a = *(const u32x4*)(yf + i), bq = *(const u32x4*)(yb + i), vv = *(const u32x4*)(v + i), gg = *(const u32x4*)(sg + i);
      const float2 bo = *(const float2*)(bonus + ((size_t)tok * 32 + h) * 2);
      float y[8]; float sum = 0.f;
#pragma unroll
      for (int e = 0; e < 4; ++e) { y[2 * e] = bflo(a[e]) + bflo(bq[e]); y[2 * e + 1] = bfhi(a[e]) + bfhi(bq[e]); sum += y[2 * e] + y[2 * e + 1]; }
      sum += __shfl_xor(sum, 1, 64); sum += __shfl_xor(sum, 2, 64); sum += __shfl_xor(sum, 4, 64);
      const float mean = sum * (1.f / 64.f);
      float var = 0.f;
#pragma unroll
      for (int e = 0; e < 8; ++e) { y[e] -= mean; var += y[e] * y[e]; }
      var += __shfl_xor(var, 1, 64); var += __shfl_xor(var, 2, 64); var += __shfl_xor(var, 4, 64);
      const float rs = rsqrtf(var * (1.f / 64.f) + 64e-5f), bon = bo.x + bo.y;
      const float4 g0 = *(const float4*)(lg + ch0), g1 = *(const float4*)(lg + ch0 + 4), b0 = *(const float4*)(lb + ch0), b1 = *(const float4*)(lb + ch0 + 4);
      const float ga[8] = {g0.x, g0.y, g0.z, g0.w, g1.x, g1.y, g1.z, g1.w}, ba[8] = {b0.x, b0.y, b0.z, b0.w, b1.x, b1.y, b1.z, b1.w};
      u32x4 o;
#pragma unroll
      for (int e = 0; e < 4; ++e) {
        const float o0 = (y[2 * e] * rs * ga[2 * e] + ba[2 * e] + bon * bflo(vv[e])) * bflo(gg[e]);
        const float o1 = (y[2 * e + 1] * rs * ga[2 * e + 1] + ba[2 * e + 1] + bon * bfhi(vv[e])) * bfhi(gg[e]);
        o[e] = cvtpk(o0, o1);
      }
      *(u32x4*)(yf + i) = o;
    }
  }
}

DEV void mla_mid_phase(const float* __restrict__ cqkv, const float* __restrict__ qn, const float* __restrict__ kvn,
                       const float* __restrict__ ct, const float* __restrict__ st,
                       u16* __restrict__ cqn, u16* __restrict__ ckvn, u16* __restrict__ kpe, int T) {
  const int tid_ = ltid(); const int lane = tid_ & 63, wid = __builtin_amdgcn_readfirstlane(tid_ >> 6);
  for (int tok = blockIdx.x * 8 + wid; tok < GT; tok += gridDim.x * 8) {
    const float* row = cqkv + (size_t)tok * 704;
    float q[6], ss = 0.f;
#pragma unroll
    for (int i = 0; i < 6; ++i) { q[i] = row[lane + i * 64]; ss += q[i] * q[i]; }
    ss = wsum(ss); float sc = rsqrtf(ss * (1.f / 384.f) + 1e-6f);
#pragma unroll
    for (int i = 0; i < 6; ++i) cqn[(size_t)tok * 384 + lane + i * 64] = f2bf(q[i] * sc * qn[lane + i * 64]);
    float c[4]; ss = 0.f;
#pragma unroll
    for (int i = 0; i < 4; ++i) { c[i] = row[384 + lane + i * 64]; ss += c[i] * c[i]; }
    ss = wsum(ss); sc = rsqrtf(ss * (1.f / 256.f) + 1e-6f);
#pragma unroll
    for (int i = 0; i < 4; ++i) ckvn[(size_t)tok * 256 + lane + i * 64] = f2bf(c[i] * sc * kvn[lane + i * 64]);
    const float x = row[640 + lane];
    const float xo = __shfl_xor(x, 32, 64);
    const int pos = tok % T, j = lane & 31;
    const float cs = ct[pos * 32 + j], sn = st[pos * 32 + j];
    const float o = lane < 32 ? x * cs - xo * sn : x * cs + xo * sn;
    kpe[(size_t)tok * 64 + lane] = f2bf(o);
  }
}

constexpr int SHM_V = 16384, SHM_K = 16384, SHM_KP = 8192;
#define KSWZ(row, colB) ((row) * 256 + ((colB) ^ (((row) & 7) << 4)))
#define KPSWZ(row, colB) ((row) * 128 + ((colB) ^ (((row) & 7) << 4)))
constexpr float ATT_SCALE = 0.07216878364870322f;
DEV void partialSM(f32x16& p0, f32x16& p1, float& m_reg, float& mn, float& alpha) {
  constexpr float C = ATT_SCALE * 1.4426950408889634f;
  float pmax = p0[0];
#pragma unroll
  for (int r = 1; r < 16; ++r) pmax = fmaxf(pmax, p0[r]);
#pragma unroll
  for (int r = 0; r < 16; ++r) pmax = fmaxf(pmax, p1[r]);
  { auto rr = __builtin_amdgcn_permlane32_swap(__float_as_uint(pmax), __float_as_uint(pmax), false, false);
    pmax = fmaxf(__uint_as_float(rr[0]), __uint_as_float(rr[1])); }
  mn = fmaxf(m_reg, pmax); alpha = __builtin_amdgcn_exp2f((m_reg - mn) * C); m_reg = mn;
  const float mnC = -mn * C;
#pragma unroll
  for (int r = 0; r < 16; ++r) p0[r] = __builtin_amdgcn_exp2f(fmaf(p0[r], C, mnC));
#pragma unroll
  for (int r = 0; r < 16; ++r) p1[r] = __builtin_amdgcn_exp2f(fmaf(p1[r], C, mnC));
}
DEV void finishSM(f32x16& p0, f32x16& p1, float alpha, float& l_reg, bf16x8& pa0, bf16x8& pa1, bf16x8& pa2, bf16x8& pa3) {
  float ps = 0;
#pragma unroll
  for (int r = 0; r < 16; ++r) ps += p0[r];
#pragma unroll
  for (int r = 0; r < 16; ++r) ps += p1[r];
  { auto rr = __builtin_amdgcn_permlane32_swap(__float_as_uint(ps), __float_as_uint(ps), false, false);
    ps = __uint_as_float(rr[0]) + __uint_as_float(rr[1]); }
  l_reg = l_reg * alpha + ps;
#define PK4(PP, BASE, OUT) do { unsigned a0 = cvtpk(PP[BASE + 0], PP[BASE + 1]), a1 = cvtpk(PP[BASE + 2], PP[BASE + 3]);   \
    unsigned b0 = cvtpk(PP[BASE + 4], PP[BASE + 5]), b1 = cvtpk(PP[BASE + 6], PP[BASE + 7]);                              \
    auto r0 = __builtin_amdgcn_permlane32_swap(a0, b0, false, false); auto r1 = __builtin_amdgcn_permlane32_swap(a1, b1, false, false); \
    u32x4 w = {r0[0], r1[0], r0[1], r1[1]}; OUT = *reinterpret_cast<bf16x8*>(&w); } while (0)
  PK4(p0, 0, pa0); PK4(p0, 8, pa1); PK4(p1, 0, pa2); PK4(p1, 8, pa3);
#undef PK4
}
DEV int v_st(int k, int c) { const int kk = (k & ~0xC) | ((k & 4) << 1) | ((k & 8) >> 1); return ((kk >> 3) * 4 + (c >> 5)) * 512 + ((kk & 7) * 32 + (c & 31)) * 2; }
DEV int v_rd_base(int lane) { return ((lane & 3) << 3) | (((lane >> 2) & 3) << 6) | (((lane >> 4) & 1) << 5) | (((lane >> 5) & 1) << 8); }
constexpr int v_rd_off(int d0, int ks, int half) { return d0 * 512 + ks * 4096 + half * 2048; }
template <int OFF> DEV s16x4 tr_read(int vb) {
  s16x4 r; asm volatile("ds_read_b64_tr_b16 %0, %1 offset:%2" : "=&v"(r) : "v"(vb), "i"(OFF) : "memory"); return r;
}
template <int D0> DEV void pv_one(f32x16& od, int vb, bf16x8 pa0, bf16x8 pa1, bf16x8 pa2, bf16x8 pa3) {
  const s16x4 l0 = tr_read<v_rd_off(D0, 0, 0)>(vb), h0 = tr_read<v_rd_off(D0, 0, 1)>(vb), l1 = tr_read<v_rd_off(D0, 1, 0)>(vb), h1 = tr_read<v_rd_off(D0, 1, 1)>(vb);
  const s16x4 l2 = tr_read<v_rd_off(D0, 2, 0)>(vb), h2 = tr_read<v_rd_off(D0, 2, 1)>(vb), l3 = tr_read<v_rd_off(D0, 3, 0)>(vb), h3 = tr_read<v_rd_off(D0, 3, 1)>(vb);
  asm volatile("s_waitcnt lgkmcnt(0)" ::: "memory"); SBAR();
#define PK(L, H) (bf16x8){L[0], L[1], L[2], L[3], H[0], H[1], H[2], H[3]}
  od = __builtin_amdgcn_mfma_f32_32x32x16_bf16(pa0, PK(l0, h0), od, 0, 0, 0);
  od = __builtin_amdgcn_mfma_f32_32x32x16_bf16(pa1, PK(l1, h1), od, 0, 0, 0);
  od = __builtin_amdgcn_mfma_f32_32x32x16_bf16(pa2, PK(l2, h2), od, 0, 0, 0);
  od = __builtin_amdgcn_mfma_f32_32x32x16_bf16(pa3, PK(l3, h3), od, 0, 0, 0);
#undef PK
}

struct AttnP { const u16* q; const u16* kv; const u16* kpe; u16* sg; const float* ct; const float* st; int nseq, T; int dry; };
DEV void attn_phase(const AttnP& a, char* lds) {
  const int tid = ltid(), wid = tid >> 6, lane = tid & 63, r32 = lane & 31, hi = lane >> 5;
  char* V_lds = lds; char* K_lds = lds + 2 * SHM_V; char* KP_lds = lds + 2 * SHM_V + 2 * SHM_K;
  float* wsc = (float*)(lds + 2 * SHM_V + 2 * SHM_K + 2 * SHM_KP) + wid * 64; float* li_l = wsc; float* al_l = wsc + 32;
  const int nqb = a.T / 256, nitems = a.nseq * 16 * nqb, NT = a.T / 64;
  const int sr = tid >> 4, sc = (tid & 15) * 8, vst0 = v_st(sr, sc), vst1 = v_st(32 + sr, sc);
  const int pr = tid >> 3, pc = (tid & 7) * 8;
  const int vb0 = (int)(uintptr_t)V_lds + v_rd_base(lane);
  int kad[4], kpd[4];
#pragma unroll
  for (int q = 0; q < 4; ++q) { kad[q] = KSWZ(r32, q * 32 + hi * 16); kpd[q] = KPSWZ(r32, q * 32 + hi * 16); }
  for (int it = blockIdx.x; it < nitems; it += gridDim.x) {
    const int qb = it % nqb, h = (it / nqb) & 15, b = it / (nqb * 16);
    const size_t sbase = (size_t)b * a.T;
    const int pos = qb * 256 + wid * 32 + r32;
    bf16x8 qr[12];
    {
      const u16* Qw = a.q + (sbase + pos) * 3072 + h * 192 + hi * 8;
#pragma unroll
      for (int d0 = 0; d0 < 12; ++d0) qr[d0] = *(const bf16x8*)(Qw + d0 * 16);
#pragma unroll
      for (int dd = 0; dd < 2; ++dd) {
        const int j0 = dd * 16 + hi * 8;
        const float4 c0 = *(const float4*)(a.ct + pos * 32 + j0), c1 = *(const float4*)(a.ct + pos * 32 + j0 + 4);
        const float4 s0 = *(const float4*)(a.st + pos * 32 + j0), s1 = *(const float4*)(a.st + pos * 32 + j0 + 4);
        const float cs[8] = {c0.x, c0.y, c0.z, c0.w, c1.x, c1.y, c1.z, c1.w};
        const float sn[8] = {s0.x, s0.y, s0.z, s0.w, s1.x, s1.y, s1.z, s1.w};
        u32x4 x1 = *(u32x4*)&qr[8 + dd], x2 = *(u32x4*)&qr[10 + dd], y1, y2;
#pragma unroll
        for (int e = 0; e < 4; ++e) {
          const float a0 = bflo(x1[e]), a1 = bfhi(x1[e]), b0 = bflo(x2[e]), b1 = bfhi(x2[e]);
          y1[e] = cvtpk(a0 * cs[2 * e] - b0 * sn[2 * e], a1 * cs[2 * e + 1] - b1 * sn[2 * e + 1]);
          y2[e] = cvtpk(b0 * cs[2 * e] + a0 * sn[2 * e], b1 * cs[2 * e + 1] + a1 * sn[2 * e + 1]);
        }
        qr[8 + dd] = *(bf16x8*)&y1; qr[10 + dd] = *(bf16x8*)&y2;
      }
    }
    float m_reg = -1e30f, l_reg = 0.f; f32x16 o[4] = {};
    bf16x8 vs0, vs1, ks0, ks1, kp0;
    const u16* kvh = a.kv + sbase * 4096 + h * 256;
    const u16* kph = a.kpe + sbase * 64;
    const unsigned voff = (unsigned)(sr * 8192 + sc * 2), poff = (unsigned)(pr * 128 + pc * 2);
#define SLOAD(k0) do { const char* bK0 = (const char*)kvh + (size_t)(k0) * 8192; const char* bK1 = bK0 + 32 * 8192; const char* bP = (const char*)kph + (size_t)(k0) * 128; \
    vs0 = *(const bf16x8*)(bK0 + voff + 256); vs1 = *(const bf16x8*)(bK1 + voff + 256); \
    ks0 = *(const bf16x8*)(bK0 + voff); ks1 = *(const bf16x8*)(bK1 + voff); \
    kp0 = *(const bf16x8*)(bP + poff); } while (0)
#define SWRITE(bb) do { *(bf16x8*)(V_lds + (bb) * SHM_V + vst0) = vs0; *(bf16x8*)(V_lds + (bb) * SHM_V + vst1) = vs1; \
    *(bf16x8*)(K_lds + (bb) * SHM_K + KSWZ(sr, sc * 2)) = ks0; *(bf16x8*)(K_lds + (bb) * SHM_K + KSWZ(32 + sr, sc * 2)) = ks1; \
    *(bf16x8*)(KP_lds + (bb) * SHM_KP + KPSWZ(pr, pc * 2)) = kp0; } while (0)
    __syncthreads();
    SLOAD(0); SWRITE(0); __syncthreads();
    for (int j = 0; j < NT; ++j) {
      const int bb = j & 1;
      if (j + 1 < NT) SLOAD((j + 1) * 64);
      SBAR();
      f32x16 p0 = {}, p1 = {};
      {
        const char* Ks = K_lds + bb * SHM_K; const char* Kp = KP_lds + bb * SHM_KP;
#pragma unroll
        for (int d0 = 0; d0 < 8; ++d0) {
          const bf16x8 b0 = *(const bf16x8*)(Ks + kad[d0 & 3] + (d0 >> 2) * 128), b1 = *(const bf16x8*)(Ks + kad[d0 & 3] + (d0 >> 2) * 128 + 8192);
          p0 = __builtin_amdgcn_mfma_f32_32x32x16_bf16(b0, qr[d0], p0, 0, 0, 0);
          p1 = __builtin_amdgcn_mfma_f32_32x32x16_bf16(b1, qr[d0], p1, 0, 0, 0); }
#pragma unroll
        for (int d0 = 0; d0 < 4; ++d0) {
          const bf16x8 b0 = *(const bf16x8*)(Kp + kpd[d0]), b1 = *(const bf16x8*)(Kp + kpd[d0] + 4096);
          p0 = __builtin_amdgcn_mfma_f32_32x32x16_bf16(b0, qr[8 + d0], p0, 0, 0, 0);
          p1 = __builtin_amdgcn_mfma_f32_32x32x16_bf16(b1, qr[8 + d0], p1, 0, 0, 0); }
      }
      float mn, alpha;
      partialSM(p0, p1, m_reg, mn, alpha);
      if (__any(alpha < 1.f)) {
        if (hi == 0) al_l[r32] = alpha;
        lds_wait();
#pragma unroll
        for (int dd = 0; dd < 4; ++dd)
#pragma unroll
          for (int r = 0; r < 16; ++r) o[dd][r] *= al_l[crow(r, hi)];
      }
      bf16x8 pa0, pa1, pa2, pa3;
      finishSM(p0, p1, alpha, l_reg, pa0, pa1, pa2, pa3); SBAR();
      const int vb = vb0 + bb * SHM_V;
      pv_one<0>(o[0], vb, pa0, pa1, pa2, pa3); pv_one<1>(o[1], vb, pa0, pa1, pa2, pa3);
      pv_one<2>(o[2], vb, pa0, pa1, pa2, pa3); pv_one<3>(o[3], vb, pa0, pa1, pa2, pa3);
      if (j + 1 < NT) SWRITE(bb ^ 1);
      __syncthreads();
    }
#undef SLOAD
#undef SWRITE
    {
      int t2 = threadIdx.x; asm volatile("" : "+v"(t2));
      const int wid2 = t2 >> 6, r2 = t2 & 31, hi2 = (t2 >> 5) & 1;
      float* li2 = (float*)(lds + 2 * SHM_V + 2 * SHM_K + 2 * SHM_KP) + wid2 * 64;
      if (hi2 == 0) li2[r2] = l_reg;
      lds_wait();
      u16* Ow = a.sg + (sbase + qb * 256 + wid2 * 32) * EI + h * 128 + r2;
#pragma unroll
      for (int r = 0; r < 16; ++r) {
        const int orow = crow(r, hi2);
        const float rl = __builtin_amdgcn_rcpf(li2[orow]);
#pragma unroll
        for (int d0 = 0; d0 < 4; ++d0) {
          u16* pp = Ow + (size_t)orow * EI + d0 * 32;
          if (!a.dry) *pp = f2bf(o[d0][r] * rl * bf2f(*pp));
        }
      }
    }
  }
}

#if MEGA
#define GRID_SYNC() gsync(p, lds)
#else
#define GRID_SYNC() do {} while (0)
#endif
struct Grp { const float* xin0; float* xres; int nseq, T; };
DEV Grp get_group(const P& p, int g) {
  Grp r;
  r.xin0 = g == 0 ? p.x_prompt : p.x_sample + (size_t)(g - 1) * GT * DM;
  r.xres = p.out + (size_t)g * GT * DM;
  r.nseq = g == 0 ? 8 : 1; r.T = g == 0 ? 2048 : 16384;
  return r;
}
template <int LT, int ph>
DEV void run_phase(const P& p, int g, int layer, char* lds) {
  const Grp G = get_group(p, g);
  const int j = layer >> 1;
  const float* xin = layer == 0 ? G.xin0 : G.xres;
  size_t zoff = 0; asm volatile("" : "+s"(zoff));
  char* ws = p.ws + zoff;
  u16* hbuf = (u16*)(ws + O_HBUF);
  u16* sg = (u16*)(ws + O_SG);
  if constexpr (LT == 0) {
    u16 *rb = (u16*)(ws + O_RB), *kb = (u16*)(ws + O_KB), *vb = (u16*)(ws + O_VB), *yf = (u16*)(ws + O_YF), *yb = (u16*)(ws + O_YB);
    u16 *twl = (u16*)(ws + O_TWL), *al = (u16*)(ws + O_AL); float* bon = (float*)(ws + O_BON);
    if constexpr (ph == 0) rms_phase(xin, p.ln_g + layer * DM, hbuf);
    else if constexpr (ph == 1) {
      GemmP q{}; q.A = hbuf; q.lda = DM; q.Bt = (const u16*)(ws + O_WRWIN) + (size_t)j * RW_N * DM; q.K = DM; q.NT = 66;
      q.mu = p.rw_mu + (size_t)j * 6 * DM; q.T = G.T; q.o0 = rb; q.o1 = kb; q.o2 = vb; q.o3 = sg; q.o4 = twl; q.o5 = al;
      for (int rep = 1; rep < REP_GEMM; ++rep) { q.dry = (gridDim.x != 12345); gemm_phase<LOAD_LERP, EPI_RWKV>(q, lds); } q.dry = 0;
      gemm_phase<LOAD_LERP, EPI_RWKV>(q, lds);
    } else if constexpr (ph == 2) {
      ScanP s{}; s.r = rb; s.k = kb; s.v = vb; s.twl = twl; s.al = al; s.yf = yf; s.yb = yb; s.bonus = bon;
      s.w0 = p.rw_w0 + (size_t)j * 2 * EI; s.w2 = p.rw_w2 + (size_t)j * 2 * 64 * EI; s.a0 = p.rw_a0 + (size_t)j * 2 * EI; s.a2 = p.rw_a2 + (size_t)j * 2 * 64 * EI;
      s.kk = p.rw_kk + (size_t)j * EI; s.ka = p.rw_ka + (size_t)j * EI; s.rk = p.rw_rk + (size_t)j * EI; s.nseq = G.nseq; s.T = G.T;
      s.tbuf = (float*)hbuf;
      if (G.T > 2048) {
        s.nseg = 16;
        scan_phase(s, lds, 0); GRID_SYNC();
        scan_combine_phase(s, lds); GRID_SYNC();
        scan_phase(s, lds, 1);
      } else { s.nseg = 1; scan_phase(s, lds, 1); }
    } else if constexpr (ph == 3) post_phase(yf, yb, vb, sg, bon, p.rw_lnx_g + (size_t)j * EI, p.rw_lnx_b + (size_t)j * EI);
    else {
      GemmP q{}; q.A = yf; q.lda = EI; q.Bt = (const u16*)(ws + O_WRWOUT) + (size_t)j * DM * EI; q.K = EI; q.NT = 8; q.xin = xin; q.xout = G.xres;
      for (int rep = 1; rep < REP_GEMM; ++rep) { q.dry = (gridDim.x != 12345); gemm_phase<LOAD_PLAIN, EPI_RES>(q, lds); } q.dry = 0;
      gemm_phase<LOAD_PLAIN, EPI_RES>(q, lds);
    }
  } else {
    float* cqkv = (float*)(ws + O_CQKV); u16 *cqn = (u16*)(ws + O_CQN), *ckvn = (u16*)(ws + O_CKVN), *kpe = (u16*)(ws + O_KPE), *qq = (u16*)(ws + O_Q), *kv = (u16*)(ws + O_KV);
    const float* ct = (const float*)(ws + O_COS); const float* st = (const float*)(ws + O_SIN);
    if constexpr (ph == 0) rms_phase(xin, p.ln_g + layer * DM, hbuf);
    else if constexpr (ph == 1) {
      GemmP q{}; q.A = hbuf; q.lda = DM; q.Bt = (const u16*)(ws + O_WMLIN) + (size_t)j * ML_NP * DM; q.K = DM; q.NT = 22; q.of = cqkv; q.o0 = sg;
      for (int rep = 1; rep < REP_GEMM; ++rep) { q.dry = (gridDim.x != 12345); gemm_phase<LOAD_PLAIN, EPI_MLAIN>(q, lds); } q.dry = 0;
      gemm_phase<LOAD_PLAIN, EPI_MLAIN>(q, lds);
    } else if constexpr (ph == 2) mla_mid_phase(cqkv, p.ml_qn + j * 384, p.ml_kvn + j * 256, ct, st, cqn, ckvn, kpe, G.T);
    else if constexpr (ph == 3) {
      GemmP q{}; q.A = cqn; q.lda = 384; q.Bt = (const u16*)(ws + O_WUQ) + (size_t)j * 3072 * 384; q.K = 384; q.NT = 24; q.o0 = qq; q.ldc = 3072;
      for (int rep = 1; rep < REP_GEMM; ++rep) { q.dry = (gridDim.x != 12345); gemm_phase<LOAD_PLAIN, EPI_BF16>(q, lds); } q.dry = 0;
      gemm_phase<LOAD_PLAIN, EPI_BF16>(q, lds);
      GemmP r{}; r.A = ckvn; r.lda = 256; r.Bt = (const u16*)(ws + O_WUKV) + (size_t)j * 4096 * 256; r.K = 256; r.NT = 32; r.o0 = kv; r.ldc = 4096;
      for (int rep = 1; rep < REP_GEMM; ++rep) { r.dry = (gridDim.x != 12345); gemm_phase<LOAD_PLAIN, EPI_BF16>(r, lds); } r.dry = 0;
      gemm_phase<LOAD_PLAIN, EPI_BF16>(r, lds);
    } else if constexpr (ph == 4) {
      AttnP a{}; a.q = qq; a.kv = kv; a.kpe = kpe; a.sg = sg; a.ct = ct; a.st = st; a.nseq = G.nseq; a.T = G.T;
      for (int rep = 1; rep < REP_ATTN; ++rep) { a.dry = (gridDim.x != 12345); attn_phase(a, lds); } a.dry = 0;
      attn_phase(a, lds);
    } else {
      GemmP q{}; q.A = sg; q.lda = EI; q.Bt = (const u16*)(ws + O_WMLOUT) + (size_t)j * DM * EI; q.K = EI; q.NT = 8; q.xin = xin; q.xout = G.xres;
      for (int rep = 1; rep < REP_GEMM; ++rep) { q.dry = (gridDim.x != 12345); gemm_phase<LOAD_PLAIN, EPI_RES>(q, lds); } q.dry = 0;
      gemm_phase<LOAD_PLAIN, EPI_RES>(q, lds);
    }
  }
}


template <int LT, int PH>
__global__ __launch_bounds__(512) void k_phase(P p, int g, int layer) {
  extern __shared__ __attribute__((aligned(16))) char lds[];
  if constexpr (LT == 2) { if constexpr (PH == 0) init_phase(p, lds); else final_phase(p.out, p.final_g); }
  else run_phase<LT, PH>(p, g, layer, lds);
}

#if MEGA
__global__ __launch_bounds__(512) void k_mega(P p) {
  extern __shared__ __attribute__((aligned(16))) char lds[];
  cg::grid_group grid = cg::this_grid();
  {
    unsigned* bar = (unsigned*)(p.ws + O_BAR);
    if (blockIdx.x == 0) for (int i = threadIdx.x; i < XCD_BAR_WORDS; i += 512) bar[i] = 0u;
    if (threadIdx.x == 0) { volatile LAS unsigned* st = (volatile LAS unsigned*)(lds + SHM_BYTES - 16); st[0] = 0u; st[1] = 0u; }
  }
  init_phase(p, lds);
  grid.sync();
  if (threadIdx.x == 0) (void)xb_add(&((unsigned*)(p.ws + O_BAR))[XB_XCNT(xb_xcc_id())], 1u);
  for (int g = 0; g < 3; ++g)
    for (int layer = 0; layer < 4; ++layer) {
      if ((layer & 1) == 0) {
        run_phase<0, 0>(p, g, layer, lds); gsync(p, lds); run_phase<0, 1>(p, g, layer, lds); gsync(p, lds); run_phase<0, 2>(p, g, layer, lds); gsync(p, lds);
        run_phase<0, 3>(p, g, layer, lds); gsync(p, lds); run_phase<0, 4>(p, g, layer, lds); gsync(p, lds);
      } else {
        run_phase<1, 0>(p, g, layer, lds); gsync(p, lds); run_phase<1, 1>(p, g, layer, lds); gsync(p, lds); run_phase<1, 2>(p, g, layer, lds); gsync(p, lds);
        run_phase<1, 3>(p, g, layer, lds); gsync(p, lds); run_phase<1, 4>(p, g, layer, lds); gsync(p, lds); run_phase<1, 5>(p, g, layer, lds); gsync(p, lds);
      }
    }
  final_phase(p.out, p.final_g);
}
#endif

extern "C" void kernel_launch(void* const* d_in, const int* in_sizes, int n_in, void* d_out, int out_size, void* d_ws, size_t ws_size, hipStream_t stream) {
  if (n_in != 22 || ws_size < WS_NEED) { fprintf(stderr, "kernel_launch: bad args n_in %d ws %zu need %zu\n", n_in, ws_size, WS_NEED); return; }
  P p{};
  const float** f = (const float**)&p;
  for (int i = 0; i < 22; ++i) f[i] = (const float*)d_in[i];
  p.out = (float*)d_out; p.ws = (char*)d_ws;
#if MEGA
  static int grid_blocks = 0;
  if (!grid_blocks) {
    hipFuncSetAttribute((const void*)k_mega, hipFuncAttributeMaxDynamicSharedMemorySize, SHM_BYTES);
    int dev = 0, cus = 0, per_cu = 0;
    hipGetDevice(&dev);
    hipDeviceGetAttribute(&cus, hipDeviceAttributeMultiprocessorCount, dev);
    hipOccupancyMaxActiveBlocksPerMultiprocessor(&per_cu, k_mega, 512, SHM_BYTES);
    if (per_cu > 1) per_cu = 1;
    grid_blocks = cus * per_cu;
  }
  void* args[] = {&p};
  hipError_t e = hipLaunchCooperativeKernel((void*)k_mega, dim3(grid_blocks), dim3(512), args, SHM_BYTES, stream);
  if (e != hipSuccess) fprintf(stderr, "cooperative launch failed: %s (grid %d)\n", hipGetErrorString(e), grid_blocks);
#else
  const int NB = 256;
#define LAUNCH(LT, PH, g, layer) do { static int inited = 0; if (!inited) { hipFuncSetAttribute((const void*)k_phase<LT, PH>, hipFuncAttributeMaxDynamicSharedMemorySize, SHM_BYTES); inited = 1; } \
    hipLaunchKernelGGL((k_phase<LT, PH>), dim3(NB), dim3(512), SHM_BYTES, stream, p, g, layer); } while (0)
  LAUNCH(2, 0, 0, 0);
  for (int g = 0; g < 3; ++g)
    for (int layer = 0; layer < 4; ++layer) {
      if ((layer & 1) == 0) { LAUNCH(0, 0, g, layer); LAUNCH(0, 1, g, layer); LAUNCH(0, 2, g, layer); LAUNCH(0, 3, g, layer); LAUNCH(0, 4, g, layer); }
      else { LAUNCH(1, 0, g, layer); LAUNCH(1, 1, g, layer); LAUNCH(1, 2, g, layer); LAUNCH(1, 3, g, layer); LAUNCH(1, 4, g, layer); LAUNCH(1, 5, g, layer); }
    }
  LAUNCH(2, 1, 0, 0);
#endif
}
```

```cpp
#include <hip/hip_runtime.h>
#include <hip/hip_bf16.h>
#include <hip/hip_cooperative_groups.h>
#include <cstdio>
namespace cg = cooperative_groups;

#ifndef REP_GEMM
#define REP_GEMM 1
#endif
#ifndef REP_ATTN
#define REP_ATTN 1
#endif
#ifndef REP_SCAN
#define REP_SCAN 1
#endif
#ifndef MEGA
#define MEGA 1
#endif

typedef unsigned short u16;
using bf16x8 = __attribute__((ext_vector_type(8))) short;
using s16x4  = __attribute__((ext_vector_type(4))) short;
using f32x16 = __attribute__((ext_vector_type(16))) float;
using f32x4  = __attribute__((ext_vector_type(4))) float;
using u32x4  = __attribute__((ext_vector_type(4))) unsigned;
using u32x2  = __attribute__((ext_vector_type(2))) unsigned;
#define DEV __device__ __forceinline__
#define SBAR() __builtin_amdgcn_sched_barrier(0)

constexpr int DM = 1024, EI = 2048, GT = 16384;
constexpr int NTOK = 49152;
constexpr int RW_N = 8448, ML_N = 2752, ML_NP = 2816;
constexpr int SHM_BYTES = 158720;

constexpr size_t alup(size_t x) { return (x + 255) / 256 * 256; }
constexpr size_t O_WRWIN  = 0;
constexpr size_t O_WRWOUT = O_WRWIN  + alup((size_t)2 * RW_N * DM * 2);
constexpr size_t O_WMLIN  = O_WRWOUT + alup((size_t)2 * DM * EI * 2);
constexpr size_t O_WUQ    = O_WMLIN  + alup((size_t)2 * ML_NP * DM * 2);
constexpr size_t O_WUKV   = O_WUQ    + alup((size_t)2 * 3072 * 384 * 2);
constexpr size_t O_WMLOUT = O_WUKV   + alup((size_t)2 * 4096 * 256 * 2);
constexpr size_t O_COS    = O_WMLOUT + alup((size_t)2 * DM * EI * 2);
constexpr size_t O_SIN    = O_COS    + alup((size_t)16384 * 32 * 4);
constexpr size_t O_HBUF   = O_SIN    + alup((size_t)16384 * 32 * 4);
constexpr size_t O_R0     = O_HBUF   + alup((size_t)GT * DM * 2);
constexpr size_t SZ_E = (size_t)GT * EI * 2;
constexpr size_t O_SG   = O_R0;
constexpr size_t O_RB   = O_SG + SZ_E;
constexpr size_t O_KB   = O_RB + SZ_E;
constexpr size_t O_VB   = O_KB + SZ_E;
constexpr size_t O_YF   = O_VB + SZ_E;
constexpr size_t O_YB   = O_YF + SZ_E;
constexpr size_t O_TWL  = O_YB + SZ_E;
constexpr size_t O_AL   = O_TWL + alup((size_t)GT * 128 * 2);
constexpr size_t O_BON  = O_AL  + alup((size_t)GT * 128 * 2);
constexpr size_t O_RW_END = O_BON + alup((size_t)GT * 64 * 4);
constexpr size_t O_CQKV = O_SG + SZ_E;
constexpr size_t O_CQN  = O_CQKV + alup((size_t)GT * 704 * 4);
constexpr size_t O_CKVN = O_CQN  + alup((size_t)GT * 384 * 2);
constexpr size_t O_KPE  = O_CKVN + alup((size_t)GT * 256 * 2);
constexpr size_t O_Q    = O_KPE  + alup((size_t)GT * 64 * 2);
constexpr size_t O_KV   = O_Q    + alup((size_t)GT * 3072 * 2);
constexpr size_t O_ML_END = O_KV + alup((size_t)GT * 4096 * 2);
constexpr size_t O_FLAG = O_RW_END > O_ML_END ? O_RW_END : O_ML_END;
constexpr size_t O_BAR = O_FLAG + 256;
constexpr size_t WS_NEED = O_BAR + 16384;

struct P {
  const float* x_prompt; const float* x_sample; const float* ln_g; const float* final_g;
  const float* rw_mu; const float* rw_in; const float* rw_w0; const float* rw_w2; const float* rw_a0; const float* rw_a2;
  const float* rw_kk; const float* rw_ka; const float* rw_rk; const float* rw_lnx_g; const float* rw_lnx_b; const float* rw_out;
  const float* ml_in; const float* ml_qn; const float* ml_kvn; const float* ml_uq; const float* ml_ukv; const float* ml_out;
  float* out; char* ws;
};

typedef __attribute__((ext_vector_type(2))) __bf16 bf16x2_t;
typedef __attribute__((ext_vector_type(2))) float f32x2_t;
DEV unsigned cvtpk(float lo, float hi) { f32x2_t v = {lo, hi}; bf16x2_t b = __builtin_convertvector(v, bf16x2_t); return __builtin_bit_cast(unsigned, b); }
DEV float bf2f(u16 x) { return __uint_as_float(((unsigned)x) << 16); }
DEV float bflo(unsigned x) { return __uint_as_float(x << 16); }
DEV float bfhi(unsigned x) { return __uint_as_float(x & 0xffff0000u); }
DEV u16 f2bf(float x) { __bf16 b = (__bf16)x; return __builtin_bit_cast(u16, b); }
DEV float wsum(float v) {
#pragma unroll
  for (int o = 32; o >= 1; o >>= 1) v += __shfl_xor(v, o, 64);
  return v;
}
DEV float siluf(float x) { return x / (1.f + __expf(-x)); }
DEV int crow(int r, int hi) { return (r & 3) + 8 * (r >> 2) + 4 * hi; }
DEV int ltid() { int t = threadIdx.x; asm volatile("" : "+v"(t)); return t; }
template <typename T> DEV T gld(size_t base, unsigned off) { return *(const __attribute__((address_space(1))) T*)(base + off); }
template <typename T> DEV void gst(size_t base, unsigned off, T v) { *(__attribute__((address_space(1))) T*)(base + off) = v; }
DEV void lds_wait() { asm volatile("s_waitcnt lgkmcnt(0)" ::: "memory"); }


#define XB_TMO      128
#define XB_XCNT(j)  (256  + 64 * (j))
#define XB_XSUB(j)  (1280 + 64 * (j))
#define XB_XGEN(j)  (2304 + 64 * (j))
#define XB_TOP      3328
#define XB_TOPGEN   3392
#define XCD_BAR_WORDS 3456
#define XB_SPIN_CAP (1u << 22)
#define LAS __attribute__((address_space(3)))
DEV unsigned xb_ld(unsigned* p)              { return __hip_atomic_load(p, __ATOMIC_RELAXED, __HIP_MEMORY_SCOPE_AGENT); }
DEV unsigned xb_add(unsigned* p, unsigned v) { return __hip_atomic_fetch_add(p, v, __ATOMIC_RELAXED, __HIP_MEMORY_SCOPE_AGENT); }
DEV unsigned xb_xcc_id() { return (unsigned)__builtin_amdgcn_s_getreg((3 << 11) | 20) & 0xFu; }
#define XB_SPIN(cond, bar) do { unsigned _sp = 0; while (cond) { __builtin_amdgcn_s_sleep(1); \
    if ((++_sp & 255u) == 0u) { if (xb_ld(&(bar)[XB_TMO])) break; if (_sp > XB_SPIN_CAP) { atomicAdd(&(bar)[XB_TMO], 1u); break; } } } } while (0)
struct XcdBarrier { unsigned* bar; unsigned x; volatile LAS unsigned* st; };
DEV void xcd_barrier_complete(unsigned* bar, unsigned x, unsigned& nloc, unsigned& nx) {
  const unsigned G = gridDim.x * gridDim.y * gridDim.z;
  unsigned sum, cnt, mine, sp = 0u;
  for (;;) {
    sum = 0u; cnt = 0u; mine = 0u;
#pragma unroll
    for (unsigned j = 0; j < 16; ++j) { const unsigned c = xb_ld(&bar[XB_XCNT(j)]); sum += c; cnt += (c > 0u) ? 1u : 0u; mine = (j == x) ? c : mine; }
    if (sum == G) break;
    __builtin_amdgcn_s_sleep(1);
    if ((++sp & 255u) == 0u) { if (xb_ld(&bar[XB_TMO])) break; if (sp > XB_SPIN_CAP) { atomicAdd(&bar[XB_TMO], 1u); break; } }
  }
  nloc = mine > 0u ? mine : 1u; nx = cnt > 0u ? cnt : 1u;
}
DEV void xcd_barrier(const XcdBarrier& b) {
  asm volatile("s_waitcnt vmcnt(0)" ::: "memory");
  __syncthreads();
  if (threadIdx.x == 0) {
    unsigned* bar = b.bar;
    __builtin_amdgcn_s_waitcnt(0);
    unsigned nloc = b.st[0], nx = b.st[1];
    if (nloc == 0u) { xcd_barrier_complete(bar, b.x, nloc, nx); b.st[0] = nloc; b.st[1] = nx; }
    const unsigned old = xb_add(&bar[XB_XSUB(b.x)], 1u);
    const unsigned gen = old / nloc;
    if (old + 1u == (gen + 1u) * nloc) {
      __builtin_amdgcn_fence(__ATOMIC_RELEASE, "agent");
      asm volatile("s_waitcnt vmcnt(0)" ::: "memory");
      const unsigned og = xb_add(&bar[XB_TOP], 1u);
      const unsigned tg = og / nx;
      if (og + 1u == (tg + 1u) * nx) xb_add(&bar[XB_TOPGEN], 1u);
      else XB_SPIN(xb_ld(&bar[XB_TOPGEN]) == tg, bar);
      __builtin_amdgcn_fence(__ATOMIC_ACQUIRE, "agent");
      xb_add(&bar[XB_XGEN(b.x)], 1u);
      asm volatile("s_waitcnt vmcnt(0)" ::: "memory");
    } else {
      XB_SPIN(xb_ld(&bar[XB_XGEN(b.x)]) == gen, bar);
      __builtin_amdgcn_fence(__ATOMIC_ACQUIRE, "agent");
      asm volatile("s_waitcnt vmcnt(0)" ::: "memory");
    }
  }
  __syncthreads();
}
DEV void gsync(const P& p, char* lds) {
  XcdBarrier b; b.bar = (unsigned*)(p.ws + O_BAR); b.x = xb_xcc_id(); b.st = (volatile LAS unsigned*)(lds + SHM_BYTES - 16);
  xcd_barrier(b);
}

DEV void convert_T(const float* __restrict__ src, u16* __restrict__ dst, int K, int N, int Npad, char* lds_) {
  float* lds = (float*)lds_;
  const int tid = ltid(), tk = K / 64, tn = Npad / 64;
  for (int t = blockIdx.x; t < tk * tn; t += gridDim.x) {
    const int k0 = (t % tk) * 64, n0 = (t / tk) * 64;
    __syncthreads();
#pragma unroll
    for (int i = 0; i < 2; ++i) {
      const int kr = (tid >> 4) + i * 32, c = (tid & 15) * 4;
      float4 v = make_float4(0.f, 0.f, 0.f, 0.f);
      if (n0 + c < N) v = *(const float4*)(src + (long)(k0 + kr) * N + n0 + c);
      lds[kr * 65 + c + 0] = v.x; lds[kr * 65 + c + 1] = v.y; lds[kr * 65 + c + 2] = v.z; lds[kr * 65 + c + 3] = v.w;
    }
    __syncthreads();
    const int n = tid >> 3, kc = (tid & 7) * 8;
    u32x4 w;
    w[0] = cvtpk(lds[(kc + 0) * 65 + n], lds[(kc + 1) * 65 + n]);
    w[1] = cvtpk(lds[(kc + 2) * 65 + n], lds[(kc + 3) * 65 + n]);
    w[2] = cvtpk(lds[(kc + 4) * 65 + n], lds[(kc + 5) * 65 + n]);
    w[3] = cvtpk(lds[(kc + 6) * 65 + n], lds[(kc + 7) * 65 + n]);
    *(u32x4*)(dst + (long)(n0 + n) * K + k0 + kc) = w;
  }
}

DEV void init_phase(const P& p, char* lds) {
  for (int j = 0; j < 2; ++j) {
    convert_T(p.rw_in  + (size_t)j * DM * RW_N, (u16*)(p.ws + O_WRWIN)  + (size_t)j * RW_N * DM, DM, RW_N, RW_N, lds);
    convert_T(p.rw_out + (size_t)j * EI * DM,   (u16*)(p.ws + O_WRWOUT) + (size_t)j * DM * EI,   EI, DM, DM, lds);
    convert_T(p.ml_in  + (size_t)j * DM * ML_N, (u16*)(p.ws + O_WMLIN)  + (size_t)j * ML_NP * DM, DM, ML_N, ML_NP, lds);
    convert_T(p.ml_uq  + (size_t)j * 384 * 3072, (u16*)(p.ws + O_WUQ)   + (size_t)j * 3072 * 384, 384, 3072, 3072, lds);
    convert_T(p.ml_ukv + (size_t)j * 256 * 4096, (u16*)(p.ws + O_WUKV)  + (size_t)j * 4096 * 256, 256, 4096, 4096, lds);
    convert_T(p.ml_out + (size_t)j * EI * DM,   (u16*)(p.ws + O_WMLOUT) + (size_t)j * DM * EI,   EI, DM, DM, lds);
  }
  float* ct = (float*)(p.ws + O_COS); float* st = (float*)(p.ws + O_SIN);
  const int tid_ = ltid();
  for (int i = blockIdx.x * 512 + tid_; i < 16384 * 32; i += gridDim.x * 512) {
    const int pos = i >> 5, j = i & 31;
    const float invf = 1.0f / powf(10000.0f, (float)(2 * j) / 64.0f);
    const float ang = (float)pos * invf;
    const double a = (double)ang;
    const double n = rint(a * 0.15915494309189535);
    const float r = (float)(a - n * 6.283185307179586);
    ct[i] = cosf(r); st[i] = sinf(r);
  }
}

DEV void rms_phase(const float* __restrict__ x, const float* __restrict__ g, u16* __restrict__ hout) {
  const int tid_ = ltid(); const int lane = tid_ & 63, wid = __builtin_amdgcn_readfirstlane(tid_ >> 6);
  for (int tok = blockIdx.x * 8 + wid; tok < GT; tok += gridDim.x * 8) {
    const float4* xr = (const float4*)(x + (size_t)tok * DM);
    float4 v[4]; float ss = 0.f;
#pragma unroll
    for (int i = 0; i < 4; ++i) { v[i] = xr[lane + i * 64]; ss += v[i].x * v[i].x + v[i].y * v[i].y + v[i].z * v[i].z + v[i].w * v[i].w; }
    ss = wsum(ss);
    const float sc = rsqrtf(ss * (1.f / DM) + 1e-6f);
#pragma unroll
    for (int i = 0; i < 4; ++i) {
      const float4 gg = ((const float4*)g)[lane + i * 64];
      u32x2 w; w[0] = cvtpk(v[i].x * sc * gg.x, v[i].y * sc * gg.y); w[1] = cvtpk(v[i].z * sc * gg.z, v[i].w * sc * gg.w);
      *(u32x2*)(hout + (size_t)tok * DM + (lane + i * 64) * 4) = w;
    }
  }
}

DEV void final_phase(float* __restrict__ x, const float* __restrict__ g) {
  const int tid_ = ltid(); const int lane = tid_ & 63, wid = __builtin_amdgcn_readfirstlane(tid_ >> 6);
  for (int tok = blockIdx.x * 8 + wid; tok < NTOK; tok += gridDim.x * 8) {
    float4* xr = (float4*)(x + (size_t)tok * DM);
    float4 v[4]; float ss = 0.f;
#pragma unroll
    for (int i = 0; i < 4; ++i) { v[i] = xr[lane + i * 64]; ss += v[i].x * v[i].x + v[i].y * v[i].y + v[i].z * v[i].z + v[i].w * v[i].w; }
    ss = wsum(ss);
    const float sc = rsqrtf(ss * (1.f / DM) + 1e-6f);
#pragma unroll
    for (int i = 0; i < 4; ++i) {
      const float4 gg = ((const float4*)g)[lane + i * 64];
      float4 ov = make_float4(v[i].x * sc * gg.x, v[i].y * sc * gg.y, v[i].z * sc * gg.z, v[i].w * sc * gg.w);
      xr[lane + i * 64] = ov;
    }
  }
}


DEV void lerp_phase(const u16* __restrict__ h, const float* __restrict__ mu, u16* __restrict__ out, int T) {
  const int tid_ = ltid(); const int lane = tid_ & 63, wid = __builtin_amdgcn_readfirstlane(tid_ >> 6);
  for (int tok = blockIdx.x * 8 + wid; tok < GT; tok += gridDim.x * 8) {
    const int pos = tok % T;
#pragma unroll
    for (int half = 0; half < 2; ++half) {
      const int c0 = half * 512 + lane * 8;
      const u32x4 c = *(const u32x4*)(h + (size_t)tok * DM + c0);
      u32x4 pv = {0u, 0u, 0u, 0u}, nx = {0u, 0u, 0u, 0u};
      if (pos > 0) pv = *(const u32x4*)(h + (size_t)(tok - 1) * DM + c0);
      if (pos < T - 1) nx = *(const u32x4*)(h + (size_t)(tok + 1) * DM + c0);
      float hh[8], xx[8];
#pragma unroll
      for (int e = 0; e < 4; ++e) {
        hh[2 * e] = bflo(c[e]); hh[2 * e + 1] = bfhi(c[e]);
        xx[2 * e] = 0.5f * (bflo(pv[e]) + bflo(nx[e])) - hh[2 * e]; xx[2 * e + 1] = 0.5f * (bfhi(pv[e]) + bfhi(nx[e])) - hh[2 * e + 1];
      }
#pragma unroll
      for (int st = 0; st < 4; ++st) {
        const int mi = st == 0 ? 0 : st == 1 ? 2 : st == 2 ? 3 : 5;
        const float4 m0v = *(const float4*)(mu + mi * DM + c0), m1v = *(const float4*)(mu + mi * DM + c0 + 4);
        const float m[8] = {m0v.x, m0v.y, m0v.z, m0v.w, m1v.x, m1v.y, m1v.z, m1v.w};
        u32x4 o;
#pragma unroll
        for (int e = 0; e < 4; ++e) o[e] = cvtpk(hh[2 * e] + m[2 * e] * xx[2 * e], hh[2 * e + 1] + m[2 * e + 1] * xx[2 * e + 1]);
        *(u32x4*)(out + (size_t)st * GT * DM + (size_t)tok * DM + c0) = o;
      }
    }
  }
}

#define GSWZ(row, c16) ((row) * 128 + ((((c16) ^ ((row) >> 1)) & 7) << 4))
constexpr int LOAD_PLAIN = 0, LOAD_LERP = 1;
constexpr int EPI_RWKV = 0, EPI_RES = 1, EPI_MLAIN = 2, EPI_BF16 = 3;
struct GemmP {
  const u16* A; int lda; const u16* Bt; int K; int NT;
  const float* mu;
  int T;
  u16* o0; u16* o1; u16* o2; u16* o3; u16* o4; u16* o5;
  int ldc;
  float* of; const float* xin; float* xout; int dry;
  int nt0; size_t astride;
};

template <int LOAD, int EPI>
DEV void gemm_phase(const GemmP& g, char* lds) {
  const int tid = ltid(), wid = tid >> 6, lane = tid & 63, r32 = lane & 31, hi = lane >> 5;
  const int wm = wid >> 1, wn = wid & 1;
  char* sA = lds; char* sB = lds + 65536;
  const int nk = g.K / 64, ntiles = 64 * g.NT;
  const int c16 = tid & 7, rowb = tid >> 3;
  for (int t = blockIdx.x; t < ntiles; t += gridDim.x) {
    const int mt = t & 63, nt = g.nt0 + (t >> 6), m0 = mt * 256, n0 = nt * 128;
    const u16* Ab = g.A + (size_t)(nt >> 4) * g.astride;
    f32x16 acc[2][2] = {};
    bf16x8 ra[4], rb[2];
    const float* mup = nullptr;
    if constexpr (LOAD == LOAD_LERP) {
      const int s = nt < 16 ? 0 : nt < 32 ? 2 : nt < 48 ? 3 : nt < 64 ? 5 : nt == 64 ? 1 : 4;
      mup = g.mu + s * DM;
    }
    auto gload = [&](int kt) {
      const int k0 = kt * 64 + c16 * 8;
#pragma unroll
      for (int i = 0; i < 4; ++i) {
        const int row = rowb + i * 64; const size_t tok = (size_t)(m0 + row);
        if constexpr (LOAD == LOAD_PLAIN) {
          ra[i] = *(const bf16x8*)(Ab + tok * g.lda + k0);
        } else {
          const int pos = (int)(tok % (size_t)g.T);
          const u32x4 c = *(const u32x4*)(g.A + tok * DM + k0);
          u32x4 pv = {0u, 0u, 0u, 0u}, nx = {0u, 0u, 0u, 0u};
          if (pos > 0) pv = *(const u32x4*)(g.A + (tok - 1) * DM + k0);
          if (pos < g.T - 1) nx = *(const u32x4*)(g.A + (tok + 1) * DM + k0);
          const float4 m0v = *(const float4*)(mup + k0), m1v = *(const float4*)(mup + k0 + 4);
          const float mu[8] = {m0v.x, m0v.y, m0v.z, m0v.w, m1v.x, m1v.y, m1v.z, m1v.w};
          u32x4 o;
#pragma unroll
          for (int e = 0; e < 4; ++e) {
            const float h0 = bflo(c[e]), h1 = bfhi(c[e]);
            const float x0 = 0.5f * (bflo(pv[e]) + bflo(nx[e])) - h0, x1 = 0.5f * (bfhi(pv[e]) + bfhi(nx[e])) - h1;
            o[e] = cvtpk(h0 + mu[2 * e] * x0, h1 + mu[2 * e + 1] * x1);
          }
          ra[i] = *(bf16x8*)&o;
        }
      }
#pragma unroll
      for (int i = 0; i < 2; ++i) {
        const int row = rowb + i * 64;
        rb[i] = *(const bf16x8*)(g.Bt + (size_t)(n0 + row) * g.K + k0);
      }
    };
    auto swrite = [&](int b) {
#pragma unroll
      for (int i = 0; i < 4; ++i) { const int row = rowb + i * 64; *(bf16x8*)(sA + b * 32768 + GSWZ(row, c16)) = ra[i]; }
#pragma unroll
      for (int i = 0; i < 2; ++i) { const int row = rowb + i * 64; *(bf16x8*)(sB + b * 16384 + GSWZ(row, c16)) = rb[i]; }
    };
    gload(0); swrite(0); __syncthreads();
    for (int kt = 0; kt < nk; ++kt) {
      const int b = kt & 1;
      if (kt + 1 < nk) gload(kt + 1);
      const char* a_ = sA + b * 32768; const char* b_ = sB + b * 16384;
#pragma unroll
      for (int ks = 0; ks < 4; ++ks) {
        bf16x8 af[2], bfr[2];
#pragma unroll
        for (int mi = 0; mi < 2; ++mi) { const int row = wm * 64 + mi * 32 + r32; af[mi] = *(const bf16x8*)(a_ + GSWZ(row, ks * 2 + hi)); }
#pragma unroll
        for (int ni = 0; ni < 2; ++ni) { const int row = wn * 64 + ni * 32 + r32; bfr[ni] = *(const bf16x8*)(b_ + GSWZ(row, ks * 2 + hi)); }
#pragma unroll
        for (int mi = 0; mi < 2; ++mi)
#pragma unroll
          for (int ni = 0; ni < 2; ++ni) acc[mi][ni] = __builtin_amdgcn_mfma_f32_32x32x16_bf16(af[mi], bfr[ni], acc[mi][ni], 0, 0, 0);
      }
      if (kt + 1 < nk) swrite(b ^ 1);
      __syncthreads();
    }
    if (!g.dry)
#pragma unroll
    for (int mi = 0; mi < 2; ++mi)
#pragma unroll
      for (int ni = 0; ni < 2; ++ni)
#pragma unroll
        for (int r = 0; r < 16; ++r) {
          const size_t m = (size_t)(m0 + wm * 64 + mi * 32 + crow(r, hi));
          const int nl = wn * 64 + ni * 32 + r32, n = n0 + nl;
          const float v = acc[mi][ni][r];
          if constexpr (EPI == EPI_RWKV) {
            if (nt < 64) {
              const int which = nt >> 4, col = (nt & 15) * 128 + nl;
              u16* dst = which == 0 ? g.o0 : which == 1 ? g.o1 : which == 2 ? g.o2 : g.o3;
              dst[m * EI + col] = f2bf(which == 3 ? siluf(v) : v);
            } else if (nt == 64) g.o4[m * 128 + nl] = f2bf(tanhf(v));
            else g.o5[m * 128 + nl] = f2bf(v);
          } else if constexpr (EPI == EPI_RES) {
            g.xout[m * DM + n] = g.xin[m * DM + n] + v;
          } else if constexpr (EPI == EPI_MLAIN) {
            if (n < 704) g.of[m * 704 + n] = v;
            else if (n < ML_N) g.o0[m * EI + (n - 704)] = f2bf(siluf(v));
          } else {
            g.o0[m * g.ldc + n] = f2bf(v);
          }
        }
  }
}

struct ScanP {
  const u16 *r, *k, *v, *twl, *al; u16 *yf, *yb; float* bonus;
  const float *w0, *w2, *a0, *a2, *kk, *ka, *rk;
  int nseq, T;
  float* tbuf; int nseg;
};
template <int CTRL> DEV float dppf(float x) {
  return __int_as_float(__builtin_amdgcn_update_dpp(0, __float_as_int(x), CTRL, 0xF, 0xF, false));
}
DEV float row_prefix16(float x) {
  x += dppf<0x111>(x); x += dppf<0x112>(x); x += dppf<0x114>(x); x += dppf<0x118>(x); return x;
}
DEV float row_total16(float x) {
  x += dppf<0x128>(x); x += dppf<0x124>(x); x += dppf<0x122>(x); x += dppf<0x121>(x); return x;
}
DEV bf16x8 pack8(float a0, float a1, float a2, float a3, float a4, float a5, float a6, float a7) {
  u32x4 w = {cvtpk(a0, a1), cvtpk(a2, a3), cvtpk(a4, a5), cvtpk(a6, a7)}; return *(bf16x8*)&w;
}
constexpr int SC_BKT = 0, SC_UVT = 5120, SC_AKM = 10240, SC_RR = 10752, SC_ABF = 11776, SC_Z = 12800, SC_PRM = 17152, SC_T = 18944, SC_WAVE = 35328;
constexpr int SC_PRE = SC_UVT;
constexpr int SC_SHARED_AW = 4 * SC_WAVE;
constexpr int SC_NW = 4;
DEV void scan_phase(const ScanP& s, char* lds_, const int pass) {
  const int tid = ltid(), wid = __builtin_amdgcn_readfirstlane(tid >> 6), lane = tid & 63, c16 = lane & 15, q = lane >> 4;
  const int nchain = s.nseq * 64, nseg = s.nseg;
  const int ipc = pass == 0 ? nseg * 2 : nseg;
  const bool shared = nchain <= (int)gridDim.x;
  const int nsb = shared ? (int)gridDim.x / nchain : 1, sbi = shared ? (int)blockIdx.x / nchain : 0;
  const int nwv = shared ? SC_NW : 2;
  if (shared && sbi >= nsb) return;
  char* wl = lds_ + (wid & 3) * SC_WAVE;
  u16* bkt = (u16*)(wl + SC_BKT); u16* uvt = (u16*)(wl + SC_UVT); u16* akm = (u16*)(wl + SC_AKM); u16* rr = (u16*)(wl + SC_RR);
  float* abf = (float*)(wl + SC_ABF); float* zl = (float*)(wl + SC_Z); float* prm = (float*)(wl + SC_PRM); float* p15l = prm + 320;
  bf16x8* awl = (bf16x8*)(shared ? lds_ + SC_SHARED_AW : lds_ + (2 + (wid & 1)) * SC_WAVE); bf16x8* aal = awl + 512;
#define SCAN_LOAD_W(CHAIN, F0, F1) do { const int d_ = (CHAIN) & 1, h_ = ((CHAIN) >> 1) & 31; \
    for (int f = (F0); f < (F1); ++f) { const int ks = f >> 2, mt = f & 3; u32x4 pw, pa; \
      _Pragma("unroll") for (int e = 0; e < 4; ++e) { const int l0 = ks * 32 + q * 8 + 2 * e; \
        const size_t i0 = ((size_t)(d_ * 64 + l0)) * EI + h_ * 64 + mt * 16 + c16; \
        pw[e] = cvtpk(s.w2[i0], s.w2[i0 + EI]); pa[e] = cvtpk(s.a2[i0], s.a2[i0 + EI]); } \
      awl[f * 64 + lane] = *(bf16x8*)&pw; aal[f * 64 + lane] = *(bf16x8*)&pa; } } while (0)
  if (shared) {
    const int chain_b = (int)blockIdx.x % nchain;
    SCAN_LOAD_W(chain_b, wid, wid + 1);
    __syncthreads();
  }
  if (wid >= nwv) return;
  const int nrounds = shared ? (ipc + nsb * SC_NW - 1) / (nsb * SC_NW) : (nchain + 2 * (int)gridDim.x - 1) / (2 * (int)gridDim.x);
  for (int round = 0; round < nrounds; ++round) {
    const int chain = shared ? (int)blockIdx.x % nchain : (round * 2 + wid) * (int)gridDim.x + (int)blockIdx.x;
    const int it = shared ? sbi * SC_NW + wid + round * nsb * SC_NW : 0;
    if (chain >= nchain || it >= ipc) continue;
    const int kind = pass == 0 ? 1 + (it & 1) : 0;
    const int seg = pass == 0 ? it >> 1 : it;
    const int cs = chain * nseg + seg;
    const int d = chain & 1, h = (chain >> 1) & 31, b = chain >> 6;
    {
      const int ch = h * 64 + lane;
      lds_wait();
      prm[lane] = s.w0[d * EI + ch]; prm[64 + lane] = s.a0[d * EI + ch]; prm[128 + lane] = s.kk[ch]; prm[192 + lane] = s.ka[ch]; prm[256 + lane] = s.rk[ch];
      lds_wait();
    }
    if (!shared) { SCAN_LOAD_W(chain, 0, 8); lds_wait(); }
    const unsigned rowi = (unsigned)(d ? 15 - c16 : c16);
    const unsigned off_tw = rowi * 256u + (unsigned)(q * 16);
    const unsigned off_kr = rowi * 4096u + (unsigned)(h * 128 + q * 8);
    const unsigned off_v  = (unsigned)(h * 128 + lane * 2);
    const unsigned off_y0 = (unsigned)(d ? 15 - 4 * q : 4 * q) * 4096u + (unsigned)(h * 128 + c16 * 2);
    const int ystep = d ? -4096 : 4096;
    f32x4* Tl = (f32x4*)(wl + SC_T);
#pragma unroll
    for (int m = 0; m < 16; ++m) {
      f32x4 t0v = {0.f, 0.f, 0.f, 0.f};
      if (kind == 2) {
        const int mt = m >> 2, nt = m & 3;
        if (mt == nt) { t0v[0] = (4 * q + 0 == c16) ? 1.f : 0.f; t0v[1] = (4 * q + 1 == c16) ? 1.f : 0.f; t0v[2] = (4 * q + 2 == c16) ? 1.f : 0.f; t0v[3] = (4 * q + 3 == c16) ? 1.f : 0.f; }
      } else if (kind == 0 && nseg > 1) {
        t0v = *(const f32x4*)(s.tbuf + ((size_t)cs * 2) * 4096 + (m * 64 + lane) * 4);
      }
      Tl[m * 64 + lane] = t0v;
    }
    u16* yout = d ? s.yb : s.yf;
    const size_t sb = (size_t)b * s.T;
    const int cps = s.T / 16 / nseg, cbeg = seg * cps, cend = cbeg + cps;
    bf16x8 n_tw0, n_tw1, n_ta0, n_ta1; u32x2 n_k[4], n_r[4];
#define SCAN_LOAD(CC) do { const int c0n = d ? (s.T - 16 - (CC) * 16) : (CC) * 16; const size_t t0n = sb + c0n; \
      size_t p_tw = (size_t)s.twl + t0n * 256 + d * 128, p_al = (size_t)s.al + t0n * 256 + d * 128, p_k = (size_t)s.k + t0n * 4096, p_r = (size_t)s.r + t0n * 4096 ; \
      asm volatile("" : "+s"(p_tw), "+s"(p_al), "+s"(p_k), "+s"(p_r)); \
      n_tw0 = gld<bf16x8>(p_tw, off_tw); n_tw1 = gld<bf16x8>(p_tw, off_tw + 64); n_ta0 = gld<bf16x8>(p_al, off_tw); n_ta1 = gld<bf16x8>(p_al, off_tw + 64); \
      _Pragma("unroll") for (int mt = 0; mt < 4; ++mt) { n_k[mt] = gld<u32x2>(p_k, off_kr + mt * 32); n_r[mt] = gld<u32x2>(p_r, off_kr + mt * 32); } } while (0)
    SCAN_LOAD(cbeg);
    for (int cc = cbeg; cc < cend; ++cc) {
      const int c0 = d ? (s.T - 16 - cc * 16) : cc * 16;
      const size_t t0 = sb + c0;
      size_t b_y = (size_t)yout + t0 * 4096, b_bon = (size_t)s.bonus + t0 * 256 + (h * 2 + d) * 4;
      asm volatile("" : "+s"(b_y), "+s"(b_bon));
      size_t b_v = (size_t)s.v + t0 * 4096; asm volatile("" : "+s"(b_v));
      u32x2 n_v[4];
#pragma unroll
      for (int mt = 0; mt < 4; ++mt) n_v[mt] = gld<u32x2>(b_v, off_kr + mt * 32);
      {
        f32x4* wpl = (f32x4*)zl; f32x4* apl = (f32x4*)(wl + SC_PRE);
#pragma unroll
        for (int mt = 0; mt < 4; ++mt) {
          f32x4 cw = {0.f, 0.f, 0.f, 0.f}, ca = {0.f, 0.f, 0.f, 0.f};
          cw = __builtin_amdgcn_mfma_f32_16x16x32_bf16(awl[(0 * 4 + mt) * 64 + lane], n_tw0, cw, 0, 0, 0);
          cw = __builtin_amdgcn_mfma_f32_16x16x32_bf16(awl[(1 * 4 + mt) * 64 + lane], n_tw1, cw, 0, 0, 0);
          ca = __builtin_amdgcn_mfma_f32_16x16x32_bf16(aal[(0 * 4 + mt) * 64 + lane], n_ta0, ca, 0, 0, 0);
          ca = __builtin_amdgcn_mfma_f32_16x16x32_bf16(aal[(1 * 4 + mt) * 64 + lane], n_ta1, ca, 0, 0, 0);
          wpl[mt * 64 + lane] = cw; apl[mt * 64 + lane] = ca;
        }
      }
      float n2 = 0.f;
#pragma unroll
      for (int mt = 0; mt < 4; ++mt) {
        const float4 kkp = *(const float4*)(prm + 128 + mt * 16 + q * 4);
        const float t0 = bflo(n_k[mt][0]) * kkp.x, t1 = bfhi(n_k[mt][0]) * kkp.y, t2 = bflo(n_k[mt][1]) * kkp.z, t3 = bfhi(n_k[mt][1]) * kkp.w;
        n2 += t0 * t0 + t1 * t1 + t2 * t2 + t3 * t3;
      }
      n2 += __shfl_xor(n2, 16, 64); n2 += __shfl_xor(n2, 32, 64);
      const float invn = __builtin_amdgcn_rsqf(fmaxf(n2, 1e-24f));
      float bon = 0.f;
      bf16x8 ktf[2], btf[2], kdf[2], rtf[2];
#pragma unroll
      for (int ks = 0; ks < 2; ++ks) {
        float ktl[8], btl[8], kdl[8], rtl[8];
#pragma unroll
        for (int mh = 0; mh < 2; ++mh) {
          const int mt = 2 * ks + mh;
          const f32x4 cw = ((const f32x4*)zl)[mt * 64 + lane], ca = ((const f32x4*)(wl + SC_PRE))[mt * 64 + lane];
          const float4 w0p = *(const float4*)(prm + mt * 16 + q * 4), a0p = *(const float4*)(prm + 64 + mt * 16 + q * 4);
          const float4 kkp = *(const float4*)(prm + 128 + mt * 16 + q * 4), kap = *(const float4*)(prm + 192 + mt * 16 + q * 4), rkp = *(const float4*)(prm + 256 + mt * 16 + q * 4);
          const float w0a[4] = {w0p.x, w0p.y, w0p.z, w0p.w}, a0a[4] = {a0p.x, a0p.y, a0p.z, a0p.w};
          const float kka[4] = {kkp.x, kkp.y, kkp.z, kkp.w}, kaa[4] = {kap.x, kap.y, kap.z, kap.w}, rka[4] = {rkp.x, rkp.y, rkp.z, rkp.w};
          const u32x2 kr_ = n_k[mt], rr_ = n_r[mt];
          const float kxa[4] = {bflo(kr_[0]), bfhi(kr_[0]), bflo(kr_[1]), bfhi(kr_[1])};
          const float rxa[4] = {bflo(rr_[0]), bfhi(rr_[0]), bflo(rr_[1]), bfhi(rr_[1])};
          float4 p15v;
#pragma unroll
          for (int e = 0; e < 4; ++e) {
            const float wp = cw[e] + w0a[e], ap = ca[e] + a0a[e];
            const float ee = 0.6065306597126334f * __builtin_amdgcn_rcpf(1.f + __expf(-wp));
            const float a = __builtin_amdgcn_rcpf(1.f + __expf(-ap));
            const float kkn = kxa[e] * kka[e] * invn;
            const float kd = kxa[e] * (1.f + (a - 1.f) * kaa[e]);
            const float bb = kkn * a;
            bon += rxa[e] * kd * rka[e];
            const float Ei = row_prefix16(ee), Et = row_total16(ee);
            const float pm = __expf(-Ei), pp = __builtin_amdgcn_rcpf(pm), pm1 = __expf(ee - Ei);
            ktl[mh * 4 + e] = kkn * pm1; btl[mh * 4 + e] = bb * pp; kdl[mh * 4 + e] = kd * pp; rtl[mh * 4 + e] = rxa[e] * pm;
            ((float*)&p15v)[e] = __expf(-Et);
            const int j = mt * 16 + q * 4 + e;
            bkt[j * 40 + c16] = f2bf(btl[mh * 4 + e]); bkt[j * 40 + 16 + c16] = f2bf(kdl[mh * 4 + e]);
          }
          if (c16 == 0) *(float4*)(p15l + mt * 16 + q * 4) = p15v;
          SBAR();
        }
        ktf[ks] = pack8(ktl[0], ktl[1], ktl[2], ktl[3], ktl[4], ktl[5], ktl[6], ktl[7]);
        btf[ks] = pack8(btl[0], btl[1], btl[2], btl[3], btl[4], btl[5], btl[6], btl[7]);
        kdf[ks] = pack8(kdl[0], kdl[1], kdl[2], kdl[3], kdl[4], kdl[5], kdl[6], kdl[7]);
        rtf[ks] = pack8(rtl[0], rtl[1], rtl[2], rtl[3], rtl[4], rtl[5], rtl[6], rtl[7]);
      }
      bon += __shfl_xor(bon, 16, 64); bon += __shfl_xor(bon, 32, 64);
      if (q == 0 && kind == 0) gst<float>(b_bon, off_tw, bon);
      SBAR();
      SBAR();
#pragma unroll
      for (int mt = 0; mt < 4; ++mt) {
        const int vb_ = (mt * 16 + q * 4) * 40 + 16 + c16;
        const unsigned v0_ = kind == 2 ? 0u : n_v[mt][0], v1_ = kind == 2 ? 0u : n_v[mt][1];
        uvt[vb_] = (u16)(v0_ & 0xffffu); uvt[vb_ + 40] = (u16)(v0_ >> 16);
        uvt[vb_ + 80] = (u16)(v1_ & 0xffffu); uvt[vb_ + 120] = (u16)(v1_ >> 16);
      }
      { const int cn = cc + 1 < cend ? cc + 1 : cc; SCAN_LOAD(cn); }
      SBAR();
      {
        f32x4 AB = {0.f, 0.f, 0.f, 0.f}, AK = AB, RB = AB, RK = AB;
        int qm = q; asm volatile("" : "+v"(qm));
#pragma unroll
        for (int ks = 0; ks < 2; ++ks) {
          AB = __builtin_amdgcn_mfma_f32_16x16x32_bf16(ktf[ks], btf[ks], AB, 0, 0, 0);
          AK = __builtin_amdgcn_mfma_f32_16x16x32_bf16(ktf[ks], kdf[ks], AK, 0, 0, 0);
          RB = __builtin_amdgcn_mfma_f32_16x16x32_bf16(rtf[ks], btf[ks], RB, 0, 0, 0);
          RK = __builtin_amdgcn_mfma_f32_16x16x32_bf16(rtf[ks], kdf[ks], RK, 0, 0, 0);
        }
#pragma unroll
        for (int r = 0; r < 4; ++r) {
          const int i = 4 * qm + r;
          const bool lo = c16 < i, le = c16 <= i;
          abf[i * 16 + c16] = lo ? AB[r] : 0.f;
          akm[i * 16 + c16] = f2bf(lo ? AK[r] : 0.f);
          rr[i * 32 + c16] = f2bf(le ? RB[r] : 0.f);
          rr[i * 32 + 16 + c16] = f2bf(le ? RK[r] : 0.f);
        }
      }
#define TFRAG(ks, nt, OUT) do { const f32x4 ta_ = Tl[((2 * (ks)) * 4 + (nt)) * 64 + lane], tb_ = Tl[((2 * (ks) + 1) * 4 + (nt)) * 64 + lane]; \
        OUT = pack8(ta_[0], ta_[1], ta_[2], ta_[3], tb_[0], tb_[1], tb_[2], tb_[3]); } while (0)
      lds_wait();
      {
        bf16x8 akf = {0, 0, 0, 0, 0, 0, 0, 0};
        if (q < 2) akf = *(const bf16x8*)(akm + c16 * 16 + q * 8);
#pragma unroll
        for (int nt = 0; nt < 4; ++nt) {
          f32x4 z = {0.f, 0.f, 0.f, 0.f};
          bf16x8 tf0, tf1; TFRAG(0, nt, tf0); TFRAG(1, nt, tf1);
          z = __builtin_amdgcn_mfma_f32_16x16x32_bf16(ktf[0], tf0, z, 0, 0, 0);
          z = __builtin_amdgcn_mfma_f32_16x16x32_bf16(ktf[1], tf1, z, 0, 0, 0);
          const bf16x8 vf = *(const bf16x8*)(uvt + (nt * 16 + c16) * 40 + 16 + (q & 1) * 8);
          z = __builtin_amdgcn_mfma_f32_16x16x32_bf16(akf, vf, z, 0, 0, 0);
#pragma unroll
          for (int r = 0; r < 4; ++r) zl[(4 * q + r) * 68 + nt * 16 + c16] = z[r];
        }
      }
      lds_wait();
      SBAR();
      {
        float U[16];
#pragma unroll
        for (int i = 0; i < 16; ++i) {
          float acc = -zl[i * 68 + lane];
#pragma unroll
          for (int s4 = 0; s4 < (i + 3) / 4; ++s4) {
            const float4 a4 = *(const float4*)(abf + i * 16 + s4 * 4);
            if (s4 * 4 + 0 < i) acc -= a4.x * U[s4 * 4 + 0];
            if (s4 * 4 + 1 < i) acc -= a4.y * U[s4 * 4 + 1];
            if (s4 * 4 + 2 < i) acc -= a4.z * U[s4 * 4 + 2];
            if (s4 * 4 + 3 < i) acc -= a4.w * U[s4 * 4 + 3];
          }
          U[i] = acc;
          if ((i & 3) == 3) SBAR();
        }
        *(bf16x8*)(uvt + lane * 40) = pack8(U[0], U[1], U[2], U[3], U[4], U[5], U[6], U[7]);
        *(bf16x8*)(uvt + lane * 40 + 8) = pack8(U[8], U[9], U[10], U[11], U[12], U[13], U[14], U[15]);
      }
      lds_wait();
      SBAR();
      {
        const bf16x8 rrf = *(const bf16x8*)(rr + c16 * 32 + q * 8);
        bf16x8 uvf[4];
#pragma unroll
        for (int nt = 0; nt < 4; ++nt) uvf[nt] = *(const bf16x8*)(uvt + (nt * 16 + c16) * 40 + q * 8);
#pragma unroll
        for (int nt = 0; nt < 4; ++nt) {
          f32x4 y = {0.f, 0.f, 0.f, 0.f};
          bf16x8 tf0, tf1; TFRAG(0, nt, tf0); TFRAG(1, nt, tf1);
          y = __builtin_amdgcn_mfma_f32_16x16x32_bf16(rtf[0], tf0, y, 0, 0, 0);
          y = __builtin_amdgcn_mfma_f32_16x16x32_bf16(rtf[1], tf1, y, 0, 0, 0);
          y = __builtin_amdgcn_mfma_f32_16x16x32_bf16(rrf, uvf[nt], y, 0, 0, 0);
#pragma unroll
          for (int r = 0; r < 4; ++r) { if (kind == 0) gst<u16>(b_y, off_y0 + (unsigned)(r * ystep) + nt * 32, f2bf(y[r])); }
        }
#pragma unroll
        for (int mt = 0; mt < 4; ++mt) {
          const bf16x8 bkf = *(const bf16x8*)(bkt + (mt * 16 + c16) * 40 + q * 8);
          const float4 pq = *(const float4*)(p15l + mt * 16 + q * 4);
#pragma unroll
          for (int nt = 0; nt < 4; ++nt) {
            f32x4 t = __builtin_amdgcn_mfma_f32_16x16x32_bf16(bkf, uvf[nt], Tl[(mt * 4 + nt) * 64 + lane], 0, 0, 0);
            t[0] *= pq.x; t[1] *= pq.y; t[2] *= pq.z; t[3] *= pq.w;
            Tl[(mt * 4 + nt) * 64 + lane] = t;
          }
        }
      }
      lds_wait();
    }
    if (pass == 0) {
      float* dst = s.tbuf + ((size_t)cs * 2 + (kind - 1)) * 4096;
#pragma unroll
      for (int m = 0; m < 16; ++m) *(f32x4*)(dst + (m * 64 + lane) * 4) = Tl[m * 64 + lane];
    }
  }
}

DEV void scan_combine_phase(const ScanP& s, char* lds_) {
  const int tid = ltid(), wid = __builtin_amdgcn_readfirstlane(tid >> 6), lane = tid & 63, c16 = lane & 15, q = lane >> 4;
  if (wid >= 2) return;
  float* til = (float*)(lds_ + wid * 16384);
  const int nchain = s.nseq * 64, nseg = s.nseg;
  for (int chain = wid * gridDim.x + blockIdx.x; chain < nchain; chain += 2 * gridDim.x) {
    f32x4 T[16];
#pragma unroll
    for (int m = 0; m < 16; ++m) T[m] = f32x4{0.f, 0.f, 0.f, 0.f};
    for (int seg = 0; seg < nseg; ++seg) {
      float* tn = s.tbuf + ((size_t)(chain * nseg + seg) * 2) * 4096; const float* ti = tn + 4096;
      lds_wait();
#pragma unroll
      for (int m = 0; m < 16; ++m) *(f32x4*)(til + (m * 64 + lane) * 4) = *(const f32x4*)(ti + (m * 64 + lane) * 4);
      lds_wait();
      f32x4 Tn[16];
#pragma unroll
      for (int m = 0; m < 16; ++m) Tn[m] = *(const f32x4*)(tn + (m * 64 + lane) * 4);
#pragma unroll
      for (int nt = 0; nt < 4; ++nt) {
        bf16x8 bh[2], bl[2];
#pragma unroll
        for (int ks = 0; ks < 2; ++ks) {
          const f32x4 ta = T[(2 * ks) * 4 + nt], tb = T[(2 * ks + 1) * 4 + nt];
          const float x[8] = {ta[0], ta[1], ta[2], ta[3], tb[0], tb[1], tb[2], tb[3]};
          float hf[8], lf[8];
#pragma unroll
          for (int e = 0; e < 8; ++e) { hf[e] = bf2f(f2bf(x[e])); lf[e] = x[e] - hf[e]; }
          bh[ks] = pack8(hf[0], hf[1], hf[2], hf[3], hf[4], hf[5], hf[6], hf[7]);
          bl[ks] = pack8(lf[0], lf[1], lf[2], lf[3], lf[4], lf[5], lf[6], lf[7]);
        }
#pragma unroll
        for (int mt = 0; mt < 4; ++mt) {
          f32x4 acc = Tn[mt * 4 + nt];
#pragma unroll
          for (int ks = 0; ks < 2; ++ks) {
            float x[8];
#pragma unroll
            for (int e = 0; e < 8; ++e) x[e] = til[((mt * 4 + 2 * ks + (e >> 2)) * 64 + ((c16 >> 2) & 3) * 16 + 4 * q + (e & 3)) * 4 + (c16 & 3)];
            float hf[8], lf[8];
#pragma unroll
            for (int e = 0; e < 8; ++e) { hf[e] = bf2f(f2bf(x[e])); lf[e] = x[e] - hf[e]; }
            const bf16x8 ah = pack8(hf[0], hf[1], hf[2], hf[3], hf[4], hf[5], hf[6], hf[7]);
            const bf16x8 al = pack8(lf[0], lf[1], lf[2], lf[3], lf[4], lf[5], lf[6], lf[7]);
            acc = __builtin_amdgcn_mfma_f32_16x16x32_bf16(ah, bh[ks], acc, 0, 0, 0);
            acc = __builtin_amdgcn_mfma_f32_16x16x32_bf16(ah, bl[ks], acc, 0, 0, 0);
            acc = __builtin_amdgcn_mfma_f32_16x16x32_bf16(al, bh[ks], acc, 0, 0, 0);
          }
          Tn[mt * 4 + nt] = acc;
        }
      }
#pragma unroll
      for (int m = 0; m < 16; ++m) { *(f32x4*)(tn + (m * 64 + lane) * 4) = T[m]; T[m] = Tn[m]; }
    }
  }
}

DEV void post_phase(u16* __restrict__ yf, const u16* __restrict__ yb, const u16* __restrict__ v, const u16* __restrict__ sg,
                    const float* __restrict__ bonus, const float* __restrict__ lg, const float* __restrict__ lb) {
  const int tid_ = ltid(); const int lane = tid_ & 63, wid = __builtin_amdgcn_readfirstlane(tid_ >> 6);
  for (int tok = blockIdx.x * 8 + wid; tok < GT; tok += gridDim.x * 8) {
#pragma unroll
    for (int it = 0; it < 4; ++it) {
      const int ch0 = it * 512 + lane * 8, h = ch0 >> 6; const size_t i = (size_t)tok * EI + ch0;
      const u32x4 a = *(const u32x4*)(yf + i), bq = *(const u32x4*)(yb + i), vv = *(const u32x4*)(v + i), gg = *(const u32x4*)(sg + i);
      const float2 bo = *(const float2*)(bonus + ((size_t)tok * 32 + h) * 2);
      float y[8]; float sum = 0.f;
#pragma unroll
      for (int e = 0; e < 4; ++e) { y[2 * e] = bflo(a[e]) + bflo(bq[e]); y[2 * e + 1] = bfhi(a[e]) + bfhi(bq[e]); sum += y[2 * e] + y[2 * e + 1]; }
      sum += __shfl_xor(sum, 1, 64); sum += __shfl_xor(sum, 2, 64); sum += __shfl_xor(sum, 4, 64);
      const float mean = sum * (1.f / 64.f);
      float var = 0.f;
#pragma unroll
      for (int e = 0; e < 8; ++e) { y[e] -= mean; var += y[e] * y[e]; }
      var += __shfl_xor(var, 1, 64); var += __shfl_xor(var, 2, 64); var += __shfl_xor(var, 4, 64);
      const float rs = rsqrtf(var * (1.f / 64.f) + 64e-5f), bon = bo.x + bo.y;
      const float4 g0 = *(const float4*)(lg + ch0), g1 = *(const float4*)(lg + ch0 + 4), b0 = *(const float4*)(lb + ch0), b1 = *(const float4*)(lb + ch0 + 4);
      const float ga[8] = {g0.x, g0.y, g0.z, g0.w, g1.x, g1.y, g1.z, g1.w}, ba[8] = {b0.x, b0.y, b0.z, b0.w, b1.x, b1.y, b1.z, b1.w};
      u32x4 o;
#pragma unroll
      for (int e = 0; e < 4; ++e) {
        const float o0 = (y[2 * e] * rs * ga[2 * e] + ba[2 * e] + bon * bflo(vv[e])) * bflo(gg[e]);
        const float o1 = (y[2 * e + 1] * rs * ga[2 * e + 1] + ba[2 * e + 1] + bon * bfhi(vv[e])) * bfhi(gg[e]);
        o[e] = cvtpk(o0, o1);
      }
      *(u32x4*)(yf + i) = o;
    }
  }
}

DEV void mla_mid_phase(const float* __restrict__ cqkv, const float* __restrict__ qn, const float* __restrict__ kvn,
                       const float* __restrict__ ct, const float* __restrict__ st,
                       u16* __restrict__ cqn, u16* __restrict__ ckvn, u16* __restrict__ kpe, int T) {
  const int tid_ = ltid(); const int lane = tid_ & 63, wid = __builtin_amdgcn_readfirstlane(tid_ >> 6);
  for (int tok = blockIdx.x * 8 + wid; tok < GT; tok += gridDim.x * 8) {
    const float* row = cqkv + (size_t)tok * 704;
    float q[6], ss = 0.f;
#pragma unroll
    for (int i = 0; i < 6; ++i) { q[i] = row[lane + i * 64]; ss += q[i] * q[i]; }
    ss = wsum(ss); float sc = rsqrtf(ss * (1.f / 384.f) + 1e-6f);
#pragma unroll
    for (int i = 0; i < 6; ++i) cqn[(size_t)tok * 384 + lane + i * 64] = f2bf(q[i] * sc * qn[lane + i * 64]);
    float c[4]; ss = 0.f;
#pragma unroll
    for (int i = 0; i < 4; ++i) { c[i] = row[384 + lane + i * 64]; ss += c[i] * c[i]; }
    ss = wsum(ss); sc = rsqrtf(ss * (1.f / 256.f) + 1e-6f);
#pragma unroll
    for (int i = 0; i < 4; ++i) ckvn[(size_t)tok * 256 + lane + i * 64] = f2bf(c[i] * sc * kvn[lane + i * 64]);
    const float x = row[640 + lane];
    const float xo = __shfl_xor(x, 32, 64);
    const int pos = tok % T, j = lane & 31;
    const float cs = ct[pos * 32 + j], sn = st[pos * 32 + j];
    const float o = lane < 32 ? x * cs - xo * sn : x * cs + xo * sn;
    kpe[(size_t)tok * 64 + lane] = f2bf(o);
  }
}

constexpr int SHM_V = 16384, SHM_K = 16384, SHM_KP = 8192;
#define KSWZ(row, colB) ((row) * 256 + ((colB) ^ (((row) & 7) << 4)))
#define KPSWZ(row, colB) ((row) * 128 + ((colB) ^ (((row) & 7) << 4)))
constexpr float ATT_SCALE = 0.07216878364870322f;
DEV void partialSM(f32x16& p0, f32x16& p1, float& m_reg, float& mn, float& alpha) {
  constexpr float C = ATT_SCALE * 1.4426950408889634f;
  float pmax = p0[0];
#pragma unroll
  for (int r = 1; r < 16; ++r) pmax = fmaxf(pmax, p0[r]);
#pragma unroll
  for (int r = 0; r < 16; ++r) pmax = fmaxf(pmax, p1[r]);
  { auto rr = __builtin_amdgcn_permlane32_swap(__float_as_uint(pmax), __float_as_uint(pmax), false, false);
    pmax = fmaxf(__uint_as_float(rr[0]), __uint_as_float(rr[1])); }
  mn = fmaxf(m_reg, pmax); alpha = __builtin_amdgcn_exp2f((m_reg - mn) * C); m_reg = mn;
  const float mnC = -mn * C;
#pragma unroll
  for (int r = 0; r < 16; ++r) p0[r] = __builtin_amdgcn_exp2f(fmaf(p0[r], C, mnC));
#pragma unroll
  for (int r = 0; r < 16; ++r) p1[r] = __builtin_amdgcn_exp2f(fmaf(p1[r], C, mnC));
}
DEV void finishSM(f32x16& p0, f32x16& p1, float alpha, float& l_reg, bf16x8& pa0, bf16x8& pa1, bf16x8& pa2, bf16x8& pa3) {
  float ps = 0;
#pragma unroll
  for (int r = 0; r < 16; ++r) ps += p0[r];
#pragma unroll
  for (int r = 0; r < 16; ++r) ps += p1[r];
  { auto rr = __builtin_amdgcn_permlane32_swap(__float_as_uint(ps), __float_as_uint(ps), false, false);
    ps = __uint_as_float(rr[0]) + __uint_as_float(rr[1]); }
  l_reg = l_reg * alpha + ps;
#define PK4(PP, BASE, OUT) do { unsigned a0 = cvtpk(PP[BASE + 0], PP[BASE + 1]), a1 = cvtpk(PP[BASE + 2], PP[BASE + 3]);   \
    unsigned b0 = cvtpk(PP[BASE + 4], PP[BASE + 5]), b1 = cvtpk(PP[BASE + 6], PP[BASE + 7]);                              \
    auto r0 = __builtin_amdgcn_permlane32_swap(a0, b0, false, false); auto r1 = __builtin_amdgcn_permlane32_swap(a1, b1, false, false); \
    u32x4 w = {r0[0], r1[0], r0[1], r1[1]}; OUT = *reinterpret_cast<bf16x8*>(&w); } while (0)
  PK4(p0, 0, pa0); PK4(p0, 8, pa1); PK4(p1, 0, pa2); PK4(p1, 8, pa3);
#undef PK4
}
DEV int v_st(int k, int c) { const int kk = (k & ~0xC) | ((k & 4) << 1) | ((k & 8) >> 1); return ((kk >> 3) * 4 + (c >> 5)) * 512 + ((kk & 7) * 32 + (c & 31)) * 2; }
DEV int v_rd_base(int lane) { return ((lane & 3) << 3) | (((lane >> 2) & 3) << 6) | (((lane >> 4) & 1) << 5) | (((lane >> 5) & 1) << 8); }
constexpr int v_rd_off(int d0, int ks, int half) { return d0 * 512 + ks * 4096 + half * 2048; }
template <int OFF> DEV s16x4 tr_read(int vb) {
  s16x4 r; asm volatile("ds_read_b64_tr_b16 %0, %1 offset:%2" : "=&v"(r) : "v"(vb), "i"(OFF) : "memory"); return r;
}
template <int D0> DEV void pv_one(f32x16& od, int vb, bf16x8 pa0, bf16x8 pa1, bf16x8 pa2, bf16x8 pa3) {
  const s16x4 l0 = tr_read<v_rd_off(D0, 0, 0)>(vb), h0 = tr_read<v_rd_off(D0, 0, 1)>(vb), l1 = tr_read<v_rd_off(D0, 1, 0)>(vb), h1 = tr_read<v_rd_off(D0, 1, 1)>(vb);
  const s16x4 l2 = tr_read<v_rd_off(D0, 2, 0)>(vb), h2 = tr_read<v_rd_off(D0, 2, 1)>(vb), l3 = tr_read<v_rd_off(D0, 3, 0)>(vb), h3 = tr_read<v_rd_off(D0, 3, 1)>(vb);
  asm volatile("s_waitcnt lgkmcnt(0)" ::: "memory"); SBAR();
#define PK(L, H) (bf16x8){L[0], L[1], L[2], L[3], H[0], H[1], H[2], H[3]}
  od = __builtin_amdgcn_mfma_f32_32x32x16_bf16(pa0, PK(l0, h0), od, 0, 0, 0);
  od = __builtin_amdgcn_mfma_f32_32x32x16_bf16(pa1, PK(l1, h1), od, 0, 0, 0);
  od = __builtin_amdgcn_mfma_f32_32x32x16_bf16(pa2, PK(l2, h2), od, 0, 0, 0);
  od = __builtin_amdgcn_mfma_f32_32x32x16_bf16(pa3, PK(l3, h3), od, 0, 0, 0);
#undef PK
}

struct AttnP { const u16* q; const u16* kv; const u16* kpe; u16* sg; const float* ct; const float* st; int nseq, T; int dry; };
DEV void attn_phase(const AttnP& a, char* lds) {
  const int tid = ltid(), wid = tid >> 6, lane = tid & 63, r32 = lane & 31, hi = lane >> 5;
  char* V_lds = lds; char* K_lds = lds + 3 * SHM_V; char* KP_lds = lds + 3 * SHM_V + 2 * SHM_K;
  float* wsc = (float*)(lds + 3 * SHM_V + 2 * SHM_K + 2 * SHM_KP) + wid * 64; float* li_l = wsc; float* al_l = wsc + 32;
  const int nqb = a.T / 256, nitems = a.nseq * 16 * nqb, NT = a.T / 64;
  const int sr = tid >> 4, sc = (tid & 15) * 8, vst0 = v_st(sr, sc), vst1 = v_st(32 + sr, sc);
  const int pr = tid >> 3, pc = (tid & 7) * 8;
  const int vb0 = (int)(uintptr_t)V_lds + v_rd_base(lane);
  int kad[4], kpd[4];
#pragma unroll
  for (int q = 0; q < 4; ++q) { kad[q] = KSWZ(r32, q * 32 + hi * 16); kpd[q] = KPSWZ(r32, q * 32 + hi * 16); }
  for (int it = blockIdx.x; it < nitems; it += gridDim.x) {
    const int qb = it % nqb, h = (it / nqb) & 15, b = it / (nqb * 16);
    const size_t sbase = (size_t)b * a.T;
    const int pos = qb * 256 + wid * 32 + r32;
    bf16x8 qr[12];
    {
      const u16* Qw = a.q + (sbase + pos) * 3072 + h * 192 + hi * 8;
#pragma unroll
      for (int d0 = 0; d0 < 12; ++d0) qr[d0] = *(const bf16x8*)(Qw + d0 * 16);
#pragma unroll
      for (int dd = 0; dd < 2; ++dd) {
        const int j0 = dd * 16 + hi * 8;
        const float4 c0 = *(const float4*)(a.ct + pos * 32 + j0), c1 = *(const float4*)(a.ct + pos * 32 + j0 + 4);
        const float4 s0 = *(const float4*)(a.st + pos * 32 + j0), s1 = *(const float4*)(a.st + pos * 32 + j0 + 4);
        const float cs[8] = {c0.x, c0.y, c0.z, c0.w, c1.x, c1.y, c1.z, c1.w};
        const float sn[8] = {s0.x, s0.y, s0.z, s0.w, s1.x, s1.y, s1.z, s1.w};
        u32x4 x1 = *(u32x4*)&qr[8 + dd], x2 = *(u32x4*)&qr[10 + dd], y1, y2;
#pragma unroll
        for (int e = 0; e < 4; ++e) {
          const float a0 = bflo(x1[e]), a1 = bfhi(x1[e]), b0 = bflo(x2[e]), b1 = bfhi(x2[e]);
          y1[e] = cvtpk(a0 * cs[2 * e] - b0 * sn[2 * e], a1 * cs[2 * e + 1] - b1 * sn[2 * e + 1]);
          y2[e] = cvtpk(b0 * cs[2 * e] + a0 * sn[2 * e], b1 * cs[2 * e + 1] + a1 * sn[2 * e + 1]);
        }
        qr[8 + dd] = *(bf16x8*)&y1; qr[10 + dd] = *(bf16x8*)&y2;
      }
    }
    float m_reg = -1e30f, l_reg = 0.f; f32x16 o[4] = {};
    bf16x8 vs0, vs1, ks0, ks1, kp0;
    const u16* kvh = a.kv + sbase * 4096 + h * 256;
    const u16* kph = a.kpe + sbase * 64;
    const unsigned voff = (unsigned)(sr * 8192 + sc * 2), poff = (unsigned)(pr * 128 + pc * 2);
#define SLOAD(k0) do { const char* bK0 = (const char*)kvh + (size_t)(k0) * 8192; const char* bK1 = bK0 + 32 * 8192; const char* bP = (const char*)kph + (size_t)(k0) * 128; \
    vs0 = *(const bf16x8*)(bK0 + voff + 256); vs1 = *(const bf16x8*)(bK1 + voff + 256); \
    ks0 = *(const bf16x8*)(bK0 + voff); ks1 = *(const bf16x8*)(bK1 + voff); \
    kp0 = *(const bf16x8*)(bP + poff); } while (0)
#define SWRITE(bb, vbuf) do { *(bf16x8*)(V_lds + (vbuf) * SHM_V + vst0) = vs0; *(bf16x8*)(V_lds + (vbuf) * SHM_V + vst1) = vs1; \
    *(bf16x8*)(K_lds + (bb) * SHM_K + KSWZ(sr, sc * 2)) = ks0; *(bf16x8*)(K_lds + (bb) * SHM_K + KSWZ(32 + sr, sc * 2)) = ks1; \
    *(bf16x8*)(KP_lds + (bb) * SHM_KP + KPSWZ(pr, pc * 2)) = kp0; } while (0)
    __syncthreads();
    SLOAD(0); SWRITE(0, 0); __syncthreads();
    const bool grpB = wid >= 4;
    bf16x8 pa0, pa1, pa2, pa3;
    int vcur = 0, vprev = 2;
#define PV_ALL(vbuf) do { const int vb_ = vb0 + (vbuf) * SHM_V; \
      pv_one<0>(o[0], vb_, pa0, pa1, pa2, pa3); pv_one<1>(o[1], vb_, pa0, pa1, pa2, pa3); \
      pv_one<2>(o[2], vb_, pa0, pa1, pa2, pa3); pv_one<3>(o[3], vb_, pa0, pa1, pa2, pa3); } while (0)
    for (int j = 0; j < NT; ++j) {
      const int bb = j & 1;
      if (j + 1 < NT) SLOAD((j + 1) * 64);
      SBAR();
      if (grpB && j > 0) PV_ALL(vprev);
      f32x16 p0 = {}, p1 = {};
      {
        const char* Ks = K_lds + bb * SHM_K; const char* Kp = KP_lds + bb * SHM_KP;
#pragma unroll
        for (int d0 = 0; d0 < 8; ++d0) {
          const bf16x8 b0 = *(const bf16x8*)(Ks + kad[d0 & 3] + (d0 >> 2) * 128), b1 = *(const bf16x8*)(Ks + kad[d0 & 3] + (d0 >> 2) * 128 + 8192);
          p0 = __builtin_amdgcn_mfma_f32_32x32x16_bf16(b0, qr[d0], p0, 0, 0, 0);
          p1 = __builtin_amdgcn_mfma_f32_32x32x16_bf16(b1, qr[d0], p1, 0, 0, 0); }
#pragma unroll
        for (int d0 = 0; d0 < 4; ++d0) {
          const bf16x8 b0 = *(const bf16x8*)(Kp + kpd[d0]), b1 = *(const bf16x8*)(Kp + kpd[d0] + 4096);
          p0 = __builtin_amdgcn_mfma_f32_32x32x16_bf16(b0, qr[8 + d0], p0, 0, 0, 0);
          p1 = __builtin_amdgcn_mfma_f32_32x32x16_bf16(b1, qr[8 + d0], p1, 0, 0, 0); }
      }
      float mn, alpha;
      partialSM(p0, p1, m_reg, mn, alpha);
      if (__any(alpha < 1.f)) {
        if (hi == 0) al_l[r32] = alpha;
        lds_wait();
#pragma unroll
        for (int dd = 0; dd < 4; ++dd)
#pragma unroll
          for (int r = 0; r < 16; ++r) o[dd][r] *= al_l[crow(r, hi)];
      }
      finishSM(p0, p1, alpha, l_reg, pa0, pa1, pa2, pa3); SBAR();
      if (!grpB) PV_ALL(vcur);
      const int vnext = vcur == 2 ? 0 : vcur + 1;
      if (j + 1 < NT) SWRITE(bb ^ 1, vnext);
      vprev = vcur; vcur = vnext;
      __syncthreads();
    }
    if (grpB) PV_ALL(vprev);
#undef PV_ALL
#undef SLOAD
#undef SWRITE
    {
      int t2 = threadIdx.x; asm volatile("" : "+v"(t2));
      const int wid2 = t2 >> 6, r2 = t2 & 31, hi2 = (t2 >> 5) & 1;
      float* li2 = (float*)(lds + 3 * SHM_V + 2 * SHM_K + 2 * SHM_KP) + wid2 * 64;
      if (hi2 == 0) li2[r2] = l_reg;
      lds_wait();
      u16* Ow = a.sg + (sbase + qb * 256 + wid2 * 32) * EI + h * 128 + r2;
#pragma unroll
      for (int r = 0; r < 16; ++r) {
        const int orow = crow(r, hi2);
        const float rl = __builtin_amdgcn_rcpf(li2[orow]);
#pragma unroll
        for (int d0 = 0; d0 < 4; ++d0) {
          u16* pp = Ow + (size_t)orow * EI + d0 * 32;
          if (!a.dry) *pp = f2bf(o[d0][r] * rl * bf2f(*pp));
        }
      }
    }
  }
}

#if MEGA
#define GRID_SYNC() gsync(p, lds)
#else
#define GRID_SYNC() do {} while (0)
#endif
struct Grp { const float* xin0; float* xres; int nseq, T; };
DEV Grp get_group(const P& p, int g) {
  Grp r;
  r.xin0 = g == 0 ? p.x_prompt : p.x_sample + (size_t)(g - 1) * GT * DM;
  r.xres = p.out + (size_t)g * GT * DM;
  r.nseq = g == 0 ? 8 : 1; r.T = g == 0 ? 2048 : 16384;
  return r;
}
template <int LT, int ph>
DEV void run_phase(const P& p, int g, int layer, char* lds) {
  const Grp G = get_group(p, g);
  const int j = layer >> 1;
  const float* xin = layer == 0 ? G.xin0 : G.xres;
  size_t zoff = 0; asm volatile("" : "+s"(zoff));
  char* ws = p.ws + zoff;
  u16* hbuf = (u16*)(ws + O_HBUF);
  u16* sg = (u16*)(ws + O_SG);
  if constexpr (LT == 0) {
    u16 *rb = (u16*)(ws + O_RB), *kb = (u16*)(ws + O_KB), *vb = (u16*)(ws + O_VB), *yf = (u16*)(ws + O_YF), *yb = (u16*)(ws + O_YB);
    u16 *twl = (u16*)(ws + O_TWL), *al = (u16*)(ws + O_AL); float* bon = (float*)(ws + O_BON);
    if constexpr (ph == 0) rms_phase(xin, p.ln_g + layer * DM, hbuf);
    else if constexpr (ph == 1) {
      GemmP q{}; q.A = hbuf; q.lda = DM; q.Bt = (const u16*)(ws + O_WRWIN) + (size_t)j * RW_N * DM; q.K = DM; q.NT = 66;
      q.mu = p.rw_mu + (size_t)j * 6 * DM; q.T = G.T; q.o0 = rb; q.o1 = kb; q.o2 = vb; q.o3 = sg; q.o4 = twl; q.o5 = al;
      lerp_phase(hbuf, q.mu, yf, G.T); GRID_SYNC();
      GemmP w = q; w.A = yf; w.astride = (size_t)GT * DM; w.NT = 64; w.nt0 = 0;
      gemm_phase<LOAD_PLAIN, EPI_RWKV>(w, lds);
      q.NT = 2; q.nt0 = 64;
      gemm_phase<LOAD_LERP, EPI_RWKV>(q, lds);
    } else if constexpr (ph == 2) {
      ScanP s{}; s.r = rb; s.k = kb; s.v = vb; s.twl = twl; s.al = al; s.yf = yf; s.yb = yb; s.bonus = bon;
      s.w0 = p.rw_w0 + (size_t)j * 2 * EI; s.w2 = p.rw_w2 + (size_t)j * 2 * 64 * EI; s.a0 = p.rw_a0 + (size_t)j * 2 * EI; s.a2 = p.rw_a2 + (size_t)j * 2 * 64 * EI;
      s.kk = p.rw_kk + (size_t)j * EI; s.ka = p.rw_ka + (size_t)j * EI; s.rk = p.rw_rk + (size_t)j * EI; s.nseq = G.nseq; s.T = G.T;
      s.tbuf = (float*)hbuf;
      if (G.T > 2048) {
        s.nseg = 16;
        scan_phase(s, lds, 0); GRID_SYNC();
        scan_combine_phase(s, lds); GRID_SYNC();
        scan_phase(s, lds, 1);
      } else { s.nseg = 1; scan_phase(s, lds, 1); }
    } else if constexpr (ph == 3) post_phase(yf, yb, vb, sg, bon, p.rw_lnx_g + (size_t)j * EI, p.rw_lnx_b + (size_t)j * EI);
    else {
      GemmP q{}; q.A = yf; q.lda = EI; q.Bt = (const u16*)(ws + O_WRWOUT) + (size_t)j * DM * EI; q.K = EI; q.NT = 8; q.xin = xin; q.xout = G.xres;
      for (int rep = 1; rep < REP_GEMM; ++rep) { q.dry = (gridDim.x != 12345); gemm_phase<LOAD_PLAIN, EPI_RES>(q, lds); } q.dry = 0;
      gemm_phase<LOAD_PLAIN, EPI_RES>(q, lds);
    }
  } else {
    float* cqkv = (float*)(ws + O_CQKV); u16 *cqn = (u16*)(ws + O_CQN), *ckvn = (u16*)(ws + O_CKVN), *kpe = (u16*)(ws + O_KPE), *qq = (u16*)(ws + O_Q), *kv = (u16*)(ws + O_KV);
    const float* ct = (const float*)(ws + O_COS); const float* st = (const float*)(ws + O_SIN);
    if constexpr (ph == 0) rms_phase(xin, p.ln_g + layer * DM, hbuf);
    else if constexpr (ph == 1) {
      GemmP q{}; q.A = hbuf; q.lda = DM; q.Bt = (const u16*)(ws + O_WMLIN) + (size_t)j * ML_NP * DM; q.K = DM; q.NT = 22; q.of = cqkv; q.o0 = sg;
      for (int rep = 1; rep < REP_GEMM; ++rep) { q.dry = (gridDim.x != 12345); gemm_phase<LOAD_PLAIN, EPI_MLAIN>(q, lds); } q.dry = 0;
      gemm_phase<LOAD_PLAIN, EPI_MLAIN>(q, lds);
    } else if constexpr (ph == 2) mla_mid_phase(cqkv, p.ml_qn + j * 384, p.ml_kvn + j * 256, ct, st, cqn, ckvn, kpe, G.T);
    else if constexpr (ph == 3) {
      GemmP q{}; q.A = cqn; q.lda = 384; q.Bt = (const u16*)(ws + O_WUQ) + (size_t)j * 3072 * 384; q.K = 384; q.NT = 24; q.o0 = qq; q.ldc = 3072;
      for (int rep = 1; rep < REP_GEMM; ++rep) { q.dry = (gridDim.x != 12345); gemm_phase<LOAD_PLAIN, EPI_BF16>(q, lds); } q.dry = 0;
      gemm_phase<LOAD_PLAIN, EPI_BF16>(q, lds);
      GemmP r{}; r.A = ckvn; r.lda = 256; r.Bt = (const u16*)(ws + O_WUKV) + (size_t)j * 4096 * 256; r.K = 256; r.NT = 32; r.o0 = kv; r.ldc = 4096;
      for (int rep = 1; rep < REP_GEMM; ++rep) { r.dry = (gridDim.x != 12345); gemm_phase<LOAD_PLAIN, EPI_BF16>(r, lds); } r.dry = 0;
      gemm_phase<LOAD_PLAIN, EPI_BF16>(r, lds);
    } else if constexpr (ph == 4) {
      AttnP a{}; a.q = qq; a.kv = kv; a.kpe = kpe; a.sg = sg; a.ct = ct; a.st = st; a.nseq = G.nseq; a.T = G.T;
      for (int rep = 1; rep < REP_ATTN; ++rep) { a.dry = (gridDim.x != 12345); attn_phase(a, lds); } a.dry = 0;
      attn_phase(a, lds);
    } else {
      GemmP q{}; q.A = sg; q.lda = EI; q.Bt = (const u16*)(ws + O_WMLOUT) + (size_t)j * DM * EI; q.K = EI; q.NT = 8; q.xin = xin; q.xout = G.xres;
      for (int rep = 1; rep < REP_GEMM; ++rep) { q.dry = (gridDim.x != 12345); gemm_phase<LOAD_PLAIN, EPI_RES>(q, lds); } q.dry = 0;
      gemm_phase<LOAD_PLAIN, EPI_RES>(q, lds);
    }
  }
}


template <int LT, int PH>
__global__ __launch_bounds__(512) void k_phase(P p, int g, int layer) {
  extern __shared__ __attribute__((aligned(16))) char lds[];
  if constexpr (LT == 2) { if constexpr (PH == 0) init_phase(p, lds); else final_phase(p.out, p.final_g); }
  else run_phase<LT, PH>(p, g, layer, lds);
}

#if MEGA
__global__ __launch_bounds__(512) void k_mega(P p) {
  extern __shared__ __attribute__((aligned(16))) char lds[];
  cg::grid_group grid = cg::this_grid();
  {
    unsigned* bar = (unsigned*)(p.ws + O_BAR);
    if (blockIdx.x == 0) for (int i = threadIdx.x; i < XCD_BAR_WORDS; i += 512) bar[i] = 0u;
    if (threadIdx.x == 0) { volatile LAS unsigned* st = (volatile LAS unsigned*)(lds + SHM_BYTES - 16); st[0] = 0u; st[1] = 0u; }
  }
  init_phase(p, lds);
  grid.sync();
  if (threadIdx.x == 0) (void)xb_add(&((unsigned*)(p.ws + O_BAR))[XB_XCNT(xb_xcc_id())], 1u);
  for (int g = 0; g < 3; ++g)
    for (int layer = 0; layer < 4; ++layer) {
      if ((layer & 1) == 0) {
        run_phase<0, 0>(p, g, layer, lds); gsync(p, lds); run_phase<0, 1>(p, g, layer, lds); gsync(p, lds); run_phase<0, 2>(p, g, layer, lds); gsync(p, lds);
        run_phase<0, 3>(p, g, layer, lds); gsync(p, lds); run_phase<0, 4>(p, g, layer, lds); gsync(p, lds);
      } else {
        run_phase<1, 0>(p, g, layer, lds); gsync(p, lds); run_phase<1, 1>(p, g, layer, lds); gsync(p, lds); run_phase<1, 2>(p, g, layer, lds); gsync(p, lds);
        run_phase<1, 3>(p, g, layer, lds); gsync(p, lds); run_phase<1, 4>(p, g, layer, lds); gsync(p, lds); run_phase<1, 5>(p, g, layer, lds); gsync(p, lds);
      }
    }
  final_phase(p.out, p.final_g);
}
#endif

extern "C" void kernel_launch(void* const* d_in, const int* in_sizes, int n_in, void* d_out, int out_size, void* d_ws, size_t ws_size, hipStream_t stream) {
  if (n_in != 22 || ws_size < WS_NEED) { fprintf(stderr, "kernel_launch: bad args n_in %d ws %zu need %zu\n", n_in, ws_size, WS_NEED); return; }
  P p{};
  const float** f = (const float**)&p;
  for (int i = 0; i < 22; ++i) f[i] = (const float*)d_in[i];
  p.out = (float*)d_out; p.ws = (char*)d_ws;
#if MEGA
  static int grid_blocks = 0;
  if (!grid_blocks) {
    hipFuncSetAttribute((const void*)k_mega, hipFuncAttributeMaxDynamicSharedMemorySize, SHM_BYTES);
    int dev = 0, cus = 0, per_cu = 0;
    hipGetDevice(&dev);
    hipDeviceGetAttribute(&cus, hipDeviceAttributeMultiprocessorCount, dev);
    hipOccupancyMaxActiveBlocksPerMultiprocessor(&per_cu, k_mega, 512, SHM_BYTES);
    if (per_cu > 1) per_cu = 1;
    grid_blocks = cus * per_cu;
  }
  void* args[] = {&p};
  hipError_t e = hipLaunchCooperativeKernel((void*)k_mega, dim3(grid_blocks), dim3(512), args, SHM_BYTES, stream);
  if (e != hipSuccess) fprintf(stderr, "cooperative launch failed: %s (grid %d)\n", hipGetErrorString(e), grid_blocks);
#else
  const int NB = 256;
#define LAUNCH(LT, PH, g, layer) do { static int inited = 0; if (!inited) { hipFuncSetAttribute((const void*)k_phase<LT, PH>, hipFuncAttributeMaxDynamicSharedMemorySize, SHM_BYTES); inited = 1; } \
    hipLaunchKernelGGL((k_phase<LT, PH>), dim3(NB), dim3(512), SHM_BYTES, stream, p, g, layer); } while (0)
  LAUNCH(2, 0, 0, 0);
  for (int g = 0; g < 3; ++g)
    for (int layer = 0; layer < 4; ++layer) {
      if ((layer & 1) == 0) { LAUNCH(0, 0, g, layer); LAUNCH(0, 1, g, layer); LAUNCH(0, 2, g, layer); LAUNCH(0, 3, g, layer); LAUNCH(0, 4, g, layer); }
      else { LAUNCH(1, 0, g, layer); LAUNCH(1, 1, g, layer); LAUNCH(1, 2, g, layer); LAUNCH(1, 3, g, layer); LAUNCH(1, 4, g, layer); LAUNCH(1, 5, g, layer); }
    }
  LAUNCH(2, 1, 0, 0);
#endif
}
```

```cpp
#include <hip/hip_runtime.h>
#include <hip/hip_bf16.h>
#include <hip/hip_cooperative_groups.h>
#include <cstdio>
namespace cg = cooperative_groups;

#ifndef REP_GEMM
#define REP_GEMM 1
#endif
#ifndef REP_ATTN
#define REP_ATTN 1
#endif
#ifndef REP_SCAN
#define REP_SCAN 1
#endif
#ifndef MEGA
#define MEGA 1
#endif

typedef unsigned short u16;
using bf16x8 = __attribute__((ext_vector_type(8))) short;
using s16x4  = __attribute__((ext_vector_type(4))) short;
using f32x16 = __attribute__((ext_vector_type(16))) float;
using f32x4  = __attribute__((ext_vector_type(4))) float;
using u32x4  = __attribute__((ext_vector_type(4))) unsigned;
using u32x2  = __attribute__((ext_vector_type(2))) unsigned;
#define DEV __device__ __forceinline__
#define SBAR() __builtin_amdgcn_sched_barrier(0)

constexpr int DM = 1024, EI = 2048, GT = 16384;
constexpr int NTOK = 49152;
constexpr int RW_N = 8448, ML_N = 2752, ML_NP = 2816;
constexpr int SHM_BYTES = 158720;

constexpr size_t alup(size_t x) { return (x + 255) / 256 * 256; }
constexpr size_t O_WRWIN  = 0;
constexpr size_t O_WRWOUT = O_WRWIN  + alup((size_t)2 * RW_N * DM * 2);
constexpr size_t O_WMLIN  = O_WRWOUT + alup((size_t)2 * DM * EI * 2);
constexpr size_t O_WUQ    = O_WMLIN  + alup((size_t)2 * ML_NP * DM * 2);
constexpr size_t O_WUKV   = O_WUQ    + alup((size_t)2 * 3072 * 384 * 2);
constexpr size_t O_WMLOUT = O_WUKV   + alup((size_t)2 * 4096 * 256 * 2);
constexpr size_t O_COS    = O_WMLOUT + alup((size_t)2 * DM * EI * 2);
constexpr size_t O_SIN    = O_COS    + alup((size_t)16384 * 32 * 4);
constexpr size_t O_HBUF   = O_SIN    + alup((size_t)16384 * 32 * 4);
constexpr size_t O_R0     = O_HBUF   + alup((size_t)GT * DM * 2);
constexpr size_t SZ_E = (size_t)GT * EI * 2;
constexpr size_t O_SG   = O_R0;
constexpr size_t O_RB   = O_SG + SZ_E;
constexpr size_t O_KB   = O_RB + SZ_E;
constexpr size_t O_VB   = O_KB + SZ_E;
constexpr size_t O_YF   = O_VB + SZ_E;
constexpr size_t O_YB   = O_YF + SZ_E;
constexpr size_t O_TWL  = O_YB + SZ_E;
constexpr size_t O_AL   = O_TWL + alup((size_t)GT * 128 * 2);
constexpr size_t O_BON  = O_AL  + alup((size_t)GT * 128 * 2);
constexpr size_t O_RW_END = O_BON + alup((size_t)GT * 64 * 4);
constexpr size_t O_CQKV = O_SG + SZ_E;
constexpr size_t O_CQN  = O_CQKV + alup((size_t)GT * 704 * 4);
constexpr size_t O_CKVN = O_CQN  + alup((size_t)GT * 384 * 2);
constexpr size_t O_KPE  = O_CKVN + alup((size_t)GT * 256 * 2);
constexpr size_t O_Q    = O_KPE  + alup((size_t)GT * 64 * 2);
constexpr size_t O_KV   = O_Q    + alup((size_t)GT * 3072 * 2);
constexpr size_t O_ML_END = O_KV + alup((size_t)GT * 4096 * 2);
constexpr size_t O_FLAG = O_RW_END > O_ML_END ? O_RW_END : O_ML_END;
constexpr size_t O_BAR = O_FLAG + 256;
constexpr size_t WS_NEED = O_BAR + 16384;

struct P {
  const float* x_prompt; const float* x_sample; const float* ln_g; const float* final_g;
  const float* rw_mu; const float* rw_in; const float* rw_w0; const float* rw_w2; const float* rw_a0; const float* rw_a2;
  const float* rw_kk; const float* rw_ka; const float* rw_rk; const float* rw_lnx_g; const float* rw_lnx_b; const float* rw_out;
  const float* ml_in; const float* ml_qn; const float* ml_kvn; const float* ml_uq; const float* ml_ukv; const float* ml_out;
  float* out; char* ws;
};

typedef __attribute__((ext_vector_type(2))) __bf16 bf16x2_t;
typedef __attribute__((ext_vector_type(2))) float f32x2_t;
DEV unsigned cvtpk(float lo, float hi) { f32x2_t v = {lo, hi}; bf16x2_t b = __builtin_convertvector(v, bf16x2_t); return __builtin_bit_cast(unsigned, b); }
DEV float bf2f(u16 x) { return __uint_as_float(((unsigned)x) << 16); }
DEV float bflo(unsigned x) { return __uint_as_float(x << 16); }
DEV float bfhi(unsigned x) { return __uint_as_float(x & 0xffff0000u); }
DEV u16 f2bf(float x) { __bf16 b = (__bf16)x; return __builtin_bit_cast(u16, b); }
DEV float wsum(float v) {
#pragma unroll
  for (int o = 32; o >= 1; o >>= 1) v += __shfl_xor(v, o, 64);
  return v;
}
DEV float siluf(float x) { return x / (1.f + __expf(-x)); }
DEV int crow(int r, int hi) { return (r & 3) + 8 * (r >> 2) + 4 * hi; }
DEV int ltid() { int t = threadIdx.x; asm volatile("" : "+v"(t)); return t; }
template <typename T> DEV T gld(size_t base, unsigned off) { return *(const __attribute__((address_space(1))) T*)(base + off); }
template <typename T> DEV void gst(size_t base, unsigned off, T v) { *(__attribute__((address_space(1))) T*)(base + off) = v; }
DEV void lds_wait() { asm volatile("s_waitcnt lgkmcnt(0)" ::: "memory"); }


#define XB_TMO      128
#define XB_XCNT(j)  (256  + 64 * (j))
#define XB_XSUB(j)  (1280 + 64 * (j))
#define XB_XGEN(j)  (2304 + 64 * (j))
#define XB_TOP      3328
#define XB_TOPGEN   3392
#define XCD_BAR_WORDS 3456
#define XB_SPIN_CAP (1u << 22)
#define LAS __attribute__((address_space(3)))
DEV unsigned xb_ld(unsigned* p)              { return __hip_atomic_load(p, __ATOMIC_RELAXED, __HIP_MEMORY_SCOPE_AGENT); }
DEV unsigned xb_add(unsigned* p, unsigned v) { return __hip_atomic_fetch_add(p, v, __ATOMIC_RELAXED, __HIP_MEMORY_SCOPE_AGENT); }
DEV unsigned xb_xcc_id() { return (unsigned)__builtin_amdgcn_s_getreg((3 << 11) | 20) & 0xFu; }
#define XB_SPIN(cond, bar) do { unsigned _sp = 0; while (cond) { __builtin_amdgcn_s_sleep(1); \
    if ((++_sp & 255u) == 0u) { if (xb_ld(&(bar)[XB_TMO])) break; if (_sp > XB_SPIN_CAP) { atomicAdd(&(bar)[XB_TMO], 1u); break; } } } } while (0)
struct XcdBarrier { unsigned* bar; unsigned x; volatile LAS unsigned* st; };
DEV void xcd_barrier_complete(unsigned* bar, unsigned x, unsigned& nloc, unsigned& nx) {
  const unsigned G = gridDim.x * gridDim.y * gridDim.z;
  unsigned sum, cnt, mine, sp = 0u;
  for (;;) {
    sum = 0u; cnt = 0u; mine = 0u;
#pragma unroll
    for (unsigned j = 0; j < 16; ++j) { const unsigned c = xb_ld(&bar[XB_XCNT(j)]); sum += c; cnt += (c > 0u) ? 1u : 0u; mine = (j == x) ? c : mine; }
    if (sum == G) break;
    __builtin_amdgcn_s_sleep(1);
    if ((++sp & 255u) == 0u) { if (xb_ld(&bar[XB_TMO])) break; if (sp > XB_SPIN_CAP) { atomicAdd(&bar[XB_TMO], 1u); break; } }
  }
  nloc = mine > 0u ? mine : 1u; nx = cnt > 0u ? cnt : 1u;
}
DEV void xcd_barrier(const XcdBarrier& b) {
  asm volatile("s_waitcnt vmcnt(0)" ::: "memory");
  __syncthreads();
  if (threadIdx.x == 0) {
    unsigned* bar = b.bar;
    __builtin_amdgcn_s_waitcnt(0);
    unsigned nloc = b.st[0], nx = b.st[1];
    if (nloc == 0u) { xcd_barrier_complete(bar, b.x, nloc, nx); b.st[0] = nloc; b.st[1] = nx; }
    const unsigned old = xb_add(&bar[XB_XSUB(b.x)], 1u);
    const unsigned gen = old / nloc;
    if (old + 1u == (gen + 1u) * nloc) {
      __builtin_amdgcn_fence(__ATOMIC_RELEASE, "agent");
      asm volatile("s_waitcnt vmcnt(0)" ::: "memory");
      const unsigned og = xb_add(&bar[XB_TOP], 1u);
      const unsigned tg = og / nx;
      if (og + 1u == (tg + 1u) * nx) xb_add(&bar[XB_TOPGEN], 1u);
      else XB_SPIN(xb_ld(&bar[XB_TOPGEN]) == tg, bar);
      __builtin_amdgcn_fence(__ATOMIC_ACQUIRE, "agent");
      xb_add(&bar[XB_XGEN(b.x)], 1u);
      asm volatile("s_waitcnt vmcnt(0)" ::: "memory");
    } else {
      XB_SPIN(xb_ld(&bar[XB_XGEN(b.x)]) == gen, bar);
      __builtin_amdgcn_fence(__ATOMIC_ACQUIRE, "agent");
      asm volatile("s_waitcnt vmcnt(0)" ::: "memory");
    }
  }
  __syncthreads();
}
DEV void gsync(const P& p, char* lds) {
  XcdBarrier b; b.bar = (unsigned*)(p.ws + O_BAR); b.x = xb_xcc_id(); b.st = (volatile LAS unsigned*)(lds + SHM_BYTES - 16);
  xcd_barrier(b);
}

DEV void convert_T(const float* __restrict__ src, u16* __restrict__ dst, int K, int N, int Npad, char* lds_) {
  float* lds = (float*)lds_;
  const int tid = ltid(), tk = K / 64, tn = Npad / 64;
  for (int t = blockIdx.x; t < tk * tn; t += gridDim.x) {
    const int k0 = (t % tk) * 64, n0 = (t / tk) * 64;
    __syncthreads();
#pragma unroll
    for (int i = 0; i < 2; ++i) {
      const int kr = (tid >> 4) + i * 32, c = (tid & 15) * 4;
      float4 v = make_float4(0.f, 0.f, 0.f, 0.f);
      if (n0 + c < N) v = *(const float4*)(src + (long)(k0 + kr) * N + n0 + c);
      lds[kr * 65 + c + 0] = v.x; lds[kr * 65 + c + 1] = v.y; lds[kr * 65 + c + 2] = v.z; lds[kr * 65 + c + 3] = v.w;
    }
    __syncthreads();
    const int n = tid >> 3, kc = (tid & 7) * 8;
    u32x4 w;
    w[0] = cvtpk(lds[(kc + 0) * 65 + n], lds[(kc + 1) * 65 + n]);
    w[1] = cvtpk(lds[(kc + 2) * 65 + n], lds[(kc + 3) * 65 + n]);
    w[2] = cvtpk(lds[(kc + 4) * 65 + n], lds[(kc + 5) * 65 + n]);
    w[3] = cvtpk(lds[(kc + 6) * 65 + n], lds[(kc + 7) * 65 + n]);
    *(u32x4*)(dst + (long)(n0 + n) * K + k0 + kc) = w;
  }
}

DEV void init_phase(const P& p, char* lds) {
  for (int j = 0; j < 2; ++j) {
    convert_T(p.rw_in  + (size_t)j * DM * RW_N, (u16*)(p.ws + O_WRWIN)  + (size_t)j * RW_N * DM, DM, RW_N, RW_N, lds);
    convert_T(p.rw_out + (size_t)j * EI * DM,   (u16*)(p.ws + O_WRWOUT) + (size_t)j * DM * EI,   EI, DM, DM, lds);
    convert_T(p.ml_in  + (size_t)j * DM * ML_N, (u16*)(p.ws + O_WMLIN)  + (size_t)j * ML_NP * DM, DM, ML_N, ML_NP, lds);
    convert_T(p.ml_uq  + (size_t)j * 384 * 3072, (u16*)(p.ws + O_WUQ)   + (size_t)j * 3072 * 384, 384, 3072, 3072, lds);
    convert_T(p.ml_ukv + (size_t)j * 256 * 4096, (u16*)(p.ws + O_WUKV)  + (size_t)j * 4096 * 256, 256, 4096, 4096, lds);
    convert_T(p.ml_out + (size_t)j * EI * DM,   (u16*)(p.ws + O_WMLOUT) + (size_t)j * DM * EI,   EI, DM, DM, lds);
  }
  float* ct = (float*)(p.ws + O_COS); float* st = (float*)(p.ws + O_SIN);
  const int tid_ = ltid();
  for (int i = blockIdx.x * 512 + tid_; i < 16384 * 32; i += gridDim.x * 512) {
    const int pos = i >> 5, j = i & 31;
    const float invf = 1.0f / powf(10000.0f, (float)(2 * j) / 64.0f);
    const float ang = (float)pos * invf;
    const double a = (double)ang;
    const double n = rint(a * 0.15915494309189535);
    const float r = (float)(a - n * 6.283185307179586);
    ct[i] = cosf(r); st[i] = sinf(r);
  }
}

DEV void rms_phase(const float* __restrict__ x, const float* __restrict__ g, u16* __restrict__ hout) {
  const int tid_ = ltid(); const int lane = tid_ & 63, wid = __builtin_amdgcn_readfirstlane(tid_ >> 6);
  for (int tok = blockIdx.x * 8 + wid; tok < GT; tok += gridDim.x * 8) {
    const float4* xr = (const float4*)(x + (size_t)tok * DM);
    float4 v[4]; float ss = 0.f;
#pragma unroll
    for (int i = 0; i < 4; ++i) { v[i] = xr[lane + i * 64]; ss += v[i].x * v[i].x + v[i].y * v[i].y + v[i].z * v[i].z + v[i].w * v[i].w; }
    ss = wsum(ss);
    const float sc = rsqrtf(ss * (1.f / DM) + 1e-6f);
#pragma unroll
    for (int i = 0; i < 4; ++i) {
      const float4 gg = ((const float4*)g)[lane + i * 64];
      u32x2 w; w[0] = cvtpk(v[i].x * sc * gg.x, v[i].y * sc * gg.y); w[1] = cvtpk(v[i].z * sc * gg.z, v[i].w * sc * gg.w);
      *(u32x2*)(hout + (size_t)tok * DM + (lane + i * 64) * 4) = w;
    }
  }
}

DEV void final_phase(float* __restrict__ x, const float* __restrict__ g) {
  const int tid_ = ltid(); const int lane = tid_ & 63, wid = __builtin_amdgcn_readfirstlane(tid_ >> 6);
  for (int tok = blockIdx.x * 8 + wid; tok < NTOK; tok += gridDim.x * 8) {
    float4* xr = (float4*)(x + (size_t)tok * DM);
    float4 v[4]; float ss = 0.f;
#pragma unroll
    for (int i = 0; i < 4; ++i) { v[i] = xr[lane + i * 64]; ss += v[i].x * v[i].x + v[i].y * v[i].y + v[i].z * v[i].z + v[i].w * v[i].w; }
    ss = wsum(ss);
    const float sc = rsqrtf(ss * (1.f / DM) + 1e-6f);
#pragma unroll
    for (int i = 0; i < 4; ++i) {
      const float4 gg = ((const float4*)g)[lane + i * 64];
      float4 ov = make_float4(v[i].x * sc * gg.x, v[i].y * sc * gg.y, v[i].z * sc * gg.z, v[i].w * sc * gg.w);
      xr[lane + i * 64] = ov;
    }
  }
}


DEV void lerp_phase(const u16* __restrict__ h, const float* __restrict__ mu, u16* __restrict__ out, int T) {
  const int tid_ = ltid(); const int lane = tid_ & 63, wid = __builtin_amdgcn_readfirstlane(tid_ >> 6);
  for (int tok = blockIdx.x * 8 + wid; tok < GT; tok += gridDim.x * 8) {
    const int pos = tok % T;
#pragma unroll
    for (int half = 0; half < 2; ++half) {
      const int c0 = half * 512 + lane * 8;
      const u32x4 c = *(const u32x4*)(h + (size_t)tok * DM + c0);
      u32x4 pv = {0u, 0u, 0u, 0u}, nx = {0u, 0u, 0u, 0u};
      if (pos > 0) pv = *(const u32x4*)(h + (size_t)(tok - 1) * DM + c0);
      if (pos < T - 1) nx = *(const u32x4*)(h + (size_t)(tok + 1) * DM + c0);
      float hh[8], xx[8];
#pragma unroll
      for (int e = 0; e < 4; ++e) {
        hh[2 * e] = bflo(c[e]); hh[2 * e + 1] = bfhi(c[e]);
        xx[2 * e] = 0.5f * (bflo(pv[e]) + bflo(nx[e])) - hh[2 * e]; xx[2 * e + 1] = 0.5f * (bfhi(pv[e]) + bfhi(nx[e])) - hh[2 * e + 1];
      }
#pragma unroll
      for (int st = 0; st < 4; ++st) {
        const int mi = st == 0 ? 0 : st == 1 ? 2 : st == 2 ? 3 : 5;
        const float4 m0v = *(const float4*)(mu + mi * DM + c0), m1v = *(const float4*)(mu + mi * DM + c0 + 4);
        const float m[8] = {m0v.x, m0v.y, m0v.z, m0v.w, m1v.x, m1v.y, m1v.z, m1v.w};
        u32x4 o;
#pragma unroll
        for (int e = 0; e < 4; ++e) o[e] = cvtpk(hh[2 * e] + m[2 * e] * xx[2 * e], hh[2 * e + 1] + m[2 * e + 1] * xx[2 * e + 1]);
        *(u32x4*)(out + (size_t)st * GT * DM + (size_t)tok * DM + c0) = o;
      }
    }
  }
}

#define GSWZ(row, c16) ((row) * 128 + ((((c16) ^ ((row) >> 1)) & 7) << 4))
constexpr int LOAD_PLAIN = 0, LOAD_LERP = 1;
constexpr int EPI_RWKV = 0, EPI_RES = 1, EPI_MLAIN = 2, EPI_BF16 = 3;
struct GemmP {
  const u16* A; int lda; const u16* Bt; int K; int NT;
  const float* mu;
  int T;
  u16* o0; u16* o1; u16* o2; u16* o3; u16* o4; u16* o5;
  int ldc;
  float* of; const float* xin; float* xout; int dry;
  int nt0; size_t astride;
};

template <int LOAD, int EPI, int NI>
DEV void gemm_phase(const GemmP& g, char* lds) {
  constexpr int BN = 64 * NI, SBB = BN * 128;
  const int tid = ltid(), wid = tid >> 6, lane = tid & 63, r32 = lane & 31, hi = lane >> 5;
  const int wm = wid >> 1, wn = wid & 1;
  char* sA = lds; char* sB = lds + 65536;
  int Kv = g.K; asm volatile("" : "+s"(Kv));
  const int nk = Kv / 64, ntiles = 64 * g.NT;
  const int c16 = tid & 7, rowb = tid >> 3;
  for (int t = blockIdx.x; t < ntiles; t += gridDim.x) {
    const int mt = t & 63, nt = g.nt0 + (t >> 6), m0 = mt * 256, n0 = nt * BN;
    const u16* Ab = g.A + (size_t)(n0 >> 11) * g.astride;
    f32x16 acc[2][NI] = {};
    bf16x8 ra[4], rb[NI];
    const float* mup = nullptr;
    if constexpr (LOAD == LOAD_LERP) {
      const int s = n0 < 2048 ? 0 : n0 < 4096 ? 2 : n0 < 6144 ? 3 : n0 < 8192 ? 5 : n0 == 8192 ? 1 : 4;
      mup = g.mu + s * DM;
    }
    auto gload = [&](int kt) {
      const int k0 = kt * 64 + c16 * 8;
#pragma unroll
      for (int i = 0; i < 4; ++i) {
        const int row = rowb + i * 64; const size_t tok = (size_t)(m0 + row);
        if constexpr (LOAD == LOAD_PLAIN) {
          ra[i] = *(const bf16x8*)(Ab + tok * g.lda + k0);
        } else {
          const int pos = (int)(tok % (size_t)g.T);
          const u32x4 c = *(const u32x4*)(g.A + tok * DM + k0);
          u32x4 pv = {0u, 0u, 0u, 0u}, nx = {0u, 0u, 0u, 0u};
          if (pos > 0) pv = *(const u32x4*)(g.A + (tok - 1) * DM + k0);
          if (pos < g.T - 1) nx = *(const u32x4*)(g.A + (tok + 1) * DM + k0);
          const float4 m0v = *(const float4*)(mup + k0), m1v = *(const float4*)(mup + k0 + 4);
          const float mu[8] = {m0v.x, m0v.y, m0v.z, m0v.w, m1v.x, m1v.y, m1v.z, m1v.w};
          u32x4 o;
#pragma unroll
          for (int e = 0; e < 4; ++e) {
            const float h0 = bflo(c[e]), h1 = bfhi(c[e]);
            const float x0 = 0.5f * (bflo(pv[e]) + bflo(nx[e])) - h0, x1 = 0.5f * (bfhi(pv[e]) + bfhi(nx[e])) - h1;
            o[e] = cvtpk(h0 + mu[2 * e] * x0, h1 + mu[2 * e + 1] * x1);
          }
          ra[i] = *(bf16x8*)&o;
        }
      }
#pragma unroll
      for (int i = 0; i < NI; ++i) {
        const int row = rowb + i * 64;
        rb[i] = *(const bf16x8*)(g.Bt + (size_t)(n0 + row) * Kv + k0);
      }
    };
    auto swrite = [&](int b) {
#pragma unroll
      for (int i = 0; i < 4; ++i) { const int row = rowb + i * 64; *(bf16x8*)(sA + b * 32768 + GSWZ(row, c16)) = ra[i]; }
#pragma unroll
      for (int i = 0; i < NI; ++i) { const int row = rowb + i * 64; *(bf16x8*)(sB + b * SBB + GSWZ(row, c16)) = rb[i]; }
    };
    gload(0); swrite(0); __syncthreads();
    for (int kt = 0; kt < nk; ++kt) {
      const int b = kt & 1;
      if (kt + 1 < nk) gload(kt + 1);
      const char* a_ = sA + b * 32768; const char* b_ = sB + b * SBB;
#pragma unroll
      for (int ks = 0; ks < 4; ++ks) {
        bf16x8 af[2], bfr[NI];
#pragma unroll
        for (int mi = 0; mi < 2; ++mi) { const int row = wm * 64 + mi * 32 + r32; af[mi] = *(const bf16x8*)(a_ + GSWZ(row, ks * 2 + hi)); }
#pragma unroll
        for (int ni = 0; ni < NI; ++ni) { const int row = wn * (32 * NI) + ni * 32 + r32; bfr[ni] = *(const bf16x8*)(b_ + GSWZ(row, ks * 2 + hi)); }
#pragma unroll
        for (int mi = 0; mi < 2; ++mi)
#pragma unroll
          for (int ni = 0; ni < NI; ++ni) acc[mi][ni] = __builtin_amdgcn_mfma_f32_32x32x16_bf16(af[mi], bfr[ni], acc[mi][ni], 0, 0, 0);
      }
      if (kt + 1 < nk) swrite(b ^ 1);
      __syncthreads();
    }
    if (!g.dry)
#pragma unroll
    for (int mi = 0; mi < 2; ++mi)
#pragma unroll
      for (int ni = 0; ni < NI; ++ni)
#pragma unroll
        for (int r = 0; r < 16; ++r) {
          const size_t m = (size_t)(m0 + wm * 64 + mi * 32 + crow(r, hi));
          const int nl = wn * (32 * NI) + ni * 32 + r32, n = n0 + nl;
          const float v = acc[mi][ni][r];
          if constexpr (EPI == EPI_RWKV) {
            if (n0 < 8192) {
              const int which = n0 >> 11, col = n & 2047;
              u16* dst = which == 0 ? g.o0 : which == 1 ? g.o1 : which == 2 ? g.o2 : g.o3;
              dst[m * EI + col] = f2bf(which == 3 ? siluf(v) : v);
            } else if (n0 == 8192) g.o4[m * 128 + nl] = f2bf(tanhf(v));
            else g.o5[m * 128 + nl] = f2bf(v);
          } else if constexpr (EPI == EPI_RES) {
            g.xout[m * DM + n] = g.xin[m * DM + n] + v;
          } else if constexpr (EPI == EPI_MLAIN) {
            if (n < 704) g.of[m * 704 + n] = v;
            else if (n < ML_N) g.o0[m * EI + (n - 704)] = f2bf(siluf(v));
          } else {
            g.o0[m * g.ldc + n] = f2bf(v);
          }
        }
  }
}

struct ScanP {
  const u16 *r, *k, *v, *twl, *al; u16 *yf, *yb; float* bonus;
  const float *w0, *w2, *a0, *a2, *kk, *ka, *rk;
  int nseq, T;
  float* tbuf; int nseg;
};
template <int CTRL> DEV float dppf(float x) {
  return __int_as_float(__builtin_amdgcn_update_dpp(0, __float_as_int(x), CTRL, 0xF, 0xF, false));
}
DEV float row_prefix16(float x) {
  x += dppf<0x111>(x); x += dppf<0x112>(x); x += dppf<0x114>(x); x += dppf<0x118>(x); return x;
}
DEV float row_total16(float x) {
  x += dppf<0x128>(x); x += dppf<0x124>(x); x += dppf<0x122>(x); x += dppf<0x121>(x); return x;
}
DEV bf16x8 pack8(float a0, float a1, float a2, float a3, float a4, float a5, float a6, float a7) {
  u32x4 w = {cvtpk(a0, a1), cvtpk(a2, a3), cvtpk(a4, a5), cvtpk(a6, a7)}; return *(bf16x8*)&w;
}
constexpr int SC_BKT = 0, SC_UVT = 5120, SC_AKM = 10240, SC_RR = 10752, SC_ABF = 11776, SC_Z = 12800, SC_PRM = 17152, SC_T = 18944, SC_WAVE = 35328;
constexpr int SC_PRE = SC_UVT;
constexpr int SC_SHARED_AW = 4 * SC_WAVE;
constexpr int SC_NW = 4;
DEV void scan_phase(const ScanP& s, char* lds_, const int pass) {
  const int tid = ltid(), wid = __builtin_amdgcn_readfirstlane(tid >> 6), lane = tid & 63, c16 = lane & 15, q = lane >> 4;
  const int nchain = s.nseq * 64, nseg = s.nseg;
  const int ipc = pass == 0 ? nseg * 2 : nseg;
  const bool shared = nchain <= (int)gridDim.x;
  const int nsb = shared ? (int)gridDim.x / nchain : 1, sbi = shared ? (int)blockIdx.x / nchain : 0;
  const int nwv = shared ? SC_NW : 2;
  if (shared && sbi >= nsb) return;
  char* wl = lds_ + (wid & 3) * SC_WAVE;
  u16* bkt = (u16*)(wl + SC_BKT); u16* uvt = (u16*)(wl + SC_UVT); u16* akm = (u16*)(wl + SC_AKM); u16* rr = (u16*)(wl + SC_RR);
  float* abf = (float*)(wl + SC_ABF); float* zl = (float*)(wl + SC_Z); float* prm = (float*)(wl + SC_PRM); float* p15l = prm + 320;
  bf16x8* awl = (bf16x8*)(shared ? lds_ + SC_SHARED_AW : lds_ + (2 + (wid & 1)) * SC_WAVE); bf16x8* aal = awl + 512;
#define SCAN_LOAD_W(CHAIN, F0, F1) do { const int d_ = (CHAIN) & 1, h_ = ((CHAIN) >> 1) & 31; \
    for (int f = (F0); f < (F1); ++f) { const int ks = f >> 2, mt = f & 3; u32x4 pw, pa; \
      _Pragma("unroll") for (int e = 0; e < 4; ++e) { const int l0 = ks * 32 + q * 8 + 2 * e; \
        const size_t i0 = ((size_t)(d_ * 64 + l0)) * EI + h_ * 64 + mt * 16 + c16; \
        pw[e] = cvtpk(s.w2[i0], s.w2[i0 + EI]); pa[e] = cvtpk(s.a2[i0], s.a2[i0 + EI]); } \
      awl[f * 64 + lane] = *(bf16x8*)&pw; aal[f * 64 + lane] = *(bf16x8*)&pa; } } while (0)
  if (shared) {
    const int chain_b = (int)blockIdx.x % nchain;
    SCAN_LOAD_W(chain_b, wid, wid + 1);
    __syncthreads();
  }
  if (wid >= nwv) return;
  const int nrounds = shared ? (ipc + nsb * SC_NW - 1) / (nsb * SC_NW) : (nchain + 2 * (int)gridDim.x - 1) / (2 * (int)gridDim.x);
  for (int round = 0; round < nrounds; ++round) {
    const int chain = shared ? (int)blockIdx.x % nchain : (round * 2 + wid) * (int)gridDim.x + (int)blockIdx.x;
    const int it = shared ? sbi * SC_NW + wid + round * nsb * SC_NW : 0;
    if (chain >= nchain || it >= ipc) continue;
    const int kind = pass == 0 ? 1 + (it & 1) : 0;
    const int seg = pass == 0 ? it >> 1 : it;
    const int cs = chain * nseg + seg;
    const int d = chain & 1, h = (chain >> 1) & 31, b = chain >> 6;
    {
      const int ch = h * 64 + lane;
      lds_wait();
      prm[lane] = s.w0[d * EI + ch]; prm[64 + lane] = s.a0[d * EI + ch]; prm[128 + lane] = s.kk[ch]; prm[192 + lane] = s.ka[ch]; prm[256 + lane] = s.rk[ch];
      lds_wait();
    }
    if (!shared) { SCAN_LOAD_W(chain, 0, 8); lds_wait(); }
    const unsigned rowi = (unsigned)(d ? 15 - c16 : c16);
    const unsigned off_tw = rowi * 256u + (unsigned)(q * 16);
    const unsigned off_kr = rowi * 4096u + (unsigned)(h * 128 + q * 8);
    const unsigned off_v  = (unsigned)(h * 128 + lane * 2);
    const unsigned off_y0 = (unsigned)(d ? 15 - 4 * q : 4 * q) * 4096u + (unsigned)(h * 128 + c16 * 2);
    const int ystep = d ? -4096 : 4096;
    f32x4* Tl = (f32x4*)(wl + SC_T);
#pragma unroll
    for (int m = 0; m < 16; ++m) {
      f32x4 t0v = {0.f, 0.f, 0.f, 0.f};
      if (kind == 2) {
        const int mt = m >> 2, nt = m & 3;
        if (mt == nt) { t0v[0] = (4 * q + 0 == c16) ? 1.f : 0.f; t0v[1] = (4 * q + 1 == c16) ? 1.f : 0.f; t0v[2] = (4 * q + 2 == c16) ? 1.f : 0.f; t0v[3] = (4 * q + 3 == c16) ? 1.f : 0.f; }
      } else if (kind == 0 && nseg > 1) {
        t0v = *(const f32x4*)(s.tbuf + ((size_t)cs * 2) * 4096 + (m * 64 + lane) * 4);
      }
      Tl[m * 64 + lane] = t0v;
    }
    u16* yout = d ? s.yb : s.yf;
    const size_t sb = (size_t)b * s.T;
    const int cps = s.T / 16 / nseg, cbeg = seg * cps, cend = cbeg + cps;
    bf16x8 n_tw0, n_tw1, n_ta0, n_ta1; u32x2 n_k[4], n_r[4];
#define SCAN_LOAD(CC) do { const int c0n = d ? (s.T - 16 - (CC) * 16) : (CC) * 16; const size_t t0n = sb + c0n; \
      size_t p_tw = (size_t)s.twl + t0n * 256 + d * 128, p_al = (size_t)s.al + t0n * 256 + d * 128, p_k = (size_t)s.k + t0n * 4096, p_r = (size_t)s.r + t0n * 4096 ; \
      asm volatile("" : "+s"(p_tw), "+s"(p_al), "+s"(p_k), "+s"(p_r)); \
      n_tw0 = gld<bf16x8>(p_tw, off_tw); n_tw1 = gld<bf16x8>(p_tw, off_tw + 64); n_ta0 = gld<bf16x8>(p_al, off_tw); n_ta1 = gld<bf16x8>(p_al, off_tw + 64); \
      _Pragma("unroll") for (int mt = 0; mt < 4; ++mt) { n_k[mt] = gld<u32x2>(p_k, off_kr + mt * 32); n_r[mt] = gld<u32x2>(p_r, off_kr + mt * 32); } } while (0)
    SCAN_LOAD(cbeg);
    for (int cc = cbeg; cc < cend; ++cc) {
      const int c0 = d ? (s.T - 16 - cc * 16) : cc * 16;
      const size_t t0 = sb + c0;
      size_t b_y = (size_t)yout + t0 * 4096, b_bon = (size_t)s.bonus + t0 * 256 + (h * 2 + d) * 4;
      asm volatile("" : "+s"(b_y), "+s"(b_bon));
      size_t b_v = (size_t)s.v + t0 * 4096; asm volatile("" : "+s"(b_v));
      u32x2 n_v[4];
#pragma unroll
      for (int mt = 0; mt < 4; ++mt) n_v[mt] = gld<u32x2>(b_v, off_kr + mt * 32);
      {
        f32x4* wpl = (f32x4*)zl; f32x4* apl = (f32x4*)(wl + SC_PRE);
#pragma unroll
        for (int mt = 0; mt < 4; ++mt) {
          f32x4 cw = {0.f, 0.f, 0.f, 0.f}, ca = {0.f, 0.f, 0.f, 0.f};
          cw = __builtin_amdgcn_mfma_f32_16x16x32_bf16(awl[(0 * 4 + mt) * 64 + lane], n_tw0, cw, 0, 0, 0);
          cw = __builtin_amdgcn_mfma_f32_16x16x32_bf16(awl[(1 * 4 + mt) * 64 + lane], n_tw1, cw, 0, 0, 0);
          ca = __builtin_amdgcn_mfma_f32_16x16x32_bf16(aal[(0 * 4 + mt) * 64 + lane], n_ta0, ca, 0, 0, 0);
          ca = __builtin_amdgcn_mfma_f32_16x16x32_bf16(aal[(1 * 4 + mt) * 64 + lane], n_ta1, ca, 0, 0, 0);
          wpl[mt * 64 + lane] = cw; apl[mt * 64 + lane] = ca;
        }
      }
      float n2 = 0.f;
#pragma unroll
      for (int mt = 0; mt < 4; ++mt) {
        const float4 kkp = *(const float4*)(prm + 128 + mt * 16 + q * 4);
        const float t0 = bflo(n_k[mt][0]) * kkp.x, t1 = bfhi(n_k[mt][0]) * kkp.y, t2 = bflo(n_k[mt][1]) * kkp.z, t3 = bfhi(n_k[mt][1]) * kkp.w;
        n2 += t0 * t0 + t1 * t1 + t2 * t2 + t3 * t3;
      }
      n2 += __shfl_xor(n2, 16, 64); n2 += __shfl_xor(n2, 32, 64);
      const float invn = __builtin_amdgcn_rsqf(fmaxf(n2, 1e-24f));
      float bon = 0.f;
      bf16x8 ktf[2], btf[2], kdf[2], rtf[2];
#pragma unroll
      for (int ks = 0; ks < 2; ++ks) {
        float ktl[8], btl[8], kdl[8], rtl[8];
#pragma unroll
        for (int mh = 0; mh < 2; ++mh) {
          const int mt = 2 * ks + mh;
          const f32x4 cw = ((const f32x4*)zl)[mt * 64 + lane], ca = ((const f32x4*)(wl + SC_PRE))[mt * 64 + lane];
          const float4 w0p = *(const float4*)(prm + mt * 16 + q * 4), a0p = *(const float4*)(prm + 64 + mt * 16 + q * 4);
          const float4 kkp = *(const float4*)(prm + 128 + mt * 16 + q * 4), kap = *(const float4*)(prm + 192 + mt * 16 + q * 4), rkp = *(const float4*)(prm + 256 + mt * 16 + q * 4);
          const float w0a[4] = {w0p.x, w0p.y, w0p.z, w0p.w}, a0a[4] = {a0p.x, a0p.y, a0p.z, a0p.w};
          const float kka[4] = {kkp.x, kkp.y, kkp.z, kkp.w}, kaa[4] = {kap.x, kap.y, kap.z, kap.w}, rka[4] = {rkp.x, rkp.y, rkp.z, rkp.w};
          const u32x2 kr_ = n_k[mt], rr_ = n_r[mt];
          const float kxa[4] = {bflo(kr_[0]), bfhi(kr_[0]), bflo(kr_[1]), bfhi(kr_[1])};
          const float rxa[4] = {bflo(rr_[0]), bfhi(rr_[0]), bflo(rr_[1]), bfhi(rr_[1])};
          float4 p15v;
#pragma unroll
          for (int e = 0; e < 4; ++e) {
            const float wp = cw[e] + w0a[e], ap = ca[e] + a0a[e];
            const float ee = 0.6065306597126334f * __builtin_amdgcn_rcpf(1.f + __expf(-wp));
            const float a = __builtin_amdgcn_rcpf(1.f + __expf(-ap));
            const float kkn = kxa[e] * kka[e] * invn;
            const float kd = kxa[e] * (1.f + (a - 1.f) * kaa[e]);
            const float bb = kkn * a;
            bon += rxa[e] * kd * rka[e];
            const float Ei = row_prefix16(ee), Et = row_total16(ee);
            const float pm = __expf(-Ei), pp = __builtin_amdgcn_rcpf(pm), pm1 = __expf(ee - Ei);
            ktl[mh * 4 + e] = kkn * pm1; btl[mh * 4 + e] = bb * pp; kdl[mh * 4 + e] = kd * pp; rtl[mh * 4 + e] = rxa[e] * pm;
            ((float*)&p15v)[e] = __expf(-Et);
            const int j = mt * 16 + q * 4 + e;
            bkt[j * 40 + c16] = f2bf(btl[mh * 4 + e]); bkt[j * 40 + 16 + c16] = f2bf(kdl[mh * 4 + e]);
          }
          if (c16 == 0) *(float4*)(p15l + mt * 16 + q * 4) = p15v;
          SBAR();
        }
        ktf[ks] = pack8(ktl[0], ktl[1], ktl[2], ktl[3], ktl[4], ktl[5], ktl[6], ktl[7]);
        btf[ks] = pack8(btl[0], btl[1], btl[2], btl[3], btl[4], btl[5], btl[6], btl[7]);
        kdf[ks] = pack8(kdl[0], kdl[1], kdl[2], kdl[3], kdl[4], kdl[5], kdl[6], kdl[7]);
        rtf[ks] = pack8(rtl[0], rtl[1], rtl[2], rtl[3], rtl[4], rtl[5], rtl[6], rtl[7]);
      }
      bon += __shfl_xor(bon, 16, 64); bon += __shfl_xor(bon, 32, 64);
      if (q == 0 && kind == 0) gst<float>(b_bon, off_tw, bon);
      SBAR();
      SBAR();
#pragma unroll
      for (int mt = 0; mt < 4; ++mt) {
        const int vb_ = (mt * 16 + q * 4) * 40 + 16 + c16;
        const unsigned v0_ = kind == 2 ? 0u : n_v[mt][0], v1_ = kind == 2 ? 0u : n_v[mt][1];
        uvt[vb_] = (u16)(v0_ & 0xffffu); uvt[vb_ + 40] = (u16)(v0_ >> 16);
        uvt[vb_ + 80] = (u16)(v1_ & 0xffffu); uvt[vb_ + 120] = (u16)(v1_ >> 16);
      }
      { const int cn = cc + 1 < cend ? cc + 1 : cc; SCAN_LOAD(cn); }
      SBAR();
      {
        f32x4 AB = {0.f, 0.f, 0.f, 0.f}, AK = AB, RB = AB, RK = AB;
        int qm = q; asm volatile("" : "+v"(qm));
#pragma unroll
        for (int ks = 0; ks < 2; ++ks) {
          AB = __builtin_amdgcn_mfma_f32_16x16x32_bf16(ktf[ks], btf[ks], AB, 0, 0, 0);
          AK = __builtin_amdgcn_mfma_f32_16x16x32_bf16(ktf[ks], kdf[ks], AK, 0, 0, 0);
          RB = __builtin_amdgcn_mfma_f32_16x16x32_bf16(rtf[ks], btf[ks], RB, 0, 0, 0);
          RK = __builtin_amdgcn_mfma_f32_16x16x32_bf16(rtf[ks], kdf[ks], RK, 0, 0, 0);
        }
#pragma unroll
        for (int r = 0; r < 4; ++r) {
          const int i = 4 * qm + r;
          const bool lo = c16 < i, le = c16 <= i;
          abf[i * 16 + c16] = lo ? AB[r] : 0.f;
          akm[i * 16 + c16] = f2bf(lo ? AK[r] : 0.f);
          rr[i * 32 + c16] = f2bf(le ? RB[r] : 0.f);
          rr[i * 32 + 16 + c16] = f2bf(le ? RK[r] : 0.f);
        }
      }
#define TFRAG(ks, nt, OUT) do { const f32x4 ta_ = Tl[((2 * (ks)) * 4 + (nt)) * 64 + lane], tb_ = Tl[((2 * (ks) + 1) * 4 + (nt)) * 64 + lane]; \
        OUT = pack8(ta_[0], ta_[1], ta_[2], ta_[3], tb_[0], tb_[1], tb_[2], tb_[3]); } while (0)
      lds_wait();
      {
        bf16x8 akf = {0, 0, 0, 0, 0, 0, 0, 0};
        if (q < 2) akf = *(const bf16x8*)(akm + c16 * 16 + q * 8);
#pragma unroll
        for (int nt = 0; nt < 4; ++nt) {
          f32x4 z = {0.f, 0.f, 0.f, 0.f};
          bf16x8 tf0, tf1; TFRAG(0, nt, tf0); TFRAG(1, nt, tf1);
          z = __builtin_amdgcn_mfma_f32_16x16x32_bf16(ktf[0], tf0, z, 0, 0, 0);
          z = __builtin_amdgcn_mfma_f32_16x16x32_bf16(ktf[1], tf1, z, 0, 0, 0);
          const bf16x8 vf = *(const bf16x8*)(uvt + (nt * 16 + c16) * 40 + 16 + (q & 1) * 8);
          z = __builtin_amdgcn_mfma_f32_16x16x32_bf16(akf, vf, z, 0, 0, 0);
#pragma unroll
          for (int r = 0; r < 4; ++r) zl[(4 * q + r) * 68 + nt * 16 + c16] = z[r];
        }
      }
      lds_wait();
      SBAR();
      {
        float U[16];
#pragma unroll
        for (int i = 0; i < 16; ++i) {
          float acc = -zl[i * 68 + lane];
#pragma unroll
          for (int s4 = 0; s4 < (i + 3) / 4; ++s4) {
            const float4 a4 = *(const float4*)(abf + i * 16 + s4 * 4);
            if (s4 * 4 + 0 < i) acc -= a4.x * U[s4 * 4 + 0];
            if (s4 * 4 + 1 < i) acc -= a4.y * U[s4 * 4 + 1];
            if (s4 * 4 + 2 < i) acc -= a4.z * U[s4 * 4 + 2];
            if (s4 * 4 + 3 < i) acc -= a4.w * U[s4 * 4 + 3];
          }
          U[i] = acc;
          if ((i & 3) == 3) SBAR();
        }
        *(bf16x8*)(uvt + lane * 40) = pack8(U[0], U[1], U[2], U[3], U[4], U[5], U[6], U[7]);
        *(bf16x8*)(uvt + lane * 40 + 8) = pack8(U[8], U[9], U[10], U[11], U[12], U[13], U[14], U[15]);
      }
      lds_wait();
      SBAR();
      {
        const bf16x8 rrf = *(const bf16x8*)(rr + c16 * 32 + q * 8);
        bf16x8 uvf[4];
#pragma unroll
        for (int nt = 0; nt < 4; ++nt) uvf[nt] = *(const bf16x8*)(uvt + (nt * 16 + c16) * 40 + q * 8);
#pragma unroll
        for (int nt = 0; nt < 4; ++nt) {
          f32x4 y = {0.f, 0.f, 0.f, 0.f};
          bf16x8 tf0, tf1; TFRAG(0, nt, tf0); TFRAG(1, nt, tf1);
          y = __builtin_amdgcn_mfma_f32_16x16x32_bf16(rtf[0], tf0, y, 0, 0, 0);
          y = __builtin_amdgcn_mfma_f32_16x16x32_bf16(rtf[1], tf1, y, 0, 0, 0);
          y = __builtin_amdgcn_mfma_f32_16x16x32_bf16(rrf, uvf[nt], y, 0, 0, 0);
#pragma unroll
          for (int r = 0; r < 4; ++r) { if (kind == 0) gst<u16>(b_y, off_y0 + (unsigned)(r * ystep) + nt * 32, f2bf(y[r])); }
        }
#pragma unroll
        for (int mt = 0; mt < 4; ++mt) {
          const bf16x8 bkf = *(const bf16x8*)(bkt + (mt * 16 + c16) * 40 + q * 8);
          const float4 pq = *(const float4*)(p15l + mt * 16 + q * 4);
#pragma unroll
          for (int nt = 0; nt < 4; ++nt) {
            f32x4 t = __builtin_amdgcn_mfma_f32_16x16x32_bf16(bkf, uvf[nt], Tl[(mt * 4 + nt) * 64 + lane], 0, 0, 0);
            t[0] *= pq.x; t[1] *= pq.y; t[2] *= pq.z; t[3] *= pq.w;
            Tl[(mt * 4 + nt) * 64 + lane] = t;
          }
        }
      }
      lds_wait();
    }
    if (pass == 0) {
      float* dst = s.tbuf + ((size_t)cs * 2 + (kind - 1)) * 4096;
#pragma unroll
      for (int m = 0; m < 16; ++m) *(f32x4*)(dst + (m * 64 + lane) * 4) = Tl[m * 64 + lane];
    }
  }
}

DEV void scan_combine_phase(const ScanP& s, char* lds_) {
  const int tid = ltid(), wid = __builtin_amdgcn_readfirstlane(tid >> 6), lane = tid & 63, c16 = lane & 15, q = lane >> 4;
  if (wid >= 2) return;
  float* til = (float*)(lds_ + wid * 16384);
  const int nchain = s.nseq * 64, nseg = s.nseg;
  for (int chain = wid * gridDim.x + blockIdx.x; chain < nchain; chain += 2 * gridDim.x) {
    f32x4 T[16];
#pragma unroll
    for (int m = 0; m < 16; ++m) T[m] = f32x4{0.f, 0.f, 0.f, 0.f};
    for (int seg = 0; seg < nseg; ++seg) {
      float* tn = s.tbuf + ((size_t)(chain * nseg + seg) * 2) * 4096; const float* ti = tn + 4096;
      lds_wait();
#pragma unroll
      for (int m = 0; m < 16; ++m) *(f32x4*)(til + (m * 64 + lane) * 4) = *(const f32x4*)(ti + (m * 64 + lane) * 4);
      lds_wait();
      f32x4 Tn[16];
#pragma unroll
      for (int m = 0; m < 16; ++m) Tn[m] = *(const f32x4*)(tn + (m * 64 + lane) * 4);
#pragma unroll
      for (int nt = 0; nt < 4; ++nt) {
        bf16x8 bh[2], bl[2];
#pragma unroll
        for (int ks = 0; ks < 2; ++ks) {
          const f32x4 ta = T[(2 * ks) * 4 + nt], tb = T[(2 * ks + 1) * 4 + nt];
          const float x[8] = {ta[0], ta[1], ta[2], ta[3], tb[0], tb[1], tb[2], tb[3]};
          float hf[8], lf[8];
#pragma unroll
          for (int e = 0; e < 8; ++e) { hf[e] = bf2f(f2bf(x[e])); lf[e] = x[e] - hf[e]; }
          bh[ks] = pack8(hf[0], hf[1], hf[2], hf[3], hf[4], hf[5], hf[6], hf[7]);
          bl[ks] = pack8(lf[0], lf[1], lf[2], lf[3], lf[4], lf[5], lf[6], lf[7]);
        }
#pragma unroll
        for (int mt = 0; mt < 4; ++mt) {
          f32x4 acc = Tn[mt * 4 + nt];
#pragma unroll
          for (int ks = 0; ks < 2; ++ks) {
            float x[8];
#pragma unroll
            for (int e = 0; e < 8; ++e) x[e] = til[((mt * 4 + 2 * ks + (e >> 2)) * 64 + ((c16 >> 2) & 3) * 16 + 4 * q + (e & 3)) * 4 + (c16 & 3)];
            float hf[8], lf[8];
#pragma unroll
            for (int e = 0; e < 8; ++e) { hf[e] = bf2f(f2bf(x[e])); lf[e] = x[e] - hf[e]; }
            const bf16x8 ah = pack8(hf[0], hf[1], hf[2], hf[3], hf[4], hf[5], hf[6], hf[7]);
            const bf16x8 al = pack8(lf[0], lf[1], lf[2], lf[3], lf[4], lf[5], lf[6], lf[7]);
            acc = __builtin_amdgcn_mfma_f32_16x16x32_bf16(ah, bh[ks], acc, 0, 0, 0);
            acc = __builtin_amdgcn_mfma_f32_16x16x32_bf16(ah, bl[ks], acc, 0, 0, 0);
            acc = __builtin_amdgcn_mfma_f32_16x16x32_bf16(al, bh[ks], acc, 0, 0, 0);
          }
          Tn[mt * 4 + nt] = acc;
        }
      }
#pragma unroll
      for (int m = 0; m < 16; ++m) { *(f32x4*)(tn + (m * 64 + lane) * 4) = T[m]; T[m] = Tn[m]; }
    }
  }
}

DEV void post_phase(u16* __restrict__ yf, const u16* __restrict__ yb, const u16* __restrict__ v, const u16* __restrict__ sg,
                    const float* __restrict__ bonus, const float* __restrict__ lg, const float* __restrict__ lb) {
  const int tid_ = ltid(); const int lane = tid_ & 63, wid = __builtin_amdgcn_readfirstlane(tid_ >> 6);
  for (int tok = blockIdx.x * 8 + wid; tok < GT; tok += gridDim.x * 8) {
#pragma unroll
    for (int it = 0; it < 4; ++it) {
      const int ch0 = it * 512 + lane * 8, h = ch0 >> 6; const size_t i = (size_t)tok * EI + ch0;
      const u32x4 a = *(const u32x4*)(yf + i), bq = *(const u32x4*)(yb + i), vv = *(const u32x4*)(v + i), gg = *(const u32x4*)(sg + i);
      const float2 bo = *(const float2*)(bonus + ((size_t)tok * 32 + h) * 2);
      float y[8]; float sum = 0.f;
#pragma unroll
      for (int e = 0; e < 4; ++e) { y[2 * e] = bflo(a[e]) + bflo(bq[e]); y[2 * e + 1] = bfhi(a[e]) + bfhi(bq[e]); sum += y[2 * e] + y[2 * e + 1]; }
      sum += __shfl_xor(sum, 1, 64); sum += __shfl_xor(sum, 2, 64); sum += __shfl_xor(sum, 4, 64);
      const float mean = sum * (1.f / 64.f);
      float var = 0.f;
#pragma unroll
      for (int e = 0; e < 8; ++e) { y[e] -= mean; var += y[e] * y[e]; }
      var += __shfl_xor(var, 1, 64); var += __shfl_xor(var, 2, 64); var += __shfl_xor(var, 4, 64);
      const float rs = rsqrtf(var * (1.f / 64.f) + 64e-5f), bon = bo.x + bo.y;
      const float4 g0 = *(const float4*)(lg + ch0), g1 = *(const float4*)(lg + ch0 + 4), b0 = *(const float4*)(lb + ch0), b1 = *(const float4*)(lb + ch0 + 4);
      const float ga[8] = {g0.x, g0.y, g0.z, g0.w, g1.x, g1.y, g1.z, g1.w}, ba[8] = {b0.x, b0.y, b0.z, b0.w, b1.x, b1.y, b1.z, b1.w};
      u32x4 o;
#pragma unroll
      for (int e = 0; e < 4; ++e) {
        const float o0 = (y[2 * e] * rs * ga[2 * e] + ba[2 * e] + bon * bflo(vv[e])) * bflo(gg[e]);
        const float o1 = (y[2 * e + 1] * rs * ga[2 * e + 1] + ba[2 * e + 1] + bon * bfhi(vv[e])) * bfhi(gg[e]);
        o[e] = cvtpk(o0, o1);
      }
      *(u32x4*)(yf + i) = o;
    }
  }
}

DEV void mla_mid_phase(const float* __restrict__ cqkv, const float* __restrict__ qn, const float* __restrict__ kvn,
                       const float* __restrict__ ct, const float* __restrict__ st,
                       u16* __restrict__ cqn, u16* __restrict__ ckvn, u16* __restrict__ kpe, int T) {
  const int tid_ = ltid(); const int lane = tid_ & 63, wid = __builtin_amdgcn_readfirstlane(tid_ >> 6);
  for (int tok = blockIdx.x * 8 + wid; tok < GT; tok += gridDim.x * 8) {
    const float* row = cqkv + (size_t)tok * 704;
    float q[6], ss = 0.f;
#pragma unroll
    for (int i = 0; i < 6; ++i) { q[i] = row[lane + i * 64]; ss += q[i] * q[i]; }
    ss = wsum(ss); float sc = rsqrtf(ss * (1.f / 384.f) + 1e-6f);
#pragma unroll
    for (int i = 0; i < 6; ++i) cqn[(size_t)tok * 384 + lane + i * 64] = f2bf(q[i] * sc * qn[lane + i * 64]);
    float c[4]; ss = 0.f;
#pragma unroll
    for (int i = 0; i < 4; ++i) { c[i] = row[384 + lane + i * 64]; ss += c[i] * c[i]; }
    ss = wsum(ss); sc = rsqrtf(ss * (1.f / 256.f) + 1e-6f);
#pragma unroll
    for (int i = 0; i < 4; ++i) ckvn[(size_t)tok * 256 + lane + i * 64] = f2bf(c[i] * sc * kvn[lane + i * 64]);
    const float x = row[640 + lane];
    const float xo = __shfl_xor(x, 32, 64);
    const int pos = tok % T, j = lane & 31;
    const float cs = ct[pos * 32 + j], sn = st[pos * 32 + j];
    const float o = lane < 32 ? x * cs - xo * sn : x * cs + xo * sn;
    kpe[(size_t)tok * 64 + lane] = f2bf(o);
  }
}

constexpr int SHM_V = 16384, SHM_K = 16384, SHM_KP = 8192;
#define KSWZ(row, colB) ((row) * 256 + ((colB) ^ (((row) & 7) << 4)))
#define KPSWZ(row, colB) ((row) * 128 + ((colB) ^ (((row) & 7) << 4)))
constexpr float ATT_SCALE = 0.07216878364870322f;
DEV void partialSM(f32x16& p0, f32x16& p1, float& m_reg, float& mn, float& alpha) {
  constexpr float C = ATT_SCALE * 1.4426950408889634f;
  float pmax = p0[0];
#pragma unroll
  for (int r = 1; r < 16; ++r) pmax = fmaxf(pmax, p0[r]);
#pragma unroll
  for (int r = 0; r < 16; ++r) pmax = fmaxf(pmax, p1[r]);
  { auto rr = __builtin_amdgcn_permlane32_swap(__float_as_uint(pmax), __float_as_uint(pmax), false, false);
    pmax = fmaxf(__uint_as_float(rr[0]), __uint_as_float(rr[1])); }
  mn = fmaxf(m_reg, pmax); alpha = __builtin_amdgcn_exp2f((m_reg - mn) * C); m_reg = mn;
  const float mnC = -mn * C;
#pragma unroll
  for (int r = 0; r < 16; ++r) p0[r] = __builtin_amdgcn_exp2f(fmaf(p0[r], C, mnC));
#pragma unroll
  for (int r = 0; r < 16; ++r) p1[r] = __builtin_amdgcn_exp2f(fmaf(p1[r], C, mnC));
}
DEV void finishSM(f32x16& p0, f32x16& p1, float alpha, float& l_reg, bf16x8& pa0, bf16x8& pa1, bf16x8& pa2, bf16x8& pa3) {
  float ps = 0;
#pragma unroll
  for (int r = 0; r < 16; ++r) ps += p0[r];
#pragma unroll
  for (int r = 0; r < 16; ++r) ps += p1[r];
  { auto rr = __builtin_amdgcn_permlane32_swap(__float_as_uint(ps), __float_as_uint(ps), false, false);
    ps = __uint_as_float(rr[0]) + __uint_as_float(rr[1]); }
  l_reg = l_reg * alpha + ps;
#define PK4(PP, BASE, OUT) do { unsigned a0 = cvtpk(PP[BASE + 0], PP[BASE + 1]), a1 = cvtpk(PP[BASE + 2], PP[BASE + 3]);   \
    unsigned b0 = cvtpk(PP[BASE + 4], PP[BASE + 5]), b1 = cvtpk(PP[BASE + 6], PP[BASE + 7]);                              \
    auto r0 = __builtin_amdgcn_permlane32_swap(a0, b0, false, false); auto r1 = __builtin_amdgcn_permlane32_swap(a1, b1, false, false); \
    u32x4 w = {r0[0], r1[0], r0[1], r1[1]}; OUT = *reinterpret_cast<bf16x8*>(&w); } while (0)
  PK4(p0, 0, pa0); PK4(p0, 8, pa1); PK4(p1, 0, pa2); PK4(p1, 8, pa3);
#undef PK4
}
DEV int v_st(int k, int c) { const int kk = (k & ~0xC) | ((k & 4) << 1) | ((k & 8) >> 1); return ((kk >> 3) * 4 + (c >> 5)) * 512 + ((kk & 7) * 32 + (c & 31)) * 2; }
DEV int v_rd_base(int lane) { return ((lane & 3) << 3) | (((lane >> 2) & 3) << 6) | (((lane >> 4) & 1) << 5) | (((lane >> 5) & 1) << 8); }
constexpr int v_rd_off(int d0, int ks, int half) { return d0 * 512 + ks * 4096 + half * 2048; }
template <int OFF> DEV s16x4 tr_read(int vb) {
  s16x4 r; asm volatile("ds_read_b64_tr_b16 %0, %1 offset:%2" : "=&v"(r) : "v"(vb), "i"(OFF) : "memory"); return r;
}
template <int D0> DEV void pv_one(f32x16& od, int vb, bf16x8 pa0, bf16x8 pa1, bf16x8 pa2, bf16x8 pa3) {
  const s16x4 l0 = tr_read<v_rd_off(D0, 0, 0)>(vb), h0 = tr_read<v_rd_off(D0, 0, 1)>(vb), l1 = tr_read<v_rd_off(D0, 1, 0)>(vb), h1 = tr_read<v_rd_off(D0, 1, 1)>(vb);
  const s16x4 l2 = tr_read<v_rd_off(D0, 2, 0)>(vb), h2 = tr_read<v_rd_off(D0, 2, 1)>(vb), l3 = tr_read<v_rd_off(D0, 3, 0)>(vb), h3 = tr_read<v_rd_off(D0, 3, 1)>(vb);
  asm volatile("s_waitcnt lgkmcnt(0)" ::: "memory"); SBAR();
#define PK(L, H) (bf16x8){L[0], L[1], L[2], L[3], H[0], H[1], H[2], H[3]}
  od = __builtin_amdgcn_mfma_f32_32x32x16_bf16(pa0, PK(l0, h0), od, 0, 0, 0);
  od = __builtin_amdgcn_mfma_f32_32x32x16_bf16(pa1, PK(l1, h1), od, 0, 0, 0);
  od = __builtin_amdgcn_mfma_f32_32x32x16_bf16(pa2, PK(l2, h2), od, 0, 0, 0);
  od = __builtin_amdgcn_mfma_f32_32x32x16_bf16(pa3, PK(l3, h3), od, 0, 0, 0);
#undef PK
}

struct AttnP { const u16* q; const u16* kv; const u16* kpe; u16* sg; const float* ct; const float* st; int nseq, T; int dry; };
DEV void attn_phase(const AttnP& a, char* lds) {
  const int tid = ltid(), wid = tid >> 6, lane = tid & 63, r32 = lane & 31, hi = lane >> 5;
  char* V_lds = lds; char* K_lds = lds + 3 * SHM_V; char* KP_lds = lds + 3 * SHM_V + 2 * SHM_K;
  float* wsc = (float*)(lds + 3 * SHM_V + 2 * SHM_K + 2 * SHM_KP) + wid * 64; float* li_l = wsc; float* al_l = wsc + 32;
  const int nqb = a.T / 256, nitems = a.nseq * 16 * nqb, NT = a.T / 64;
  const int sr = tid >> 4, sc = (tid & 15) * 8, vst0 = v_st(sr, sc), vst1 = v_st(32 + sr, sc);
  const int pr = tid >> 3, pc = (tid & 7) * 8;
  const int vb0 = (int)(uintptr_t)V_lds + v_rd_base(lane);
  int kad[4], kpd[4];
#pragma unroll
  for (int q = 0; q < 4; ++q) { kad[q] = KSWZ(r32, q * 32 + hi * 16); kpd[q] = KPSWZ(r32, q * 32 + hi * 16); }
  for (int it = blockIdx.x; it < nitems; it += gridDim.x) {
    const int qb = it % nqb, h = (it / nqb) & 15, b = it / (nqb * 16);
    const size_t sbase = (size_t)b * a.T;
    const int pos = qb * 256 + wid * 32 + r32;
    bf16x8 qr[12];
    {
      const u16* Qw = a.q + (sbase + pos) * 3072 + h * 192 + hi * 8;
#pragma unroll
      for (int d0 = 0; d0 < 12; ++d0) qr[d0] = *(const bf16x8*)(Qw + d0 * 16);
#pragma unroll
      for (int dd = 0; dd < 2; ++dd) {
        const int j0 = dd * 16 + hi * 8;
        const float4 c0 = *(const float4*)(a.ct + pos * 32 + j0), c1 = *(const float4*)(a.ct + pos * 32 + j0 + 4);
        const float4 s0 = *(const float4*)(a.st + pos * 32 + j0), s1 = *(const float4*)(a.st + pos * 32 + j0 + 4);
        const float cs[8] = {c0.x, c0.y, c0.z, c0.w, c1.x, c1.y, c1.z, c1.w};
        const float sn[8] = {s0.x, s0.y, s0.z, s0.w, s1.x, s1.y, s1.z, s1.w};
        u32x4 x1 = *(u32x4*)&qr[8 + dd], x2 = *(u32x4*)&qr[10 + dd], y1, y2;
#pragma unroll
        for (int e = 0; e < 4; ++e) {
          const float a0 = bflo(x1[e]), a1 = bfhi(x1[e]), b0 = bflo(x2[e]), b1 = bfhi(x2[e]);
          y1[e] = cvtpk(a0 * cs[2 * e] - b0 * sn[2 * e], a1 * cs[2 * e + 1] - b1 * sn[2 * e + 1]);
          y2[e] = cvtpk(b0 * cs[2 * e] + a0 * sn[2 * e], b1 * cs[2 * e + 1] + a1 * sn[2 * e + 1]);
        }
        qr[8 + dd] = *(bf16x8*)&y1; qr[10 + dd] = *(bf16x8*)&y2;
      }
    }
    float m_reg = -1e30f, l_reg = 0.f; f32x16 o[4] = {};
    bf16x8 vs0, vs1, ks0, ks1, kp0;
    const u16* kvh = a.kv + sbase * 4096 + h * 256;
    const u16* kph = a.kpe + sbase * 64;
    const unsigned voff = (unsigned)(sr * 8192 + sc * 2), poff = (unsigned)(pr * 128 + pc * 2);
#define SLOAD(k0) do { const char* bK0 = (const char*)kvh + (size_t)(k0) * 8192; const char* bK1 = bK0 + 32 * 8192; const char* bP = (const char*)kph + (size_t)(k0) * 128; \
    vs0 = *(const bf16x8*)(bK0 + voff + 256); vs1 = *(const bf16x8*)(bK1 + voff + 256); \
    ks0 = *(const bf16x8*)(bK0 + voff); ks1 = *(const bf16x8*)(bK1 + voff); \
    kp0 = *(const bf16x8*)(bP + poff); } while (0)
#define SWRITE(bb, vbuf) do { *(bf16x8*)(V_lds + (vbuf) * SHM_V + vst0) = vs0; *(bf16x8*)(V_lds + (vbuf) * SHM_V + vst1) = vs1; \
    *(bf16x8*)(K_lds + (bb) * SHM_K + KSWZ(sr, sc * 2)) = ks0; *(bf16x8*)(K_lds + (bb) * SHM_K + KSWZ(32 + sr, sc * 2)) = ks1; \
    *(bf16x8*)(KP_lds + (bb) * SHM_KP + KPSWZ(pr, pc * 2)) = kp0; } while (0)
    __syncthreads();
    SLOAD(0); SWRITE(0, 0); __syncthreads();
    const bool grpB = wid >= 4;
    bf16x8 pa0, pa1, pa2, pa3;
    int vcur = 0, vprev = 2;
#define PV_ALL(vbuf) do { const int vb_ = vb0 + (vbuf) * SHM_V; \
      pv_one<0>(o[0], vb_, pa0, pa1, pa2, pa3); pv_one<1>(o[1], vb_, pa0, pa1, pa2, pa3); \
      pv_one<2>(o[2], vb_, pa0, pa1, pa2, pa3); pv_one<3>(o[3], vb_, pa0, pa1, pa2, pa3); } while (0)
    for (int j = 0; j < NT; ++j) {
      const int bb = j & 1;
      if (j + 1 < NT) SLOAD((j + 1) * 64);
      SBAR();
      if (grpB && j > 0) PV_ALL(vprev);
      f32x16 p0 = {}, p1 = {};
      {
        const char* Ks = K_lds + bb * SHM_K; const char* Kp = KP_lds + bb * SHM_KP;
#pragma unroll
        for (int d0 = 0; d0 < 8; ++d0) {
          const bf16x8 b0 = *(const bf16x8*)(Ks + kad[d0 & 3] + (d0 >> 2) * 128), b1 = *(const bf16x8*)(Ks + kad[d0 & 3] + (d0 >> 2) * 128 + 8192);
          p0 = __builtin_amdgcn_mfma_f32_32x32x16_bf16(b0, qr[d0], p0, 0, 0, 0);
          p1 = __builtin_amdgcn_mfma_f32_32x32x16_bf16(b1, qr[d0], p1, 0, 0, 0); }
#pragma unroll
        for (int d0 = 0; d0 < 4; ++d0) {
          const bf16x8 b0 = *(const bf16x8*)(Kp + kpd[d0]), b1 = *(const bf16x8*)(Kp + kpd[d0] + 4096);
          p0 = __builtin_amdgcn_mfma_f32_32x32x16_bf16(b0, qr[8 + d0], p0, 0, 0, 0);
          p1 = __builtin_amdgcn_mfma_f32_32x32x16_bf16(b1, qr[8 + d0], p1, 0, 0, 0); }
      }
      float mn, alpha;
      partialSM(p0, p1, m_reg, mn, alpha);
      if (__any(alpha < 1.f)) {
        if (hi == 0) al_l[r32] = alpha;
        lds_wait();
#pragma unroll
        for (int dd = 0; dd < 4; ++dd)
#pragma unroll
          for (int r = 0; r < 16; ++r) o[dd][r] *= al_l[crow(r, hi)];
      }
      finishSM(p0, p1, alpha, l_reg, pa0, pa1, pa2, pa3); SBAR();
      if (!grpB) PV_ALL(vcur);
      const int vnext = vcur == 2 ? 0 : vcur + 1;
      if (j + 1 < NT) SWRITE(bb ^ 1, vnext);
      vprev = vcur; vcur = vnext;
      __syncthreads();
    }
    if (grpB) PV_ALL(vprev);
#undef PV_ALL
#undef SLOAD
#undef SWRITE
    {
      int t2 = threadIdx.x; asm volatile("" : "+v"(t2));
      const int wid2 = t2 >> 6, r2 = t2 & 31, hi2 = (t2 >> 5) & 1;
      float* li2 = (float*)(lds + 3 * SHM_V + 2 * SHM_K + 2 * SHM_KP) + wid2 * 64;
      if (hi2 == 0) li2[r2] = l_reg;
      lds_wait();
      u16* Ow = a.sg + (sbase + qb * 256 + wid2 * 32) * EI + h * 128 + r2;
#pragma unroll
      for (int r = 0; r < 16; ++r) {
        const int orow = crow(r, hi2);
        const float rl = __builtin_amdgcn_rcpf(li2[orow]);
#pragma unroll
        for (int d0 = 0; d0 < 4; ++d0) {
          u16* pp = Ow + (size_t)orow * EI + d0 * 32;
          if (!a.dry) *pp = f2bf(o[d0][r] * rl * bf2f(*pp));
        }
      }
    }
  }
}

#if MEGA
#define GRID_SYNC() gsync(p, lds)
#else
#define GRID_SYNC() do {} while (0)
#endif
struct Grp { const float* xin0; float* xres; int nseq, T; };
DEV Grp get_group(const P& p, int g) {
  Grp r;
  r.xin0 = g == 0 ? p.x_prompt : p.x_sample + (size_t)(g - 1) * GT * DM;
  r.xres = p.out + (size_t)g * GT * DM;
  r.nseq = g == 0 ? 8 : 1; r.T = g == 0 ? 2048 : 16384;
  return r;
}
template <int LT, int ph>
DEV void run_phase(const P& p, int g, int layer, char* lds) {
  const Grp G = get_group(p, g);
  const int j = layer >> 1;
  const float* xin = layer == 0 ? G.xin0 : G.xres;
  size_t zoff = 0; asm volatile("" : "+s"(zoff));
  char* ws = p.ws + zoff;
  u16* hbuf = (u16*)(ws + O_HBUF);
  u16* sg = (u16*)(ws + O_SG);
  if constexpr (LT == 0) {
    u16 *rb = (u16*)(ws + O_RB), *kb = (u16*)(ws + O_KB), *vb = (u16*)(ws + O_VB), *yf = (u16*)(ws + O_YF), *yb = (u16*)(ws + O_YB);
    u16 *twl = (u16*)(ws + O_TWL), *al = (u16*)(ws + O_AL); float* bon = (float*)(ws + O_BON);
    if constexpr (ph == 0) rms_phase(xin, p.ln_g + layer * DM, hbuf);
    else if constexpr (ph == 1) {
      GemmP q{}; q.A = hbuf; q.lda = DM; q.Bt = (const u16*)(ws + O_WRWIN) + (size_t)j * RW_N * DM; q.K = DM; q.NT = 66;
      q.mu = p.rw_mu + (size_t)j * 6 * DM; q.T = G.T; q.o0 = rb; q.o1 = kb; q.o2 = vb; q.o3 = sg; q.o4 = twl; q.o5 = al;
      lerp_phase(hbuf, q.mu, yf, G.T); GRID_SYNC();
      GemmP w = q; w.A = yf; w.astride = (size_t)GT * DM; w.NT = 32; w.nt0 = 0;
      gemm_phase<LOAD_PLAIN, EPI_RWKV, 4>(w, lds);
      q.NT = 2; q.nt0 = 64;
      gemm_phase<LOAD_LERP, EPI_RWKV, 2>(q, lds);
    } else if constexpr (ph == 2) {
      ScanP s{}; s.r = rb; s.k = kb; s.v = vb; s.twl = twl; s.al = al; s.yf = yf; s.yb = yb; s.bonus = bon;
      s.w0 = p.rw_w0 + (size_t)j * 2 * EI; s.w2 = p.rw_w2 + (size_t)j * 2 * 64 * EI; s.a0 = p.rw_a0 + (size_t)j * 2 * EI; s.a2 = p.rw_a2 + (size_t)j * 2 * 64 * EI;
      s.kk = p.rw_kk + (size_t)j * EI; s.ka = p.rw_ka + (size_t)j * EI; s.rk = p.rw_rk + (size_t)j * EI; s.nseq = G.nseq; s.T = G.T;
      s.tbuf = (float*)hbuf;
      if (G.T > 2048) {
        s.nseg = 16;
        scan_phase(s, lds, 0); GRID_SYNC();
        scan_combine_phase(s, lds); GRID_SYNC();
        scan_phase(s, lds, 1);
      } else { s.nseg = 1; scan_phase(s, lds, 1); }
    } else if constexpr (ph == 3) post_phase(yf, yb, vb, sg, bon, p.rw_lnx_g + (size_t)j * EI, p.rw_lnx_b + (size_t)j * EI);
    else {
      GemmP q{}; q.A = yf; q.lda = EI; q.Bt = (const u16*)(ws + O_WRWOUT) + (size_t)j * DM * EI; q.K = EI; q.NT = 4; q.xin = xin; q.xout = G.xres;
      for (int rep = 1; rep < REP_GEMM; ++rep) { q.dry = (gridDim.x != 12345); gemm_phase<LOAD_PLAIN, EPI_RES, 4>(q, lds); } q.dry = 0;
      gemm_phase<LOAD_PLAIN, EPI_RES, 4>(q, lds);
    }
  } else {
    float* cqkv = (float*)(ws + O_CQKV); u16 *cqn = (u16*)(ws + O_CQN), *ckvn = (u16*)(ws + O_CKVN), *kpe = (u16*)(ws + O_KPE), *qq = (u16*)(ws + O_Q), *kv = (u16*)(ws + O_KV);
    const float* ct = (const float*)(ws + O_COS); const float* st = (const float*)(ws + O_SIN);
    if constexpr (ph == 0) rms_phase(xin, p.ln_g + layer * DM, hbuf);
    else if constexpr (ph == 1) {
      GemmP q{}; q.A = hbuf; q.lda = DM; q.Bt = (const u16*)(ws + O_WMLIN) + (size_t)j * ML_NP * DM; q.K = DM; q.NT = 11; q.of = cqkv; q.o0 = sg;
      for (int rep = 1; rep < REP_GEMM; ++rep) { q.dry = (gridDim.x != 12345); gemm_phase<LOAD_PLAIN, EPI_MLAIN, 4>(q, lds); } q.dry = 0;
      gemm_phase<LOAD_PLAIN, EPI_MLAIN, 4>(q, lds);
    } else if constexpr (ph == 2) mla_mid_phase(cqkv, p.ml_qn + j * 384, p.ml_kvn + j * 256, ct, st, cqn, ckvn, kpe, G.T);
    else if constexpr (ph == 3) {
      GemmP q{}; q.A = cqn; q.lda = 384; q.Bt = (const u16*)(ws + O_WUQ) + (size_t)j * 3072 * 384; q.K = 384; q.NT = 12; q.o0 = qq; q.ldc = 3072;
      for (int rep = 1; rep < REP_GEMM; ++rep) { q.dry = (gridDim.x != 12345); gemm_phase<LOAD_PLAIN, EPI_BF16, 4>(q, lds); } q.dry = 0;
      gemm_phase<LOAD_PLAIN, EPI_BF16, 4>(q, lds);
      GemmP r{}; r.A = ckvn; r.lda = 256; r.Bt = (const u16*)(ws + O_WUKV) + (size_t)j * 4096 * 256; r.K = 256; r.NT = 16; r.o0 = kv; r.ldc = 4096;
      for (int rep = 1; rep < REP_GEMM; ++rep) { r.dry = (gridDim.x != 12345); gemm_phase<LOAD_PLAIN, EPI_BF16, 4>(r, lds); } r.dry = 0;
      gemm_phase<LOAD_PLAIN, EPI_BF16, 4>(r, lds);
    } else if constexpr (ph == 4) {
      AttnP a{}; a.q = qq; a.kv = kv; a.kpe = kpe; a.sg = sg; a.ct = ct; a.st = st; a.nseq = G.nseq; a.T = G.T;
      for (int rep = 1; rep < REP_ATTN; ++rep) { a.dry = (gridDim.x != 12345); attn_phase(a, lds); } a.dry = 0;
      attn_phase(a, lds);
    } else {
      GemmP q{}; q.A = sg; q.lda = EI; q.Bt = (const u16*)(ws + O_WMLOUT) + (size_t)j * DM * EI; q.K = EI; q.NT = 4; q.xin = xin; q.xout = G.xres;
      for (int rep = 1; rep < REP_GEMM; ++rep) { q.dry = (gridDim.x != 12345); gemm_phase<LOAD_PLAIN, EPI_RES, 4>(q, lds); } q.dry = 0;
      gemm_phase<LOAD_PLAIN, EPI_RES, 4>(q, lds);
    }
  }
}


template <int LT, int PH>
__global__ __launch_bounds__(512) void k_phase(P p, int g, int layer) {
  extern __shared__ __attribute__((aligned(16))) char lds[];
  if constexpr (LT == 2) { if constexpr (PH == 0) init_phase(p, lds); else final_phase(p.out, p.final_g); }
  else run_phase<LT, PH>(p, g, layer, lds);
}

#if MEGA
__global__ __launch_bounds__(512) void k_mega(P p) {
  extern __shared__ __attribute__((aligned(16))) char lds[];
  cg::grid_group grid = cg::this_grid();
  {
    unsigned* bar = (unsigned*)(p.ws + O_BAR);
    if (blockIdx.x == 0) for (int i = threadIdx.x; i < XCD_BAR_WORDS; i += 512) bar[i] = 0u;
    if (threadIdx.x == 0) { volatile LAS unsigned* st = (volatile LAS unsigned*)(lds + SHM_BYTES - 16); st[0] = 0u; st[1] = 0u; }
  }
  init_phase(p, lds);
  grid.sync();
  if (threadIdx.x == 0) (void)xb_add(&((unsigned*)(p.ws + O_BAR))[XB_XCNT(xb_xcc_id())], 1u);
  for (int g = 0; g < 3; ++g)
    for (int layer = 0; layer < 4; ++layer) {
      if ((layer & 1) == 0) {
        run_phase<0, 0>(p, g, layer, lds); gsync(p, lds); run_phase<0, 1>(p, g, layer, lds); gsync(p, lds); run_phase<0, 2>(p, g, layer, lds); gsync(p, lds);
        run_phase<0, 3>(p, g, layer, lds); gsync(p, lds); run_phase<0, 4>(p, g, layer, lds); gsync(p, lds);
      } else {
        run_phase<1, 0>(p, g, layer, lds); gsync(p, lds); run_phase<1, 1>(p, g, layer, lds); gsync(p, lds); run_phase<1, 2>(p, g, layer, lds); gsync(p, lds);
        run_phase<1, 3>(p, g, layer, lds); gsync(p, lds); run_phase<1, 4>(p, g, layer, lds); gsync(p, lds); run_phase<1, 5>(p, g, layer, lds); gsync(p, lds);
      }
    }
  final_phase(p.out, p.final_g);
}
#endif

extern "C" void kernel_launch(void* const* d_in, const int* in_sizes, int n_in, void* d_out, int out_size, void* d_ws, size_t ws_size, hipStream_t stream) {
  if (n_in != 22 || ws_size < WS_NEED) { fprintf(stderr, "kernel_launch: bad args n_in %d ws %zu need %zu\n", n_in, ws_size, WS_NEED); return; }
  P p{};
  const float** f = (const float**)&p;
  for (int i = 0; i < 22; ++i) f[i] = (const float*)d_in[i];
  p.out = (float*)d_out; p.ws = (char*)d_ws;
#if MEGA
  static int grid_blocks = 0;
  if (!grid_blocks) {
    hipFuncSetAttribute((const void*)k_mega, hipFuncAttributeMaxDynamicSharedMemorySize, SHM_BYTES);
    int dev = 0, cus = 0, per_cu = 0;
    hipGetDevice(&dev);
    hipDeviceGetAttribute(&cus, hipDeviceAttributeMultiprocessorCount, dev);
    hipOccupancyMaxActiveBlocksPerMultiprocessor(&per_cu, k_mega, 512, SHM_BYTES);
    if (per_cu > 1) per_cu = 1;
    grid_blocks = cus * per_cu;
  }
  void* args[] = {&p};
  hipError_t e = hipLaunchCooperativeKernel((void*)k_mega, dim3(grid_blocks), dim3(512), args, SHM_BYTES, stream);
  if (e != hipSuccess) fprintf(stderr, "cooperative launch failed: %s (grid %d)\n", hipGetErrorString(e), grid_blocks);
#else
  const int NB = 256;
#define LAUNCH(LT, PH, g, layer) do { static int inited = 0; if (!inited) { hipFuncSetAttribute((const void*)k_phase<LT, PH>, hipFuncAttributeMaxDynamicSharedMemorySize, SHM_BYTES); inited = 1; } \
    hipLaunchKernelGGL((k_phase<LT, PH>), dim3(NB), dim3(512), SHM_BYTES, stream, p, g, layer); } while (0)
  LAUNCH(2, 0, 0, 0);
  for (int g = 0; g < 3; ++g)
    for (int layer = 0; layer < 4; ++layer) {
      if ((layer & 1) == 0) { LAUNCH(0, 0, g, layer); LAUNCH(0, 1, g, layer); LAUNCH(0, 2, g, layer); LAUNCH(0, 3, g, layer); LAUNCH(0, 4, g, layer); }
      else { LAUNCH(1, 0, g, layer); LAUNCH(1, 1, g, layer); LAUNCH(1, 2, g, layer); LAUNCH(1, 3, g, layer); LAUNCH(1, 4, g, layer); LAUNCH(1, 5, g, layer); }
    }
  LAUNCH(2, 1, 0, 0);
#endif
}
```

```cpp
#include <hip/hip_runtime.h>
#include <hip/hip_bf16.h>
#include <hip/hip_cooperative_groups.h>
#include <cstdio>
namespace cg = cooperative_groups;

#ifndef REP_GEMM
#define REP_GEMM 1
#endif
#ifndef REP_ATTN
#define REP_ATTN 1
#endif
#ifndef REP_SCAN
#define REP_SCAN 1
#endif
#ifndef MEGA
#define MEGA 1
#endif

typedef unsigned short u16;
using bf16x8 = __attribute__((ext_vector_type(8))) short;
using s16x4  = __attribute__((ext_vector_type(4))) short;
using f32x16 = __attribute__((ext_vector_type(16))) float;
using f32x4  = __attribute__((ext_vector_type(4))) float;
using u32x4  = __attribute__((ext_vector_type(4))) unsigned;
using u32x2  = __attribute__((ext_vector_type(2))) unsigned;
#define DEV __device__ __forceinline__
#define SBAR() __builtin_amdgcn_sched_barrier(0)

constexpr int DM = 1024, EI = 2048, GT = 16384;
constexpr int NTOK = 49152;
constexpr int RW_N = 8448, ML_N = 2752, ML_NP = 2816;
constexpr int SHM_BYTES = 158720;

constexpr size_t alup(size_t x) { return (x + 255) / 256 * 256; }
constexpr size_t O_WRWIN  = 0;
constexpr size_t O_WRWOUT = O_WRWIN  + alup((size_t)2 * RW_N * DM * 2);
constexpr size_t O_WMLIN  = O_WRWOUT + alup((size_t)2 * DM * EI * 2);
constexpr size_t O_WUQ    = O_WMLIN  + alup((size_t)2 * ML_NP * DM * 2);
constexpr size_t O_WUKV   = O_WUQ    + alup((size_t)2 * 3072 * 384 * 2);
constexpr size_t O_WMLOUT = O_WUKV   + alup((size_t)2 * 4096 * 256 * 2);
constexpr size_t O_COS    = O_WMLOUT + alup((size_t)2 * DM * EI * 2);
constexpr size_t O_SIN    = O_COS    + alup((size_t)16384 * 32 * 4);
constexpr size_t O_HBUF   = O_SIN    + alup((size_t)16384 * 32 * 4);
constexpr size_t O_R0     = O_HBUF   + alup((size_t)GT * DM * 2);
constexpr size_t SZ_E = (size_t)GT * EI * 2;
constexpr size_t O_SG   = O_R0;
constexpr size_t O_RB   = O_SG + SZ_E;
constexpr size_t O_KB   = O_RB + SZ_E;
constexpr size_t O_VB   = O_KB + SZ_E;
constexpr size_t O_YF   = O_VB + SZ_E;
constexpr size_t O_YB   = O_YF + SZ_E;
constexpr size_t O_TWL  = O_YB + SZ_E;
constexpr size_t O_AL   = O_TWL + alup((size_t)GT * 128 * 2);
constexpr size_t O_BON  = O_AL  + alup((size_t)GT * 128 * 2);
constexpr size_t O_RW_END = O_BON + alup((size_t)GT * 64 * 4);
constexpr size_t O_CQKV = O_SG + SZ_E;
constexpr size_t O_CQN  = O_CQKV + alup((size_t)GT * 704 * 4);
constexpr size_t O_CKVN = O_CQN  + alup((size_t)GT * 384 * 2);
constexpr size_t O_KPE  = O_CKVN + alup((size_t)GT * 256 * 2);
constexpr size_t O_Q    = O_KPE  + alup((size_t)GT * 64 * 2);
constexpr size_t O_KV   = O_Q    + alup((size_t)GT * 3072 * 2);
constexpr size_t O_ML_END = O_KV + alup((size_t)GT * 4096 * 2);
constexpr size_t O_FLAG = O_RW_END > O_ML_END ? O_RW_END : O_ML_END;
constexpr size_t O_BAR = O_FLAG + 256;
constexpr size_t WS_NEED = O_BAR + 16384;

struct P {
  const float* x_prompt; const float* x_sample; const float* ln_g; const float* final_g;
  const float* rw_mu; const float* rw_in; const float* rw_w0; const float* rw_w2; const float* rw_a0; const float* rw_a2;
  const float* rw_kk; const float* rw_ka; const float* rw_rk; const float* rw_lnx_g; const float* rw_lnx_b; const float* rw_out;
  const float* ml_in; const float* ml_qn; const float* ml_kvn; const float* ml_uq; const float* ml_ukv; const float* ml_out;
  float* out; char* ws;
};

typedef __attribute__((ext_vector_type(2))) __bf16 bf16x2_t;
typedef __attribute__((ext_vector_type(2))) float f32x2_t;
DEV unsigned cvtpk(float lo, float hi) { f32x2_t v = {lo, hi}; bf16x2_t b = __builtin_convertvector(v, bf16x2_t); return __builtin_bit_cast(unsigned, b); }
DEV float bf2f(u16 x) { return __uint_as_float(((unsigned)x) << 16); }
DEV float bflo(unsigned x) { return __uint_as_float(x << 16); }
DEV float bfhi(unsigned x) { return __uint_as_float(x & 0xffff0000u); }
DEV u16 f2bf(float x) { __bf16 b = (__bf16)x; return __builtin_bit_cast(u16, b); }
DEV float wsum(float v) {
#pragma unroll
  for (int o = 32; o >= 1; o >>= 1) v += __shfl_xor(v, o, 64);
  return v;
}
DEV float siluf(float x) { return x / (1.f + __expf(-x)); }
DEV int crow(int r, int hi) { return (r & 3) + 8 * (r >> 2) + 4 * hi; }
DEV int ltid() { int t = threadIdx.x; asm volatile("" : "+v"(t)); return t; }
template <typename T> DEV T gld(size_t base, unsigned off) { return *(const __attribute__((address_space(1))) T*)(base + off); }
template <typename T> DEV void gst(size_t base, unsigned off, T v) { *(__attribute__((address_space(1))) T*)(base + off) = v; }
DEV void lds_wait() { asm volatile("s_waitcnt lgkmcnt(0)" ::: "memory"); }


#define XB_TMO      128
#define XB_XCNT(j)  (256  + 64 * (j))
#define XB_XSUB(j)  (1280 + 64 * (j))
#define XB_XGEN(j)  (2304 + 64 * (j))
#define XB_TOP      3328
#define XB_TOPGEN   3392
#define XCD_BAR_WORDS 3456
#define XB_SPIN_CAP (1u << 22)
#define LAS __attribute__((address_space(3)))
DEV unsigned xb_ld(unsigned* p)              { return __hip_atomic_load(p, __ATOMIC_RELAXED, __HIP_MEMORY_SCOPE_AGENT); }
DEV unsigned xb_add(unsigned* p, unsigned v) { return __hip_atomic_fetch_add(p, v, __ATOMIC_RELAXED, __HIP_MEMORY_SCOPE_AGENT); }
DEV unsigned xb_xcc_id() { return (unsigned)__builtin_amdgcn_s_getreg((3 << 11) | 20) & 0xFu; }
#define XB_SPIN(cond, bar) do { unsigned _sp = 0; while (cond) { __builtin_amdgcn_s_sleep(1); \
    if ((++_sp & 255u) == 0u) { if (xb_ld(&(bar)[XB_TMO])) break; if (_sp > XB_SPIN_CAP) { atomicAdd(&(bar)[XB_TMO], 1u); break; } } } } while (0)
struct XcdBarrier { unsigned* bar; unsigned x; volatile LAS unsigned* st; };
DEV void xcd_barrier_complete(unsigned* bar, unsigned x, unsigned& nloc, unsigned& nx) {
  const unsigned G = gridDim.x * gridDim.y * gridDim.z;
  unsigned sum, cnt, mine, sp = 0u;
  for (;;) {
    sum = 0u; cnt = 0u; mine = 0u;
#pragma unroll
    for (unsigned j = 0; j < 16; ++j) { const unsigned c = xb_ld(&bar[XB_XCNT(j)]); sum += c; cnt += (c > 0u) ? 1u : 0u; mine = (j == x) ? c : mine; }
    if (sum == G) break;
    __builtin_amdgcn_s_sleep(1);
    if ((++sp & 255u) == 0u) { if (xb_ld(&bar[XB_TMO])) break; if (sp > XB_SPIN_CAP) { atomicAdd(&bar[XB_TMO], 1u); break; } }
  }
  nloc = mine > 0u ? mine : 1u; nx = cnt > 0u ? cnt : 1u;
}
DEV void xcd_barrier(const XcdBarrier& b) {
  asm volatile("s_waitcnt vmcnt(0)" ::: "memory");
  __syncthreads();
  if (threadIdx.x == 0) {
    unsigned* bar = b.bar;
    __builtin_amdgcn_s_waitcnt(0);
    unsigned nloc = b.st[0], nx = b.st[1];
    if (nloc == 0u) { xcd_barrier_complete(bar, b.x, nloc, nx); b.st[0] = nloc; b.st[1] = nx; }
    const unsigned old = xb_add(&bar[XB_XSUB(b.x)], 1u);
    const unsigned gen = old / nloc;
    if (old + 1u == (gen + 1u) * nloc) {
      __builtin_amdgcn_fence(__ATOMIC_RELEASE, "agent");
      asm volatile("s_waitcnt vmcnt(0)" ::: "memory");
      const unsigned og = xb_add(&bar[XB_TOP], 1u);
      const unsigned tg = og / nx;
      if (og + 1u == (tg + 1u) * nx) xb_add(&bar[XB_TOPGEN], 1u);
      else XB_SPIN(xb_ld(&bar[XB_TOPGEN]) == tg, bar);
      __builtin_amdgcn_fence(__ATOMIC_ACQUIRE, "agent");
      xb_add(&bar[XB_XGEN(b.x)], 1u);
      asm volatile("s_waitcnt vmcnt(0)" ::: "memory");
    } else {
      XB_SPIN(xb_ld(&bar[XB_XGEN(b.x)]) == gen, bar);
      __builtin_amdgcn_fence(__ATOMIC_ACQUIRE, "agent");
      asm volatile("s_waitcnt vmcnt(0)" ::: "memory");
    }
  }
  __syncthreads();
}
DEV void gsync(const P& p, char* lds) {
  XcdBarrier b; b.bar = (unsigned*)(p.ws + O_BAR); b.x = xb_xcc_id(); b.st = (volatile LAS unsigned*)(lds + SHM_BYTES - 16);
  xcd_barrier(b);
}

DEV void convert_T(const float* __restrict__ src, u16* __restrict__ dst, int K, int N, int Npad, char* lds_) {
  float* lds = (float*)lds_;
  const int tid = ltid(), tk = K / 64, tn = Npad / 64;
  for (int t = blockIdx.x; t < tk * tn; t += gridDim.x) {
    const int k0 = (t % tk) * 64, n0 = (t / tk) * 64;
    __syncthreads();
#pragma unroll
    for (int i = 0; i < 2; ++i) {
      const int kr = (tid >> 4) + i * 32, c = (tid & 15) * 4;
      float4 v = make_float4(0.f, 0.f, 0.f, 0.f);
      if (n0 + c < N) v = *(const float4*)(src + (long)(k0 + kr) * N + n0 + c);
      lds[kr * 65 + c + 0] = v.x; lds[kr * 65 + c + 1] = v.y; lds[kr * 65 + c + 2] = v.z; lds[kr * 65 + c + 3] = v.w;
    }
    __syncthreads();
    const int n = tid >> 3, kc = (tid & 7) * 8;
    u32x4 w;
    w[0] = cvtpk(lds[(kc + 0) * 65 + n], lds[(kc + 1) * 65 + n]);
    w[1] = cvtpk(lds[(kc + 2) * 65 + n], lds[(kc + 3) * 65 + n]);
    w[2] = cvtpk(lds[(kc + 4) * 65 + n], lds[(kc + 5) * 65 + n]);
    w[3] = cvtpk(lds[(kc + 6) * 65 + n], lds[(kc + 7) * 65 + n]);
    *(u32x4*)(dst + (long)(n0 + n) * K + k0 + kc) = w;
  }
}

DEV void init_phase(const P& p, char* lds) {
  for (int j = 0; j < 2; ++j) {
    convert_T(p.rw_in  + (size_t)j * DM * RW_N, (u16*)(p.ws + O_WRWIN)  + (size_t)j * RW_N * DM, DM, RW_N, RW_N, lds);
    convert_T(p.rw_out + (size_t)j * EI * DM,   (u16*)(p.ws + O_WRWOUT) + (size_t)j * DM * EI,   EI, DM, DM, lds);
    convert_T(p.ml_in  + (size_t)j * DM * ML_N, (u16*)(p.ws + O_WMLIN)  + (size_t)j * ML_NP * DM, DM, ML_N, ML_NP, lds);
    convert_T(p.ml_uq  + (size_t)j * 384 * 3072, (u16*)(p.ws + O_WUQ)   + (size_t)j * 3072 * 384, 384, 3072, 3072, lds);
    convert_T(p.ml_ukv + (size_t)j * 256 * 4096, (u16*)(p.ws + O_WUKV)  + (size_t)j * 4096 * 256, 256, 4096, 4096, lds);
    convert_T(p.ml_out + (size_t)j * EI * DM,   (u16*)(p.ws + O_WMLOUT) + (size_t)j * DM * EI,   EI, DM, DM, lds);
  }
  float* ct = (float*)(p.ws + O_COS); float* st = (float*)(p.ws + O_SIN);
  const int tid_ = ltid();
  for (int i = blockIdx.x * 512 + tid_; i < 16384 * 32; i += gridDim.x * 512) {
    const int pos = i >> 5, j = i & 31;
    const float invf = 1.0f / powf(10000.0f, (float)(2 * j) / 64.0f);
    const float ang = (float)pos * invf;
    const double a = (double)ang;
    const double n = rint(a * 0.15915494309189535);
    const float r = (float)(a - n * 6.283185307179586);
    ct[i] = cosf(r); st[i] = sinf(r);
  }
}

DEV void rms_phase(const float* __restrict__ x, const float* __restrict__ g, u16* __restrict__ hout) {
  const int tid_ = ltid(); const int lane = tid_ & 63, wid = __builtin_amdgcn_readfirstlane(tid_ >> 6);
  for (int tok = blockIdx.x * 8 + wid; tok < GT; tok += gridDim.x * 8) {
    const float4* xr = (const float4*)(x + (size_t)tok * DM);
    float4 v[4]; float ss = 0.f;
#pragma unroll
    for (int i = 0; i < 4; ++i) { v[i] = xr[lane + i * 64]; ss += v[i].x * v[i].x + v[i].y * v[i].y + v[i].z * v[i].z + v[i].w * v[i].w; }
    ss = wsum(ss);
    const float sc = rsqrtf(ss * (1.f / DM) + 1e-6f);
#pragma unroll
    for (int i = 0; i < 4; ++i) {
      const float4 gg = ((const float4*)g)[lane + i * 64];
      u32x2 w; w[0] = cvtpk(v[i].x * sc * gg.x, v[i].y * sc * gg.y); w[1] = cvtpk(v[i].z * sc * gg.z, v[i].w * sc * gg.w);
      *(u32x2*)(hout + (size_t)tok * DM + (lane + i * 64) * 4) = w;
    }
  }
}

DEV void final_phase(float* __restrict__ x, const float* __restrict__ g) {
  const int tid_ = ltid(); const int lane = tid_ & 63, wid = __builtin_amdgcn_readfirstlane(tid_ >> 6);
  for (int tok = blockIdx.x * 8 + wid; tok < NTOK; tok += gridDim.x * 8) {
    float4* xr = (float4*)(x + (size_t)tok * DM);
    float4 v[4]; float ss = 0.f;
#pragma unroll
    for (int i = 0; i < 4; ++i) { v[i] = xr[lane + i * 64]; ss += v[i].x * v[i].x + v[i].y * v[i].y + v[i].z * v[i].z + v[i].w * v[i].w; }
    ss = wsum(ss);
    const float sc = rsqrtf(ss * (1.f / DM) + 1e-6f);
#pragma unroll
    for (int i = 0; i < 4; ++i) {
      const float4 gg = ((const float4*)g)[lane + i * 64];
      float4 ov = make_float4(v[i].x * sc * gg.x, v[i].y * sc * gg.y, v[i].z * sc * gg.z, v[i].w * sc * gg.w);
      xr[lane + i * 64] = ov;
    }
  }
}


DEV void lerp_phase(const u16* __restrict__ h, const float* __restrict__ mu, u16* __restrict__ out, int T) {
  const int tid_ = ltid(); const int lane = tid_ & 63, wid = __builtin_amdgcn_readfirstlane(tid_ >> 6);
  for (int tok = blockIdx.x * 8 + wid; tok < GT; tok += gridDim.x * 8) {
    const int pos = tok % T;
#pragma unroll
    for (int half = 0; half < 2; ++half) {
      const int c0 = half * 512 + lane * 8;
      const u32x4 c = *(const u32x4*)(h + (size_t)tok * DM + c0);
      u32x4 pv = {0u, 0u, 0u, 0u}, nx = {0u, 0u, 0u, 0u};
      if (pos > 0) pv = *(const u32x4*)(h + (size_t)(tok - 1) * DM + c0);
      if (pos < T - 1) nx = *(const u32x4*)(h + (size_t)(tok + 1) * DM + c0);
      float hh[8], xx[8];
#pragma unroll
      for (int e = 0; e < 4; ++e) {
        hh[2 * e] = bflo(c[e]); hh[2 * e + 1] = bfhi(c[e]);
        xx[2 * e] = 0.5f * (bflo(pv[e]) + bflo(nx[e])) - hh[2 * e]; xx[2 * e + 1] = 0.5f * (bfhi(pv[e]) + bfhi(nx[e])) - hh[2 * e + 1];
      }
#pragma unroll
      for (int st = 0; st < 4; ++st) {
        const int mi = st == 0 ? 0 : st == 1 ? 2 : st == 2 ? 3 : 5;
        const float4 m0v = *(const float4*)(mu + mi * DM + c0), m1v = *(const float4*)(mu + mi * DM + c0 + 4);
        const float m[8] = {m0v.x, m0v.y, m0v.z, m0v.w, m1v.x, m1v.y, m1v.z, m1v.w};
        u32x4 o;
#pragma unroll
        for (int e = 0; e < 4; ++e) o[e] = cvtpk(hh[2 * e] + m[2 * e] * xx[2 * e], hh[2 * e + 1] + m[2 * e + 1] * xx[2 * e + 1]);
        *(u32x4*)(out + (size_t)st * GT * DM + (size_t)tok * DM + c0) = o;
      }
    }
  }
}

#define GSWZ(row, c16) ((row) * 128 + ((((c16) ^ ((row) >> 1)) & 7) << 4))
constexpr int LOAD_PLAIN = 0, LOAD_LERP = 1;
constexpr int EPI_RWKV = 0, EPI_RES = 1, EPI_MLAIN = 2, EPI_BF16 = 3;
struct GemmP {
  const u16* A; int lda; const u16* Bt; int K; int NT;
  const float* mu;
  int T;
  u16* o0; u16* o1; u16* o2; u16* o3; u16* o4; u16* o5;
  int ldc;
  float* of; const float* xin; float* xout; int dry;
  int nt0; size_t astride;
};

template <int LOAD, int EPI, int NI>
DEV void gemm_phase(const GemmP& g, char* lds) {
  constexpr int BN = 64 * NI, SBB = BN * 128;
  const int tid = ltid(), wid = __builtin_amdgcn_readfirstlane(tid >> 6), lane = tid & 63, r32 = lane & 31, hi = lane >> 5;
  const int wm = wid >> 1, wn = wid & 1;
  char* sA = lds; char* sB = lds + 65536;
  int Kv = g.K; asm volatile("" : "+s"(Kv));
  const int nk = Kv / 64, ntiles = 64 * g.NT;
  const int c16 = tid & 7, rowb = tid >> 3;
  for (int t = blockIdx.x; t < ntiles; t += gridDim.x) {
    const int mt = t & 63, nt = g.nt0 + (t >> 6), m0 = mt * 256, n0 = nt * BN;
    const u16* Ab = g.A + (size_t)(n0 >> 11) * g.astride;
    f32x16 acc[2][NI] = {};
    bf16x8 ra[4], rb[NI];
    const float* mup = nullptr;
    if constexpr (LOAD == LOAD_LERP) {
      const int s = n0 < 2048 ? 0 : n0 < 4096 ? 2 : n0 < 6144 ? 3 : n0 < 8192 ? 5 : n0 == 8192 ? 1 : 4;
      mup = g.mu + s * DM;
    }
    auto gload = [&](int kt) {
      const int k0 = kt * 64 + c16 * 8;
#pragma unroll
      for (int i = 0; i < 4; ++i) {
        const int row = rowb + i * 64; const size_t tok = (size_t)(m0 + row);
        if constexpr (LOAD == LOAD_PLAIN) {
          ra[i] = *(const bf16x8*)(Ab + tok * g.lda + k0);
        } else {
          const int pos = (int)(tok % (size_t)g.T);
          const u32x4 c = *(const u32x4*)(g.A + tok * DM + k0);
          u32x4 pv = {0u, 0u, 0u, 0u}, nx = {0u, 0u, 0u, 0u};
          if (pos > 0) pv = *(const u32x4*)(g.A + (tok - 1) * DM + k0);
          if (pos < g.T - 1) nx = *(const u32x4*)(g.A + (tok + 1) * DM + k0);
          const float4 m0v = *(const float4*)(mup + k0), m1v = *(const float4*)(mup + k0 + 4);
          const float mu[8] = {m0v.x, m0v.y, m0v.z, m0v.w, m1v.x, m1v.y, m1v.z, m1v.w};
          u32x4 o;
#pragma unroll
          for (int e = 0; e < 4; ++e) {
            const float h0 = bflo(c[e]), h1 = bfhi(c[e]);
            const float x0 = 0.5f * (bflo(pv[e]) + bflo(nx[e])) - h0, x1 = 0.5f * (bfhi(pv[e]) + bfhi(nx[e])) - h1;
            o[e] = cvtpk(h0 + mu[2 * e] * x0, h1 + mu[2 * e + 1] * x1);
          }
          ra[i] = *(bf16x8*)&o;
        }
      }
#pragma unroll
      for (int i = 0; i < NI; ++i) {
        const int row = rowb + i * 64;
        rb[i] = *(const bf16x8*)(g.Bt + (size_t)(n0 + row) * Kv + k0);
      }
    };
    auto swrite = [&](int b) {
#pragma unroll
      for (int i = 0; i < 4; ++i) { const int row = rowb + i * 64; *(bf16x8*)(sA + b * 32768 + GSWZ(row, c16)) = ra[i]; }
#pragma unroll
      for (int i = 0; i < NI; ++i) { const int row = rowb + i * 64; *(bf16x8*)(sB + b * SBB + GSWZ(row, c16)) = rb[i]; }
    };
    gload(0); swrite(0); __syncthreads();
    for (int kt = 0; kt < nk; ++kt) {
      const int b = kt & 1;
      if (kt + 1 < nk) gload(kt + 1);
      const char* a_ = sA + b * 32768; const char* b_ = sB + b * SBB;
#pragma unroll
      for (int ks = 0; ks < 4; ++ks) {
        bf16x8 af[2], bfr[NI];
#pragma unroll
        for (int mi = 0; mi < 2; ++mi) { const int row = wm * 64 + mi * 32 + r32; af[mi] = *(const bf16x8*)(a_ + GSWZ(row, ks * 2 + hi)); }
#pragma unroll
        for (int ni = 0; ni < NI; ++ni) { const int row = wn * (32 * NI) + ni * 32 + r32; bfr[ni] = *(const bf16x8*)(b_ + GSWZ(row, ks * 2 + hi)); }
#pragma unroll
        for (int mi = 0; mi < 2; ++mi)
#pragma unroll
          for (int ni = 0; ni < NI; ++ni) acc[mi][ni] = __builtin_amdgcn_mfma_f32_32x32x16_bf16(af[mi], bfr[ni], acc[mi][ni], 0, 0, 0);
      }
      if (kt + 1 < nk) swrite(b ^ 1);
      __syncthreads();
    }
    if (!g.dry)
#pragma unroll
    for (int mi = 0; mi < 2; ++mi)
#pragma unroll
      for (int ni = 0; ni < NI; ++ni)
#pragma unroll
        for (int r = 0; r < 16; ++r) {
          const size_t m = (size_t)(m0 + wm * 64 + mi * 32 + crow(r, hi));
          const int nl = wn * (32 * NI) + ni * 32 + r32, n = n0 + nl;
          const float v = acc[mi][ni][r];
          if constexpr (EPI == EPI_RWKV) {
            if (n0 < 8192) {
              const int which = n0 >> 11, col = n & 2047;
              u16* dst = which == 0 ? g.o0 : which == 1 ? g.o1 : which == 2 ? g.o2 : g.o3;
              dst[m * EI + col] = f2bf(which == 3 ? siluf(v) : v);
            } else if (n0 == 8192) g.o4[m * 128 + nl] = f2bf(tanhf(v));
            else g.o5[m * 128 + nl] = f2bf(v);
          } else if constexpr (EPI == EPI_RES) {
            g.xout[m * DM + n] = g.xin[m * DM + n] + v;
          } else if constexpr (EPI == EPI_MLAIN) {
            if (n < 704) g.of[m * 704 + n] = v;
            else if (n < ML_N) g.o0[m * EI + (n - 704)] = f2bf(siluf(v));
          } else {
            g.o0[m * g.ldc + n] = f2bf(v);
          }
        }
  }
}

struct ScanP {
  const u16 *r, *k, *v, *twl, *al; u16 *yf, *yb; float* bonus;
  const float *w0, *w2, *a0, *a2, *kk, *ka, *rk;
  int nseq, T;
  float* tbuf; int nseg;
};
template <int CTRL> DEV float dppf(float x) {
  return __int_as_float(__builtin_amdgcn_update_dpp(0, __float_as_int(x), CTRL, 0xF, 0xF, false));
}
DEV float row_prefix16(float x) {
  x += dppf<0x111>(x); x += dppf<0x112>(x); x += dppf<0x114>(x); x += dppf<0x118>(x); return x;
}
DEV float row_total16(float x) {
  x += dppf<0x128>(x); x += dppf<0x124>(x); x += dppf<0x122>(x); x += dppf<0x121>(x); return x;
}
DEV bf16x8 pack8(float a0, float a1, float a2, float a3, float a4, float a5, float a6, float a7) {
  u32x4 w = {cvtpk(a0, a1), cvtpk(a2, a3), cvtpk(a4, a5), cvtpk(a6, a7)}; return *(bf16x8*)&w;
}
constexpr int SC_BKT = 0, SC_UVT = 5120, SC_AKM = 10240, SC_RR = 10752, SC_ABF = 11776, SC_Z = 12800, SC_PRM = 17152, SC_T = 18944, SC_WAVE = 35328;
constexpr int SC_PRE = SC_UVT;
constexpr int SC_SHARED_AW = 4 * SC_WAVE;
constexpr int SC_NW = 4;
DEV void scan_phase(const ScanP& s, char* lds_, const int pass) {
  const int tid = ltid(), wid = __builtin_amdgcn_readfirstlane(tid >> 6), lane = tid & 63, c16 = lane & 15, q = lane >> 4;
  const int nchain = s.nseq * 64, nseg = s.nseg;
  const int ipc = pass == 0 ? nseg * 2 : nseg;
  const bool shared = nchain <= (int)gridDim.x;
  const int nsb = shared ? (int)gridDim.x / nchain : 1, sbi = shared ? (int)blockIdx.x / nchain : 0;
  const int nwv = shared ? SC_NW : 2;
  if (shared && sbi >= nsb) return;
  char* wl = lds_ + (wid & 3) * SC_WAVE;
  u16* bkt = (u16*)(wl + SC_BKT); u16* uvt = (u16*)(wl + SC_UVT); u16* akm = (u16*)(wl + SC_AKM); u16* rr = (u16*)(wl + SC_RR);
  float* abf = (float*)(wl + SC_ABF); float* zl = (float*)(wl + SC_Z); float* prm = (float*)(wl + SC_PRM); float* p15l = prm + 320;
  bf16x8* awl = (bf16x8*)(shared ? lds_ + SC_SHARED_AW : lds_ + (2 + (wid & 1)) * SC_WAVE); bf16x8* aal = awl + 512;
#define SCAN_LOAD_W(CHAIN, F0, F1) do { const int d_ = (CHAIN) & 1, h_ = ((CHAIN) >> 1) & 31; \
    for (int f = (F0); f < (F1); ++f) { const int ks = f >> 2, mt = f & 3; u32x4 pw, pa; \
      _Pragma("unroll") for (int e = 0; e < 4; ++e) { const int l0 = ks * 32 + q * 8 + 2 * e; \
        const size_t i0 = ((size_t)(d_ * 64 + l0)) * EI + h_ * 64 + mt * 16 + c16; \
        pw[e] = cvtpk(s.w2[i0], s.w2[i0 + EI]); pa[e] = cvtpk(s.a2[i0], s.a2[i0 + EI]); } \
      awl[f * 64 + lane] = *(bf16x8*)&pw; aal[f * 64 + lane] = *(bf16x8*)&pa; } } while (0)
  if (shared) {
    const int chain_b = (int)blockIdx.x % nchain;
    SCAN_LOAD_W(chain_b, wid, wid + 1);
    __syncthreads();
  }
  if (wid >= nwv) return;
  const int nrounds = shared ? (ipc + nsb * SC_NW - 1) / (nsb * SC_NW) : (nchain + 2 * (int)gridDim.x - 1) / (2 * (int)gridDim.x);
  for (int round = 0; round < nrounds; ++round) {
    const int chain = shared ? (int)blockIdx.x % nchain : (round * 2 + wid) * (int)gridDim.x + (int)blockIdx.x;
    const int it = shared ? sbi * SC_NW + wid + round * nsb * SC_NW : 0;
    if (chain >= nchain || it >= ipc) continue;
    const int kind = pass == 0 ? 1 + (it & 1) : 0;
    const int seg = pass == 0 ? it >> 1 : it;
    const int cs = chain * nseg + seg;
    const int d = chain & 1, h = (chain >> 1) & 31, b = chain >> 6;
    {
      const int ch = h * 64 + lane;
      lds_wait();
      prm[lane] = s.w0[d * EI + ch]; prm[64 + lane] = s.a0[d * EI + ch]; prm[128 + lane] = s.kk[ch]; prm[192 + lane] = s.ka[ch]; prm[256 + lane] = s.rk[ch];
      lds_wait();
    }
    if (!shared) { SCAN_LOAD_W(chain, 0, 8); lds_wait(); }
    const unsigned rowi = (unsigned)(d ? 15 - c16 : c16);
    const unsigned off_tw = rowi * 256u + (unsigned)(q * 16);
    const unsigned off_kr = rowi * 4096u + (unsigned)(h * 128 + q * 8);
    const unsigned off_v  = (unsigned)(h * 128 + lane * 2);
    const unsigned off_y0 = (unsigned)(d ? 15 - 4 * q : 4 * q) * 4096u + (unsigned)(h * 128 + c16 * 2);
    const int ystep = d ? -4096 : 4096;
    f32x4* Tl = (f32x4*)(wl + SC_T);
#pragma unroll
    for (int m = 0; m < 16; ++m) {
      f32x4 t0v = {0.f, 0.f, 0.f, 0.f};
      if (kind == 2) {
        const int mt = m >> 2, nt = m & 3;
        if (mt == nt) { t0v[0] = (4 * q + 0 == c16) ? 1.f : 0.f; t0v[1] = (4 * q + 1 == c16) ? 1.f : 0.f; t0v[2] = (4 * q + 2 == c16) ? 1.f : 0.f; t0v[3] = (4 * q + 3 == c16) ? 1.f : 0.f; }
      } else if (kind == 0 && nseg > 1) {
        t0v = *(const f32x4*)(s.tbuf + ((size_t)cs * 2) * 4096 + (m * 64 + lane) * 4);
      }
      Tl[m * 64 + lane] = t0v;
    }
    u16* yout = d ? s.yb : s.yf;
    const size_t sb = (size_t)b * s.T;
    const int cps = s.T / 16 / nseg, cbeg = seg * cps, cend = cbeg + cps;
    bf16x8 n_tw0, n_tw1, n_ta0, n_ta1; u32x2 n_k[4], n_r[4];
#define SCAN_LOAD(CC) do { const int c0n = d ? (s.T - 16 - (CC) * 16) : (CC) * 16; const size_t t0n = sb + c0n; \
      size_t p_tw = (size_t)s.twl + t0n * 256 + d * 128, p_al = (size_t)s.al + t0n * 256 + d * 128, p_k = (size_t)s.k + t0n * 4096, p_r = (size_t)s.r + t0n * 4096 ; \
      asm volatile("" : "+s"(p_tw), "+s"(p_al), "+s"(p_k), "+s"(p_r)); \
      n_tw0 = gld<bf16x8>(p_tw, off_tw); n_tw1 = gld<bf16x8>(p_tw, off_tw + 64); n_ta0 = gld<bf16x8>(p_al, off_tw); n_ta1 = gld<bf16x8>(p_al, off_tw + 64); \
      _Pragma("unroll") for (int mt = 0; mt < 4; ++mt) { n_k[mt] = gld<u32x2>(p_k, off_kr + mt * 32); n_r[mt] = gld<u32x2>(p_r, off_kr + mt * 32); } } while (0)
    SCAN_LOAD(cbeg);
    for (int cc = cbeg; cc < cend; ++cc) {
      const int c0 = d ? (s.T - 16 - cc * 16) : cc * 16;
      const size_t t0 = sb + c0;
      size_t b_y = (size_t)yout + t0 * 4096, b_bon = (size_t)s.bonus + t0 * 256 + (h * 2 + d) * 4;
      asm volatile("" : "+s"(b_y), "+s"(b_bon));
      size_t b_v = (size_t)s.v + t0 * 4096; asm volatile("" : "+s"(b_v));
      u32x2 n_v[4];
#pragma unroll
      for (int mt = 0; mt < 4; ++mt) n_v[mt] = gld<u32x2>(b_v, off_kr + mt * 32);
      {
        f32x4* wpl = (f32x4*)zl; f32x4* apl = (f32x4*)(wl + SC_PRE);
#pragma unroll
        for (int mt = 0; mt < 4; ++mt) {
          f32x4 cw = {0.f, 0.f, 0.f, 0.f}, ca = {0.f, 0.f, 0.f, 0.f};
          cw = __builtin_amdgcn_mfma_f32_16x16x32_bf16(awl[(0 * 4 + mt) * 64 + lane], n_tw0, cw, 0, 0, 0);
          cw = __builtin_amdgcn_mfma_f32_16x16x32_bf16(awl[(1 * 4 + mt) * 64 + lane], n_tw1, cw, 0, 0, 0);
          ca = __builtin_amdgcn_mfma_f32_16x16x32_bf16(aal[(0 * 4 + mt) * 64 + lane], n_ta0, ca, 0, 0, 0);
          ca = __builtin_amdgcn_mfma_f32_16x16x32_bf16(aal[(1 * 4 + mt) * 64 + lane], n_ta1, ca, 0, 0, 0);
          wpl[mt * 64 + lane] = cw; apl[mt * 64 + lane] = ca;
        }
      }
      float n2 = 0.f;
#pragma unroll
      for (int mt = 0; mt < 4; ++mt) {
        const float4 kkp = *(const float4*)(prm + 128 + mt * 16 + q * 4);
        const float t0 = bflo(n_k[mt][0]) * kkp.x, t1 = bfhi(n_k[mt][0]) * kkp.y, t2 = bflo(n_k[mt][1]) * kkp.z, t3 = bfhi(n_k[mt][1]) * kkp.w;
        n2 += t0 * t0 + t1 * t1 + t2 * t2 + t3 * t3;
      }
      n2 += __shfl_xor(n2, 16, 64); n2 += __shfl_xor(n2, 32, 64);
      const float invn = __builtin_amdgcn_rsqf(fmaxf(n2, 1e-24f));
      float bon = 0.f;
      bf16x8 ktf[2], btf[2], kdf[2], rtf[2];
#pragma unroll
      for (int ks = 0; ks < 2; ++ks) {
        float ktl[8], btl[8], kdl[8], rtl[8];
#pragma unroll
        for (int mh = 0; mh < 2; ++mh) {
          const int mt = 2 * ks + mh;
          const f32x4 cw = ((const f32x4*)zl)[mt * 64 + lane], ca = ((const f32x4*)(wl + SC_PRE))[mt * 64 + lane];
          const float4 w0p = *(const float4*)(prm + mt * 16 + q * 4), a0p = *(const float4*)(prm + 64 + mt * 16 + q * 4);
          const float4 kkp = *(const float4*)(prm + 128 + mt * 16 + q * 4), kap = *(const float4*)(prm + 192 + mt * 16 + q * 4), rkp = *(const float4*)(prm + 256 + mt * 16 + q * 4);
          const float w0a[4] = {w0p.x, w0p.y, w0p.z, w0p.w}, a0a[4] = {a0p.x, a0p.y, a0p.z, a0p.w};
          const float kka[4] = {kkp.x, kkp.y, kkp.z, kkp.w}, kaa[4] = {kap.x, kap.y, kap.z, kap.w}, rka[4] = {rkp.x, rkp.y, rkp.z, rkp.w};
          const u32x2 kr_ = n_k[mt], rr_ = n_r[mt];
          const float kxa[4] = {bflo(kr_[0]), bfhi(kr_[0]), bflo(kr_[1]), bfhi(kr_[1])};
          const float rxa[4] = {bflo(rr_[0]), bfhi(rr_[0]), bflo(rr_[1]), bfhi(rr_[1])};
          float4 p15v;
#pragma unroll
          for (int e = 0; e < 4; ++e) {
            const float wp = cw[e] + w0a[e], ap = ca[e] + a0a[e];
            const float ee = 0.6065306597126334f * __builtin_amdgcn_rcpf(1.f + __expf(-wp));
            const float a = __builtin_amdgcn_rcpf(1.f + __expf(-ap));
            const float kkn = kxa[e] * kka[e] * invn;
            const float kd = kxa[e] * (1.f + (a - 1.f) * kaa[e]);
            const float bb = kkn * a;
            bon += rxa[e] * kd * rka[e];
            const float Ei = row_prefix16(ee);
            const float pm = __expf(-Ei), pp = __builtin_amdgcn_rcpf(pm);
            const float pm1s = dppf<0x111>(pm), pm1 = c16 == 0 ? 1.f : pm1s;
            ktl[mh * 4 + e] = kkn * pm1; btl[mh * 4 + e] = bb * pp; kdl[mh * 4 + e] = kd * pp; rtl[mh * 4 + e] = rxa[e] * pm;
            ((float*)&p15v)[e] = pm;
            const int j = mt * 16 + q * 4 + e;
            bkt[j * 40 + c16] = f2bf(btl[mh * 4 + e]); bkt[j * 40 + 16 + c16] = f2bf(kdl[mh * 4 + e]);
          }
          if (c16 == 15) *(float4*)(p15l + mt * 16 + q * 4) = p15v;
          SBAR();
        }
        ktf[ks] = pack8(ktl[0], ktl[1], ktl[2], ktl[3], ktl[4], ktl[5], ktl[6], ktl[7]);
        btf[ks] = pack8(btl[0], btl[1], btl[2], btl[3], btl[4], btl[5], btl[6], btl[7]);
        kdf[ks] = pack8(kdl[0], kdl[1], kdl[2], kdl[3], kdl[4], kdl[5], kdl[6], kdl[7]);
        rtf[ks] = pack8(rtl[0], rtl[1], rtl[2], rtl[3], rtl[4], rtl[5], rtl[6], rtl[7]);
      }
      bon += __shfl_xor(bon, 16, 64); bon += __shfl_xor(bon, 32, 64);
      if (q == 0 && kind == 0) gst<float>(b_bon, off_tw, bon);
      SBAR();
      SBAR();
#pragma unroll
      for (int mt = 0; mt < 4; ++mt) {
        const int vb_ = (mt * 16 + q * 4) * 40 + 16 + c16;
        const unsigned v0_ = kind == 2 ? 0u : n_v[mt][0], v1_ = kind == 2 ? 0u : n_v[mt][1];
        uvt[vb_] = (u16)(v0_ & 0xffffu); uvt[vb_ + 40] = (u16)(v0_ >> 16);
        uvt[vb_ + 80] = (u16)(v1_ & 0xffffu); uvt[vb_ + 120] = (u16)(v1_ >> 16);
      }
      { const int cn = cc + 1 < cend ? cc + 1 : cc; SCAN_LOAD(cn); }
      SBAR();
      {
        f32x4 AB = {0.f, 0.f, 0.f, 0.f}, AK = AB, RB = AB, RK = AB;
        int qm = q; asm volatile("" : "+v"(qm));
#pragma unroll
        for (int ks = 0; ks < 2; ++ks) {
          AB = __builtin_amdgcn_mfma_f32_16x16x32_bf16(ktf[ks], btf[ks], AB, 0, 0, 0);
          AK = __builtin_amdgcn_mfma_f32_16x16x32_bf16(ktf[ks], kdf[ks], AK, 0, 0, 0);
          RB = __builtin_amdgcn_mfma_f32_16x16x32_bf16(rtf[ks], btf[ks], RB, 0, 0, 0);
          RK = __builtin_amdgcn_mfma_f32_16x16x32_bf16(rtf[ks], kdf[ks], RK, 0, 0, 0);
        }
#pragma unroll
        for (int r = 0; r < 4; ++r) {
          const int i = 4 * qm + r;
          const bool lo = c16 < i, le = c16 <= i;
          abf[i * 16 + c16] = lo ? AB[r] : 0.f;
          akm[i * 16 + c16] = f2bf(lo ? AK[r] : 0.f);
          rr[i * 32 + c16] = f2bf(le ? RB[r] : 0.f);
          rr[i * 32 + 16 + c16] = f2bf(le ? RK[r] : 0.f);
        }
      }
#define TFRAG(ks, nt, OUT) do { const f32x4 ta_ = Tl[((2 * (ks)) * 4 + (nt)) * 64 + lane], tb_ = Tl[((2 * (ks) + 1) * 4 + (nt)) * 64 + lane]; \
        OUT = pack8(ta_[0], ta_[1], ta_[2], ta_[3], tb_[0], tb_[1], tb_[2], tb_[3]); } while (0)
      lds_wait();
      {
        bf16x8 akf = {0, 0, 0, 0, 0, 0, 0, 0};
        if (q < 2) akf = *(const bf16x8*)(akm + c16 * 16 + q * 8);
#pragma unroll
        for (int nt = 0; nt < 4; ++nt) {
          f32x4 z = {0.f, 0.f, 0.f, 0.f};
          bf16x8 tf0, tf1; TFRAG(0, nt, tf0); TFRAG(1, nt, tf1);
          z = __builtin_amdgcn_mfma_f32_16x16x32_bf16(ktf[0], tf0, z, 0, 0, 0);
          z = __builtin_amdgcn_mfma_f32_16x16x32_bf16(ktf[1], tf1, z, 0, 0, 0);
          const bf16x8 vf = *(const bf16x8*)(uvt + (nt * 16 + c16) * 40 + 16 + (q & 1) * 8);
          z = __builtin_amdgcn_mfma_f32_16x16x32_bf16(akf, vf, z, 0, 0, 0);
#pragma unroll
          for (int r = 0; r < 4; ++r) zl[(4 * q + r) * 68 + nt * 16 + c16] = z[r];
        }
      }
      lds_wait();
      SBAR();
      {
        float U[16];
#pragma unroll
        for (int i = 0; i < 16; ++i) {
          float acc = -zl[i * 68 + lane];
#pragma unroll
          for (int s4 = 0; s4 < (i + 3) / 4; ++s4) {
            const float4 a4 = *(const float4*)(abf + i * 16 + s4 * 4);
            if (s4 * 4 + 0 < i) acc -= a4.x * U[s4 * 4 + 0];
            if (s4 * 4 + 1 < i) acc -= a4.y * U[s4 * 4 + 1];
            if (s4 * 4 + 2 < i) acc -= a4.z * U[s4 * 4 + 2];
            if (s4 * 4 + 3 < i) acc -= a4.w * U[s4 * 4 + 3];
          }
          U[i] = acc;
          if ((i & 3) == 3) SBAR();
        }
        *(bf16x8*)(uvt + lane * 40) = pack8(U[0], U[1], U[2], U[3], U[4], U[5], U[6], U[7]);
        *(bf16x8*)(uvt + lane * 40 + 8) = pack8(U[8], U[9], U[10], U[11], U[12], U[13], U[14], U[15]);
      }
      lds_wait();
      SBAR();
      {
        const bf16x8 rrf = *(const bf16x8*)(rr + c16 * 32 + q * 8);
        bf16x8 uvf[4];
#pragma unroll
        for (int nt = 0; nt < 4; ++nt) uvf[nt] = *(const bf16x8*)(uvt + (nt * 16 + c16) * 40 + q * 8);
#pragma unroll
        for (int nt = 0; nt < 4; ++nt) {
          f32x4 y = {0.f, 0.f, 0.f, 0.f};
          bf16x8 tf0, tf1; TFRAG(0, nt, tf0); TFRAG(1, nt, tf1);
          y = __builtin_amdgcn_mfma_f32_16x16x32_bf16(rtf[0], tf0, y, 0, 0, 0);
          y = __builtin_amdgcn_mfma_f32_16x16x32_bf16(rtf[1], tf1, y, 0, 0, 0);
          y = __builtin_amdgcn_mfma_f32_16x16x32_bf16(rrf, uvf[nt], y, 0, 0, 0);
#pragma unroll
          for (int r = 0; r < 4; ++r) { if (kind == 0) gst<u16>(b_y, off_y0 + (unsigned)(r * ystep) + nt * 32, f2bf(y[r])); }
        }
#pragma unroll
        for (int mt = 0; mt < 4; ++mt) {
          const bf16x8 bkf = *(const bf16x8*)(bkt + (mt * 16 + c16) * 40 + q * 8);
          const float4 pq = *(const float4*)(p15l + mt * 16 + q * 4);
#pragma unroll
          for (int nt = 0; nt < 4; ++nt) {
            f32x4 t = __builtin_amdgcn_mfma_f32_16x16x32_bf16(bkf, uvf[nt], Tl[(mt * 4 + nt) * 64 + lane], 0, 0, 0);
            t[0] *= pq.x; t[1] *= pq.y; t[2] *= pq.z; t[3] *= pq.w;
            Tl[(mt * 4 + nt) * 64 + lane] = t;
          }
        }
      }
      lds_wait();
    }
    if (pass == 0) {
      float* dst = s.tbuf + ((size_t)cs * 2 + (kind - 1)) * 4096;
#pragma unroll
      for (int m = 0; m < 16; ++m) *(f32x4*)(dst + (m * 64 + lane) * 4) = Tl[m * 64 + lane];
    }
  }
}

DEV void scan_combine_phase(const ScanP& s, char* lds_) {
  const int tid = ltid(), wid = __builtin_amdgcn_readfirstlane(tid >> 6), lane = tid & 63, c16 = lane & 15, q = lane >> 4;
  if (wid >= 2) return;
  float* til = (float*)(lds_ + wid * 16384);
  const int nchain = s.nseq * 64, nseg = s.nseg;
  for (int chain = wid * gridDim.x + blockIdx.x; chain < nchain; chain += 2 * gridDim.x) {
    f32x4 T[16];
#pragma unroll
    for (int m = 0; m < 16; ++m) T[m] = f32x4{0.f, 0.f, 0.f, 0.f};
    for (int seg = 0; seg < nseg; ++seg) {
      float* tn = s.tbuf + ((size_t)(chain * nseg + seg) * 2) * 4096; const float* ti = tn + 4096;
      lds_wait();
#pragma unroll
      for (int m = 0; m < 16; ++m) *(f32x4*)(til + (m * 64 + lane) * 4) = *(const f32x4*)(ti + (m * 64 + lane) * 4);
      lds_wait();
      f32x4 Tn[16];
#pragma unroll
      for (int m = 0; m < 16; ++m) Tn[m] = *(const f32x4*)(tn + (m * 64 + lane) * 4);
#pragma unroll
      for (int nt = 0; nt < 4; ++nt) {
        bf16x8 bh[2], bl[2];
#pragma unroll
        for (int ks = 0; ks < 2; ++ks) {
          const f32x4 ta = T[(2 * ks) * 4 + nt], tb = T[(2 * ks + 1) * 4 + nt];
          const float x[8] = {ta[0], ta[1], ta[2], ta[3], tb[0], tb[1], tb[2], tb[3]};
          float hf[8], lf[8];
#pragma unroll
          for (int e = 0; e < 8; ++e) { hf[e] = bf2f(f2bf(x[e])); lf[e] = x[e] - hf[e]; }
          bh[ks] = pack8(hf[0], hf[1], hf[2], hf[3], hf[4], hf[5], hf[6], hf[7]);
          bl[ks] = pack8(lf[0], lf[1], lf[2], lf[3], lf[4], lf[5], lf[6], lf[7]);
        }
#pragma unroll
        for (int mt = 0; mt < 4; ++mt) {
          f32x4 acc = Tn[mt * 4 + nt];
#pragma unroll
          for (int ks = 0; ks < 2; ++ks) {
            float x[8];
#pragma unroll
            for (int e = 0; e < 8; ++e) x[e] = til[((mt * 4 + 2 * ks + (e >> 2)) * 64 + ((c16 >> 2) & 3) * 16 + 4 * q + (e & 3)) * 4 + (c16 & 3)];
            float hf[8], lf[8];
#pragma unroll
            for (int e = 0; e < 8; ++e) { hf[e] = bf2f(f2bf(x[e])); lf[e] = x[e] - hf[e]; }
            const bf16x8 ah = pack8(hf[0], hf[1], hf[2], hf[3], hf[4], hf[5], hf[6], hf[7]);
            const bf16x8 al = pack8(lf[0], lf[1], lf[2], lf[3], lf[4], lf[5], lf[6], lf[7]);
            acc = __builtin_amdgcn_mfma_f32_16x16x32_bf16(ah, bh[ks], acc, 0, 0, 0);
            acc = __builtin_amdgcn_mfma_f32_16x16x32_bf16(ah, bl[ks], acc, 0, 0, 0);
            acc = __builtin_amdgcn_mfma_f32_16x16x32_bf16(al, bh[ks], acc, 0, 0, 0);
          }
          Tn[mt * 4 + nt] = acc;
        }
      }
#pragma unroll
      for (int m = 0; m < 16; ++m) { *(f32x4*)(tn + (m * 64 + lane) * 4) = T[m]; T[m] = Tn[m]; }
    }
  }
}

DEV void post_phase(u16* __restrict__ yf, const u16* __restrict__ yb, const u16* __restrict__ v, const u16* __restrict__ sg,
                    const float* __restrict__ bonus, const float* __restrict__ lg, const float* __restrict__ lb) {
  const int tid_ = ltid(); const int lane = tid_ & 63, wid = __builtin_amdgcn_readfirstlane(tid_ >> 6);
  for (int tok = blockIdx.x * 8 + wid; tok < GT; tok += gridDim.x * 8) {
#pragma unroll
    for (int it = 0; it < 4; ++it) {
      const int ch0 = it * 512 + lane * 8, h = ch0 >> 6; const size_t i = (size_t)tok * EI + ch0;
      const u32x4 a = *(const u32x4*)(yf + i), bq = *(const u32x4*)(yb + i), vv = *(const u32x4*)(v + i), gg = *(const u32x4*)(sg + i);
      const float2 bo = *(const float2*)(bonus + ((size_t)tok * 32 + h) * 2);
      float y[8]; float sum = 0.f;
#pragma unroll
      for (int e = 0; e < 4; ++e) { y[2 * e] = bflo(a[e]) + bflo(bq[e]); y[2 * e + 1] = bfhi(a[e]) + bfhi(bq[e]); sum += y[2 * e] + y[2 * e + 1]; }
      sum += __shfl_xor(sum, 1, 64); sum += __shfl_xor(sum, 2, 64); sum += __shfl_xor(sum, 4, 64);
      const float mean = sum * (1.f / 64.f);
      float var = 0.f;
#pragma unroll
      for (int e = 0; e < 8; ++e) { y[e] -= mean; var += y[e] * y[e]; }
      var += __shfl_xor(var, 1, 64); var += __shfl_xor(var, 2, 64); var += __shfl_xor(var, 4, 64);
      const float rs = rsqrtf(var * (1.f / 64.f) + 64e-5f), bon = bo.x + bo.y;
      const float4 g0 = *(const float4*)(lg + ch0), g1 = *(const float4*)(lg + ch0 + 4), b0 = *(const float4*)(lb + ch0), b1 = *(const float4*)(lb + ch0 + 4);
      const float ga[8] = {g0.x, g0.y, g0.z, g0.w, g1.x, g1.y, g1.z, g1.w}, ba[8] = {b0.x, b0.y, b0.z, b0.w, b1.x, b1.y, b1.z, b1.w};
      u32x4 o;
#pragma unroll
      for (int e = 0; e < 4; ++e) {
        const float o0 = (y[2 * e] * rs * ga[2 * e] + ba[2 * e] + bon * bflo(vv[e])) * bflo(gg[e]);
        const float o1 = (y[2 * e + 1] * rs * ga[2 * e + 1] + ba[2 * e + 1] + bon * bfhi(vv[e])) * bfhi(gg[e]);
        o[e] = cvtpk(o0, o1);
      }
      *(u32x4*)(yf + i) = o;
    }
  }
}

DEV void mla_mid_phase(const float* __restrict__ cqkv, const float* __restrict__ qn, const float* __restrict__ kvn,
                       const float* __restrict__ ct, const float* __restrict__ st,
                       u16* __restrict__ cqn, u16* __restrict__ ckvn, u16* __restrict__ kpe, int T) {
  const int tid_ = ltid(); const int lane = tid_ & 63, wid = __builtin_amdgcn_readfirstlane(tid_ >> 6);
  for (int tok = blockIdx.x * 8 + wid; tok < GT; tok += gridDim.x * 8) {
    const float* row = cqkv + (size_t)tok * 704;
    float q[6], ss = 0.f;
#pragma unroll
    for (int i = 0; i < 6; ++i) { q[i] = row[lane + i * 64]; ss += q[i] * q[i]; }
    ss = wsum(ss); float sc = rsqrtf(ss * (1.f / 384.f) + 1e-6f);
#pragma unroll
    for (int i = 0; i < 6; ++i) cqn[(size_t)tok * 384 + lane + i * 64] = f2bf(q[i] * sc * qn[lane + i * 64]);
    float c[4]; ss = 0.f;
#pragma unroll
    for (int i = 0; i < 4; ++i) { c[i] = row[384 + lane + i * 64]; ss += c[i] * c[i]; }
    ss = wsum(ss); sc = rsqrtf(ss * (1.f / 256.f) + 1e-6f);
#pragma unroll
    for (int i = 0; i < 4; ++i) ckvn[(size_t)tok * 256 + lane + i * 64] = f2bf(c[i] * sc * kvn[lane + i * 64]);
    const float x = row[640 + lane];
    const float xo = __shfl_xor(x, 32, 64);
    const int pos = tok % T, j = lane & 31;
    const float cs = ct[pos * 32 + j], sn = st[pos * 32 + j];
    const float o = lane < 32 ? x * cs - xo * sn : x * cs + xo * sn;
    kpe[(size_t)tok * 64 + lane] = f2bf(o);
  }
}

constexpr int SHM_V = 16384, SHM_K = 16384, SHM_KP = 8192;
#define KSWZ(row, colB) ((row) * 256 + ((colB) ^ (((row) & 7) << 4)))
#define KPSWZ(row, colB) ((row) * 128 + ((colB) ^ (((row) & 7) << 4)))
constexpr float ATT_SCALE = 0.07216878364870322f;
DEV void partialSM(f32x16& p0, f32x16& p1, float& m_reg, float& mn, float& alpha) {
  constexpr float C = ATT_SCALE * 1.4426950408889634f;
  float pmax = p0[0];
#pragma unroll
  for (int r = 1; r < 16; ++r) pmax = fmaxf(pmax, p0[r]);
#pragma unroll
  for (int r = 0; r < 16; ++r) pmax = fmaxf(pmax, p1[r]);
  { auto rr = __builtin_amdgcn_permlane32_swap(__float_as_uint(pmax), __float_as_uint(pmax), false, false);
    pmax = fmaxf(__uint_as_float(rr[0]), __uint_as_float(rr[1])); }
  mn = fmaxf(m_reg, pmax); alpha = __builtin_amdgcn_exp2f((m_reg - mn) * C); m_reg = mn;
  const float mnC = -mn * C;
#pragma unroll
  for (int r = 0; r < 16; ++r) p0[r] = __builtin_amdgcn_exp2f(fmaf(p0[r], C, mnC));
#pragma unroll
  for (int r = 0; r < 16; ++r) p1[r] = __builtin_amdgcn_exp2f(fmaf(p1[r], C, mnC));
}
DEV void finishSM(f32x16& p0, f32x16& p1, float alpha, float& l_reg, bf16x8& pa0, bf16x8& pa1, bf16x8& pa2, bf16x8& pa3) {
  float ps = 0;
#pragma unroll
  for (int r = 0; r < 16; ++r) ps += p0[r];
#pragma unroll
  for (int r = 0; r < 16; ++r) ps += p1[r];
  { auto rr = __builtin_amdgcn_permlane32_swap(__float_as_uint(ps), __float_as_uint(ps), false, false);
    ps = __uint_as_float(rr[0]) + __uint_as_float(rr[1]); }
  l_reg = l_reg * alpha + ps;
#define PK4(PP, BASE, OUT) do { unsigned a0 = cvtpk(PP[BASE + 0], PP[BASE + 1]), a1 = cvtpk(PP[BASE + 2], PP[BASE + 3]);   \
    unsigned b0 = cvtpk(PP[BASE + 4], PP[BASE + 5]), b1 = cvtpk(PP[BASE + 6], PP[BASE + 7]);                              \
    auto r0 = __builtin_amdgcn_permlane32_swap(a0, b0, false, false); auto r1 = __builtin_amdgcn_permlane32_swap(a1, b1, false, false); \
    u32x4 w = {r0[0], r1[0], r0[1], r1[1]}; OUT = *reinterpret_cast<bf16x8*>(&w); } while (0)
  PK4(p0, 0, pa0); PK4(p0, 8, pa1); PK4(p1, 0, pa2); PK4(p1, 8, pa3);
#undef PK4
}
DEV int v_st(int k, int c) { const int kk = (k & ~0xC) | ((k & 4) << 1) | ((k & 8) >> 1); return ((kk >> 3) * 4 + (c >> 5)) * 512 + ((kk & 7) * 32 + (c & 31)) * 2; }
DEV int v_rd_base(int lane) { return ((lane & 3) << 3) | (((lane >> 2) & 3) << 6) | (((lane >> 4) & 1) << 5) | (((lane >> 5) & 1) << 8); }
constexpr int v_rd_off(int d0, int ks, int half) { return d0 * 512 + ks * 4096 + half * 2048; }
template <int OFF> DEV s16x4 tr_read(int vb) {
  s16x4 r; asm volatile("ds_read_b64_tr_b16 %0, %1 offset:%2" : "=&v"(r) : "v"(vb), "i"(OFF) : "memory"); return r;
}
template <int D0> DEV void pv_one(f32x16& od, int vb, bf16x8 pa0, bf16x8 pa1, bf16x8 pa2, bf16x8 pa3) {
  const s16x4 l0 = tr_read<v_rd_off(D0, 0, 0)>(vb), h0 = tr_read<v_rd_off(D0, 0, 1)>(vb), l1 = tr_read<v_rd_off(D0, 1, 0)>(vb), h1 = tr_read<v_rd_off(D0, 1, 1)>(vb);
  const s16x4 l2 = tr_read<v_rd_off(D0, 2, 0)>(vb), h2 = tr_read<v_rd_off(D0, 2, 1)>(vb), l3 = tr_read<v_rd_off(D0, 3, 0)>(vb), h3 = tr_read<v_rd_off(D0, 3, 1)>(vb);
  asm volatile("s_waitcnt lgkmcnt(0)" ::: "memory"); SBAR();
#define PK(L, H) (bf16x8){L[0], L[1], L[2], L[3], H[0], H[1], H[2], H[3]}
  od = __builtin_amdgcn_mfma_f32_32x32x16_bf16(pa0, PK(l0, h0), od, 0, 0, 0);
  od = __builtin_amdgcn_mfma_f32_32x32x16_bf16(pa1, PK(l1, h1), od, 0, 0, 0);
  od = __builtin_amdgcn_mfma_f32_32x32x16_bf16(pa2, PK(l2, h2), od, 0, 0, 0);
  od = __builtin_amdgcn_mfma_f32_32x32x16_bf16(pa3, PK(l3, h3), od, 0, 0, 0);
#undef PK
}

struct AttnP { const u16* q; const u16* kv; const u16* kpe; u16* sg; const float* ct; const float* st; int nseq, T; int dry; };
DEV void attn_phase(const AttnP& a, char* lds) {
  const int tid = ltid(), wid = __builtin_amdgcn_readfirstlane(tid >> 6), lane = tid & 63, r32 = lane & 31, hi = lane >> 5;
  char* V_lds = lds; char* K_lds = lds + 3 * SHM_V; char* KP_lds = lds + 3 * SHM_V + 2 * SHM_K;
  float* wsc = (float*)(lds + 3 * SHM_V + 2 * SHM_K + 2 * SHM_KP) + wid * 64; float* li_l = wsc; float* al_l = wsc + 32;
  const int nqb = a.T / 256, nitems = a.nseq * 16 * nqb, NT = a.T / 64;
  const int sr = tid >> 4, sc = (tid & 15) * 8, vst0 = v_st(sr, sc), vst1 = v_st(32 + sr, sc);
  const int pr = tid >> 3, pc = (tid & 7) * 8;
  const int vb0 = (int)(uintptr_t)V_lds + v_rd_base(lane);
  int kad[4], kpd[4];
#pragma unroll
  for (int q = 0; q < 4; ++q) { kad[q] = KSWZ(r32, q * 32 + hi * 16); kpd[q] = KPSWZ(r32, q * 32 + hi * 16); }
  for (int it = blockIdx.x; it < nitems; it += gridDim.x) {
    const int qb = it % nqb, h = (it / nqb) & 15, b = it / (nqb * 16);
    const size_t sbase = (size_t)b * a.T;
    const int pos = qb * 256 + wid * 32 + r32;
    bf16x8 qr[12];
    {
      const u16* Qw = a.q + (sbase + pos) * 3072 + h * 192 + hi * 8;
#pragma unroll
      for (int d0 = 0; d0 < 12; ++d0) qr[d0] = *(const bf16x8*)(Qw + d0 * 16);
#pragma unroll
      for (int dd = 0; dd < 2; ++dd) {
        const int j0 = dd * 16 + hi * 8;
        const float4 c0 = *(const float4*)(a.ct + pos * 32 + j0), c1 = *(const float4*)(a.ct + pos * 32 + j0 + 4);
        const float4 s0 = *(const float4*)(a.st + pos * 32 + j0), s1 = *(const float4*)(a.st + pos * 32 + j0 + 4);
        const float cs[8] = {c0.x, c0.y, c0.z, c0.w, c1.x, c1.y, c1.z, c1.w};
        const float sn[8] = {s0.x, s0.y, s0.z, s0.w, s1.x, s1.y, s1.z, s1.w};
        u32x4 x1 = *(u32x4*)&qr[8 + dd], x2 = *(u32x4*)&qr[10 + dd], y1, y2;
#pragma unroll
        for (int e = 0; e < 4; ++e) {
          const float a0 = bflo(x1[e]), a1 = bfhi(x1[e]), b0 = bflo(x2[e]), b1 = bfhi(x2[e]);
          y1[e] = cvtpk(a0 * cs[2 * e] - b0 * sn[2 * e], a1 * cs[2 * e + 1] - b1 * sn[2 * e + 1]);
          y2[e] = cvtpk(b0 * cs[2 * e] + a0 * sn[2 * e], b1 * cs[2 * e + 1] + a1 * sn[2 * e + 1]);
        }
        qr[8 + dd] = *(bf16x8*)&y1; qr[10 + dd] = *(bf16x8*)&y2;
      }
    }
    float m_reg = -1e30f, l_reg = 0.f; f32x16 o[4] = {};
    bf16x8 vs0, vs1, ks0, ks1, kp0;
    const u16* kvh = a.kv + sbase * 4096 + h * 256;
    const u16* kph = a.kpe + sbase * 64;
    const unsigned voff = (unsigned)(sr * 8192 + sc * 2), poff = (unsigned)(pr * 128 + pc * 2);
#define SLOAD(k0) do { const char* bK0 = (const char*)kvh + (size_t)(k0) * 8192; const char* bK1 = bK0 + 32 * 8192; const char* bP = (const char*)kph + (size_t)(k0) * 128; \
    vs0 = *(const bf16x8*)(bK0 + voff + 256); vs1 = *(const bf16x8*)(bK1 + voff + 256); \
    ks0 = *(const bf16x8*)(bK0 + voff); ks1 = *(const bf16x8*)(bK1 + voff); \
    kp0 = *(const bf16x8*)(bP + poff); } while (0)
#define SWRITE(bb, vbuf) do { *(bf16x8*)(V_lds + (vbuf) * SHM_V + vst0) = vs0; *(bf16x8*)(V_lds + (vbuf) * SHM_V + vst1) = vs1; \
    *(bf16x8*)(K_lds + (bb) * SHM_K + KSWZ(sr, sc * 2)) = ks0; *(bf16x8*)(K_lds + (bb) * SHM_K + KSWZ(32 + sr, sc * 2)) = ks1; \
    *(bf16x8*)(KP_lds + (bb) * SHM_KP + KPSWZ(pr, pc * 2)) = kp0; } while (0)
    __syncthreads();
    SLOAD(0); SWRITE(0, 0); __syncthreads();
    const bool grpB = wid >= 4;
    bf16x8 pa0, pa1, pa2, pa3;
    int vcur = 0, vprev = 2;
#define PV_ALL(vbuf) do { const int vb_ = vb0 + (vbuf) * SHM_V; \
      pv_one<0>(o[0], vb_, pa0, pa1, pa2, pa3); pv_one<1>(o[1], vb_, pa0, pa1, pa2, pa3); \
      pv_one<2>(o[2], vb_, pa0, pa1, pa2, pa3); pv_one<3>(o[3], vb_, pa0, pa1, pa2, pa3); } while (0)
    for (int j = 0; j < NT; ++j) {
      const int bb = j & 1;
      if (j + 1 < NT) SLOAD((j + 1) * 64);
      SBAR();
      if (grpB && j > 0) PV_ALL(vprev);
      f32x16 p0 = {}, p1 = {};
      {
        const char* Ks = K_lds + bb * SHM_K; const char* Kp = KP_lds + bb * SHM_KP;
#pragma unroll
        for (int d0 = 0; d0 < 8; ++d0) {
          const bf16x8 b0 = *(const bf16x8*)(Ks + kad[d0 & 3] + (d0 >> 2) * 128), b1 = *(const bf16x8*)(Ks + kad[d0 & 3] + (d0 >> 2) * 128 + 8192);
          p0 = __builtin_amdgcn_mfma_f32_32x32x16_bf16(b0, qr[d0], p0, 0, 0, 0);
          p1 = __builtin_amdgcn_mfma_f32_32x32x16_bf16(b1, qr[d0], p1, 0, 0, 0); }
#pragma unroll
        for (int d0 = 0; d0 < 4; ++d0) {
          const bf16x8 b0 = *(const bf16x8*)(Kp + kpd[d0]), b1 = *(const bf16x8*)(Kp + kpd[d0] + 4096);
          p0 = __builtin_amdgcn_mfma_f32_32x32x16_bf16(b0, qr[8 + d0], p0, 0, 0, 0);
          p1 = __builtin_amdgcn_mfma_f32_32x32x16_bf16(b1, qr[8 + d0], p1, 0, 0, 0); }
      }
      float mn, alpha;
      partialSM(p0, p1, m_reg, mn, alpha);
      if (__any(alpha < 1.f)) {
        if (hi == 0) al_l[r32] = alpha;
        lds_wait();
#pragma unroll
        for (int dd = 0; dd < 4; ++dd)
#pragma unroll
          for (int r = 0; r < 16; ++r) o[dd][r] *= al_l[crow(r, hi)];
      }
      finishSM(p0, p1, alpha, l_reg, pa0, pa1, pa2, pa3); SBAR();
      if (!grpB) PV_ALL(vcur);
      const int vnext = vcur == 2 ? 0 : vcur + 1;
      if (j + 1 < NT) SWRITE(bb ^ 1, vnext);
      vprev = vcur; vcur = vnext;
      __syncthreads();
    }
    if (grpB) PV_ALL(vprev);
#undef PV_ALL
#undef SLOAD
#undef SWRITE
    {
      int t2 = threadIdx.x; asm volatile("" : "+v"(t2));
      const int wid2 = t2 >> 6, r2 = t2 & 31, hi2 = (t2 >> 5) & 1;
      float* li2 = (float*)(lds + 3 * SHM_V + 2 * SHM_K + 2 * SHM_KP) + wid2 * 64;
      if (hi2 == 0) li2[r2] = l_reg;
      lds_wait();
      u16* Ow = a.sg + (sbase + qb * 256 + wid2 * 32) * EI + h * 128 + r2;
#pragma unroll
      for (int r = 0; r < 16; ++r) {
        const int orow = crow(r, hi2);
        const float rl = __builtin_amdgcn_rcpf(li2[orow]);
#pragma unroll
        for (int d0 = 0; d0 < 4; ++d0) {
          u16* pp = Ow + (size_t)orow * EI + d0 * 32;
          if (!a.dry) *pp = f2bf(o[d0][r] * rl * bf2f(*pp));
        }
      }
    }
  }
}

#if MEGA
#define GRID_SYNC() gsync(p, lds)
#else
#define GRID_SYNC() do {} while (0)
#endif
struct Grp { const float* xin0; float* xres; int nseq, T; };
DEV Grp get_group(const P& p, int g) {
  Grp r;
  r.xin0 = g == 0 ? p.x_prompt : p.x_sample + (size_t)(g - 1) * GT * DM;
  r.xres = p.out + (size_t)g * GT * DM;
  r.nseq = g == 0 ? 8 : 1; r.T = g == 0 ? 2048 : 16384;
  return r;
}
template <int LT, int ph>
DEV void run_phase(const P& p, int g, int layer, char* lds) {
  const Grp G = get_group(p, g);
  const int j = layer >> 1;
  const float* xin = layer == 0 ? G.xin0 : G.xres;
  size_t zoff = 0; asm volatile("" : "+s"(zoff));
  char* ws = p.ws + zoff;
  u16* hbuf = (u16*)(ws + O_HBUF);
  u16* sg = (u16*)(ws + O_SG);
  if constexpr (LT == 0) {
    u16 *rb = (u16*)(ws + O_RB), *kb = (u16*)(ws + O_KB), *vb = (u16*)(ws + O_VB), *yf = (u16*)(ws + O_YF), *yb = (u16*)(ws + O_YB);
    u16 *twl = (u16*)(ws + O_TWL), *al = (u16*)(ws + O_AL); float* bon = (float*)(ws + O_BON);
    if constexpr (ph == 0) rms_phase(xin, p.ln_g + layer * DM, hbuf);
    else if constexpr (ph == 1) {
      GemmP q{}; q.A = hbuf; q.lda = DM; q.Bt = (const u16*)(ws + O_WRWIN) + (size_t)j * RW_N * DM; q.K = DM; q.NT = 66;
      q.mu = p.rw_mu + (size_t)j * 6 * DM; q.T = G.T; q.o0 = rb; q.o1 = kb; q.o2 = vb; q.o3 = sg; q.o4 = twl; q.o5 = al;
      lerp_phase(hbuf, q.mu, yf, G.T); GRID_SYNC();
      GemmP w = q; w.A = yf; w.astride = (size_t)GT * DM; w.NT = 32; w.nt0 = 0;
      gemm_phase<LOAD_PLAIN, EPI_RWKV, 4>(w, lds);
      q.NT = 2; q.nt0 = 64;
      gemm_phase<LOAD_LERP, EPI_RWKV, 2>(q, lds);
    } else if constexpr (ph == 2) {
      ScanP s{}; s.r = rb; s.k = kb; s.v = vb; s.twl = twl; s.al = al; s.yf = yf; s.yb = yb; s.bonus = bon;
      s.w0 = p.rw_w0 + (size_t)j * 2 * EI; s.w2 = p.rw_w2 + (size_t)j * 2 * 64 * EI; s.a0 = p.rw_a0 + (size_t)j * 2 * EI; s.a2 = p.rw_a2 + (size_t)j * 2 * 64 * EI;
      s.kk = p.rw_kk + (size_t)j * EI; s.ka = p.rw_ka + (size_t)j * EI; s.rk = p.rw_rk + (size_t)j * EI; s.nseq = G.nseq; s.T = G.T;
      s.tbuf = (float*)hbuf;
      if (G.T > 2048) {
        s.nseg = 16;
        scan_phase(s, lds, 0); GRID_SYNC();
        scan_combine_phase(s, lds); GRID_SYNC();
        scan_phase(s, lds, 1);
      } else { s.nseg = 1; scan_phase(s, lds, 1); }
    } else if constexpr (ph == 3) post_phase(yf, yb, vb, sg, bon, p.rw_lnx_g + (size_t)j * EI, p.rw_lnx_b + (size_t)j * EI);
    else {
      GemmP q{}; q.A = yf; q.lda = EI; q.Bt = (const u16*)(ws + O_WRWOUT) + (size_t)j * DM * EI; q.K = EI; q.NT = 4; q.xin = xin; q.xout = G.xres;
      for (int rep = 1; rep < REP_GEMM; ++rep) { q.dry = (gridDim.x != 12345); gemm_phase<LOAD_PLAIN, EPI_RES, 4>(q, lds); } q.dry = 0;
      gemm_phase<LOAD_PLAIN, EPI_RES, 4>(q, lds);
    }
  } else {
    float* cqkv = (float*)(ws + O_CQKV); u16 *cqn = (u16*)(ws + O_CQN), *ckvn = (u16*)(ws + O_CKVN), *kpe = (u16*)(ws + O_KPE), *qq = (u16*)(ws + O_Q), *kv = (u16*)(ws + O_KV);
    const float* ct = (const float*)(ws + O_COS); const float* st = (const float*)(ws + O_SIN);
    if constexpr (ph == 0) rms_phase(xin, p.ln_g + layer * DM, hbuf);
    else if constexpr (ph == 1) {
      GemmP q{}; q.A = hbuf; q.lda = DM; q.Bt = (const u16*)(ws + O_WMLIN) + (size_t)j * ML_NP * DM; q.K = DM; q.NT = 11; q.of = cqkv; q.o0 = sg;
      for (int rep = 1; rep < REP_GEMM; ++rep) { q.dry = (gridDim.x != 12345); gemm_phase<LOAD_PLAIN, EPI_MLAIN, 4>(q, lds); } q.dry = 0;
      gemm_phase<LOAD_PLAIN, EPI_MLAIN, 4>(q, lds);
    } else if constexpr (ph == 2) mla_mid_phase(cqkv, p.ml_qn + j * 384, p.ml_kvn + j * 256, ct, st, cqn, ckvn, kpe, G.T);
    else if constexpr (ph == 3) {
      GemmP q{}; q.A = cqn; q.lda = 384; q.Bt = (const u16*)(ws + O_WUQ) + (size_t)j * 3072 * 384; q.K = 384; q.NT = 12; q.o0 = qq; q.ldc = 3072;
      for (int rep = 1; rep < REP_GEMM; ++rep) { q.dry = (gridDim.x != 12345); gemm_phase<LOAD_PLAIN, EPI_BF16, 4>(q, lds); } q.dry = 0;
      gemm_phase<LOAD_PLAIN, EPI_BF16, 4>(q, lds);
      GemmP r{}; r.A = ckvn; r.lda = 256; r.Bt = (const u16*)(ws + O_WUKV) + (size_t)j * 4096 * 256; r.K = 256; r.NT = 16; r.o0 = kv; r.ldc = 4096;
      for (int rep = 1; rep < REP_GEMM; ++rep) { r.dry = (gridDim.x != 12345); gemm_phase<LOAD_PLAIN, EPI_BF16, 4>(r, lds); } r.dry = 0;
      gemm_phase<LOAD_PLAIN, EPI_BF16, 4>(r, lds);
    } else if constexpr (ph == 4) {
      AttnP a{}; a.q = qq; a.kv = kv; a.kpe = kpe; a.sg = sg; a.ct = ct; a.st = st; a.nseq = G.nseq; a.T = G.T;
      for (int rep = 1; rep < REP_ATTN; ++rep) { a.dry = (gridDim.x != 12345); attn_phase(a, lds); } a.dry = 0;
      attn_phase(a, lds);
    } else {
      GemmP q{}; q.A = sg; q.lda = EI; q.Bt = (const u16*)(ws + O_WMLOUT) + (size_t)j * DM * EI; q.K = EI; q.NT = 4; q.xin = xin; q.xout = G.xres;
      for (int rep = 1; rep < REP_GEMM; ++rep) { q.dry = (gridDim.x != 12345); gemm_phase<LOAD_PLAIN, EPI_RES, 4>(q, lds); } q.dry = 0;
      gemm_phase<LOAD_PLAIN, EPI_RES, 4>(q, lds);
    }
  }
}


template <int LT, int PH>
__global__ __launch_bounds__(512) void k_phase(P p, int g, int layer) {
  extern __shared__ __attribute__((aligned(16))) char lds[];
  if constexpr (LT == 2) { if constexpr (PH == 0) init_phase(p, lds); else final_phase(p.out, p.final_g); }
  else run_phase<LT, PH>(p, g, layer, lds);
}

#if MEGA
__global__ __launch_bounds__(512) void k_mega(P p) {
  extern __shared__ __attribute__((aligned(16))) char lds[];
  cg::grid_group grid = cg::this_grid();
  {
    unsigned* bar = (unsigned*)(p.ws + O_BAR);
    if (blockIdx.x == 0) for (int i = threadIdx.x; i < XCD_BAR_WORDS; i += 512) bar[i] = 0u;
    if (threadIdx.x == 0) { volatile LAS unsigned* st = (volatile LAS unsigned*)(lds + SHM_BYTES - 16); st[0] = 0u; st[1] = 0u; }
  }
  init_phase(p, lds);
  grid.sync();
  if (threadIdx.x == 0) (void)xb_add(&((unsigned*)(p.ws + O_BAR))[XB_XCNT(xb_xcc_id())], 1u);
  for (int g = 0; g < 3; ++g)
    for (int layer = 0; layer < 4; ++layer) {
      if ((layer & 1) == 0) {
        run_phase<0, 0>(p, g, layer, lds); gsync(p, lds); run_phase<0, 1>(p, g, layer, lds); gsync(p, lds); run_phase<0, 2>(p, g, layer, lds); gsync(p, lds);
        run_phase<0, 3>(p, g, layer, lds); gsync(p, lds); run_phase<0, 4>(p, g, layer, lds); gsync(p, lds);
      } else {
        run_phase<1, 0>(p, g, layer, lds); gsync(p, lds); run_phase<1, 1>(p, g, layer, lds); gsync(p, lds); run_phase<1, 2>(p, g, layer, lds); gsync(p, lds);
        run_phase<1, 3>(p, g, layer, lds); gsync(p, lds); run_phase<1, 4>(p, g, layer, lds); gsync(p, lds); run_phase<1, 5>(p, g, layer, lds); gsync(p, lds);
      }
    }
  final_phase(p.out, p.final_g);
}
#endif

extern "C" void kernel_launch(void* const* d_in, const int* in_sizes, int n_in, void* d_out, int out_size, void* d_ws, size_t ws_size, hipStream_t stream) {
  if (n_in != 22 || ws_size < WS_NEED) { fprintf(stderr, "kernel_launch: bad args n_in %d ws %zu need %zu\n", n_in, ws_size, WS_NEED); return; }
  P p{};
  const float** f = (const float**)&p;
  for (int i = 0; i < 22; ++i) f[i] = (const float*)d_in[i];
  p.out = (float*)d_out; p.ws = (char*)d_ws;
#if MEGA
  static int grid_blocks = 0;
  if (!grid_blocks) {
    hipFuncSetAttribute((const void*)k_mega, hipFuncAttributeMaxDynamicSharedMemorySize, SHM_BYTES);
    int dev = 0, cus = 0, per_cu = 0;
    hipGetDevice(&dev);
    hipDeviceGetAttribute(&cus, hipDeviceAttributeMultiprocessorCount, dev);
    hipOccupancyMaxActiveBlocksPerMultiprocessor(&per_cu, k_mega, 512, SHM_BYTES);
    if (per_cu > 1) per_cu = 1;
    grid_blocks = cus * per_cu;
  }
  void* args[] = {&p};
  hipError_t e = hipLaunchCooperativeKernel((void*)k_mega, dim3(grid_blocks), dim3(512), args, SHM_BYTES, stream);
  if (e != hipSuccess) fprintf(stderr, "cooperative launch failed: %s (grid %d)\n", hipGetErrorString(e), grid_blocks);
#else
  const int NB = 256;
#define LAUNCH(LT, PH, g, layer) do { static int inited = 0; if (!inited) { hipFuncSetAttribute((const void*)k_phase<LT, PH>, hipFuncAttributeMaxDynamicSharedMemorySize, SHM_BYTES); inited = 1; } \
    hipLaunchKernelGGL((k_phase<LT, PH>), dim3(NB), dim3(512), SHM_BYTES, stream, p, g, layer); } while (0)
  LAUNCH(2, 0, 0, 0);
  for (int g = 0; g < 3; ++g)
    for (int layer = 0; layer < 4; ++layer) {
      if ((layer & 1) == 0) { LAUNCH(0, 0, g, layer); LAUNCH(0, 1, g, layer); LAUNCH(0, 2, g, layer); LAUNCH(0, 3, g, layer); LAUNCH(0, 4, g, layer); }
      else { LAUNCH(1, 0, g, layer); LAUNCH(1, 1, g, layer); LAUNCH(1, 2, g, layer); LAUNCH(1, 3, g, layer); LAUNCH(1, 4, g, layer); LAUNCH(1, 5, g, layer); }
    }
  LAUNCH(2, 1, 0, 0);
#endif
}
```

```cpp
#include <hip/hip_runtime.h>
#include <hip/hip_bf16.h>
#include <hip/hip_cooperative_groups.h>
#include <cstdio>
namespace cg = cooperative_groups;

#ifndef REP_GEMM
#define REP_GEMM 1
#endif
#ifndef REP_ATTN
#define REP_ATTN 1
#endif
#ifndef REP_SCAN
#define REP_SCAN 1
#endif
#ifndef MEGA
#define MEGA 1
#endif

typedef unsigned short u16;
using bf16x8 = __attribute__((ext_vector_type(8))) short;
using s16x4  = __attribute__((ext_vector_type(4))) short;
using f32x16 = __attribute__((ext_vector_type(16))) float;
using f32x4  = __attribute__((ext_vector_type(4))) float;
using u32x4  = __attribute__((ext_vector_type(4))) unsigned;
using u32x2  = __attribute__((ext_vector_type(2))) unsigned;
#define DEV __device__ __forceinline__
#define SBAR() __builtin_amdgcn_sched_barrier(0)

constexpr int DM = 1024, EI = 2048, GT = 16384;
constexpr int NTOK = 49152;
constexpr int RW_N = 8448, ML_N = 2752, ML_NP = 2816;
constexpr int SHM_BYTES = 158720;

constexpr size_t alup(size_t x) { return (x + 255) / 256 * 256; }
constexpr size_t O_WRWIN  = 0;
constexpr size_t O_WRWOUT = O_WRWIN  + alup((size_t)2 * RW_N * DM * 2);
constexpr size_t O_WMLIN  = O_WRWOUT + alup((size_t)2 * DM * EI * 2);
constexpr size_t O_WUQ    = O_WMLIN  + alup((size_t)2 * ML_NP * DM * 2);
constexpr size_t O_WUKV   = O_WUQ    + alup((size_t)2 * 3072 * 384 * 2);
constexpr size_t O_WMLOUT = O_WUKV   + alup((size_t)2 * 4096 * 256 * 2);
constexpr size_t O_COS    = O_WMLOUT + alup((size_t)2 * DM * EI * 2);
constexpr size_t O_SIN    = O_COS    + alup((size_t)16384 * 32 * 4);
constexpr size_t O_HBUF   = O_SIN    + alup((size_t)16384 * 32 * 4);
constexpr size_t O_R0     = O_HBUF   + alup((size_t)GT * DM * 2);
constexpr size_t SZ_E = (size_t)GT * EI * 2;
constexpr size_t O_SG   = O_R0;
constexpr size_t O_RB   = O_SG + SZ_E;
constexpr size_t O_KB   = O_RB + SZ_E;
constexpr size_t O_VB   = O_KB + SZ_E;
constexpr size_t O_YF   = O_VB + SZ_E;
constexpr size_t O_YB   = O_YF + SZ_E;
constexpr size_t O_TWL  = O_YB + SZ_E;
constexpr size_t O_AL   = O_TWL + alup((size_t)GT * 128 * 2);
constexpr size_t O_BON  = O_AL  + alup((size_t)GT * 128 * 2);
constexpr size_t O_RW_END = O_BON + alup((size_t)GT * 64 * 4);
constexpr size_t O_CQKV = O_SG + SZ_E;
constexpr size_t O_CQN  = O_CQKV + alup((size_t)GT * 704 * 4);
constexpr size_t O_CKVN = O_CQN  + alup((size_t)GT * 384 * 2);
constexpr size_t O_KPE  = O_CKVN + alup((size_t)GT * 256 * 2);
constexpr size_t O_Q    = O_KPE  + alup((size_t)GT * 64 * 2);
constexpr size_t O_KV   = O_Q    + alup((size_t)GT * 3072 * 2);
constexpr size_t O_ML_END = O_KV + alup((size_t)GT * 4096 * 2);
constexpr size_t O_FLAG = O_RW_END > O_ML_END ? O_RW_END : O_ML_END;
constexpr size_t O_BAR = O_FLAG + 256;
constexpr size_t WS_NEED = O_BAR + 16384;

struct P {
  const float* x_prompt; const float* x_sample; const float* ln_g; const float* final_g;
  const float* rw_mu; const float* rw_in; const float* rw_w0; const float* rw_w2; const float* rw_a0; const float* rw_a2;
  const float* rw_kk; const float* rw_ka; const float* rw_rk; const float* rw_lnx_g; const float* rw_lnx_b; const float* rw_out;
  const float* ml_in; const float* ml_qn; const float* ml_kvn; const float* ml_uq; const float* ml_ukv; const float* ml_out;
  float* out; char* ws;
};

typedef __attribute__((ext_vector_type(2))) __bf16 bf16x2_t;
typedef __attribute__((ext_vector_type(2))) float f32x2_t;
DEV unsigned cvtpk(float lo, float hi) { f32x2_t v = {lo, hi}; bf16x2_t b = __builtin_convertvector(v, bf16x2_t); return __builtin_bit_cast(unsigned, b); }
DEV float bf2f(u16 x) { return __uint_as_float(((unsigned)x) << 16); }
DEV float bflo(unsigned x) { return __uint_as_float(x << 16); }
DEV float bfhi(unsigned x) { return __uint_as_float(x & 0xffff0000u); }
DEV u16 f2bf(float x) { __bf16 b = (__bf16)x; return __builtin_bit_cast(u16, b); }
DEV float wsum(float v) {
#pragma unroll
  for (int o = 32; o >= 1; o >>= 1) v += __shfl_xor(v, o, 64);
  return v;
}
DEV float siluf(float x) { return x / (1.f + __expf(-x)); }
DEV int crow(int r, int hi) { return (r & 3) + 8 * (r >> 2) + 4 * hi; }
DEV int ltid() { int t = threadIdx.x; asm volatile("" : "+v"(t)); return t; }
template <typename T> DEV T gld(size_t base, unsigned off) { return *(const __attribute__((address_space(1))) T*)(base + off); }
template <typename T> DEV void gst(size_t base, unsigned off, T v) { *(__attribute__((address_space(1))) T*)(base + off) = v; }
DEV void lds_wait() { asm volatile("s_waitcnt lgkmcnt(0)" ::: "memory"); }


#define XB_TMO      128
#define XB_XCNT(j)  (256  + 64 * (j))
#define XB_XSUB(j)  (1280 + 64 * (j))
#define XB_XGEN(j)  (2304 + 64 * (j))
#define XB_TOP      3328
#define XB_TOPGEN   3392
#define XCD_BAR_WORDS 3456
#define XB_SPIN_CAP (1u << 22)
#define LAS __attribute__((address_space(3)))
DEV unsigned xb_ld(unsigned* p)              { return __hip_atomic_load(p, __ATOMIC_RELAXED, __HIP_MEMORY_SCOPE_AGENT); }
DEV unsigned xb_add(unsigned* p, unsigned v) { return __hip_atomic_fetch_add(p, v, __ATOMIC_RELAXED, __HIP_MEMORY_SCOPE_AGENT); }
DEV unsigned xb_xcc_id() { return (unsigned)__builtin_amdgcn_s_getreg((3 << 11) | 20) & 0xFu; }
#define XB_SPIN(cond, bar) do { unsigned _sp = 0; while (cond) { __builtin_amdgcn_s_sleep(1); \
    if ((++_sp & 255u) == 0u) { if (xb_ld(&(bar)[XB_TMO])) break; if (_sp > XB_SPIN_CAP) { atomicAdd(&(bar)[XB_TMO], 1u); break; } } } } while (0)
struct XcdBarrier { unsigned* bar; unsigned x; volatile LAS unsigned* st; };
DEV void xcd_barrier_complete(unsigned* bar, unsigned x, unsigned& nloc, unsigned& nx) {
  const unsigned G = gridDim.x * gridDim.y * gridDim.z;
  unsigned sum, cnt, mine, sp = 0u;
  for (;;) {
    sum = 0u; cnt = 0u; mine = 0u;
#pragma unroll
    for (unsigned j = 0; j < 16; ++j) { const unsigned c = xb_ld(&bar[XB_XCNT(j)]); sum += c; cnt += (c > 0u) ? 1u : 0u; mine = (j == x) ? c : mine; }
    if (sum == G) break;
    __builtin_amdgcn_s_sleep(1);
    if ((++sp & 255u) == 0u) { if (xb_ld(&bar[XB_TMO])) break; if (sp > XB_SPIN_CAP) { atomicAdd(&bar[XB_TMO], 1u); break; } }
  }
  nloc = mine > 0u ? mine : 1u; nx = cnt > 0u ? cnt : 1u;
}
DEV void xcd_barrier(const XcdBarrier& b) {
  asm volatile("s_waitcnt vmcnt(0)" ::: "memory");
  __syncthreads();
  if (threadIdx.x == 0) {
    unsigned* bar = b.bar;
    __builtin_amdgcn_s_waitcnt(0);
    unsigned nloc = b.st[0], nx = b.st[1];
    if (nloc == 0u) { xcd_barrier_complete(bar, b.x, nloc, nx); b.st[0] = nloc; b.st[1] = nx; }
    const unsigned old = xb_add(&bar[XB_XSUB(b.x)], 1u);
    const unsigned gen = old / nloc;
    if (old + 1u == (gen + 1u) * nloc) {
      __builtin_amdgcn_fence(__ATOMIC_RELEASE, "agent");
      asm volatile("s_waitcnt vmcnt(0)" ::: "memory");
      const unsigned og = xb_add(&bar[XB_TOP], 1u);
      const unsigned tg = og / nx;
      if (og + 1u == (tg + 1u) * nx) xb_add(&bar[XB_TOPGEN], 1u);
      else XB_SPIN(xb_ld(&bar[XB_TOPGEN]) == tg, bar);
      __builtin_amdgcn_fence(__ATOMIC_ACQUIRE, "agent");
      xb_add(&bar[XB_XGEN(b.x)], 1u);
      asm volatile("s_waitcnt vmcnt(0)" ::: "memory");
    } else {
      XB_SPIN(xb_ld(&bar[XB_XGEN(b.x)]) == gen, bar);
      __builtin_amdgcn_fence(__ATOMIC_ACQUIRE, "agent");
      asm volatile("s_waitcnt vmcnt(0)" ::: "memory");
    }
  }
  __syncthreads();
}
DEV void gsync(const P& p, char* lds) {
  XcdBarrier b; b.bar = (unsigned*)(p.ws + O_BAR); b.x = xb_xcc_id(); b.st = (volatile LAS unsigned*)(lds + SHM_BYTES - 16);
  xcd_barrier(b);
}

DEV void convert_T(const float* __restrict__ src, u16* __restrict__ dst, int K, int N, int Npad, char* lds_) {
  float* lds = (float*)lds_;
  const int tid = ltid(), tk = K / 64, tn = Npad / 64;
  for (int t = blockIdx.x; t < tk * tn; t += gridDim.x) {
    const int k0 = (t % tk) * 64, n0 = (t / tk) * 64;
    __syncthreads();
#pragma unroll
    for (int i = 0; i < 2; ++i) {
      const int kr = (tid >> 4) + i * 32, c = (tid & 15) * 4;
      float4 v = make_float4(0.f, 0.f, 0.f, 0.f);
      if (n0 + c < N) v = *(const float4*)(src + (long)(k0 + kr) * N + n0 + c);
      lds[kr * 65 + c + 0] = v.x; lds[kr * 65 + c + 1] = v.y; lds[kr * 65 + c + 2] = v.z; lds[kr * 65 + c + 3] = v.w;
    }
    __syncthreads();
    const int n = tid >> 3, kc = (tid & 7) * 8;
    u32x4 w;
    w[0] = cvtpk(lds[(kc + 0) * 65 + n], lds[(kc + 1) * 65 + n]);
    w[1] = cvtpk(lds[(kc + 2) * 65 + n], lds[(kc + 3) * 65 + n]);
    w[2] = cvtpk(lds[(kc + 4) * 65 + n], lds[(kc + 5) * 65 + n]);
    w[3] = cvtpk(lds[(kc + 6) * 65 + n], lds[(kc + 7) * 65 + n]);
    *(u32x4*)(dst + (long)(n0 + n) * K + k0 + kc) = w;
  }
}

DEV void init_phase(const P& p, char* lds) {
  for (int j = 0; j < 2; ++j) {
    convert_T(p.rw_in  + (size_t)j * DM * RW_N, (u16*)(p.ws + O_WRWIN)  + (size_t)j * RW_N * DM, DM, RW_N, RW_N, lds);
    convert_T(p.rw_out + (size_t)j * EI * DM,   (u16*)(p.ws + O_WRWOUT) + (size_t)j * DM * EI,   EI, DM, DM, lds);
    convert_T(p.ml_in  + (size_t)j * DM * ML_N, (u16*)(p.ws + O_WMLIN)  + (size_t)j * ML_NP * DM, DM, ML_N, ML_NP, lds);
    convert_T(p.ml_uq  + (size_t)j * 384 * 3072, (u16*)(p.ws + O_WUQ)   + (size_t)j * 3072 * 384, 384, 3072, 3072, lds);
    convert_T(p.ml_ukv + (size_t)j * 256 * 4096, (u16*)(p.ws + O_WUKV)  + (size_t)j * 4096 * 256, 256, 4096, 4096, lds);
    convert_T(p.ml_out + (size_t)j * EI * DM,   (u16*)(p.ws + O_WMLOUT) + (size_t)j * DM * EI,   EI, DM, DM, lds);
  }
  float* ct = (float*)(p.ws + O_COS); float* st = (float*)(p.ws + O_SIN);
  const int tid_ = ltid();
  for (int i = blockIdx.x * 512 + tid_; i < 16384 * 32; i += gridDim.x * 512) {
    const int pos = i >> 5, j = i & 31;
    const float invf = 1.0f / powf(10000.0f, (float)(2 * j) / 64.0f);
    const float ang = (float)pos * invf;
    const double a = (double)ang;
    const double n = rint(a * 0.15915494309189535);
    const float r = (float)(a - n * 6.283185307179586);
    ct[i] = cosf(r); st[i] = sinf(r);
  }
}

DEV void rms_phase(const float* __restrict__ x, const float* __restrict__ g, u16* __restrict__ hout) {
  const int tid_ = ltid(); const int lane = tid_ & 63, wid = __builtin_amdgcn_readfirstlane(tid_ >> 6);
  for (int tok = blockIdx.x * 8 + wid; tok < GT; tok += gridDim.x * 8) {
    const float4* xr = (const float4*)(x + (size_t)tok * DM);
    float4 v[4]; float ss = 0.f;
#pragma unroll
    for (int i = 0; i < 4; ++i) { v[i] = xr[lane + i * 64]; ss += v[i].x * v[i].x + v[i].y * v[i].y + v[i].z * v[i].z + v[i].w * v[i].w; }
    ss = wsum(ss);
    const float sc = rsqrtf(ss * (1.f / DM) + 1e-6f);
#pragma unroll
    for (int i = 0; i < 4; ++i) {
      const float4 gg = ((const float4*)g)[lane + i * 64];
      u32x2 w; w[0] = cvtpk(v[i].x * sc * gg.x, v[i].y * sc * gg.y); w[1] = cvtpk(v[i].z * sc * gg.z, v[i].w * sc * gg.w);
      *(u32x2*)(hout + (size_t)tok * DM + (lane + i * 64) * 4) = w;
    }
  }
}

DEV void final_phase(float* __restrict__ x, const float* __restrict__ g) {
  const int tid_ = ltid(); const int lane = tid_ & 63, wid = __builtin_amdgcn_readfirstlane(tid_ >> 6);
  for (int tok = blockIdx.x * 8 + wid; tok < NTOK; tok += gridDim.x * 8) {
    float4* xr = (float4*)(x + (size_t)tok * DM);
    float4 v[4]; float ss = 0.f;
#pragma unroll
    for (int i = 0; i < 4; ++i) { v[i] = xr[lane + i * 64]; ss += v[i].x * v[i].x + v[i].y * v[i].y + v[i].z * v[i].z + v[i].w * v[i].w; }
    ss = wsum(ss);
    const float sc = rsqrtf(ss * (1.f / DM) + 1e-6f);
#pragma unroll
    for (int i = 0; i < 4; ++i) {
      const float4 gg = ((const float4*)g)[lane + i * 64];
      float4 ov = make_float4(v[i].x * sc * gg.x, v[i].y * sc * gg.y, v[i].z * sc * gg.z, v[i].w * sc * gg.w);
      xr[lane + i * 64] = ov;
    }
  }
}


DEV void lerp_phase(const u16* __restrict__ h, const float* __restrict__ mu, u16* __restrict__ out, int T) {
  const int tid_ = ltid(); const int lane = tid_ & 63, wid = __builtin_amdgcn_readfirstlane(tid_ >> 6);
  for (int tok = blockIdx.x * 8 + wid; tok < GT; tok += gridDim.x * 8) {
    const int pos = tok % T;
#pragma unroll
    for (int half = 0; half < 2; ++half) {
      const int c0 = half * 512 + lane * 8;
      const u32x4 c = *(const u32x4*)(h + (size_t)tok * DM + c0);
      u32x4 pv = {0u, 0u, 0u, 0u}, nx = {0u, 0u, 0u, 0u};
      if (pos > 0) pv = *(const u32x4*)(h + (size_t)(tok - 1) * DM + c0);
      if (pos < T - 1) nx = *(const u32x4*)(h + (size_t)(tok + 1) * DM + c0);
      float hh[8], xx[8];
#pragma unroll
      for (int e = 0; e < 4; ++e) {
        hh[2 * e] = bflo(c[e]); hh[2 * e + 1] = bfhi(c[e]);
        xx[2 * e] = 0.5f * (bflo(pv[e]) + bflo(nx[e])) - hh[2 * e]; xx[2 * e + 1] = 0.5f * (bfhi(pv[e]) + bfhi(nx[e])) - hh[2 * e + 1];
      }
#pragma unroll
      for (int st = 0; st < 4; ++st) {
        const int mi = st == 0 ? 0 : st == 1 ? 2 : st == 2 ? 3 : 5;
        const float4 m0v = *(const float4*)(mu + mi * DM + c0), m1v = *(const float4*)(mu + mi * DM + c0 + 4);
        const float m[8] = {m0v.x, m0v.y, m0v.z, m0v.w, m1v.x, m1v.y, m1v.z, m1v.w};
        u32x4 o;
#pragma unroll
        for (int e = 0; e < 4; ++e) o[e] = cvtpk(hh[2 * e] + m[2 * e] * xx[2 * e], hh[2 * e + 1] + m[2 * e + 1] * xx[2 * e + 1]);
        *(u32x4*)(out + (size_t)st * GT * DM + (size_t)tok * DM + c0) = o;
      }
    }
  }
}

#define GSWZ(row, c16) ((row) * 128 + ((((c16) ^ ((row) >> 1)) & 7) << 4))
constexpr int LOAD_PLAIN = 0, LOAD_LERP = 1;
constexpr int EPI_RWKV = 0, EPI_RES = 1, EPI_MLAIN = 2, EPI_BF16 = 3;
struct GemmP {
  const u16* A; int lda; const u16* Bt; int K; int NT;
  const float* mu;
  int T;
  u16* o0; u16* o1; u16* o2; u16* o3; u16* o4; u16* o5;
  int ldc;
  float* of; const float* xin; float* xout; int dry;
  int nt0; size_t astride;
};

template <int LOAD, int EPI, int NI>
DEV void gemm_phase(const GemmP& g, char* lds) {
  constexpr int BN = 64 * NI, SBB = BN * 128;
  const int tid = ltid(), wid = __builtin_amdgcn_readfirstlane(tid >> 6), lane = tid & 63, r32 = lane & 31, hi = lane >> 5;
  const int wm = wid >> 1, wn = wid & 1;
  char* sA = lds; char* sB = lds + 65536;
  int Kv = g.K; asm volatile("" : "+s"(Kv));
  const int nk = Kv / 64, ntiles = 64 * g.NT;
  const int c16 = tid & 7, rowb = tid >> 3;
  for (int t = blockIdx.x; t < ntiles; t += gridDim.x) {
    const int mt = t & 63, nt = g.nt0 + (t >> 6), m0 = mt * 256, n0 = nt * BN;
    const u16* Ab = g.A + (size_t)(n0 >> 11) * g.astride;
    f32x16 acc[2][NI] = {};
    bf16x8 ra[4], rb[NI];
    const float* mup = nullptr;
    if constexpr (LOAD == LOAD_LERP) {
      const int s = n0 < 2048 ? 0 : n0 < 4096 ? 2 : n0 < 6144 ? 3 : n0 < 8192 ? 5 : n0 == 8192 ? 1 : 4;
      mup = g.mu + s * DM;
    }
    auto gload = [&](int kt) {
      const int k0 = kt * 64 + c16 * 8;
#pragma unroll
      for (int i = 0; i < 4; ++i) {
        const int row = rowb + i * 64; const size_t tok = (size_t)(m0 + row);
        if constexpr (LOAD == LOAD_PLAIN) {
          ra[i] = *(const bf16x8*)(Ab + tok * g.lda + k0);
        } else {
          const int pos = (int)(tok % (size_t)g.T);
          const u32x4 c = *(const u32x4*)(g.A + tok * DM + k0);
          u32x4 pv = {0u, 0u, 0u, 0u}, nx = {0u, 0u, 0u, 0u};
          if (pos > 0) pv = *(const u32x4*)(g.A + (tok - 1) * DM + k0);
          if (pos < g.T - 1) nx = *(const u32x4*)(g.A + (tok + 1) * DM + k0);
          const float4 m0v = *(const float4*)(mup + k0), m1v = *(const float4*)(mup + k0 + 4);
          const float mu[8] = {m0v.x, m0v.y, m0v.z, m0v.w, m1v.x, m1v.y, m1v.z, m1v.w};
          u32x4 o;
#pragma unroll
          for (int e = 0; e < 4; ++e) {
            const float h0 = bflo(c[e]), h1 = bfhi(c[e]);
            const float x0 = 0.5f * (bflo(pv[e]) + bflo(nx[e])) - h0, x1 = 0.5f * (bfhi(pv[e]) + bfhi(nx[e])) - h1;
            o[e] = cvtpk(h0 + mu[2 * e] * x0, h1 + mu[2 * e + 1] * x1);
          }
          ra[i] = *(bf16x8*)&o;
        }
      }
#pragma unroll
      for (int i = 0; i < NI; ++i) {
        const int row = rowb + i * 64;
        rb[i] = *(const bf16x8*)(g.Bt + (size_t)(n0 + row) * Kv + k0);
      }
    };
    auto swrite = [&](int b) {
#pragma unroll
      for (int i = 0; i < 4; ++i) { const int row = rowb + i * 64; *(bf16x8*)(sA + b * 32768 + GSWZ(row, c16)) = ra[i]; }
#pragma unroll
      for (int i = 0; i < NI; ++i) { const int row = rowb + i * 64; *(bf16x8*)(sB + b * SBB + GSWZ(row, c16)) = rb[i]; }
    };
    gload(0); swrite(0); __syncthreads();
    for (int kt = 0; kt < nk; ++kt) {
      const int b = kt & 1;
      if (kt + 1 < nk) gload(kt + 1);
      const char* a_ = sA + b * 32768; const char* b_ = sB + b * SBB;
#pragma unroll
      for (int ks = 0; ks < 4; ++ks) {
        bf16x8 af[2], bfr[NI];
#pragma unroll
        for (int mi = 0; mi < 2; ++mi) { const int row = wm * 64 + mi * 32 + r32; af[mi] = *(const bf16x8*)(a_ + GSWZ(row, ks * 2 + hi)); }
#pragma unroll
        for (int ni = 0; ni < NI; ++ni) { const int row = wn * (32 * NI) + ni * 32 + r32; bfr[ni] = *(const bf16x8*)(b_ + GSWZ(row, ks * 2 + hi)); }
#pragma unroll
        for (int mi = 0; mi < 2; ++mi)
#pragma unroll
          for (int ni = 0; ni < NI; ++ni) acc[mi][ni] = __builtin_amdgcn_mfma_f32_32x32x16_bf16(af[mi], bfr[ni], acc[mi][ni], 0, 0, 0);
      }
      if (kt + 1 < nk) swrite(b ^ 1);
      __syncthreads();
    }
    if (!g.dry)
#pragma unroll
    for (int mi = 0; mi < 2; ++mi)
#pragma unroll
      for (int ni = 0; ni < NI; ++ni)
#pragma unroll
        for (int r = 0; r < 16; ++r) {
          const size_t m = (size_t)(m0 + wm * 64 + mi * 32 + crow(r, hi));
          const int nl = wn * (32 * NI) + ni * 32 + r32, n = n0 + nl;
          const float v = acc[mi][ni][r];
          if constexpr (EPI == EPI_RWKV) {
            if (n0 < 8192) {
              const int which = n0 >> 11, col = n & 2047;
              u16* dst = which == 0 ? g.o0 : which == 1 ? g.o1 : which == 2 ? g.o2 : g.o3;
              dst[m * EI + col] = f2bf(which == 3 ? siluf(v) : v);
            } else if (n0 == 8192) g.o4[m * 128 + nl] = f2bf(tanhf(v));
            else g.o5[m * 128 + nl] = f2bf(v);
          } else if constexpr (EPI == EPI_RES) {
            g.xout[m * DM + n] = g.xin[m * DM + n] + v;
          } else if constexpr (EPI == EPI_MLAIN) {
            if (n < 704) g.of[m * 704 + n] = v;
            else if (n < ML_N) g.o0[m * EI + (n - 704)] = f2bf(siluf(v));
          } else {
            g.o0[m * g.ldc + n] = f2bf(v);
          }
        }
  }
}

struct ScanP {
  const u16 *r, *k, *v, *twl, *al; u16 *yf, *yb; float* bonus;
  const float *w0, *w2, *a0, *a2, *kk, *ka, *rk;
  int nseq, T;
  float* tbuf; int nseg;
};
template <int CTRL> DEV float dppf(float x) {
  return __int_as_float(__builtin_amdgcn_update_dpp(0, __float_as_int(x), CTRL, 0xF, 0xF, false));
}
DEV float row_prefix16(float x) {
  x += dppf<0x111>(x); x += dppf<0x112>(x); x += dppf<0x114>(x); x += dppf<0x118>(x); return x;
}
DEV float row_total16(float x) {
  x += dppf<0x128>(x); x += dppf<0x124>(x); x += dppf<0x122>(x); x += dppf<0x121>(x); return x;
}
DEV bf16x8 pack8(float a0, float a1, float a2, float a3, float a4, float a5, float a6, float a7) {
  u32x4 w = {cvtpk(a0, a1), cvtpk(a2, a3), cvtpk(a4, a5), cvtpk(a6, a7)}; return *(bf16x8*)&w;
}
constexpr int SC_BKT = 0, SC_UVT = 5120, SC_AKM = 10240, SC_RR = 10752, SC_ABF = 11776, SC_Z = 12800, SC_PRM = 17152, SC_T = 18944, SC_WAVE = 35328;
constexpr int SC_PRE = SC_UVT;
constexpr int SC_SHARED_AW = 4 * SC_WAVE;
constexpr int SC_NW = 4;
DEV void scan_phase(const ScanP& s, char* lds_, const int pass) {
  const int tid = ltid(), wid = __builtin_amdgcn_readfirstlane(tid >> 6), lane = tid & 63, c16 = lane & 15, q = lane >> 4;
  const int nchain = s.nseq * 64, nseg = s.nseg;
  const int ipc = pass == 0 ? nseg * 2 : nseg;
  const bool shared = nchain <= (int)gridDim.x;
  const int nsb = shared ? (int)gridDim.x / nchain : 1, sbi = shared ? (int)blockIdx.x / nchain : 0;
  const int nwv = shared ? SC_NW : 2;
  if (shared && sbi >= nsb) return;
  char* wl = lds_ + (wid & 3) * SC_WAVE;
  u16* bkt = (u16*)(wl + SC_BKT); u16* uvt = (u16*)(wl + SC_UVT); u16* akm = (u16*)(wl + SC_AKM); u16* rr = (u16*)(wl + SC_RR);
  float* abf = (float*)(wl + SC_ABF); float* zl = (float*)(wl + SC_Z); float* prm = (float*)(wl + SC_PRM); float* p15l = prm + 320;
  bf16x8* awl = (bf16x8*)(shared ? lds_ + SC_SHARED_AW : lds_ + (2 + (wid & 1)) * SC_WAVE); bf16x8* aal = awl + 512;
#define SCAN_LOAD_W(CHAIN, F0, F1) do { const int d_ = (CHAIN) & 1, h_ = ((CHAIN) >> 1) & 31; \
    for (int f = (F0); f < (F1); ++f) { const int ks = f >> 2, mt = f & 3; u32x4 pw, pa; \
      _Pragma("unroll") for (int e = 0; e < 4; ++e) { const int l0 = ks * 32 + q * 8 + 2 * e; \
        const size_t i0 = ((size_t)(d_ * 64 + l0)) * EI + h_ * 64 + mt * 16 + c16; \
        pw[e] = cvtpk(s.w2[i0], s.w2[i0 + EI]); pa[e] = cvtpk(s.a2[i0], s.a2[i0 + EI]); } \
      awl[f * 64 + lane] = *(bf16x8*)&pw; aal[f * 64 + lane] = *(bf16x8*)&pa; } } while (0)
  if (shared) {
    const int chain_b = (int)blockIdx.x % nchain;
    SCAN_LOAD_W(chain_b, wid, wid + 1);
    __syncthreads();
  }
  if (wid >= nwv) return;
  const int nrounds = shared ? (ipc + nsb * SC_NW - 1) / (nsb * SC_NW) : (nchain + 2 * (int)gridDim.x - 1) / (2 * (int)gridDim.x);
  for (int round = 0; round < nrounds; ++round) {
    const int chain = shared ? (int)blockIdx.x % nchain : (round * 2 + wid) * (int)gridDim.x + (int)blockIdx.x;
    const int it = shared ? sbi * SC_NW + wid + round * nsb * SC_NW : 0;
    if (chain >= nchain || it >= ipc) continue;
    const int kind = pass == 0 ? 1 + (it & 1) : 0;
    const int seg = pass == 0 ? it >> 1 : it;
    const int cs = chain * nseg + seg;
    const int d = chain & 1, h = (chain >> 1) & 31, b = chain >> 6;
    {
      const int ch = h * 64 + lane;
      lds_wait();
      prm[lane] = s.w0[d * EI + ch]; prm[64 + lane] = s.a0[d * EI + ch]; prm[128 + lane] = s.kk[ch]; prm[192 + lane] = s.ka[ch]; prm[256 + lane] = s.rk[ch];
      lds_wait();
    }
    if (!shared) { SCAN_LOAD_W(chain, 0, 8); lds_wait(); }
    const unsigned rowi = (unsigned)(d ? 15 - c16 : c16);
    const unsigned off_tw = rowi * 256u + (unsigned)(q * 16);
    const unsigned off_kr = rowi * 4096u + (unsigned)(h * 128 + q * 8);
    const unsigned off_v  = (unsigned)(h * 128 + lane * 2);
    const unsigned off_y0 = (unsigned)(d ? 15 - 4 * q : 4 * q) * 4096u + (unsigned)(h * 128 + c16 * 2);
    const int ystep = d ? -4096 : 4096;
    f32x4* Tl = (f32x4*)(wl + SC_T);
#pragma unroll
    for (int m = 0; m < 16; ++m) {
      f32x4 t0v = {0.f, 0.f, 0.f, 0.f};
      if (kind == 2) {
        const int mt = m >> 2, nt = m & 3;
        if (mt == nt) { t0v[0] = (4 * q + 0 == c16) ? 1.f : 0.f; t0v[1] = (4 * q + 1 == c16) ? 1.f : 0.f; t0v[2] = (4 * q + 2 == c16) ? 1.f : 0.f; t0v[3] = (4 * q + 3 == c16) ? 1.f : 0.f; }
      } else if (kind == 0 && nseg > 1) {
        t0v = *(const f32x4*)(s.tbuf + ((size_t)cs * 2) * 4096 + (m * 64 + lane) * 4);
      }
      Tl[m * 64 + lane] = t0v;
    }
    u16* yout = d ? s.yb : s.yf;
    const size_t sb = (size_t)b * s.T;
    const int cps = s.T / 16 / nseg, cbeg = seg * cps, cend = cbeg + cps;
    bf16x8 n_tw0, n_tw1, n_ta0, n_ta1; u32x2 n_k[4], n_r[4];
#define SCAN_LOAD(CC) do { const int c0n = d ? (s.T - 16 - (CC) * 16) : (CC) * 16; const size_t t0n = sb + c0n; \
      size_t p_tw = (size_t)s.twl + t0n * 256 + d * 128, p_al = (size_t)s.al + t0n * 256 + d * 128, p_k = (size_t)s.k + t0n * 4096, p_r = (size_t)s.r + t0n * 4096 ; \
      asm volatile("" : "+s"(p_tw), "+s"(p_al), "+s"(p_k), "+s"(p_r)); \
      n_tw0 = gld<bf16x8>(p_tw, off_tw); n_tw1 = gld<bf16x8>(p_tw, off_tw + 64); n_ta0 = gld<bf16x8>(p_al, off_tw); n_ta1 = gld<bf16x8>(p_al, off_tw + 64); \
      _Pragma("unroll") for (int mt = 0; mt < 4; ++mt) { n_k[mt] = gld<u32x2>(p_k, off_kr + mt * 32); n_r[mt] = gld<u32x2>(p_r, off_kr + mt * 32); } } while (0)
    SCAN_LOAD(cbeg);
    for (int cc = cbeg; cc < cend; ++cc) {
      const int c0 = d ? (s.T - 16 - cc * 16) : cc * 16;
      const size_t t0 = sb + c0;
      size_t b_y = (size_t)yout + t0 * 4096, b_bon = (size_t)s.bonus + t0 * 256 + (h * 2 + d) * 4;
      asm volatile("" : "+s"(b_y), "+s"(b_bon));
      size_t b_v = (size_t)s.v + t0 * 4096; asm volatile("" : "+s"(b_v));
      u32x2 n_v[4];
#pragma unroll
      for (int mt = 0; mt < 4; ++mt) n_v[mt] = gld<u32x2>(b_v, off_kr + mt * 32);
      {
        f32x4* wpl = (f32x4*)zl; f32x4* apl = (f32x4*)(wl + SC_PRE);
#pragma unroll
        for (int mt = 0; mt < 4; ++mt) {
          f32x4 cw = {0.f, 0.f, 0.f, 0.f}, ca = {0.f, 0.f, 0.f, 0.f};
          cw = __builtin_amdgcn_mfma_f32_16x16x32_bf16(awl[(0 * 4 + mt) * 64 + lane], n_tw0, cw, 0, 0, 0);
          cw = __builtin_amdgcn_mfma_f32_16x16x32_bf16(awl[(1 * 4 + mt) * 64 + lane], n_tw1, cw, 0, 0, 0);
          ca = __builtin_amdgcn_mfma_f32_16x16x32_bf16(aal[(0 * 4 + mt) * 64 + lane], n_ta0, ca, 0, 0, 0);
          ca = __builtin_amdgcn_mfma_f32_16x16x32_bf16(aal[(1 * 4 + mt) * 64 + lane], n_ta1, ca, 0, 0, 0);
          wpl[mt * 64 + lane] = cw; apl[mt * 64 + lane] = ca;
        }
      }
      float n2 = 0.f;
#pragma unroll
      for (int mt = 0; mt < 4; ++mt) {
        const float4 kkp = *(const float4*)(prm + 128 + mt * 16 + q * 4);
        const float t0 = bflo(n_k[mt][0]) * kkp.x, t1 = bfhi(n_k[mt][0]) * kkp.y, t2 = bflo(n_k[mt][1]) * kkp.z, t3 = bfhi(n_k[mt][1]) * kkp.w;
        n2 += t0 * t0 + t1 * t1 + t2 * t2 + t3 * t3;
      }
      n2 += __shfl_xor(n2, 16, 64); n2 += __shfl_xor(n2, 32, 64);
      const float invn = __builtin_amdgcn_rsqf(fmaxf(n2, 1e-24f));
      float bon = 0.f;
      bf16x8 ktf[2], btf[2], kdf[2], rtf[2];
#pragma unroll
      for (int ks = 0; ks < 2; ++ks) {
        float ktl[8], btl[8], kdl[8], rtl[8];
#pragma unroll
        for (int mh = 0; mh < 2; ++mh) {
          const int mt = 2 * ks + mh;
          const f32x4 cw = ((const f32x4*)zl)[mt * 64 + lane], ca = ((const f32x4*)(wl + SC_PRE))[mt * 64 + lane];
          const float4 w0p = *(const float4*)(prm + mt * 16 + q * 4), a0p = *(const float4*)(prm + 64 + mt * 16 + q * 4);
          const float4 kkp = *(const float4*)(prm + 128 + mt * 16 + q * 4), kap = *(const float4*)(prm + 192 + mt * 16 + q * 4), rkp = *(const float4*)(prm + 256 + mt * 16 + q * 4);
          const float w0a[4] = {w0p.x, w0p.y, w0p.z, w0p.w}, a0a[4] = {a0p.x, a0p.y, a0p.z, a0p.w};
          const float kka[4] = {kkp.x, kkp.y, kkp.z, kkp.w}, kaa[4] = {kap.x, kap.y, kap.z, kap.w}, rka[4] = {rkp.x, rkp.y, rkp.z, rkp.w};
          const u32x2 kr_ = n_k[mt], rr_ = n_r[mt];
          const float kxa[4] = {bflo(kr_[0]), bfhi(kr_[0]), bflo(kr_[1]), bfhi(kr_[1])};
          const float rxa[4] = {bflo(rr_[0]), bfhi(rr_[0]), bflo(rr_[1]), bfhi(rr_[1])};
          float4 p15v;
#pragma unroll
          for (int e = 0; e < 4; ++e) {
            const float wp = cw[e] + w0a[e], ap = ca[e] + a0a[e];
            const float ee = 0.6065306597126334f * __builtin_amdgcn_rcpf(1.f + __expf(-wp));
            const float a = __builtin_amdgcn_rcpf(1.f + __expf(-ap));
            const float kkn = kxa[e] * kka[e] * invn;
            const float kd = kxa[e] * (1.f + (a - 1.f) * kaa[e]);
            const float bb = kkn * a;
            bon += rxa[e] * kd * rka[e];
            const float Ei = row_prefix16(ee);
            const float pm = __expf(-Ei), pp = __builtin_amdgcn_rcpf(pm);
            const float pm1s = dppf<0x111>(pm), pm1 = c16 == 0 ? 1.f : pm1s;
            ktl[mh * 4 + e] = kkn * pm1; btl[mh * 4 + e] = bb * pp; kdl[mh * 4 + e] = kd * pp; rtl[mh * 4 + e] = rxa[e] * pm;
            ((float*)&p15v)[e] = pm;
          }
          if (c16 == 15) *(float4*)(p15l + mt * 16 + q * 4) = p15v;
          SBAR();
        }
        ktf[ks] = pack8(ktl[0], ktl[1], ktl[2], ktl[3], ktl[4], ktl[5], ktl[6], ktl[7]);
        btf[ks] = pack8(btl[0], btl[1], btl[2], btl[3], btl[4], btl[5], btl[6], btl[7]);
        kdf[ks] = pack8(kdl[0], kdl[1], kdl[2], kdl[3], kdl[4], kdl[5], kdl[6], kdl[7]);
        rtf[ks] = pack8(rtl[0], rtl[1], rtl[2], rtl[3], rtl[4], rtl[5], rtl[6], rtl[7]);
        {
          const u32x4 bw_ = *(const u32x4*)&btf[ks], kw_ = *(const u32x4*)&kdf[ks];
#pragma unroll
          for (int w = 0; w < 4; ++w) {
            const int j = (2 * ks + (w >> 1)) * 16 + q * 4 + (w & 1) * 2;
            bkt[j * 40 + c16] = (u16)(bw_[w] & 0xffffu); bkt[(j + 1) * 40 + c16] = (u16)(bw_[w] >> 16);
            bkt[j * 40 + 16 + c16] = (u16)(kw_[w] & 0xffffu); bkt[(j + 1) * 40 + 16 + c16] = (u16)(kw_[w] >> 16);
          }
        }
      }
      bon += __shfl_xor(bon, 16, 64); bon += __shfl_xor(bon, 32, 64);
      if (q == 0 && kind == 0) gst<float>(b_bon, off_tw, bon);
      SBAR();
      SBAR();
#pragma unroll
      for (int mt = 0; mt < 4; ++mt) {
        const int vb_ = (mt * 16 + q * 4) * 40 + 16 + c16;
        const unsigned v0_ = kind == 2 ? 0u : n_v[mt][0], v1_ = kind == 2 ? 0u : n_v[mt][1];
        uvt[vb_] = (u16)(v0_ & 0xffffu); uvt[vb_ + 40] = (u16)(v0_ >> 16);
        uvt[vb_ + 80] = (u16)(v1_ & 0xffffu); uvt[vb_ + 120] = (u16)(v1_ >> 16);
      }
      { const int cn = cc + 1 < cend ? cc + 1 : cc; SCAN_LOAD(cn); }
      SBAR();
      {
        f32x4 AB = {0.f, 0.f, 0.f, 0.f}, AK = AB, RB = AB, RK = AB;
        int qm = q; asm volatile("" : "+v"(qm));
#pragma unroll
        for (int ks = 0; ks < 2; ++ks) {
          AB = __builtin_amdgcn_mfma_f32_16x16x32_bf16(ktf[ks], btf[ks], AB, 0, 0, 0);
          AK = __builtin_amdgcn_mfma_f32_16x16x32_bf16(ktf[ks], kdf[ks], AK, 0, 0, 0);
          RB = __builtin_amdgcn_mfma_f32_16x16x32_bf16(rtf[ks], btf[ks], RB, 0, 0, 0);
          RK = __builtin_amdgcn_mfma_f32_16x16x32_bf16(rtf[ks], kdf[ks], RK, 0, 0, 0);
        }
#pragma unroll
        for (int r = 0; r < 4; ++r) {
          const int i = 4 * qm + r;
          const bool lo = c16 < i, le = c16 <= i;
          abf[i * 16 + c16] = lo ? AB[r] : 0.f;
          akm[i * 16 + c16] = f2bf(lo ? AK[r] : 0.f);
          rr[i * 32 + c16] = f2bf(le ? RB[r] : 0.f);
          rr[i * 32 + 16 + c16] = f2bf(le ? RK[r] : 0.f);
        }
      }
#define TFRAG(ks, nt, OUT) do { const f32x4 ta_ = Tl[((2 * (ks)) * 4 + (nt)) * 64 + lane], tb_ = Tl[((2 * (ks) + 1) * 4 + (nt)) * 64 + lane]; \
        OUT = pack8(ta_[0], ta_[1], ta_[2], ta_[3], tb_[0], tb_[1], tb_[2], tb_[3]); } while (0)
      lds_wait();
      {
        bf16x8 akf = {0, 0, 0, 0, 0, 0, 0, 0};
        if (q < 2) akf = *(const bf16x8*)(akm + c16 * 16 + q * 8);
#pragma unroll
        for (int nt = 0; nt < 4; ++nt) {
          f32x4 z = {0.f, 0.f, 0.f, 0.f};
          bf16x8 tf0, tf1; TFRAG(0, nt, tf0); TFRAG(1, nt, tf1);
          z = __builtin_amdgcn_mfma_f32_16x16x32_bf16(ktf[0], tf0, z, 0, 0, 0);
          z = __builtin_amdgcn_mfma_f32_16x16x32_bf16(ktf[1], tf1, z, 0, 0, 0);
          const bf16x8 vf = *(const bf16x8*)(uvt + (nt * 16 + c16) * 40 + 16 + (q & 1) * 8);
          z = __builtin_amdgcn_mfma_f32_16x16x32_bf16(akf, vf, z, 0, 0, 0);
#pragma unroll
          for (int r = 0; r < 4; ++r) zl[(4 * q + r) * 68 + nt * 16 + c16] = z[r];
        }
      }
      lds_wait();
      SBAR();
      {
        float U[16];
#pragma unroll
        for (int i = 0; i < 16; ++i) {
          float acc = -zl[i * 68 + lane];
#pragma unroll
          for (int s4 = 0; s4 < (i + 3) / 4; ++s4) {
            const float4 a4 = *(const float4*)(abf + i * 16 + s4 * 4);
            if (s4 * 4 + 0 < i) acc -= a4.x * U[s4 * 4 + 0];
            if (s4 * 4 + 1 < i) acc -= a4.y * U[s4 * 4 + 1];
            if (s4 * 4 + 2 < i) acc -= a4.z * U[s4 * 4 + 2];
            if (s4 * 4 + 3 < i) acc -= a4.w * U[s4 * 4 + 3];
          }
          U[i] = acc;
          if ((i & 3) == 3) SBAR();
        }
        *(bf16x8*)(uvt + lane * 40) = pack8(U[0], U[1], U[2], U[3], U[4], U[5], U[6], U[7]);
        *(bf16x8*)(uvt + lane * 40 + 8) = pack8(U[8], U[9], U[10], U[11], U[12], U[13], U[14], U[15]);
      }
      lds_wait();
      SBAR();
      {
        const bf16x8 rrf = *(const bf16x8*)(rr + c16 * 32 + q * 8);
        bf16x8 uvf[4];
#pragma unroll
        for (int nt = 0; nt < 4; ++nt) uvf[nt] = *(const bf16x8*)(uvt + (nt * 16 + c16) * 40 + q * 8);
#pragma unroll
        for (int nt = 0; nt < 4; ++nt) {
          f32x4 y = {0.f, 0.f, 0.f, 0.f};
          bf16x8 tf0, tf1; TFRAG(0, nt, tf0); TFRAG(1, nt, tf1);
          y = __builtin_amdgcn_mfma_f32_16x16x32_bf16(rtf[0], tf0, y, 0, 0, 0);
          y = __builtin_amdgcn_mfma_f32_16x16x32_bf16(rtf[1], tf1, y, 0, 0, 0);
          y = __builtin_amdgcn_mfma_f32_16x16x32_bf16(rrf, uvf[nt], y, 0, 0, 0);
#pragma unroll
          for (int r = 0; r < 4; ++r) { if (kind == 0) gst<u16>(b_y, off_y0 + (unsigned)(r * ystep) + nt * 32, f2bf(y[r])); }
        }
#pragma unroll
        for (int mt = 0; mt < 4; ++mt) {
          const bf16x8 bkf = *(const bf16x8*)(bkt + (mt * 16 + c16) * 40 + q * 8);
          const float4 pq = *(const float4*)(p15l + mt * 16 + q * 4);
#pragma unroll
          for (int nt = 0; nt < 4; ++nt) {
            f32x4 t = __builtin_amdgcn_mfma_f32_16x16x32_bf16(bkf, uvf[nt], Tl[(mt * 4 + nt) * 64 + lane], 0, 0, 0);
            t[0] *= pq.x; t[1] *= pq.y; t[2] *= pq.z; t[3] *= pq.w;
            Tl[(mt * 4 + nt) * 64 + lane] = t;
          }
        }
      }
      lds_wait();
    }
    if (pass == 0) {
      float* dst = s.tbuf + ((size_t)cs * 2 + (kind - 1)) * 4096;
#pragma unroll
      for (int m = 0; m < 16; ++m) *(f32x4*)(dst + (m * 64 + lane) * 4) = Tl[m * 64 + lane];
    }
  }
}

DEV void scan_combine_phase(const ScanP& s, char* lds_) {
  const int tid = ltid(), wid = __builtin_amdgcn_readfirstlane(tid >> 6), lane = tid & 63, c16 = lane & 15, q = lane >> 4;
  if (wid >= 2) return;
  float* til = (float*)(lds_ + wid * 16384);
  const int nchain = s.nseq * 64, nseg = s.nseg;
  for (int chain = wid * gridDim.x + blockIdx.x; chain < nchain; chain += 2 * gridDim.x) {
    f32x4 T[16];
#pragma unroll
    for (int m = 0; m < 16; ++m) T[m] = f32x4{0.f, 0.f, 0.f, 0.f};
    for (int seg = 0; seg < nseg; ++seg) {
      float* tn = s.tbuf + ((size_t)(chain * nseg + seg) * 2) * 4096; const float* ti = tn + 4096;
      lds_wait();
#pragma unroll
      for (int m = 0; m < 16; ++m) *(f32x4*)(til + (m * 64 + lane) * 4) = *(const f32x4*)(ti + (m * 64 + lane) * 4);
      lds_wait();
      f32x4 Tn[16];
#pragma unroll
      for (int m = 0; m < 16; ++m) Tn[m] = *(const f32x4*)(tn + (m * 64 + lane) * 4);
#pragma unroll
      for (int nt = 0; nt < 4; ++nt) {
        bf16x8 bh[2], bl[2];
#pragma unroll
        for (int ks = 0; ks < 2; ++ks) {
          const f32x4 ta = T[(2 * ks) * 4 + nt], tb = T[(2 * ks + 1) * 4 + nt];
          const float x[8] = {ta[0], ta[1], ta[2], ta[3], tb[0], tb[1], tb[2], tb[3]};
          float hf[8], lf[8];
#pragma unroll
          for (int e = 0; e < 8; ++e) { hf[e] = bf2f(f2bf(x[e])); lf[e] = x[e] - hf[e]; }
          bh[ks] = pack8(hf[0], hf[1], hf[2], hf[3], hf[4], hf[5], hf[6], hf[7]);
          bl[ks] = pack8(lf[0], lf[1], lf[2], lf[3], lf[4], lf[5], lf[6], lf[7]);
        }
#pragma unroll
        for (int mt = 0; mt < 4; ++mt) {
          f32x4 acc = Tn[mt * 4 + nt];
#pragma unroll
          for (int ks = 0; ks < 2; ++ks) {
            float x[8];
#pragma unroll
            for (int e = 0; e < 8; ++e) x[e] = til[((mt * 4 + 2 * ks + (e >> 2)) * 64 + ((c16 >> 2) & 3) * 16 + 4 * q + (e & 3)) * 4 + (c16 & 3)];
            float hf[8], lf[8];
#pragma unroll
            for (int e = 0; e < 8; ++e) { hf[e] = bf2f(f2bf(x[e])); lf[e] = x[e] - hf[e]; }
            const bf16x8 ah = pack8(hf[0], hf[1], hf[2], hf[3], hf[4], hf[5], hf[6], hf[7]);
            const bf16x8 al = pack8(lf[0], lf[1], lf[2], lf[3], lf[4], lf[5], lf[6], lf[7]);
            acc = __builtin_amdgcn_mfma_f32_16x16x32_bf16(ah, bh[ks], acc, 0, 0, 0);
            acc = __builtin_amdgcn_mfma_f32_16x16x32_bf16(ah, bl[ks], acc, 0, 0, 0);
            acc = __builtin_amdgcn_mfma_f32_16x16x32_bf16(al, bh[ks], acc, 0, 0, 0);
          }
          Tn[mt * 4 + nt] = acc;
        }
      }
#pragma unroll
      for (int m = 0; m < 16; ++m) { *(f32x4*)(tn + (m * 64 + lane) * 4) = T[m]; T[m] = Tn[m]; }
    }
  }
}

DEV void post_phase(u16* __restrict__ yf, const u16* __restrict__ yb, const u16* __restrict__ v, const u16* __restrict__ sg,
                    const float* __restrict__ bonus, const float* __restrict__ lg, const float* __restrict__ lb) {
  const int tid_ = ltid(); const int lane = tid_ & 63, wid = __builtin_amdgcn_readfirstlane(tid_ >> 6);
  for (int tok = blockIdx.x * 8 + wid; tok < GT; tok += gridDim.x * 8) {
#pragma unroll
    for (int it = 0; it < 4; ++it) {
      const int ch0 = it * 512 + lane * 8, h = ch0 >> 6; const size_t i = (size_t)tok * EI + ch0;
      const u32x4 a = *(const u32x4*)(yf + i), bq = *(const u32x4*)(yb + i), vv = *(const u32x4*)(v + i), gg = *(const u32x4*)(sg + i);
      const float2 bo = *(const float2*)(bonus + ((size_t)tok * 32 + h) * 2);
      float y[8]; float sum = 0.f;
#pragma unroll
      for (int e = 0; e < 4; ++e) { y[2 * e] = bflo(a[e]) + bflo(bq[e]); y[2 * e + 1] = bfhi(a[e]) + bfhi(bq[e]); sum += y[2 * e] + y[2 * e + 1]; }
      sum += __shfl_xor(sum, 1, 64); sum += __shfl_xor(sum, 2, 64); sum += __shfl_xor(sum, 4, 64);
      const float mean = sum * (1.f / 64.f);
      float var = 0.f;
#pragma unroll
      for (int e = 0; e < 8; ++e) { y[e] -= mean; var += y[e] * y[e]; }
      var += __shfl_xor(var, 1, 64); var += __shfl_xor(var, 2, 64); var += __shfl_xor(var, 4, 64);
      const float rs = rsqrtf(var * (1.f / 64.f) + 64e-5f), bon = bo.x + bo.y;
      const float4 g0 = *(const float4*)(lg + ch0), g1 = *(const float4*)(lg + ch0 + 4), b0 = *(const float4*)(lb + ch0), b1 = *(const float4*)(lb + ch0 + 4);
      const float ga[8] = {g0.x, g0.y, g0.z, g0.w, g1.x, g1.y, g1.z, g1.w}, ba[8] = {b0.x, b0.y, b0.z, b0.w, b1.x, b1.y, b1.z, b1.w};
      u32x4 o;
#pragma unroll
      for (int e = 0; e < 4; ++e) {
        const float o0 = (y[2 * e] * rs * ga[2 * e] + ba[2 * e] + bon * bflo(vv[e])) * bflo(gg[e]);
        const float o1 = (y[2 * e + 1] * rs * ga[2 * e + 1] + ba[2 * e + 1] + bon * bfhi(vv[e])) * bfhi(gg[e]);
        o[e] = cvtpk(o0, o1);
      }
      *(u32x4*)(yf + i) = o;
    }
  }
}

DEV void mla_mid_phase(const float* __restrict__ cqkv, const float* __restrict__ qn, const float* __restrict__ kvn,
                       const float* __restrict__ ct, const float* __restrict__ st,
                       u16* __restrict__ cqn, u16* __restrict__ ckvn, u16* __restrict__ kpe, int T) {
  const int tid_ = ltid(); const int lane = tid_ & 63, wid = __builtin_amdgcn_readfirstlane(tid_ >> 6);
  for (int tok = blockIdx.x * 8 + wid; tok < GT; tok += gridDim.x * 8) {
    const float* row = cqkv + (size_t)tok * 704;
    float q[6], ss = 0.f;
#pragma unroll
    for (int i = 0; i < 6; ++i) { q[i] = row[lane + i * 64]; ss += q[i] * q[i]; }
    ss = wsum(ss); float sc = rsqrtf(ss * (1.f / 384.f) + 1e-6f);
#pragma unroll
    for (int i = 0; i < 6; ++i) cqn[(size_t)tok * 384 + lane + i * 64] = f2bf(q[i] * sc * qn[lane + i * 64]);
    float c[4]; ss = 0.f;
#pragma unroll
    for (int i = 0; i < 4; ++i) { c[i] = row[384 + lane + i * 64]; ss += c[i] * c[i]; }
    ss = wsum(ss); sc = rsqrtf(ss * (1.f / 256.f) + 1e-6f);
#pragma unroll
    for (int i = 0; i < 4; ++i) ckvn[(size_t)tok * 256 + lane + i * 64] = f2bf(c[i] * sc * kvn[lane + i * 64]);
    const float x = row[640 + lane];
    const float xo = __shfl_xor(x, 32, 64);
    const int pos = tok % T, j = lane & 31;
    const float cs = ct[pos * 32 + j], sn = st[pos * 32 + j];
    const float o = lane < 32 ? x * cs - xo * sn : x * cs + xo * sn;
    kpe[(size_t)tok * 64 + lane] = f2bf(o);
  }
}

constexpr int SHM_V = 16384, SHM_K = 16384, SHM_KP = 8192;
#define KSWZ(row, colB) ((row) * 256 + ((colB) ^ (((row) & 7) << 4)))
#define KPSWZ(row, colB) ((row) * 128 + ((colB) ^ (((row) & 7) << 4)))
constexpr float ATT_SCALE = 0.07216878364870322f;
DEV void partialSM(f32x16& p0, f32x16& p1, float& m_reg, float& mn, float& alpha) {
  constexpr float C = ATT_SCALE * 1.4426950408889634f;
  float pmax = p0[0];
#pragma unroll
  for (int r = 1; r < 16; ++r) pmax = fmaxf(pmax, p0[r]);
#pragma unroll
  for (int r = 0; r < 16; ++r) pmax = fmaxf(pmax, p1[r]);
  { auto rr = __builtin_amdgcn_permlane32_swap(__float_as_uint(pmax), __float_as_uint(pmax), false, false);
    pmax = fmaxf(__uint_as_float(rr[0]), __uint_as_float(rr[1])); }
  mn = fmaxf(m_reg, pmax); alpha = __builtin_amdgcn_exp2f((m_reg - mn) * C); m_reg = mn;
  const float mnC = -mn * C;
#pragma unroll
  for (int r = 0; r < 16; ++r) p0[r] = __builtin_amdgcn_exp2f(fmaf(p0[r], C, mnC));
#pragma unroll
  for (int r = 0; r < 16; ++r) p1[r] = __builtin_amdgcn_exp2f(fmaf(p1[r], C, mnC));
}
DEV void finishSM(f32x16& p0, f32x16& p1, float alpha, float& l_reg, bf16x8& pa0, bf16x8& pa1, bf16x8& pa2, bf16x8& pa3) {
  float ps = 0;
#pragma unroll
  for (int r = 0; r < 16; ++r) ps += p0[r];
#pragma unroll
  for (int r = 0; r < 16; ++r) ps += p1[r];
  { auto rr = __builtin_amdgcn_permlane32_swap(__float_as_uint(ps), __float_as_uint(ps), false, false);
    ps = __uint_as_float(rr[0]) + __uint_as_float(rr[1]); }
  l_reg = l_reg * alpha + ps;
#define PK4(PP, BASE, OUT) do { unsigned a0 = cvtpk(PP[BASE + 0], PP[BASE + 1]), a1 = cvtpk(PP[BASE + 2], PP[BASE + 3]);   \
    unsigned b0 = cvtpk(PP[BASE + 4], PP[BASE + 5]), b1 = cvtpk(PP[BASE + 6], PP[BASE + 7]);                              \
    auto r0 = __builtin_amdgcn_permlane32_swap(a0, b0, false, false); auto r1 = __builtin_amdgcn_permlane32_swap(a1, b1, false, false); \
    u32x4 w = {r0[0], r1[0], r0[1], r1[1]}; OUT = *reinterpret_cast<bf16x8*>(&w); } while (0)
  PK4(p0, 0, pa0); PK4(p0, 8, pa1); PK4(p1, 0, pa2); PK4(p1, 8, pa3);
#undef PK4
}
DEV int v_st(int k, int c) { const int kk = (k & ~0xC) | ((k & 4) << 1) | ((k & 8) >> 1); return ((kk >> 3) * 4 + (c >> 5)) * 512 + ((kk & 7) * 32 + (c & 31)) * 2; }
DEV int v_rd_base(int lane) { return ((lane & 3) << 3) | (((lane >> 2) & 3) << 6) | (((lane >> 4) & 1) << 5) | (((lane >> 5) & 1) << 8); }
constexpr int v_rd_off(int d0, int ks, int half) { return d0 * 512 + ks * 4096 + half * 2048; }
template <int OFF> DEV s16x4 tr_read(int vb) {
  s16x4 r; asm volatile("ds_read_b64_tr_b16 %0, %1 offset:%2" : "=&v"(r) : "v"(vb), "i"(OFF) : "memory"); return r;
}
template <int D0> DEV void pv_one(f32x16& od, int vb, bf16x8 pa0, bf16x8 pa1, bf16x8 pa2, bf16x8 pa3) {
  const s16x4 l0 = tr_read<v_rd_off(D0, 0, 0)>(vb), h0 = tr_read<v_rd_off(D0, 0, 1)>(vb), l1 = tr_read<v_rd_off(D0, 1, 0)>(vb), h1 = tr_read<v_rd_off(D0, 1, 1)>(vb);
  const s16x4 l2 = tr_read<v_rd_off(D0, 2, 0)>(vb), h2 = tr_read<v_rd_off(D0, 2, 1)>(vb), l3 = tr_read<v_rd_off(D0, 3, 0)>(vb), h3 = tr_read<v_rd_off(D0, 3, 1)>(vb);
  asm volatile("s_waitcnt lgkmcnt(0)" ::: "memory"); SBAR();
#define PK(L, H) (bf16x8){L[0], L[1], L[2], L[3], H[0], H[1], H[2], H[3]}
  od = __builtin_amdgcn_mfma_f32_32x32x16_bf16(pa0, PK(l0, h0), od, 0, 0, 0);
  od = __builtin_amdgcn_mfma_f32_32x32x16_bf16(pa1, PK(l1, h1), od, 0, 0, 0);
  od = __builtin_amdgcn_mfma_f32_32x32x16_bf16(pa2, PK(l2, h2), od, 0, 0, 0);
  od = __builtin_amdgcn_mfma_f32_32x32x16_bf16(pa3, PK(l3, h3), od, 0, 0, 0);
#undef PK
}

struct AttnP { const u16* q; const u16* kv; const u16* kpe; u16* sg; const float* ct; const float* st; int nseq, T; int dry; };
DEV void attn_phase(const AttnP& a, char* lds) {
  const int tid = ltid(), wid = __builtin_amdgcn_readfirstlane(tid >> 6), lane = tid & 63, r32 = lane & 31, hi = lane >> 5;
  char* V_lds = lds; char* K_lds = lds + 3 * SHM_V; char* KP_lds = lds + 3 * SHM_V + 2 * SHM_K;
  float* wsc = (float*)(lds + 3 * SHM_V + 2 * SHM_K + 2 * SHM_KP) + wid * 64; float* li_l = wsc; float* al_l = wsc + 32;
  const int nqb = a.T / 256, nitems = a.nseq * 16 * nqb, NT = a.T / 64;
  const int sr = tid >> 4, sc = (tid & 15) * 8, vst0 = v_st(sr, sc), vst1 = v_st(32 + sr, sc);
  const int pr = tid >> 3, pc = (tid & 7) * 8;
  const int vb0 = (int)(uintptr_t)V_lds + v_rd_base(lane);
  int kad[4], kpd[4];
#pragma unroll
  for (int q = 0; q < 4; ++q) { kad[q] = KSWZ(r32, q * 32 + hi * 16); kpd[q] = KPSWZ(r32, q * 32 + hi * 16); }
  for (int it = blockIdx.x; it < nitems; it += gridDim.x) {
    const int qb = it % nqb, h = (it / nqb) & 15, b = it / (nqb * 16);
    const size_t sbase = (size_t)b * a.T;
    const int pos = qb * 256 + wid * 32 + r32;
    bf16x8 qr[12];
    {
      const u16* Qw = a.q + (sbase + pos) * 3072 + h * 192 + hi * 8;
#pragma unroll
      for (int d0 = 0; d0 < 12; ++d0) qr[d0] = *(const bf16x8*)(Qw + d0 * 16);
#pragma unroll
      for (int dd = 0; dd < 2; ++dd) {
        const int j0 = dd * 16 + hi * 8;
        const float4 c0 = *(const float4*)(a.ct + pos * 32 + j0), c1 = *(const float4*)(a.ct + pos * 32 + j0 + 4);
        const float4 s0 = *(const float4*)(a.st + pos * 32 + j0), s1 = *(const float4*)(a.st + pos * 32 + j0 + 4);
        const float cs[8] = {c0.x, c0.y, c0.z, c0.w, c1.x, c1.y, c1.z, c1.w};
        const float sn[8] = {s0.x, s0.y, s0.z, s0.w, s1.x, s1.y, s1.z, s1.w};
        u32x4 x1 = *(u32x4*)&qr[8 + dd], x2 = *(u32x4*)&qr[10 + dd], y1, y2;
#pragma unroll
        for (int e = 0; e < 4; ++e) {
          const float a0 = bflo(x1[e]), a1 = bfhi(x1[e]), b0 = bflo(x2[e]), b1 = bfhi(x2[e]);
          y1[e] = cvtpk(a0 * cs[2 * e] - b0 * sn[2 * e], a1 * cs[2 * e + 1] - b1 * sn[2 * e + 1]);
          y2[e] = cvtpk(b0 * cs[2 * e] + a0 * sn[2 * e], b1 * cs[2 * e + 1] + a1 * sn[2 * e + 1]);
        }
        qr[8 + dd] = *(bf16x8*)&y1; qr[10 + dd] = *(bf16x8*)&y2;
      }
    }
    float m_reg = -1e30f, l_reg = 0.f; f32x16 o[4] = {};
    bf16x8 vs0, vs1, ks0, ks1, kp0;
    const u16* kvh = a.kv + sbase * 4096 + h * 256;
    const u16* kph = a.kpe + sbase * 64;
    const unsigned voff = (unsigned)(sr * 8192 + sc * 2), poff = (unsigned)(pr * 128 + pc * 2);
#define SLOAD(k0) do { const char* bK0 = (const char*)kvh + (size_t)(k0) * 8192; const char* bK1 = bK0 + 32 * 8192; const char* bP = (const char*)kph + (size_t)(k0) * 128; \
    vs0 = *(const bf16x8*)(bK0 + voff + 256); vs1 = *(const bf16x8*)(bK1 + voff + 256); \
    ks0 = *(const bf16x8*)(bK0 + voff); ks1 = *(const bf16x8*)(bK1 + voff); \
    kp0 = *(const bf16x8*)(bP + poff); } while (0)
#define SWRITE(bb, vbuf) do { *(bf16x8*)(V_lds + (vbuf) * SHM_V + vst0) = vs0; *(bf16x8*)(V_lds + (vbuf) * SHM_V + vst1) = vs1; \
    *(bf16x8*)(K_lds + (bb) * SHM_K + KSWZ(sr, sc * 2)) = ks0; *(bf16x8*)(K_lds + (bb) * SHM_K + KSWZ(32 + sr, sc * 2)) = ks1; \
    *(bf16x8*)(KP_lds + (bb) * SHM_KP + KPSWZ(pr, pc * 2)) = kp0; } while (0)
    __syncthreads();
    SLOAD(0); SWRITE(0, 0); __syncthreads();
    const bool grpB = wid >= 4;
    bf16x8 pa0, pa1, pa2, pa3;
    int vcur = 0, vprev = 2;
#define PV_ALL(vbuf) do { const int vb_ = vb0 + (vbuf) * SHM_V; \
      pv_one<0>(o[0], vb_, pa0, pa1, pa2, pa3); pv_one<1>(o[1], vb_, pa0, pa1, pa2, pa3); \
      pv_one<2>(o[2], vb_, pa0, pa1, pa2, pa3); pv_one<3>(o[3], vb_, pa0, pa1, pa2, pa3); } while (0)
    for (int j = 0; j < NT; ++j) {
      const int bb = j & 1;
      if (j + 1 < NT) SLOAD((j + 1) * 64);
      SBAR();
      if (grpB && j > 0) PV_ALL(vprev);
      f32x16 p0 = {}, p1 = {};
      {
        const char* Ks = K_lds + bb * SHM_K; const char* Kp = KP_lds + bb * SHM_KP;
#pragma unroll
        for (int d0 = 0; d0 < 8; ++d0) {
          const bf16x8 b0 = *(const bf16x8*)(Ks + kad[d0 & 3] + (d0 >> 2) * 128), b1 = *(const bf16x8*)(Ks + kad[d0 & 3] + (d0 >> 2) * 128 + 8192);
          p0 = __builtin_amdgcn_mfma_f32_32x32x16_bf16(b0, qr[d0], p0, 0, 0, 0);
          p1 = __builtin_amdgcn_mfma_f32_32x32x16_bf16(b1, qr[d0], p1, 0, 0, 0); }
#pragma unroll
        for (int d0 = 0; d0 < 4; ++d0) {
          const bf16x8 b0 = *(const bf16x8*)(Kp + kpd[d0]), b1 = *(const bf16x8*)(Kp + kpd[d0] + 4096);
          p0 = __builtin_amdgcn_mfma_f32_32x32x16_bf16(b0, qr[8 + d0], p0, 0, 0, 0);
          p1 = __builtin_amdgcn_mfma_f32_32x32x16_bf16(b1, qr[8 + d0], p1, 0, 0, 0); }
      }
      float mn, alpha;
      partialSM(p0, p1, m_reg, mn, alpha);
      if (__any(alpha < 1.f)) {
        if (hi == 0) al_l[r32] = alpha;
        lds_wait();
#pragma unroll
        for (int dd = 0; dd < 4; ++dd)
#pragma unroll
          for (int r = 0; r < 16; ++r) o[dd][r] *= al_l[crow(r, hi)];
      }
      finishSM(p0, p1, alpha, l_reg, pa0, pa1, pa2, pa3); SBAR();
      if (!grpB) PV_ALL(vcur);
      const int vnext = vcur == 2 ? 0 : vcur + 1;
      if (j + 1 < NT) SWRITE(bb ^ 1, vnext);
      vprev = vcur; vcur = vnext;
      __syncthreads();
    }
    if (grpB) PV_ALL(vprev);
#undef PV_ALL
#undef SLOAD
#undef SWRITE
    {
      int t2 = threadIdx.x; asm volatile("" : "+v"(t2));
      const int wid2 = t2 >> 6, r2 = t2 & 31, hi2 = (t2 >> 5) & 1;
      float* li2 = (float*)(lds + 3 * SHM_V + 2 * SHM_K + 2 * SHM_KP) + wid2 * 64;
      if (hi2 == 0) li2[r2] = l_reg;
      lds_wait();
      u16* Ow = a.sg + (sbase + qb * 256 + wid2 * 32) * EI + h * 128 + r2;
#pragma unroll
      for (int r = 0; r < 16; ++r) {
        const int orow = crow(r, hi2);
        const float rl = __builtin_amdgcn_rcpf(li2[orow]);
#pragma unroll
        for (int d0 = 0; d0 < 4; ++d0) {
          u16* pp = Ow + (size_t)orow * EI + d0 * 32;
          if (!a.dry) *pp = f2bf(o[d0][r] * rl * bf2f(*pp));
        }
      }
    }
  }
}

#if MEGA
#define GRID_SYNC() gsync(p, lds)
#else
#define GRID_SYNC() do {} while (0)
#endif
struct Grp { const float* xin0; float* xres; int nseq, T; };
DEV Grp get_group(const P& p, int g) {
  Grp r;
  r.xin0 = g == 0 ? p.x_prompt : p.x_sample + (size_t)(g - 1) * GT * DM;
  r.xres = p.out + (size_t)g * GT * DM;
  r.nseq = g == 0 ? 8 : 1; r.T = g == 0 ? 2048 : 16384;
  return r;
}
template <int LT, int ph>
DEV void run_phase(const P& p, int g, int layer, char* lds) {
  const Grp G = get_group(p, g);
  const int j = layer >> 1;
  const float* xin = layer == 0 ? G.xin0 : G.xres;
  size_t zoff = 0; asm volatile("" : "+s"(zoff));
  char* ws = p.ws + zoff;
  u16* hbuf = (u16*)(ws + O_HBUF);
  u16* sg = (u16*)(ws + O_SG);
  if constexpr (LT == 0) {
    u16 *rb = (u16*)(ws + O_RB), *kb = (u16*)(ws + O_KB), *vb = (u16*)(ws + O_VB), *yf = (u16*)(ws + O_YF), *yb = (u16*)(ws + O_YB);
    u16 *twl = (u16*)(ws + O_TWL), *al = (u16*)(ws + O_AL); float* bon = (float*)(ws + O_BON);
    if constexpr (ph == 0) rms_phase(xin, p.ln_g + layer * DM, hbuf);
    else if constexpr (ph == 1) {
      GemmP q{}; q.A = hbuf; q.lda = DM; q.Bt = (const u16*)(ws + O_WRWIN) + (size_t)j * RW_N * DM; q.K = DM; q.NT = 66;
      q.mu = p.rw_mu + (size_t)j * 6 * DM; q.T = G.T; q.o0 = rb; q.o1 = kb; q.o2 = vb; q.o3 = sg; q.o4 = twl; q.o5 = al;
      lerp_phase(hbuf, q.mu, yf, G.T); GRID_SYNC();
      GemmP w = q; w.A = yf; w.astride = (size_t)GT * DM; w.NT = 32; w.nt0 = 0;
      gemm_phase<LOAD_PLAIN, EPI_RWKV, 4>(w, lds);
      q.NT = 2; q.nt0 = 64;
      gemm_phase<LOAD_LERP, EPI_RWKV, 2>(q, lds);
    } else if constexpr (ph == 2) {
      ScanP s{}; s.r = rb; s.k = kb; s.v = vb; s.twl = twl; s.al = al; s.yf = yf; s.yb = yb; s.bonus = bon;
      s.w0 = p.rw_w0 + (size_t)j * 2 * EI; s.w2 = p.rw_w2 + (size_t)j * 2 * 64 * EI; s.a0 = p.rw_a0 + (size_t)j * 2 * EI; s.a2 = p.rw_a2 + (size_t)j * 2 * 64 * EI;
      s.kk = p.rw_kk + (size_t)j * EI; s.ka = p.rw_ka + (size_t)j * EI; s.rk = p.rw_rk + (size_t)j * EI; s.nseq = G.nseq; s.T = G.T;
      s.tbuf = (float*)hbuf;
      if (G.T > 2048) {
        s.nseg = 16;
        scan_phase(s, lds, 0); GRID_SYNC();
        scan_combine_phase(s, lds); GRID_SYNC();
        scan_phase(s, lds, 1);
      } else { s.nseg = 1; scan_phase(s, lds, 1); }
    } else if constexpr (ph == 3) post_phase(yf, yb, vb, sg, bon, p.rw_lnx_g + (size_t)j * EI, p.rw_lnx_b + (size_t)j * EI);
    else {
      GemmP q{}; q.A = yf; q.lda = EI; q.Bt = (const u16*)(ws + O_WRWOUT) + (size_t)j * DM * EI; q.K = EI; q.NT = 4; q.xin = xin; q.xout = G.xres;
      for (int rep = 1; rep < REP_GEMM; ++rep) { q.dry = (gridDim.x != 12345); gemm_phase<LOAD_PLAIN, EPI_RES, 4>(q, lds); } q.dry = 0;
      gemm_phase<LOAD_PLAIN, EPI_RES, 4>(q, lds);
    }
  } else {
    float* cqkv = (float*)(ws + O_CQKV); u16 *cqn = (u16*)(ws + O_CQN), *ckvn = (u16*)(ws + O_CKVN), *kpe = (u16*)(ws + O_KPE), *qq = (u16*)(ws + O_Q), *kv = (u16*)(ws + O_KV);
    const float* ct = (const float*)(ws + O_COS); const float* st = (const float*)(ws + O_SIN);
    if constexpr (ph == 0) rms_phase(xin, p.ln_g + layer * DM, hbuf);
    else if constexpr (ph == 1) {
      GemmP q{}; q.A = hbuf; q.lda = DM; q.Bt = (const u16*)(ws + O_WMLIN) + (size_t)j * ML_NP * DM; q.K = DM; q.NT = 11; q.of = cqkv; q.o0 = sg;
      for (int rep = 1; rep < REP_GEMM; ++rep) { q.dry = (gridDim.x != 12345); gemm_phase<LOAD_PLAIN, EPI_MLAIN, 4>(q, lds); } q.dry = 0;
      gemm_phase<LOAD_PLAIN, EPI_MLAIN, 4>(q, lds);
    } else if constexpr (ph == 2) mla_mid_phase(cqkv, p.ml_qn + j * 384, p.ml_kvn + j * 256, ct, st, cqn, ckvn, kpe, G.T);
    else if constexpr (ph == 3) {
      GemmP q{}; q.A = cqn; q.lda = 384; q.Bt = (const u16*)(ws + O_WUQ) + (size_t)j * 3072 * 384; q.K = 384; q.NT = 12; q.o0 = qq; q.ldc = 3072;
      for (int rep = 1; rep < REP_GEMM; ++rep) { q.dry = (gridDim.x != 12345); gemm_phase<LOAD_PLAIN, EPI_BF16, 4>(q, lds); } q.dry = 0;
      gemm_phase<LOAD_PLAIN, EPI_BF16, 4>(q, lds);
      GemmP r{}; r.A = ckvn; r.lda = 256; r.Bt = (const u16*)(ws + O_WUKV) + (size_t)j * 4096 * 256; r.K = 256; r.NT = 16; r.o0 = kv; r.ldc = 4096;
      for (int rep = 1; rep < REP_GEMM; ++rep) { r.dry = (gridDim.x != 12345); gemm_phase<LOAD_PLAIN, EPI_BF16, 4>(r, lds); } r.dry = 0;
      gemm_phase<LOAD_PLAIN, EPI_BF16, 4>(r, lds);
    } else if constexpr (ph == 4) {
      AttnP a{}; a.q = qq; a.kv = kv; a.kpe = kpe; a.sg = sg; a.ct = ct; a.st = st; a.nseq = G.nseq; a.T = G.T;
      for (int rep = 1; rep < REP_ATTN; ++rep) { a.dry = (gridDim.x != 12345); attn_phase(a, lds); } a.dry = 0;
      attn_phase(a, lds);
    } else {
      GemmP q{}; q.A = sg; q.lda = EI; q.Bt = (const u16*)(ws + O_WMLOUT) + (size_t)j * DM * EI; q.K = EI; q.NT = 4; q.xin = xin; q.xout = G.xres;
      for (int rep = 1; rep < REP_GEMM; ++rep) { q.dry = (gridDim.x != 12345); gemm_phase<LOAD_PLAIN, EPI_RES, 4>(q, lds); } q.dry = 0;
      gemm_phase<LOAD_PLAIN, EPI_RES, 4>(q, lds);
    }
  }
}


template <int LT, int PH>
__global__ __launch_bounds__(512) void k_phase(P p, int g, int layer) {
  extern __shared__ __attribute__((aligned(16))) char lds[];
  if constexpr (LT == 2) { if constexpr (PH == 0) init_phase(p, lds); else final_phase(p.out, p.final_g); }
  else run_phase<LT, PH>(p, g, layer, lds);
}

#if MEGA
__global__ __launch_bounds__(512) void k_mega(P p) {
  extern __shared__ __attribute__((aligned(16))) char lds[];
  cg::grid_group grid = cg::this_grid();
  {
    unsigned* bar = (unsigned*)(p.ws + O_BAR);
    if (blockIdx.x == 0) for (int i = threadIdx.x; i < XCD_BAR_WORDS; i += 512) bar[i] = 0u;
    if (threadIdx.x == 0) { volatile LAS unsigned* st = (volatile LAS unsigned*)(lds + SHM_BYTES - 16); st[0] = 0u; st[1] = 0u; }
  }
  init_phase(p, lds);
  grid.sync();
  if (threadIdx.x == 0) (void)xb_add(&((unsigned*)(p.ws + O_BAR))[XB_XCNT(xb_xcc_id())], 1u);
  for (int g = 0; g < 3; ++g)
    for (int layer = 0; layer < 4; ++layer) {
      if ((layer & 1) == 0) {
        run_phase<0, 0>(p, g, layer, lds); gsync(p, lds); run_phase<0, 1>(p, g, layer, lds); gsync(p, lds); run_phase<0, 2>(p, g, layer, lds); gsync(p, lds);
        run_phase<0, 3>(p, g, layer, lds); gsync(p, lds); run_phase<0, 4>(p, g, layer, lds); gsync(p, lds);
      } else {
        run_phase<1, 0>(p, g, layer, lds); gsync(p, lds); run_phase<1, 1>(p, g, layer, lds); gsync(p, lds); run_phase<1, 2>(p, g, layer, lds); gsync(p, lds);
        run_phase<1, 3>(p, g, layer, lds); gsync(p, lds); run_phase<1, 4>(p, g, layer, lds); gsync(p, lds); run_phase<1, 5>(p, g, layer, lds); gsync(p, lds);
      }
    }
  final_phase(p.out, p.final_g);
}
#endif

extern "C" void kernel_launch(void* const* d_in, const int* in_sizes, int n_in, void* d_out, int out_size, void* d_ws, size_t ws_size, hipStream_t stream) {
  if (n_in != 22 || ws_size < WS_NEED) { fprintf(stderr, "kernel_launch: bad args n_in %d ws %zu need %zu\n", n_in, ws_size, WS_NEED); return; }
  P p{};
  const float** f = (const float**)&p;
  for (int i = 0; i < 22; ++i) f[i] = (const float*)d_in[i];
  p.out = (float*)d_out; p.ws = (char*)d_ws;
#if MEGA
  static int grid_blocks = 0;
  if (!grid_blocks) {
    hipFuncSetAttribute((const void*)k_mega, hipFuncAttributeMaxDynamicSharedMemorySize, SHM_BYTES);
    int dev = 0, cus = 0, per_cu = 0;
    hipGetDevice(&dev);
    hipDeviceGetAttribute(&cus, hipDeviceAttributeMultiprocessorCount, dev);
    hipOccupancyMaxActiveBlocksPerMultiprocessor(&per_cu, k_mega, 512, SHM_BYTES);
    if (per_cu > 1) per_cu = 1;
    grid_blocks = cus * per_cu;
  }
  void* args[] = {&p};
  hipError_t e = hipLaunchCooperativeKernel((void*)k_mega, dim3(grid_blocks), dim3(512), args, SHM_BYTES, stream);
  if (e != hipSuccess) fprintf(stderr, "cooperative launch failed: %s (grid %d)\n", hipGetErrorString(e), grid_blocks);
#else
  const int NB = 256;
#define LAUNCH(LT, PH, g, layer) do { static int inited = 0; if (!inited) { hipFuncSetAttribute((const void*)k_phase<LT, PH>, hipFuncAttributeMaxDynamicSharedMemorySize, SHM_BYTES); inited = 1; } \
    hipLaunchKernelGGL((k_phase<LT, PH>), dim3(NB), dim3(512), SHM_BYTES, stream, p, g, layer); } while (0)
  LAUNCH(2, 0, 0, 0);
  for (int g = 0; g < 3; ++g)
    for (int layer = 0; layer < 4; ++layer) {
      if ((layer & 1) == 0) { LAUNCH(0, 0, g, layer); LAUNCH(0, 1, g, layer); LAUNCH(0, 2, g, layer); LAUNCH(0, 3, g, layer); LAUNCH(0, 4, g, layer); }
      else { LAUNCH(1, 0, g, layer); LAUNCH(1, 1, g, layer); LAUNCH(1, 2, g, layer); LAUNCH(1, 3, g, layer); LAUNCH(1, 4, g, layer); LAUNCH(1, 5, g, layer); }
    }
  LAUNCH(2, 1, 0, 0);
#endif
}
```

```cpp
#include <hip/hip_runtime.h>
#include <hip/hip_bf16.h>
#include <hip/hip_cooperative_groups.h>
#include <cstdio>
namespace cg = cooperative_groups;

#ifndef REP_GEMM
#define REP_GEMM 1
#endif
#ifndef REP_ATTN
#define REP_ATTN 1
#endif
#ifndef REP_SCAN
#define REP_SCAN 1
#endif
#ifndef MEGA
#define MEGA 1
#endif

typedef unsigned short u16;
using bf16x8 = __attribute__((ext_vector_type(8))) short;
using s16x4  = __attribute__((ext_vector_type(4))) short;
using f32x16 = __attribute__((ext_vector_type(16))) float;
using f32x4  = __attribute__((ext_vector_type(4))) float;
using u32x4  = __attribute__((ext_vector_type(4))) unsigned;
using u32x2  = __attribute__((ext_vector_type(2))) unsigned;
#define DEV __device__ __forceinline__
#define SBAR() __builtin_amdgcn_sched_barrier(0)

constexpr int DM = 1024, EI = 2048, GT = 16384;
constexpr int NTOK = 49152;
constexpr int RW_N = 8448, ML_N = 2752, ML_NP = 2816;
constexpr int SHM_BYTES = 158720;

constexpr size_t alup(size_t x) { return (x + 255) / 256 * 256; }
constexpr size_t O_WRWIN  = 0;
constexpr size_t O_WRWOUT = O_WRWIN  + alup((size_t)2 * RW_N * DM * 2);
constexpr size_t O_WMLIN  = O_WRWOUT + alup((size_t)2 * DM * EI * 2);
constexpr size_t O_WUQ    = O_WMLIN  + alup((size_t)2 * ML_NP * DM * 2);
constexpr size_t O_WUKV   = O_WUQ    + alup((size_t)2 * 3072 * 384 * 2);
constexpr size_t O_WMLOUT = O_WUKV   + alup((size_t)2 * 4096 * 256 * 2);
constexpr size_t O_COS    = O_WMLOUT + alup((size_t)2 * DM * EI * 2);
constexpr size_t O_SIN    = O_COS    + alup((size_t)16384 * 32 * 4);
constexpr size_t O_HBUF   = O_SIN    + alup((size_t)16384 * 32 * 4);
constexpr size_t O_R0     = O_HBUF   + alup((size_t)GT * DM * 2);
constexpr size_t SZ_E = (size_t)GT * EI * 2;
constexpr size_t O_SG   = O_R0;
constexpr size_t O_RB   = O_SG + SZ_E;
constexpr size_t O_KB   = O_RB + SZ_E;
constexpr size_t O_VB   = O_KB + SZ_E;
constexpr size_t O_YF   = O_VB + SZ_E;
constexpr size_t O_YB   = O_YF + SZ_E;
constexpr size_t O_TWL  = O_YB + SZ_E;
constexpr size_t O_AL   = O_TWL + alup((size_t)GT * 128 * 2);
constexpr size_t O_BON  = O_AL  + alup((size_t)GT * 128 * 2);
constexpr size_t O_RW_END = O_BON + alup((size_t)GT * 64 * 4);
constexpr size_t O_CQKV = O_SG + SZ_E;
constexpr size_t O_CQN  = O_CQKV + alup((size_t)GT * 704 * 4);
constexpr size_t O_CKVN = O_CQN  + alup((size_t)GT * 384 * 2);
constexpr size_t O_KPE  = O_CKVN + alup((size_t)GT * 256 * 2);
constexpr size_t O_Q    = O_KPE  + alup((size_t)GT * 64 * 2);
constexpr size_t O_KV   = O_Q    + alup((size_t)GT * 3072 * 2);
constexpr size_t O_ML_END = O_KV + alup((size_t)GT * 4096 * 2);
constexpr size_t O_FLAG = O_RW_END > O_ML_END ? O_RW_END : O_ML_END;
constexpr size_t O_BAR = O_FLAG + 256;
constexpr size_t WS_NEED = O_BAR + 16384;

struct P {
  const float* x_prompt; const float* x_sample; const float* ln_g; const float* final_g;
  const float* rw_mu; const float* rw_in; const float* rw_w0; const float* rw_w2; const float* rw_a0; const float* rw_a2;
  const float* rw_kk; const float* rw_ka; const float* rw_rk; const float* rw_lnx_g; const float* rw_lnx_b; const float* rw_out;
  const float* ml_in; const float* ml_qn; const float* ml_kvn; const float* ml_uq; const float* ml_ukv; const float* ml_out;
  float* out; char* ws;
};

typedef __attribute__((ext_vector_type(2))) __bf16 bf16x2_t;
typedef __attribute__((ext_vector_type(2))) float f32x2_t;
DEV unsigned cvtpk(float lo, float hi) { f32x2_t v = {lo, hi}; bf16x2_t b = __builtin_convertvector(v, bf16x2_t); return __builtin_bit_cast(unsigned, b); }
DEV float bf2f(u16 x) { return __uint_as_float(((unsigned)x) << 16); }
DEV float bflo(unsigned x) { return __uint_as_float(x << 16); }
DEV float bfhi(unsigned x) { return __uint_as_float(x & 0xffff0000u); }
DEV u16 f2bf(float x) { __bf16 b = (__bf16)x; return __builtin_bit_cast(u16, b); }
DEV float wsum(float v) {
#pragma unroll
  for (int o = 32; o >= 1; o >>= 1) v += __shfl_xor(v, o, 64);
  return v;
}
DEV float siluf(float x) { return x / (1.f + __expf(-x)); }
DEV int crow(int r, int hi) { return (r & 3) + 8 * (r >> 2) + 4 * hi; }
DEV int ltid() { int t = threadIdx.x; asm volatile("" : "+v"(t)); return t; }
template <typename T> DEV T gld(size_t base, unsigned off) { return *(const __attribute__((address_space(1))) T*)(base + off); }
template <typename T> DEV void gst(size_t base, unsigned off, T v) { *(__attribute__((address_space(1))) T*)(base + off) = v; }
DEV void lds_wait() { asm volatile("s_waitcnt lgkmcnt(0)" ::: "memory"); }


#define XB_TMO      128
#define XB_XCNT(j)  (256  + 64 * (j))
#define XB_XSUB(j)  (1280 + 64 * (j))
#define XB_XGEN(j)  (2304 + 64 * (j))
#define XB_TOP      3328
#define XB_TOPGEN   3392
#define XCD_BAR_WORDS 3456
#define XB_SPIN_CAP (1u << 22)
#define LAS __attribute__((address_space(3)))
DEV unsigned xb_ld(unsigned* p)              { return __hip_atomic_load(p, __ATOMIC_RELAXED, __HIP_MEMORY_SCOPE_AGENT); }
DEV unsigned xb_add(unsigned* p, unsigned v) { return __hip_atomic_fetch_add(p, v, __ATOMIC_RELAXED, __HIP_MEMORY_SCOPE_AGENT); }
DEV unsigned xb_xcc_id() { return (unsigned)__builtin_amdgcn_s_getreg((3 << 11) | 20) & 0xFu; }
#define XB_SPIN(cond, bar) do { unsigned _sp = 0; while (cond) { __builtin_amdgcn_s_sleep(1); \
    if ((++_sp & 255u) == 0u) { if (xb_ld(&(bar)[XB_TMO])) break; if (_sp > XB_SPIN_CAP) { atomicAdd(&(bar)[XB_TMO], 1u); break; } } } } while (0)
struct XcdBarrier { unsigned* bar; unsigned x; volatile LAS unsigned* st; };
DEV void xcd_barrier_complete(unsigned* bar, unsigned x, unsigned& nloc, unsigned& nx) {
  const unsigned G = gridDim.x * gridDim.y * gridDim.z;
  unsigned sum, cnt, mine, sp = 0u;
  for (;;) {
    sum = 0u; cnt = 0u; mine = 0u;
#pragma unroll
    for (unsigned j = 0; j < 16; ++j) { const unsigned c = xb_ld(&bar[XB_XCNT(j)]); sum += c; cnt += (c > 0u) ? 1u : 0u; mine = (j == x) ? c : mine; }
    if (sum == G) break;
    __builtin_amdgcn_s_sleep(1);
    if ((++sp & 255u) == 0u) { if (xb_ld(&bar[XB_TMO])) break; if (sp > XB_SPIN_CAP) { atomicAdd(&bar[XB_TMO], 1u); break; } }
  }
  nloc = mine > 0u ? mine : 1u; nx = cnt > 0u ? cnt : 1u;
}
DEV void xcd_barrier(const XcdBarrier& b) {
  asm volatile("s_waitcnt vmcnt(0)" ::: "memory");
  __syncthreads();
  if (threadIdx.x == 0) {
    unsigned* bar = b.bar;
    __builtin_amdgcn_s_waitcnt(0);
    unsigned nloc = b.st[0], nx = b.st[1];
    if (nloc == 0u) { xcd_barrier_complete(bar, b.x, nloc, nx); b.st[0] = nloc; b.st[1] = nx; }
    const unsigned old = xb_add(&bar[XB_XSUB(b.x)], 1u);
    const unsigned gen = old / nloc;
    if (old + 1u == (gen + 1u) * nloc) {
      __builtin_amdgcn_fence(__ATOMIC_RELEASE, "agent");
      asm volatile("s_waitcnt vmcnt(0)" ::: "memory");
      const unsigned og = xb_add(&bar[XB_TOP], 1u);
      const unsigned tg = og / nx;
      if (og + 1u == (tg + 1u) * nx) xb_add(&bar[XB_TOPGEN], 1u);
      else XB_SPIN(xb_ld(&bar[XB_TOPGEN]) == tg, bar);
      __builtin_amdgcn_fence(__ATOMIC_ACQUIRE, "agent");
      xb_add(&bar[XB_XGEN(b.x)], 1u);
      asm volatile("s_waitcnt vmcnt(0)" ::: "memory");
    } else {
      XB_SPIN(xb_ld(&bar[XB_XGEN(b.x)]) == gen, bar);
      __builtin_amdgcn_fence(__ATOMIC_ACQUIRE, "agent");
      asm volatile("s_waitcnt vmcnt(0)" ::: "memory");
    }
  }
  __syncthreads();
}
DEV void gsync(const P& p, char* lds) {
  XcdBarrier b; b.bar = (unsigned*)(p.ws + O_BAR); b.x = xb_xcc_id(); b.st = (volatile LAS unsigned*)(lds + SHM_BYTES - 16);
  xcd_barrier(b);
}

DEV void convert_T(const float* __restrict__ src, u16* __restrict__ dst, int K, int N, int Npad, char* lds_) {
  float* lds = (float*)lds_;
  const int tid = ltid(), tk = K / 64, tn = Npad / 64;
  for (int t = blockIdx.x; t < tk * tn; t += gridDim.x) {
    const int k0 = (t % tk) * 64, n0 = (t / tk) * 64;
    __syncthreads();
#pragma unroll
    for (int i = 0; i < 2; ++i) {
      const int kr = (tid >> 4) + i * 32, c = (tid & 15) * 4;
      float4 v = make_float4(0.f, 0.f, 0.f, 0.f);
      if (n0 + c < N) v = *(const float4*)(src + (long)(k0 + kr) * N + n0 + c);
      lds[kr * 65 + c + 0] = v.x; lds[kr * 65 + c + 1] = v.y; lds[kr * 65 + c + 2] = v.z; lds[kr * 65 + c + 3] = v.w;
    }
    __syncthreads();
    const int n = tid >> 3, kc = (tid & 7) * 8;
    u32x4 w;
    w[0] = cvtpk(lds[(kc + 0) * 65 + n], lds[(kc + 1) * 65 + n]);
    w[1] = cvtpk(lds[(kc + 2) * 65 + n], lds[(kc + 3) * 65 + n]);
    w[2] = cvtpk(lds[(kc + 4) * 65 + n], lds[(kc + 5) * 65 + n]);
    w[3] = cvtpk(lds[(kc + 6) * 65 + n], lds[(kc + 7) * 65 + n]);
    *(u32x4*)(dst + (long)(n0 + n) * K + k0 + kc) = w;
  }
}

DEV void init_phase(const P& p, char* lds) {
  for (int j = 0; j < 2; ++j) {
    convert_T(p.rw_in  + (size_t)j * DM * RW_N, (u16*)(p.ws + O_WRWIN)  + (size_t)j * RW_N * DM, DM, RW_N, RW_N, lds);
    convert_T(p.rw_out + (size_t)j * EI * DM,   (u16*)(p.ws + O_WRWOUT) + (size_t)j * DM * EI,   EI, DM, DM, lds);
    convert_T(p.ml_in  + (size_t)j * DM * ML_N, (u16*)(p.ws + O_WMLIN)  + (size_t)j * ML_NP * DM, DM, ML_N, ML_NP, lds);
    convert_T(p.ml_uq  + (size_t)j * 384 * 3072, (u16*)(p.ws + O_WUQ)   + (size_t)j * 3072 * 384, 384, 3072, 3072, lds);
    convert_T(p.ml_ukv + (size_t)j * 256 * 4096, (u16*)(p.ws + O_WUKV)  + (size_t)j * 4096 * 256, 256, 4096, 4096, lds);
    convert_T(p.ml_out + (size_t)j * EI * DM,   (u16*)(p.ws + O_WMLOUT) + (size_t)j * DM * EI,   EI, DM, DM, lds);
  }
  float* ct = (float*)(p.ws + O_COS); float* st = (float*)(p.ws + O_SIN);
  const int tid_ = ltid();
  for (int i = blockIdx.x * 512 + tid_; i < 16384 * 32; i += gridDim.x * 512) {
    const int pos = i >> 5, j = i & 31;
    const float invf = 1.0f / powf(10000.0f, (float)(2 * j) / 64.0f);
    const float ang = (float)pos * invf;
    const double a = (double)ang;
    const double n = rint(a * 0.15915494309189535);
    const float r = (float)(a - n * 6.283185307179586);
    ct[i] = cosf(r); st[i] = sinf(r);
  }
}

DEV void rms_phase(const float* __restrict__ x, const float* __restrict__ g, u16* __restrict__ hout) {
  const int tid_ = ltid(); const int lane = tid_ & 63, wid = __builtin_amdgcn_readfirstlane(tid_ >> 6);
  for (int tok = blockIdx.x * 8 + wid; tok < GT; tok += gridDim.x * 8) {
    const float4* xr = (const float4*)(x + (size_t)tok * DM);
    float4 v[4]; float ss = 0.f;
#pragma unroll
    for (int i = 0; i < 4; ++i) { v[i] = xr[lane + i * 64]; ss += v[i].x * v[i].x + v[i].y * v[i].y + v[i].z * v[i].z + v[i].w * v[i].w; }
    ss = wsum(ss);
    const float sc = rsqrtf(ss * (1.f / DM) + 1e-6f);
#pragma unroll
    for (int i = 0; i < 4; ++i) {
      const float4 gg = ((const float4*)g)[lane + i * 64];
      u32x2 w; w[0] = cvtpk(v[i].x * sc * gg.x, v[i].y * sc * gg.y); w[1] = cvtpk(v[i].z * sc * gg.z, v[i].w * sc * gg.w);
      *(u32x2*)(hout + (size_t)tok * DM + (lane + i * 64) * 4) = w;
    }
  }
}

DEV void final_phase(float* __restrict__ x, const float* __restrict__ g) {
  const int tid_ = ltid(); const int lane = tid_ & 63, wid = __builtin_amdgcn_readfirstlane(tid_ >> 6);
  for (int tok = blockIdx.x * 8 + wid; tok < NTOK; tok += gridDim.x * 8) {
    float4* xr = (float4*)(x + (size_t)tok * DM);
    float4 v[4]; float ss = 0.f;
#pragma unroll
    for (int i = 0; i < 4; ++i) { v[i] = xr[lane + i * 64]; ss += v[i].x * v[i].x + v[i].y * v[i].y + v[i].z * v[i].z + v[i].w * v[i].w; }
    ss = wsum(ss);
    const float sc = rsqrtf(ss * (1.f / DM) + 1e-6f);
#pragma unroll
    for (int i = 0; i < 4; ++i) {
      const float4 gg = ((const float4*)g)[lane + i * 64];
      float4 ov = make_float4(v[i].x * sc * gg.x, v[i].y * sc * gg.y, v[i].z * sc * gg.z, v[i].w * sc * gg.w);
      xr[lane + i * 64] = ov;
    }
  }
}


DEV void lerp_phase(const u16* __restrict__ h, const float* __restrict__ mu, u16* __restrict__ out, int T) {
  const int tid_ = ltid(); const int lane = tid_ & 63, wid = __builtin_amdgcn_readfirstlane(tid_ >> 6);
  for (int tok = blockIdx.x * 8 + wid; tok < GT; tok += gridDim.x * 8) {
    const int pos = tok % T;
#pragma unroll
    for (int half = 0; half < 2; ++half) {
      const int c0 = half * 512 + lane * 8;
      const u32x4 c = *(const u32x4*)(h + (size_t)tok * DM + c0);
      u32x4 pv = {0u, 0u, 0u, 0u}, nx = {0u, 0u, 0u, 0u};
      if (pos > 0) pv = *(const u32x4*)(h + (size_t)(tok - 1) * DM + c0);
      if (pos < T - 1) nx = *(const u32x4*)(h + (size_t)(tok + 1) * DM + c0);
      float hh[8], xx[8];
#pragma unroll
      for (int e = 0; e < 4; ++e) {
        hh[2 * e] = bflo(c[e]); hh[2 * e + 1] = bfhi(c[e]);
        xx[2 * e] = 0.5f * (bflo(pv[e]) + bflo(nx[e])) - hh[2 * e]; xx[2 * e + 1] = 0.5f * (bfhi(pv[e]) + bfhi(nx[e])) - hh[2 * e + 1];
      }
#pragma unroll
      for (int st = 0; st < 4; ++st) {
        const int mi = st == 0 ? 0 : st == 1 ? 2 : st == 2 ? 3 : 5;
        const float4 m0v = *(const float4*)(mu + mi * DM + c0), m1v = *(const float4*)(mu + mi * DM + c0 + 4);
        const float m[8] = {m0v.x, m0v.y, m0v.z, m0v.w, m1v.x, m1v.y, m1v.z, m1v.w};
        u32x4 o;
#pragma unroll
        for (int e = 0; e < 4; ++e) o[e] = cvtpk(hh[2 * e] + m[2 * e] * xx[2 * e], hh[2 * e + 1] + m[2 * e + 1] * xx[2 * e + 1]);
        *(u32x4*)(out + (size_t)st * GT * DM + (size_t)tok * DM + c0) = o;
      }
    }
  }
}

#define GSWZ(row, c16) ((row) * 128 + ((((c16) ^ ((row) >> 1)) & 7) << 4))
constexpr int LOAD_PLAIN = 0, LOAD_LERP = 1;
constexpr int EPI_RWKV = 0, EPI_RES = 1, EPI_MLAIN = 2, EPI_BF16 = 3;
struct GemmP {
  const u16* A; int lda; const u16* Bt; int K; int NT;
  const float* mu;
  int T;
  u16* o0; u16* o1; u16* o2; u16* o3; u16* o4; u16* o5;
  int ldc;
  float* of; const float* xin; float* xout; int dry;
  int nt0; size_t astride;
};

template <int LOAD, int EPI, int NI>
DEV void gemm_phase(const GemmP& g, char* lds) {
  constexpr int BN = 64 * NI, SBB = BN * 128;
  const int tid = ltid(), wid = __builtin_amdgcn_readfirstlane(tid >> 6), lane = tid & 63, r32 = lane & 31, hi = lane >> 5;
  const int wm = wid >> 1, wn = wid & 1;
  char* sA = lds; char* sB = lds + 65536;
  int Kv = g.K; asm volatile("" : "+s"(Kv));
  const int nk = Kv / 64, ntiles = 64 * g.NT;
  const int c16 = tid & 7, rowb = tid >> 3;
  for (int t = blockIdx.x; t < ntiles; t += gridDim.x) {
    const int mt = t & 63, nt = g.nt0 + (t >> 6), m0 = mt * 256, n0 = nt * BN;
    const u16* Ab = g.A + (size_t)(n0 >> 11) * g.astride;
    f32x16 acc[2][NI] = {};
    bf16x8 ra[4], rb[NI];
    const float* mup = nullptr;
    if constexpr (LOAD == LOAD_LERP) {
      const int s = n0 < 2048 ? 0 : n0 < 4096 ? 2 : n0 < 6144 ? 3 : n0 < 8192 ? 5 : n0 == 8192 ? 1 : 4;
      mup = g.mu + s * DM;
    }
    auto gload = [&](int kt) {
      const int k0 = kt * 64 + c16 * 8;
#pragma unroll
      for (int i = 0; i < 4; ++i) {
        const int row = rowb + i * 64; const size_t tok = (size_t)(m0 + row);
        if constexpr (LOAD == LOAD_PLAIN) {
          ra[i] = *(const bf16x8*)(Ab + tok * g.lda + k0);
        } else {
          const int pos = (int)(tok % (size_t)g.T);
          const u32x4 c = *(const u32x4*)(g.A + tok * DM + k0);
          u32x4 pv = {0u, 0u, 0u, 0u}, nx = {0u, 0u, 0u, 0u};
          if (pos > 0) pv = *(const u32x4*)(g.A + (tok - 1) * DM + k0);
          if (pos < g.T - 1) nx = *(const u32x4*)(g.A + (tok + 1) * DM + k0);
          const float4 m0v = *(const float4*)(mup + k0), m1v = *(const float4*)(mup + k0 + 4);
          const float mu[8] = {m0v.x, m0v.y, m0v.z, m0v.w, m1v.x, m1v.y, m1v.z, m1v.w};
          u32x4 o;
#pragma unroll
          for (int e = 0; e < 4; ++e) {
            const float h0 = bflo(c[e]), h1 = bfhi(c[e]);
            const float x0 = 0.5f * (bflo(pv[e]) + bflo(nx[e])) - h0, x1 = 0.5f * (bfhi(pv[e]) + bfhi(nx[e])) - h1;
            o[e] = cvtpk(h0 + mu[2 * e] * x0, h1 + mu[2 * e + 1] * x1);
          }
          ra[i] = *(bf16x8*)&o;
        }
      }
#pragma unroll
      for (int i = 0; i < NI; ++i) {
        const int row = rowb + i * 64;
        rb[i] = *(const bf16x8*)(g.Bt + (size_t)(n0 + row) * Kv + k0);
      }
    };
    auto swrite = [&](int b) {
#pragma unroll
      for (int i = 0; i < 4; ++i) { const int row = rowb + i * 64; *(bf16x8*)(sA + b * 32768 + GSWZ(row, c16)) = ra[i]; }
#pragma unroll
      for (int i = 0; i < NI; ++i) { const int row = rowb + i * 64; *(bf16x8*)(sB + b * SBB + GSWZ(row, c16)) = rb[i]; }
    };
    gload(0); swrite(0); __syncthreads();
    for (int kt = 0; kt < nk; ++kt) {
      const int b = kt & 1;
      if (kt + 1 < nk) gload(kt + 1);
      const char* a_ = sA + b * 32768; const char* b_ = sB + b * SBB;
#pragma unroll
      for (int ks = 0; ks < 4; ++ks) {
        bf16x8 af[2], bfr[NI];
#pragma unroll
        for (int mi = 0; mi < 2; ++mi) { const int row = wm * 64 + mi * 32 + r32; af[mi] = *(const bf16x8*)(a_ + GSWZ(row, ks * 2 + hi)); }
#pragma unroll
        for (int ni = 0; ni < NI; ++ni) { const int row = wn * (32 * NI) + ni * 32 + r32; bfr[ni] = *(const bf16x8*)(b_ + GSWZ(row, ks * 2 + hi)); }
#pragma unroll
        for (int mi = 0; mi < 2; ++mi)
#pragma unroll
          for (int ni = 0; ni < NI; ++ni) acc[mi][ni] = __builtin_amdgcn_mfma_f32_32x32x16_bf16(af[mi], bfr[ni], acc[mi][ni], 0, 0, 0);
      }
      if (kt + 1 < nk) swrite(b ^ 1);
      __syncthreads();
    }
    if (!g.dry)
#pragma unroll
    for (int mi = 0; mi < 2; ++mi)
#pragma unroll
      for (int ni = 0; ni < NI; ++ni)
#pragma unroll
        for (int r = 0; r < 16; ++r) {
          const size_t m = (size_t)(m0 + wm * 64 + mi * 32 + crow(r, hi));
          const int nl = wn * (32 * NI) + ni * 32 + r32, n = n0 + nl;
          const float v = acc[mi][ni][r];
          if constexpr (EPI == EPI_RWKV) {
            if (n0 < 8192) {
              const int which = n0 >> 11, col = n & 2047;
              u16* dst = which == 0 ? g.o0 : which == 1 ? g.o1 : which == 2 ? g.o2 : g.o3;
              dst[m * EI + col] = f2bf(which == 3 ? siluf(v) : v);
            } else if (n0 == 8192) g.o4[m * 128 + nl] = f2bf(tanhf(v));
            else g.o5[m * 128 + nl] = f2bf(v);
          } else if constexpr (EPI == EPI_RES) {
            g.xout[m * DM + n] = g.xin[m * DM + n] + v;
          } else if constexpr (EPI == EPI_MLAIN) {
            if (n < 704) g.of[m * 704 + n] = v;
            else if (n < ML_N) g.o0[m * EI + (n - 704)] = f2bf(siluf(v));
          } else {
            g.o0[m * g.ldc + n] = f2bf(v);
          }
        }
  }
}

struct ScanP {
  const u16 *r, *k, *v, *twl, *al; u16 *yf, *yb; float* bonus;
  const float *w0, *w2, *a0, *a2, *kk, *ka, *rk;
  int nseq, T;
  float* tbuf; int nseg;
};
template <int CTRL> DEV float dppf(float x) {
  return __int_as_float(__builtin_amdgcn_update_dpp(0, __float_as_int(x), CTRL, 0xF, 0xF, false));
}
DEV float row_prefix16(float x) {
  x += dppf<0x111>(x); x += dppf<0x112>(x); x += dppf<0x114>(x); x += dppf<0x118>(x); return x;
}
DEV float row_total16(float x) {
  x += dppf<0x128>(x); x += dppf<0x124>(x); x += dppf<0x122>(x); x += dppf<0x121>(x); return x;
}
DEV bf16x8 pack8(float a0, float a1, float a2, float a3, float a4, float a5, float a6, float a7) {
  u32x4 w = {cvtpk(a0, a1), cvtpk(a2, a3), cvtpk(a4, a5), cvtpk(a6, a7)}; return *(bf16x8*)&w;
}
constexpr int SC_BKT = 0, SC_UVT = 5120, SC_AKM = 10240, SC_RR = 10752, SC_ABF = 11776, SC_Z = 12800, SC_PRM = 17152, SC_T = 18944, SC_WAVE = 35328;
constexpr int SC_PRE = SC_UVT;
constexpr int SC_SHARED_AW = 4 * SC_WAVE;
constexpr int SC_NW = 4;
DEV void scan_phase(const ScanP& s, char* lds_, const int pass) {
  const int tid = ltid(), wid = __builtin_amdgcn_readfirstlane(tid >> 6), lane = tid & 63, c16 = lane & 15, q = lane >> 4;
  const int nchain = s.nseq * 64, nseg = s.nseg;
  const int ipc = pass == 0 ? nseg * 2 : nseg;
  const bool shared = nchain <= (int)gridDim.x;
  const int nsb = shared ? (int)gridDim.x / nchain : 1, sbi = shared ? (int)blockIdx.x / nchain : 0;
  const int nwv = shared ? SC_NW : 2;
  if (shared && sbi >= nsb) return;
  char* wl = lds_ + (wid & 3) * SC_WAVE;
  u16* bkt = (u16*)(wl + SC_BKT); u16* uvt = (u16*)(wl + SC_UVT); u16* akm = (u16*)(wl + SC_AKM); u16* rr = (u16*)(wl + SC_RR);
  float* abf = (float*)(wl + SC_ABF); float* zl = (float*)(wl + SC_Z); float* prm = (float*)(wl + SC_PRM); float* p15l = prm + 320;
  bf16x8* awl = (bf16x8*)(shared ? lds_ + SC_SHARED_AW : lds_ + (2 + (wid & 1)) * SC_WAVE); bf16x8* aal = awl + 512;
#define SCAN_LOAD_W(CHAIN, F0, F1) do { const int d_ = (CHAIN) & 1, h_ = ((CHAIN) >> 1) & 31; \
    for (int f = (F0); f < (F1); ++f) { const int ks = f >> 2, mt = f & 3; u32x4 pw, pa; \
      _Pragma("unroll") for (int e = 0; e < 4; ++e) { const int l0 = ks * 32 + q * 8 + 2 * e; \
        const size_t i0 = ((size_t)(d_ * 64 + l0)) * EI + h_ * 64 + mt * 16 + c16; \
        pw[e] = cvtpk(s.w2[i0], s.w2[i0 + EI]); pa[e] = cvtpk(s.a2[i0], s.a2[i0 + EI]); } \
      awl[f * 64 + lane] = *(bf16x8*)&pw; aal[f * 64 + lane] = *(bf16x8*)&pa; } } while (0)
  if (shared) {
    const int chain_b = (int)blockIdx.x % nchain;
    SCAN_LOAD_W(chain_b, wid, wid + 1);
    __syncthreads();
  }
  if (wid >= nwv) return;
  const int nrounds = shared ? (ipc + nsb * SC_NW - 1) / (nsb * SC_NW) : (nchain + 2 * (int)gridDim.x - 1) / (2 * (int)gridDim.x);
  for (int round = 0; round < nrounds; ++round) {
    const int chain = shared ? (int)blockIdx.x % nchain : (round * 2 + wid) * (int)gridDim.x + (int)blockIdx.x;
    const int it = shared ? sbi * SC_NW + wid + round * nsb * SC_NW : 0;
    if (chain >= nchain || it >= ipc) continue;
    const int kind = pass == 0 ? 1 + (it & 1) : 0;
    const int seg = pass == 0 ? it >> 1 : it;
    const int cs = chain * nseg + seg;
    const int d = chain & 1, h = (chain >> 1) & 31, b = chain >> 6;
    {
      const int ch = h * 64 + lane;
      lds_wait();
      prm[lane] = s.w0[d * EI + ch]; prm[64 + lane] = s.a0[d * EI + ch]; prm[128 + lane] = s.kk[ch]; prm[192 + lane] = s.ka[ch]; prm[256 + lane] = s.rk[ch];
      lds_wait();
    }
    if (!shared) { SCAN_LOAD_W(chain, 0, 8); lds_wait(); }
    const unsigned rowi = (unsigned)(d ? 15 - c16 : c16);
    const unsigned off_tw = rowi * 256u + (unsigned)(q * 16);
    const unsigned off_kr = rowi * 4096u + (unsigned)(h * 128 + q * 8);
    const unsigned off_v  = (unsigned)(h * 128 + lane * 2);
    const unsigned off_y0 = (unsigned)(d ? 15 - 4 * q : 4 * q) * 4096u + (unsigned)(h * 128 + c16 * 2);
    const int ystep = d ? -4096 : 4096;
    f32x4* Tl = (f32x4*)(wl + SC_T);
#pragma unroll
    for (int m = 0; m < 16; ++m) {
      f32x4 t0v = {0.f, 0.f, 0.f, 0.f};
      if (kind == 2) {
        const int mt = m >> 2, nt = m & 3;
        if (mt == nt) { t0v[0] = (4 * q + 0 == c16) ? 1.f : 0.f; t0v[1] = (4 * q + 1 == c16) ? 1.f : 0.f; t0v[2] = (4 * q + 2 == c16) ? 1.f : 0.f; t0v[3] = (4 * q + 3 == c16) ? 1.f : 0.f; }
      } else if (kind == 0 && nseg > 1) {
        t0v = *(const f32x4*)(s.tbuf + ((size_t)cs * 2) * 4096 + (m * 64 + lane) * 4);
      }
      Tl[m * 64 + lane] = t0v;
    }
    u16* yout = d ? s.yb : s.yf;
    const size_t sb = (size_t)b * s.T;
    const int cps = s.T / 16 / nseg, cbeg = seg * cps, cend = cbeg + cps;
    bf16x8 n_tw0, n_tw1, n_ta0, n_ta1; u32x2 n_k[4], n_r[4];
#define SCAN_LOAD(CC) do { const int c0n = d ? (s.T - 16 - (CC) * 16) : (CC) * 16; const size_t t0n = sb + c0n; \
      size_t p_tw = (size_t)s.twl + t0n * 256 + d * 128, p_al = (size_t)s.al + t0n * 256 + d * 128, p_k = (size_t)s.k + t0n * 4096, p_r = (size_t)s.r + t0n * 4096 ; \
      asm volatile("" : "+s"(p_tw), "+s"(p_al), "+s"(p_k), "+s"(p_r)); \
      n_tw0 = gld<bf16x8>(p_tw, off_tw); n_tw1 = gld<bf16x8>(p_tw, off_tw + 64); n_ta0 = gld<bf16x8>(p_al, off_tw); n_ta1 = gld<bf16x8>(p_al, off_tw + 64); \
      _Pragma("unroll") for (int mt = 0; mt < 4; ++mt) { n_k[mt] = gld<u32x2>(p_k, off_kr + mt * 32); n_r[mt] = gld<u32x2>(p_r, off_kr + mt * 32); } } while (0)
    SCAN_LOAD(cbeg);
    for (int cc = cbeg; cc < cend; ++cc) {
      const int c0 = d ? (s.T - 16 - cc * 16) : cc * 16;
      const size_t t0 = sb + c0;
      size_t b_y = (size_t)yout + t0 * 4096, b_bon = (size_t)s.bonus + t0 * 256 + (h * 2 + d) * 4;
      asm volatile("" : "+s"(b_y), "+s"(b_bon));
      size_t b_v = (size_t)s.v + t0 * 4096; asm volatile("" : "+s"(b_v));
      u32x2 n_v[4];
#pragma unroll
      for (int mt = 0; mt < 4; ++mt) n_v[mt] = gld<u32x2>(b_v, off_kr + mt * 32);
      {
        f32x4* wpl = (f32x4*)zl; f32x4* apl = (f32x4*)(wl + SC_PRE);
#pragma unroll
        for (int mt = 0; mt < 4; ++mt) {
          f32x4 cw = {0.f, 0.f, 0.f, 0.f}, ca = {0.f, 0.f, 0.f, 0.f};
          cw = __builtin_amdgcn_mfma_f32_16x16x32_bf16(awl[(0 * 4 + mt) * 64 + lane], n_tw0, cw, 0, 0, 0);
          cw = __builtin_amdgcn_mfma_f32_16x16x32_bf16(awl[(1 * 4 + mt) * 64 + lane], n_tw1, cw, 0, 0, 0);
          ca = __builtin_amdgcn_mfma_f32_16x16x32_bf16(aal[(0 * 4 + mt) * 64 + lane], n_ta0, ca, 0, 0, 0);
          ca = __builtin_amdgcn_mfma_f32_16x16x32_bf16(aal[(1 * 4 + mt) * 64 + lane], n_ta1, ca, 0, 0, 0);
          wpl[mt * 64 + lane] = cw; apl[mt * 64 + lane] = ca;
        }
      }
      float n2 = 0.f;
#pragma unroll
      for (int mt = 0; mt < 4; ++mt) {
        const float4 kkp = *(const float4*)(prm + 128 + mt * 16 + q * 4);
        const float t0 = bflo(n_k[mt][0]) * kkp.x, t1 = bfhi(n_k[mt][0]) * kkp.y, t2 = bflo(n_k[mt][1]) * kkp.z, t3 = bfhi(n_k[mt][1]) * kkp.w;
        n2 += t0 * t0 + t1 * t1 + t2 * t2 + t3 * t3;
      }
      n2 += __shfl_xor(n2, 16, 64); n2 += __shfl_xor(n2, 32, 64);
      const float invn = __builtin_amdgcn_rsqf(fmaxf(n2, 1e-24f));
      float bon = 0.f;
      bf16x8 ktf[2], btf[2], kdf[2], rtf[2];
#pragma unroll
      for (int ks = 0; ks < 2; ++ks) {
        float ktl[8], btl[8], kdl[8], rtl[8];
#pragma unroll
        for (int mh = 0; mh < 2; ++mh) {
          const int mt = 2 * ks + mh;
          const f32x4 cw = ((const f32x4*)zl)[mt * 64 + lane], ca = ((const f32x4*)(wl + SC_PRE))[mt * 64 + lane];
          const float4 w0p = *(const float4*)(prm + mt * 16 + q * 4), a0p = *(const float4*)(prm + 64 + mt * 16 + q * 4);
          const float4 kkp = *(const float4*)(prm + 128 + mt * 16 + q * 4), kap = *(const float4*)(prm + 192 + mt * 16 + q * 4), rkp = *(const float4*)(prm + 256 + mt * 16 + q * 4);
          const float w0a[4] = {w0p.x, w0p.y, w0p.z, w0p.w}, a0a[4] = {a0p.x, a0p.y, a0p.z, a0p.w};
          const float kka[4] = {kkp.x, kkp.y, kkp.z, kkp.w}, kaa[4] = {kap.x, kap.y, kap.z, kap.w}, rka[4] = {rkp.x, rkp.y, rkp.z, rkp.w};
          const u32x2 kr_ = n_k[mt], rr_ = n_r[mt];
          const float kxa[4] = {bflo(kr_[0]), bfhi(kr_[0]), bflo(kr_[1]), bfhi(kr_[1])};
          const float rxa[4] = {bflo(rr_[0]), bfhi(rr_[0]), bflo(rr_[1]), bfhi(rr_[1])};
          float4 p15v;
#pragma unroll
          for (int e = 0; e < 4; ++e) {
            const float wp = cw[e] + w0a[e], ap = ca[e] + a0a[e];
            const float ee = 0.6065306597126334f * __builtin_amdgcn_rcpf(1.f + __expf(-wp));
            const float a = __builtin_amdgcn_rcpf(1.f + __expf(-ap));
            const float kkn = kxa[e] * kka[e] * invn;
            const float kd = kxa[e] * (1.f + (a - 1.f) * kaa[e]);
            const float bb = kkn * a;
            bon += rxa[e] * kd * rka[e];
            const float Ei = row_prefix16(ee);
            const float pm = __expf(-Ei), pp = __builtin_amdgcn_rcpf(pm);
            const float pm1s = dppf<0x111>(pm), pm1 = c16 == 0 ? 1.f : pm1s;
            ktl[mh * 4 + e] = kkn * pm1; btl[mh * 4 + e] = bb * pp; kdl[mh * 4 + e] = kd * pp; rtl[mh * 4 + e] = rxa[e] * pm;
            ((float*)&p15v)[e] = pm;
          }
          if (c16 == 15) *(float4*)(p15l + mt * 16 + q * 4) = p15v;
          SBAR();
        }
        ktf[ks] = pack8(ktl[0], ktl[1], ktl[2], ktl[3], ktl[4], ktl[5], ktl[6], ktl[7]);
        btf[ks] = pack8(btl[0], btl[1], btl[2], btl[3], btl[4], btl[5], btl[6], btl[7]);
        kdf[ks] = pack8(kdl[0], kdl[1], kdl[2], kdl[3], kdl[4], kdl[5], kdl[6], kdl[7]);
        rtf[ks] = pack8(rtl[0], rtl[1], rtl[2], rtl[3], rtl[4], rtl[5], rtl[6], rtl[7]);
        {
          const u32x4 bw_ = *(const u32x4*)&btf[ks], kw_ = *(const u32x4*)&kdf[ks];
#pragma unroll
          for (int w = 0; w < 4; ++w) {
            const int j = (2 * ks + (w >> 1)) * 16 + q * 4 + (w & 1) * 2;
            bkt[j * 40 + c16] = (u16)(bw_[w] & 0xffffu); bkt[(j + 1) * 40 + c16] = (u16)(bw_[w] >> 16);
            bkt[j * 40 + 16 + c16] = (u16)(kw_[w] & 0xffffu); bkt[(j + 1) * 40 + 16 + c16] = (u16)(kw_[w] >> 16);
          }
        }
      }
      bon += __shfl_xor(bon, 16, 64); bon += __shfl_xor(bon, 32, 64);
      if (q == 0 && kind == 0) gst<float>(b_bon, off_tw, bon);
      SBAR();
      SBAR();
#pragma unroll
      for (int mt = 0; mt < 4; ++mt) {
        const int vb_ = (mt * 16 + q * 4) * 40 + 16 + c16;
        const unsigned v0_ = kind == 2 ? 0u : n_v[mt][0], v1_ = kind == 2 ? 0u : n_v[mt][1];
        uvt[vb_] = (u16)(v0_ & 0xffffu); uvt[vb_ + 40] = (u16)(v0_ >> 16);
        uvt[vb_ + 80] = (u16)(v1_ & 0xffffu); uvt[vb_ + 120] = (u16)(v1_ >> 16);
      }
      { const int cn = cc + 1 < cend ? cc + 1 : cc; SCAN_LOAD(cn); }
      SBAR();
      {
        f32x4 AB = {0.f, 0.f, 0.f, 0.f}, AK = AB, RB = AB, RK = AB;
        int qm = q; asm volatile("" : "+v"(qm));
#pragma unroll
        for (int ks = 0; ks < 2; ++ks) {
          AB = __builtin_amdgcn_mfma_f32_16x16x32_bf16(ktf[ks], btf[ks], AB, 0, 0, 0);
          AK = __builtin_amdgcn_mfma_f32_16x16x32_bf16(ktf[ks], kdf[ks], AK, 0, 0, 0);
          RB = __builtin_amdgcn_mfma_f32_16x16x32_bf16(rtf[ks], btf[ks], RB, 0, 0, 0);
          RK = __builtin_amdgcn_mfma_f32_16x16x32_bf16(rtf[ks], kdf[ks], RK, 0, 0, 0);
        }
#pragma unroll
        for (int r = 0; r < 4; ++r) {
          const int i = 4 * qm + r;
          const bool lo = c16 < i, le = c16 <= i;
          abf[i * 16 + c16] = lo ? AB[r] : 0.f;
          akm[i * 16 + c16] = f2bf(lo ? AK[r] : 0.f);
          rr[i * 32 + c16] = f2bf(le ? RB[r] : 0.f);
          rr[i * 32 + 16 + c16] = f2bf(le ? RK[r] : 0.f);
        }
      }
#define TFRAG(ks, nt, OUT) do { const f32x4 ta_ = Tl[((2 * (ks)) * 4 + (nt)) * 64 + lane], tb_ = Tl[((2 * (ks) + 1) * 4 + (nt)) * 64 + lane]; \
        OUT = pack8(ta_[0], ta_[1], ta_[2], ta_[3], tb_[0], tb_[1], tb_[2], tb_[3]); } while (0)
      lds_wait();
      {
        bf16x8 akf = {0, 0, 0, 0, 0, 0, 0, 0};
        if (q < 2) akf = *(const bf16x8*)(akm + c16 * 16 + q * 8);
#pragma unroll
        for (int nt = 0; nt < 4; ++nt) {
          f32x4 z = {0.f, 0.f, 0.f, 0.f};
          bf16x8 tf0, tf1; TFRAG(0, nt, tf0); TFRAG(1, nt, tf1);
          z = __builtin_amdgcn_mfma_f32_16x16x32_bf16(ktf[0], tf0, z, 0, 0, 0);
          z = __builtin_amdgcn_mfma_f32_16x16x32_bf16(ktf[1], tf1, z, 0, 0, 0);
          const bf16x8 vf = *(const bf16x8*)(uvt + (nt * 16 + c16) * 40 + 16 + (q & 1) * 8);
          z = __builtin_amdgcn_mfma_f32_16x16x32_bf16(akf, vf, z, 0, 0, 0);
#pragma unroll
          for (int r = 0; r < 4; ++r) zl[(4 * q + r) * 68 + nt * 16 + c16] = z[r];
        }
      }
      lds_wait();
      SBAR();
      {
        float U[16];
#pragma unroll
        for (int i = 0; i < 16; ++i) {
          float acc = -zl[i * 68 + lane];
#pragma unroll
          for (int s4 = 0; s4 < (i + 3) / 4; ++s4) {
            const float4 a4 = *(const float4*)(abf + i * 16 + s4 * 4);
            if (s4 * 4 + 0 < i) acc -= a4.x * U[s4 * 4 + 0];
            if (s4 * 4 + 1 < i) acc -= a4.y * U[s4 * 4 + 1];
            if (s4 * 4 + 2 < i) acc -= a4.z * U[s4 * 4 + 2];
            if (s4 * 4 + 3 < i) acc -= a4.w * U[s4 * 4 + 3];
          }
          U[i] = acc;
          if ((i & 3) == 3) SBAR();
        }
        *(bf16x8*)(uvt + lane * 40) = pack8(U[0], U[1], U[2], U[3], U[4], U[5], U[6], U[7]);
        *(bf16x8*)(uvt + lane * 40 + 8) = pack8(U[8], U[9], U[10], U[11], U[12], U[13], U[14], U[15]);
      }
      lds_wait();
      SBAR();
      {
        const bf16x8 rrf = *(const bf16x8*)(rr + c16 * 32 + q * 8);
        bf16x8 uvf[4];
#pragma unroll
        for (int nt = 0; nt < 4; ++nt) uvf[nt] = *(const bf16x8*)(uvt + (nt * 16 + c16) * 40 + q * 8);
#pragma unroll
        for (int nt = 0; nt < 4; ++nt) {
          f32x4 y = {0.f, 0.f, 0.f, 0.f};
          bf16x8 tf0, tf1; TFRAG(0, nt, tf0); TFRAG(1, nt, tf1);
          y = __builtin_amdgcn_mfma_f32_16x16x32_bf16(rtf[0], tf0, y, 0, 0, 0);
          y = __builtin_amdgcn_mfma_f32_16x16x32_bf16(rtf[1], tf1, y, 0, 0, 0);
          y = __builtin_amdgcn_mfma_f32_16x16x32_bf16(rrf, uvf[nt], y, 0, 0, 0);
#pragma unroll
          for (int r = 0; r < 4; ++r) { if (kind == 0) gst<u16>(b_y, off_y0 + (unsigned)(r * ystep) + nt * 32, f2bf(y[r])); }
        }
#pragma unroll
        for (int mt = 0; mt < 4; ++mt) {
          const bf16x8 bkf = *(const bf16x8*)(bkt + (mt * 16 + c16) * 40 + q * 8);
          const float4 pq = *(const float4*)(p15l + mt * 16 + q * 4);
#pragma unroll
          for (int nt = 0; nt < 4; ++nt) {
            f32x4 t = __builtin_amdgcn_mfma_f32_16x16x32_bf16(bkf, uvf[nt], Tl[(mt * 4 + nt) * 64 + lane], 0, 0, 0);
            t[0] *= pq.x; t[1] *= pq.y; t[2] *= pq.z; t[3] *= pq.w;
            Tl[(mt * 4 + nt) * 64 + lane] = t;
          }
        }
      }
      lds_wait();
    }
    if (pass == 0) {
      float* dst = s.tbuf + ((size_t)cs * 2 + (kind - 1)) * 4096;
#pragma unroll
      for (int m = 0; m < 16; ++m) *(f32x4*)(dst + (m * 64 + lane) * 4) = Tl[m * 64 + lane];
    }
  }
}

DEV void scan_combine_phase(const ScanP& s, char* lds_) {
  const int tid = ltid(), wid = __builtin_amdgcn_readfirstlane(tid >> 6), lane = tid & 63, c16 = lane & 15, q = lane >> 4;
  if (wid >= 2) return;
  float* til = (float*)(lds_ + wid * 16384);
  const int nchain = s.nseq * 64, nseg = s.nseg;
  for (int chain = wid * gridDim.x + blockIdx.x; chain < nchain; chain += 2 * gridDim.x) {
    f32x4 T[16];
#pragma unroll
    for (int m = 0; m < 16; ++m) T[m] = f32x4{0.f, 0.f, 0.f, 0.f};
    for (int seg = 0; seg < nseg; ++seg) {
      float* tn = s.tbuf + ((size_t)(chain * nseg + seg) * 2) * 4096; const float* ti = tn + 4096;
      lds_wait();
#pragma unroll
      for (int m = 0; m < 16; ++m) *(f32x4*)(til + (m * 64 + lane) * 4) = *(const f32x4*)(ti + (m * 64 + lane) * 4);
      lds_wait();
      f32x4 Tn[16];
#pragma unroll
      for (int m = 0; m < 16; ++m) Tn[m] = *(const f32x4*)(tn + (m * 64 + lane) * 4);
#pragma unroll
      for (int nt = 0; nt < 4; ++nt) {
        bf16x8 bh[2], bl[2];
#pragma unroll
        for (int ks = 0; ks < 2; ++ks) {
          const f32x4 ta = T[(2 * ks) * 4 + nt], tb = T[(2 * ks + 1) * 4 + nt];
          const float x[8] = {ta[0], ta[1], ta[2], ta[3], tb[0], tb[1], tb[2], tb[3]};
          float hf[8], lf[8];
#pragma unroll
          for (int e = 0; e < 8; ++e) { hf[e] = bf2f(f2bf(x[e])); lf[e] = x[e] - hf[e]; }
          bh[ks] = pack8(hf[0], hf[1], hf[2], hf[3], hf[4], hf[5], hf[6], hf[7]);
          bl[ks] = pack8(lf[0], lf[1], lf[2], lf[3], lf[4], lf[5], lf[6], lf[7]);
        }
#pragma unroll
        for (int mt = 0; mt < 4; ++mt) {
          f32x4 acc = Tn[mt * 4 + nt];
#pragma unroll
          for (int ks = 0; ks < 2; ++ks) {
            float x[8];
#pragma unroll
            for (int e = 0; e < 8; ++e) x[e] = til[((mt * 4 + 2 * ks + (e >> 2)) * 64 + ((c16 >> 2) & 3) * 16 + 4 * q + (e & 3)) * 4 + (c16 & 3)];
            float hf[8], lf[8];
#pragma unroll
            for (int e = 0; e < 8; ++e) { hf[e] = bf2f(f2bf(x[e])); lf[e] = x[e] - hf[e]; }
            const bf16x8 ah = pack8(hf[0], hf[1], hf[2], hf[3], hf[4], hf[5], hf[6], hf[7]);
            const bf16x8 al = pack8(lf[0], lf[1], lf[2], lf[3], lf[4], lf[5], lf[6], lf[7]);
            acc = __builtin_amdgcn_mfma_f32_16x16x32_bf16(ah, bh[ks], acc, 0, 0, 0);
            acc = __builtin_amdgcn_mfma_f32_16x16x32_bf16(ah, bl[ks], acc, 0, 0, 0);
            acc = __builtin_amdgcn_mfma_f32_16x16x32_bf16(al, bh[ks], acc, 0, 0, 0);
          }
          Tn[mt * 4 + nt] = acc;
        }
      }
#pragma unroll
      for (int m = 0; m < 16; ++m) { *(f32x4*)(tn + (m * 64 + lane) * 4) = T[m]; T[m] = Tn[m]; }
    }
  }
}

DEV void post_phase(u16* __restrict__ yf, const u16* __restrict__ yb, const u16* __restrict__ v, const u16* __restrict__ sg,
                    const float* __restrict__ bonus, const float* __restrict__ lg, const float* __restrict__ lb) {
  const int tid_ = ltid(); const int lane = tid_ & 63, wid = __builtin_amdgcn_readfirstlane(tid_ >> 6);
  for (int tok = blockIdx.x * 8 + wid; tok < GT; tok += gridDim.x * 8) {
#pragma unroll
    for (int it = 0; it < 4; ++it) {
      const int ch0 = it * 512 + lane * 8, h = ch0 >> 6; const size_t i = (size_t)tok * EI + ch0;
      const u32x4 a = *(const u32x4*)(yf + i), bq = *(const u32x4*)(yb + i), vv = *(const u32x4*)(v + i), gg = *(const u32x4*)(sg + i);
      const float2 bo = *(const float2*)(bonus + ((size_t)tok * 32 + h) * 2);
      float y[8]; float sum = 0.f;
#pragma unroll
      for (int e = 0; e < 4; ++e) { y[2 * e] = bflo(a[e]) + bflo(bq[e]); y[2 * e + 1] = bfhi(a[e]) + bfhi(bq[e]); sum += y[2 * e] + y[2 * e + 1]; }
      sum += __shfl_xor(sum, 1, 64); sum += __shfl_xor(sum, 2, 64); sum += __shfl_xor(sum, 4, 64);
      const float mean = sum * (1.f / 64.f);
      float var = 0.f;
#pragma unroll
      for (int e = 0; e < 8; ++e) { y[e] -= mean; var += y[e] * y[e]; }
      var += __shfl_xor(var, 1, 64); var += __shfl_xor(var, 2, 64); var += __shfl_xor(var, 4, 64);
      const float rs = rsqrtf(var * (1.f / 64.f) + 64e-5f), bon = bo.x + bo.y;
      const float4 g0 = *(const float4*)(lg + ch0), g1 = *(const float4*)(lg + ch0 + 4), b0 = *(const float4*)(lb + ch0), b1 = *(const float4*)(lb + ch0 + 4);
      const float ga[8] = {g0.x, g0.y, g0.z, g0.w, g1.x, g1.y, g1.z, g1.w}, ba[8] = {b0.x, b0.y, b0.z, b0.w, b1.x, b1.y, b1.z, b1.w};
      u32x4 o;
#pragma unroll
      for (int e = 0; e < 4; ++e) {
        const float o0 = (y[2 * e] * rs * ga[2 * e] + ba[2 * e] + bon * bflo(vv[e])) * bflo(gg[e]);
        const float o1 = (y[2 * e + 1] * rs * ga[2 * e + 1] + ba[2 * e + 1] + bon * bfhi(vv[e])) * bfhi(gg[e]);
        o[e] = cvtpk(o0, o1);
      }
      *(u32x4*)(yf + i) = o;
    }
  }
}

DEV void mla_mid_phase(const float* __restrict__ cqkv, const float* __restrict__ qn, const float* __restrict__ kvn,
                       const float* __restrict__ ct, const float* __restrict__ st,
                       u16* __restrict__ cqn, u16* __restrict__ ckvn, u16* __restrict__ kpe, int T) {
  const int tid_ = ltid(); const int lane = tid_ & 63, wid = __builtin_amdgcn_readfirstlane(tid_ >> 6);
  for (int tok = blockIdx.x * 8 + wid; tok < GT; tok += gridDim.x * 8) {
    const float* row = cqkv + (size_t)tok * 704;
    float q[6], ss = 0.f;
#pragma unroll
    for (int i = 0; i < 6; ++i) { q[i] = row[lane + i * 64]; ss += q[i] * q[i]; }
    ss = wsum(ss); float sc = rsqrtf(ss * (1.f / 384.f) + 1e-6f);
#pragma unroll
    for (int i = 0; i < 6; ++i) cqn[(size_t)tok * 384 + lane + i * 64] = f2bf(q[i] * sc * qn[lane + i * 64]);
    float c[4]; ss = 0.f;
#pragma unroll
    for (int i = 0; i < 4; ++i) { c[i] = row[384 + lane + i * 64]; ss += c[i] * c[i]; }
    ss = wsum(ss); sc = rsqrtf(ss * (1.f / 256.f) + 1e-6f);
#pragma unroll
    for (int i = 0; i < 4; ++i) ckvn[(size_t)tok * 256 + lane + i * 64] = f2bf(c[i] * sc * kvn[lane + i * 64]);
    const float x = row[640 + lane];
    const float xo = __shfl_xor(x, 32, 64);
    const int pos = tok % T, j = lane & 31;
    const float cs = ct[pos * 32 + j], sn = st[pos * 32 + j];
    const float o = lane < 32 ? x * cs - xo * sn : x * cs + xo * sn;
    kpe[(size_t)tok * 64 + lane] = f2bf(o);
  }
}

constexpr int SHM_V = 16384, SHM_K = 16384, SHM_KP = 8192;
#define KSWZ(row, colB) ((row) * 256 + ((colB) ^ (((row) & 7) << 4)))
#define KPSWZ(row, colB) ((row) * 128 + ((colB) ^ (((row) & 7) << 4)))
constexpr float ATT_SCALE = 0.07216878364870322f;
DEV void partialSM(f32x16& p0, f32x16& p1, float& m_reg, float& mn, float& alpha) {
  constexpr float C = ATT_SCALE * 1.4426950408889634f;
  float pmax = p0[0];
#pragma unroll
  for (int r = 1; r < 16; ++r) pmax = fmaxf(pmax, p0[r]);
#pragma unroll
  for (int r = 0; r < 16; ++r) pmax = fmaxf(pmax, p1[r]);
  { auto rr = __builtin_amdgcn_permlane32_swap(__float_as_uint(pmax), __float_as_uint(pmax), false, false);
    pmax = fmaxf(__uint_as_float(rr[0]), __uint_as_float(rr[1])); }
  if (__builtin_expect(__all(pmax - m_reg <= 8.f / ATT_SCALE), 1)) { mn = m_reg; alpha = 1.f; }
  else { mn = fmaxf(m_reg, pmax); alpha = __builtin_amdgcn_exp2f((m_reg - mn) * C); m_reg = mn; }
  const float mnC = -mn * C;
#pragma unroll
  for (int r = 0; r < 16; ++r) p0[r] = __builtin_amdgcn_exp2f(fmaf(p0[r], C, mnC));
#pragma unroll
  for (int r = 0; r < 16; ++r) p1[r] = __builtin_amdgcn_exp2f(fmaf(p1[r], C, mnC));
}
DEV void finishSM(f32x16& p0, f32x16& p1, float alpha, float& l_reg, bf16x8& pa0, bf16x8& pa1, bf16x8& pa2, bf16x8& pa3) {
  float ps = 0;
#pragma unroll
  for (int r = 0; r < 16; ++r) ps += p0[r];
#pragma unroll
  for (int r = 0; r < 16; ++r) ps += p1[r];
  { auto rr = __builtin_amdgcn_permlane32_swap(__float_as_uint(ps), __float_as_uint(ps), false, false);
    ps = __uint_as_float(rr[0]) + __uint_as_float(rr[1]); }
  l_reg = l_reg * alpha + ps;
#define PK4(PP, BASE, OUT) do { unsigned a0 = cvtpk(PP[BASE + 0], PP[BASE + 1]), a1 = cvtpk(PP[BASE + 2], PP[BASE + 3]);   \
    unsigned b0 = cvtpk(PP[BASE + 4], PP[BASE + 5]), b1 = cvtpk(PP[BASE + 6], PP[BASE + 7]);                              \
    auto r0 = __builtin_amdgcn_permlane32_swap(a0, b0, false, false); auto r1 = __builtin_amdgcn_permlane32_swap(a1, b1, false, false); \
    u32x4 w = {r0[0], r1[0], r0[1], r1[1]}; OUT = *reinterpret_cast<bf16x8*>(&w); } while (0)
  PK4(p0, 0, pa0); PK4(p0, 8, pa1); PK4(p1, 0, pa2); PK4(p1, 8, pa3);
#undef PK4
}
DEV int v_st(int k, int c) { const int kk = (k & ~0xC) | ((k & 4) << 1) | ((k & 8) >> 1); return ((kk >> 3) * 4 + (c >> 5)) * 512 + ((kk & 7) * 32 + (c & 31)) * 2; }
DEV int v_rd_base(int lane) { return ((lane & 3) << 3) | (((lane >> 2) & 3) << 6) | (((lane >> 4) & 1) << 5) | (((lane >> 5) & 1) << 8); }
constexpr int v_rd_off(int d0, int ks, int half) { return d0 * 512 + ks * 4096 + half * 2048; }
template <int OFF> DEV s16x4 tr_read(int vb) {
  s16x4 r; asm volatile("ds_read_b64_tr_b16 %0, %1 offset:%2" : "=&v"(r) : "v"(vb), "i"(OFF) : "memory"); return r;
}
template <int D0> DEV void pv_one(f32x16& od, int vb, bf16x8 pa0, bf16x8 pa1, bf16x8 pa2, bf16x8 pa3) {
  const s16x4 l0 = tr_read<v_rd_off(D0, 0, 0)>(vb), h0 = tr_read<v_rd_off(D0, 0, 1)>(vb), l1 = tr_read<v_rd_off(D0, 1, 0)>(vb), h1 = tr_read<v_rd_off(D0, 1, 1)>(vb);
  const s16x4 l2 = tr_read<v_rd_off(D0, 2, 0)>(vb), h2 = tr_read<v_rd_off(D0, 2, 1)>(vb), l3 = tr_read<v_rd_off(D0, 3, 0)>(vb), h3 = tr_read<v_rd_off(D0, 3, 1)>(vb);
  asm volatile("s_waitcnt lgkmcnt(0)" ::: "memory"); SBAR();
#define PK(L, H) (bf16x8){L[0], L[1], L[2], L[3], H[0], H[1], H[2], H[3]}
  od = __builtin_amdgcn_mfma_f32_32x32x16_bf16(pa0, PK(l0, h0), od, 0, 0, 0);
  od = __builtin_amdgcn_mfma_f32_32x32x16_bf16(pa1, PK(l1, h1), od, 0, 0, 0);
  od = __builtin_amdgcn_mfma_f32_32x32x16_bf16(pa2, PK(l2, h2), od, 0, 0, 0);
  od = __builtin_amdgcn_mfma_f32_32x32x16_bf16(pa3, PK(l3, h3), od, 0, 0, 0);
#undef PK
}

struct AttnP { const u16* q; const u16* kv; const u16* kpe; u16* sg; const float* ct; const float* st; int nseq, T; int dry; };
DEV void attn_phase(const AttnP& a, char* lds) {
  const int tid = ltid(), wid = __builtin_amdgcn_readfirstlane(tid >> 6), lane = tid & 63, r32 = lane & 31, hi = lane >> 5;
  char* V_lds = lds; char* K_lds = lds + 3 * SHM_V; char* KP_lds = lds + 3 * SHM_V + 2 * SHM_K;
  float* wsc = (float*)(lds + 3 * SHM_V + 2 * SHM_K + 2 * SHM_KP) + wid * 64; float* li_l = wsc; float* al_l = wsc + 32;
  const int nqb = a.T / 256, nitems = a.nseq * 16 * nqb, NT = a.T / 64;
  const int sr = tid >> 4, sc = (tid & 15) * 8, vst0 = v_st(sr, sc), vst1 = v_st(32 + sr, sc);
  const int pr = tid >> 3, pc = (tid & 7) * 8;
  const int vb0 = (int)(uintptr_t)V_lds + v_rd_base(lane);
  int kad[4], kpd[4];
#pragma unroll
  for (int q = 0; q < 4; ++q) { kad[q] = KSWZ(r32, q * 32 + hi * 16); kpd[q] = KPSWZ(r32, q * 32 + hi * 16); }
  for (int it = blockIdx.x; it < nitems; it += gridDim.x) {
    const int qb = it % nqb, h = (it / nqb) & 15, b = it / (nqb * 16);
    const size_t sbase = (size_t)b * a.T;
    const int pos = qb * 256 + wid * 32 + r32;
    bf16x8 qr[12];
    {
      const u16* Qw = a.q + (sbase + pos) * 3072 + h * 192 + hi * 8;
#pragma unroll
      for (int d0 = 0; d0 < 12; ++d0) qr[d0] = *(const bf16x8*)(Qw + d0 * 16);
#pragma unroll
      for (int dd = 0; dd < 2; ++dd) {
        const int j0 = dd * 16 + hi * 8;
        const float4 c0 = *(const float4*)(a.ct + pos * 32 + j0), c1 = *(const float4*)(a.ct + pos * 32 + j0 + 4);
        const float4 s0 = *(const float4*)(a.st + pos * 32 + j0), s1 = *(const float4*)(a.st + pos * 32 + j0 + 4);
        const float cs[8] = {c0.x, c0.y, c0.z, c0.w, c1.x, c1.y, c1.z, c1.w};
        const float sn[8] = {s0.x, s0.y, s0.z, s0.w, s1.x, s1.y, s1.z, s1.w};
        u32x4 x1 = *(u32x4*)&qr[8 + dd], x2 = *(u32x4*)&qr[10 + dd], y1, y2;
#pragma unroll
        for (int e = 0; e < 4; ++e) {
          const float a0 = bflo(x1[e]), a1 = bfhi(x1[e]), b0 = bflo(x2[e]), b1 = bfhi(x2[e]);
          y1[e] = cvtpk(a0 * cs[2 * e] - b0 * sn[2 * e], a1 * cs[2 * e + 1] - b1 * sn[2 * e + 1]);
          y2[e] = cvtpk(b0 * cs[2 * e] + a0 * sn[2 * e], b1 * cs[2 * e + 1] + a1 * sn[2 * e + 1]);
        }
        qr[8 + dd] = *(bf16x8*)&y1; qr[10 + dd] = *(bf16x8*)&y2;
      }
    }
    float m_reg = -1e30f, l_reg = 0.f; f32x16 o[4] = {};
    bf16x8 vs0, vs1, ks0, ks1, kp0;
    const u16* kvh = a.kv + sbase * 4096 + h * 256;
    const u16* kph = a.kpe + sbase * 64;
    const unsigned voff = (unsigned)(sr * 8192 + sc * 2), poff = (unsigned)(pr * 128 + pc * 2);
#define SLOAD(k0) do { const char* bK0 = (const char*)kvh + (size_t)(k0) * 8192; const char* bK1 = bK0 + 32 * 8192; const char* bP = (const char*)kph + (size_t)(k0) * 128; \
    vs0 = *(const bf16x8*)(bK0 + voff + 256); vs1 = *(const bf16x8*)(bK1 + voff + 256); \
    ks0 = *(const bf16x8*)(bK0 + voff); ks1 = *(const bf16x8*)(bK1 + voff); \
    kp0 = *(const bf16x8*)(bP + poff); } while (0)
#define SWRITE(bb, vbuf) do { *(bf16x8*)(V_lds + (vbuf) * SHM_V + vst0) = vs0; *(bf16x8*)(V_lds + (vbuf) * SHM_V + vst1) = vs1; \
    *(bf16x8*)(K_lds + (bb) * SHM_K + KSWZ(sr, sc * 2)) = ks0; *(bf16x8*)(K_lds + (bb) * SHM_K + KSWZ(32 + sr, sc * 2)) = ks1; \
    *(bf16x8*)(KP_lds + (bb) * SHM_KP + KPSWZ(pr, pc * 2)) = kp0; } while (0)
    __syncthreads();
    SLOAD(0); SWRITE(0, 0); __syncthreads();
    const bool grpB = wid >= 4;
    bf16x8 pa0, pa1, pa2, pa3;
    int vcur = 0, vprev = 2;
#define PV_ALL(vbuf) do { const int vb_ = vb0 + (vbuf) * SHM_V; \
      pv_one<0>(o[0], vb_, pa0, pa1, pa2, pa3); pv_one<1>(o[1], vb_, pa0, pa1, pa2, pa3); \
      pv_one<2>(o[2], vb_, pa0, pa1, pa2, pa3); pv_one<3>(o[3], vb_, pa0, pa1, pa2, pa3); } while (0)
    for (int j = 0; j < NT; ++j) {
      const int bb = j & 1;
      if (j + 1 < NT) SLOAD((j + 1) * 64);
      SBAR();
      if (grpB && j > 0) PV_ALL(vprev);
      f32x16 p0 = {}, p1 = {};
      {
        const char* Ks = K_lds + bb * SHM_K; const char* Kp = KP_lds + bb * SHM_KP;
#pragma unroll
        for (int d0 = 0; d0 < 8; ++d0) {
          const bf16x8 b0 = *(const bf16x8*)(Ks + kad[d0 & 3] + (d0 >> 2) * 128), b1 = *(const bf16x8*)(Ks + kad[d0 & 3] + (d0 >> 2) * 128 + 8192);
          p0 = __builtin_amdgcn_mfma_f32_32x32x16_bf16(b0, qr[d0], p0, 0, 0, 0);
          p1 = __builtin_amdgcn_mfma_f32_32x32x16_bf16(b1, qr[d0], p1, 0, 0, 0); }
#pragma unroll
        for (int d0 = 0; d0 < 4; ++d0) {
          const bf16x8 b0 = *(const bf16x8*)(Kp + kpd[d0]), b1 = *(const bf16x8*)(Kp + kpd[d0] + 4096);
          p0 = __builtin_amdgcn_mfma_f32_32x32x16_bf16(b0, qr[8 + d0], p0, 0, 0, 0);
          p1 = __builtin_amdgcn_mfma_f32_32x32x16_bf16(b1, qr[8 + d0], p1, 0, 0, 0); }
      }
      float mn, alpha;
      partialSM(p0, p1, m_reg, mn, alpha);
      if (__any(alpha < 1.f)) {
        if (hi == 0) al_l[r32] = alpha;
        lds_wait();
#pragma unroll
        for (int dd = 0; dd < 4; ++dd)
#pragma unroll
          for (int r = 0; r < 16; ++r) o[dd][r] *= al_l[crow(r, hi)];
      }
      finishSM(p0, p1, alpha, l_reg, pa0, pa1, pa2, pa3); SBAR();
      if (!grpB) PV_ALL(vcur);
      const int vnext = vcur == 2 ? 0 : vcur + 1;
      if (j + 1 < NT) SWRITE(bb ^ 1, vnext);
      vprev = vcur; vcur = vnext;
      __syncthreads();
    }
    if (grpB) PV_ALL(vprev);
#undef PV_ALL
#undef SLOAD
#undef SWRITE
    {
      int t2 = threadIdx.x; asm volatile("" : "+v"(t2));
      const int wid2 = t2 >> 6, r2 = t2 & 31, hi2 = (t2 >> 5) & 1;
      float* li2 = (float*)(lds + 3 * SHM_V + 2 * SHM_K + 2 * SHM_KP) + wid2 * 64;
      if (hi2 == 0) li2[r2] = l_reg;
      lds_wait();
      u16* Ow = a.sg + (sbase + qb * 256 + wid2 * 32) * EI + h * 128 + r2;
#pragma unroll
      for (int r = 0; r < 16; ++r) {
        const int orow = crow(r, hi2);
        const float rl = __builtin_amdgcn_rcpf(li2[orow]);
#pragma unroll
        for (int d0 = 0; d0 < 4; ++d0) {
          u16* pp = Ow + (size_t)orow * EI + d0 * 32;
          if (!a.dry) *pp = f2bf(o[d0][r] * rl * bf2f(*pp));
        }
      }
    }
  }
}

#if MEGA
#define GRID_SYNC() gsync(p, lds)
#else
#define GRID_SYNC() do {} while (0)
#endif
struct Grp { const float* xin0; float* xres; int nseq, T; };
DEV Grp get_group(const P& p, int g) {
  Grp r;
  r.xin0 = g == 0 ? p.x_prompt : p.x_sample + (size_t)(g - 1) * GT * DM;
  r.xres = p.out + (size_t)g * GT * DM;
  r.nseq = g == 0 ? 8 : 1; r.T = g == 0 ? 2048 : 16384;
  return r;
}
template <int LT, int ph>
DEV void run_phase(const P& p, int g, int layer, char* lds) {
  const Grp G = get_group(p, g);
  const int j = layer >> 1;
  const float* xin = layer == 0 ? G.xin0 : G.xres;
  size_t zoff = 0; asm volatile("" : "+s"(zoff));
  char* ws = p.ws + zoff;
  u16* hbuf = (u16*)(ws + O_HBUF);
  u16* sg = (u16*)(ws + O_SG);
  if constexpr (LT == 0) {
    u16 *rb = (u16*)(ws + O_RB), *kb = (u16*)(ws + O_KB), *vb = (u16*)(ws + O_VB), *yf = (u16*)(ws + O_YF), *yb = (u16*)(ws + O_YB);
    u16 *twl = (u16*)(ws + O_TWL), *al = (u16*)(ws + O_AL); float* bon = (float*)(ws + O_BON);
    if constexpr (ph == 0) rms_phase(xin, p.ln_g + layer * DM, hbuf);
    else if constexpr (ph == 1) {
      GemmP q{}; q.A = hbuf; q.lda = DM; q.Bt = (const u16*)(ws + O_WRWIN) + (size_t)j * RW_N * DM; q.K = DM; q.NT = 66;
      q.mu = p.rw_mu + (size_t)j * 6 * DM; q.T = G.T; q.o0 = rb; q.o1 = kb; q.o2 = vb; q.o3 = sg; q.o4 = twl; q.o5 = al;
      lerp_phase(hbuf, q.mu, yf, G.T); GRID_SYNC();
      GemmP w = q; w.A = yf; w.astride = (size_t)GT * DM; w.NT = 32; w.nt0 = 0;
      gemm_phase<LOAD_PLAIN, EPI_RWKV, 4>(w, lds);
      q.NT = 2; q.nt0 = 64;
      gemm_phase<LOAD_LERP, EPI_RWKV, 2>(q, lds);
    } else if constexpr (ph == 2) {
      ScanP s{}; s.r = rb; s.k = kb; s.v = vb; s.twl = twl; s.al = al; s.yf = yf; s.yb = yb; s.bonus = bon;
      s.w0 = p.rw_w0 + (size_t)j * 2 * EI; s.w2 = p.rw_w2 + (size_t)j * 2 * 64 * EI; s.a0 = p.rw_a0 + (size_t)j * 2 * EI; s.a2 = p.rw_a2 + (size_t)j * 2 * 64 * EI;
      s.kk = p.rw_kk + (size_t)j * EI; s.ka = p.rw_ka + (size_t)j * EI; s.rk = p.rw_rk + (size_t)j * EI; s.nseq = G.nseq; s.T = G.T;
      s.tbuf = (float*)hbuf;
      if (G.T > 2048) {
        s.nseg = 16;
        scan_phase(s, lds, 0); GRID_SYNC();
        scan_combine_phase(s, lds); GRID_SYNC();
        scan_phase(s, lds, 1);
      } else { s.nseg = 1; scan_phase(s, lds, 1); }
    } else if constexpr (ph == 3) post_phase(yf, yb, vb, sg, bon, p.rw_lnx_g + (size_t)j * EI, p.rw_lnx_b + (size_t)j * EI);
    else {
      GemmP q{}; q.A = yf; q.lda = EI; q.Bt = (const u16*)(ws + O_WRWOUT) + (size_t)j * DM * EI; q.K = EI; q.NT = 4; q.xin = xin; q.xout = G.xres;
      for (int rep = 1; rep < REP_GEMM; ++rep) { q.dry = (gridDim.x != 12345); gemm_phase<LOAD_PLAIN, EPI_RES, 4>(q, lds); } q.dry = 0;
      gemm_phase<LOAD_PLAIN, EPI_RES, 4>(q, lds);
    }
  } else {
    float* cqkv = (float*)(ws + O_CQKV); u16 *cqn = (u16*)(ws + O_CQN), *ckvn = (u16*)(ws + O_CKVN), *kpe = (u16*)(ws + O_KPE), *qq = (u16*)(ws + O_Q), *kv = (u16*)(ws + O_KV);
    const float* ct = (const float*)(ws + O_COS); const float* st = (const float*)(ws + O_SIN);
    if constexpr (ph == 0) rms_phase(xin, p.ln_g + layer * DM, hbuf);
    else if constexpr (ph == 1) {
      GemmP q{}; q.A = hbuf; q.lda = DM; q.Bt = (const u16*)(ws + O_WMLIN) + (size_t)j * ML_NP * DM; q.K = DM; q.NT = 11; q.of = cqkv; q.o0 = sg;
      for (int rep = 1; rep < REP_GEMM; ++rep) { q.dry = (gridDim.x != 12345); gemm_phase<LOAD_PLAIN, EPI_MLAIN, 4>(q, lds); } q.dry = 0;
      gemm_phase<LOAD_PLAIN, EPI_MLAIN, 4>(q, lds);
    } else if constexpr (ph == 2) mla_mid_phase(cqkv, p.ml_qn + j * 384, p.ml_kvn + j * 256, ct, st, cqn, ckvn, kpe, G.T);
    else if constexpr (ph == 3) {
      GemmP q{}; q.A = cqn; q.lda = 384; q.Bt = (const u16*)(ws + O_WUQ) + (size_t)j * 3072 * 384; q.K = 384; q.NT = 12; q.o0 = qq; q.ldc = 3072;
      for (int rep = 1; rep < REP_GEMM; ++rep) { q.dry = (gridDim.x != 12345); gemm_phase<LOAD_PLAIN, EPI_BF16, 4>(q, lds); } q.dry = 0;
      gemm_phase<LOAD_PLAIN, EPI_BF16, 4>(q, lds);
      GemmP r{}; r.A = ckvn; r.lda = 256; r.Bt = (const u16*)(ws + O_WUKV) + (size_t)j * 4096 * 256; r.K = 256; r.NT = 16; r.o0 = kv; r.ldc = 4096;
      for (int rep = 1; rep < REP_GEMM; ++rep) { r.dry = (gridDim.x != 12345); gemm_phase<LOAD_PLAIN, EPI_BF16, 4>(r, lds); } r.dry = 0;
      gemm_phase<LOAD_PLAIN, EPI_BF16, 4>(r, lds);
    } else if constexpr (ph == 4) {
      AttnP a{}; a.q = qq; a.kv = kv; a.kpe = kpe; a.sg = sg; a.ct = ct; a.st = st; a.nseq = G.nseq; a.T = G.T;
      for (int rep = 1; rep < REP_ATTN; ++rep) { a.dry = (gridDim.x != 12345); attn_phase(a, lds); } a.dry = 0;
      attn_phase(a, lds);
    } else {
      GemmP q{}; q.A = sg; q.lda = EI; q.Bt = (const u16*)(ws + O_WMLOUT) + (size_t)j * DM * EI; q.K = EI; q.NT = 4; q.xin = xin; q.xout = G.xres;
      for (int rep = 1; rep < REP_GEMM; ++rep) { q.dry = (gridDim.x != 12345); gemm_phase<LOAD_PLAIN, EPI_RES, 4>(q, lds); } q.dry = 0;
      gemm_phase<LOAD_PLAIN, EPI_RES, 4>(q, lds);
    }
  }
}


template <int LT, int PH>
__global__ __launch_bounds__(512) void k_phase(P p, int g, int layer) {
  extern __shared__ __attribute__((aligned(16))) char lds[];
  if constexpr (LT == 2) { if constexpr (PH == 0) init_phase(p, lds); else final_phase(p.out, p.final_g); }
  else run_phase<LT, PH>(p, g, layer, lds);
}

#if MEGA
__global__ __launch_bounds__(512) void k_mega(P p) {
  extern __shared__ __attribute__((aligned(16))) char lds[];
  cg::grid_group grid = cg::this_grid();
  {
    unsigned* bar = (unsigned*)(p.ws + O_BAR);
    if (blockIdx.x == 0) for (int i = threadIdx.x; i < XCD_BAR_WORDS; i += 512) bar[i] = 0u;
    if (threadIdx.x == 0) { volatile LAS unsigned* st = (volatile LAS unsigned*)(lds + SHM_BYTES - 16); st[0] = 0u; st[1] = 0u; }
  }
  init_phase(p, lds);
  grid.sync();
  if (threadIdx.x == 0) (void)xb_add(&((unsigned*)(p.ws + O_BAR))[XB_XCNT(xb_xcc_id())], 1u);
  for (int g = 0; g < 3; ++g)
    for (int layer = 0; layer < 4; ++layer) {
      if ((layer & 1) == 0) {
        run_phase<0, 0>(p, g, layer, lds); gsync(p, lds); run_phase<0, 1>(p, g, layer, lds); gsync(p, lds); run_phase<0, 2>(p, g, layer, lds); gsync(p, lds);
        run_phase<0, 3>(p, g, layer, lds); gsync(p, lds); run_phase<0, 4>(p, g, layer, lds); gsync(p, lds);
      } else {
        run_phase<1, 0>(p, g, layer, lds); gsync(p, lds); run_phase<1, 1>(p, g, layer, lds); gsync(p, lds); run_phase<1, 2>(p, g, layer, lds); gsync(p, lds);
        run_phase<1, 3>(p, g, layer, lds); gsync(p, lds); run_phase<1, 4>(p, g, layer, lds); gsync(p, lds); run_phase<1, 5>(p, g, layer, lds); gsync(p, lds);
      }
    }
  final_phase(p.out, p.final_g);
}
#endif

extern "C" void kernel_launch(void* const* d_in, const int* in_sizes, int n_in, void* d_out, int out_size, void* d_ws, size_t ws_size, hipStream_t stream) {
  if (n_in != 22 || ws_size < WS_NEED) { fprintf(stderr, "kernel_launch: bad args n_in %d ws %zu need %zu\n", n_in, ws_size, WS_NEED); return; }
  P p{};
  const float** f = (const float**)&p;
  for (int i = 0; i < 22; ++i) f[i] = (const float*)d_in[i];
  p.out = (float*)d_out; p.ws = (char*)d_ws;
#if MEGA
  static int grid_blocks = 0;
  if (!grid_blocks) {
    hipFuncSetAttribute((const void*)k_mega, hipFuncAttributeMaxDynamicSharedMemorySize, SHM_BYTES);
    int dev = 0, cus = 0, per_cu = 0;
    hipGetDevice(&dev);
    hipDeviceGetAttribute(&cus, hipDeviceAttributeMultiprocessorCount, dev);
    hipOccupancyMaxActiveBlocksPerMultiprocessor(&per_cu, k_mega, 512, SHM_BYTES);
    if (per_cu > 1) per_cu = 1;
    grid_blocks = cus * per_cu;
  }
  void* args[] = {&p};
  hipError_t e = hipLaunchCooperativeKernel((void*)k_mega, dim3(grid_blocks), dim3(512), args, SHM_BYTES, stream);
  if (e != hipSuccess) fprintf(stderr, "cooperative launch failed: %s (grid %d)\n", hipGetErrorString(e), grid_blocks);
#else
  const int NB = 256;
#define LAUNCH(LT, PH, g, layer) do { static int inited = 0; if (!inited) { hipFuncSetAttribute((const void*)k_phase<LT, PH>, hipFuncAttributeMaxDynamicSharedMemorySize, SHM_BYTES); inited = 1; } \
    hipLaunchKernelGGL((k_phase<LT, PH>), dim3(NB), dim3(512), SHM_BYTES, stream, p, g, layer); } while (0)
  LAUNCH(2, 0, 0, 0);
  for (int g = 0; g < 3; ++g)
    for (int layer = 0; layer < 4; ++layer) {
      if ((layer & 1) == 0) { LAUNCH(0, 0, g, layer); LAUNCH(0, 1, g, layer); LAUNCH(0, 2, g, layer); LAUNCH(0, 3, g, layer); LAUNCH(0, 4, g, layer); }
      else { LAUNCH(1, 0, g, layer); LAUNCH(1, 1, g, layer); LAUNCH(1, 2, g, layer); LAUNCH(1, 3, g, layer); LAUNCH(1, 4, g, layer); LAUNCH(1, 5, g, layer); }
    }
  LAUNCH(2, 1, 0, 0);
#endif
}
```

```cpp
#include <hip/hip_runtime.h>
#include <hip/hip_bf16.h>
#include <hip/hip_cooperative_groups.h>
#include <cstdio>
namespace cg = cooperative_groups;

#ifndef REP_GEMM
#define REP_GEMM 1
#endif
#ifndef REP_ATTN
#define REP_ATTN 1
#endif
#ifndef REP_SCAN
#define REP_SCAN 1
#endif
#ifndef MEGA
#define MEGA 1
#endif

typedef unsigned short u16;
using bf16x8 = __attribute__((ext_vector_type(8))) short;
using s16x4  = __attribute__((ext_vector_type(4))) short;
using f32x16 = __attribute__((ext_vector_type(16))) float;
using f32x4  = __attribute__((ext_vector_type(4))) float;
using u32x4  = __attribute__((ext_vector_type(4))) unsigned;
using u32x2  = __attribute__((ext_vector_type(2))) unsigned;
#define DEV __device__ __forceinline__
#define SBAR() __builtin_amdgcn_sched_barrier(0)

constexpr int DM = 1024, EI = 2048, GT = 16384;
constexpr int NTOK = 49152;
constexpr int RW_N = 8448, ML_N = 2752, ML_NP = 2816;
constexpr int SHM_BYTES = 158720;

constexpr size_t alup(size_t x) { return (x + 255) / 256 * 256; }
constexpr size_t O_WRWIN  = 0;
constexpr size_t O_WRWOUT = O_WRWIN  + alup((size_t)2 * RW_N * DM * 2);
constexpr size_t O_WMLIN  = O_WRWOUT + alup((size_t)2 * DM * EI * 2);
constexpr size_t O_WUQ    = O_WMLIN  + alup((size_t)2 * ML_NP * DM * 2);
constexpr size_t O_WUKV   = O_WUQ    + alup((size_t)2 * 3072 * 384 * 2);
constexpr size_t O_WMLOUT = O_WUKV   + alup((size_t)2 * 4096 * 256 * 2);
constexpr size_t O_COS    = O_WMLOUT + alup((size_t)2 * DM * EI * 2);
constexpr size_t O_SIN    = O_COS    + alup((size_t)16384 * 32 * 4);
constexpr size_t O_HBUF   = O_SIN    + alup((size_t)16384 * 32 * 4);
constexpr size_t O_R0     = O_HBUF   + alup((size_t)GT * DM * 2);
constexpr size_t SZ_E = (size_t)GT * EI * 2;
constexpr size_t O_SG   = O_R0;
constexpr size_t O_RB   = O_SG + SZ_E;
constexpr size_t O_KB   = O_RB + SZ_E;
constexpr size_t O_VB   = O_KB + SZ_E;
constexpr size_t O_YF   = O_VB + SZ_E;
constexpr size_t O_YB   = O_YF + SZ_E;
constexpr size_t O_TWL  = O_YB + SZ_E;
constexpr size_t O_AL   = O_TWL + alup((size_t)GT * 128 * 2);
constexpr size_t O_BON  = O_AL  + alup((size_t)GT * 128 * 2);
constexpr size_t O_RW_END = O_BON + alup((size_t)GT * 64 * 4);
constexpr size_t O_CQKV = O_SG + SZ_E;
constexpr size_t O_CQN  = O_CQKV + alup((size_t)GT * 704 * 4);
constexpr size_t O_CKVN = O_CQN  + alup((size_t)GT * 384 * 2);
constexpr size_t O_KPE  = O_CKVN + alup((size_t)GT * 256 * 2);
constexpr size_t O_Q    = O_KPE  + alup((size_t)GT * 64 * 2);
constexpr size_t O_KV   = O_Q    + alup((size_t)GT * 3072 * 2);
constexpr size_t O_ML_END = O_KV + alup((size_t)GT * 4096 * 2);
constexpr size_t O_FLAG = O_RW_END > O_ML_END ? O_RW_END : O_ML_END;
constexpr size_t O_BAR = O_FLAG + 256;
constexpr size_t WS_NEED = O_BAR + 16384;

struct P {
  const float* x_prompt; const float* x_sample; const float* ln_g; const float* final_g;
  const float* rw_mu; const float* rw_in; const float* rw_w0; const float* rw_w2; const float* rw_a0; const float* rw_a2;
  const float* rw_kk; const float* rw_ka; const float* rw_rk; const float* rw_lnx_g; const float* rw_lnx_b; const float* rw_out;
  const float* ml_in; const float* ml_qn; const float* ml_kvn; const float* ml_uq; const float* ml_ukv; const float* ml_out;
  float* out; char* ws;
};

typedef __attribute__((ext_vector_type(2))) __bf16 bf16x2_t;
typedef __attribute__((ext_vector_type(2))) float f32x2_t;
DEV unsigned cvtpk(float lo, float hi) { f32x2_t v = {lo, hi}; bf16x2_t b = __builtin_convertvector(v, bf16x2_t); return __builtin_bit_cast(unsigned, b); }
DEV float bf2f(u16 x) { return __uint_as_float(((unsigned)x) << 16); }
DEV float bflo(unsigned x) { return __uint_as_float(x << 16); }
DEV float bfhi(unsigned x) { return __uint_as_float(x & 0xffff0000u); }
DEV u16 f2bf(float x) { __bf16 b = (__bf16)x; return __builtin_bit_cast(u16, b); }
DEV float wsum(float v) {
#pragma unroll
  for (int o = 32; o >= 1; o >>= 1) v += __shfl_xor(v, o, 64);
  return v;
}
DEV float siluf(float x) { return x / (1.f + __expf(-x)); }
DEV int crow(int r, int hi) { return (r & 3) + 8 * (r >> 2) + 4 * hi; }
DEV int ltid() { int t = threadIdx.x; asm volatile("" : "+v"(t)); return t; }
template <typename T> DEV T gld(size_t base, unsigned off) { return *(const __attribute__((address_space(1))) T*)(base + off); }
template <typename T> DEV void gst(size_t base, unsigned off, T v) { *(__attribute__((address_space(1))) T*)(base + off) = v; }
DEV void lds_wait() { asm volatile("s_waitcnt lgkmcnt(0)" ::: "memory"); }


#define XB_TMO      128
#define XB_XCNT(j)  (256  + 64 * (j))
#define XB_XSUB(j)  (1280 + 64 * (j))
#define XB_XGEN(j)  (2304 + 64 * (j))
#define XB_TOP      3328
#define XB_TOPGEN   3392
#define XCD_BAR_WORDS 3456
#define XB_SPIN_CAP (1u << 22)
#define LAS __attribute__((address_space(3)))
DEV unsigned xb_ld(unsigned* p)              { return __hip_atomic_load(p, __ATOMIC_RELAXED, __HIP_MEMORY_SCOPE_AGENT); }
DEV unsigned xb_add(unsigned* p, unsigned v) { return __hip_atomic_fetch_add(p, v, __ATOMIC_RELAXED, __HIP_MEMORY_SCOPE_AGENT); }
DEV unsigned xb_xcc_id() { return (unsigned)__builtin_amdgcn_s_getreg((3 << 11) | 20) & 0xFu; }
#define XB_SPIN(cond, bar) do { unsigned _sp = 0; while (cond) { __builtin_amdgcn_s_sleep(1); \
    if ((++_sp & 255u) == 0u) { if (xb_ld(&(bar)[XB_TMO])) break; if (_sp > XB_SPIN_CAP) { atomicAdd(&(bar)[XB_TMO], 1u); break; } } } } while (0)
struct XcdBarrier { unsigned* bar; unsigned x; volatile LAS unsigned* st; };
DEV void xcd_barrier_complete(unsigned* bar, unsigned x, unsigned& nloc, unsigned& nx) {
  const unsigned G = gridDim.x * gridDim.y * gridDim.z;
  unsigned sum, cnt, mine, sp = 0u;
  for (;;) {
    sum = 0u; cnt = 0u; mine = 0u;
#pragma unroll
    for (unsigned j = 0; j < 16; ++j) { const unsigned c = xb_ld(&bar[XB_XCNT(j)]); sum += c; cnt += (c > 0u) ? 1u : 0u; mine = (j == x) ? c : mine; }
    if (sum == G) break;
    __builtin_amdgcn_s_sleep(1);
    if ((++sp & 255u) == 0u) { if (xb_ld(&bar[XB_TMO])) break; if (sp > XB_SPIN_CAP) { atomicAdd(&bar[XB_TMO], 1u); break; } }
  }
  nloc = mine > 0u ? mine : 1u; nx = cnt > 0u ? cnt : 1u;
}
DEV void xcd_barrier(const XcdBarrier& b) {
  asm volatile("s_waitcnt vmcnt(0)" ::: "memory");
  __syncthreads();
  if (threadIdx.x == 0) {
    unsigned* bar = b.bar;
    __builtin_amdgcn_s_waitcnt(0);
    unsigned nloc = b.st[0], nx = b.st[1];
    if (nloc == 0u) { xcd_barrier_complete(bar, b.x, nloc, nx); b.st[0] = nloc; b.st[1] = nx; }
    const unsigned old = xb_add(&bar[XB_XSUB(b.x)], 1u);
    const unsigned gen = old / nloc;
    if (old + 1u == (gen + 1u) * nloc) {
      __builtin_amdgcn_fence(__ATOMIC_RELEASE, "agent");
      asm volatile("s_waitcnt vmcnt(0)" ::: "memory");
      const unsigned og = xb_add(&bar[XB_TOP], 1u);
      const unsigned tg = og / nx;
      if (og + 1u == (tg + 1u) * nx) xb_add(&bar[XB_TOPGEN], 1u);
      else XB_SPIN(xb_ld(&bar[XB_TOPGEN]) == tg, bar);
      __builtin_amdgcn_fence(__ATOMIC_ACQUIRE, "agent");
      xb_add(&bar[XB_XGEN(b.x)], 1u);
      asm volatile("s_waitcnt vmcnt(0)" ::: "memory");
    } else {
      XB_SPIN(xb_ld(&bar[XB_XGEN(b.x)]) == gen, bar);
      __builtin_amdgcn_fence(__ATOMIC_ACQUIRE, "agent");
      asm volatile("s_waitcnt vmcnt(0)" ::: "memory");
    }
  }
  __syncthreads();
}
DEV void gsync(const P& p, char* lds) {
  XcdBarrier b; b.bar = (unsigned*)(p.ws + O_BAR); b.x = xb_xcc_id(); b.st = (volatile LAS unsigned*)(lds + SHM_BYTES - 16);
  xcd_barrier(b);
}

DEV void convert_T(const float* __restrict__ src, u16* __restrict__ dst, int K, int N, int Npad, char* lds_) {
  float* lds = (float*)lds_;
  const int tid = ltid(), tk = K / 64, tn = Npad / 64;
  for (int t = blockIdx.x; t < tk * tn; t += gridDim.x) {
    const int k0 = (t % tk) * 64, n0 = (t / tk) * 64;
    __syncthreads();
#pragma unroll
    for (int i = 0; i < 2; ++i) {
      const int kr = (tid >> 4) + i * 32, c = (tid & 15) * 4;
      float4 v = make_float4(0.f, 0.f, 0.f, 0.f);
      if (n0 + c < N) v = *(const float4*)(src + (long)(k0 + kr) * N + n0 + c);
      lds[kr * 65 + c + 0] = v.x; lds[kr * 65 + c + 1] = v.y; lds[kr * 65 + c + 2] = v.z; lds[kr * 65 + c + 3] = v.w;
    }
    __syncthreads();
    const int n = tid >> 3, kc = (tid & 7) * 8;
    u32x4 w;
    w[0] = cvtpk(lds[(kc + 0) * 65 + n], lds[(kc + 1) * 65 + n]);
    w[1] = cvtpk(lds[(kc + 2) * 65 + n], lds[(kc + 3) * 65 + n]);
    w[2] = cvtpk(lds[(kc + 4) * 65 + n], lds[(kc + 5) * 65 + n]);
    w[3] = cvtpk(lds[(kc + 6) * 65 + n], lds[(kc + 7) * 65 + n]);
    *(u32x4*)(dst + (long)(n0 + n) * K + k0 + kc) = w;
  }
}

DEV void init_phase(const P& p, char* lds) {
  for (int j = 0; j < 2; ++j) {
    convert_T(p.rw_in  + (size_t)j * DM * RW_N, (u16*)(p.ws + O_WRWIN)  + (size_t)j * RW_N * DM, DM, RW_N, RW_N, lds);
    convert_T(p.rw_out + (size_t)j * EI * DM,   (u16*)(p.ws + O_WRWOUT) + (size_t)j * DM * EI,   EI, DM, DM, lds);
    convert_T(p.ml_in  + (size_t)j * DM * ML_N, (u16*)(p.ws + O_WMLIN)  + (size_t)j * ML_NP * DM, DM, ML_N, ML_NP, lds);
    convert_T(p.ml_uq  + (size_t)j * 384 * 3072, (u16*)(p.ws + O_WUQ)   + (size_t)j * 3072 * 384, 384, 3072, 3072, lds);
    convert_T(p.ml_ukv + (size_t)j * 256 * 4096, (u16*)(p.ws + O_WUKV)  + (size_t)j * 4096 * 256, 256, 4096, 4096, lds);
    convert_T(p.ml_out + (size_t)j * EI * DM,   (u16*)(p.ws + O_WMLOUT) + (size_t)j * DM * EI,   EI, DM, DM, lds);
  }
  float* ct = (float*)(p.ws + O_COS); float* st = (float*)(p.ws + O_SIN);
  const int tid_ = ltid();
  for (int i = blockIdx.x * 512 + tid_; i < 16384 * 32; i += gridDim.x * 512) {
    const int pos = i >> 5, j = i & 31;
    const float invf = 1.0f / powf(10000.0f, (float)(2 * j) / 64.0f);
    const float ang = (float)pos * invf;
    const double a = (double)ang;
    const double n = rint(a * 0.15915494309189535);
    const float r = (float)(a - n * 6.283185307179586);
    ct[i] = cosf(r); st[i] = sinf(r);
  }
}

DEV void rms_phase(const float* __restrict__ x, const float* __restrict__ g, u16* __restrict__ hout) {
  const int tid_ = ltid(); const int lane = tid_ & 63, wid = __builtin_amdgcn_readfirstlane(tid_ >> 6);
  for (int tok = blockIdx.x * 8 + wid; tok < GT; tok += gridDim.x * 8) {
    const float4* xr = (const float4*)(x + (size_t)tok * DM);
    float4 v[4]; float ss = 0.f;
#pragma unroll
    for (int i = 0; i < 4; ++i) { v[i] = xr[lane + i * 64]; ss += v[i].x * v[i].x + v[i].y * v[i].y + v[i].z * v[i].z + v[i].w * v[i].w; }
    ss = wsum(ss);
    const float sc = rsqrtf(ss * (1.f / DM) + 1e-6f);
#pragma unroll
    for (int i = 0; i < 4; ++i) {
      const float4 gg = ((const float4*)g)[lane + i * 64];
      u32x2 w; w[0] = cvtpk(v[i].x * sc * gg.x, v[i].y * sc * gg.y); w[1] = cvtpk(v[i].z * sc * gg.z, v[i].w * sc * gg.w);
      *(u32x2*)(hout + (size_t)tok * DM + (lane + i * 64) * 4) = w;
    }
  }
}

DEV void final_phase(float* __restrict__ x, const float* __restrict__ g) {
  const int tid_ = ltid(); const int lane = tid_ & 63, wid = __builtin_amdgcn_readfirstlane(tid_ >> 6);
  for (int tok = blockIdx.x * 8 + wid; tok < NTOK; tok += gridDim.x * 8) {
    float4* xr = (float4*)(x + (size_t)tok * DM);
    float4 v[4]; float ss = 0.f;
#pragma unroll
    for (int i = 0; i < 4; ++i) { v[i] = xr[lane + i * 64]; ss += v[i].x * v[i].x + v[i].y * v[i].y + v[i].z * v[i].z + v[i].w * v[i].w; }
    ss = wsum(ss);
    const float sc = rsqrtf(ss * (1.f / DM) + 1e-6f);
#pragma unroll
    for (int i = 0; i < 4; ++i) {
      const float4 gg = ((const float4*)g)[lane + i * 64];
      float4 ov = make_float4(v[i].x * sc * gg.x, v[i].y * sc * gg.y, v[i].z * sc * gg.z, v[i].w * sc * gg.w);
      xr[lane + i * 64] = ov;
    }
  }
}


DEV void lerp_phase(const u16* __restrict__ h, const float* __restrict__ mu, u16* __restrict__ out, int T) {
  const int tid_ = ltid(); const int lane = tid_ & 63, wid = __builtin_amdgcn_readfirstlane(tid_ >> 6);
  for (int tok = blockIdx.x * 8 + wid; tok < GT; tok += gridDim.x * 8) {
    const int pos = tok % T;
#pragma unroll
    for (int half = 0; half < 2; ++half) {
      const int c0 = half * 512 + lane * 8;
      const u32x4 c = *(const u32x4*)(h + (size_t)tok * DM + c0);
      u32x4 pv = {0u, 0u, 0u, 0u}, nx = {0u, 0u, 0u, 0u};
      if (pos > 0) pv = *(const u32x4*)(h + (size_t)(tok - 1) * DM + c0);
      if (pos < T - 1) nx = *(const u32x4*)(h + (size_t)(tok + 1) * DM + c0);
      float hh[8], xx[8];
#pragma unroll
      for (int e = 0; e < 4; ++e) {
        hh[2 * e] = bflo(c[e]); hh[2 * e + 1] = bfhi(c[e]);
        xx[2 * e] = 0.5f * (bflo(pv[e]) + bflo(nx[e])) - hh[2 * e]; xx[2 * e + 1] = 0.5f * (bfhi(pv[e]) + bfhi(nx[e])) - hh[2 * e + 1];
      }
#pragma unroll
      for (int st = 0; st < 4; ++st) {
        const int mi = st == 0 ? 0 : st == 1 ? 2 : st == 2 ? 3 : 5;
        const float4 m0v = *(const float4*)(mu + mi * DM + c0), m1v = *(const float4*)(mu + mi * DM + c0 + 4);
        const float m[8] = {m0v.x, m0v.y, m0v.z, m0v.w, m1v.x, m1v.y, m1v.z, m1v.w};
        u32x4 o;
#pragma unroll
        for (int e = 0; e < 4; ++e) o[e] = cvtpk(hh[2 * e] + m[2 * e] * xx[2 * e], hh[2 * e + 1] + m[2 * e + 1] * xx[2 * e + 1]);
        *(u32x4*)(out + (size_t)st * GT * DM + (size_t)tok * DM + c0) = o;
      }
    }
  }
}

#define GSWZ(row, c16) ((row) * 128 + ((((c16) ^ ((row) >> 1)) & 7) << 4))
constexpr int LOAD_PLAIN = 0, LOAD_LERP = 1;
constexpr int EPI_RWKV = 0, EPI_RES = 1, EPI_MLAIN = 2, EPI_BF16 = 3;
struct GemmP {
  const u16* A; int lda; const u16* Bt; int K; int NT;
  const float* mu;
  int T;
  u16* o0; u16* o1; u16* o2; u16* o3; u16* o4; u16* o5;
  int ldc;
  float* of; const float* xin; float* xout; int dry;
  int nt0; size_t astride;
};

template <int LOAD, int EPI, int NI>
DEV void gemm_phase(const GemmP& g, char* lds) {
  constexpr int BN = 64 * NI, SBB = BN * 128;
  const int tid = ltid(), wid = __builtin_amdgcn_readfirstlane(tid >> 6), lane = tid & 63, r32 = lane & 31, hi = lane >> 5;
  const int wm = wid >> 1, wn = wid & 1;
  char* sA = lds; char* sB = lds + 65536;
  int Kv = g.K; asm volatile("" : "+s"(Kv));
  const int nk = Kv / 64, ntiles = 64 * g.NT;
  const int c16 = tid & 7, rowb = tid >> 3;
  for (int t = blockIdx.x; t < ntiles; t += gridDim.x) {
    const int mt = t & 63, nt = g.nt0 + (t >> 6), m0 = mt * 256, n0 = nt * BN;
    const u16* Ab = g.A + (size_t)(n0 >> 11) * g.astride;
    f32x16 acc[2][NI] = {};
    bf16x8 ra[4], rb[NI];
    const float* mup = nullptr;
    if constexpr (LOAD == LOAD_LERP) {
      const int s = n0 < 2048 ? 0 : n0 < 4096 ? 2 : n0 < 6144 ? 3 : n0 < 8192 ? 5 : n0 == 8192 ? 1 : 4;
      mup = g.mu + s * DM;
    }
    auto gload = [&](int kt) {
      const int k0 = kt * 64 + c16 * 8;
#pragma unroll
      for (int i = 0; i < 4; ++i) {
        const int row = rowb + i * 64; const size_t tok = (size_t)(m0 + row);
        if constexpr (LOAD == LOAD_PLAIN) {
          ra[i] = *(const bf16x8*)(Ab + tok * g.lda + k0);
        } else {
          const int pos = (int)(tok % (size_t)g.T);
          const u32x4 c = *(const u32x4*)(g.A + tok * DM + k0);
          u32x4 pv = {0u, 0u, 0u, 0u}, nx = {0u, 0u, 0u, 0u};
          if (pos > 0) pv = *(const u32x4*)(g.A + (tok - 1) * DM + k0);
          if (pos < g.T - 1) nx = *(const u32x4*)(g.A + (tok + 1) * DM + k0);
          const float4 m0v = *(const float4*)(mup + k0), m1v = *(const float4*)(mup + k0 + 4);
          const float mu[8] = {m0v.x, m0v.y, m0v.z, m0v.w, m1v.x, m1v.y, m1v.z, m1v.w};
          u32x4 o;
#pragma unroll
          for (int e = 0; e < 4; ++e) {
            const float h0 = bflo(c[e]), h1 = bfhi(c[e]);
            const float x0 = 0.5f * (bflo(pv[e]) + bflo(nx[e])) - h0, x1 = 0.5f * (bfhi(pv[e]) + bfhi(nx[e])) - h1;
            o[e] = cvtpk(h0 + mu[2 * e] * x0, h1 + mu[2 * e + 1] * x1);
          }
          ra[i] = *(bf16x8*)&o;
        }
      }
#pragma unroll
      for (int i = 0; i < NI; ++i) {
        const int row = rowb + i * 64;
        rb[i] = *(const bf16x8*)(g.Bt + (size_t)(n0 + row) * Kv + k0);
      }
    };
    auto swrite = [&](int b) {
#pragma unroll
      for (int i = 0; i < 4; ++i) { const int row = rowb + i * 64; *(bf16x8*)(sA + b * 32768 + GSWZ(row, c16)) = ra[i]; }
#pragma unroll
      for (int i = 0; i < NI; ++i) { const int row = rowb + i * 64; *(bf16x8*)(sB + b * SBB + GSWZ(row, c16)) = rb[i]; }
    };
    gload(0); swrite(0); __syncthreads();
    for (int kt = 0; kt < nk; ++kt) {
      const int b = kt & 1;
      if (kt + 1 < nk) gload(kt + 1);
      const char* a_ = sA + b * 32768; const char* b_ = sB + b * SBB;
#pragma unroll
      for (int ks = 0; ks < 4; ++ks) {
        bf16x8 af[2], bfr[NI];
#pragma unroll
        for (int mi = 0; mi < 2; ++mi) { const int row = wm * 64 + mi * 32 + r32; af[mi] = *(const bf16x8*)(a_ + GSWZ(row, ks * 2 + hi)); }
#pragma unroll
        for (int ni = 0; ni < NI; ++ni) { const int row = wn * (32 * NI) + ni * 32 + r32; bfr[ni] = *(const bf16x8*)(b_ + GSWZ(row, ks * 2 + hi)); }
#pragma unroll
        for (int mi = 0; mi < 2; ++mi)
#pragma unroll
          for (int ni = 0; ni < NI; ++ni) acc[mi][ni] = __builtin_amdgcn_mfma_f32_32x32x16_bf16(af[mi], bfr[ni], acc[mi][ni], 0, 0, 0);
      }
      if (kt + 1 < nk) swrite(b ^ 1);
      __syncthreads();
    }
    if (!g.dry)
#pragma unroll
    for (int mi = 0; mi < 2; ++mi)
#pragma unroll
      for (int ni = 0; ni < NI; ++ni)
#pragma unroll
        for (int r = 0; r < 16; ++r) {
          const size_t m = (size_t)(m0 + wm * 64 + mi * 32 + crow(r, hi));
          const int nl = wn * (32 * NI) + ni * 32 + r32, n = n0 + nl;
          const float v = acc[mi][ni][r];
          if constexpr (EPI == EPI_RWKV) {
            if (n0 < 8192) {
              const int which = n0 >> 11, col = n & 2047;
              u16* dst = which == 0 ? g.o0 : which == 1 ? g.o1 : which == 2 ? g.o2 : g.o3;
              dst[m * EI + col] = f2bf(which == 3 ? siluf(v) : v);
            } else if (n0 == 8192) g.o4[m * 128 + nl] = f2bf(tanhf(v));
            else g.o5[m * 128 + nl] = f2bf(v);
          } else if constexpr (EPI == EPI_RES) {
            g.xout[m * DM + n] = g.xin[m * DM + n] + v;
          } else if constexpr (EPI == EPI_MLAIN) {
            if (n < 704) g.of[m * 704 + n] = v;
            else if (n < ML_N) g.o0[m * EI + (n - 704)] = f2bf(siluf(v));
          } else {
            g.o0[m * g.ldc + n] = f2bf(v);
          }
        }
  }
}

struct ScanP {
  const u16 *r, *k, *v, *twl, *al; u16 *yf, *yb; float* bonus;
  const float *w0, *w2, *a0, *a2, *kk, *ka, *rk;
  int nseq, T;
  float* tbuf; int nseg;
};
template <int CTRL> DEV float dppf(float x) {
  return __int_as_float(__builtin_amdgcn_update_dpp(0, __float_as_int(x), CTRL, 0xF, 0xF, false));
}
DEV float row_prefix16(float x) {
  x += dppf<0x111>(x); x += dppf<0x112>(x); x += dppf<0x114>(x); x += dppf<0x118>(x); return x;
}
DEV float row_total16(float x) {
  x += dppf<0x128>(x); x += dppf<0x124>(x); x += dppf<0x122>(x); x += dppf<0x121>(x); return x;
}
DEV bf16x8 pack8(float a0, float a1, float a2, float a3, float a4, float a5, float a6, float a7) {
  u32x4 w = {cvtpk(a0, a1), cvtpk(a2, a3), cvtpk(a4, a5), cvtpk(a6, a7)}; return *(bf16x8*)&w;
}
constexpr int SC_BKT = 0, SC_UVT = 5120, SC_AKM = 10240, SC_RR = 10752, SC_ABF = 11776, SC_Z = 12800, SC_PRM = 17152, SC_T = 18944, SC_WAVE = 35328;
constexpr int SC_PRE = SC_UVT;
constexpr int SC_SHARED_AW = 4 * SC_WAVE;
constexpr int SC_NW = 4;
DEV void scan_phase(const ScanP& s, char* lds_, const int pass) {
  const int tid = ltid(), wid = __builtin_amdgcn_readfirstlane(tid >> 6), lane = tid & 63, c16 = lane & 15, q = lane >> 4;
  const int nchain = s.nseq * 64, nseg = s.nseg;
  const int ipc = pass == 0 ? nseg * 2 : nseg;
  const bool shared = nchain <= (int)gridDim.x;
  const int nsb = shared ? (int)gridDim.x / nchain : 1, sbi = shared ? (int)blockIdx.x / nchain : 0;
  const int nwv = shared ? SC_NW : 2;
  if (shared && sbi >= nsb) return;
  char* wl = lds_ + (wid & 3) * SC_WAVE;
  u16* bkt = (u16*)(wl + SC_BKT); u16* uvt = (u16*)(wl + SC_UVT); u16* akm = (u16*)(wl + SC_AKM); u16* rr = (u16*)(wl + SC_RR);
  float* abf = (float*)(wl + SC_ABF); float* zl = (float*)(wl + SC_Z); float* prm = (float*)(wl + SC_PRM); float* p15l = prm + 320;
  bf16x8* awl = (bf16x8*)(shared ? lds_ + SC_SHARED_AW : lds_ + (2 + (wid & 1)) * SC_WAVE); bf16x8* aal = awl + 512;
#define SCAN_LOAD_W(CHAIN, F0, F1) do { const int d_ = (CHAIN) & 1, h_ = ((CHAIN) >> 1) & 31; \
    for (int f = (F0); f < (F1); ++f) { const int ks = f >> 2, mt = f & 3; u32x4 pw, pa; \
      _Pragma("unroll") for (int e = 0; e < 4; ++e) { const int l0 = ks * 32 + q * 8 + 2 * e; \
        const size_t i0 = ((size_t)(d_ * 64 + l0)) * EI + h_ * 64 + mt * 16 + c16; \
        pw[e] = cvtpk(s.w2[i0], s.w2[i0 + EI]); pa[e] = cvtpk(s.a2[i0], s.a2[i0 + EI]); } \
      awl[f * 64 + lane] = *(bf16x8*)&pw; aal[f * 64 + lane] = *(bf16x8*)&pa; } } while (0)
  if (shared) {
    const int chain_b = (int)blockIdx.x % nchain;
    SCAN_LOAD_W(chain_b, wid, wid + 1);
    __syncthreads();
  }
  if (wid >= nwv) return;
  const int nrounds = shared ? (ipc + nsb * SC_NW - 1) / (nsb * SC_NW) : (nchain + 2 * (int)gridDim.x - 1) / (2 * (int)gridDim.x);
  for (int round = 0; round < nrounds; ++round) {
    const int chain = shared ? (int)blockIdx.x % nchain : (round * 2 + wid) * (int)gridDim.x + (int)blockIdx.x;
    const int it = shared ? sbi * SC_NW + wid + round * nsb * SC_NW : 0;
    if (chain >= nchain || it >= ipc) continue;
    const int kind = pass == 0 ? 1 + (it & 1) : 0;
    const int seg = pass == 0 ? it >> 1 : it;
    const int cs = chain * nseg + seg;
    const int d = chain & 1, h = (chain >> 1) & 31, b = chain >> 6;
    {
      const int ch = h * 64 + lane;
      lds_wait();
      prm[lane] = s.w0[d * EI + ch]; prm[64 + lane] = s.a0[d * EI + ch]; prm[128 + lane] = s.kk[ch]; prm[192 + lane] = s.ka[ch]; prm[256 + lane] = s.rk[ch];
      lds_wait();
    }
    if (!shared) { SCAN_LOAD_W(chain, 0, 8); lds_wait(); }
    const unsigned rowi = (unsigned)(d ? 15 - c16 : c16);
    const unsigned off_tw = rowi * 256u + (unsigned)(q * 16);
    const unsigned off_kr = rowi * 4096u + (unsigned)(h * 128 + q * 8);
    const unsigned off_v  = (unsigned)(h * 128 + lane * 2);
    const unsigned off_y0 = (unsigned)(d ? 15 - 4 * q : 4 * q) * 4096u + (unsigned)(h * 128 + c16 * 2);
    const int ystep = d ? -4096 : 4096;
    f32x4* Tl = (f32x4*)(wl + SC_T);
#pragma unroll
    for (int m = 0; m < 16; ++m) {
      f32x4 t0v = {0.f, 0.f, 0.f, 0.f};
      if (kind == 2) {
        const int mt = m >> 2, nt = m & 3;
        if (mt == nt) { t0v[0] = (4 * q + 0 == c16) ? 1.f : 0.f; t0v[1] = (4 * q + 1 == c16) ? 1.f : 0.f; t0v[2] = (4 * q + 2 == c16) ? 1.f : 0.f; t0v[3] = (4 * q + 3 == c16) ? 1.f : 0.f; }
      } else if (kind == 0 && nseg > 1) {
        t0v = *(const f32x4*)(s.tbuf + ((size_t)cs * 2) * 4096 + (m * 64 + lane) * 4);
      }
      Tl[m * 64 + lane] = t0v;
    }
    u16* yout = d ? s.yb : s.yf;
    const size_t sb = (size_t)b * s.T;
    const int cps = s.T / 16 / nseg, cbeg = seg * cps, cend = cbeg + cps;
    bf16x8 n_tw0, n_tw1, n_ta0, n_ta1; u32x2 n_k[4], n_r[4];
#define SCAN_LOAD(CC) do { const int c0n = d ? (s.T - 16 - (CC) * 16) : (CC) * 16; const size_t t0n = sb + c0n; \
      size_t p_tw = (size_t)s.twl + t0n * 256 + d * 128, p_al = (size_t)s.al + t0n * 256 + d * 128, p_k = (size_t)s.k + t0n * 4096, p_r = (size_t)s.r + t0n * 4096 ; \
      asm volatile("" : "+s"(p_tw), "+s"(p_al), "+s"(p_k), "+s"(p_r)); \
      n_tw0 = gld<bf16x8>(p_tw, off_tw); n_tw1 = gld<bf16x8>(p_tw, off_tw + 64); n_ta0 = gld<bf16x8>(p_al, off_tw); n_ta1 = gld<bf16x8>(p_al, off_tw + 64); \
      _Pragma("unroll") for (int mt = 0; mt < 4; ++mt) { n_k[mt] = gld<u32x2>(p_k, off_kr + mt * 32); n_r[mt] = gld<u32x2>(p_r, off_kr + mt * 32); } } while (0)
    SCAN_LOAD(cbeg);
    for (int cc = cbeg; cc < cend; ++cc) {
      const int c0 = d ? (s.T - 16 - cc * 16) : cc * 16;
      const size_t t0 = sb + c0;
      size_t b_y = (size_t)yout + t0 * 4096, b_bon = (size_t)s.bonus + t0 * 256 + (h * 2 + d) * 4;
      asm volatile("" : "+s"(b_y), "+s"(b_bon));
      size_t b_v = (size_t)s.v + t0 * 4096; asm volatile("" : "+s"(b_v));
      u32x2 n_v[4];
#pragma unroll
      for (int mt = 0; mt < 4; ++mt) n_v[mt] = gld<u32x2>(b_v, off_kr + mt * 32);
      {
        f32x4* wpl = (f32x4*)zl; f32x4* apl = (f32x4*)(wl + SC_PRE);
#pragma unroll
        for (int mt = 0; mt < 4; ++mt) {
          f32x4 cw = {0.f, 0.f, 0.f, 0.f}, ca = {0.f, 0.f, 0.f, 0.f};
          cw = __builtin_amdgcn_mfma_f32_16x16x32_bf16(awl[(0 * 4 + mt) * 64 + lane], n_tw0, cw, 0, 0, 0);
          cw = __builtin_amdgcn_mfma_f32_16x16x32_bf16(awl[(1 * 4 + mt) * 64 + lane], n_tw1, cw, 0, 0, 0);
          ca = __builtin_amdgcn_mfma_f32_16x16x32_bf16(aal[(0 * 4 + mt) * 64 + lane], n_ta0, ca, 0, 0, 0);
          ca = __builtin_amdgcn_mfma_f32_16x16x32_bf16(aal[(1 * 4 + mt) * 64 + lane], n_ta1, ca, 0, 0, 0);
          wpl[mt * 64 + lane] = cw; apl[mt * 64 + lane] = ca;
        }
      }
      float n2 = 0.f;
#pragma unroll
      for (int mt = 0; mt < 4; ++mt) {
        const float4 kkp = *(const float4*)(prm + 128 + mt * 16 + q * 4);
        const float t0 = bflo(n_k[mt][0]) * kkp.x, t1 = bfhi(n_k[mt][0]) * kkp.y, t2 = bflo(n_k[mt][1]) * kkp.z, t3 = bfhi(n_k[mt][1]) * kkp.w;
        n2 += t0 * t0 + t1 * t1 + t2 * t2 + t3 * t3;
      }
      n2 += __shfl_xor(n2, 16, 64); n2 += __shfl_xor(n2, 32, 64);
      const float invn = __builtin_amdgcn_rsqf(fmaxf(n2, 1e-24f));
      float bon = 0.f;
      bf16x8 ktf[2], btf[2], kdf[2], rtf[2];
#pragma unroll
      for (int ks = 0; ks < 2; ++ks) {
        float ktl[8], btl[8], kdl[8], rtl[8];
#pragma unroll
        for (int mh = 0; mh < 2; ++mh) {
          const int mt = 2 * ks + mh;
          const f32x4 cw = ((const f32x4*)zl)[mt * 64 + lane], ca = ((const f32x4*)(wl + SC_PRE))[mt * 64 + lane];
          const float4 w0p = *(const float4*)(prm + mt * 16 + q * 4), a0p = *(const float4*)(prm + 64 + mt * 16 + q * 4);
          const float4 kkp = *(const float4*)(prm + 128 + mt * 16 + q * 4), kap = *(const float4*)(prm + 192 + mt * 16 + q * 4), rkp = *(const float4*)(prm + 256 + mt * 16 + q * 4);
          const float w0a[4] = {w0p.x, w0p.y, w0p.z, w0p.w}, a0a[4] = {a0p.x, a0p.y, a0p.z, a0p.w};
          const float kka[4] = {kkp.x, kkp.y, kkp.z, kkp.w}, kaa[4] = {kap.x, kap.y, kap.z, kap.w}, rka[4] = {rkp.x, rkp.y, rkp.z, rkp.w};
          const u32x2 kr_ = n_k[mt], rr_ = n_r[mt];
          const float kxa[4] = {bflo(kr_[0]), bfhi(kr_[0]), bflo(kr_[1]), bfhi(kr_[1])};
          const float rxa[4] = {bflo(rr_[0]), bfhi(rr_[0]), bflo(rr_[1]), bfhi(rr_[1])};
          float4 p15v;
#pragma unroll
          for (int e = 0; e < 4; ++e) {
            const float wp = cw[e] + w0a[e], ap = ca[e] + a0a[e];
            const float ee = 0.6065306597126334f * __builtin_amdgcn_rcpf(1.f + __expf(-wp));
            const float a = __builtin_amdgcn_rcpf(1.f + __expf(-ap));
            const float kkn = kxa[e] * kka[e] * invn;
            const float kd = kxa[e] * (1.f + (a - 1.f) * kaa[e]);
            const float bb = kkn * a;
            bon += rxa[e] * kd * rka[e];
            const float Ei = row_prefix16(ee);
            const float pm = __expf(-Ei), pp = __builtin_amdgcn_rcpf(pm);
            const float pm1s = dppf<0x111>(pm), pm1 = c16 == 0 ? 1.f : pm1s;
            ktl[mh * 4 + e] = kkn * pm1; btl[mh * 4 + e] = bb * pp; kdl[mh * 4 + e] = kd * pp; rtl[mh * 4 + e] = rxa[e] * pm;
            ((float*)&p15v)[e] = pm;
          }
          if (c16 == 15) *(float4*)(p15l + mt * 16 + q * 4) = p15v;
          SBAR();
        }
        ktf[ks] = pack8(ktl[0], ktl[1], ktl[2], ktl[3], ktl[4], ktl[5], ktl[6], ktl[7]);
        btf[ks] = pack8(btl[0], btl[1], btl[2], btl[3], btl[4], btl[5], btl[6], btl[7]);
        kdf[ks] = pack8(kdl[0], kdl[1], kdl[2], kdl[3], kdl[4], kdl[5], kdl[6], kdl[7]);
        rtf[ks] = pack8(rtl[0], rtl[1], rtl[2], rtl[3], rtl[4], rtl[5], rtl[6], rtl[7]);
        {
          const u32x4 bw_ = *(const u32x4*)&btf[ks], kw_ = *(const u32x4*)&kdf[ks];
#pragma unroll
          for (int w = 0; w < 4; ++w) {
            const int j = (2 * ks + (w >> 1)) * 16 + q * 4 + (w & 1) * 2;
            bkt[j * 40 + c16] = (u16)(bw_[w] & 0xffffu); bkt[(j + 1) * 40 + c16] = (u16)(bw_[w] >> 16);
            bkt[j * 40 + 16 + c16] = (u16)(kw_[w] & 0xffffu); bkt[(j + 1) * 40 + 16 + c16] = (u16)(kw_[w] >> 16);
          }
        }
      }
      bon += __shfl_xor(bon, 16, 64); bon += __shfl_xor(bon, 32, 64);
      if (q == 0 && kind == 0) gst<float>(b_bon, off_tw, bon);
      SBAR();
      SBAR();
#pragma unroll
      for (int mt = 0; mt < 4; ++mt) {
        const int vb_ = (mt * 16 + q * 4) * 40 + 16 + c16;
        const unsigned v0_ = kind == 2 ? 0u : n_v[mt][0], v1_ = kind == 2 ? 0u : n_v[mt][1];
        uvt[vb_] = (u16)(v0_ & 0xffffu); uvt[vb_ + 40] = (u16)(v0_ >> 16);
        uvt[vb_ + 80] = (u16)(v1_ & 0xffffu); uvt[vb_ + 120] = (u16)(v1_ >> 16);
      }
      { const int cn = cc + 1 < cend ? cc + 1 : cc; SCAN_LOAD(cn); }
      SBAR();
      {
        f32x4 AB = {0.f, 0.f, 0.f, 0.f}, AK = AB, RB = AB, RK = AB;
        int qm = q; asm volatile("" : "+v"(qm));
#pragma unroll
        for (int ks = 0; ks < 2; ++ks) {
          AB = __builtin_amdgcn_mfma_f32_16x16x32_bf16(ktf[ks], btf[ks], AB, 0, 0, 0);
          AK = __builtin_amdgcn_mfma_f32_16x16x32_bf16(ktf[ks], kdf[ks], AK, 0, 0, 0);
          RB = __builtin_amdgcn_mfma_f32_16x16x32_bf16(rtf[ks], btf[ks], RB, 0, 0, 0);
          RK = __builtin_amdgcn_mfma_f32_16x16x32_bf16(rtf[ks], kdf[ks], RK, 0, 0, 0);
        }
#pragma unroll
        for (int r = 0; r < 4; ++r) {
          const int i = 4 * qm + r;
          const bool lo = c16 < i, le = c16 <= i;
          abf[i * 16 + c16] = lo ? AB[r] : 0.f;
          akm[i * 16 + c16] = f2bf(lo ? AK[r] : 0.f);
          rr[i * 32 + c16] = f2bf(le ? RB[r] : 0.f);
          rr[i * 32 + 16 + c16] = f2bf(le ? RK[r] : 0.f);
        }
      }
#define TFRAG(ks, nt, OUT) do { const f32x4 ta_ = Tl[((2 * (ks)) * 4 + (nt)) * 64 + lane], tb_ = Tl[((2 * (ks) + 1) * 4 + (nt)) * 64 + lane]; \
        OUT = pack8(ta_[0], ta_[1], ta_[2], ta_[3], tb_[0], tb_[1], tb_[2], tb_[3]); } while (0)
      lds_wait();
      {
        bf16x8 akf = {0, 0, 0, 0, 0, 0, 0, 0};
        if (q < 2) akf = *(const bf16x8*)(akm + c16 * 16 + q * 8);
#pragma unroll
        for (int nt = 0; nt < 4; ++nt) {
          f32x4 z = {0.f, 0.f, 0.f, 0.f};
          bf16x8 tf0, tf1; TFRAG(0, nt, tf0); TFRAG(1, nt, tf1);
          z = __builtin_amdgcn_mfma_f32_16x16x32_bf16(ktf[0], tf0, z, 0, 0, 0);
          z = __builtin_amdgcn_mfma_f32_16x16x32_bf16(ktf[1], tf1, z, 0, 0, 0);
          const bf16x8 vf = *(const bf16x8*)(uvt + (nt * 16 + c16) * 40 + 16 + (q & 1) * 8);
          z = __builtin_amdgcn_mfma_f32_16x16x32_bf16(akf, vf, z, 0, 0, 0);
#pragma unroll
          for (int r = 0; r < 4; ++r) zl[(4 * q + r) * 68 + nt * 16 + c16] = z[r];
        }
      }
      lds_wait();
      SBAR();
      {
        float U[16];
#pragma unroll
        for (int i = 0; i < 16; ++i) {
          float acc = -zl[i * 68 + lane];
#pragma unroll
          for (int s4 = 0; s4 < (i + 3) / 4; ++s4) {
            const float4 a4 = *(const float4*)(abf + i * 16 + s4 * 4);
            if (s4 * 4 + 0 < i) acc -= a4.x * U[s4 * 4 + 0];
            if (s4 * 4 + 1 < i) acc -= a4.y * U[s4 * 4 + 1];
            if (s4 * 4 + 2 < i) acc -= a4.z * U[s4 * 4 + 2];
            if (s4 * 4 + 3 < i) acc -= a4.w * U[s4 * 4 + 3];
          }
          U[i] = acc;
          if ((i & 3) == 3) SBAR();
        }
        *(bf16x8*)(uvt + lane * 40) = pack8(U[0], U[1], U[2], U[3], U[4], U[5], U[6], U[7]);
        *(bf16x8*)(uvt + lane * 40 + 8) = pack8(U[8], U[9], U[10], U[11], U[12], U[13], U[14], U[15]);
      }
      lds_wait();
      SBAR();
      {
        const bf16x8 rrf = *(const bf16x8*)(rr + c16 * 32 + q * 8);
        bf16x8 uvf[4];
#pragma unroll
        for (int nt = 0; nt < 4; ++nt) uvf[nt] = *(const bf16x8*)(uvt + (nt * 16 + c16) * 40 + q * 8);
#pragma unroll
        for (int nt = 0; nt < 4; ++nt) {
          f32x4 y = {0.f, 0.f, 0.f, 0.f};
          bf16x8 tf0, tf1; TFRAG(0, nt, tf0); TFRAG(1, nt, tf1);
          y = __builtin_amdgcn_mfma_f32_16x16x32_bf16(rtf[0], tf0, y, 0, 0, 0);
          y = __builtin_amdgcn_mfma_f32_16x16x32_bf16(rtf[1], tf1, y, 0, 0, 0);
          y = __builtin_amdgcn_mfma_f32_16x16x32_bf16(rrf, uvf[nt], y, 0, 0, 0);
#pragma unroll
          for (int r = 0; r < 4; ++r) { if (kind == 0) gst<u16>(b_y, off_y0 + (unsigned)(r * ystep) + nt * 32, f2bf(y[r])); }
        }
#pragma unroll
        for (int mt = 0; mt < 4; ++mt) {
          const bf16x8 bkf = *(const bf16x8*)(bkt + (mt * 16 + c16) * 40 + q * 8);
          const float4 pq = *(const float4*)(p15l + mt * 16 + q * 4);
#pragma unroll
          for (int nt = 0; nt < 4; ++nt) {
            f32x4 t = __builtin_amdgcn_mfma_f32_16x16x32_bf16(bkf, uvf[nt], Tl[(mt * 4 + nt) * 64 + lane], 0, 0, 0);
            t[0] *= pq.x; t[1] *= pq.y; t[2] *= pq.z; t[3] *= pq.w;
            Tl[(mt * 4 + nt) * 64 + lane] = t;
          }
        }
      }
      lds_wait();
    }
    if (pass == 0) {
      float* dst = s.tbuf + ((size_t)cs * 2 + (kind - 1)) * 4096;
#pragma unroll
      for (int m = 0; m < 16; ++m) *(f32x4*)(dst + (m * 64 + lane) * 4) = Tl[m * 64 + lane];
    }
  }
}

DEV void scan_combine_phase(const ScanP& s, char* lds_) {
  const int tid = ltid(), wid = __builtin_amdgcn_readfirstlane(tid >> 6), lane = tid & 63, c16 = lane & 15, q = lane >> 4;
  if (wid >= 2) return;
  float* til = (float*)(lds_ + wid * 16384);
  const int nchain = s.nseq * 64, nseg = s.nseg;
  for (int chain = wid * gridDim.x + blockIdx.x; chain < nchain; chain += 2 * gridDim.x) {
    f32x4 T[16];
#pragma unroll
    for (int m = 0; m < 16; ++m) T[m] = f32x4{0.f, 0.f, 0.f, 0.f};
    for (int seg = 0; seg < nseg; ++seg) {
      float* tn = s.tbuf + ((size_t)(chain * nseg + seg) * 2) * 4096; const float* ti = tn + 4096;
      lds_wait();
#pragma unroll
      for (int m = 0; m < 16; ++m) *(f32x4*)(til + (m * 64 + lane) * 4) = *(const f32x4*)(ti + (m * 64 + lane) * 4);
      lds_wait();
      f32x4 Tn[16];
#pragma unroll
      for (int m = 0; m < 16; ++m) Tn[m] = *(const f32x4*)(tn + (m * 64 + lane) * 4);
#pragma unroll
      for (int nt = 0; nt < 4; ++nt) {
        bf16x8 bh[2], bl[2];
#pragma unroll
        for (int ks = 0; ks < 2; ++ks) {
          const f32x4 ta = T[(2 * ks) * 4 + nt], tb = T[(2 * ks + 1) * 4 + nt];
          const float x[8] = {ta[0], ta[1], ta[2], ta[3], tb[0], tb[1], tb[2], tb[3]};
          float hf[8], lf[8];
#pragma unroll
          for (int e = 0; e < 8; ++e) { hf[e] = bf2f(f2bf(x[e])); lf[e] = x[e] - hf[e]; }
          bh[ks] = pack8(hf[0], hf[1], hf[2], hf[3], hf[4], hf[5], hf[6], hf[7]);
          bl[ks] = pack8(lf[0], lf[1], lf[2], lf[3], lf[4], lf[5], lf[6], lf[7]);
        }
#pragma unroll
        for (int mt = 0; mt < 4; ++mt) {
          f32x4 acc = Tn[mt * 4 + nt];
#pragma unroll
          for (int ks = 0; ks < 2; ++ks) {
            float x[8];
#pragma unroll
            for (int e = 0; e < 8; ++e) x[e] = til[((mt * 4 + 2 * ks + (e >> 2)) * 64 + ((c16 >> 2) & 3) * 16 + 4 * q + (e & 3)) * 4 + (c16 & 3)];
            float hf[8], lf[8];
#pragma unroll
            for (int e = 0; e < 8; ++e) { hf[e] = bf2f(f2bf(x[e])); lf[e] = x[e] - hf[e]; }
            const bf16x8 ah = pack8(hf[0], hf[1], hf[2], hf[3], hf[4], hf[5], hf[6], hf[7]);
            const bf16x8 al = pack8(lf[0], lf[1], lf[2], lf[3], lf[4], lf[5], lf[6], lf[7]);
            acc = __builtin_amdgcn_mfma_f32_16x16x32_bf16(ah, bh[ks], acc, 0, 0, 0);
            acc = __builtin_amdgcn_mfma_f32_16x16x32_bf16(ah, bl[ks], acc, 0, 0, 0);
            acc = __builtin_amdgcn_mfma_f32_16x16x32_bf16(al, bh[ks], acc, 0, 0, 0);
          }
          Tn[mt * 4 + nt] = acc;
        }
      }
#pragma unroll
      for (int m = 0; m < 16; ++m) { *(f32x4*)(tn + (m * 64 + lane) * 4) = T[m]; T[m] = Tn[m]; }
    }
  }
}

DEV void post_phase(u16* __restrict__ yf, const u16* __restrict__ yb, const u16* __restrict__ v, const u16* __restrict__ sg,
                    const float* __restrict__ bonus, const float* __restrict__ lg, const float* __restrict__ lb) {
  const int tid_ = ltid(); const int lane = tid_ & 63, wid = __builtin_amdgcn_readfirstlane(tid_ >> 6);
  for (int tok = blockIdx.x * 8 + wid; tok < GT; tok += gridDim.x * 8) {
#pragma unroll
    for (int it = 0; it < 4; ++it) {
      const int ch0 = it * 512 + lane * 8, h = ch0 >> 6; const size_t i = (size_t)tok * EI + ch0;
      const u32x4 a = *(const u32x4*)(yf + i), bq = *(const u32x4*)(yb + i), vv = *(const u32x4*)(v + i), gg = *(const u32x4*)(sg + i);
      const float2 bo = *(const float2*)(bonus + ((size_t)tok * 32 + h) * 2);
      float y[8]; float sum = 0.f;
#pragma unroll
      for (int e = 0; e < 4; ++e) { y[2 * e] = bflo(a[e]) + bflo(bq[e]); y[2 * e + 1] = bfhi(a[e]) + bfhi(bq[e]); sum += y[2 * e] + y[2 * e + 1]; }
      sum += __shfl_xor(sum, 1, 64); sum += __shfl_xor(sum, 2, 64); sum += __shfl_xor(sum, 4, 64);
      const float mean = sum * (1.f / 64.f);
      float var = 0.f;
#pragma unroll
      for (int e = 0; e < 8; ++e) { y[e] -= mean; var += y[e] * y[e]; }
      var += __shfl_xor(var, 1, 64); var += __shfl_xor(var, 2, 64); var += __shfl_xor(var, 4, 64);
      const float rs = rsqrtf(var * (1.f / 64.f) + 64e-5f), bon = bo.x + bo.y;
      const float4 g0 = *(const float4*)(lg + ch0), g1 = *(const float4*)(lg + ch0 + 4), b0 = *(const float4*)(lb + ch0), b1 = *(const float4*)(lb + ch0 + 4);
      const float ga[8] = {g0.x, g0.y, g0.z, g0.w, g1.x, g1.y, g1.z, g1.w}, ba[8] = {b0.x, b0.y, b0.z, b0.w, b1.x, b1.y, b1.z, b1.w};
      u32x4 o;
#pragma unroll
      for (int e = 0; e < 4; ++e) {
        const float o0 = (y[2 * e] * rs * ga[2 * e] + ba[2 * e] + bon * bflo(vv[e])) * bflo(gg[e]);
        const float o1 = (y[2 * e + 1] * rs * ga[2 * e + 1] + ba[2 * e + 1] + bon * bfhi(vv[e])) * bfhi(gg[e]);
        o[e] = cvtpk(o0, o1);
      }
      *(u32x4*)(yf + i) = o;
    }
  }
}

DEV void mla_mid_phase(const float* __restrict__ cqkv, const float* __restrict__ qn, const float* __restrict__ kvn,
                       const float* __restrict__ ct, const float* __restrict__ st,
                       u16* __restrict__ cqn, u16* __restrict__ ckvn, u16* __restrict__ kpe, int T) {
  const int tid_ = ltid(); const int lane = tid_ & 63, wid = __builtin_amdgcn_readfirstlane(tid_ >> 6);
  for (int tok = blockIdx.x * 8 + wid; tok < GT; tok += gridDim.x * 8) {
    const float* row = cqkv + (size_t)tok * 704;
    float q[6], ss = 0.f;
#pragma unroll
    for (int i = 0; i < 6; ++i) { q[i] = row[lane + i * 64]; ss += q[i] * q[i]; }
    ss = wsum(ss); float sc = rsqrtf(ss * (1.f / 384.f) + 1e-6f);
#pragma unroll
    for (int i = 0; i < 6; ++i) cqn[(size_t)tok * 384 + lane + i * 64] = f2bf(q[i] * sc * qn[lane + i * 64]);
    float c[4]; ss = 0.f;
#pragma unroll
    for (int i = 0; i < 4; ++i) { c[i] = row[384 + lane + i * 64]; ss += c[i] * c[i]; }
    ss = wsum(ss); sc = rsqrtf(ss * (1.f / 256.f) + 1e-6f);
#pragma unroll
    for (int i = 0; i < 4; ++i) ckvn[(size_t)tok * 256 + lane + i * 64] = f2bf(c[i] * sc * kvn[lane + i * 64]);
    const float x = row[640 + lane];
    const float xo = __shfl_xor(x, 32, 64);
    const int pos = tok % T, j = lane & 31;
    const float cs = ct[pos * 32 + j], sn = st[pos * 32 + j];
    const float o = lane < 32 ? x * cs - xo * sn : x * cs + xo * sn;
    kpe[(size_t)tok * 64 + lane] = f2bf(o);
  }
}

constexpr int SHM_V = 16384, SHM_K = 16384, SHM_KP = 8192;
#define KSWZ(row, colB) ((row) * 256 + ((colB) ^ (((row) & 7) << 4)))
#define KPSWZ(row, colB) ((row) * 128 + ((colB) ^ (((row) & 7) << 4)))
constexpr float ATT_SCALE = 0.07216878364870322f;
DEV void partialSM(f32x16& p0, f32x16& p1, float& m_reg, float& mn, float& alpha) {
  constexpr float C = ATT_SCALE * 1.4426950408889634f;
  float pmax = p0[0];
#pragma unroll
  for (int r = 1; r < 16; ++r) pmax = fmaxf(pmax, p0[r]);
#pragma unroll
  for (int r = 0; r < 16; ++r) pmax = fmaxf(pmax, p1[r]);
  { auto rr = __builtin_amdgcn_permlane32_swap(__float_as_uint(pmax), __float_as_uint(pmax), false, false);
    pmax = fmaxf(__uint_as_float(rr[0]), __uint_as_float(rr[1])); }
  if (__builtin_expect(__all(pmax - m_reg <= 8.f / ATT_SCALE), 1)) { mn = m_reg; alpha = 1.f; }
  else { mn = fmaxf(m_reg, pmax); alpha = __builtin_amdgcn_exp2f((m_reg - mn) * C); m_reg = mn; }
  const float mnC = -mn * C;
#pragma unroll
  for (int r = 0; r < 16; ++r) p0[r] = __builtin_amdgcn_exp2f(fmaf(p0[r], C, mnC));
#pragma unroll
  for (int r = 0; r < 16; ++r) p1[r] = __builtin_amdgcn_exp2f(fmaf(p1[r], C, mnC));
}
DEV void finishSM(f32x16& p0, f32x16& p1, float alpha, float& l_reg, bf16x8& pa0, bf16x8& pa1, bf16x8& pa2, bf16x8& pa3) {
  float ps = 0;
#pragma unroll
  for (int r = 0; r < 16; ++r) ps += p0[r];
#pragma unroll
  for (int r = 0; r < 16; ++r) ps += p1[r];
  { auto rr = __builtin_amdgcn_permlane32_swap(__float_as_uint(ps), __float_as_uint(ps), false, false);
    ps = __uint_as_float(rr[0]) + __uint_as_float(rr[1]); }
  l_reg = l_reg * alpha + ps;
#define PK4(PP, BASE, OUT) do { unsigned a0 = cvtpk(PP[BASE + 0], PP[BASE + 1]), a1 = cvtpk(PP[BASE + 2], PP[BASE + 3]);   \
    unsigned b0 = cvtpk(PP[BASE + 4], PP[BASE + 5]), b1 = cvtpk(PP[BASE + 6], PP[BASE + 7]);                              \
    auto r0 = __builtin_amdgcn_permlane32_swap(a0, b0, false, false); auto r1 = __builtin_amdgcn_permlane32_swap(a1, b1, false, false); \
    u32x4 w = {r0[0], r1[0], r0[1], r1[1]}; OUT = *reinterpret_cast<bf16x8*>(&w); } while (0)
  PK4(p0, 0, pa0); PK4(p0, 8, pa1); PK4(p1, 0, pa2); PK4(p1, 8, pa3);
#undef PK4
}
DEV int v_st(int k, int c) { const int kk = (k & ~0xC) | ((k & 4) << 1) | ((k & 8) >> 1); return ((kk >> 3) * 4 + (c >> 5)) * 512 + ((kk & 7) * 32 + (c & 31)) * 2; }
DEV int v_rd_base(int lane) { return ((lane & 3) << 3) | (((lane >> 2) & 3) << 6) | (((lane >> 4) & 1) << 5) | (((lane >> 5) & 1) << 8); }
constexpr int v_rd_off(int d0, int ks, int half) { return d0 * 512 + ks * 4096 + half * 2048; }
template <int OFF> DEV s16x4 tr_read(int vb) {
  s16x4 r; asm volatile("ds_read_b64_tr_b16 %0, %1 offset:%2" : "=&v"(r) : "v"(vb), "i"(OFF) : "memory"); return r;
}
template <int D0> DEV void pv_one(f32x16& od, int vb, bf16x8 pa0, bf16x8 pa1, bf16x8 pa2, bf16x8 pa3) {
  const s16x4 l0 = tr_read<v_rd_off(D0, 0, 0)>(vb), h0 = tr_read<v_rd_off(D0, 0, 1)>(vb), l1 = tr_read<v_rd_off(D0, 1, 0)>(vb), h1 = tr_read<v_rd_off(D0, 1, 1)>(vb);
  const s16x4 l2 = tr_read<v_rd_off(D0, 2, 0)>(vb), h2 = tr_read<v_rd_off(D0, 2, 1)>(vb), l3 = tr_read<v_rd_off(D0, 3, 0)>(vb), h3 = tr_read<v_rd_off(D0, 3, 1)>(vb);
  asm volatile("s_waitcnt lgkmcnt(0)" ::: "memory"); SBAR();
#define PK(L, H) (bf16x8){L[0], L[1], L[2], L[3], H[0], H[1], H[2], H[3]}
  od = __builtin_amdgcn_mfma_f32_32x32x16_bf16(pa0, PK(l0, h0), od, 0, 0, 0);
  od = __builtin_amdgcn_mfma_f32_32x32x16_bf16(pa1, PK(l1, h1), od, 0, 0, 0);
  od = __builtin_amdgcn_mfma_f32_32x32x16_bf16(pa2, PK(l2, h2), od, 0, 0, 0);
  od = __builtin_amdgcn_mfma_f32_32x32x16_bf16(pa3, PK(l3, h3), od, 0, 0, 0);
#undef PK
}

struct AttnP { const u16* q; const u16* kv; const u16* kpe; u16* sg; const float* ct; const float* st; int nseq, T; int dry; };
DEV void attn_phase(const AttnP& a, char* lds) {
  const int tid = ltid(), wid = __builtin_amdgcn_readfirstlane(tid >> 6), lane = tid & 63, r32 = lane & 31, hi = lane >> 5;
  char* V_lds = lds; char* K_lds = lds + 3 * SHM_V; char* KP_lds = lds + 3 * SHM_V + 2 * SHM_K;
  float* wsc = (float*)(lds + 3 * SHM_V + 2 * SHM_K + 2 * SHM_KP) + wid * 64; float* li_l = wsc; float* al_l = wsc + 32;
  const int nqb = a.T / 256, nitems = a.nseq * 16 * nqb, NT = a.T / 64;
  const int sr = tid >> 4, sc = (tid & 15) * 8, vst0 = v_st(sr, sc), vst1 = v_st(32 + sr, sc);
  const int pr = tid >> 3, pc = (tid & 7) * 8;
  const int vb0 = (int)(uintptr_t)V_lds + v_rd_base(lane);
  int kad[4], kpd[4];
#pragma unroll
  for (int q = 0; q < 4; ++q) { kad[q] = KSWZ(r32, q * 32 + hi * 16); kpd[q] = KPSWZ(r32, q * 32 + hi * 16); }
  const int vblk = (gridDim.x & 7) == 0 ? (int)(blockIdx.x & 7) * (int)(gridDim.x >> 3) + (int)(blockIdx.x >> 3) : (int)blockIdx.x;
  for (int it = vblk; it < nitems; it += gridDim.x) {
    const int qb = it % nqb, h = (it / nqb) & 15, b = it / (nqb * 16);
    const size_t sbase = (size_t)b * a.T;
    const int pos = qb * 256 + wid * 32 + r32;
    bf16x8 qr[12];
    {
      const u16* Qw = a.q + (sbase + pos) * 3072 + h * 192 + hi * 8;
#pragma unroll
      for (int d0 = 0; d0 < 12; ++d0) qr[d0] = *(const bf16x8*)(Qw + d0 * 16);
#pragma unroll
      for (int dd = 0; dd < 2; ++dd) {
        const int j0 = dd * 16 + hi * 8;
        const float4 c0 = *(const float4*)(a.ct + pos * 32 + j0), c1 = *(const float4*)(a.ct + pos * 32 + j0 + 4);
        const float4 s0 = *(const float4*)(a.st + pos * 32 + j0), s1 = *(const float4*)(a.st + pos * 32 + j0 + 4);
        const float cs[8] = {c0.x, c0.y, c0.z, c0.w, c1.x, c1.y, c1.z, c1.w};
        const float sn[8] = {s0.x, s0.y, s0.z, s0.w, s1.x, s1.y, s1.z, s1.w};
        u32x4 x1 = *(u32x4*)&qr[8 + dd], x2 = *(u32x4*)&qr[10 + dd], y1, y2;
#pragma unroll
        for (int e = 0; e < 4; ++e) {
          const float a0 = bflo(x1[e]), a1 = bfhi(x1[e]), b0 = bflo(x2[e]), b1 = bfhi(x2[e]);
          y1[e] = cvtpk(a0 * cs[2 * e] - b0 * sn[2 * e], a1 * cs[2 * e + 1] - b1 * sn[2 * e + 1]);
          y2[e] = cvtpk(b0 * cs[2 * e] + a0 * sn[2 * e], b1 * cs[2 * e + 1] + a1 * sn[2 * e + 1]);
        }
        qr[8 + dd] = *(bf16x8*)&y1; qr[10 + dd] = *(bf16x8*)&y2;
      }
    }
    float m_reg = -1e30f, l_reg = 0.f; f32x16 o[4] = {};
    bf16x8 vs0, vs1, ks0, ks1, kp0;
    const u16* kvh = a.kv + sbase * 4096 + h * 256;
    const u16* kph = a.kpe + sbase * 64;
    const unsigned voff = (unsigned)(sr * 8192 + sc * 2), poff = (unsigned)(pr * 128 + pc * 2);
#define SLOAD(k0) do { const char* bK0 = (const char*)kvh + (size_t)(k0) * 8192; const char* bK1 = bK0 + 32 * 8192; const char* bP = (const char*)kph + (size_t)(k0) * 128; \
    vs0 = *(const bf16x8*)(bK0 + voff + 256); vs1 = *(const bf16x8*)(bK1 + voff + 256); \
    ks0 = *(const bf16x8*)(bK0 + voff); ks1 = *(const bf16x8*)(bK1 + voff); \
    kp0 = *(const bf16x8*)(bP + poff); } while (0)
#define SWRITE(bb, vbuf) do { *(bf16x8*)(V_lds + (vbuf) * SHM_V + vst0) = vs0; *(bf16x8*)(V_lds + (vbuf) * SHM_V + vst1) = vs1; \
    *(bf16x8*)(K_lds + (bb) * SHM_K + KSWZ(sr, sc * 2)) = ks0; *(bf16x8*)(K_lds + (bb) * SHM_K + KSWZ(32 + sr, sc * 2)) = ks1; \
    *(bf16x8*)(KP_lds + (bb) * SHM_KP + KPSWZ(pr, pc * 2)) = kp0; } while (0)
    __syncthreads();
    SLOAD(0); SWRITE(0, 0); __syncthreads();
    const bool grpB = wid >= 4;
    bf16x8 pa0, pa1, pa2, pa3;
    int vcur = 0, vprev = 2;
#define PV_ALL(vbuf) do { const int vb_ = vb0 + (vbuf) * SHM_V; \
      pv_one<0>(o[0], vb_, pa0, pa1, pa2, pa3); pv_one<1>(o[1], vb_, pa0, pa1, pa2, pa3); \
      pv_one<2>(o[2], vb_, pa0, pa1, pa2, pa3); pv_one<3>(o[3], vb_, pa0, pa1, pa2, pa3); } while (0)
    for (int j = 0; j < NT; ++j) {
      const int bb = j & 1;
      if (j + 1 < NT) SLOAD((j + 1) * 64);
      SBAR();
      if (grpB && j > 0) PV_ALL(vprev);
      f32x16 p0 = {}, p1 = {};
      {
        const char* Ks = K_lds + bb * SHM_K; const char* Kp = KP_lds + bb * SHM_KP;
#pragma unroll
        for (int d0 = 0; d0 < 8; ++d0) {
          const bf16x8 b0 = *(const bf16x8*)(Ks + kad[d0 & 3] + (d0 >> 2) * 128), b1 = *(const bf16x8*)(Ks + kad[d0 & 3] + (d0 >> 2) * 128 + 8192);
          p0 = __builtin_amdgcn_mfma_f32_32x32x16_bf16(b0, qr[d0], p0, 0, 0, 0);
          p1 = __builtin_amdgcn_mfma_f32_32x32x16_bf16(b1, qr[d0], p1, 0, 0, 0); }
#pragma unroll
        for (int d0 = 0; d0 < 4; ++d0) {
          const bf16x8 b0 = *(const bf16x8*)(Kp + kpd[d0]), b1 = *(const bf16x8*)(Kp + kpd[d0] + 4096);
          p0 = __builtin_amdgcn_mfma_f32_32x32x16_bf16(b0, qr[8 + d0], p0, 0, 0, 0);
          p1 = __builtin_amdgcn_mfma_f32_32x32x16_bf16(b1, qr[8 + d0], p1, 0, 0, 0); }
      }
      float mn, alpha;
      partialSM(p0, p1, m_reg, mn, alpha);
      if (__any(alpha < 1.f)) {
        if (hi == 0) al_l[r32] = alpha;
        lds_wait();
#pragma unroll
        for (int dd = 0; dd < 4; ++dd)
#pragma unroll
          for (int r = 0; r < 16; ++r) o[dd][r] *= al_l[crow(r, hi)];
      }
      finishSM(p0, p1, alpha, l_reg, pa0, pa1, pa2, pa3); SBAR();
      if (!grpB) PV_ALL(vcur);
      const int vnext = vcur == 2 ? 0 : vcur + 1;
      if (j + 1 < NT) SWRITE(bb ^ 1, vnext);
      vprev = vcur; vcur = vnext;
      __syncthreads();
    }
    if (grpB) PV_ALL(vprev);
#undef PV_ALL
#undef SLOAD
#undef SWRITE
    {
      int t2 = threadIdx.x; asm volatile("" : "+v"(t2));
      const int wid2 = t2 >> 6, r2 = t2 & 31, hi2 = (t2 >> 5) & 1;
      float* li2 = (float*)(lds + 3 * SHM_V + 2 * SHM_K + 2 * SHM_KP) + wid2 * 64;
      if (hi2 == 0) li2[r2] = l_reg;
      lds_wait();
      u16* Ow = a.sg + (sbase + qb * 256 + wid2 * 32) * EI + h * 128 + r2;
#pragma unroll
      for (int r = 0; r < 16; ++r) {
        const int orow = crow(r, hi2);
        const float rl = __builtin_amdgcn_rcpf(li2[orow]);
#pragma unroll
        for (int d0 = 0; d0 < 4; ++d0) {
          u16* pp = Ow + (size_t)orow * EI + d0 * 32;
          if (!a.dry) *pp = f2bf(o[d0][r] * rl * bf2f(*pp));
        }
      }
    }
  }
}

#if MEGA
#define GRID_SYNC() gsync(p, lds)
#else
#define GRID_SYNC() do {} while (0)
#endif
struct Grp { const float* xin0; float* xres; int nseq, T; };
DEV Grp get_group(const P& p, int g) {
  Grp r;
  r.xin0 = g == 0 ? p.x_prompt : p.x_sample + (size_t)(g - 1) * GT * DM;
  r.xres = p.out + (size_t)g * GT * DM;
  r.nseq = g == 0 ? 8 : 1; r.T = g == 0 ? 2048 : 16384;
  return r;
}
template <int LT, int ph>
DEV void run_phase(const P& p, int g, int layer, char* lds) {
  const Grp G = get_group(p, g);
  const int j = layer >> 1;
  const float* xin = layer == 0 ? G.xin0 : G.xres;
  size_t zoff = 0; asm volatile("" : "+s"(zoff));
  char* ws = p.ws + zoff;
  u16* hbuf = (u16*)(ws + O_HBUF);
  u16* sg = (u16*)(ws + O_SG);
  if constexpr (LT == 0) {
    u16 *rb = (u16*)(ws + O_RB), *kb = (u16*)(ws + O_KB), *vb = (u16*)(ws + O_VB), *yf = (u16*)(ws + O_YF), *yb = (u16*)(ws + O_YB);
    u16 *twl = (u16*)(ws + O_TWL), *al = (u16*)(ws + O_AL); float* bon = (float*)(ws + O_BON);
    if constexpr (ph == 0) rms_phase(xin, p.ln_g + layer * DM, hbuf);
    else if constexpr (ph == 1) {
      GemmP q{}; q.A = hbuf; q.lda = DM; q.Bt = (const u16*)(ws + O_WRWIN) + (size_t)j * RW_N * DM; q.K = DM; q.NT = 66;
      q.mu = p.rw_mu + (size_t)j * 6 * DM; q.T = G.T; q.o0 = rb; q.o1 = kb; q.o2 = vb; q.o3 = sg; q.o4 = twl; q.o5 = al;
      lerp_phase(hbuf, q.mu, yf, G.T); GRID_SYNC();
      GemmP w = q; w.A = yf; w.astride = (size_t)GT * DM; w.NT = 32; w.nt0 = 0;
      gemm_phase<LOAD_PLAIN, EPI_RWKV, 4>(w, lds);
      q.NT = 2; q.nt0 = 64;
      gemm_phase<LOAD_LERP, EPI_RWKV, 2>(q, lds);
    } else if constexpr (ph == 2) {
      ScanP s{}; s.r = rb; s.k = kb; s.v = vb; s.twl = twl; s.al = al; s.yf = yf; s.yb = yb; s.bonus = bon;
      s.w0 = p.rw_w0 + (size_t)j * 2 * EI; s.w2 = p.rw_w2 + (size_t)j * 2 * 64 * EI; s.a0 = p.rw_a0 + (size_t)j * 2 * EI; s.a2 = p.rw_a2 + (size_t)j * 2 * 64 * EI;
      s.kk = p.rw_kk + (size_t)j * EI; s.ka = p.rw_ka + (size_t)j * EI; s.rk = p.rw_rk + (size_t)j * EI; s.nseq = G.nseq; s.T = G.T;
      s.tbuf = (float*)hbuf;
      if (G.T > 2048) {
        s.nseg = 16;
        scan_phase(s, lds, 0); GRID_SYNC();
        scan_combine_phase(s, lds); GRID_SYNC();
        scan_phase(s, lds, 1);
      } else { s.nseg = 1; scan_phase(s, lds, 1); }
    } else if constexpr (ph == 3) post_phase(yf, yb, vb, sg, bon, p.rw_lnx_g + (size_t)j * EI, p.rw_lnx_b + (size_t)j * EI);
    else {
      GemmP q{}; q.A = yf; q.lda = EI; q.Bt = (const u16*)(ws + O_WRWOUT) + (size_t)j * DM * EI; q.K = EI; q.NT = 4; q.xin = xin; q.xout = G.xres;
      for (int rep = 1; rep < REP_GEMM; ++rep) { q.dry = (gridDim.x != 12345); gemm_phase<LOAD_PLAIN, EPI_RES, 4>(q, lds); } q.dry = 0;
      gemm_phase<LOAD_PLAIN, EPI_RES, 4>(q, lds);
    }
  } else {
    float* cqkv = (float*)(ws + O_CQKV); u16 *cqn = (u16*)(ws + O_CQN), *ckvn = (u16*)(ws + O_CKVN), *kpe = (u16*)(ws + O_KPE), *qq = (u16*)(ws + O_Q), *kv = (u16*)(ws + O_KV);
    const float* ct = (const float*)(ws + O_COS); const float* st = (const float*)(ws + O_SIN);
    if constexpr (ph == 0) rms_phase(xin, p.ln_g + layer * DM, hbuf);
    else if constexpr (ph == 1) {
      GemmP q{}; q.A = hbuf; q.lda = DM; q.Bt = (const u16*)(ws + O_WMLIN) + (size_t)j * ML_NP * DM; q.K = DM; q.NT = 11; q.of = cqkv; q.o0 = sg;
      for (int rep = 1; rep < REP_GEMM; ++rep) { q.dry = (gridDim.x != 12345); gemm_phase<LOAD_PLAIN, EPI_MLAIN, 4>(q, lds); } q.dry = 0;
      gemm_phase<LOAD_PLAIN, EPI_MLAIN, 4>(q, lds);
    } else if constexpr (ph == 2) mla_mid_phase(cqkv, p.ml_qn + j * 384, p.ml_kvn + j * 256, ct, st, cqn, ckvn, kpe, G.T);
    else if constexpr (ph == 3) {
      GemmP q{}; q.A = cqn; q.lda = 384; q.Bt = (const u16*)(ws + O_WUQ) + (size_t)j * 3072 * 384; q.K = 384; q.NT = 12; q.o0 = qq; q.ldc = 3072;
      for (int rep = 1; rep < REP_GEMM; ++rep) { q.dry = (gridDim.x != 12345); gemm_phase<LOAD_PLAIN, EPI_BF16, 4>(q, lds); } q.dry = 0;
      gemm_phase<LOAD_PLAIN, EPI_BF16, 4>(q, lds);
      GemmP r{}; r.A = ckvn; r.lda = 256; r.Bt = (const u16*)(ws + O_WUKV) + (size_t)j * 4096 * 256; r.K = 256; r.NT = 16; r.o0 = kv; r.ldc = 4096;
      for (int rep = 1; rep < REP_GEMM; ++rep) { r.dry = (gridDim.x != 12345); gemm_phase<LOAD_PLAIN, EPI_BF16, 4>(r, lds); } r.dry = 0;
      gemm_phase<LOAD_PLAIN, EPI_BF16, 4>(r, lds);
    } else if constexpr (ph == 4) {
      AttnP a{}; a.q = qq; a.kv = kv; a.kpe = kpe; a.sg = sg; a.ct = ct; a.st = st; a.nseq = G.nseq; a.T = G.T;
      for (int rep = 1; rep < REP_ATTN; ++rep) { a.dry = (gridDim.x != 12345); attn_phase(a, lds); } a.dry = 0;
      attn_phase(a, lds);
    } else {
      GemmP q{}; q.A = sg; q.lda = EI; q.Bt = (const u16*)(ws + O_WMLOUT) + (size_t)j * DM * EI; q.K = EI; q.NT = 4; q.xin = xin; q.xout = G.xres;
      for (int rep = 1; rep < REP_GEMM; ++rep) { q.dry = (gridDim.x != 12345); gemm_phase<LOAD_PLAIN, EPI_RES, 4>(q, lds); } q.dry = 0;
      gemm_phase<LOAD_PLAIN, EPI_RES, 4>(q, lds);
    }
  }
}


template <int LT, int PH>
__global__ __launch_bounds__(512) void k_phase(P p, int g, int layer) {
  extern __shared__ __attribute__((aligned(16))) char lds[];
  if constexpr (LT == 2) { if constexpr (PH == 0) init_phase(p, lds); else final_phase(p.out, p.final_g); }
  else run_phase<LT, PH>(p, g, layer, lds);
}

#if MEGA
__global__ __launch_bounds__(512) void k_mega(P p) {
  extern __shared__ __attribute__((aligned(16))) char lds[];
  cg::grid_group grid = cg::this_grid();
  {
    unsigned* bar = (unsigned*)(p.ws + O_BAR);
    if (blockIdx.x == 0) for (int i = threadIdx.x; i < XCD_BAR_WORDS; i += 512) bar[i] = 0u;
    if (threadIdx.x == 0) { volatile LAS unsigned* st = (volatile LAS unsigned*)(lds + SHM_BYTES - 16); st[0] = 0u; st[1] = 0u; }
  }
  init_phase(p, lds);
  grid.sync();
  if (threadIdx.x == 0) (void)xb_add(&((unsigned*)(p.ws + O_BAR))[XB_XCNT(xb_xcc_id())], 1u);
  for (int g = 0; g < 3; ++g)
    for (int layer = 0; layer < 4; ++layer) {
      if ((layer & 1) == 0) {
        run_phase<0, 0>(p, g, layer, lds); gsync(p, lds); run_phase<0, 1>(p, g, layer, lds); gsync(p, lds); run_phase<0, 2>(p, g, layer, lds); gsync(p, lds);
        run_phase<0, 3>(p, g, layer, lds); gsync(p, lds); run_phase<0, 4>(p, g, layer, lds); gsync(p, lds);
      } else {
        run_phase<1, 0>(p, g, layer, lds); gsync(p, lds); run_phase<1, 1>(p, g, layer, lds); gsync(p, lds); run_phase<1, 2>(p, g, layer, lds); gsync(p, lds);
        run_phase<1, 3>(p, g, layer, lds); gsync(p, lds); run_phase<1, 4>(p, g, layer, lds); gsync(p, lds); run_phase<1, 5>(p, g, layer, lds); gsync(p, lds);
      }
    }
  final_phase(p.out, p.final_g);
}
#endif

extern "C" void kernel_launch(void* const* d_in, const int* in_sizes, int n_in, void* d_out, int out_size, void* d_ws, size_t ws_size, hipStream_t stream) {
  if (n_in != 22 || ws_size < WS_NEED) { fprintf(stderr, "kernel_launch: bad args n_in %d ws %zu need %zu\n", n_in, ws_size, WS_NEED); return; }
  P p{};
  const float** f = (const float**)&p;
  for (int i = 0; i < 22; ++i) f[i] = (const float*)d_in[i];
  p.out = (float*)d_out; p.ws = (char*)d_ws;
#if MEGA
  static int grid_blocks = 0;
  if (!grid_blocks) {
    hipFuncSetAttribute((const void*)k_mega, hipFuncAttributeMaxDynamicSharedMemorySize, SHM_BYTES);
    int dev = 0, cus = 0, per_cu = 0;
    hipGetDevice(&dev);
    hipDeviceGetAttribute(&cus, hipDeviceAttributeMultiprocessorCount, dev);
    hipOccupancyMaxActiveBlocksPerMultiprocessor(&per_cu, k_mega, 512, SHM_BYTES);
    if (per_cu > 1) per_cu = 1;
    grid_blocks = cus * per_cu;
  }
  void* args[] = {&p};
  hipError_t e = hipLaunchCooperativeKernel((void*)k_mega, dim3(grid_blocks), dim3(512), args, SHM_BYTES, stream);
  if (e != hipSuccess) fprintf(stderr, "cooperative launch failed: %s (grid %d)\n", hipGetErrorString(e), grid_blocks);
#else
  const int NB = 256;
#define LAUNCH(LT, PH, g, layer) do { static int inited = 0; if (!inited) { hipFuncSetAttribute((const void*)k_phase<LT, PH>, hipFuncAttributeMaxDynamicSharedMemorySize, SHM_BYTES); inited = 1; } \
    hipLaunchKernelGGL((k_phase<LT, PH>), dim3(NB), dim3(512), SHM_BYTES, stream, p, g, layer); } while (0)
  LAUNCH(2, 0, 0, 0);
  for (int g = 0; g < 3; ++g)
    for (int layer = 0; layer < 4; ++layer) {
      if ((layer & 1) == 0) { LAUNCH(0, 0, g, layer); LAUNCH(0, 1, g, layer); LAUNCH(0, 2, g, layer); LAUNCH(0, 3, g, layer); LAUNCH(0, 4, g, layer); }
      else { LAUNCH(1, 0, g, layer); LAUNCH(1, 1, g, layer); LAUNCH(1, 2, g, layer); LAUNCH(1, 3, g, layer); LAUNCH(1, 4, g, layer); LAUNCH(1, 5, g, layer); }
    }
  LAUNCH(2, 1, 0, 0);
#endif
}
```

```cpp
#include <hip/hip_runtime.h>
#include <hip/hip_bf16.h>
#include <hip/hip_cooperative_groups.h>
#include <cstdio>
namespace cg = cooperative_groups;

#ifndef REP_GEMM
#define REP_GEMM 1
#endif
#ifndef REP_ATTN
#define REP_ATTN 1
#endif
#ifndef REP_SCAN
#define REP_SCAN 1
#endif
#ifndef MEGA
#define MEGA 1
#endif

typedef unsigned short u16;
using bf16x8 = __attribute__((ext_vector_type(8))) short;
using s16x4  = __attribute__((ext_vector_type(4))) short;
using f32x16 = __attribute__((ext_vector_type(16))) float;
using f32x4  = __attribute__((ext_vector_type(4))) float;
using u32x4  = __attribute__((ext_vector_type(4))) unsigned;
using u32x2  = __attribute__((ext_vector_type(2))) unsigned;
#define DEV __device__ __forceinline__
#define SBAR() __builtin_amdgcn_sched_barrier(0)

constexpr int DM = 1024, EI = 2048, GT = 16384;
constexpr int NTOK = 49152;
constexpr int RW_N = 8448, ML_N = 2752, ML_NP = 2816;
constexpr int SHM_BYTES = 158720;

constexpr size_t alup(size_t x) { return (x + 255) / 256 * 256; }
constexpr size_t O_WRWIN  = 0;
constexpr size_t O_WRWOUT = O_WRWIN  + alup((size_t)2 * RW_N * DM * 2);
constexpr size_t O_WMLIN  = O_WRWOUT + alup((size_t)2 * DM * EI * 2);
constexpr size_t O_WUQ    = O_WMLIN  + alup((size_t)2 * ML_NP * DM * 2);
constexpr size_t O_WUKV   = O_WUQ    + alup((size_t)2 * 3072 * 384 * 2);
constexpr size_t O_WMLOUT = O_WUKV   + alup((size_t)2 * 4096 * 256 * 2);
constexpr size_t O_COS    = O_WMLOUT + alup((size_t)2 * DM * EI * 2);
constexpr size_t O_SIN    = O_COS    + alup((size_t)16384 * 32 * 4);
constexpr size_t O_HBUF   = O_SIN    + alup((size_t)16384 * 32 * 4);
constexpr size_t O_R0     = O_HBUF   + alup((size_t)GT * DM * 2);
constexpr size_t SZ_E = (size_t)GT * EI * 2;
constexpr size_t O_SG   = O_R0;
constexpr size_t O_RB   = O_SG + SZ_E;
constexpr size_t O_KB   = O_RB + SZ_E;
constexpr size_t O_VB   = O_KB + SZ_E;
constexpr size_t O_YF   = O_VB + SZ_E;
constexpr size_t O_YB   = O_YF + SZ_E;
constexpr size_t O_TWL  = O_YB + SZ_E;
constexpr size_t O_AL   = O_TWL + alup((size_t)GT * 128 * 2);
constexpr size_t O_BON  = O_AL  + alup((size_t)GT * 128 * 2);
constexpr size_t O_RW_END = O_BON + alup((size_t)GT * 64 * 4);
constexpr size_t O_CQKV = O_SG + SZ_E;
constexpr size_t O_CQN  = O_CQKV + alup((size_t)GT * 704 * 4);
constexpr size_t O_CKVN = O_CQN  + alup((size_t)GT * 384 * 2);
constexpr size_t O_KPE  = O_CKVN + alup((size_t)GT * 256 * 2);
constexpr size_t O_Q    = O_KPE  + alup((size_t)GT * 64 * 2);
constexpr size_t O_KV   = O_Q    + alup((size_t)GT * 3072 * 2);
constexpr size_t O_ML_END = O_KV + alup((size_t)GT * 4096 * 2);
constexpr size_t O_FLAG = O_RW_END > O_ML_END ? O_RW_END : O_ML_END;
constexpr size_t O_BAR = O_FLAG + 256;
constexpr size_t WS_NEED = O_BAR + 16384;

struct P {
  const float* x_prompt; const float* x_sample; const float* ln_g; const float* final_g;
  const float* rw_mu; const float* rw_in; const float* rw_w0; const float* rw_w2; const float* rw_a0; const float* rw_a2;
  const float* rw_kk; const float* rw_ka; const float* rw_rk; const float* rw_lnx_g; const float* rw_lnx_b; const float* rw_out;
  const float* ml_in; const float* ml_qn; const float* ml_kvn; const float* ml_uq; const float* ml_ukv; const float* ml_out;
  float* out; char* ws;
};

typedef __attribute__((ext_vector_type(2))) __bf16 bf16x2_t;
typedef __attribute__((ext_vector_type(2))) float f32x2_t;
DEV unsigned cvtpk(float lo, float hi) { f32x2_t v = {lo, hi}; bf16x2_t b = __builtin_convertvector(v, bf16x2_t); return __builtin_bit_cast(unsigned, b); }
DEV float bf2f(u16 x) { return __uint_as_float(((unsigned)x) << 16); }
DEV float bflo(unsigned x) { return __uint_as_float(x << 16); }
DEV float bfhi(unsigned x) { return __uint_as_float(x & 0xffff0000u); }
DEV u16 f2bf(float x) { __bf16 b = (__bf16)x; return __builtin_bit_cast(u16, b); }
DEV float wsum(float v) {
#pragma unroll
  for (int o = 32; o >= 1; o >>= 1) v += __shfl_xor(v, o, 64);
  return v;
}
DEV float siluf(float x) { return x / (1.f + __expf(-x)); }
DEV int crow(int r, int hi) { return (r & 3) + 8 * (r >> 2) + 4 * hi; }
DEV int ltid() { int t = threadIdx.x; asm volatile("" : "+v"(t)); return t; }
template <typename T> DEV T gld(size_t base, unsigned off) { return *(const __attribute__((address_space(1))) T*)(base + off); }
template <typename T> DEV void gst(size_t base, unsigned off, T v) { *(__attribute__((address_space(1))) T*)(base + off) = v; }
DEV void lds_wait() { asm volatile("s_waitcnt lgkmcnt(0)" ::: "memory"); }


#define XB_TMO      128
#define XB_XCNT(j)  (256  + 64 * (j))
#define XB_XSUB(j)  (1280 + 64 * (j))
#define XB_XGEN(j)  (2304 + 64 * (j))
#define XB_TOP      3328
#define XB_TOPGEN   3392
#define XCD_BAR_WORDS 3456
#define XB_SPIN_CAP (1u << 22)
#define LAS __attribute__((address_space(3)))
DEV unsigned xb_ld(unsigned* p)              { return __hip_atomic_load(p, __ATOMIC_RELAXED, __HIP_MEMORY_SCOPE_AGENT); }
DEV unsigned xb_add(unsigned* p, unsigned v) { return __hip_atomic_fetch_add(p, v, __ATOMIC_RELAXED, __HIP_MEMORY_SCOPE_AGENT); }
DEV unsigned xb_xcc_id() { return (unsigned)__builtin_amdgcn_s_getreg((3 << 11) | 20) & 0xFu; }
#define XB_SPIN(cond, bar) do { unsigned _sp = 0; while (cond) { __builtin_amdgcn_s_sleep(1); \
    if ((++_sp & 255u) == 0u) { if (xb_ld(&(bar)[XB_TMO])) break; if (_sp > XB_SPIN_CAP) { atomicAdd(&(bar)[XB_TMO], 1u); break; } } } } while (0)
struct XcdBarrier { unsigned* bar; unsigned x; volatile LAS unsigned* st; };
DEV void xcd_barrier_complete(unsigned* bar, unsigned x, unsigned& nloc, unsigned& nx) {
  const unsigned G = gridDim.x * gridDim.y * gridDim.z;
  unsigned sum, cnt, mine, sp = 0u;
  for (;;) {
    sum = 0u; cnt = 0u; mine = 0u;
#pragma unroll
    for (unsigned j = 0; j < 16; ++j) { const unsigned c = xb_ld(&bar[XB_XCNT(j)]); sum += c; cnt += (c > 0u) ? 1u : 0u; mine = (j == x) ? c : mine; }
    if (sum == G) break;
    __builtin_amdgcn_s_sleep(1);
    if ((++sp & 255u) == 0u) { if (xb_ld(&bar[XB_TMO])) break; if (sp > XB_SPIN_CAP) { atomicAdd(&bar[XB_TMO], 1u); break; } }
  }
  nloc = mine > 0u ? mine : 1u; nx = cnt > 0u ? cnt : 1u;
}
DEV void xcd_barrier(const XcdBarrier& b) {
  asm volatile("s_waitcnt vmcnt(0)" ::: "memory");
  __syncthreads();
  if (threadIdx.x == 0) {
    unsigned* bar = b.bar;
    __builtin_amdgcn_s_waitcnt(0);
    unsigned nloc = b.st[0], nx = b.st[1];
    if (nloc == 0u) { xcd_barrier_complete(bar, b.x, nloc, nx); b.st[0] = nloc; b.st[1] = nx; }
    const unsigned old = xb_add(&bar[XB_XSUB(b.x)], 1u);
    const unsigned gen = old / nloc;
    if (old + 1u == (gen + 1u) * nloc) {
      __builtin_amdgcn_fence(__ATOMIC_RELEASE, "agent");
      asm volatile("s_waitcnt vmcnt(0)" ::: "memory");
      const unsigned og = xb_add(&bar[XB_TOP], 1u);
      const unsigned tg = og / nx;
      if (og + 1u == (tg + 1u) * nx) xb_add(&bar[XB_TOPGEN], 1u);
      else XB_SPIN(xb_ld(&bar[XB_TOPGEN]) == tg, bar);
      __builtin_amdgcn_fence(__ATOMIC_ACQUIRE, "agent");
      xb_add(&bar[XB_XGEN(b.x)], 1u);
      asm volatile("s_waitcnt vmcnt(0)" ::: "memory");
    } else {
      XB_SPIN(xb_ld(&bar[XB_XGEN(b.x)]) == gen, bar);
      __builtin_amdgcn_fence(__ATOMIC_ACQUIRE, "agent");
      asm volatile("s_waitcnt vmcnt(0)" ::: "memory");
    }
  }
  __syncthreads();
}
DEV void gsync(const P& p, char* lds) {
  XcdBarrier b; b.bar = (unsigned*)(p.ws + O_BAR); b.x = xb_xcc_id(); b.st = (volatile LAS unsigned*)(lds + SHM_BYTES - 16);
  xcd_barrier(b);
}

DEV void convert_T(const float* __restrict__ src, u16* __restrict__ dst, int K, int N, int Npad, char* lds_) {
  float* lds = (float*)lds_;
  const int tid = ltid(), tk = K / 64, tn = Npad / 64;
  for (int t = blockIdx.x; t < tk * tn; t += gridDim.x) {
    const int k0 = (t % tk) * 64, n0 = (t / tk) * 64;
    __syncthreads();
#pragma unroll
    for (int i = 0; i < 2; ++i) {
      const int kr = (tid >> 4) + i * 32, c = (tid & 15) * 4;
      float4 v = make_float4(0.f, 0.f, 0.f, 0.f);
      if (n0 + c < N) v = *(const float4*)(src + (long)(k0 + kr) * N + n0 + c);
      lds[kr * 65 + c + 0] = v.x; lds[kr * 65 + c + 1] = v.y; lds[kr * 65 + c + 2] = v.z; lds[kr * 65 + c + 3] = v.w;
    }
    __syncthreads();
    const int n = tid >> 3, kc = (tid & 7) * 8;
    u32x4 w;
    w[0] = cvtpk(lds[(kc + 0) * 65 + n], lds[(kc + 1) * 65 + n]);
    w[1] = cvtpk(lds[(kc + 2) * 65 + n], lds[(kc + 3) * 65 + n]);
    w[2] = cvtpk(lds[(kc + 4) * 65 + n], lds[(kc + 5) * 65 + n]);
    w[3] = cvtpk(lds[(kc + 6) * 65 + n], lds[(kc + 7) * 65 + n]);
    *(u32x4*)(dst + (long)(n0 + n) * K + k0 + kc) = w;
  }
}

DEV void init_phase(const P& p, char* lds) {
  for (int j = 0; j < 2; ++j) {
    convert_T(p.rw_in  + (size_t)j * DM * RW_N, (u16*)(p.ws + O_WRWIN)  + (size_t)j * RW_N * DM, DM, RW_N, RW_N, lds);
    convert_T(p.rw_out + (size_t)j * EI * DM,   (u16*)(p.ws + O_WRWOUT) + (size_t)j * DM * EI,   EI, DM, DM, lds);
    convert_T(p.ml_in  + (size_t)j * DM * ML_N, (u16*)(p.ws + O_WMLIN)  + (size_t)j * ML_NP * DM, DM, ML_N, ML_NP, lds);
    convert_T(p.ml_uq  + (size_t)j * 384 * 3072, (u16*)(p.ws + O_WUQ)   + (size_t)j * 3072 * 384, 384, 3072, 3072, lds);
    convert_T(p.ml_ukv + (size_t)j * 256 * 4096, (u16*)(p.ws + O_WUKV)  + (size_t)j * 4096 * 256, 256, 4096, 4096, lds);
    convert_T(p.ml_out + (size_t)j * EI * DM,   (u16*)(p.ws + O_WMLOUT) + (size_t)j * DM * EI,   EI, DM, DM, lds);
  }
  float* ct = (float*)(p.ws + O_COS); float* st = (float*)(p.ws + O_SIN);
  const int tid_ = ltid();
  for (int i = blockIdx.x * 512 + tid_; i < 16384 * 32; i += gridDim.x * 512) {
    const int pos = i >> 5, j = i & 31;
    const float invf = 1.0f / powf(10000.0f, (float)(2 * j) / 64.0f);
    const float ang = (float)pos * invf;
    const double a = (double)ang;
    const double n = rint(a * 0.15915494309189535);
    const float r = (float)(a - n * 6.283185307179586);
    ct[i] = cosf(r); st[i] = sinf(r);
  }
}

DEV void rms_phase(const float* __restrict__ x, const float* __restrict__ g, u16* __restrict__ hout) {
  const int tid_ = ltid(); const int lane = tid_ & 63, wid = __builtin_amdgcn_readfirstlane(tid_ >> 6);
  for (int tok = blockIdx.x * 8 + wid; tok < GT; tok += gridDim.x * 8) {
    const float4* xr = (const float4*)(x + (size_t)tok * DM);
    float4 v[4]; float ss = 0.f;
#pragma unroll
    for (int i = 0; i < 4; ++i) { v[i] = xr[lane + i * 64]; ss += v[i].x * v[i].x + v[i].y * v[i].y + v[i].z * v[i].z + v[i].w * v[i].w; }
    ss = wsum(ss);
    const float sc = rsqrtf(ss * (1.f / DM) + 1e-6f);
#pragma unroll
    for (int i = 0; i < 4; ++i) {
      const float4 gg = ((const float4*)g)[lane + i * 64];
      u32x2 w; w[0] = cvtpk(v[i].x * sc * gg.x, v[i].y * sc * gg.y); w[1] = cvtpk(v[i].z * sc * gg.z, v[i].w * sc * gg.w);
      *(u32x2*)(hout + (size_t)tok * DM + (lane + i * 64) * 4) = w;
    }
  }
}

DEV void final_phase(float* __restrict__ x, const float* __restrict__ g) {
  const int tid_ = ltid(); const int lane = tid_ & 63, wid = __builtin_amdgcn_readfirstlane(tid_ >> 6);
  for (int tok = blockIdx.x * 8 + wid; tok < NTOK; tok += gridDim.x * 8) {
    float4* xr = (float4*)(x + (size_t)tok * DM);
    float4 v[4]; float ss = 0.f;
#pragma unroll
    for (int i = 0; i < 4; ++i) { v[i] = xr[lane + i * 64]; ss += v[i].x * v[i].x + v[i].y * v[i].y + v[i].z * v[i].z + v[i].w * v[i].w; }
    ss = wsum(ss);
    const float sc = rsqrtf(ss * (1.f / DM) + 1e-6f);
#pragma unroll
    for (int i = 0; i < 4; ++i) {
      const float4 gg = ((const float4*)g)[lane + i * 64];
      float4 ov = make_float4(v[i].x * sc * gg.x, v[i].y * sc * gg.y, v[i].z * sc * gg.z, v[i].w * sc * gg.w);
      xr[lane + i * 64] = ov;
    }
  }
}


DEV void lerp_phase(const u16* __restrict__ h, const float* __restrict__ mu, u16* __restrict__ out, int T) {
  const int tid_ = ltid(); const int lane = tid_ & 63, wid = __builtin_amdgcn_readfirstlane(tid_ >> 6);
  for (int tok = blockIdx.x * 8 + wid; tok < GT; tok += gridDim.x * 8) {
    const int pos = tok % T;
#pragma unroll
    for (int half = 0; half < 2; ++half) {
      const int c0 = half * 512 + lane * 8;
      const u32x4 c = *(const u32x4*)(h + (size_t)tok * DM + c0);
      u32x4 pv = {0u, 0u, 0u, 0u}, nx = {0u, 0u, 0u, 0u};
      if (pos > 0) pv = *(const u32x4*)(h + (size_t)(tok - 1) * DM + c0);
      if (pos < T - 1) nx = *(const u32x4*)(h + (size_t)(tok + 1) * DM + c0);
      float hh[8], xx[8];
#pragma unroll
      for (int e = 0; e < 4; ++e) {
        hh[2 * e] = bflo(c[e]); hh[2 * e + 1] = bfhi(c[e]);
        xx[2 * e] = 0.5f * (bflo(pv[e]) + bflo(nx[e])) - hh[2 * e]; xx[2 * e + 1] = 0.5f * (bfhi(pv[e]) + bfhi(nx[e])) - hh[2 * e + 1];
      }
#pragma unroll
      for (int st = 0; st < 4; ++st) {
        const int mi = st == 0 ? 0 : st == 1 ? 2 : st == 2 ? 3 : 5;
        const float4 m0v = *(const float4*)(mu + mi * DM + c0), m1v = *(const float4*)(mu + mi * DM + c0 + 4);
        const float m[8] = {m0v.x, m0v.y, m0v.z, m0v.w, m1v.x, m1v.y, m1v.z, m1v.w};
        u32x4 o;
#pragma unroll
        for (int e = 0; e < 4; ++e) o[e] = cvtpk(hh[2 * e] + m[2 * e] * xx[2 * e], hh[2 * e + 1] + m[2 * e + 1] * xx[2 * e + 1]);
        *(u32x4*)(out + (size_t)st * GT * DM + (size_t)tok * DM + c0) = o;
      }
    }
  }
}

#define GSWZ(row, c16) ((row) * 128 + ((((c16) ^ ((row) >> 1)) & 7) << 4))
constexpr int LOAD_PLAIN = 0, LOAD_LERP = 1;
constexpr int EPI_RWKV = 0, EPI_RES = 1, EPI_MLAIN = 2, EPI_BF16 = 3;
struct GemmP {
  const u16* A; int lda; const u16* Bt; int K; int NT;
  const float* mu;
  int T;
  u16* o0; u16* o1; u16* o2; u16* o3; u16* o4; u16* o5;
  int ldc;
  float* of; const float* xin; float* xout; int dry;
  int nt0; size_t astride;
};

template <int LOAD, int EPI, int NI>
DEV void gemm_phase(const GemmP& g, char* lds) {
  constexpr int BN = 64 * NI, SBB = BN * 128;
  const int tid = ltid(), wid = __builtin_amdgcn_readfirstlane(tid >> 6), lane = tid & 63, r32 = lane & 31, hi = lane >> 5;
  const int wm = wid >> 1, wn = wid & 1;
  char* sA = lds; char* sB = lds + 65536;
  int Kv = g.K; asm volatile("" : "+s"(Kv));
  const int nk = Kv / 64, ntiles = 64 * g.NT;
  const int c16 = tid & 7, rowb = tid >> 3;
  for (int t = blockIdx.x; t < ntiles; t += gridDim.x) {
    const int mt = t & 63, nt = g.nt0 + (t >> 6), m0 = mt * 256, n0 = nt * BN;
    const u16* Ab = g.A + (size_t)(n0 >> 11) * g.astride;
    f32x16 acc[2][NI] = {};
    bf16x8 ra[4], rb[NI];
    const float* mup = nullptr;
    if constexpr (LOAD == LOAD_LERP) {
      const int s = n0 < 2048 ? 0 : n0 < 4096 ? 2 : n0 < 6144 ? 3 : n0 < 8192 ? 5 : n0 == 8192 ? 1 : 4;
      mup = g.mu + s * DM;
    }
    auto gload = [&](int kt) {
      const int k0 = kt * 64 + c16 * 8;
#pragma unroll
      for (int i = 0; i < 4; ++i) {
        const int row = rowb + i * 64; const size_t tok = (size_t)(m0 + row);
        if constexpr (LOAD == LOAD_PLAIN) {
          ra[i] = *(const bf16x8*)(Ab + tok * g.lda + k0);
        } else {
          const int pos = (int)(tok % (size_t)g.T);
          const u32x4 c = *(const u32x4*)(g.A + tok * DM + k0);
          u32x4 pv = {0u, 0u, 0u, 0u}, nx = {0u, 0u, 0u, 0u};
          if (pos > 0) pv = *(const u32x4*)(g.A + (tok - 1) * DM + k0);
          if (pos < g.T - 1) nx = *(const u32x4*)(g.A + (tok + 1) * DM + k0);
          const float4 m0v = *(const float4*)(mup + k0), m1v = *(const float4*)(mup + k0 + 4);
          const float mu[8] = {m0v.x, m0v.y, m0v.z, m0v.w, m1v.x, m1v.y, m1v.z, m1v.w};
          u32x4 o;
#pragma unroll
          for (int e = 0; e < 4; ++e) {
            const float h0 = bflo(c[e]), h1 = bfhi(c[e]);
            const float x0 = 0.5f * (bflo(pv[e]) + bflo(nx[e])) - h0, x1 = 0.5f * (bfhi(pv[e]) + bfhi(nx[e])) - h1;
            o[e] = cvtpk(h0 + mu[2 * e] * x0, h1 + mu[2 * e + 1] * x1);
          }
          ra[i] = *(bf16x8*)&o;
        }
      }
#pragma unroll
      for (int i = 0; i < NI; ++i) {
        const int row = rowb + i * 64;
        rb[i] = *(const bf16x8*)(g.Bt + (size_t)(n0 + row) * Kv + k0);
      }
    };
    auto swrite = [&](int b) {
#pragma unroll
      for (int i = 0; i < 4; ++i) { const int row = rowb + i * 64; *(bf16x8*)(sA + b * 32768 + GSWZ(row, c16)) = ra[i]; }
#pragma unroll
      for (int i = 0; i < NI; ++i) { const int row = rowb + i * 64; *(bf16x8*)(sB + b * SBB + GSWZ(row, c16)) = rb[i]; }
    };
    auto gdma = [&](int kt, int b) {
      const int cl = c16 ^ ((rowb >> 1) & 7);
#pragma unroll
      for (int i = 0; i < 4; ++i) {
        const u16* src = Ab + (size_t)(m0 + rowb + i * 64) * g.lda + kt * 64 + cl * 8;
        __builtin_amdgcn_global_load_lds((const __attribute__((address_space(1))) void*)src, (__attribute__((address_space(3))) void*)(sA + b * 32768 + (tid + i * 512) * 16), 16, 0, 0);
      }
#pragma unroll
      for (int i = 0; i < NI; ++i) {
        const u16* src = g.Bt + (size_t)(n0 + rowb + i * 64) * Kv + kt * 64 + cl * 8;
        __builtin_amdgcn_global_load_lds((const __attribute__((address_space(1))) void*)src, (__attribute__((address_space(3))) void*)(sB + b * SBB + (tid + i * 512) * 16), 16, 0, 0);
      }
    };
    if constexpr (LOAD == LOAD_PLAIN) { gdma(0, 0); asm volatile("s_waitcnt vmcnt(0)" ::: "memory"); __syncthreads(); }
    else { gload(0); swrite(0); __syncthreads(); }
    for (int kt = 0; kt < nk; ++kt) {
      const int b = kt & 1;
      if constexpr (LOAD == LOAD_PLAIN) { if (kt + 1 < nk) gdma(kt + 1, b ^ 1); }
      else { if (kt + 1 < nk) gload(kt + 1); }
      const char* a_ = sA + b * 32768; const char* b_ = sB + b * SBB;
#pragma unroll
      for (int ks = 0; ks < 4; ++ks) {
        bf16x8 af[2], bfr[NI];
#pragma unroll
        for (int mi = 0; mi < 2; ++mi) { const int row = wm * 64 + mi * 32 + r32; af[mi] = *(const bf16x8*)(a_ + GSWZ(row, ks * 2 + hi)); }
#pragma unroll
        for (int ni = 0; ni < NI; ++ni) { const int row = wn * (32 * NI) + ni * 32 + r32; bfr[ni] = *(const bf16x8*)(b_ + GSWZ(row, ks * 2 + hi)); }
#pragma unroll
        for (int mi = 0; mi < 2; ++mi)
#pragma unroll
          for (int ni = 0; ni < NI; ++ni) acc[mi][ni] = __builtin_amdgcn_mfma_f32_32x32x16_bf16(af[mi], bfr[ni], acc[mi][ni], 0, 0, 0);
      }
      if constexpr (LOAD == LOAD_PLAIN) asm volatile("s_waitcnt vmcnt(0)" ::: "memory");
      else { if (kt + 1 < nk) swrite(b ^ 1); }
      __syncthreads();
    }
    if (!g.dry)
#pragma unroll
    for (int mi = 0; mi < 2; ++mi)
#pragma unroll
      for (int ni = 0; ni < NI; ++ni)
#pragma unroll
        for (int r = 0; r < 16; ++r) {
          const size_t m = (size_t)(m0 + wm * 64 + mi * 32 + crow(r, hi));
          const int nl = wn * (32 * NI) + ni * 32 + r32, n = n0 + nl;
          const float v = acc[mi][ni][r];
          if constexpr (EPI == EPI_RWKV) {
            if (n0 < 8192) {
              const int which = n0 >> 11, col = n & 2047;
              u16* dst = which == 0 ? g.o0 : which == 1 ? g.o1 : which == 2 ? g.o2 : g.o3;
              dst[m * EI + col] = f2bf(which == 3 ? siluf(v) : v);
            } else if (n0 == 8192) g.o4[m * 128 + nl] = f2bf(tanhf(v));
            else g.o5[m * 128 + nl] = f2bf(v);
          } else if constexpr (EPI == EPI_RES) {
            g.xout[m * DM + n] = g.xin[m * DM + n] + v;
          } else if constexpr (EPI == EPI_MLAIN) {
            if (n < 704) g.of[m * 704 + n] = v;
            else if (n < ML_N) g.o0[m * EI + (n - 704)] = f2bf(siluf(v));
          } else {
            g.o0[m * g.ldc + n] = f2bf(v);
          }
        }
  }
}

struct ScanP {
  const u16 *r, *k, *v, *twl, *al; u16 *yf, *yb; float* bonus;
  const float *w0, *w2, *a0, *a2, *kk, *ka, *rk;
  int nseq, T;
  float* tbuf; int nseg;
};
template <int CTRL> DEV float dppf(float x) {
  return __int_as_float(__builtin_amdgcn_update_dpp(0, __float_as_int(x), CTRL, 0xF, 0xF, false));
}
DEV float row_prefix16(float x) {
  x += dppf<0x111>(x); x += dppf<0x112>(x); x += dppf<0x114>(x); x += dppf<0x118>(x); return x;
}
DEV float row_total16(float x) {
  x += dppf<0x128>(x); x += dppf<0x124>(x); x += dppf<0x122>(x); x += dppf<0x121>(x); return x;
}
DEV bf16x8 pack8(float a0, float a1, float a2, float a3, float a4, float a5, float a6, float a7) {
  u32x4 w = {cvtpk(a0, a1), cvtpk(a2, a3), cvtpk(a4, a5), cvtpk(a6, a7)}; return *(bf16x8*)&w;
}
constexpr int SC_BKT = 0, SC_UVT = 5120, SC_AKM = 10240, SC_RR = 10752, SC_ABF = 11776, SC_Z = 12800, SC_PRM = 17152, SC_T = 18944, SC_WAVE = 35328;
constexpr int SC_PRE = SC_UVT;
constexpr int SC_SHARED_AW = 4 * SC_WAVE;
constexpr int SC_NW = 4;
DEV void scan_phase(const ScanP& s, char* lds_, const int pass) {
  const int tid = ltid(), wid = __builtin_amdgcn_readfirstlane(tid >> 6), lane = tid & 63, c16 = lane & 15, q = lane >> 4;
  const int nchain = s.nseq * 64, nseg = s.nseg;
  const int ipc = pass == 0 ? nseg * 2 : nseg;
  const bool shared = nchain <= (int)gridDim.x;
  const int nsb = shared ? (int)gridDim.x / nchain : 1, sbi = shared ? (int)blockIdx.x / nchain : 0;
  const int nwv = shared ? SC_NW : 2;
  if (shared && sbi >= nsb) return;
  char* wl = lds_ + (wid & 3) * SC_WAVE;
  u16* bkt = (u16*)(wl + SC_BKT); u16* uvt = (u16*)(wl + SC_UVT); u16* akm = (u16*)(wl + SC_AKM); u16* rr = (u16*)(wl + SC_RR);
  float* abf = (float*)(wl + SC_ABF); float* zl = (float*)(wl + SC_Z); float* prm = (float*)(wl + SC_PRM); float* p15l = prm + 320;
  bf16x8* awl = (bf16x8*)(shared ? lds_ + SC_SHARED_AW : lds_ + (2 + (wid & 1)) * SC_WAVE); bf16x8* aal = awl + 512;
#define SCAN_LOAD_W(CHAIN, F0, F1) do { const int d_ = (CHAIN) & 1, h_ = ((CHAIN) >> 1) & 31; \
    for (int f = (F0); f < (F1); ++f) { const int ks = f >> 2, mt = f & 3; u32x4 pw, pa; \
      _Pragma("unroll") for (int e = 0; e < 4; ++e) { const int l0 = ks * 32 + q * 8 + 2 * e; \
        const size_t i0 = ((size_t)(d_ * 64 + l0)) * EI + h_ * 64 + mt * 16 + c16; \
        pw[e] = cvtpk(s.w2[i0], s.w2[i0 + EI]); pa[e] = cvtpk(s.a2[i0], s.a2[i0 + EI]); } \
      awl[f * 64 + lane] = *(bf16x8*)&pw; aal[f * 64 + lane] = *(bf16x8*)&pa; } } while (0)
  if (shared) {
    const int chain_b = (int)blockIdx.x % nchain;
    SCAN_LOAD_W(chain_b, wid, wid + 1);
    __syncthreads();
  }
  if (wid >= nwv) return;
  const int nrounds = shared ? (ipc + nsb * SC_NW - 1) / (nsb * SC_NW) : (nchain + 2 * (int)gridDim.x - 1) / (2 * (int)gridDim.x);
  for (int round = 0; round < nrounds; ++round) {
    const int chain = shared ? (int)blockIdx.x % nchain : (round * 2 + wid) * (int)gridDim.x + (int)blockIdx.x;
    const int it = shared ? sbi * SC_NW + wid + round * nsb * SC_NW : 0;
    if (chain >= nchain || it >= ipc) continue;
    const int kind = pass == 0 ? 1 + (it & 1) : 0;
    const int seg = pass == 0 ? it >> 1 : it;
    const int cs = chain * nseg + seg;
    const int d = chain & 1, h = (chain >> 1) & 31, b = chain >> 6;
    {
      const int ch = h * 64 + lane;
      lds_wait();
      prm[lane] = s.w0[d * EI + ch]; prm[64 + lane] = s.a0[d * EI + ch]; prm[128 + lane] = s.kk[ch]; prm[192 + lane] = s.ka[ch]; prm[256 + lane] = s.rk[ch];
      lds_wait();
    }
    if (!shared) { SCAN_LOAD_W(chain, 0, 8); lds_wait(); }
    const unsigned rowi = (unsigned)(d ? 15 - c16 : c16);
    const unsigned off_tw = rowi * 256u + (unsigned)(q * 16);
    const unsigned off_kr = rowi * 4096u + (unsigned)(h * 128 + q * 8);
    const unsigned off_v  = (unsigned)(h * 128 + lane * 2);
    const unsigned off_y0 = (unsigned)(d ? 15 - 4 * q : 4 * q) * 4096u + (unsigned)(h * 128 + c16 * 2);
    const int ystep = d ? -4096 : 4096;
    f32x4* Tl = (f32x4*)(wl + SC_T);
#pragma unroll
    for (int m = 0; m < 16; ++m) {
      f32x4 t0v = {0.f, 0.f, 0.f, 0.f};
      if (kind == 2) {
        const int mt = m >> 2, nt = m & 3;
        if (mt == nt) { t0v[0] = (4 * q + 0 == c16) ? 1.f : 0.f; t0v[1] = (4 * q + 1 == c16) ? 1.f : 0.f; t0v[2] = (4 * q + 2 == c16) ? 1.f : 0.f; t0v[3] = (4 * q + 3 == c16) ? 1.f : 0.f; }
      } else if (kind == 0 && nseg > 1) {
        t0v = *(const f32x4*)(s.tbuf + ((size_t)cs * 2) * 4096 + (m * 64 + lane) * 4);
      }
      Tl[m * 64 + lane] = t0v;
    }
    u16* yout = d ? s.yb : s.yf;
    const size_t sb = (size_t)b * s.T;
    const int cps = s.T / 16 / nseg, cbeg = seg * cps, cend = cbeg + cps;
    bf16x8 n_tw0, n_tw1, n_ta0, n_ta1; u32x2 n_k[4], n_r[4];
#define SCAN_LOAD(CC) do { const int c0n = d ? (s.T - 16 - (CC) * 16) : (CC) * 16; const size_t t0n = sb + c0n; \
      size_t p_tw = (size_t)s.twl + t0n * 256 + d * 128, p_al = (size_t)s.al + t0n * 256 + d * 128, p_k = (size_t)s.k + t0n * 4096, p_r = (size_t)s.r + t0n * 4096 ; \
      asm volatile("" : "+s"(p_tw), "+s"(p_al), "+s"(p_k), "+s"(p_r)); \
      n_tw0 = gld<bf16x8>(p_tw, off_tw); n_tw1 = gld<bf16x8>(p_tw, off_tw + 64); n_ta0 = gld<bf16x8>(p_al, off_tw); n_ta1 = gld<bf16x8>(p_al, off_tw + 64); \
      _Pragma("unroll") for (int mt = 0; mt < 4; ++mt) { n_k[mt] = gld<u32x2>(p_k, off_kr + mt * 32); n_r[mt] = gld<u32x2>(p_r, off_kr + mt * 32); } } while (0)
    SCAN_LOAD(cbeg);
    for (int cc = cbeg; cc < cend; ++cc) {
      const int c0 = d ? (s.T - 16 - cc * 16) : cc * 16;
      const size_t t0 = sb + c0;
      size_t b_y = (size_t)yout + t0 * 4096, b_bon = (size_t)s.bonus + t0 * 256 + (h * 2 + d) * 4;
      asm volatile("" : "+s"(b_y), "+s"(b_bon));
      size_t b_v = (size_t)s.v + t0 * 4096; asm volatile("" : "+s"(b_v));
      u32x2 n_v[4];
#pragma unroll
      for (int mt = 0; mt < 4; ++mt) n_v[mt] = gld<u32x2>(b_v, off_kr + mt * 32);
      {
        f32x4* wpl = (f32x4*)zl; f32x4* apl = (f32x4*)(wl + SC_PRE);
#pragma unroll
        for (int mt = 0; mt < 4; ++mt) {
          f32x4 cw = {0.f, 0.f, 0.f, 0.f}, ca = {0.f, 0.f, 0.f, 0.f};
          cw = __builtin_amdgcn_mfma_f32_16x16x32_bf16(awl[(0 * 4 + mt) * 64 + lane], n_tw0, cw, 0, 0, 0);
          cw = __builtin_amdgcn_mfma_f32_16x16x32_bf16(awl[(1 * 4 + mt) * 64 + lane], n_tw1, cw, 0, 0, 0);
          ca = __builtin_amdgcn_mfma_f32_16x16x32_bf16(aal[(0 * 4 + mt) * 64 + lane], n_ta0, ca, 0, 0, 0);
          ca = __builtin_amdgcn_mfma_f32_16x16x32_bf16(aal[(1 * 4 + mt) * 64 + lane], n_ta1, ca, 0, 0, 0);
          wpl[mt * 64 + lane] = cw; apl[mt * 64 + lane] = ca;
        }
      }
      float n2 = 0.f;
#pragma unroll
      for (int mt = 0; mt < 4; ++mt) {
        const float4 kkp = *(const float4*)(prm + 128 + mt * 16 + q * 4);
        const float t0 = bflo(n_k[mt][0]) * kkp.x, t1 = bfhi(n_k[mt][0]) * kkp.y, t2 = bflo(n_k[mt][1]) * kkp.z, t3 = bfhi(n_k[mt][1]) * kkp.w;
        n2 += t0 * t0 + t1 * t1 + t2 * t2 + t3 * t3;
      }
      n2 += __shfl_xor(n2, 16, 64); n2 += __shfl_xor(n2, 32, 64);
      const float invn = __builtin_amdgcn_rsqf(fmaxf(n2, 1e-24f));
      float bon = 0.f;
      bf16x8 ktf[2], btf[2], kdf[2], rtf[2];
#pragma unroll
      for (int ks = 0; ks < 2; ++ks) {
        float ktl[8], btl[8], kdl[8], rtl[8];
#pragma unroll
        for (int mh = 0; mh < 2; ++mh) {
          const int mt = 2 * ks + mh;
          const f32x4 cw = ((const f32x4*)zl)[mt * 64 + lane], ca = ((const f32x4*)(wl + SC_PRE))[mt * 64 + lane];
          const float4 w0p = *(const float4*)(prm + mt * 16 + q * 4), a0p = *(const float4*)(prm + 64 + mt * 16 + q * 4);
          const float4 kkp = *(const float4*)(prm + 128 + mt * 16 + q * 4), kap = *(const float4*)(prm + 192 + mt * 16 + q * 4), rkp = *(const float4*)(prm + 256 + mt * 16 + q * 4);
          const float w0a[4] = {w0p.x, w0p.y, w0p.z, w0p.w}, a0a[4] = {a0p.x, a0p.y, a0p.z, a0p.w};
          const float kka[4] = {kkp.x, kkp.y, kkp.z, kkp.w}, kaa[4] = {kap.x, kap.y, kap.z, kap.w}, rka[4] = {rkp.x, rkp.y, rkp.z, rkp.w};
          const u32x2 kr_ = n_k[mt], rr_ = n_r[mt];
          const float kxa[4] = {bflo(kr_[0]), bfhi(kr_[0]), bflo(kr_[1]), bfhi(kr_[1])};
          const float rxa[4] = {bflo(rr_[0]), bfhi(rr_[0]), bflo(rr_[1]), bfhi(rr_[1])};
          float4 p15v;
#pragma unroll
          for (int e = 0; e < 4; ++e) {
            const float wp = cw[e] + w0a[e], ap = ca[e] + a0a[e];
            const float ee = 0.6065306597126334f * __builtin_amdgcn_rcpf(1.f + __expf(-wp));
            const float a = __builtin_amdgcn_rcpf(1.f + __expf(-ap));
            const float kkn = kxa[e] * kka[e] * invn;
            const float kd = kxa[e] * (1.f + (a - 1.f) * kaa[e]);
            const float bb = kkn * a;
            bon += rxa[e] * kd * rka[e];
            const float Ei = row_prefix16(ee);
            const float pm = __expf(-Ei), pp = __builtin_amdgcn_rcpf(pm);
            const float pm1s = dppf<0x111>(pm), pm1 = c16 == 0 ? 1.f : pm1s;
            ktl[mh * 4 + e] = kkn * pm1; btl[mh * 4 + e] = bb * pp; kdl[mh * 4 + e] = kd * pp; rtl[mh * 4 + e] = rxa[e] * pm;
            ((float*)&p15v)[e] = pm;
          }
          if (c16 == 15) *(float4*)(p15l + mt * 16 + q * 4) = p15v;
          SBAR();
        }
        ktf[ks] = pack8(ktl[0], ktl[1], ktl[2], ktl[3], ktl[4], ktl[5], ktl[6], ktl[7]);
        btf[ks] = pack8(btl[0], btl[1], btl[2], btl[3], btl[4], btl[5], btl[6], btl[7]);
        kdf[ks] = pack8(kdl[0], kdl[1], kdl[2], kdl[3], kdl[4], kdl[5], kdl[6], kdl[7]);
        rtf[ks] = pack8(rtl[0], rtl[1], rtl[2], rtl[3], rtl[4], rtl[5], rtl[6], rtl[7]);
        {
          const u32x4 bw_ = *(const u32x4*)&btf[ks], kw_ = *(const u32x4*)&kdf[ks];
#pragma unroll
          for (int w = 0; w < 4; ++w) {
            const int j = (2 * ks + (w >> 1)) * 16 + q * 4 + (w & 1) * 2;
            bkt[j * 40 + c16] = (u16)(bw_[w] & 0xffffu); bkt[(j + 1) * 40 + c16] = (u16)(bw_[w] >> 16);
            bkt[j * 40 + 16 + c16] = (u16)(kw_[w] & 0xffffu); bkt[(j + 1) * 40 + 16 + c16] = (u16)(kw_[w] >> 16);
          }
        }
      }
      bon += __shfl_xor(bon, 16, 64); bon += __shfl_xor(bon, 32, 64);
      if (q == 0 && kind == 0) gst<float>(b_bon, off_tw, bon);
      SBAR();
      SBAR();
#pragma unroll
      for (int mt = 0; mt < 4; ++mt) {
        const int vb_ = (mt * 16 + q * 4) * 40 + 16 + c16;
        const unsigned v0_ = kind == 2 ? 0u : n_v[mt][0], v1_ = kind == 2 ? 0u : n_v[mt][1];
        uvt[vb_] = (u16)(v0_ & 0xffffu); uvt[vb_ + 40] = (u16)(v0_ >> 16);
        uvt[vb_ + 80] = (u16)(v1_ & 0xffffu); uvt[vb_ + 120] = (u16)(v1_ >> 16);
      }
      { const int cn = cc + 1 < cend ? cc + 1 : cc; SCAN_LOAD(cn); }
      SBAR();
      {
        f32x4 AB = {0.f, 0.f, 0.f, 0.f}, AK = AB, RB = AB, RK = AB;
        int qm = q; asm volatile("" : "+v"(qm));
#pragma unroll
        for (int ks = 0; ks < 2; ++ks) {
          AB = __builtin_amdgcn_mfma_f32_16x16x32_bf16(ktf[ks], btf[ks], AB, 0, 0, 0);
          AK = __builtin_amdgcn_mfma_f32_16x16x32_bf16(ktf[ks], kdf[ks], AK, 0, 0, 0);
          RB = __builtin_amdgcn_mfma_f32_16x16x32_bf16(rtf[ks], btf[ks], RB, 0, 0, 0);
          RK = __builtin_amdgcn_mfma_f32_16x16x32_bf16(rtf[ks], kdf[ks], RK, 0, 0, 0);
        }
#pragma unroll
        for (int r = 0; r < 4; ++r) {
          const int i = 4 * qm + r;
          const bool lo = c16 < i, le = c16 <= i;
          abf[i * 16 + c16] = lo ? AB[r] : 0.f;
          akm[i * 16 + c16] = f2bf(lo ? AK[r] : 0.f);
          rr[i * 32 + c16] = f2bf(le ? RB[r] : 0.f);
          rr[i * 32 + 16 + c16] = f2bf(le ? RK[r] : 0.f);
        }
      }
#define TFRAG(ks, nt, OUT) do { const f32x4 ta_ = Tl[((2 * (ks)) * 4 + (nt)) * 64 + lane], tb_ = Tl[((2 * (ks) + 1) * 4 + (nt)) * 64 + lane]; \
        OUT = pack8(ta_[0], ta_[1], ta_[2], ta_[3], tb_[0], tb_[1], tb_[2], tb_[3]); } while (0)
      lds_wait();
      {
        bf16x8 akf = {0, 0, 0, 0, 0, 0, 0, 0};
        if (q < 2) akf = *(const bf16x8*)(akm + c16 * 16 + q * 8);
#pragma unroll
        for (int nt = 0; nt < 4; ++nt) {
          f32x4 z = {0.f, 0.f, 0.f, 0.f};
          bf16x8 tf0, tf1; TFRAG(0, nt, tf0); TFRAG(1, nt, tf1);
          z = __builtin_amdgcn_mfma_f32_16x16x32_bf16(ktf[0], tf0, z, 0, 0, 0);
          z = __builtin_amdgcn_mfma_f32_16x16x32_bf16(ktf[1], tf1, z, 0, 0, 0);
          const bf16x8 vf = *(const bf16x8*)(uvt + (nt * 16 + c16) * 40 + 16 + (q & 1) * 8);
          z = __builtin_amdgcn_mfma_f32_16x16x32_bf16(akf, vf, z, 0, 0, 0);
#pragma unroll
          for (int r = 0; r < 4; ++r) zl[(4 * q + r) * 68 + nt * 16 + c16] = z[r];
        }
      }
      lds_wait();
      SBAR();
      {
        float U[16];
#pragma unroll
        for (int i = 0; i < 16; ++i) {
          float acc = -zl[i * 68 + lane];
#pragma unroll
          for (int s4 = 0; s4 < (i + 3) / 4; ++s4) {
            const float4 a4 = *(const float4*)(abf + i * 16 + s4 * 4);
            if (s4 * 4 + 0 < i) acc -= a4.x * U[s4 * 4 + 0];
            if (s4 * 4 + 1 < i) acc -= a4.y * U[s4 * 4 + 1];
            if (s4 * 4 + 2 < i) acc -= a4.z * U[s4 * 4 + 2];
            if (s4 * 4 + 3 < i) acc -= a4.w * U[s4 * 4 + 3];
          }
          U[i] = acc;
          if ((i & 3) == 3) SBAR();
        }
        *(bf16x8*)(uvt + lane * 40) = pack8(U[0], U[1], U[2], U[3], U[4], U[5], U[6], U[7]);
        *(bf16x8*)(uvt + lane * 40 + 8) = pack8(U[8], U[9], U[10], U[11], U[12], U[13], U[14], U[15]);
      }
      lds_wait();
      SBAR();
      {
        const bf16x8 rrf = *(const bf16x8*)(rr + c16 * 32 + q * 8);
        bf16x8 uvf[4];
#pragma unroll
        for (int nt = 0; nt < 4; ++nt) uvf[nt] = *(const bf16x8*)(uvt + (nt * 16 + c16) * 40 + q * 8);
#pragma unroll
        for (int nt = 0; nt < 4; ++nt) {
          f32x4 y = {0.f, 0.f, 0.f, 0.f};
          bf16x8 tf0, tf1; TFRAG(0, nt, tf0); TFRAG(1, nt, tf1);
          y = __builtin_amdgcn_mfma_f32_16x16x32_bf16(rtf[0], tf0, y, 0, 0, 0);
          y = __builtin_amdgcn_mfma_f32_16x16x32_bf16(rtf[1], tf1, y, 0, 0, 0);
          y = __builtin_amdgcn_mfma_f32_16x16x32_bf16(rrf, uvf[nt], y, 0, 0, 0);
#pragma unroll
          for (int r = 0; r < 4; ++r) { if (kind == 0) gst<u16>(b_y, off_y0 + (unsigned)(r * ystep) + nt * 32, f2bf(y[r])); }
        }
#pragma unroll
        for (int mt = 0; mt < 4; ++mt) {
          const bf16x8 bkf = *(const bf16x8*)(bkt + (mt * 16 + c16) * 40 + q * 8);
          const float4 pq = *(const float4*)(p15l + mt * 16 + q * 4);
#pragma unroll
          for (int nt = 0; nt < 4; ++nt) {
            f32x4 t = __builtin_amdgcn_mfma_f32_16x16x32_bf16(bkf, uvf[nt], Tl[(mt * 4 + nt) * 64 + lane], 0, 0, 0);
            t[0] *= pq.x; t[1] *= pq.y; t[2] *= pq.z; t[3] *= pq.w;
            Tl[(mt * 4 + nt) * 64 + lane] = t;
          }
        }
      }
      lds_wait();
    }
    if (pass == 0) {
      float* dst = s.tbuf + ((size_t)cs * 2 + (kind - 1)) * 4096;
#pragma unroll
      for (int m = 0; m < 16; ++m) *(f32x4*)(dst + (m * 64 + lane) * 4) = Tl[m * 64 + lane];
    }
  }
}

DEV void scan_combine_phase(const ScanP& s, char* lds_) {
  const int tid = ltid(), wid = __builtin_amdgcn_readfirstlane(tid >> 6), lane = tid & 63, c16 = lane & 15, q = lane >> 4;
  if (wid >= 2) return;
  float* til = (float*)(lds_ + wid * 16384);
  const int nchain = s.nseq * 64, nseg = s.nseg;
  for (int chain = wid * gridDim.x + blockIdx.x; chain < nchain; chain += 2 * gridDim.x) {
    f32x4 T[16];
#pragma unroll
    for (int m = 0; m < 16; ++m) T[m] = f32x4{0.f, 0.f, 0.f, 0.f};
    for (int seg = 0; seg < nseg; ++seg) {
      float* tn = s.tbuf + ((size_t)(chain * nseg + seg) * 2) * 4096; const float* ti = tn + 4096;
      lds_wait();
#pragma unroll
      for (int m = 0; m < 16; ++m) *(f32x4*)(til + (m * 64 + lane) * 4) = *(const f32x4*)(ti + (m * 64 + lane) * 4);
      lds_wait();
      f32x4 Tn[16];
#pragma unroll
      for (int m = 0; m < 16; ++m) Tn[m] = *(const f32x4*)(tn + (m * 64 + lane) * 4);
#pragma unroll
      for (int nt = 0; nt < 4; ++nt) {
        bf16x8 bh[2], bl[2];
#pragma unroll
        for (int ks = 0; ks < 2; ++ks) {
          const f32x4 ta = T[(2 * ks) * 4 + nt], tb = T[(2 * ks + 1) * 4 + nt];
          const float x[8] = {ta[0], ta[1], ta[2], ta[3], tb[0], tb[1], tb[2], tb[3]};
          float hf[8], lf[8];
#pragma unroll
          for (int e = 0; e < 8; ++e) { hf[e] = bf2f(f2bf(x[e])); lf[e] = x[e] - hf[e]; }
          bh[ks] = pack8(hf[0], hf[1], hf[2], hf[3], hf[4], hf[5], hf[6], hf[7]);
          bl[ks] = pack8(lf[0], lf[1], lf[2], lf[3], lf[4], lf[5], lf[6], lf[7]);
        }
#pragma unroll
        for (int mt = 0; mt < 4; ++mt) {
          f32x4 acc = Tn[mt * 4 + nt];
#pragma unroll
          for (int ks = 0; ks < 2; ++ks) {
            float x[8];
#pragma unroll
            for (int e = 0; e < 8; ++e) x[e] = til[((mt * 4 + 2 * ks + (e >> 2)) * 64 + ((c16 >> 2) & 3) * 16 + 4 * q + (e & 3)) * 4 + (c16 & 3)];
            float hf[8], lf[8];
#pragma unroll
            for (int e = 0; e < 8; ++e) { hf[e] = bf2f(f2bf(x[e])); lf[e] = x[e] - hf[e]; }
            const bf16x8 ah = pack8(hf[0], hf[1], hf[2], hf[3], hf[4], hf[5], hf[6], hf[7]);
            const bf16x8 al = pack8(lf[0], lf[1], lf[2], lf[3], lf[4], lf[5], lf[6], lf[7]);
            acc = __builtin_amdgcn_mfma_f32_16x16x32_bf16(ah, bh[ks], acc, 0, 0, 0);
            acc = __builtin_amdgcn_mfma_f32_16x16x32_bf16(ah, bl[ks], acc, 0, 0, 0);
            acc = __builtin_amdgcn_mfma_f32_16x16x32_bf16(al, bh[ks], acc, 0, 0, 0);
          }
          Tn[mt * 4 + nt] = acc;
        }
      }
#pragma unroll
      for (int m = 0; m < 16; ++m) { *(f32x4*)(tn + (m * 64 + lane) * 4) = T[m]; T[m] = Tn[m]; }
    }
  }
}

DEV void post_phase(u16* __restrict__ yf, const u16* __restrict__ yb, const u16* __restrict__ v, const u16* __restrict__ sg,
                    const float* __restrict__ bonus, const float* __restrict__ lg, const float* __restrict__ lb) {
  const int tid_ = ltid(); const int lane = tid_ & 63, wid = __builtin_amdgcn_readfirstlane(tid_ >> 6);
  for (int tok = blockIdx.x * 8 + wid; tok < GT; tok += gridDim.x * 8) {
#pragma unroll
    for (int it = 0; it < 4; ++it) {
      const int ch0 = it * 512 + lane * 8, h = ch0 >> 6; const size_t i = (size_t)tok * EI + ch0;
      const u32x4 a = *(const u32x4*)(yf + i), bq = *(const u32x4*)(yb + i), vv = *(const u32x4*)(v + i), gg = *(const u32x4*)(sg + i);
      const float2 bo = *(const float2*)(bonus + ((size_t)tok * 32 + h) * 2);
      float y[8]; float sum = 0.f;
#pragma unroll
      for (int e = 0; e < 4; ++e) { y[2 * e] = bflo(a[e]) + bflo(bq[e]); y[2 * e + 1] = bfhi(a[e]) + bfhi(bq[e]); sum += y[2 * e] + y[2 * e + 1]; }
      sum += __shfl_xor(sum, 1, 64); sum += __shfl_xor(sum, 2, 64); sum += __shfl_xor(sum, 4, 64);
      const float mean = sum * (1.f / 64.f);
      float var = 0.f;
#pragma unroll
      for (int e = 0; e < 8; ++e) { y[e] -= mean; var += y[e] * y[e]; }
      var += __shfl_xor(var, 1, 64); var += __shfl_xor(var, 2, 64); var += __shfl_xor(var, 4, 64);
      const float rs = rsqrtf(var * (1.f / 64.f) + 64e-5f), bon = bo.x + bo.y;
      const float4 g0 = *(const float4*)(lg + ch0), g1 = *(const float4*)(lg + ch0 + 4), b0 = *(const float4*)(lb + ch0), b1 = *(const float4*)(lb + ch0 + 4);
      const float ga[8] = {g0.x, g0.y, g0.z, g0.w, g1.x, g1.y, g1.z, g1.w}, ba[8] = {b0.x, b0.y, b0.z, b0.w, b1.x, b1.y, b1.z, b1.w};
      u32x4 o;
#pragma unroll
      for (int e = 0; e < 4; ++e) {
        const float o0 = (y[2 * e] * rs * ga[2 * e] + ba[2 * e] + bon * bflo(vv[e])) * bflo(gg[e]);
        const float o1 = (y[2 * e + 1] * rs * ga[2 * e + 1] + ba[2 * e + 1] + bon * bfhi(vv[e])) * bfhi(gg[e]);
        o[e] = cvtpk(o0, o1);
      }
      *(u32x4*)(yf + i) = o;
    }
  }
}

DEV void mla_mid_phase(const float* __restrict__ cqkv, const float* __restrict__ qn, const float* __restrict__ kvn,
                       const float* __restrict__ ct, const float* __restrict__ st,
                       u16* __restrict__ cqn, u16* __restrict__ ckvn, u16* __restrict__ kpe, int T) {
  const int tid_ = ltid(); const int lane = tid_ & 63, wid = __builtin_amdgcn_readfirstlane(tid_ >> 6);
  for (int tok = blockIdx.x * 8 + wid; tok < GT; tok += gridDim.x * 8) {
    const float* row = cqkv + (size_t)tok * 704;
    float q[6], ss = 0.f;
#pragma unroll
    for (int i = 0; i < 6; ++i) { q[i] = row[lane + i * 64]; ss += q[i] * q[i]; }
    ss = wsum(ss); float sc = rsqrtf(ss * (1.f / 384.f) + 1e-6f);
#pragma unroll
    for (int i = 0; i < 6; ++i) cqn[(size_t)tok * 384 + lane + i * 64] = f2bf(q[i] * sc * qn[lane + i * 64]);
    float c[4]; ss = 0.f;
#pragma unroll
    for (int i = 0; i < 4; ++i) { c[i] = row[384 + lane + i * 64]; ss += c[i] * c[i]; }
    ss = wsum(ss); sc = rsqrtf(ss * (1.f / 256.f) + 1e-6f);
#pragma unroll
    for (int i = 0; i < 4; ++i) ckvn[(size_t)tok * 256 + lane + i * 64] = f2bf(c[i] * sc * kvn[lane + i * 64]);
    const float x = row[640 + lane];
    const float xo = __shfl_xor(x, 32, 64);
    const int pos = tok % T, j = lane & 31;
    const float cs = ct[pos * 32 + j], sn = st[pos * 32 + j];
    const float o = lane < 32 ? x * cs - xo * sn : x * cs + xo * sn;
    kpe[(size_t)tok * 64 + lane] = f2bf(o);
  }
}

constexpr int SHM_V = 16384, SHM_K = 16384, SHM_KP = 8192;
#define KSWZ(row, colB) ((row) * 256 + ((colB) ^ (((row) & 7) << 4)))
#define KPSWZ(row, colB) ((row) * 128 + ((colB) ^ (((row) & 7) << 4)))
constexpr float ATT_SCALE = 0.07216878364870322f;
DEV void partialSM(f32x16& p0, f32x16& p1, float& m_reg, float& mn, float& alpha) {
  constexpr float C = ATT_SCALE * 1.4426950408889634f;
  float pmax = p0[0];
#pragma unroll
  for (int r = 1; r < 16; ++r) pmax = fmaxf(pmax, p0[r]);
#pragma unroll
  for (int r = 0; r < 16; ++r) pmax = fmaxf(pmax, p1[r]);
  { auto rr = __builtin_amdgcn_permlane32_swap(__float_as_uint(pmax), __float_as_uint(pmax), false, false);
    pmax = fmaxf(__uint_as_float(rr[0]), __uint_as_float(rr[1])); }
  if (__builtin_expect(__all(pmax - m_reg <= 8.f / ATT_SCALE), 1)) { mn = m_reg; alpha = 1.f; }
  else { mn = fmaxf(m_reg, pmax); alpha = __builtin_amdgcn_exp2f((m_reg - mn) * C); m_reg = mn; }
  const float mnC = -mn * C;
#pragma unroll
  for (int r = 0; r < 16; ++r) p0[r] = __builtin_amdgcn_exp2f(fmaf(p0[r], C, mnC));
#pragma unroll
  for (int r = 0; r < 16; ++r) p1[r] = __builtin_amdgcn_exp2f(fmaf(p1[r], C, mnC));
}
DEV void finishSM(f32x16& p0, f32x16& p1, float alpha, float& l_reg, bf16x8& pa0, bf16x8& pa1, bf16x8& pa2, bf16x8& pa3) {
  float ps = 0;
#pragma unroll
  for (int r = 0; r < 16; ++r) ps += p0[r];
#pragma unroll
  for (int r = 0; r < 16; ++r) ps += p1[r];
  { auto rr = __builtin_amdgcn_permlane32_swap(__float_as_uint(ps), __float_as_uint(ps), false, false);
    ps = __uint_as_float(rr[0]) + __uint_as_float(rr[1]); }
  l_reg = l_reg * alpha + ps;
#define PK4(PP, BASE, OUT) do { unsigned a0 = cvtpk(PP[BASE + 0], PP[BASE + 1]), a1 = cvtpk(PP[BASE + 2], PP[BASE + 3]);   \
    unsigned b0 = cvtpk(PP[BASE + 4], PP[BASE + 5]), b1 = cvtpk(PP[BASE + 6], PP[BASE + 7]);                              \
    auto r0 = __builtin_amdgcn_permlane32_swap(a0, b0, false, false); auto r1 = __builtin_amdgcn_permlane32_swap(a1, b1, false, false); \
    u32x4 w = {r0[0], r1[0], r0[1], r1[1]}; OUT = *reinterpret_cast<bf16x8*>(&w); } while (0)
  PK4(p0, 0, pa0); PK4(p0, 8, pa1); PK4(p1, 0, pa2); PK4(p1, 8, pa3);
#undef PK4
}
DEV int v_st(int k, int c) { const int kk = (k & ~0xC) | ((k & 4) << 1) | ((k & 8) >> 1); return ((kk >> 3) * 4 + (c >> 5)) * 512 + ((kk & 7) * 32 + (c & 31)) * 2; }
DEV int v_rd_base(int lane) { return ((lane & 3) << 3) | (((lane >> 2) & 3) << 6) | (((lane >> 4) & 1) << 5) | (((lane >> 5) & 1) << 8); }
constexpr int v_rd_off(int d0, int ks, int half) { return d0 * 512 + ks * 4096 + half * 2048; }
template <int OFF> DEV s16x4 tr_read(int vb) {
  s16x4 r; asm volatile("ds_read_b64_tr_b16 %0, %1 offset:%2" : "=&v"(r) : "v"(vb), "i"(OFF) : "memory"); return r;
}
template <int D0> DEV void pv_one(f32x16& od, int vb, bf16x8 pa0, bf16x8 pa1, bf16x8 pa2, bf16x8 pa3) {
  const s16x4 l0 = tr_read<v_rd_off(D0, 0, 0)>(vb), h0 = tr_read<v_rd_off(D0, 0, 1)>(vb), l1 = tr_read<v_rd_off(D0, 1, 0)>(vb), h1 = tr_read<v_rd_off(D0, 1, 1)>(vb);
  const s16x4 l2 = tr_read<v_rd_off(D0, 2, 0)>(vb), h2 = tr_read<v_rd_off(D0, 2, 1)>(vb), l3 = tr_read<v_rd_off(D0, 3, 0)>(vb), h3 = tr_read<v_rd_off(D0, 3, 1)>(vb);
  asm volatile("s_waitcnt lgkmcnt(0)" ::: "memory"); SBAR();
#define PK(L, H) (bf16x8){L[0], L[1], L[2], L[3], H[0], H[1], H[2], H[3]}
  od = __builtin_amdgcn_mfma_f32_32x32x16_bf16(pa0, PK(l0, h0), od, 0, 0, 0);
  od = __builtin_amdgcn_mfma_f32_32x32x16_bf16(pa1, PK(l1, h1), od, 0, 0, 0);
  od = __builtin_amdgcn_mfma_f32_32x32x16_bf16(pa2, PK(l2, h2), od, 0, 0, 0);
  od = __builtin_amdgcn_mfma_f32_32x32x16_bf16(pa3, PK(l3, h3), od, 0, 0, 0);
#undef PK
}

struct AttnP { const u16* q; const u16* kv; const u16* kpe; u16* sg; const float* ct; const float* st; int nseq, T; int dry; };
DEV void attn_phase(const AttnP& a, char* lds) {
  const int tid = ltid(), wid = __builtin_amdgcn_readfirstlane(tid >> 6), lane = tid & 63, r32 = lane & 31, hi = lane >> 5;
  char* V_lds = lds; char* K_lds = lds + 3 * SHM_V; char* KP_lds = lds + 3 * SHM_V + 2 * SHM_K;
  float* wsc = (float*)(lds + 3 * SHM_V + 2 * SHM_K + 2 * SHM_KP) + wid * 64; float* li_l = wsc; float* al_l = wsc + 32;
  const int nqb = a.T / 256, nitems = a.nseq * 16 * nqb, NT = a.T / 64;
  const int sr = tid >> 4, sc = (tid & 15) * 8, vst0 = v_st(sr, sc), vst1 = v_st(32 + sr, sc);
  const int pr = tid >> 3, pc = (tid & 7) * 8;
  const int vb0 = (int)(uintptr_t)V_lds + v_rd_base(lane);
  int kad[4], kpd[4];
#pragma unroll
  for (int q = 0; q < 4; ++q) { kad[q] = KSWZ(r32, q * 32 + hi * 16); kpd[q] = KPSWZ(r32, q * 32 + hi * 16); }
  const int vblk = (gridDim.x & 7) == 0 ? (int)(blockIdx.x & 7) * (int)(gridDim.x >> 3) + (int)(blockIdx.x >> 3) : (int)blockIdx.x;
  for (int it = vblk; it < nitems; it += gridDim.x) {
    const int qb = it % nqb, h = (it / nqb) & 15, b = it / (nqb * 16);
    const size_t sbase = (size_t)b * a.T;
    const int pos = qb * 256 + wid * 32 + r32;
    bf16x8 qr[12];
    {
      const u16* Qw = a.q + (sbase + pos) * 3072 + h * 192 + hi * 8;
#pragma unroll
      for (int d0 = 0; d0 < 12; ++d0) qr[d0] = *(const bf16x8*)(Qw + d0 * 16);
#pragma unroll
      for (int dd = 0; dd < 2; ++dd) {
        const int j0 = dd * 16 + hi * 8;
        const float4 c0 = *(const float4*)(a.ct + pos * 32 + j0), c1 = *(const float4*)(a.ct + pos * 32 + j0 + 4);
        const float4 s0 = *(const float4*)(a.st + pos * 32 + j0), s1 = *(const float4*)(a.st + pos * 32 + j0 + 4);
        const float cs[8] = {c0.x, c0.y, c0.z, c0.w, c1.x, c1.y, c1.z, c1.w};
        const float sn[8] = {s0.x, s0.y, s0.z, s0.w, s1.x, s1.y, s1.z, s1.w};
        u32x4 x1 = *(u32x4*)&qr[8 + dd], x2 = *(u32x4*)&qr[10 + dd], y1, y2;
#pragma unroll
        for (int e = 0; e < 4; ++e) {
          const float a0 = bflo(x1[e]), a1 = bfhi(x1[e]), b0 = bflo(x2[e]), b1 = bfhi(x2[e]);
          y1[e] = cvtpk(a0 * cs[2 * e] - b0 * sn[2 * e], a1 * cs[2 * e + 1] - b1 * sn[2 * e + 1]);
          y2[e] = cvtpk(b0 * cs[2 * e] + a0 * sn[2 * e], b1 * cs[2 * e + 1] + a1 * sn[2 * e + 1]);
        }
        qr[8 + dd] = *(bf16x8*)&y1; qr[10 + dd] = *(bf16x8*)&y2;
      }
    }
    float m_reg = -1e30f, l_reg = 0.f; f32x16 o[4] = {};
    bf16x8 vs0, vs1, ks0, ks1, kp0;
    const u16* kvh = a.kv + sbase * 4096 + h * 256;
    const u16* kph = a.kpe + sbase * 64;
    const unsigned voff = (unsigned)(sr * 8192 + sc * 2), poff = (unsigned)(pr * 128 + pc * 2);
#define SLOAD(k0) do { const char* bK0 = (const char*)kvh + (size_t)(k0) * 8192; const char* bK1 = bK0 + 32 * 8192; const char* bP = (const char*)kph + (size_t)(k0) * 128; \
    vs0 = *(const bf16x8*)(bK0 + voff + 256); vs1 = *(const bf16x8*)(bK1 + voff + 256); \
    ks0 = *(const bf16x8*)(bK0 + voff); ks1 = *(const bf16x8*)(bK1 + voff); \
    kp0 = *(const bf16x8*)(bP + poff); } while (0)
#define SWRITE(bb, vbuf) do { *(bf16x8*)(V_lds + (vbuf) * SHM_V + vst0) = vs0; *(bf16x8*)(V_lds + (vbuf) * SHM_V + vst1) = vs1; \
    *(bf16x8*)(K_lds + (bb) * SHM_K + KSWZ(sr, sc * 2)) = ks0; *(bf16x8*)(K_lds + (bb) * SHM_K + KSWZ(32 + sr, sc * 2)) = ks1; \
    *(bf16x8*)(KP_lds + (bb) * SHM_KP + KPSWZ(pr, pc * 2)) = kp0; } while (0)
    __syncthreads();
    SLOAD(0); SWRITE(0, 0); __syncthreads();
    const bool grpB = wid >= 4;
    bf16x8 pa0, pa1, pa2, pa3;
    int vcur = 0, vprev = 2;
#define PV_ALL(vbuf) do { const int vb_ = vb0 + (vbuf) * SHM_V; \
      pv_one<0>(o[0], vb_, pa0, pa1, pa2, pa3); pv_one<1>(o[1], vb_, pa0, pa1, pa2, pa3); \
      pv_one<2>(o[2], vb_, pa0, pa1, pa2, pa3); pv_one<3>(o[3], vb_, pa0, pa1, pa2, pa3); } while (0)
    for (int j = 0; j < NT; ++j) {
      const int bb = j & 1;
      if (j + 1 < NT) SLOAD((j + 1) * 64);
      SBAR();
      if (grpB && j > 0) PV_ALL(vprev);
      f32x16 p0 = {}, p1 = {};
      {
        const char* Ks = K_lds + bb * SHM_K; const char* Kp = KP_lds + bb * SHM_KP;
#pragma unroll
        for (int d0 = 0; d0 < 8; ++d0) {
          const bf16x8 b0 = *(const bf16x8*)(Ks + kad[d0 & 3] + (d0 >> 2) * 128), b1 = *(const bf16x8*)(Ks + kad[d0 & 3] + (d0 >> 2) * 128 + 8192);
          p0 = __builtin_amdgcn_mfma_f32_32x32x16_bf16(b0, qr[d0], p0, 0, 0, 0);
          p1 = __builtin_amdgcn_mfma_f32_32x32x16_bf16(b1, qr[d0], p1, 0, 0, 0); }
#pragma unroll
        for (int d0 = 0; d0 < 4; ++d0) {
          const bf16x8 b0 = *(const bf16x8*)(Kp + kpd[d0]), b1 = *(const bf16x8*)(Kp + kpd[d0] + 4096);
          p0 = __builtin_amdgcn_mfma_f32_32x32x16_bf16(b0, qr[8 + d0], p0, 0, 0, 0);
          p1 = __builtin_amdgcn_mfma_f32_32x32x16_bf16(b1, qr[8 + d0], p1, 0, 0, 0); }
      }
      float mn, alpha;
      partialSM(p0, p1, m_reg, mn, alpha);
      if (__any(alpha < 1.f)) {
        if (hi == 0) al_l[r32] = alpha;
        lds_wait();
#pragma unroll
        for (int dd = 0; dd < 4; ++dd)
#pragma unroll
          for (int r = 0; r < 16; ++r) o[dd][r] *= al_l[crow(r, hi)];
      }
      finishSM(p0, p1, alpha, l_reg, pa0, pa1, pa2, pa3); SBAR();
      if (!grpB) PV_ALL(vcur);
      const int vnext = vcur == 2 ? 0 : vcur + 1;
      if (j + 1 < NT) SWRITE(bb ^ 1, vnext);
      vprev = vcur; vcur = vnext;
      __syncthreads();
    }
    if (grpB) PV_ALL(vprev);
#undef PV_ALL
#undef SLOAD
#undef SWRITE
    {
      int t2 = threadIdx.x; asm volatile("" : "+v"(t2));
      const int wid2 = t2 >> 6, r2 = t2 & 31, hi2 = (t2 >> 5) & 1;
      float* li2 = (float*)(lds + 3 * SHM_V + 2 * SHM_K + 2 * SHM_KP) + wid2 * 64;
      if (hi2 == 0) li2[r2] = l_reg;
      lds_wait();
      u16* Ow = a.sg + (sbase + qb * 256 + wid2 * 32) * EI + h * 128 + r2;
#pragma unroll
      for (int r = 0; r < 16; ++r) {
        const int orow = crow(r, hi2);
        const float rl = __builtin_amdgcn_rcpf(li2[orow]);
#pragma unroll
        for (int d0 = 0; d0 < 4; ++d0) {
          u16* pp = Ow + (size_t)orow * EI + d0 * 32;
          if (!a.dry) *pp = f2bf(o[d0][r] * rl * bf2f(*pp));
        }
      }
    }
  }
}

#if MEGA
#define GRID_SYNC() gsync(p, lds)
#else
#define GRID_SYNC() do {} while (0)
#endif
struct Grp { const float* xin0; float* xres; int nseq, T; };
DEV Grp get_group(const P& p, int g) {
  Grp r;
  r.xin0 = g == 0 ? p.x_prompt : p.x_sample + (size_t)(g - 1) * GT * DM;
  r.xres = p.out + (size_t)g * GT * DM;
  r.nseq = g == 0 ? 8 : 1; r.T = g == 0 ? 2048 : 16384;
  return r;
}
template <int LT, int ph>
DEV void run_phase(const P& p, int g, int layer, char* lds) {
  const Grp G = get_group(p, g);
  const int j = layer >> 1;
  const float* xin = layer == 0 ? G.xin0 : G.xres;
  size_t zoff = 0; asm volatile("" : "+s"(zoff));
  char* ws = p.ws + zoff;
  u16* hbuf = (u16*)(ws + O_HBUF);
  u16* sg = (u16*)(ws + O_SG);
  if constexpr (LT == 0) {
    u16 *rb = (u16*)(ws + O_RB), *kb = (u16*)(ws + O_KB), *vb = (u16*)(ws + O_VB), *yf = (u16*)(ws + O_YF), *yb = (u16*)(ws + O_YB);
    u16 *twl = (u16*)(ws + O_TWL), *al = (u16*)(ws + O_AL); float* bon = (float*)(ws + O_BON);
    if constexpr (ph == 0) rms_phase(xin, p.ln_g + layer * DM, hbuf);
    else if constexpr (ph == 1) {
      GemmP q{}; q.A = hbuf; q.lda = DM; q.Bt = (const u16*)(ws + O_WRWIN) + (size_t)j * RW_N * DM; q.K = DM; q.NT = 66;
      q.mu = p.rw_mu + (size_t)j * 6 * DM; q.T = G.T; q.o0 = rb; q.o1 = kb; q.o2 = vb; q.o3 = sg; q.o4 = twl; q.o5 = al;
      lerp_phase(hbuf, q.mu, yf, G.T); GRID_SYNC();
      GemmP w = q; w.A = yf; w.astride = (size_t)GT * DM; w.NT = 32; w.nt0 = 0;
      gemm_phase<LOAD_PLAIN, EPI_RWKV, 4>(w, lds);
      q.NT = 2; q.nt0 = 64;
      gemm_phase<LOAD_LERP, EPI_RWKV, 2>(q, lds);
    } else if constexpr (ph == 2) {
      ScanP s{}; s.r = rb; s.k = kb; s.v = vb; s.twl = twl; s.al = al; s.yf = yf; s.yb = yb; s.bonus = bon;
      s.w0 = p.rw_w0 + (size_t)j * 2 * EI; s.w2 = p.rw_w2 + (size_t)j * 2 * 64 * EI; s.a0 = p.rw_a0 + (size_t)j * 2 * EI; s.a2 = p.rw_a2 + (size_t)j * 2 * 64 * EI;
      s.kk = p.rw_kk + (size_t)j * EI; s.ka = p.rw_ka + (size_t)j * EI; s.rk = p.rw_rk + (size_t)j * EI; s.nseq = G.nseq; s.T = G.T;
      s.tbuf = (float*)hbuf;
      if (G.T > 2048) {
        s.nseg = 16;
        scan_phase(s, lds, 0); GRID_SYNC();
        scan_combine_phase(s, lds); GRID_SYNC();
        scan_phase(s, lds, 1);
      } else { s.nseg = 1; scan_phase(s, lds, 1); }
    } else if constexpr (ph == 3) post_phase(yf, yb, vb, sg, bon, p.rw_lnx_g + (size_t)j * EI, p.rw_lnx_b + (size_t)j * EI);
    else {
      GemmP q{}; q.A = yf; q.lda = EI; q.Bt = (const u16*)(ws + O_WRWOUT) + (size_t)j * DM * EI; q.K = EI; q.NT = 4; q.xin = xin; q.xout = G.xres;
      for (int rep = 1; rep < REP_GEMM; ++rep) { q.dry = (gridDim.x != 12345); gemm_phase<LOAD_PLAIN, EPI_RES, 4>(q, lds); } q.dry = 0;
      gemm_phase<LOAD_PLAIN, EPI_RES, 4>(q, lds);
    }
  } else {
    float* cqkv = (float*)(ws + O_CQKV); u16 *cqn = (u16*)(ws + O_CQN), *ckvn = (u16*)(ws + O_CKVN), *kpe = (u16*)(ws + O_KPE), *qq = (u16*)(ws + O_Q), *kv = (u16*)(ws + O_KV);
    const float* ct = (const float*)(ws + O_COS); const float* st = (const float*)(ws + O_SIN);
    if constexpr (ph == 0) rms_phase(xin, p.ln_g + layer * DM, hbuf);
    else if constexpr (ph == 1) {
      GemmP q{}; q.A = hbuf; q.lda = DM; q.Bt = (const u16*)(ws + O_WMLIN) + (size_t)j * ML_NP * DM; q.K = DM; q.NT = 11; q.of = cqkv; q.o0 = sg;
      for (int rep = 1; rep < REP_GEMM; ++rep) { q.dry = (gridDim.x != 12345); gemm_phase<LOAD_PLAIN, EPI_MLAIN, 4>(q, lds); } q.dry = 0;
      gemm_phase<LOAD_PLAIN, EPI_MLAIN, 4>(q, lds);
    } else if constexpr (ph == 2) mla_mid_phase(cqkv, p.ml_qn + j * 384, p.ml_kvn + j * 256, ct, st, cqn, ckvn, kpe, G.T);
    else if constexpr (ph == 3) {
      GemmP q{}; q.A = cqn; q.lda = 384; q.Bt = (const u16*)(ws + O_WUQ) + (size_t)j * 3072 * 384; q.K = 384; q.NT = 12; q.o0 = qq; q.ldc = 3072;
      for (int rep = 1; rep < REP_GEMM; ++rep) { q.dry = (gridDim.x != 12345); gemm_phase<LOAD_PLAIN, EPI_BF16, 4>(q, lds); } q.dry = 0;
      gemm_phase<LOAD_PLAIN, EPI_BF16, 4>(q, lds);
      GemmP r{}; r.A = ckvn; r.lda = 256; r.Bt = (const u16*)(ws + O_WUKV) + (size_t)j * 4096 * 256; r.K = 256; r.NT = 16; r.o0 = kv; r.ldc = 4096;
      for (int rep = 1; rep < REP_GEMM; ++rep) { r.dry = (gridDim.x != 12345); gemm_phase<LOAD_PLAIN, EPI_BF16, 4>(r, lds); } r.dry = 0;
      gemm_phase<LOAD_PLAIN, EPI_BF16, 4>(r, lds);
    } else if constexpr (ph == 4) {
      AttnP a{}; a.q = qq; a.kv = kv; a.kpe = kpe; a.sg = sg; a.ct = ct; a.st = st; a.nseq = G.nseq; a.T = G.T;
      for (int rep = 1; rep < REP_ATTN; ++rep) { a.dry = (gridDim.x != 12345); attn_phase(a, lds); } a.dry = 0;
      attn_phase(a, lds);
    } else {
      GemmP q{}; q.A = sg; q.lda = EI; q.Bt = (const u16*)(ws + O_WMLOUT) + (size_t)j * DM * EI; q.K = EI; q.NT = 4; q.xin = xin; q.xout = G.xres;
      for (int rep = 1; rep < REP_GEMM; ++rep) { q.dry = (gridDim.x != 12345); gemm_phase<LOAD_PLAIN, EPI_RES, 4>(q, lds); } q.dry = 0;
      gemm_phase<LOAD_PLAIN, EPI_RES, 4>(q, lds);
    }
  }
}


template <int LT, int PH>
__global__ __launch_bounds__(512) void k_phase(P p, int g, int layer) {
  extern __shared__ __attribute__((aligned(16))) char lds[];
  if constexpr (LT == 2) { if constexpr (PH == 0) init_phase(p, lds); else final_phase(p.out, p.final_g); }
  else run_phase<LT, PH>(p, g, layer, lds);
}

#if MEGA
__global__ __launch_bounds__(512) void k_mega(P p) {
  extern __shared__ __attribute__((aligned(16))) char lds[];
  cg::grid_group grid = cg::this_grid();
  {
    unsigned* bar = (unsigned*)(p.ws + O_BAR);
    if (blockIdx.x == 0) for (int i = threadIdx.x; i < XCD_BAR_WORDS; i += 512) bar[i] = 0u;
    if (threadIdx.x == 0) { volatile LAS unsigned* st = (volatile LAS unsigned*)(lds + SHM_BYTES - 16); st[0] = 0u; st[1] = 0u; }
  }
  init_phase(p, lds);
  grid.sync();
  if (threadIdx.x == 0) (void)xb_add(&((unsigned*)(p.ws + O_BAR))[XB_XCNT(xb_xcc_id())], 1u);
  for (int g = 0; g < 3; ++g)
    for (int layer = 0; layer < 4; ++layer) {
      if ((layer & 1) == 0) {
        run_phase<0, 0>(p, g, layer, lds); gsync(p, lds); run_phase<0, 1>(p, g, layer, lds); gsync(p, lds); run_phase<0, 2>(p, g, layer, lds); gsync(p, lds);
        run_phase<0, 3>(p, g, layer, lds); gsync(p, lds); run_phase<0, 4>(p, g, layer, lds); gsync(p, lds);
      } else {
        run_phase<1, 0>(p, g, layer, lds); gsync(p, lds); run_phase<1, 1>(p, g, layer, lds); gsync(p, lds); run_phase<1, 2>(p, g, layer, lds); gsync(p, lds);
        run_phase<1, 3>(p, g, layer, lds); gsync(p, lds); run_phase<1, 4>(p, g, layer, lds); gsync(p, lds); run_phase<1, 5>(p, g, layer, lds); gsync(p, lds);
      }
    }
  final_phase(p.out, p.final_g);
}
#endif

extern "C" void kernel_launch(void* const* d_in, const int* in_sizes, int n_in, void* d_out, int out_size, void* d_ws, size_t ws_size, hipStream_t stream) {
  if (n_in != 22 || ws_size < WS_NEED) { fprintf(stderr, "kernel_launch: bad args n_in %d ws %zu need %zu\n", n_in, ws_size, WS_NEED); return; }
  P p{};
  const float** f = (const float**)&p;
  for (int i = 0; i < 22; ++i) f[i] = (const float*)d_in[i];
  p.out = (float*)d_out; p.ws = (char*)d_ws;
#if MEGA
  static int grid_blocks = 0;
  if (!grid_blocks) {
    hipFuncSetAttribute((const void*)k_mega, hipFuncAttributeMaxDynamicSharedMemorySize, SHM_BYTES);
    int dev = 0, cus = 0, per_cu = 0;
    hipGetDevice(&dev);
    hipDeviceGetAttribute(&cus, hipDeviceAttributeMultiprocessorCount, dev);
    hipOccupancyMaxActiveBlocksPerMultiprocessor(&per_cu, k_mega, 512, SHM_BYTES);
    if (per_cu > 1) per_cu = 1;
    grid_blocks = cus * per_cu;
  }
  void* args[] = {&p};
  hipError_t e = hipLaunchCooperativeKernel((void*)k_mega, dim3(grid_blocks), dim3(512), args, SHM_BYTES, stream);
  if (e != hipSuccess) fprintf(stderr, "cooperative launch failed: %s (grid %d)\n", hipGetErrorString(e), grid_blocks);
#else
  const int NB = 256;
#define LAUNCH(LT, PH, g, layer) do { static int inited = 0; if (!inited) { hipFuncSetAttribute((const void*)k_phase<LT, PH>, hipFuncAttributeMaxDynamicSharedMemorySize, SHM_BYTES); inited = 1; } \
    hipLaunchKernelGGL((k_phase<LT, PH>), dim3(NB), dim3(512), SHM_BYTES, stream, p, g, layer); } while (0)
  LAUNCH(2, 0, 0, 0);
  for (int g = 0; g < 3; ++g)
    for (int layer = 0; layer < 4; ++layer) {
      if ((layer & 1) == 0) { LAUNCH(0, 0, g, layer); LAUNCH(0, 1, g, layer); LAUNCH(0, 2, g, layer); LAUNCH(0, 3, g, layer); LAUNCH(0, 4, g, layer); }
      else { LAUNCH(1, 0, g, layer); LAUNCH(1, 1, g, layer); LAUNCH(1, 2, g, layer); LAUNCH(1, 3, g, layer); LAUNCH(1, 4, g, layer); LAUNCH(1, 5, g, layer); }
    }
  LAUNCH(2, 1, 0, 0);
#endif
}
```

```cpp
#include <hip/hip_runtime.h>
#include <hip/hip_bf16.h>
#include <hip/hip_cooperative_groups.h>
#include <cstdio>
namespace cg = cooperative_groups;

#ifndef REP_GEMM
#define REP_GEMM 1
#endif
#ifndef REP_ATTN
#define REP_ATTN 1
#endif
#ifndef REP_SCAN
#define REP_SCAN 1
#endif
#ifndef MEGA
#define MEGA 1
#endif

typedef unsigned short u16;
using bf16x8 = __attribute__((ext_vector_type(8))) short;
using s16x4  = __attribute__((ext_vector_type(4))) short;
using f32x16 = __attribute__((ext_vector_type(16))) float;
using f32x4  = __attribute__((ext_vector_type(4))) float;
using u32x4  = __attribute__((ext_vector_type(4))) unsigned;
using u32x2  = __attribute__((ext_vector_type(2))) unsigned;
#define DEV __device__ __forceinline__
#define SBAR() __builtin_amdgcn_sched_barrier(0)

constexpr int DM = 1024, EI = 2048, GT = 16384;
constexpr int NTOK = 49152;
constexpr int RW_N = 8448, ML_N = 2752, ML_NP = 2816;
constexpr int SHM_BYTES = 158720;

constexpr size_t alup(size_t x) { return (x + 255) / 256 * 256; }
constexpr size_t O_WRWIN  = 0;
constexpr size_t O_WRWOUT = O_WRWIN  + alup((size_t)2 * RW_N * DM * 2);
constexpr size_t O_WMLIN  = O_WRWOUT + alup((size_t)2 * DM * EI * 2);
constexpr size_t O_WUQ    = O_WMLIN  + alup((size_t)2 * ML_NP * DM * 2);
constexpr size_t O_WUKV   = O_WUQ    + alup((size_t)2 * 3072 * 384 * 2);
constexpr size_t O_WMLOUT = O_WUKV   + alup((size_t)2 * 4096 * 256 * 2);
constexpr size_t O_COS    = O_WMLOUT + alup((size_t)2 * DM * EI * 2);
constexpr size_t O_SIN    = O_COS    + alup((size_t)16384 * 32 * 4);
constexpr size_t O_HBUF   = O_SIN    + alup((size_t)16384 * 32 * 4);
constexpr size_t O_R0     = O_HBUF   + alup((size_t)GT * DM * 2);
constexpr size_t SZ_E = (size_t)GT * EI * 2;
constexpr size_t O_SG   = O_R0;
constexpr size_t O_RB   = O_SG + SZ_E;
constexpr size_t O_KB   = O_RB + SZ_E;
constexpr size_t O_VB   = O_KB + SZ_E;
constexpr size_t O_YF   = O_VB + SZ_E;
constexpr size_t O_YB   = O_YF + SZ_E;
constexpr size_t O_TWL  = O_YB + SZ_E;
constexpr size_t O_AL   = O_TWL + alup((size_t)GT * 128 * 2);
constexpr size_t O_BON  = O_AL  + alup((size_t)GT * 128 * 2);
constexpr size_t O_RW_END = O_BON + alup((size_t)GT * 64 * 4);
constexpr size_t O_CQKV = O_SG + SZ_E;
constexpr size_t O_CQN  = O_CQKV + alup((size_t)GT * 704 * 4);
constexpr size_t O_CKVN = O_CQN  + alup((size_t)GT * 384 * 2);
constexpr size_t O_KPE  = O_CKVN + alup((size_t)GT * 256 * 2);
constexpr size_t O_Q    = O_KPE  + alup((size_t)GT * 64 * 2);
constexpr size_t O_KV   = O_Q    + alup((size_t)GT * 3072 * 2);
constexpr size_t O_ML_END = O_KV + alup((size_t)GT * 4096 * 2);
constexpr size_t O_FLAG = O_RW_END > O_ML_END ? O_RW_END : O_ML_END;
constexpr size_t O_BAR = O_FLAG + 256;
constexpr size_t WS_NEED = O_BAR + 16384;

struct P {
  const float* x_prompt; const float* x_sample; const float* ln_g; const float* final_g;
  const float* rw_mu; const float* rw_in; const float* rw_w0; const float* rw_w2; const float* rw_a0; const float* rw_a2;
  const float* rw_kk; const float* rw_ka; const float* rw_rk; const float* rw_lnx_g; const float* rw_lnx_b; const float* rw_out;
  const float* ml_in; const float* ml_qn; const float* ml_kvn; const float* ml_uq; const float* ml_ukv; const float* ml_out;
  float* out; char* ws;
};

typedef __attribute__((ext_vector_type(2))) __bf16 bf16x2_t;
typedef __attribute__((ext_vector_type(2))) float f32x2_t;
DEV unsigned cvtpk(float lo, float hi) { f32x2_t v = {lo, hi}; bf16x2_t b = __builtin_convertvector(v, bf16x2_t); return __builtin_bit_cast(unsigned, b); }
DEV float bf2f(u16 x) { return __uint_as_float(((unsigned)x) << 16); }
DEV float bflo(unsigned x) { return __uint_as_float(x << 16); }
DEV float bfhi(unsigned x) { return __uint_as_float(x & 0xffff0000u); }
DEV u16 f2bf(float x) { __bf16 b = (__bf16)x; return __builtin_bit_cast(u16, b); }
DEV float wsum(float v) {
#pragma unroll
  for (int o = 32; o >= 1; o >>= 1) v += __shfl_xor(v, o, 64);
  return v;
}
DEV float siluf(float x) { return x / (1.f + __expf(-x)); }
DEV int crow(int r, int hi) { return (r & 3) + 8 * (r >> 2) + 4 * hi; }
DEV int ltid() { int t = threadIdx.x; asm volatile("" : "+v"(t)); return t; }
template <typename T> DEV T gld(size_t base, unsigned off) { return *(const __attribute__((address_space(1))) T*)(base + off); }
template <typename T> DEV void gst(size_t base, unsigned off, T v) { *(__attribute__((address_space(1))) T*)(base + off) = v; }
DEV void lds_wait() { asm volatile("s_waitcnt lgkmcnt(0)" ::: "memory"); }


#define XB_TMO      128
#define XB_XCNT(j)  (256  + 64 * (j))
#define XB_XSUB(j)  (1280 + 64 * (j))
#define XB_XGEN(j)  (2304 + 64 * (j))
#define XB_TOP      3328
#define XB_TOPGEN   3392
#define XCD_BAR_WORDS 3456
#define XB_SPIN_CAP (1u << 22)
#define LAS __attribute__((address_space(3)))
DEV unsigned xb_ld(unsigned* p)              { return __hip_atomic_load(p, __ATOMIC_RELAXED, __HIP_MEMORY_SCOPE_AGENT); }
DEV unsigned xb_add(unsigned* p, unsigned v) { return __hip_atomic_fetch_add(p, v, __ATOMIC_RELAXED, __HIP_MEMORY_SCOPE_AGENT); }
DEV unsigned xb_xcc_id() { return (unsigned)__builtin_amdgcn_s_getreg((3 << 11) | 20) & 0xFu; }
#define XB_SPIN(cond, bar) do { unsigned _sp = 0; while (cond) { __builtin_amdgcn_s_sleep(1); \
    if ((++_sp & 255u) == 0u) { if (xb_ld(&(bar)[XB_TMO])) break; if (_sp > XB_SPIN_CAP) { atomicAdd(&(bar)[XB_TMO], 1u); break; } } } } while (0)
struct XcdBarrier { unsigned* bar; unsigned x; volatile LAS unsigned* st; };
DEV void xcd_barrier_complete(unsigned* bar, unsigned x, unsigned& nloc, unsigned& nx) {
  const unsigned G = gridDim.x * gridDim.y * gridDim.z;
  unsigned sum, cnt, mine, sp = 0u;
  for (;;) {
    sum = 0u; cnt = 0u; mine = 0u;
#pragma unroll
    for (unsigned j = 0; j < 16; ++j) { const unsigned c = xb_ld(&bar[XB_XCNT(j)]); sum += c; cnt += (c > 0u) ? 1u : 0u; mine = (j == x) ? c : mine; }
    if (sum == G) break;
    __builtin_amdgcn_s_sleep(1);
    if ((++sp & 255u) == 0u) { if (xb_ld(&bar[XB_TMO])) break; if (sp > XB_SPIN_CAP) { atomicAdd(&bar[XB_TMO], 1u); break; } }
  }
  nloc = mine > 0u ? mine : 1u; nx = cnt > 0u ? cnt : 1u;
}
DEV void xcd_barrier(const XcdBarrier& b) {
  asm volatile("s_waitcnt vmcnt(0)" ::: "memory");
  __syncthreads();
  if (threadIdx.x == 0) {
    unsigned* bar = b.bar;
    __builtin_amdgcn_s_waitcnt(0);
    unsigned nloc = b.st[0], nx = b.st[1];
    if (nloc == 0u) { xcd_barrier_complete(bar, b.x, nloc, nx); b.st[0] = nloc; b.st[1] = nx; }
    const unsigned old = xb_add(&bar[XB_XSUB(b.x)], 1u);
    const unsigned gen = old / nloc;
    if (old + 1u == (gen + 1u) * nloc) {
      __builtin_amdgcn_fence(__ATOMIC_RELEASE, "agent");
      asm volatile("s_waitcnt vmcnt(0)" ::: "memory");
      const unsigned og = xb_add(&bar[XB_TOP], 1u);
      const unsigned tg = og / nx;
      if (og + 1u == (tg + 1u) * nx) xb_add(&bar[XB_TOPGEN], 1u);
      else XB_SPIN(xb_ld(&bar[XB_TOPGEN]) == tg, bar);
      __builtin_amdgcn_fence(__ATOMIC_ACQUIRE, "agent");
      xb_add(&bar[XB_XGEN(b.x)], 1u);
      asm volatile("s_waitcnt vmcnt(0)" ::: "memory");
    } else {
      XB_SPIN(xb_ld(&bar[XB_XGEN(b.x)]) == gen, bar);
      __builtin_amdgcn_fence(__ATOMIC_ACQUIRE, "agent");
      asm volatile("s_waitcnt vmcnt(0)" ::: "memory");
    }
  }
  __syncthreads();
}
DEV void gsync(const P& p, char* lds) {
  XcdBarrier b; b.bar = (unsigned*)(p.ws + O_BAR); b.x = xb_xcc_id(); b.st = (volatile LAS unsigned*)(lds + SHM_BYTES - 16);
  xcd_barrier(b);
}

DEV void convert_T(const float* __restrict__ src, u16* __restrict__ dst, int K, int N, int Npad, char* lds_) {
  float* lds = (float*)lds_;
  const int tid = ltid(), tk = K / 64, tn = Npad / 64;
  for (int t = blockIdx.x; t < tk * tn; t += gridDim.x) {
    const int k0 = (t % tk) * 64, n0 = (t / tk) * 64;
    __syncthreads();
#pragma unroll
    for (int i = 0; i < 2; ++i) {
      const int kr = (tid >> 4) + i * 32, c = (tid & 15) * 4;
      float4 v = make_float4(0.f, 0.f, 0.f, 0.f);
      if (n0 + c < N) v = *(const float4*)(src + (long)(k0 + kr) * N + n0 + c);
      lds[kr * 65 + c + 0] = v.x; lds[kr * 65 + c + 1] = v.y; lds[kr * 65 + c + 2] = v.z; lds[kr * 65 + c + 3] = v.w;
    }
    __syncthreads();
    const int n = tid >> 3, kc = (tid & 7) * 8;
    u32x4 w;
    w[0] = cvtpk(lds[(kc + 0) * 65 + n], lds[(kc + 1) * 65 + n]);
    w[1] = cvtpk(lds[(kc + 2) * 65 + n], lds[(kc + 3) * 65 + n]);
    w[2] = cvtpk(lds[(kc + 4) * 65 + n], lds[(kc + 5) * 65 + n]);
    w[3] = cvtpk(lds[(kc + 6) * 65 + n], lds[(kc + 7) * 65 + n]);
    *(u32x4*)(dst + (long)(n0 + n) * K + k0 + kc) = w;
  }
}

DEV void init_phase(const P& p, char* lds) {
  for (int j = 0; j < 2; ++j) {
    convert_T(p.rw_in  + (size_t)j * DM * RW_N, (u16*)(p.ws + O_WRWIN)  + (size_t)j * RW_N * DM, DM, RW_N, RW_N, lds);
    convert_T(p.rw_out + (size_t)j * EI * DM,   (u16*)(p.ws + O_WRWOUT) + (size_t)j * DM * EI,   EI, DM, DM, lds);
    convert_T(p.ml_in  + (size_t)j * DM * ML_N, (u16*)(p.ws + O_WMLIN)  + (size_t)j * ML_NP * DM, DM, ML_N, ML_NP, lds);
    convert_T(p.ml_uq  + (size_t)j * 384 * 3072, (u16*)(p.ws + O_WUQ)   + (size_t)j * 3072 * 384, 384, 3072, 3072, lds);
    convert_T(p.ml_ukv + (size_t)j * 256 * 4096, (u16*)(p.ws + O_WUKV)  + (size_t)j * 4096 * 256, 256, 4096, 4096, lds);
    convert_T(p.ml_out + (size_t)j * EI * DM,   (u16*)(p.ws + O_WMLOUT) + (size_t)j * DM * EI,   EI, DM, DM, lds);
  }
  float* ct = (float*)(p.ws + O_COS); float* st = (float*)(p.ws + O_SIN);
  const int tid_ = ltid();
  for (int i = blockIdx.x * 512 + tid_; i < 16384 * 32; i += gridDim.x * 512) {
    const int pos = i >> 5, j = i & 31;
    const float invf = 1.0f / powf(10000.0f, (float)(2 * j) / 64.0f);
    const float ang = (float)pos * invf;
    const double a = (double)ang;
    const double n = rint(a * 0.15915494309189535);
    const float r = (float)(a - n * 6.283185307179586);
    ct[i] = cosf(r); st[i] = sinf(r);
  }
}

DEV void rms_phase(const float* __restrict__ x, const float* __restrict__ g, u16* __restrict__ hout) {
  const int tid_ = ltid(); const int lane = tid_ & 63, wid = __builtin_amdgcn_readfirstlane(tid_ >> 6);
  for (int tok = blockIdx.x * 8 + wid; tok < GT; tok += gridDim.x * 8) {
    const float4* xr = (const float4*)(x + (size_t)tok * DM);
    float4 v[4]; float ss = 0.f;
#pragma unroll
    for (int i = 0; i < 4; ++i) { v[i] = xr[lane + i * 64]; ss += v[i].x * v[i].x + v[i].y * v[i].y + v[i].z * v[i].z + v[i].w * v[i].w; }
    ss = wsum(ss);
    const float sc = rsqrtf(ss * (1.f / DM) + 1e-6f);
#pragma unroll
    for (int i = 0; i < 4; ++i) {
      const float4 gg = ((const float4*)g)[lane + i * 64];
      u32x2 w; w[0] = cvtpk(v[i].x * sc * gg.x, v[i].y * sc * gg.y); w[1] = cvtpk(v[i].z * sc * gg.z, v[i].w * sc * gg.w);
      *(u32x2*)(hout + (size_t)tok * DM + (lane + i * 64) * 4) = w;
    }
  }
}

DEV void final_phase(float* __restrict__ x, const float* __restrict__ g) {
  const int tid_ = ltid(); const int lane = tid_ & 63, wid = __builtin_amdgcn_readfirstlane(tid_ >> 6);
  for (int tok = blockIdx.x * 8 + wid; tok < NTOK; tok += gridDim.x * 8) {
    float4* xr = (float4*)(x + (size_t)tok * DM);
    float4 v[4]; float ss = 0.f;
#pragma unroll
    for (int i = 0; i < 4; ++i) { v[i] = xr[lane + i * 64]; ss += v[i].x * v[i].x + v[i].y * v[i].y + v[i].z * v[i].z + v[i].w * v[i].w; }
    ss = wsum(ss);
    const float sc = rsqrtf(ss * (1.f / DM) + 1e-6f);
#pragma unroll
    for (int i = 0; i < 4; ++i) {
      const float4 gg = ((const float4*)g)[lane + i * 64];
      float4 ov = make_float4(v[i].x * sc * gg.x, v[i].y * sc * gg.y, v[i].z * sc * gg.z, v[i].w * sc * gg.w);
      xr[lane + i * 64] = ov;
    }
  }
}


DEV void lerp_phase(const u16* __restrict__ h, const float* __restrict__ mu, u16* __restrict__ out, int T) {
  const int tid_ = ltid(); const int lane = tid_ & 63, wid = __builtin_amdgcn_readfirstlane(tid_ >> 6);
  for (int tok = blockIdx.x * 8 + wid; tok < GT; tok += gridDim.x * 8) {
    const int pos = tok % T;
#pragma unroll
    for (int half = 0; half < 2; ++half) {
      const int c0 = half * 512 + lane * 8;
      const u32x4 c = *(const u32x4*)(h + (size_t)tok * DM + c0);
      u32x4 pv = {0u, 0u, 0u, 0u}, nx = {0u, 0u, 0u, 0u};
      if (pos > 0) pv = *(const u32x4*)(h + (size_t)(tok - 1) * DM + c0);
      if (pos < T - 1) nx = *(const u32x4*)(h + (size_t)(tok + 1) * DM + c0);
      float hh[8], xx[8];
#pragma unroll
      for (int e = 0; e < 4; ++e) {
        hh[2 * e] = bflo(c[e]); hh[2 * e + 1] = bfhi(c[e]);
        xx[2 * e] = 0.5f * (bflo(pv[e]) + bflo(nx[e])) - hh[2 * e]; xx[2 * e + 1] = 0.5f * (bfhi(pv[e]) + bfhi(nx[e])) - hh[2 * e + 1];
      }
#pragma unroll
      for (int st = 0; st < 4; ++st) {
        const int mi = st == 0 ? 0 : st == 1 ? 2 : st == 2 ? 3 : 5;
        const float4 m0v = *(const float4*)(mu + mi * DM + c0), m1v = *(const float4*)(mu + mi * DM + c0 + 4);
        const float m[8] = {m0v.x, m0v.y, m0v.z, m0v.w, m1v.x, m1v.y, m1v.z, m1v.w};
        u32x4 o;
#pragma unroll
        for (int e = 0; e < 4; ++e) o[e] = cvtpk(hh[2 * e] + m[2 * e] * xx[2 * e], hh[2 * e + 1] + m[2 * e + 1] * xx[2 * e + 1]);
        *(u32x4*)(out + (size_t)st * GT * DM + (size_t)tok * DM + c0) = o;
      }
    }
  }
}

#define GSWZ(row, c16) ((row) * 128 + ((((c16) ^ ((row) >> 1)) & 7) << 4))
constexpr int LOAD_PLAIN = 0, LOAD_LERP = 1;
constexpr int EPI_RWKV = 0, EPI_RES = 1, EPI_MLAIN = 2, EPI_BF16 = 3;
struct GemmP {
  const u16* A; int lda; const u16* Bt; int K; int NT;
  const float* mu;
  int T;
  u16* o0; u16* o1; u16* o2; u16* o3; u16* o4; u16* o5;
  int ldc;
  float* of; const float* xin; float* xout; int dry;
  int nt0; size_t astride;
};

template <int LOAD, int EPI, int NI>
DEV void gemm_phase(const GemmP& g, char* lds) {
  constexpr int BN = 64 * NI, SBB = BN * 128;
  const int tid = ltid(), wid = __builtin_amdgcn_readfirstlane(tid >> 6), lane = tid & 63, r32 = lane & 31, hi = lane >> 5;
  const int wm = wid >> 1, wn = wid & 1;
  char* sA = lds; char* sB = lds + 65536;
  int Kv = g.K; asm volatile("" : "+s"(Kv));
  const int nk = Kv / 64, ntiles = 64 * g.NT;
  const int c16 = tid & 7, rowb = tid >> 3;
  for (int t = blockIdx.x; t < ntiles; t += gridDim.x) {
    const int mt = t & 63, nt = g.nt0 + (t >> 6), m0 = mt * 256, n0 = nt * BN;
    const u16* Ab = g.A + (size_t)(n0 >> 11) * g.astride;
    f32x16 acc[2][NI] = {};
    bf16x8 ra[4], rb[NI];
    const float* mup = nullptr;
    if constexpr (LOAD == LOAD_LERP) {
      const int s = n0 < 2048 ? 0 : n0 < 4096 ? 2 : n0 < 6144 ? 3 : n0 < 8192 ? 5 : n0 == 8192 ? 1 : 4;
      mup = g.mu + s * DM;
    }
    auto gload = [&](int kt) {
      const int k0 = kt * 64 + c16 * 8;
#pragma unroll
      for (int i = 0; i < 4; ++i) {
        const int row = rowb + i * 64; const size_t tok = (size_t)(m0 + row);
        if constexpr (LOAD == LOAD_PLAIN) {
          ra[i] = *(const bf16x8*)(Ab + tok * g.lda + k0);
        } else {
          const int pos = (int)(tok % (size_t)g.T);
          const u32x4 c = *(const u32x4*)(g.A + tok * DM + k0);
          u32x4 pv = {0u, 0u, 0u, 0u}, nx = {0u, 0u, 0u, 0u};
          if (pos > 0) pv = *(const u32x4*)(g.A + (tok - 1) * DM + k0);
          if (pos < g.T - 1) nx = *(const u32x4*)(g.A + (tok + 1) * DM + k0);
          const float4 m0v = *(const float4*)(mup + k0), m1v = *(const float4*)(mup + k0 + 4);
          const float mu[8] = {m0v.x, m0v.y, m0v.z, m0v.w, m1v.x, m1v.y, m1v.z, m1v.w};
          u32x4 o;
#pragma unroll
          for (int e = 0; e < 4; ++e) {
            const float h0 = bflo(c[e]), h1 = bfhi(c[e]);
            const float x0 = 0.5f * (bflo(pv[e]) + bflo(nx[e])) - h0, x1 = 0.5f * (bfhi(pv[e]) + bfhi(nx[e])) - h1;
            o[e] = cvtpk(h0 + mu[2 * e] * x0, h1 + mu[2 * e + 1] * x1);
          }
          ra[i] = *(bf16x8*)&o;
        }
      }
#pragma unroll
      for (int i = 0; i < NI; ++i) {
        const int row = rowb + i * 64;
        rb[i] = *(const bf16x8*)(g.Bt + (size_t)(n0 + row) * Kv + k0);
      }
    };
    auto swrite = [&](int b) {
#pragma unroll
      for (int i = 0; i < 4; ++i) { const int row = rowb + i * 64; *(bf16x8*)(sA + b * 32768 + GSWZ(row, c16)) = ra[i]; }
#pragma unroll
      for (int i = 0; i < NI; ++i) { const int row = rowb + i * 64; *(bf16x8*)(sB + b * SBB + GSWZ(row, c16)) = rb[i]; }
    };
    auto gdma = [&](int kt, int b) {
      const int cl = c16 ^ ((rowb >> 1) & 7);
#pragma unroll
      for (int i = 0; i < 4; ++i) {
        const u16* src = Ab + (size_t)(m0 + rowb + i * 64) * g.lda + kt * 64 + cl * 8;
        __builtin_amdgcn_global_load_lds((const __attribute__((address_space(1))) void*)src, (__attribute__((address_space(3))) void*)(sA + b * 32768 + (tid + i * 512) * 16), 16, 0, 0);
      }
#pragma unroll
      for (int i = 0; i < NI; ++i) {
        const u16* src = g.Bt + (size_t)(n0 + rowb + i * 64) * Kv + kt * 64 + cl * 8;
        __builtin_amdgcn_global_load_lds((const __attribute__((address_space(1))) void*)src, (__attribute__((address_space(3))) void*)(sB + b * SBB + (tid + i * 512) * 16), 16, 0, 0);
      }
    };
    if constexpr (LOAD == LOAD_PLAIN) { gdma(0, 0); asm volatile("s_waitcnt vmcnt(0)" ::: "memory"); __syncthreads(); }
    else { gload(0); swrite(0); __syncthreads(); }
    for (int kt = 0; kt < nk; ++kt) {
      const int b = kt & 1;
      if constexpr (LOAD == LOAD_PLAIN) { if (kt + 1 < nk) gdma(kt + 1, b ^ 1); }
      else { if (kt + 1 < nk) gload(kt + 1); }
      const char* a_ = sA + b * 32768; const char* b_ = sB + b * SBB;
#pragma unroll
      for (int ks = 0; ks < 4; ++ks) {
        bf16x8 af[2], bfr[NI];
#pragma unroll
        for (int mi = 0; mi < 2; ++mi) { const int row = wm * 64 + mi * 32 + r32; af[mi] = *(const bf16x8*)(a_ + GSWZ(row, ks * 2 + hi)); }
#pragma unroll
        for (int ni = 0; ni < NI; ++ni) { const int row = wn * (32 * NI) + ni * 32 + r32; bfr[ni] = *(const bf16x8*)(b_ + GSWZ(row, ks * 2 + hi)); }
#pragma unroll
        for (int mi = 0; mi < 2; ++mi)
#pragma unroll
          for (int ni = 0; ni < NI; ++ni) acc[mi][ni] = __builtin_amdgcn_mfma_f32_32x32x16_bf16(af[mi], bfr[ni], acc[mi][ni], 0, 0, 0);
      }
      if constexpr (LOAD == LOAD_PLAIN) asm volatile("s_waitcnt vmcnt(0)" ::: "memory");
      else { if (kt + 1 < nk) swrite(b ^ 1); }
      __syncthreads();
    }
    if (!g.dry)
#pragma unroll
    for (int mi = 0; mi < 2; ++mi)
#pragma unroll
      for (int ni = 0; ni < NI; ++ni)
#pragma unroll
        for (int r = 0; r < 16; ++r) {
          const size_t m = (size_t)(m0 + wm * 64 + mi * 32 + crow(r, hi));
          const int nl = wn * (32 * NI) + ni * 32 + r32, n = n0 + nl;
          const float v = acc[mi][ni][r];
          if constexpr (EPI == EPI_RWKV) {
            if (n0 < 8192) {
              const int which = n0 >> 11, col = n & 2047;
              u16* dst = which == 0 ? g.o0 : which == 1 ? g.o1 : which == 2 ? g.o2 : g.o3;
              dst[m * EI + col] = f2bf(which == 3 ? siluf(v) : v);
            } else if (n0 == 8192) g.o4[m * 128 + nl] = f2bf(tanhf(v));
            else g.o5[m * 128 + nl] = f2bf(v);
          } else if constexpr (EPI == EPI_RES) {
            g.xout[m * DM + n] = g.xin[m * DM + n] + v;
          } else if constexpr (EPI == EPI_MLAIN) {
            if (n < 704) g.of[m * 704 + n] = v;
            else if (n < ML_N) g.o0[m * EI + (n - 704)] = f2bf(siluf(v));
          } else {
            g.o0[m * g.ldc + n] = f2bf(v);
          }
        }
  }
}

struct ScanP {
  const u16 *r, *k, *v, *twl, *al; u16 *yf, *yb; float* bonus;
  const float *w0, *w2, *a0, *a2, *kk, *ka, *rk;
  int nseq, T;
  float* tbuf; int nseg;
};
template <int CTRL> DEV float dppf(float x) {
  return __int_as_float(__builtin_amdgcn_update_dpp(0, __float_as_int(x), CTRL, 0xF, 0xF, false));
}
DEV float row_prefix16(float x) {
  x += dppf<0x111>(x); x += dppf<0x112>(x); x += dppf<0x114>(x); x += dppf<0x118>(x); return x;
}
DEV float row_total16(float x) {
  x += dppf<0x128>(x); x += dppf<0x124>(x); x += dppf<0x122>(x); x += dppf<0x121>(x); return x;
}
DEV bf16x8 pack8(float a0, float a1, float a2, float a3, float a4, float a5, float a6, float a7) {
  u32x4 w = {cvtpk(a0, a1), cvtpk(a2, a3), cvtpk(a4, a5), cvtpk(a6, a7)}; return *(bf16x8*)&w;
}
constexpr int SC_BKT = 0, SC_UVT = 5120, SC_AKM = 10240, SC_RR = 10752, SC_ABF = 11776, SC_Z = 12800, SC_PRM = 17152, SC_T = 18944, SC_WAVE = 35328;
constexpr int SC_PRE = SC_UVT;
constexpr int SC_SHARED_AW = 4 * SC_WAVE;
constexpr int SC_NW = 4;
DEV void scan_phase(const ScanP& s, char* lds_, const int pass) {
  const int tid = ltid(), wid = __builtin_amdgcn_readfirstlane(tid >> 6), lane = tid & 63, c16 = lane & 15, q = lane >> 4;
  const int nchain = s.nseq * 64, nseg = s.nseg;
  const int ipc = pass == 0 ? nseg * 2 : nseg;
  const bool shared = nchain <= (int)gridDim.x;
  const int nsb = shared ? (int)gridDim.x / nchain : 1, sbi = shared ? (int)blockIdx.x / nchain : 0;
  const int nwv = shared ? SC_NW : 2;
  if (shared && sbi >= nsb) return;
  char* wl = lds_ + (wid & 3) * SC_WAVE;
  u16* bkt = (u16*)(wl + SC_BKT); u16* uvt = (u16*)(wl + SC_UVT); u16* akm = (u16*)(wl + SC_AKM); u16* rr = (u16*)(wl + SC_RR);
  float* abf = (float*)(wl + SC_ABF); float* zl = (float*)(wl + SC_Z); float* prm = (float*)(wl + SC_PRM); float* p15l = prm + 320;
  bf16x8* awl = (bf16x8*)(shared ? lds_ + SC_SHARED_AW : lds_ + (2 + (wid & 1)) * SC_WAVE); bf16x8* aal = awl + 512;
#define SCAN_LOAD_W(CHAIN, F0, F1) do { const int d_ = (CHAIN) & 1, h_ = ((CHAIN) >> 1) & 31; \
    for (int f = (F0); f < (F1); ++f) { const int ks = f >> 2, mt = f & 3; u32x4 pw, pa; \
      _Pragma("unroll") for (int e = 0; e < 4; ++e) { const int l0 = ks * 32 + q * 8 + 2 * e; \
        const size_t i0 = ((size_t)(d_ * 64 + l0)) * EI + h_ * 64 + mt * 16 + c16; \
        pw[e] = cvtpk(s.w2[i0], s.w2[i0 + EI]); pa[e] = cvtpk(s.a2[i0], s.a2[i0 + EI]); } \
      awl[f * 64 + lane] = *(bf16x8*)&pw; aal[f * 64 + lane] = *(bf16x8*)&pa; } } while (0)
  if (shared) {
    const int chain_b = (int)blockIdx.x % nchain;
    SCAN_LOAD_W(chain_b, wid, wid + 1);
    __syncthreads();
  }
  if (wid >= nwv) return;
  const int nrounds = shared ? (ipc + nsb * SC_NW - 1) / (nsb * SC_NW) : (nchain + 2 * (int)gridDim.x - 1) / (2 * (int)gridDim.x);
  for (int round = 0; round < nrounds; ++round) {
    const int chain = shared ? (int)blockIdx.x % nchain : (round * 2 + wid) * (int)gridDim.x + (int)blockIdx.x;
    const int it = shared ? sbi * SC_NW + wid + round * nsb * SC_NW : 0;
    if (chain >= nchain || it >= ipc) continue;
    const int kind = pass == 0 ? 1 + (it & 1) : 0;
    const int seg = pass == 0 ? it >> 1 : it;
    const int cs = chain * nseg + seg;
    const int d = chain & 1, h = (chain >> 1) & 31, b = chain >> 6;
    {
      const int ch = h * 64 + lane;
      lds_wait();
      prm[lane] = s.w0[d * EI + ch]; prm[64 + lane] = s.a0[d * EI + ch]; prm[128 + lane] = s.kk[ch]; prm[192 + lane] = s.ka[ch]; prm[256 + lane] = s.rk[ch];
      lds_wait();
    }
    if (!shared) { SCAN_LOAD_W(chain, 0, 8); lds_wait(); }
    const unsigned rowi = (unsigned)(d ? 15 - c16 : c16);
    const unsigned off_tw = rowi * 256u + (unsigned)(q * 16);
    const unsigned off_kr = rowi * 4096u + (unsigned)(h * 128 + q * 8);
    const unsigned off_v  = (unsigned)(h * 128 + lane * 2);
    const unsigned off_y0 = (unsigned)(d ? 15 - 4 * q : 4 * q) * 4096u + (unsigned)(h * 128 + c16 * 2);
    const int ystep = d ? -4096 : 4096;
    f32x4* Tl = (f32x4*)(wl + SC_T);
#pragma unroll
    for (int m = 0; m < 16; ++m) {
      f32x4 t0v = {0.f, 0.f, 0.f, 0.f};
      if (kind == 2) {
        const int mt = m >> 2, nt = m & 3;
        if (mt == nt) { t0v[0] = (4 * q + 0 == c16) ? 1.f : 0.f; t0v[1] = (4 * q + 1 == c16) ? 1.f : 0.f; t0v[2] = (4 * q + 2 == c16) ? 1.f : 0.f; t0v[3] = (4 * q + 3 == c16) ? 1.f : 0.f; }
      } else if (kind == 0 && nseg > 1) {
        t0v = *(const f32x4*)(s.tbuf + ((size_t)cs * 2) * 4096 + (m * 64 + lane) * 4);
      }
      Tl[m * 64 + lane] = t0v;
    }
    u16* yout = d ? s.yb : s.yf;
    const size_t sb = (size_t)b * s.T;
    const int cps = s.T / 16 / nseg, cbeg = seg * cps, cend = cbeg + cps;
    bf16x8 n_tw0, n_tw1, n_ta0, n_ta1; u32x2 n_k[4], n_r[4];
#define SCAN_LOAD(CC) do { const int c0n = d ? (s.T - 16 - (CC) * 16) : (CC) * 16; const size_t t0n = sb + c0n; \
      size_t p_tw = (size_t)s.twl + t0n * 256 + d * 128, p_al = (size_t)s.al + t0n * 256 + d * 128, p_k = (size_t)s.k + t0n * 4096, p_r = (size_t)s.r + t0n * 4096 ; \
      asm volatile("" : "+s"(p_tw), "+s"(p_al), "+s"(p_k), "+s"(p_r)); \
      n_tw0 = gld<bf16x8>(p_tw, off_tw); n_tw1 = gld<bf16x8>(p_tw, off_tw + 64); n_ta0 = gld<bf16x8>(p_al, off_tw); n_ta1 = gld<bf16x8>(p_al, off_tw + 64); \
      _Pragma("unroll") for (int mt = 0; mt < 4; ++mt) { n_k[mt] = gld<u32x2>(p_k, off_kr + mt * 32); n_r[mt] = gld<u32x2>(p_r, off_kr + mt * 32); } } while (0)
    SCAN_LOAD(cbeg);
    for (int cc = cbeg; cc < cend; ++cc) {
      const int c0 = d ? (s.T - 16 - cc * 16) : cc * 16;
      const size_t t0 = sb + c0;
      size_t b_y = (size_t)yout + t0 * 4096, b_bon = (size_t)s.bonus + t0 * 256 + (h * 2 + d) * 4;
      asm volatile("" : "+s"(b_y), "+s"(b_bon));
      size_t b_v = (size_t)s.v + t0 * 4096; asm volatile("" : "+s"(b_v));
      u32x2 n_v[4];
#pragma unroll
      for (int mt = 0; mt < 4; ++mt) n_v[mt] = gld<u32x2>(b_v, off_kr + mt * 32);
      {
        f32x4* wpl = (f32x4*)zl; f32x4* apl = (f32x4*)(wl + SC_PRE);
#pragma unroll
        for (int mt = 0; mt < 4; ++mt) {
          f32x4 cw = {0.f, 0.f, 0.f, 0.f}, ca = {0.f, 0.f, 0.f, 0.f};
          cw = __builtin_amdgcn_mfma_f32_16x16x32_bf16(awl[(0 * 4 + mt) * 64 + lane], n_tw0, cw, 0, 0, 0);
          cw = __builtin_amdgcn_mfma_f32_16x16x32_bf16(awl[(1 * 4 + mt) * 64 + lane], n_tw1, cw, 0, 0, 0);
          ca = __builtin_amdgcn_mfma_f32_16x16x32_bf16(aal[(0 * 4 + mt) * 64 + lane], n_ta0, ca, 0, 0, 0);
          ca = __builtin_amdgcn_mfma_f32_16x16x32_bf16(aal[(1 * 4 + mt) * 64 + lane], n_ta1, ca, 0, 0, 0);
          wpl[mt * 64 + lane] = cw; apl[mt * 64 + lane] = ca;
        }
      }
      float n2 = 0.f;
#pragma unroll
      for (int mt = 0; mt < 4; ++mt) {
        const float4 kkp = *(const float4*)(prm + 128 + mt * 16 + q * 4);
        const float t0 = bflo(n_k[mt][0]) * kkp.x, t1 = bfhi(n_k[mt][0]) * kkp.y, t2 = bflo(n_k[mt][1]) * kkp.z, t3 = bfhi(n_k[mt][1]) * kkp.w;
        n2 += t0 * t0 + t1 * t1 + t2 * t2 + t3 * t3;
      }
      n2 += __shfl_xor(n2, 16, 64); n2 += __shfl_xor(n2, 32, 64);
      const float invn = __builtin_amdgcn_rsqf(fmaxf(n2, 1e-24f));
      float bon = 0.f;
      bf16x8 ktf[2], btf[2], kdf[2], rtf[2];
#pragma unroll
      for (int ks = 0; ks < 2; ++ks) {
        float ktl[8], btl[8], kdl[8], rtl[8];
#pragma unroll
        for (int mh = 0; mh < 2; ++mh) {
          const int mt = 2 * ks + mh;
          const f32x4 cw = ((const f32x4*)zl)[mt * 64 + lane], ca = ((const f32x4*)(wl + SC_PRE))[mt * 64 + lane];
          const float4 w0p = *(const float4*)(prm + mt * 16 + q * 4), a0p = *(const float4*)(prm + 64 + mt * 16 + q * 4);
          const float4 kkp = *(const float4*)(prm + 128 + mt * 16 + q * 4), kap = *(const float4*)(prm + 192 + mt * 16 + q * 4), rkp = *(const float4*)(prm + 256 + mt * 16 + q * 4);
          const float w0a[4] = {w0p.x, w0p.y, w0p.z, w0p.w}, a0a[4] = {a0p.x, a0p.y, a0p.z, a0p.w};
          const float kka[4] = {kkp.x, kkp.y, kkp.z, kkp.w}, kaa[4] = {kap.x, kap.y, kap.z, kap.w}, rka[4] = {rkp.x, rkp.y, rkp.z, rkp.w};
          const u32x2 kr_ = n_k[mt], rr_ = n_r[mt];
          const float kxa[4] = {bflo(kr_[0]), bfhi(kr_[0]), bflo(kr_[1]), bfhi(kr_[1])};
          const float rxa[4] = {bflo(rr_[0]), bfhi(rr_[0]), bflo(rr_[1]), bfhi(rr_[1])};
          float4 p15v;
#pragma unroll
          for (int e = 0; e < 4; ++e) {
            const float wp = cw[e] + w0a[e], ap = ca[e] + a0a[e];
            const float ee = 0.6065306597126334f * __builtin_amdgcn_rcpf(1.f + __expf(-wp));
            const float a = __builtin_amdgcn_rcpf(1.f + __expf(-ap));
            const float kkn = kxa[e] * kka[e] * invn;
            const float kd = kxa[e] * (1.f + (a - 1.f) * kaa[e]);
            const float bb = kkn * a;
            bon += rxa[e] * kd * rka[e];
            const float Ei = row_prefix16(ee);
            const float pm = __expf(-Ei), pp = __builtin_amdgcn_rcpf(pm);
            const float pm1s = dppf<0x111>(pm), pm1 = c16 == 0 ? 1.f : pm1s;
            ktl[mh * 4 + e] = kkn * pm1; btl[mh * 4 + e] = bb * pp; kdl[mh * 4 + e] = kd * pp; rtl[mh * 4 + e] = rxa[e] * pm;
            ((float*)&p15v)[e] = pm;
          }
          if (c16 == 15) *(float4*)(p15l + mt * 16 + q * 4) = p15v;
          SBAR();
        }
        ktf[ks] = pack8(ktl[0], ktl[1], ktl[2], ktl[3], ktl[4], ktl[5], ktl[6], ktl[7]);
        btf[ks] = pack8(btl[0], btl[1], btl[2], btl[3], btl[4], btl[5], btl[6], btl[7]);
        kdf[ks] = pack8(kdl[0], kdl[1], kdl[2], kdl[3], kdl[4], kdl[5], kdl[6], kdl[7]);
        rtf[ks] = pack8(rtl[0], rtl[1], rtl[2], rtl[3], rtl[4], rtl[5], rtl[6], rtl[7]);
        {
          const u32x4 bw_ = *(const u32x4*)&btf[ks], kw_ = *(const u32x4*)&kdf[ks];
#pragma unroll
          for (int w = 0; w < 4; ++w) {
            const int j = (2 * ks + (w >> 1)) * 16 + q * 4 + (w & 1) * 2;
            bkt[j * 40 + c16] = (u16)(bw_[w] & 0xffffu); bkt[(j + 1) * 40 + c16] = (u16)(bw_[w] >> 16);
            bkt[j * 40 + 16 + c16] = (u16)(kw_[w] & 0xffffu); bkt[(j + 1) * 40 + 16 + c16] = (u16)(kw_[w] >> 16);
          }
        }
      }
      bon += __shfl_xor(bon, 16, 64); bon += __shfl_xor(bon, 32, 64);
      if (q == 0 && kind == 0) gst<float>(b_bon, off_tw, bon);
      SBAR();
      SBAR();
#pragma unroll
      for (int mt = 0; mt < 4; ++mt) {
        const int vb_ = (mt * 16 + q * 4) * 40 + 16 + c16;
        const unsigned v0_ = kind == 2 ? 0u : n_v[mt][0], v1_ = kind == 2 ? 0u : n_v[mt][1];
        uvt[vb_] = (u16)(v0_ & 0xffffu); uvt[vb_ + 40] = (u16)(v0_ >> 16);
        uvt[vb_ + 80] = (u16)(v1_ & 0xffffu); uvt[vb_ + 120] = (u16)(v1_ >> 16);
      }
      { const int cn = cc + 1 < cend ? cc + 1 : cc; SCAN_LOAD(cn); }
      SBAR();
      {
        f32x4 AB = {0.f, 0.f, 0.f, 0.f}, AK = AB, RB = AB, RK = AB;
        int qm = q; asm volatile("" : "+v"(qm));
#pragma unroll
        for (int ks = 0; ks < 2; ++ks) {
          AB = __builtin_amdgcn_mfma_f32_16x16x32_bf16(ktf[ks], btf[ks], AB, 0, 0, 0);
          AK = __builtin_amdgcn_mfma_f32_16x16x32_bf16(ktf[ks], kdf[ks], AK, 0, 0, 0);
          RB = __builtin_amdgcn_mfma_f32_16x16x32_bf16(rtf[ks], btf[ks], RB, 0, 0, 0);
          RK = __builtin_amdgcn_mfma_f32_16x16x32_bf16(rtf[ks], kdf[ks], RK, 0, 0, 0);
        }
#pragma unroll
        for (int r = 0; r < 4; ++r) {
          const int i = 4 * qm + r;
          const bool lo = c16 < i, le = c16 <= i;
          abf[i * 16 + c16] = lo ? AB[r] : 0.f;
          akm[i * 16 + c16] = f2bf(lo ? AK[r] : 0.f);
          rr[i * 32 + c16] = f2bf(le ? RB[r] : 0.f);
          rr[i * 32 + 16 + c16] = f2bf(le ? RK[r] : 0.f);
        }
      }
#define TFRAG(ks, nt, OUT) do { const f32x4 ta_ = Tl[((2 * (ks)) * 4 + (nt)) * 64 + lane], tb_ = Tl[((2 * (ks) + 1) * 4 + (nt)) * 64 + lane]; \
        OUT = pack8(ta_[0], ta_[1], ta_[2], ta_[3], tb_[0], tb_[1], tb_[2], tb_[3]); } while (0)
      lds_wait();
      {
        bf16x8 akf = {0, 0, 0, 0, 0, 0, 0, 0};
        if (q < 2) akf = *(const bf16x8*)(akm + c16 * 16 + q * 8);
#pragma unroll
        for (int nt = 0; nt < 4; ++nt) {
          f32x4 z = {0.f, 0.f, 0.f, 0.f};
          bf16x8 tf0, tf1; TFRAG(0, nt, tf0); TFRAG(1, nt, tf1);
          z = __builtin_amdgcn_mfma_f32_16x16x32_bf16(ktf[0], tf0, z, 0, 0, 0);
          z = __builtin_amdgcn_mfma_f32_16x16x32_bf16(ktf[1], tf1, z, 0, 0, 0);
          const bf16x8 vf = *(const bf16x8*)(uvt + (nt * 16 + c16) * 40 + 16 + (q & 1) * 8);
          z = __builtin_amdgcn_mfma_f32_16x16x32_bf16(akf, vf, z, 0, 0, 0);
#pragma unroll
          for (int r = 0; r < 4; ++r) zl[(4 * q + r) * 68 + nt * 16 + c16] = z[r];
        }
      }
      lds_wait();
      SBAR();
      {
        float U[16];
#pragma unroll
        for (int i = 0; i < 16; ++i) {
          float acc = -zl[i * 68 + lane];
#pragma unroll
          for (int s4 = 0; s4 < (i + 3) / 4; ++s4) {
            const float4 a4 = *(const float4*)(abf + i * 16 + s4 * 4);
            if (s4 * 4 + 0 < i) acc -= a4.x * U[s4 * 4 + 0];
            if (s4 * 4 + 1 < i) acc -= a4.y * U[s4 * 4 + 1];
            if (s4 * 4 + 2 < i) acc -= a4.z * U[s4 * 4 + 2];
            if (s4 * 4 + 3 < i) acc -= a4.w * U[s4 * 4 + 3];
          }
          U[i] = acc;
          if ((i & 3) == 3) SBAR();
        }
        *(bf16x8*)(uvt + lane * 40) = pack8(U[0], U[1], U[2], U[3], U[4], U[5], U[6], U[7]);
        *(bf16x8*)(uvt + lane * 40 + 8) = pack8(U[8], U[9], U[10], U[11], U[12], U[13], U[14], U[15]);
      }
      lds_wait();
      SBAR();
      {
        const bf16x8 rrf = *(const bf16x8*)(rr + c16 * 32 + q * 8);
        bf16x8 uvf[4];
#pragma unroll
        for (int nt = 0; nt < 4; ++nt) uvf[nt] = *(const bf16x8*)(uvt + (nt * 16 + c16) * 40 + q * 8);
#pragma unroll
        for (int nt = 0; nt < 4; ++nt) {
          f32x4 y = {0.f, 0.f, 0.f, 0.f};
          bf16x8 tf0, tf1; TFRAG(0, nt, tf0); TFRAG(1, nt, tf1);
          y = __builtin_amdgcn_mfma_f32_16x16x32_bf16(rtf[0], tf0, y, 0, 0, 0);
          y = __builtin_amdgcn_mfma_f32_16x16x32_bf16(rtf[1], tf1, y, 0, 0, 0);
          y = __builtin_amdgcn_mfma_f32_16x16x32_bf16(rrf, uvf[nt], y, 0, 0, 0);
#pragma unroll
          for (int r = 0; r < 4; ++r) { if (kind == 0) gst<u16>(b_y, off_y0 + (unsigned)(r * ystep) + nt * 32, f2bf(y[r])); }
        }
#pragma unroll
        for (int mt = 0; mt < 4; ++mt) {
          const bf16x8 bkf = *(const bf16x8*)(bkt + (mt * 16 + c16) * 40 + q * 8);
          const float4 pq = *(const float4*)(p15l + mt * 16 + q * 4);
#pragma unroll
          for (int nt = 0; nt < 4; ++nt) {
            f32x4 t = __builtin_amdgcn_mfma_f32_16x16x32_bf16(bkf, uvf[nt], Tl[(mt * 4 + nt) * 64 + lane], 0, 0, 0);
            t[0] *= pq.x; t[1] *= pq.y; t[2] *= pq.z; t[3] *= pq.w;
            Tl[(mt * 4 + nt) * 64 + lane] = t;
          }
        }
      }
      lds_wait();
    }
    if (pass == 0) {
      float* dst = s.tbuf + ((size_t)cs * 2 + (kind - 1)) * 4096;
#pragma unroll
      for (int m = 0; m < 16; ++m) *(f32x4*)(dst + (m * 64 + lane) * 4) = Tl[m * 64 + lane];
    }
  }
}

DEV void scan_combine_phase(const ScanP& s, char* lds_) {
  const int tid = ltid(), wid = __builtin_amdgcn_readfirstlane(tid >> 6), lane = tid & 63, c16 = lane & 15, q = lane >> 4;
  if (wid >= 2) return;
  float* til = (float*)(lds_ + wid * 16384);
  const int nchain = s.nseq * 64, nseg = s.nseg;
  for (int chain = wid * gridDim.x + blockIdx.x; chain < nchain; chain += 2 * gridDim.x) {
    f32x4 T[16];
#pragma unroll
    for (int m = 0; m < 16; ++m) T[m] = f32x4{0.f, 0.f, 0.f, 0.f};
    for (int seg = 0; seg < nseg; ++seg) {
      float* tn = s.tbuf + ((size_t)(chain * nseg + seg) * 2) * 4096; const float* ti = tn + 4096;
      lds_wait();
#pragma unroll
      for (int m = 0; m < 16; ++m) *(f32x4*)(til + (m * 64 + lane) * 4) = *(const f32x4*)(ti + (m * 64 + lane) * 4);
      lds_wait();
      f32x4 Tn[16];
#pragma unroll
      for (int m = 0; m < 16; ++m) Tn[m] = *(const f32x4*)(tn + (m * 64 + lane) * 4);
#pragma unroll
      for (int nt = 0; nt < 4; ++nt) {
        bf16x8 bh[2], bl[2];
#pragma unroll
        for (int ks = 0; ks < 2; ++ks) {
          const f32x4 ta = T[(2 * ks) * 4 + nt], tb = T[(2 * ks + 1) * 4 + nt];
          const float x[8] = {ta[0], ta[1], ta[2], ta[3], tb[0], tb[1], tb[2], tb[3]};
          float hf[8], lf[8];
#pragma unroll
          for (int e = 0; e < 8; ++e) { hf[e] = bf2f(f2bf(x[e])); lf[e] = x[e] - hf[e]; }
          bh[ks] = pack8(hf[0], hf[1], hf[2], hf[3], hf[4], hf[5], hf[6], hf[7]);
          bl[ks] = pack8(lf[0], lf[1], lf[2], lf[3], lf[4], lf[5], lf[6], lf[7]);
        }
#pragma unroll
        for (int mt = 0; mt < 4; ++mt) {
          f32x4 acc = Tn[mt * 4 + nt];
#pragma unroll
          for (int ks = 0; ks < 2; ++ks) {
            float x[8];
#pragma unroll
            for (int e = 0; e < 8; ++e) x[e] = til[((mt * 4 + 2 * ks + (e >> 2)) * 64 + ((c16 >> 2) & 3) * 16 + 4 * q + (e & 3)) * 4 + (c16 & 3)];
            float hf[8], lf[8];
#pragma unroll
            for (int e = 0; e < 8; ++e) { hf[e] = bf2f(f2bf(x[e])); lf[e] = x[e] - hf[e]; }
            const bf16x8 ah = pack8(hf[0], hf[1], hf[2], hf[3], hf[4], hf[5], hf[6], hf[7]);
            const bf16x8 al = pack8(lf[0], lf[1], lf[2], lf[3], lf[4], lf[5], lf[6], lf[7]);
            acc = __builtin_amdgcn_mfma_f32_16x16x32_bf16(ah, bh[ks], acc, 0, 0, 0);
            acc = __builtin_amdgcn_mfma_f32_16x16x32_bf16(ah, bl[ks], acc, 0, 0, 0);
            acc = __builtin_amdgcn_mfma_f32_16x16x32_bf16(al, bh[ks], acc, 0, 0, 0);
          }
          Tn[mt * 4 + nt] = acc;
        }
      }
#pragma unroll
      for (int m = 0; m < 16; ++m) { *(f32x4*)(tn + (m * 64 + lane) * 4) = T[m]; T[m] = Tn[m]; }
    }
  }
}

DEV void post_phase(u16* __restrict__ yf, const u16* __restrict__ yb, const u16* __restrict__ v, const u16* __restrict__ sg,
                    const float* __restrict__ bonus, const float* __restrict__ lg, const float* __restrict__ lb) {
  const int tid_ = ltid(); const int lane = tid_ & 63, wid = __builtin_amdgcn_readfirstlane(tid_ >> 6);
  for (int tok = blockIdx.x * 8 + wid; tok < GT; tok += gridDim.x * 8) {
#pragma unroll
    for (int it = 0; it < 4; ++it) {
      const int ch0 = it * 512 + lane * 8, h = ch0 >> 6; const size_t i = (size_t)tok * EI + ch0;
      const u32x4 a = *(const u32x4*)(yf + i), bq = *(const u32x4*)(yb + i), vv = *(const u32x4*)(v + i), gg = *(const u32x4*)(sg + i);
      const float2 bo = *(const float2*)(bonus + ((size_t)tok * 32 + h) * 2);
      float y[8]; float sum = 0.f;
#pragma unroll
      for (int e = 0; e < 4; ++e) { y[2 * e] = bflo(a[e]) + bflo(bq[e]); y[2 * e + 1] = bfhi(a[e]) + bfhi(bq[e]); sum += y[2 * e] + y[2 * e + 1]; }
      sum += __shfl_xor(sum, 1, 64); sum += __shfl_xor(sum, 2, 64); sum += __shfl_xor(sum, 4, 64);
      const float mean = sum * (1.f / 64.f);
      float var = 0.f;
#pragma unroll
      for (int e = 0; e < 8; ++e) { y[e] -= mean; var += y[e] * y[e]; }
      var += __shfl_xor(var, 1, 64); var += __shfl_xor(var, 2, 64); var += __shfl_xor(var, 4, 64);
      const float rs = rsqrtf(var * (1.f / 64.f) + 64e-5f), bon = bo.x + bo.y;
      const float4 g0 = *(const float4*)(lg + ch0), g1 = *(const float4*)(lg + ch0 + 4), b0 = *(const float4*)(lb + ch0), b1 = *(const float4*)(lb + ch0 + 4);
      const float ga[8] = {g0.x, g0.y, g0.z, g0.w, g1.x, g1.y, g1.z, g1.w}, ba[8] = {b0.x, b0.y, b0.z, b0.w, b1.x, b1.y, b1.z, b1.w};
      u32x4 o;
#pragma unroll
      for (int e = 0; e < 4; ++e) {
        const float o0 = (y[2 * e] * rs * ga[2 * e] + ba[2 * e] + bon * bflo(vv[e])) * bflo(gg[e]);
        const float o1 = (y[2 * e + 1] * rs * ga[2 * e + 1] + ba[2 * e + 1] + bon * bfhi(vv[e])) * bfhi(gg[e]);
        o[e] = cvtpk(o0, o1);
      }
      *(u32x4*)(yf + i) = o;
    }
  }
}

DEV void mla_mid_phase(const float* __restrict__ cqkv, const float* __restrict__ qn, const float* __restrict__ kvn,
                       const float* __restrict__ ct, const float* __restrict__ st,
                       u16* __restrict__ cqn, u16* __restrict__ ckvn, u16* __restrict__ kpe, int T) {
  const int tid_ = ltid(); const int lane = tid_ & 63, wid = __builtin_amdgcn_readfirstlane(tid_ >> 6);
  for (int tok = blockIdx.x * 8 + wid; tok < GT; tok += gridDim.x * 8) {
    const float* row = cqkv + (size_t)tok * 704;
    float q[6], ss = 0.f;
#pragma unroll
    for (int i = 0; i < 6; ++i) { q[i] = row[lane + i * 64]; ss += q[i] * q[i]; }
    ss = wsum(ss); float sc = rsqrtf(ss * (1.f / 384.f) + 1e-6f);
#pragma unroll
    for (int i = 0; i < 6; ++i) cqn[(size_t)tok * 384 + lane + i * 64] = f2bf(q[i] * sc * qn[lane + i * 64]);
    float c[4]; ss = 0.f;
#pragma unroll
    for (int i = 0; i < 4; ++i) { c[i] = row[384 + lane + i * 64]; ss += c[i] * c[i]; }
    ss = wsum(ss); sc = rsqrtf(ss * (1.f / 256.f) + 1e-6f);
#pragma unroll
    for (int i = 0; i < 4; ++i) ckvn[(size_t)tok * 256 + lane + i * 64] = f2bf(c[i] * sc * kvn[lane + i * 64]);
    const float x = row[640 + lane];
    const float xo = __shfl_xor(x, 32, 64);
    const int pos = tok % T, j = lane & 31;
    const float cs = ct[pos * 32 + j], sn = st[pos * 32 + j];
    const float o = lane < 32 ? x * cs - xo * sn : x * cs + xo * sn;
    kpe[(size_t)tok * 64 + lane] = f2bf(o);
  }
}

constexpr int SHM_V = 16384, SHM_K = 16384, SHM_KP = 8192;
#define KSWZ(row, colB) ((row) * 256 + ((colB) ^ (((row) & 7) << 4)))
#define KPSWZ(row, colB) ((row) * 128 + ((colB) ^ (((row) & 7) << 4)))
constexpr float ATT_SCALE = 0.07216878364870322f;
DEV void partialSM(f32x16& p0, f32x16& p1, float& m_reg, float& mn, float& alpha) {
  constexpr float C = ATT_SCALE * 1.4426950408889634f;
  float pmax = p0[0];
#pragma unroll
  for (int r = 1; r < 16; ++r) pmax = fmaxf(pmax, p0[r]);
#pragma unroll
  for (int r = 0; r < 16; ++r) pmax = fmaxf(pmax, p1[r]);
  { auto rr = __builtin_amdgcn_permlane32_swap(__float_as_uint(pmax), __float_as_uint(pmax), false, false);
    pmax = fmaxf(__uint_as_float(rr[0]), __uint_as_float(rr[1])); }
  if (__builtin_expect(__all(pmax - m_reg <= 8.f / ATT_SCALE), 1)) { mn = m_reg; alpha = 1.f; }
  else { mn = fmaxf(m_reg, pmax); alpha = __builtin_amdgcn_exp2f((m_reg - mn) * C); m_reg = mn; }
  const float mnC = -mn * C;
#pragma unroll
  for (int r = 0; r < 16; ++r) p0[r] = __builtin_amdgcn_exp2f(fmaf(p0[r], C, mnC));
#pragma unroll
  for (int r = 0; r < 16; ++r) p1[r] = __builtin_amdgcn_exp2f(fmaf(p1[r], C, mnC));
}
DEV void finishSM(f32x16& p0, f32x16& p1, float alpha, float& l_reg, bf16x8& pa0, bf16x8& pa1, bf16x8& pa2, bf16x8& pa3) {
  float ps = 0;
#pragma unroll
  for (int r = 0; r < 16; ++r) ps += p0[r];
#pragma unroll
  for (int r = 0; r < 16; ++r) ps += p1[r];
  { auto rr = __builtin_amdgcn_permlane32_swap(__float_as_uint(ps), __float_as_uint(ps), false, false);
    ps = __uint_as_float(rr[0]) + __uint_as_float(rr[1]); }
  l_reg = l_reg * alpha + ps;
#define PK4(PP, BASE, OUT) do { unsigned a0 = cvtpk(PP[BASE + 0], PP[BASE + 1]), a1 = cvtpk(PP[BASE + 2], PP[BASE + 3]);   \
    unsigned b0 = cvtpk(PP[BASE + 4], PP[BASE + 5]), b1 = cvtpk(PP[BASE + 6], PP[BASE + 7]);                              \
    auto r0 = __builtin_amdgcn_permlane32_swap(a0, b0, false, false); auto r1 = __builtin_amdgcn_permlane32_swap(a1, b1, false, false); \
    u32x4 w = {r0[0], r1[0], r0[1], r1[1]}; OUT = *reinterpret_cast<bf16x8*>(&w); } while (0)
  PK4(p0, 0, pa0); PK4(p0, 8, pa1); PK4(p1, 0, pa2); PK4(p1, 8, pa3);
#undef PK4
}
DEV int v_st(int k, int c) { const int kk = (k & ~0xC) | ((k & 4) << 1) | ((k & 8) >> 1); return ((kk >> 3) * 4 + (c >> 5)) * 512 + ((kk & 7) * 32 + (c & 31)) * 2; }
DEV int v_rd_base(int lane) { return ((lane & 3) << 3) | (((lane >> 2) & 3) << 6) | (((lane >> 4) & 1) << 5) | (((lane >> 5) & 1) << 8); }
constexpr int v_rd_off(int d0, int ks, int half) { return d0 * 512 + ks * 4096 + half * 2048; }
template <int OFF> DEV s16x4 tr_read(int vb) {
  s16x4 r; asm volatile("ds_read_b64_tr_b16 %0, %1 offset:%2" : "=&v"(r) : "v"(vb), "i"(OFF) : "memory"); return r;
}
template <int D0> DEV void pv_one(f32x16& od, int vb, bf16x8 pa0, bf16x8 pa1, bf16x8 pa2, bf16x8 pa3) {
  const s16x4 l0 = tr_read<v_rd_off(D0, 0, 0)>(vb), h0 = tr_read<v_rd_off(D0, 0, 1)>(vb), l1 = tr_read<v_rd_off(D0, 1, 0)>(vb), h1 = tr_read<v_rd_off(D0, 1, 1)>(vb);
  const s16x4 l2 = tr_read<v_rd_off(D0, 2, 0)>(vb), h2 = tr_read<v_rd_off(D0, 2, 1)>(vb), l3 = tr_read<v_rd_off(D0, 3, 0)>(vb), h3 = tr_read<v_rd_off(D0, 3, 1)>(vb);
  asm volatile("s_waitcnt lgkmcnt(0)" ::: "memory"); SBAR();
#define PK(L, H) (bf16x8){L[0], L[1], L[2], L[3], H[0], H[1], H[2], H[3]}
  od = __builtin_amdgcn_mfma_f32_32x32x16_bf16(pa0, PK(l0, h0), od, 0, 0, 0);
  od = __builtin_amdgcn_mfma_f32_32x32x16_bf16(pa1, PK(l1, h1), od, 0, 0, 0);
  od = __builtin_amdgcn_mfma_f32_32x32x16_bf16(pa2, PK(l2, h2), od, 0, 0, 0);
  od = __builtin_amdgcn_mfma_f32_32x32x16_bf16(pa3, PK(l3, h3), od, 0, 0, 0);
#undef PK
}

struct AttnP { const u16* q; const u16* kv; const u16* kpe; u16* sg; const float* ct; const float* st; int nseq, T; int dry; };
DEV void attn_phase(const AttnP& a, char* lds) {
  const int tid = ltid(), wid = __builtin_amdgcn_readfirstlane(tid >> 6), lane = tid & 63, r32 = lane & 31, hi = lane >> 5;
  char* V_lds = lds; char* K_lds = lds + 3 * SHM_V; char* KP_lds = lds + 3 * SHM_V + 2 * SHM_K;
  float* wsc = (float*)(lds + 3 * SHM_V + 2 * SHM_K + 2 * SHM_KP) + wid * 64; float* li_l = wsc; float* al_l = wsc + 32;
  const int nqb = a.T / 256, nitems = a.nseq * 16 * nqb, NT = a.T / 64;
  const int sr = tid >> 4, sc = (tid & 15) * 8, vst0 = v_st(sr, sc), vst1 = v_st(32 + sr, sc);
  const int pr = tid >> 3, pc = (tid & 7) * 8;
  const int vb0 = (int)(uintptr_t)V_lds + v_rd_base(lane);
  int kad[4], kpd[4];
#pragma unroll
  for (int q = 0; q < 4; ++q) { kad[q] = KSWZ(r32, q * 32 + hi * 16); kpd[q] = KPSWZ(r32, q * 32 + hi * 16); }
  const int vblk = (gridDim.x & 7) == 0 ? (int)(blockIdx.x & 7) * (int)(gridDim.x >> 3) + (int)(blockIdx.x >> 3) : (int)blockIdx.x;
  for (int it = vblk; it < nitems; it += gridDim.x) {
    const int qb = it % nqb, h = (it / nqb) & 15, b = it / (nqb * 16);
    const size_t sbase = (size_t)b * a.T;
    const int pos = qb * 256 + wid * 32 + r32;
    bf16x8 qr[12];
    {
      const u16* Qw = a.q + (sbase + pos) * 3072 + h * 192 + hi * 8;
#pragma unroll
      for (int d0 = 0; d0 < 12; ++d0) qr[d0] = *(const bf16x8*)(Qw + d0 * 16);
#pragma unroll
      for (int dd = 0; dd < 2; ++dd) {
        const int j0 = dd * 16 + hi * 8;
        const float4 c0 = *(const float4*)(a.ct + pos * 32 + j0), c1 = *(const float4*)(a.ct + pos * 32 + j0 + 4);
        const float4 s0 = *(const float4*)(a.st + pos * 32 + j0), s1 = *(const float4*)(a.st + pos * 32 + j0 + 4);
        const float cs[8] = {c0.x, c0.y, c0.z, c0.w, c1.x, c1.y, c1.z, c1.w};
        const float sn[8] = {s0.x, s0.y, s0.z, s0.w, s1.x, s1.y, s1.z, s1.w};
        u32x4 x1 = *(u32x4*)&qr[8 + dd], x2 = *(u32x4*)&qr[10 + dd], y1, y2;
#pragma unroll
        for (int e = 0; e < 4; ++e) {
          const float a0 = bflo(x1[e]), a1 = bfhi(x1[e]), b0 = bflo(x2[e]), b1 = bfhi(x2[e]);
          y1[e] = cvtpk(a0 * cs[2 * e] - b0 * sn[2 * e], a1 * cs[2 * e + 1] - b1 * sn[2 * e + 1]);
          y2[e] = cvtpk(b0 * cs[2 * e] + a0 * sn[2 * e], b1 * cs[2 * e + 1] + a1 * sn[2 * e + 1]);
        }
        qr[8 + dd] = *(bf16x8*)&y1; qr[10 + dd] = *(bf16x8*)&y2;
      }
    }
    float m_reg = -1e30f, l_reg = 0.f; f32x16 o[4] = {};
    const u16* kvh = a.kv + sbase * 4096 + h * 256;
    const u16* kph = a.kpe + sbase * 64;
    unsigned gv0, gv1, gk0, gk1, gp0;
    {
      auto vsrc = [&](int s_) { const int kk = ((s_ >> 7) << 3) | ((s_ >> 2) & 7); const int k = (kk & ~0xC) | ((kk & 4) << 1) | ((kk & 8) >> 1);
                                const int c = ((s_ >> 5) & 3) * 32 + (s_ & 3) * 8; return (unsigned)(k * 8192 + 256 + c * 2); };
      auto ksrc = [&](int s_) { const int k = s_ >> 4; const int c = (s_ & 15) ^ (k & 7); return (unsigned)(k * 8192 + c * 16); };
      gv0 = vsrc(tid); gv1 = vsrc(tid + 512); gk0 = ksrc(tid); gk1 = ksrc(tid + 512);
      const int kp_ = tid >> 3; gp0 = (unsigned)(kp_ * 128 + (((tid & 7) ^ (kp_ & 7)) * 16));
    }
#define GLDS(SRC, DST) __builtin_amdgcn_global_load_lds((const __attribute__((address_space(1))) void*)(SRC), (__attribute__((address_space(3))) void*)(DST), 16, 0, 0)
#define SDMA(k0, bb, vbuf) do { const char* bK = (const char*)kvh + (size_t)(k0) * 8192; const char* bP = (const char*)kph + (size_t)(k0) * 128; \
    GLDS(bK + gv0, V_lds + (vbuf) * SHM_V + tid * 16); GLDS(bK + gv1, V_lds + (vbuf) * SHM_V + (tid + 512) * 16); \
    GLDS(bK + gk0, K_lds + (bb) * SHM_K + tid * 16);   GLDS(bK + gk1, K_lds + (bb) * SHM_K + (tid + 512) * 16); \
    GLDS(bP + gp0, KP_lds + (bb) * SHM_KP + tid * 16); } while (0)
#define SDMA_WAIT() asm volatile("s_waitcnt vmcnt(0)" ::: "memory")
    __syncthreads();
    SDMA(0, 0, 0); SDMA_WAIT(); __syncthreads();
    const bool grpB = wid >= 4;
    bf16x8 pa0, pa1, pa2, pa3;
    int vcur = 0, vprev = 2;
#define PV_ALL(vbuf) do { const int vb_ = vb0 + (vbuf) * SHM_V; \
      pv_one<0>(o[0], vb_, pa0, pa1, pa2, pa3); pv_one<1>(o[1], vb_, pa0, pa1, pa2, pa3); \
      pv_one<2>(o[2], vb_, pa0, pa1, pa2, pa3); pv_one<3>(o[3], vb_, pa0, pa1, pa2, pa3); } while (0)
    for (int j = 0; j < NT; ++j) {
      const int bb = j & 1;
      const int vnext = vcur == 2 ? 0 : vcur + 1;
      if (j + 1 < NT) SDMA((j + 1) * 64, bb ^ 1, vnext);
      SBAR();
      if (grpB && j > 0) PV_ALL(vprev);
      f32x16 p0 = {}, p1 = {};
      {
        const char* Ks = K_lds + bb * SHM_K; const char* Kp = KP_lds + bb * SHM_KP;
#pragma unroll
        for (int d0 = 0; d0 < 8; ++d0) {
          const bf16x8 b0 = *(const bf16x8*)(Ks + kad[d0 & 3] + (d0 >> 2) * 128), b1 = *(const bf16x8*)(Ks + kad[d0 & 3] + (d0 >> 2) * 128 + 8192);
          p0 = __builtin_amdgcn_mfma_f32_32x32x16_bf16(b0, qr[d0], p0, 0, 0, 0);
          p1 = __builtin_amdgcn_mfma_f32_32x32x16_bf16(b1, qr[d0], p1, 0, 0, 0); }
#pragma unroll
        for (int d0 = 0; d0 < 4; ++d0) {
          const bf16x8 b0 = *(const bf16x8*)(Kp + kpd[d0]), b1 = *(const bf16x8*)(Kp + kpd[d0] + 4096);
          p0 = __builtin_amdgcn_mfma_f32_32x32x16_bf16(b0, qr[8 + d0], p0, 0, 0, 0);
          p1 = __builtin_amdgcn_mfma_f32_32x32x16_bf16(b1, qr[8 + d0], p1, 0, 0, 0); }
      }
      float mn, alpha;
      partialSM(p0, p1, m_reg, mn, alpha);
      if (__any(alpha < 1.f)) {
        if (hi == 0) al_l[r32] = alpha;
        lds_wait();
#pragma unroll
        for (int dd = 0; dd < 4; ++dd)
#pragma unroll
          for (int r = 0; r < 16; ++r) o[dd][r] *= al_l[crow(r, hi)];
      }
      finishSM(p0, p1, alpha, l_reg, pa0, pa1, pa2, pa3); SBAR();
      if (!grpB) PV_ALL(vcur);
      SDMA_WAIT();
      vprev = vcur; vcur = vnext;
      __syncthreads();
    }
    if (grpB) PV_ALL(vprev);
#undef PV_ALL
#undef SDMA
#undef SDMA_WAIT
#undef GLDS
    {
      int t2 = threadIdx.x; asm volatile("" : "+v"(t2));
      const int wid2 = t2 >> 6, r2 = t2 & 31, hi2 = (t2 >> 5) & 1;
      float* li2 = (float*)(lds + 3 * SHM_V + 2 * SHM_K + 2 * SHM_KP) + wid2 * 64;
      if (hi2 == 0) li2[r2] = l_reg;
      lds_wait();
      u16* Ow = a.sg + (sbase + qb * 256 + wid2 * 32) * EI + h * 128 + r2;
#pragma unroll
      for (int r = 0; r < 16; ++r) {
        const int orow = crow(r, hi2);
        const float rl = __builtin_amdgcn_rcpf(li2[orow]);
#pragma unroll
        for (int d0 = 0; d0 < 4; ++d0) {
          u16* pp = Ow + (size_t)orow * EI + d0 * 32;
          if (!a.dry) *pp = f2bf(o[d0][r] * rl * bf2f(*pp));
        }
      }
    }
  }
}

#if MEGA
#define GRID_SYNC() gsync(p, lds)
#else
#define GRID_SYNC() do {} while (0)
#endif
struct Grp { const float* xin0; float* xres; int nseq, T; };
DEV Grp get_group(const P& p, int g) {
  Grp r;
  r.xin0 = g == 0 ? p.x_prompt : p.x_sample + (size_t)(g - 1) * GT * DM;
  r.xres = p.out + (size_t)g * GT * DM;
  r.nseq = g == 0 ? 8 : 1; r.T = g == 0 ? 2048 : 16384;
  return r;
}
template <int LT, int ph>
DEV void run_phase(const P& p, int g, int layer, char* lds) {
  const Grp G = get_group(p, g);
  const int j = layer >> 1;
  const float* xin = layer == 0 ? G.xin0 : G.xres;
  size_t zoff = 0; asm volatile("" : "+s"(zoff));
  char* ws = p.ws + zoff;
  u16* hbuf = (u16*)(ws + O_HBUF);
  u16* sg = (u16*)(ws + O_SG);
  if constexpr (LT == 0) {
    u16 *rb = (u16*)(ws + O_RB), *kb = (u16*)(ws + O_KB), *vb = (u16*)(ws + O_VB), *yf = (u16*)(ws + O_YF), *yb = (u16*)(ws + O_YB);
    u16 *twl = (u16*)(ws + O_TWL), *al = (u16*)(ws + O_AL); float* bon = (float*)(ws + O_BON);
    if constexpr (ph == 0) rms_phase(xin, p.ln_g + layer * DM, hbuf);
    else if constexpr (ph == 1) {
      GemmP q{}; q.A = hbuf; q.lda = DM; q.Bt = (const u16*)(ws + O_WRWIN) + (size_t)j * RW_N * DM; q.K = DM; q.NT = 66;
      q.mu = p.rw_mu + (size_t)j * 6 * DM; q.T = G.T; q.o0 = rb; q.o1 = kb; q.o2 = vb; q.o3 = sg; q.o4 = twl; q.o5 = al;
      lerp_phase(hbuf, q.mu, yf, G.T); GRID_SYNC();
      GemmP w = q; w.A = yf; w.astride = (size_t)GT * DM; w.NT = 32; w.nt0 = 0;
      gemm_phase<LOAD_PLAIN, EPI_RWKV, 4>(w, lds);
      q.NT = 2; q.nt0 = 64;
      gemm_phase<LOAD_LERP, EPI_RWKV, 2>(q, lds);
    } else if constexpr (ph == 2) {
      ScanP s{}; s.r = rb; s.k = kb; s.v = vb; s.twl = twl; s.al = al; s.yf = yf; s.yb = yb; s.bonus = bon;
      s.w0 = p.rw_w0 + (size_t)j * 2 * EI; s.w2 = p.rw_w2 + (size_t)j * 2 * 64 * EI; s.a0 = p.rw_a0 + (size_t)j * 2 * EI; s.a2 = p.rw_a2 + (size_t)j * 2 * 64 * EI;
      s.kk = p.rw_kk + (size_t)j * EI; s.ka = p.rw_ka + (size_t)j * EI; s.rk = p.rw_rk + (size_t)j * EI; s.nseq = G.nseq; s.T = G.T;
      s.tbuf = (float*)hbuf;
      if (G.T > 2048) {
        s.nseg = 16;
        scan_phase(s, lds, 0); GRID_SYNC();
        scan_combine_phase(s, lds); GRID_SYNC();
        scan_phase(s, lds, 1);
      } else { s.nseg = 1; scan_phase(s, lds, 1); }
    } else if constexpr (ph == 3) post_phase(yf, yb, vb, sg, bon, p.rw_lnx_g + (size_t)j * EI, p.rw_lnx_b + (size_t)j * EI);
    else {
      GemmP q{}; q.A = yf; q.lda = EI; q.Bt = (const u16*)(ws + O_WRWOUT) + (size_t)j * DM * EI; q.K = EI; q.NT = 4; q.xin = xin; q.xout = G.xres;
      for (int rep = 1; rep < REP_GEMM; ++rep) { q.dry = (gridDim.x != 12345); gemm_phase<LOAD_PLAIN, EPI_RES, 4>(q, lds); } q.dry = 0;
      gemm_phase<LOAD_PLAIN, EPI_RES, 4>(q, lds);
    }
  } else {
    float* cqkv = (float*)(ws + O_CQKV); u16 *cqn = (u16*)(ws + O_CQN), *ckvn = (u16*)(ws + O_CKVN), *kpe = (u16*)(ws + O_KPE), *qq = (u16*)(ws + O_Q), *kv = (u16*)(ws + O_KV);
    const float* ct = (const float*)(ws + O_COS); const float* st = (const float*)(ws + O_SIN);
    if constexpr (ph == 0) rms_phase(xin, p.ln_g + layer * DM, hbuf);
    else if constexpr (ph == 1) {
      GemmP q{}; q.A = hbuf; q.lda = DM; q.Bt = (const u16*)(ws + O_WMLIN) + (size_t)j * ML_NP * DM; q.K = DM; q.NT = 11; q.of = cqkv; q.o0 = sg;
      for (int rep = 1; rep < REP_GEMM; ++rep) { q.dry = (gridDim.x != 12345); gemm_phase<LOAD_PLAIN, EPI_MLAIN, 4>(q, lds); } q.dry = 0;
      gemm_phase<LOAD_PLAIN, EPI_MLAIN, 4>(q, lds);
    } else if constexpr (ph == 2) mla_mid_phase(cqkv, p.ml_qn + j * 384, p.ml_kvn + j * 256, ct, st, cqn, ckvn, kpe, G.T);
    else if constexpr (ph == 3) {
      GemmP q{}; q.A = cqn; q.lda = 384; q.Bt = (const u16*)(ws + O_WUQ) + (size_t)j * 3072 * 384; q.K = 384; q.NT = 12; q.o0 = qq; q.ldc = 3072;
      for (int rep = 1; rep < REP_GEMM; ++rep) { q.dry = (gridDim.x != 12345); gemm_phase<LOAD_PLAIN, EPI_BF16, 4>(q, lds); } q.dry = 0;
      gemm_phase<LOAD_PLAIN, EPI_BF16, 4>(q, lds);
      GemmP r{}; r.A = ckvn; r.lda = 256; r.Bt = (const u16*)(ws + O_WUKV) + (size_t)j * 4096 * 256; r.K = 256; r.NT = 16; r.o0 = kv; r.ldc = 4096;
      for (int rep = 1; rep < REP_GEMM; ++rep) { r.dry = (gridDim.x != 12345); gemm_phase<LOAD_PLAIN, EPI_BF16, 4>(r, lds); } r.dry = 0;
      gemm_phase<LOAD_PLAIN, EPI_BF16, 4>(r, lds);
    } else if constexpr (ph == 4) {
      AttnP a{}; a.q = qq; a.kv = kv; a.kpe = kpe; a.sg = sg; a.ct = ct; a.st = st; a.nseq = G.nseq; a.T = G.T;
      for (int rep = 1; rep < REP_ATTN; ++rep) { a.dry = (gridDim.x != 12345); attn_phase(a, lds); } a.dry = 0;
      attn_phase(a, lds);
    } else {
      GemmP q{}; q.A = sg; q.lda = EI; q.Bt = (const u16*)(ws + O_WMLOUT) + (size_t)j * DM * EI; q.K = EI; q.NT = 4; q.xin = xin; q.xout = G.xres;
      for (int rep = 1; rep < REP_GEMM; ++rep) { q.dry = (gridDim.x != 12345); gemm_phase<LOAD_PLAIN, EPI_RES, 4>(q, lds); } q.dry = 0;
      gemm_phase<LOAD_PLAIN, EPI_RES, 4>(q, lds);
    }
  }
}


template <int LT, int PH>
__global__ __launch_bounds__(512) void k_phase(P p, int g, int layer) {
  extern __shared__ __attribute__((aligned(16))) char lds[];
  if constexpr (LT == 2) { if constexpr (PH == 0) init_phase(p, lds); else final_phase(p.out, p.final_g); }
  else run_phase<LT, PH>(p, g, layer, lds);
}

#if MEGA
__global__ __launch_bounds__(512) void k_mega(P p) {
  extern __shared__ __attribute__((aligned(16))) char lds[];
  cg::grid_group grid = cg::this_grid();
  {
    unsigned* bar = (unsigned*)(p.ws + O_BAR);
    if (blockIdx.x == 0) for (int i = threadIdx.x; i < XCD_BAR_WORDS; i += 512) bar[i] = 0u;
    if (threadIdx.x == 0) { volatile LAS unsigned* st = (volatile LAS unsigned*)(lds + SHM_BYTES - 16); st[0] = 0u; st[1] = 0u; }
  }
  init_phase(p, lds);
  grid.sync();
  if (threadIdx.x == 0) (void)xb_add(&((unsigned*)(p.ws + O_BAR))[XB_XCNT(xb_xcc_id())], 1u);
  for (int g = 0; g < 3; ++g)
    for (int layer = 0; layer < 4; ++layer) {
      if ((layer & 1) == 0) {
        run_phase<0, 0>(p, g, layer, lds); gsync(p, lds); run_phase<0, 1>(p, g, layer, lds); gsync(p, lds); run_phase<0, 2>(p, g, layer, lds); gsync(p, lds);
        run_phase<0, 3>(p, g, layer, lds); gsync(p, lds); run_phase<0, 4>(p, g, layer, lds); gsync(p, lds);
      } else {
        run_phase<1, 0>(p, g, layer, lds); gsync(p, lds); run_phase<1, 1>(p, g, layer, lds); gsync(p, lds); run_phase<1, 2>(p, g, layer, lds); gsync(p, lds);
        run_phase<1, 3>(p, g, layer, lds); gsync(p, lds); run_phase<1, 4>(p, g, layer, lds); gsync(p, lds); run_phase<1, 5>(p, g, layer, lds); gsync(p, lds);
      }
    }
  final_phase(p.out, p.final_g);
}
#endif

extern "C" void kernel_launch(void* const* d_in, const int* in_sizes, int n_in, void* d_out, int out_size, void* d_ws, size_t ws_size, hipStream_t stream) {
  if (n_in != 22 || ws_size < WS_NEED) { fprintf(stderr, "kernel_launch: bad args n_in %d ws %zu need %zu\n", n_in, ws_size, WS_NEED); return; }
  P p{};
  const float** f = (const float**)&p;
  for (int i = 0; i < 22; ++i) f[i] = (const float*)d_in[i];
  p.out = (float*)d_out; p.ws = (char*)d_ws;
#if MEGA
  static int grid_blocks = 0;
  if (!grid_blocks) {
    hipFuncSetAttribute((const void*)k_mega, hipFuncAttributeMaxDynamicSharedMemorySize, SHM_BYTES);
    int dev = 0, cus = 0, per_cu = 0;
    hipGetDevice(&dev);
    hipDeviceGetAttribute(&cus, hipDeviceAttributeMultiprocessorCount, dev);
    hipOccupancyMaxActiveBlocksPerMultiprocessor(&per_cu, k_mega, 512, SHM_BYTES);
    if (per_cu > 1) per_cu = 1;
    grid_blocks = cus * per_cu;
  }
  void* args[] = {&p};
  hipError_t e = hipLaunchCooperativeKernel((void*)k_mega, dim3(grid_blocks), dim3(512), args, SHM_BYTES, stream);
  if (e != hipSuccess) fprintf(stderr, "cooperative launch failed: %s (grid %d)\n", hipGetErrorString(e), grid_blocks);
#else
  const int NB = 256;
#define LAUNCH(LT, PH, g, layer) do { static int inited = 0; if (!inited) { hipFuncSetAttribute((const void*)k_phase<LT, PH>, hipFuncAttributeMaxDynamicSharedMemorySize, SHM_BYTES); inited = 1; } \
    hipLaunchKernelGGL((k_phase<LT, PH>), dim3(NB), dim3(512), SHM_BYTES, stream, p, g, layer); } while (0)
  LAUNCH(2, 0, 0, 0);
  for (int g = 0; g < 3; ++g)
    for (int layer = 0; layer < 4; ++layer) {
      if ((layer & 1) == 0) { LAUNCH(0, 0, g, layer); LAUNCH(0, 1, g, layer); LAUNCH(0, 2, g, layer); LAUNCH(0, 3, g, layer); LAUNCH(0, 4, g, layer); }
      else { LAUNCH(1, 0, g, layer); LAUNCH(1, 1, g, layer); LAUNCH(1, 2, g, layer); LAUNCH(1, 3, g, layer); LAUNCH(1, 4, g, layer); LAUNCH(1, 5, g, layer); }
    }
  LAUNCH(2, 1, 0, 0);
#endif
}
```

```cpp
#include <hip/hip_runtime.h>
#include <hip/hip_bf16.h>
#include <hip/hip_cooperative_groups.h>
#include <cstdio>
namespace cg = cooperative_groups;

#ifndef REP_GEMM
#define REP_GEMM 1
#endif
#ifndef REP_ATTN
#define REP_ATTN 1
#endif
#ifndef REP_SCAN
#define REP_SCAN 1
#endif
#ifndef MEGA
#define MEGA 1
#endif

typedef unsigned short u16;
using bf16x8 = __attribute__((ext_vector_type(8))) short;
using s16x4  = __attribute__((ext_vector_type(4))) short;
using f32x16 = __attribute__((ext_vector_type(16))) float;
using f32x4  = __attribute__((ext_vector_type(4))) float;
using u32x4  = __attribute__((ext_vector_type(4))) unsigned;
using u32x2  = __attribute__((ext_vector_type(2))) unsigned;
#define DEV __device__ __forceinline__
#define SBAR() __builtin_amdgcn_sched_barrier(0)

constexpr int DM = 1024, EI = 2048, GT = 16384;
constexpr int NTOK = 49152;
constexpr int RW_N = 8448, ML_N = 2752, ML_NP = 2816;
constexpr int SHM_BYTES = 158720;

constexpr size_t alup(size_t x) { return (x + 255) / 256 * 256; }
constexpr size_t O_WRWIN  = 0;
constexpr size_t O_WRWOUT = O_WRWIN  + alup((size_t)2 * RW_N * DM * 2);
constexpr size_t O_WMLIN  = O_WRWOUT + alup((size_t)2 * DM * EI * 2);
constexpr size_t O_WUQ    = O_WMLIN  + alup((size_t)2 * ML_NP * DM * 2);
constexpr size_t O_WUKV   = O_WUQ    + alup((size_t)2 * 3072 * 384 * 2);
constexpr size_t O_WMLOUT = O_WUKV   + alup((size_t)2 * 4096 * 256 * 2);
constexpr size_t O_COS    = O_WMLOUT + alup((size_t)2 * DM * EI * 2);
constexpr size_t O_SIN    = O_COS    + alup((size_t)16384 * 32 * 4);
constexpr size_t O_HBUF   = O_SIN    + alup((size_t)16384 * 32 * 4);
constexpr size_t O_R0     = O_HBUF   + alup((size_t)GT * DM * 2);
constexpr size_t SZ_E = (size_t)GT * EI * 2;
constexpr size_t O_SG   = O_R0;
constexpr size_t O_RB   = O_SG + SZ_E;
constexpr size_t O_KB   = O_RB + SZ_E;
constexpr size_t O_VB   = O_KB + SZ_E;
constexpr size_t O_YF   = O_VB + SZ_E;
constexpr size_t O_YB   = O_YF + SZ_E;
constexpr size_t O_TWL  = O_YB + SZ_E;
constexpr size_t O_AL   = O_TWL + alup((size_t)GT * 128 * 2);
constexpr size_t O_BON  = O_AL  + alup((size_t)GT * 128 * 2);
constexpr size_t O_RW_END = O_BON + alup((size_t)GT * 64 * 4);
constexpr size_t O_CQKV = O_SG + SZ_E;
constexpr size_t O_CQN  = O_CQKV + alup((size_t)GT * 704 * 4);
constexpr size_t O_CKVN = O_CQN  + alup((size_t)GT * 384 * 2);
constexpr size_t O_KPE  = O_CKVN + alup((size_t)GT * 256 * 2);
constexpr size_t O_Q    = O_KPE  + alup((size_t)GT * 64 * 2);
constexpr size_t O_KV   = O_Q    + alup((size_t)GT * 3072 * 2);
constexpr size_t O_ML_END = O_KV + alup((size_t)GT * 4096 * 2);
constexpr size_t O_FLAG = O_RW_END > O_ML_END ? O_RW_END : O_ML_END;
constexpr size_t O_BAR = O_FLAG + 256;
constexpr size_t WS_NEED = O_BAR + 16384;

struct P {
  const float* x_prompt; const float* x_sample; const float* ln_g; const float* final_g;
  const float* rw_mu; const float* rw_in; const float* rw_w0; const float* rw_w2; const float* rw_a0; const float* rw_a2;
  const float* rw_kk; const float* rw_ka; const float* rw_rk; const float* rw_lnx_g; const float* rw_lnx_b; const float* rw_out;
  const float* ml_in; const float* ml_qn; const float* ml_kvn; const float* ml_uq; const float* ml_ukv; const float* ml_out;
  float* out; char* ws;
};

typedef __attribute__((ext_vector_type(2))) __bf16 bf16x2_t;
typedef __attribute__((ext_vector_type(2))) float f32x2_t;
DEV unsigned cvtpk(float lo, float hi) { f32x2_t v = {lo, hi}; bf16x2_t b = __builtin_convertvector(v, bf16x2_t); return __builtin_bit_cast(unsigned, b); }
DEV float bf2f(u16 x) { return __uint_as_float(((unsigned)x) << 16); }
DEV float bflo(unsigned x) { return __uint_as_float(x << 16); }
DEV float bfhi(unsigned x) { return __uint_as_float(x & 0xffff0000u); }
DEV u16 f2bf(float x) { __bf16 b = (__bf16)x; return __builtin_bit_cast(u16, b); }
DEV float wsum(float v) {
#pragma unroll
  for (int o = 32; o >= 1; o >>= 1) v += __shfl_xor(v, o, 64);
  return v;
}
DEV float siluf(float x) { return x / (1.f + __expf(-x)); }
DEV int crow(int r, int hi) { return (r & 3) + 8 * (r >> 2) + 4 * hi; }
DEV int ltid() { int t = threadIdx.x; asm volatile("" : "+v"(t)); return t; }
template <typename T> DEV T gld(size_t base, unsigned off) { return *(const __attribute__((address_space(1))) T*)(base + off); }
template <typename T> DEV void gst(size_t base, unsigned off, T v) { *(__attribute__((address_space(1))) T*)(base + off) = v; }
DEV void lds_wait() { asm volatile("s_waitcnt lgkmcnt(0)" ::: "memory"); }


#define XB_TMO      128
#define XB_XCNT(j)  (256  + 64 * (j))
#define XB_XSUB(j)  (1280 + 64 * (j))
#define XB_XGEN(j)  (2304 + 64 * (j))
#define XB_TOP      3328
#define XB_TOPGEN   3392
#define XCD_BAR_WORDS 3456
#define XB_SPIN_CAP (1u << 22)
#define LAS __attribute__((address_space(3)))
DEV unsigned xb_ld(unsigned* p)              { return __hip_atomic_load(p, __ATOMIC_RELAXED, __HIP_MEMORY_SCOPE_AGENT); }
DEV unsigned xb_add(unsigned* p, unsigned v) { return __hip_atomic_fetch_add(p, v, __ATOMIC_RELAXED, __HIP_MEMORY_SCOPE_AGENT); }
DEV unsigned xb_xcc_id() { return (unsigned)__builtin_amdgcn_s_getreg((3 << 11) | 20) & 0xFu; }
#define XB_SPIN(cond, bar) do { unsigned _sp = 0; while (cond) { __builtin_amdgcn_s_sleep(1); \
    if ((++_sp & 255u) == 0u) { if (xb_ld(&(bar)[XB_TMO])) break; if (_sp > XB_SPIN_CAP) { atomicAdd(&(bar)[XB_TMO], 1u); break; } } } } while (0)
struct XcdBarrier { unsigned* bar; unsigned x; volatile LAS unsigned* st; };
DEV void xcd_barrier_complete(unsigned* bar, unsigned x, unsigned& nloc, unsigned& nx) {
  const unsigned G = gridDim.x * gridDim.y * gridDim.z;
  unsigned sum, cnt, mine, sp = 0u;
  for (;;) {
    sum = 0u; cnt = 0u; mine = 0u;
#pragma unroll
    for (unsigned j = 0; j < 16; ++j) { const unsigned c = xb_ld(&bar[XB_XCNT(j)]); sum += c; cnt += (c > 0u) ? 1u : 0u; mine = (j == x) ? c : mine; }
    if (sum == G) break;
    __builtin_amdgcn_s_sleep(1);
    if ((++sp & 255u) == 0u) { if (xb_ld(&bar[XB_TMO])) break; if (sp > XB_SPIN_CAP) { atomicAdd(&bar[XB_TMO], 1u); break; } }
  }
  nloc = mine > 0u ? mine : 1u; nx = cnt > 0u ? cnt : 1u;
}
DEV void xcd_barrier(const XcdBarrier& b) {
  asm volatile("s_waitcnt vmcnt(0)" ::: "memory");
  __syncthreads();
  if (threadIdx.x == 0) {
    unsigned* bar = b.bar;
    __builtin_amdgcn_s_waitcnt(0);
    unsigned nloc = b.st[0], nx = b.st[1];
    if (nloc == 0u) { xcd_barrier_complete(bar, b.x, nloc, nx); b.st[0] = nloc; b.st[1] = nx; }
    const unsigned old = xb_add(&bar[XB_XSUB(b.x)], 1u);
    const unsigned gen = old / nloc;
    if (old + 1u == (gen + 1u) * nloc) {
      __builtin_amdgcn_fence(__ATOMIC_RELEASE, "agent");
      asm volatile("s_waitcnt vmcnt(0)" ::: "memory");
      const unsigned og = xb_add(&bar[XB_TOP], 1u);
      const unsigned tg = og / nx;
      if (og + 1u == (tg + 1u) * nx) xb_add(&bar[XB_TOPGEN], 1u);
      else XB_SPIN(xb_ld(&bar[XB_TOPGEN]) == tg, bar);
      __builtin_amdgcn_fence(__ATOMIC_ACQUIRE, "agent");
      xb_add(&bar[XB_XGEN(b.x)], 1u);
      asm volatile("s_waitcnt vmcnt(0)" ::: "memory");
    } else {
      XB_SPIN(xb_ld(&bar[XB_XGEN(b.x)]) == gen, bar);
      __builtin_amdgcn_fence(__ATOMIC_ACQUIRE, "agent");
      asm volatile("s_waitcnt vmcnt(0)" ::: "memory");
    }
  }
  __syncthreads();
}
DEV void gsync(const P& p, char* lds) {
  XcdBarrier b; b.bar = (unsigned*)(p.ws + O_BAR); b.x = xb_xcc_id(); b.st = (volatile LAS unsigned*)(lds + SHM_BYTES - 16);
  xcd_barrier(b);
}

DEV void convert_T(const float* __restrict__ src, u16* __restrict__ dst, int K, int N, int Npad, char* lds_) {
  float* lds = (float*)lds_;
  const int tid = ltid(), tk = K / 64, tn = Npad / 64;
  for (int t = blockIdx.x; t < tk * tn; t += gridDim.x) {
    const int k0 = (t % tk) * 64, n0 = (t / tk) * 64;
    __syncthreads();
#pragma unroll
    for (int i = 0; i < 2; ++i) {
      const int kr = (tid >> 4) + i * 32, c = (tid & 15) * 4;
      float4 v = make_float4(0.f, 0.f, 0.f, 0.f);
      if (n0 + c < N) v = *(const float4*)(src + (long)(k0 + kr) * N + n0 + c);
      lds[kr * 65 + c + 0] = v.x; lds[kr * 65 + c + 1] = v.y; lds[kr * 65 + c + 2] = v.z; lds[kr * 65 + c + 3] = v.w;
    }
    __syncthreads();
    const int n = tid >> 3, kc = (tid & 7) * 8;
    u32x4 w;
    w[0] = cvtpk(lds[(kc + 0) * 65 + n], lds[(kc + 1) * 65 + n]);
    w[1] = cvtpk(lds[(kc + 2) * 65 + n], lds[(kc + 3) * 65 + n]);
    w[2] = cvtpk(lds[(kc + 4) * 65 + n], lds[(kc + 5) * 65 + n]);
    w[3] = cvtpk(lds[(kc + 6) * 65 + n], lds[(kc + 7) * 65 + n]);
    *(u32x4*)(dst + (long)(n0 + n) * K + k0 + kc) = w;
  }
}

DEV void init_phase(const P& p, char* lds) {
  for (int j = 0; j < 2; ++j) {
    convert_T(p.rw_in  + (size_t)j * DM * RW_N, (u16*)(p.ws + O_WRWIN)  + (size_t)j * RW_N * DM, DM, RW_N, RW_N, lds);
    convert_T(p.rw_out + (size_t)j * EI * DM,   (u16*)(p.ws + O_WRWOUT) + (size_t)j * DM * EI,   EI, DM, DM, lds);
    convert_T(p.ml_in  + (size_t)j * DM * ML_N, (u16*)(p.ws + O_WMLIN)  + (size_t)j * ML_NP * DM, DM, ML_N, ML_NP, lds);
    convert_T(p.ml_uq  + (size_t)j * 384 * 3072, (u16*)(p.ws + O_WUQ)   + (size_t)j * 3072 * 384, 384, 3072, 3072, lds);
    convert_T(p.ml_ukv + (size_t)j * 256 * 4096, (u16*)(p.ws + O_WUKV)  + (size_t)j * 4096 * 256, 256, 4096, 4096, lds);
    convert_T(p.ml_out + (size_t)j * EI * DM,   (u16*)(p.ws + O_WMLOUT) + (size_t)j * DM * EI,   EI, DM, DM, lds);
  }
  float* ct = (float*)(p.ws + O_COS); float* st = (float*)(p.ws + O_SIN);
  const int tid_ = ltid();
  for (int i = blockIdx.x * 512 + tid_; i < 16384 * 32; i += gridDim.x * 512) {
    const int pos = i >> 5, j = i & 31;
    const float invf = 1.0f / powf(10000.0f, (float)(2 * j) / 64.0f);
    const float ang = (float)pos * invf;
    const double a = (double)ang;
    const double n = rint(a * 0.15915494309189535);
    const float r = (float)(a - n * 6.283185307179586);
    ct[i] = cosf(r); st[i] = sinf(r);
  }
}

DEV void rms_phase(const float* __restrict__ x, const float* __restrict__ g, u16* __restrict__ hout) {
  const int tid_ = ltid(); const int lane = tid_ & 63, wid = __builtin_amdgcn_readfirstlane(tid_ >> 6);
  for (int tok = blockIdx.x * 8 + wid; tok < GT; tok += gridDim.x * 8) {
    const float4* xr = (const float4*)(x + (size_t)tok * DM);
    float4 v[4]; float ss = 0.f;
#pragma unroll
    for (int i = 0; i < 4; ++i) { v[i] = xr[lane + i * 64]; ss += v[i].x * v[i].x + v[i].y * v[i].y + v[i].z * v[i].z + v[i].w * v[i].w; }
    ss = wsum(ss);
    const float sc = rsqrtf(ss * (1.f / DM) + 1e-6f);
#pragma unroll
    for (int i = 0; i < 4; ++i) {
      const float4 gg = ((const float4*)g)[lane + i * 64];
      u32x2 w; w[0] = cvtpk(v[i].x * sc * gg.x, v[i].y * sc * gg.y); w[1] = cvtpk(v[i].z * sc * gg.z, v[i].w * sc * gg.w);
      *(u32x2*)(hout + (size_t)tok * DM + (lane + i * 64) * 4) = w;
    }
  }
}

DEV void final_phase(float* __restrict__ x, const float* __restrict__ g) {
  const int tid_ = ltid(); const int lane = tid_ & 63, wid = __builtin_amdgcn_readfirstlane(tid_ >> 6);
  for (int tok = blockIdx.x * 8 + wid; tok < NTOK; tok += gridDim.x * 8) {
    float4* xr = (float4*)(x + (size_t)tok * DM);
    float4 v[4]; float ss = 0.f;
#pragma unroll
    for (int i = 0; i < 4; ++i) { v[i] = xr[lane + i * 64]; ss += v[i].x * v[i].x + v[i].y * v[i].y + v[i].z * v[i].z + v[i].w * v[i].w; }
    ss = wsum(ss);
    const float sc = rsqrtf(ss * (1.f / DM) + 1e-6f);
#pragma unroll
    for (int i = 0; i < 4; ++i) {
      const float4 gg = ((const float4*)g)[lane + i * 64];
      float4 ov = make_float4(v[i].x * sc * gg.x, v[i].y * sc * gg.y, v[i].z * sc * gg.z, v[i].w * sc * gg.w);
      xr[lane + i * 64] = ov;
    }
  }
}


DEV void lerp_phase(const u16* __restrict__ h, const float* __restrict__ mu, u16* __restrict__ out, int T) {
  const int tid_ = ltid(); const int lane = tid_ & 63, wid = __builtin_amdgcn_readfirstlane(tid_ >> 6);
  for (int tok = blockIdx.x * 8 + wid; tok < GT; tok += gridDim.x * 8) {
    const int pos = tok % T;
#pragma unroll
    for (int half = 0; half < 2; ++half) {
      const int c0 = half * 512 + lane * 8;
      const u32x4 c = *(const u32x4*)(h + (size_t)tok * DM + c0);
      u32x4 pv = {0u, 0u, 0u, 0u}, nx = {0u, 0u, 0u, 0u};
      if (pos > 0) pv = *(const u32x4*)(h + (size_t)(tok - 1) * DM + c0);
      if (pos < T - 1) nx = *(const u32x4*)(h + (size_t)(tok + 1) * DM + c0);
      float hh[8], xx[8];
#pragma unroll
      for (int e = 0; e < 4; ++e) {
        hh[2 * e] = bflo(c[e]); hh[2 * e + 1] = bfhi(c[e]);
        xx[2 * e] = 0.5f * (bflo(pv[e]) + bflo(nx[e])) - hh[2 * e]; xx[2 * e + 1] = 0.5f * (bfhi(pv[e]) + bfhi(nx[e])) - hh[2 * e + 1];
      }
#pragma unroll
      for (int st = 0; st < 4; ++st) {
        const int mi = st == 0 ? 0 : st == 1 ? 2 : st == 2 ? 3 : 5;
        const float4 m0v = *(const float4*)(mu + mi * DM + c0), m1v = *(const float4*)(mu + mi * DM + c0 + 4);
        const float m[8] = {m0v.x, m0v.y, m0v.z, m0v.w, m1v.x, m1v.y, m1v.z, m1v.w};
        u32x4 o;
#pragma unroll
        for (int e = 0; e < 4; ++e) o[e] = cvtpk(hh[2 * e] + m[2 * e] * xx[2 * e], hh[2 * e + 1] + m[2 * e + 1] * xx[2 * e + 1]);
        *(u32x4*)(out + (size_t)st * GT * DM + (size_t)tok * DM + c0) = o;
      }
    }
  }
}

#define GSWZ(row, c16) ((row) * 128 + ((((c16) ^ ((row) >> 1)) & 7) << 4))
constexpr int LOAD_PLAIN = 0, LOAD_LERP = 1;
constexpr int EPI_RWKV = 0, EPI_RES = 1, EPI_MLAIN = 2, EPI_BF16 = 3;
struct GemmP {
  const u16* A; int lda; const u16* Bt; int K; int NT;
  const float* mu;
  int T;
  u16* o0; u16* o1; u16* o2; u16* o3; u16* o4; u16* o5;
  int ldc;
  float* of; const float* xin; float* xout; int dry;
  int nt0; size_t astride;
};

template <int LOAD, int EPI, int NI>
DEV void gemm_phase(const GemmP& g, char* lds) {
  constexpr int BN = 64 * NI, SBB = BN * 128;
  const int tid = ltid(), wid = __builtin_amdgcn_readfirstlane(tid >> 6), lane = tid & 63, r32 = lane & 31, hi = lane >> 5;
  const int wm = wid >> 1, wn = wid & 1;
  char* sA = lds; char* sB = lds + 65536;
  int Kv = g.K; asm volatile("" : "+s"(Kv));
  const int nk = Kv / 64, ntiles = 64 * g.NT;
  const int c16 = tid & 7, rowb = tid >> 3;
  for (int t = blockIdx.x; t < ntiles; t += gridDim.x) {
    const int mt = t & 63, nt = g.nt0 + (t >> 6), m0 = mt * 256, n0 = nt * BN;
    const u16* Ab = g.A + (size_t)(n0 >> 11) * g.astride;
    f32x16 acc[2][NI] = {};
    bf16x8 ra[4], rb[NI];
    const float* mup = nullptr;
    if constexpr (LOAD == LOAD_LERP) {
      const int s = n0 < 2048 ? 0 : n0 < 4096 ? 2 : n0 < 6144 ? 3 : n0 < 8192 ? 5 : n0 == 8192 ? 1 : 4;
      mup = g.mu + s * DM;
    }
    auto gload = [&](int kt) {
      const int k0 = kt * 64 + c16 * 8;
#pragma unroll
      for (int i = 0; i < 4; ++i) {
        const int row = rowb + i * 64; const size_t tok = (size_t)(m0 + row);
        if constexpr (LOAD == LOAD_PLAIN) {
          ra[i] = *(const bf16x8*)(Ab + tok * g.lda + k0);
        } else {
          const int pos = (int)(tok % (size_t)g.T);
          const u32x4 c = *(const u32x4*)(g.A + tok * DM + k0);
          u32x4 pv = {0u, 0u, 0u, 0u}, nx = {0u, 0u, 0u, 0u};
          if (pos > 0) pv = *(const u32x4*)(g.A + (tok - 1) * DM + k0);
          if (pos < g.T - 1) nx = *(const u32x4*)(g.A + (tok + 1) * DM + k0);
          const float4 m0v = *(const float4*)(mup + k0), m1v = *(const float4*)(mup + k0 + 4);
          const float mu[8] = {m0v.x, m0v.y, m0v.z, m0v.w, m1v.x, m1v.y, m1v.z, m1v.w};
          u32x4 o;
#pragma unroll
          for (int e = 0; e < 4; ++e) {
            const float h0 = bflo(c[e]), h1 = bfhi(c[e]);
            const float x0 = 0.5f * (bflo(pv[e]) + bflo(nx[e])) - h0, x1 = 0.5f * (bfhi(pv[e]) + bfhi(nx[e])) - h1;
            o[e] = cvtpk(h0 + mu[2 * e] * x0, h1 + mu[2 * e + 1] * x1);
          }
          ra[i] = *(bf16x8*)&o;
        }
      }
#pragma unroll
      for (int i = 0; i < NI; ++i) {
        const int row = rowb + i * 64;
        rb[i] = *(const bf16x8*)(g.Bt + (size_t)(n0 + row) * Kv + k0);
      }
    };
    auto swrite = [&](int b) {
#pragma unroll
      for (int i = 0; i < 4; ++i) { const int row = rowb + i * 64; *(bf16x8*)(sA + b * 32768 + GSWZ(row, c16)) = ra[i]; }
#pragma unroll
      for (int i = 0; i < NI; ++i) { const int row = rowb + i * 64; *(bf16x8*)(sB + b * SBB + GSWZ(row, c16)) = rb[i]; }
    };
    auto gdma = [&](int kt, int b, int m0_, int n0_, const u16* Ab_) {
      const int cl = c16 ^ ((rowb >> 1) & 7);
#pragma unroll
      for (int i = 0; i < 4; ++i) {
        const u16* src = Ab_ + (size_t)(m0_ + rowb + i * 64) * g.lda + kt * 64 + cl * 8;
        __builtin_amdgcn_global_load_lds((const __attribute__((address_space(1))) void*)src, (__attribute__((address_space(3))) void*)(sA + b * 32768 + (tid + i * 512) * 16), 16, 0, 0);
      }
#pragma unroll
      for (int i = 0; i < NI; ++i) {
        const u16* src = g.Bt + (size_t)(n0_ + rowb + i * 64) * Kv + kt * 64 + cl * 8;
        __builtin_amdgcn_global_load_lds((const __attribute__((address_space(1))) void*)src, (__attribute__((address_space(3))) void*)(sB + b * SBB + (tid + i * 512) * 16), 16, 0, 0);
      }
    };
    if constexpr (LOAD == LOAD_PLAIN) { if (t == (int)blockIdx.x) gdma(0, 0, m0, n0, Ab);
      asm volatile("s_waitcnt vmcnt(0)" ::: "memory"); __syncthreads(); }
    else { gload(0); swrite(0); __syncthreads(); }
    for (int kt = 0; kt < nk; ++kt) {
      const int b = kt & 1;
      if constexpr (LOAD == LOAD_PLAIN) { if (kt + 1 < nk) gdma(kt + 1, b ^ 1, m0, n0, Ab); }
      else { if (kt + 1 < nk) gload(kt + 1); }
      const char* a_ = sA + b * 32768; const char* b_ = sB + b * SBB;
#pragma unroll
      for (int ks = 0; ks < 4; ++ks) {
        bf16x8 af[2], bfr[NI];
#pragma unroll
        for (int mi = 0; mi < 2; ++mi) { const int row = wm * 64 + mi * 32 + r32; af[mi] = *(const bf16x8*)(a_ + GSWZ(row, ks * 2 + hi)); }
#pragma unroll
        for (int ni = 0; ni < NI; ++ni) { const int row = wn * (32 * NI) + ni * 32 + r32; bfr[ni] = *(const bf16x8*)(b_ + GSWZ(row, ks * 2 + hi)); }
#pragma unroll
        for (int mi = 0; mi < 2; ++mi)
#pragma unroll
          for (int ni = 0; ni < NI; ++ni) acc[mi][ni] = __builtin_amdgcn_mfma_f32_32x32x16_bf16(af[mi], bfr[ni], acc[mi][ni], 0, 0, 0);
      }
      if constexpr (LOAD == LOAD_PLAIN) asm volatile("s_waitcnt vmcnt(0)" ::: "memory");
      else { if (kt + 1 < nk) swrite(b ^ 1); }
      __syncthreads();
    }
    if constexpr (LOAD == LOAD_PLAIN) {
      const int tn_ = t + (int)gridDim.x;
      if (tn_ < ntiles) { const int ntn = g.nt0 + (tn_ >> 6), m0n = (tn_ & 63) * 256, n0n = ntn * BN; gdma(0, 0, m0n, n0n, g.A + (size_t)(n0n >> 11) * g.astride); }
    }
    if (!g.dry)
#pragma unroll
    for (int mi = 0; mi < 2; ++mi)
#pragma unroll
      for (int ni = 0; ni < NI; ++ni)
#pragma unroll
        for (int r = 0; r < 16; ++r) {
          const size_t m = (size_t)(m0 + wm * 64 + mi * 32 + crow(r, hi));
          const int nl = wn * (32 * NI) + ni * 32 + r32, n = n0 + nl;
          const float v = acc[mi][ni][r];
          if constexpr (EPI == EPI_RWKV) {
            if (n0 < 8192) {
              const int which = n0 >> 11, col = n & 2047;
              u16* dst = which == 0 ? g.o0 : which == 1 ? g.o1 : which == 2 ? g.o2 : g.o3;
              dst[m * EI + col] = f2bf(which == 3 ? siluf(v) : v);
            } else if (n0 == 8192) g.o4[m * 128 + nl] = f2bf(tanhf(v));
            else g.o5[m * 128 + nl] = f2bf(v);
          } else if constexpr (EPI == EPI_RES) {
            g.xout[m * DM + n] = g.xin[m * DM + n] + v;
          } else if constexpr (EPI == EPI_MLAIN) {
            if (n < 704) g.of[m * 704 + n] = v;
            else if (n < ML_N) g.o0[m * EI + (n - 704)] = f2bf(siluf(v));
          } else {
            g.o0[m * g.ldc + n] = f2bf(v);
          }
        }
  }
}

struct ScanP {
  const u16 *r, *k, *v, *twl, *al; u16 *yf, *yb; float* bonus;
  const float *w0, *w2, *a0, *a2, *kk, *ka, *rk;
  int nseq, T;
  float* tbuf; int nseg;
};
template <int CTRL> DEV float dppf(float x) {
  return __int_as_float(__builtin_amdgcn_update_dpp(0, __float_as_int(x), CTRL, 0xF, 0xF, false));
}
DEV float row_prefix16(float x) {
  x += dppf<0x111>(x); x += dppf<0x112>(x); x += dppf<0x114>(x); x += dppf<0x118>(x); return x;
}
DEV float row_total16(float x) {
  x += dppf<0x128>(x); x += dppf<0x124>(x); x += dppf<0x122>(x); x += dppf<0x121>(x); return x;
}
DEV bf16x8 pack8(float a0, float a1, float a2, float a3, float a4, float a5, float a6, float a7) {
  u32x4 w = {cvtpk(a0, a1), cvtpk(a2, a3), cvtpk(a4, a5), cvtpk(a6, a7)}; return *(bf16x8*)&w;
}
constexpr int SC_BKT = 0, SC_UVT = 5120, SC_AKM = 10240, SC_RR = 10752, SC_ABF = 11776, SC_Z = 12800, SC_PRM = 17152, SC_T = 18944, SC_WAVE = 35328;
constexpr int SC_PRE = SC_UVT;
constexpr int SC_SHARED_AW = 4 * SC_WAVE;
constexpr int SC_NW = 4;
DEV void scan_phase(const ScanP& s, char* lds_, const int pass) {
  const int tid = ltid(), wid = __builtin_amdgcn_readfirstlane(tid >> 6), lane = tid & 63, c16 = lane & 15, q = lane >> 4;
  const int nchain = s.nseq * 64, nseg = s.nseg;
  const int ipc = pass == 0 ? nseg * 2 : nseg;
  const bool shared = nchain <= (int)gridDim.x;
  const int nsb = shared ? (int)gridDim.x / nchain : 1, sbi = shared ? (int)blockIdx.x / nchain : 0;
  const int nwv = shared ? SC_NW : 2;
  if (shared && sbi >= nsb) return;
  char* wl = lds_ + (wid & 3) * SC_WAVE;
  u16* bkt = (u16*)(wl + SC_BKT); u16* uvt = (u16*)(wl + SC_UVT); u16* akm = (u16*)(wl + SC_AKM); u16* rr = (u16*)(wl + SC_RR);
  float* abf = (float*)(wl + SC_ABF); float* zl = (float*)(wl + SC_Z); float* prm = (float*)(wl + SC_PRM); float* p15l = prm + 320;
  bf16x8* awl = (bf16x8*)(shared ? lds_ + SC_SHARED_AW : lds_ + (2 + (wid & 1)) * SC_WAVE); bf16x8* aal = awl + 512;
#define SCAN_LOAD_W(CHAIN, F0, F1) do { const int d_ = (CHAIN) & 1, h_ = ((CHAIN) >> 1) & 31; \
    for (int f = (F0); f < (F1); ++f) { const int ks = f >> 2, mt = f & 3; u32x4 pw, pa; \
      _Pragma("unroll") for (int e = 0; e < 4; ++e) { const int l0 = ks * 32 + q * 8 + 2 * e; \
        const size_t i0 = ((size_t)(d_ * 64 + l0)) * EI + h_ * 64 + mt * 16 + c16; \
        pw[e] = cvtpk(s.w2[i0], s.w2[i0 + EI]); pa[e] = cvtpk(s.a2[i0], s.a2[i0 + EI]); } \
      awl[f * 64 + lane] = *(bf16x8*)&pw; aal[f * 64 + lane] = *(bf16x8*)&pa; } } while (0)
  if (shared) {
    const int chain_b = (int)blockIdx.x % nchain;
    SCAN_LOAD_W(chain_b, wid, wid + 1);
    __syncthreads();
  }
  if (wid >= nwv) return;
  const int nrounds = shared ? (ipc + nsb * SC_NW - 1) / (nsb * SC_NW) : (nchain + 2 * (int)gridDim.x - 1) / (2 * (int)gridDim.x);
  for (int round = 0; round < nrounds; ++round) {
    const int chain = shared ? (int)blockIdx.x % nchain : (round * 2 + wid) * (int)gridDim.x + (int)blockIdx.x;
    const int it = shared ? sbi * SC_NW + wid + round * nsb * SC_NW : 0;
    if (chain >= nchain || it >= ipc) continue;
    const int kind = pass == 0 ? 1 + (it & 1) : 0;
    const int seg = pass == 0 ? it >> 1 : it;
    const int cs = chain * nseg + seg;
    const int d = chain & 1, h = (chain >> 1) & 31, b = chain >> 6;
    {
      const int ch = h * 64 + lane;
      lds_wait();
      prm[lane] = s.w0[d * EI + ch]; prm[64 + lane] = s.a0[d * EI + ch]; prm[128 + lane] = s.kk[ch]; prm[192 + lane] = s.ka[ch]; prm[256 + lane] = s.rk[ch];
      lds_wait();
    }
    if (!shared) { SCAN_LOAD_W(chain, 0, 8); lds_wait(); }
    const unsigned rowi = (unsigned)(d ? 15 - c16 : c16);
    const unsigned off_tw = rowi * 256u + (unsigned)(q * 16);
    const unsigned off_kr = rowi * 4096u + (unsigned)(h * 128 + q * 8);
    const unsigned off_v  = (unsigned)(h * 128 + lane * 2);
    const unsigned off_y0 = (unsigned)(d ? 15 - 4 * q : 4 * q) * 4096u + (unsigned)(h * 128 + c16 * 2);
    const int ystep = d ? -4096 : 4096;
    f32x4* Tl = (f32x4*)(wl + SC_T);
#pragma unroll
    for (int m = 0; m < 16; ++m) {
      f32x4 t0v = {0.f, 0.f, 0.f, 0.f};
      if (kind == 2) {
        const int mt = m >> 2, nt = m & 3;
        if (mt == nt) { t0v[0] = (4 * q + 0 == c16) ? 1.f : 0.f; t0v[1] = (4 * q + 1 == c16) ? 1.f : 0.f; t0v[2] = (4 * q + 2 == c16) ? 1.f : 0.f; t0v[3] = (4 * q + 3 == c16) ? 1.f : 0.f; }
      } else if (kind == 0 && nseg > 1) {
        t0v = *(const f32x4*)(s.tbuf + ((size_t)cs * 2) * 4096 + (m * 64 + lane) * 4);
      }
      Tl[m * 64 + lane] = t0v;
    }
    u16* yout = d ? s.yb : s.yf;
    const size_t sb = (size_t)b * s.T;
    const int cps = s.T / 16 / nseg, cbeg = seg * cps, cend = cbeg + cps;
    bf16x8 n_tw0, n_tw1, n_ta0, n_ta1; u32x2 n_k[4], n_r[4];
#define SCAN_LOAD(CC) do { const int c0n = d ? (s.T - 16 - (CC) * 16) : (CC) * 16; const size_t t0n = sb + c0n; \
      size_t p_tw = (size_t)s.twl + t0n * 256 + d * 128, p_al = (size_t)s.al + t0n * 256 + d * 128, p_k = (size_t)s.k + t0n * 4096, p_r = (size_t)s.r + t0n * 4096 ; \
      asm volatile("" : "+s"(p_tw), "+s"(p_al), "+s"(p_k), "+s"(p_r)); \
      n_tw0 = gld<bf16x8>(p_tw, off_tw); n_tw1 = gld<bf16x8>(p_tw, off_tw + 64); n_ta0 = gld<bf16x8>(p_al, off_tw); n_ta1 = gld<bf16x8>(p_al, off_tw + 64); \
      _Pragma("unroll") for (int mt = 0; mt < 4; ++mt) { n_k[mt] = gld<u32x2>(p_k, off_kr + mt * 32); n_r[mt] = gld<u32x2>(p_r, off_kr + mt * 32); } } while (0)
    SCAN_LOAD(cbeg);
    for (int cc = cbeg; cc < cend; ++cc) {
      const int c0 = d ? (s.T - 16 - cc * 16) : cc * 16;
      const size_t t0 = sb + c0;
      size_t b_y = (size_t)yout + t0 * 4096, b_bon = (size_t)s.bonus + t0 * 256 + (h * 2 + d) * 4;
      asm volatile("" : "+s"(b_y), "+s"(b_bon));
      size_t b_v = (size_t)s.v + t0 * 4096; asm volatile("" : "+s"(b_v));
      u32x2 n_v[4];
#pragma unroll
      for (int mt = 0; mt < 4; ++mt) n_v[mt] = gld<u32x2>(b_v, off_kr + mt * 32);
      {
        f32x4* wpl = (f32x4*)zl; f32x4* apl = (f32x4*)(wl + SC_PRE);
#pragma unroll
        for (int mt = 0; mt < 4; ++mt) {
          f32x4 cw = {0.f, 0.f, 0.f, 0.f}, ca = {0.f, 0.f, 0.f, 0.f};
          cw = __builtin_amdgcn_mfma_f32_16x16x32_bf16(awl[(0 * 4 + mt) * 64 + lane], n_tw0, cw, 0, 0, 0);
          cw = __builtin_amdgcn_mfma_f32_16x16x32_bf16(awl[(1 * 4 + mt) * 64 + lane], n_tw1, cw, 0, 0, 0);
          ca = __builtin_amdgcn_mfma_f32_16x16x32_bf16(aal[(0 * 4 + mt) * 64 + lane], n_ta0, ca, 0, 0, 0);
          ca = __builtin_amdgcn_mfma_f32_16x16x32_bf16(aal[(1 * 4 + mt) * 64 + lane], n_ta1, ca, 0, 0, 0);
          wpl[mt * 64 + lane] = cw; apl[mt * 64 + lane] = ca;
        }
      }
      float n2 = 0.f;
#pragma unroll
      for (int mt = 0; mt < 4; ++mt) {
        const float4 kkp = *(const float4*)(prm + 128 + mt * 16 + q * 4);
        const float t0 = bflo(n_k[mt][0]) * kkp.x, t1 = bfhi(n_k[mt][0]) * kkp.y, t2 = bflo(n_k[mt][1]) * kkp.z, t3 = bfhi(n_k[mt][1]) * kkp.w;
        n2 += t0 * t0 + t1 * t1 + t2 * t2 + t3 * t3;
      }
      n2 += __shfl_xor(n2, 16, 64); n2 += __shfl_xor(n2, 32, 64);
      const float invn = __builtin_amdgcn_rsqf(fmaxf(n2, 1e-24f));
      float bon = 0.f;
      bf16x8 ktf[2], btf[2], kdf[2], rtf[2];
#pragma unroll
      for (int ks = 0; ks < 2; ++ks) {
        float ktl[8], btl[8], kdl[8], rtl[8];
#pragma unroll
        for (int mh = 0; mh < 2; ++mh) {
          const int mt = 2 * ks + mh;
          const f32x4 cw = ((const f32x4*)zl)[mt * 64 + lane], ca = ((const f32x4*)(wl + SC_PRE))[mt * 64 + lane];
          const float4 w0p = *(const float4*)(prm + mt * 16 + q * 4), a0p = *(const float4*)(prm + 64 + mt * 16 + q * 4);
          const float4 kkp = *(const float4*)(prm + 128 + mt * 16 + q * 4), kap = *(const float4*)(prm + 192 + mt * 16 + q * 4), rkp = *(const float4*)(prm + 256 + mt * 16 + q * 4);
          const float w0a[4] = {w0p.x, w0p.y, w0p.z, w0p.w}, a0a[4] = {a0p.x, a0p.y, a0p.z, a0p.w};
          const float kka[4] = {kkp.x, kkp.y, kkp.z, kkp.w}, kaa[4] = {kap.x, kap.y, kap.z, kap.w}, rka[4] = {rkp.x, rkp.y, rkp.z, rkp.w};
          const u32x2 kr_ = n_k[mt], rr_ = n_r[mt];
          const float kxa[4] = {bflo(kr_[0]), bfhi(kr_[0]), bflo(kr_[1]), bfhi(kr_[1])};
          const float rxa[4] = {bflo(rr_[0]), bfhi(rr_[0]), bflo(rr_[1]), bfhi(rr_[1])};
          float4 p15v;
#pragma unroll
          for (int e = 0; e < 4; ++e) {
            const float wp = cw[e] + w0a[e], ap = ca[e] + a0a[e];
            const float ee = 0.6065306597126334f * __builtin_amdgcn_rcpf(1.f + __expf(-wp));
            const float a = __builtin_amdgcn_rcpf(1.f + __expf(-ap));
            const float kkn = kxa[e] * kka[e] * invn;
            const float kd = kxa[e] * (1.f + (a - 1.f) * kaa[e]);
            const float bb = kkn * a;
            bon += rxa[e] * kd * rka[e];
            const float Ei = row_prefix16(ee);
            const float pm = __expf(-Ei), pp = __builtin_amdgcn_rcpf(pm);
            const float pm1s = dppf<0x111>(pm), pm1 = c16 == 0 ? 1.f : pm1s;
            ktl[mh * 4 + e] = kkn * pm1; btl[mh * 4 + e] = bb * pp; kdl[mh * 4 + e] = kd * pp; rtl[mh * 4 + e] = rxa[e] * pm;
            ((float*)&p15v)[e] = pm;
          }
          if (c16 == 15) *(float4*)(p15l + mt * 16 + q * 4) = p15v;
          SBAR();
        }
        ktf[ks] = pack8(ktl[0], ktl[1], ktl[2], ktl[3], ktl[4], ktl[5], ktl[6], ktl[7]);
        btf[ks] = pack8(btl[0], btl[1], btl[2], btl[3], btl[4], btl[5], btl[6], btl[7]);
        kdf[ks] = pack8(kdl[0], kdl[1], kdl[2], kdl[3], kdl[4], kdl[5], kdl[6], kdl[7]);
        rtf[ks] = pack8(rtl[0], rtl[1], rtl[2], rtl[3], rtl[4], rtl[5], rtl[6], rtl[7]);
        {
          const u32x4 bw_ = *(const u32x4*)&btf[ks], kw_ = *(const u32x4*)&kdf[ks];
#pragma unroll
          for (int w = 0; w < 4; ++w) {
            const int j = (2 * ks + (w >> 1)) * 16 + q * 4 + (w & 1) * 2;
            bkt[j * 40 + c16] = (u16)(bw_[w] & 0xffffu); bkt[(j + 1) * 40 + c16] = (u16)(bw_[w] >> 16);
            bkt[j * 40 + 16 + c16] = (u16)(kw_[w] & 0xffffu); bkt[(j + 1) * 40 + 16 + c16] = (u16)(kw_[w] >> 16);
          }
        }
      }
      bon += __shfl_xor(bon, 16, 64); bon += __shfl_xor(bon, 32, 64);
      if (q == 0 && kind == 0) gst<float>(b_bon, off_tw, bon);
      SBAR();
      SBAR();
#pragma unroll
      for (int mt = 0; mt < 4; ++mt) {
        const int vb_ = (mt * 16 + q * 4) * 40 + 16 + c16;
        const unsigned v0_ = kind == 2 ? 0u : n_v[mt][0], v1_ = kind == 2 ? 0u : n_v[mt][1];
        uvt[vb_] = (u16)(v0_ & 0xffffu); uvt[vb_ + 40] = (u16)(v0_ >> 16);
        uvt[vb_ + 80] = (u16)(v1_ & 0xffffu); uvt[vb_ + 120] = (u16)(v1_ >> 16);
      }
      { const int cn = cc + 1 < cend ? cc + 1 : cc; SCAN_LOAD(cn); }
      SBAR();
      {
        f32x4 AB = {0.f, 0.f, 0.f, 0.f}, AK = AB, RB = AB, RK = AB;
        int qm = q; asm volatile("" : "+v"(qm));
#pragma unroll
        for (int ks = 0; ks < 2; ++ks) {
          AB = __builtin_amdgcn_mfma_f32_16x16x32_bf16(ktf[ks], btf[ks], AB, 0, 0, 0);
          AK = __builtin_amdgcn_mfma_f32_16x16x32_bf16(ktf[ks], kdf[ks], AK, 0, 0, 0);
          RB = __builtin_amdgcn_mfma_f32_16x16x32_bf16(rtf[ks], btf[ks], RB, 0, 0, 0);
          RK = __builtin_amdgcn_mfma_f32_16x16x32_bf16(rtf[ks], kdf[ks], RK, 0, 0, 0);
        }
#pragma unroll
        for (int r = 0; r < 4; ++r) {
          const int i = 4 * qm + r;
          const bool lo = c16 < i, le = c16 <= i;
          abf[i * 16 + c16] = lo ? AB[r] : 0.f;
          akm[i * 16 + c16] = f2bf(lo ? AK[r] : 0.f);
          rr[i * 32 + c16] = f2bf(le ? RB[r] : 0.f);
          rr[i * 32 + 16 + c16] = f2bf(le ? RK[r] : 0.f);
        }
      }
#define TFRAG(ks, nt, OUT) do { const f32x4 ta_ = Tl[((2 * (ks)) * 4 + (nt)) * 64 + lane], tb_ = Tl[((2 * (ks) + 1) * 4 + (nt)) * 64 + lane]; \
        OUT = pack8(ta_[0], ta_[1], ta_[2], ta_[3], tb_[0], tb_[1], tb_[2], tb_[3]); } while (0)
      lds_wait();
      {
        bf16x8 akf = {0, 0, 0, 0, 0, 0, 0, 0};
        if (q < 2) akf = *(const bf16x8*)(akm + c16 * 16 + q * 8);
#pragma unroll
        for (int nt = 0; nt < 4; ++nt) {
          f32x4 z = {0.f, 0.f, 0.f, 0.f};
          bf16x8 tf0, tf1; TFRAG(0, nt, tf0); TFRAG(1, nt, tf1);
          z = __builtin_amdgcn_mfma_f32_16x16x32_bf16(ktf[0], tf0, z, 0, 0, 0);
          z = __builtin_amdgcn_mfma_f32_16x16x32_bf16(ktf[1], tf1, z, 0, 0, 0);
          const bf16x8 vf = *(const bf16x8*)(uvt + (nt * 16 + c16) * 40 + 16 + (q & 1) * 8);
          z = __builtin_amdgcn_mfma_f32_16x16x32_bf16(akf, vf, z, 0, 0, 0);
#pragma unroll
          for (int r = 0; r < 4; ++r) zl[(4 * q + r) * 68 + nt * 16 + c16] = z[r];
        }
      }
      lds_wait();
      SBAR();
      {
        float U[16];
#pragma unroll
        for (int i = 0; i < 16; ++i) {
          float acc = -zl[i * 68 + lane];
#pragma unroll
          for (int s4 = 0; s4 < (i + 3) / 4; ++s4) {
            const float4 a4 = *(const float4*)(abf + i * 16 + s4 * 4);
            if (s4 * 4 + 0 < i) acc -= a4.x * U[s4 * 4 + 0];
            if (s4 * 4 + 1 < i) acc -= a4.y * U[s4 * 4 + 1];
            if (s4 * 4 + 2 < i) acc -= a4.z * U[s4 * 4 + 2];
            if (s4 * 4 + 3 < i) acc -= a4.w * U[s4 * 4 + 3];
          }
          U[i] = acc;
          if ((i & 3) == 3) SBAR();
        }
        *(bf16x8*)(uvt + lane * 40) = pack8(U[0], U[1], U[2], U[3], U[4], U[5], U[6], U[7]);
        *(bf16x8*)(uvt + lane * 40 + 8) = pack8(U[8], U[9], U[10], U[11], U[12], U[13], U[14], U[15]);
      }
      lds_wait();
      SBAR();
      {
        const bf16x8 rrf = *(const bf16x8*)(rr + c16 * 32 + q * 8);
        bf16x8 uvf[4];
#pragma unroll
        for (int nt = 0; nt < 4; ++nt) uvf[nt] = *(const bf16x8*)(uvt + (nt * 16 + c16) * 40 + q * 8);
#pragma unroll
        for (int nt = 0; nt < 4; ++nt) {
          f32x4 y = {0.f, 0.f, 0.f, 0.f};
          bf16x8 tf0, tf1; TFRAG(0, nt, tf0); TFRAG(1, nt, tf1);
          y = __builtin_amdgcn_mfma_f32_16x16x32_bf16(rtf[0], tf0, y, 0, 0, 0);
          y = __builtin_amdgcn_mfma_f32_16x16x32_bf16(rtf[1], tf1, y, 0, 0, 0);
          y = __builtin_amdgcn_mfma_f32_16x16x32_bf16(rrf, uvf[nt], y, 0, 0, 0);
#pragma unroll
          for (int r = 0; r < 4; ++r) { if (kind == 0) gst<u16>(b_y, off_y0 + (unsigned)(r * ystep) + nt * 32, f2bf(y[r])); }
        }
#pragma unroll
        for (int mt = 0; mt < 4; ++mt) {
          const bf16x8 bkf = *(const bf16x8*)(bkt + (mt * 16 + c16) * 40 + q * 8);
          const float4 pq = *(const float4*)(p15l + mt * 16 + q * 4);
#pragma unroll
          for (int nt = 0; nt < 4; ++nt) {
            f32x4 t = __builtin_amdgcn_mfma_f32_16x16x32_bf16(bkf, uvf[nt], Tl[(mt * 4 + nt) * 64 + lane], 0, 0, 0);
            t[0] *= pq.x; t[1] *= pq.y; t[2] *= pq.z; t[3] *= pq.w;
            Tl[(mt * 4 + nt) * 64 + lane] = t;
          }
        }
      }
      lds_wait();
    }
    if (pass == 0) {
      float* dst = s.tbuf + ((size_t)cs * 2 + (kind - 1)) * 4096;
#pragma unroll
      for (int m = 0; m < 16; ++m) *(f32x4*)(dst + (m * 64 + lane) * 4) = Tl[m * 64 + lane];
    }
  }
}

DEV void scan_combine_phase(const ScanP& s, char* lds_) {
  const int tid = ltid(), wid = __builtin_amdgcn_readfirstlane(tid >> 6), lane = tid & 63, c16 = lane & 15, q = lane >> 4;
  if (wid >= 2) return;
  float* til = (float*)(lds_ + wid * 16384);
  const int nchain = s.nseq * 64, nseg = s.nseg;
  for (int chain = wid * gridDim.x + blockIdx.x; chain < nchain; chain += 2 * gridDim.x) {
    f32x4 T[16];
#pragma unroll
    for (int m = 0; m < 16; ++m) T[m] = f32x4{0.f, 0.f, 0.f, 0.f};
    for (int seg = 0; seg < nseg; ++seg) {
      float* tn = s.tbuf + ((size_t)(chain * nseg + seg) * 2) * 4096; const float* ti = tn + 4096;
      lds_wait();
#pragma unroll
      for (int m = 0; m < 16; ++m) *(f32x4*)(til + (m * 64 + lane) * 4) = *(const f32x4*)(ti + (m * 64 + lane) * 4);
      lds_wait();
      f32x4 Tn[16];
#pragma unroll
      for (int m = 0; m < 16; ++m) Tn[m] = *(const f32x4*)(tn + (m * 64 + lane) * 4);
#pragma unroll
      for (int nt = 0; nt < 4; ++nt) {
        bf16x8 bh[2], bl[2];
#pragma unroll
        for (int ks = 0; ks < 2; ++ks) {
          const f32x4 ta = T[(2 * ks) * 4 + nt], tb = T[(2 * ks + 1) * 4 + nt];
          const float x[8] = {ta[0], ta[1], ta[2], ta[3], tb[0], tb[1], tb[2], tb[3]};
          float hf[8], lf[8];
#pragma unroll
          for (int e = 0; e < 8; ++e) { hf[e] = bf2f(f2bf(x[e])); lf[e] = x[e] - hf[e]; }
          bh[ks] = pack8(hf[0], hf[1], hf[2], hf[3], hf[4], hf[5], hf[6], hf[7]);
          bl[ks] = pack8(lf[0], lf[1], lf[2], lf[3], lf[4], lf[5], lf[6], lf[7]);
        }
#pragma unroll
        for (int mt = 0; mt < 4; ++mt) {
          f32x4 acc = Tn[mt * 4 + nt];
#pragma unroll
          for (int ks = 0; ks < 2; ++ks) {
            float x[8];
#pragma unroll
            for (int e = 0; e < 8; ++e) x[e] = til[((mt * 4 + 2 * ks + (e >> 2)) * 64 + ((c16 >> 2) & 3) * 16 + 4 * q + (e & 3)) * 4 + (c16 & 3)];
            float hf[8], lf[8];
#pragma unroll
            for (int e = 0; e < 8; ++e) { hf[e] = bf2f(f2bf(x[e])); lf[e] = x[e] - hf[e]; }
            const bf16x8 ah = pack8(hf[0], hf[1], hf[2], hf[3], hf[4], hf[5], hf[6], hf[7]);
            const bf16x8 al = pack8(lf[0], lf[1], lf[2], lf[3], lf[4], lf[5], lf[6], lf[7]);
            acc = __builtin_amdgcn_mfma_f32_16x16x32_bf16(ah, bh[ks], acc, 0, 0, 0);
            acc = __builtin_amdgcn_mfma_f32_16x16x32_bf16(ah, bl[ks], acc, 0, 0, 0);
            acc = __builtin_amdgcn_mfma_f32_16x16x32_bf16(al, bh[ks], acc, 0, 0, 0);
          }
          Tn[mt * 4 + nt] = acc;
        }
      }
#pragma unroll
      for (int m = 0; m < 16; ++m) { *(f32x4*)(tn + (m * 64 + lane) * 4) = T[m]; T[m] = Tn[m]; }
    }
  }
}

DEV void post_phase(u16* __restrict__ yf, const u16* __restrict__ yb, const u16* __restrict__ v, const u16* __restrict__ sg,
                    const float* __restrict__ bonus, const float* __restrict__ lg, const float* __restrict__ lb) {
  const int tid_ = ltid(); const int lane = tid_ & 63, wid = __builtin_amdgcn_readfirstlane(tid_ >> 6);
  for (int tok = blockIdx.x * 8 + wid; tok < GT; tok += gridDim.x * 8) {
#pragma unroll
    for (int it = 0; it < 4; ++it) {
      const int ch0 = it * 512 + lane * 8, h = ch0 >> 6; const size_t i = (size_t)tok * EI + ch0;
      const u32x4 a = *(const u32x4*)(yf + i), bq = *(const u32x4*)(yb + i), vv = *(const u32x4*)(v + i), gg = *(const u32x4*)(sg + i);
      const float2 bo = *(const float2*)(bonus + ((size_t)tok * 32 + h) * 2);
      float y[8]; float sum = 0.f;
#pragma unroll
      for (int e = 0; e < 4; ++e) { y[2 * e] = bflo(a[e]) + bflo(bq[e]); y[2 * e + 1] = bfhi(a[e]) + bfhi(bq[e]); sum += y[2 * e] + y[2 * e + 1]; }
      sum += __shfl_xor(sum, 1, 64); sum += __shfl_xor(sum, 2, 64); sum += __shfl_xor(sum, 4, 64);
      const float mean = sum * (1.f / 64.f);
      float var = 0.f;
#pragma unroll
      for (int e = 0; e < 8; ++e) { y[e] -= mean; var += y[e] * y[e]; }
      var += __shfl_xor(var, 1, 64); var += __shfl_xor(var, 2, 64); var += __shfl_xor(var, 4, 64);
      const float rs = rsqrtf(var * (1.f / 64.f) + 64e-5f), bon = bo.x + bo.y;
      const float4 g0 = *(const float4*)(lg + ch0), g1 = *(const float4*)(lg + ch0 + 4), b0 = *(const float4*)(lb + ch0), b1 = *(const float4*)(lb + ch0 + 4);
      const float ga[8] = {g0.x, g0.y, g0.z, g0.w, g1.x, g1.y, g1.z, g1.w}, ba[8] = {b0.x, b0.y, b0.z, b0.w, b1.x, b1.y, b1.z, b1.w};
      u32x4 o;
#pragma unroll
      for (int e = 0; e < 4; ++e) {
        const float o0 = (y[2 * e] * rs * ga[2 * e] + ba[2 * e] + bon * bflo(vv[e])) * bflo(gg[e]);
        const float o1 = (y[2 * e + 1] * rs * ga[2 * e + 1] + ba[2 * e + 1] + bon * bfhi(vv[e])) * bfhi(gg[e]);
        o[e] = cvtpk(o0, o1);
      }
      *(u32x4*)(yf + i) = o;
    }
  }
}

DEV void mla_mid_phase(const float* __restrict__ cqkv, const float* __restrict__ qn, const float* __restrict__ kvn,
                       const float* __restrict__ ct, const float* __restrict__ st,
                       u16* __restrict__ cqn, u16* __restrict__ ckvn, u16* __restrict__ kpe, int T) {
  const int tid_ = ltid(); const int lane = tid_ & 63, wid = __builtin_amdgcn_readfirstlane(tid_ >> 6);
  for (int tok = blockIdx.x * 8 + wid; tok < GT; tok += gridDim.x * 8) {
    const float* row = cqkv + (size_t)tok * 704;
    float q[6], ss = 0.f;
#pragma unroll
    for (int i = 0; i < 6; ++i) { q[i] = row[lane + i * 64]; ss += q[i] * q[i]; }
    ss = wsum(ss); float sc = rsqrtf(ss * (1.f / 384.f) + 1e-6f);
#pragma unroll
    for (int i = 0; i < 6; ++i) cqn[(size_t)tok * 384 + lane + i * 64] = f2bf(q[i] * sc * qn[lane + i * 64]);
    float c[4]; ss = 0.f;
#pragma unroll
    for (int i = 0; i < 4; ++i) { c[i] = row[384 + lane + i * 64]; ss += c[i] * c[i]; }
    ss = wsum(ss); sc = rsqrtf(ss * (1.f / 256.f) + 1e-6f);
#pragma unroll
    for (int i = 0; i < 4; ++i) ckvn[(size_t)tok * 256 + lane + i * 64] = f2bf(c[i] * sc * kvn[lane + i * 64]);
    const float x = row[640 + lane];
    const float xo = __shfl_xor(x, 32, 64);
    const int pos = tok % T, j = lane & 31;
    const float cs = ct[pos * 32 + j], sn = st[pos * 32 + j];
    const float o = lane < 32 ? x * cs - xo * sn : x * cs + xo * sn;
    kpe[(size_t)tok * 64 + lane] = f2bf(o);
  }
}

constexpr int SHM_V = 16384, SHM_K = 16384, SHM_KP = 8192;
#define KSWZ(row, colB) ((row) * 256 + ((colB) ^ (((row) & 7) << 4)))
#define KPSWZ(row, colB) ((row) * 128 + ((colB) ^ (((row) & 7) << 4)))
constexpr float ATT_SCALE = 0.07216878364870322f;
DEV void partialSM(f32x16& p0, f32x16& p1, float& m_reg, float& mn, float& alpha) {
  constexpr float C = ATT_SCALE * 1.4426950408889634f;
  float pmax = p0[0];
#pragma unroll
  for (int r = 1; r < 16; ++r) pmax = fmaxf(pmax, p0[r]);
#pragma unroll
  for (int r = 0; r < 16; ++r) pmax = fmaxf(pmax, p1[r]);
  { auto rr = __builtin_amdgcn_permlane32_swap(__float_as_uint(pmax), __float_as_uint(pmax), false, false);
    pmax = fmaxf(__uint_as_float(rr[0]), __uint_as_float(rr[1])); }
  if (__builtin_expect(__all(pmax - m_reg <= 8.f / ATT_SCALE), 1)) { mn = m_reg; alpha = 1.f; }
  else { mn = fmaxf(m_reg, pmax); alpha = __builtin_amdgcn_exp2f((m_reg - mn) * C); m_reg = mn; }
  const float mnC = -mn * C;
#pragma unroll
  for (int r = 0; r < 16; ++r) p0[r] = __builtin_amdgcn_exp2f(fmaf(p0[r], C, mnC));
#pragma unroll
  for (int r = 0; r < 16; ++r) p1[r] = __builtin_amdgcn_exp2f(fmaf(p1[r], C, mnC));
}
DEV void finishSM(f32x16& p0, f32x16& p1, float alpha, float& l_reg, bf16x8& pa0, bf16x8& pa1, bf16x8& pa2, bf16x8& pa3) {
  float ps = 0;
#pragma unroll
  for (int r = 0; r < 16; ++r) ps += p0[r];
#pragma unroll
  for (int r = 0; r < 16; ++r) ps += p1[r];
  { auto rr = __builtin_amdgcn_permlane32_swap(__float_as_uint(ps), __float_as_uint(ps), false, false);
    ps = __uint_as_float(rr[0]) + __uint_as_float(rr[1]); }
  l_reg = l_reg * alpha + ps;
#define PK4(PP, BASE, OUT) do { unsigned a0 = cvtpk(PP[BASE + 0], PP[BASE + 1]), a1 = cvtpk(PP[BASE + 2], PP[BASE + 3]);   \
    unsigned b0 = cvtpk(PP[BASE + 4], PP[BASE + 5]), b1 = cvtpk(PP[BASE + 6], PP[BASE + 7]);                              \
    auto r0 = __builtin_amdgcn_permlane32_swap(a0, b0, false, false); auto r1 = __builtin_amdgcn_permlane32_swap(a1, b1, false, false); \
    u32x4 w = {r0[0], r1[0], r0[1], r1[1]}; OUT = *reinterpret_cast<bf16x8*>(&w); } while (0)
  PK4(p0, 0, pa0); PK4(p0, 8, pa1); PK4(p1, 0, pa2); PK4(p1, 8, pa3);
#undef PK4
}
DEV int v_st(int k, int c) { const int kk = (k & ~0xC) | ((k & 4) << 1) | ((k & 8) >> 1); return ((kk >> 3) * 4 + (c >> 5)) * 512 + ((kk & 7) * 32 + (c & 31)) * 2; }
DEV int v_rd_base(int lane) { return ((lane & 3) << 3) | (((lane >> 2) & 3) << 6) | (((lane >> 4) & 1) << 5) | (((lane >> 5) & 1) << 8); }
constexpr int v_rd_off(int d0, int ks, int half) { return d0 * 512 + ks * 4096 + half * 2048; }
template <int OFF> DEV s16x4 tr_read(int vb) {
  s16x4 r; asm volatile("ds_read_b64_tr_b16 %0, %1 offset:%2" : "=&v"(r) : "v"(vb), "i"(OFF) : "memory"); return r;
}
template <int D0> DEV void pv_one(f32x16& od, int vb, bf16x8 pa0, bf16x8 pa1, bf16x8 pa2, bf16x8 pa3) {
  const s16x4 l0 = tr_read<v_rd_off(D0, 0, 0)>(vb), h0 = tr_read<v_rd_off(D0, 0, 1)>(vb), l1 = tr_read<v_rd_off(D0, 1, 0)>(vb), h1 = tr_read<v_rd_off(D0, 1, 1)>(vb);
  const s16x4 l2 = tr_read<v_rd_off(D0, 2, 0)>(vb), h2 = tr_read<v_rd_off(D0, 2, 1)>(vb), l3 = tr_read<v_rd_off(D0, 3, 0)>(vb), h3 = tr_read<v_rd_off(D0, 3, 1)>(vb);
  asm volatile("s_waitcnt lgkmcnt(0)" ::: "memory"); SBAR();
#define PK(L, H) (bf16x8){L[0], L[1], L[2], L[3], H[0], H[1], H[2], H[3]}
  od = __builtin_amdgcn_mfma_f32_32x32x16_bf16(pa0, PK(l0, h0), od, 0, 0, 0);
  od = __builtin_amdgcn_mfma_f32_32x32x16_bf16(pa1, PK(l1, h1), od, 0, 0, 0);
  od = __builtin_amdgcn_mfma_f32_32x32x16_bf16(pa2, PK(l2, h2), od, 0, 0, 0);
  od = __builtin_amdgcn_mfma_f32_32x32x16_bf16(pa3, PK(l3, h3), od, 0, 0, 0);
#undef PK
}

struct AttnP { const u16* q; const u16* kv; const u16* kpe; u16* sg; const float* ct; const float* st; int nseq, T; int dry; };
DEV void attn_phase(const AttnP& a, char* lds) {
  const int tid = ltid(), wid = __builtin_amdgcn_readfirstlane(tid >> 6), lane = tid & 63, r32 = lane & 31, hi = lane >> 5;
  char* V_lds = lds; char* K_lds = lds + 3 * SHM_V; char* KP_lds = lds + 3 * SHM_V + 2 * SHM_K;
  float* wsc = (float*)(lds + 3 * SHM_V + 2 * SHM_K + 2 * SHM_KP) + wid * 64; float* li_l = wsc; float* al_l = wsc + 32;
  const int nqb = a.T / 256, nitems = a.nseq * 16 * nqb, NT = a.T / 64;
  const int sr = tid >> 4, sc = (tid & 15) * 8, vst0 = v_st(sr, sc), vst1 = v_st(32 + sr, sc);
  const int pr = tid >> 3, pc = (tid & 7) * 8;
  const int vb0 = (int)(uintptr_t)V_lds + v_rd_base(lane);
  int kad[4], kpd[4];
#pragma unroll
  for (int q = 0; q < 4; ++q) { kad[q] = KSWZ(r32, q * 32 + hi * 16); kpd[q] = KPSWZ(r32, q * 32 + hi * 16); }
  const int vblk = (gridDim.x & 7) == 0 ? (int)(blockIdx.x & 7) * (int)(gridDim.x >> 3) + (int)(blockIdx.x >> 3) : (int)blockIdx.x;
  for (int it = vblk; it < nitems; it += gridDim.x) {
    const int qb = it % nqb, h = (it / nqb) & 15, b = it / (nqb * 16);
    const size_t sbase = (size_t)b * a.T;
    const int pos = qb * 256 + wid * 32 + r32;
    bf16x8 qr[12];
    {
      const u16* Qw = a.q + (sbase + pos) * 3072 + h * 192 + hi * 8;
#pragma unroll
      for (int d0 = 0; d0 < 12; ++d0) qr[d0] = *(const bf16x8*)(Qw + d0 * 16);
#pragma unroll
      for (int dd = 0; dd < 2; ++dd) {
        const int j0 = dd * 16 + hi * 8;
        const float4 c0 = *(const float4*)(a.ct + pos * 32 + j0), c1 = *(const float4*)(a.ct + pos * 32 + j0 + 4);
        const float4 s0 = *(const float4*)(a.st + pos * 32 + j0), s1 = *(const float4*)(a.st + pos * 32 + j0 + 4);
        const float cs[8] = {c0.x, c0.y, c0.z, c0.w, c1.x, c1.y, c1.z, c1.w};
        const float sn[8] = {s0.x, s0.y, s0.z, s0.w, s1.x, s1.y, s1.z, s1.w};
        u32x4 x1 = *(u32x4*)&qr[8 + dd], x2 = *(u32x4*)&qr[10 + dd], y1, y2;
#pragma unroll
        for (int e = 0; e < 4; ++e) {
          const float a0 = bflo(x1[e]), a1 = bfhi(x1[e]), b0 = bflo(x2[e]), b1 = bfhi(x2[e]);
          y1[e] = cvtpk(a0 * cs[2 * e] - b0 * sn[2 * e], a1 * cs[2 * e + 1] - b1 * sn[2 * e + 1]);
          y2[e] = cvtpk(b0 * cs[2 * e] + a0 * sn[2 * e], b1 * cs[2 * e + 1] + a1 * sn[2 * e + 1]);
        }
        qr[8 + dd] = *(bf16x8*)&y1; qr[10 + dd] = *(bf16x8*)&y2;
      }
    }
    float m_reg = -1e30f, l_reg = 0.f; f32x16 o[4] = {};
    const u16* kvh = a.kv + sbase * 4096 + h * 256;
    const u16* kph = a.kpe + sbase * 64;
    unsigned gv0, gv1, gk0, gk1, gp0;
    {
      auto vsrc = [&](int s_) { const int kk = ((s_ >> 7) << 3) | ((s_ >> 2) & 7); const int k = (kk & ~0xC) | ((kk & 4) << 1) | ((kk & 8) >> 1);
                                const int c = ((s_ >> 5) & 3) * 32 + (s_ & 3) * 8; return (unsigned)(k * 8192 + 256 + c * 2); };
      auto ksrc = [&](int s_) { const int k = s_ >> 4; const int c = (s_ & 15) ^ (k & 7); return (unsigned)(k * 8192 + c * 16); };
      gv0 = vsrc(tid); gv1 = vsrc(tid + 512); gk0 = ksrc(tid); gk1 = ksrc(tid + 512);
      const int kp_ = tid >> 3; gp0 = (unsigned)(kp_ * 128 + (((tid & 7) ^ (kp_ & 7)) * 16));
    }
#define GLDS(SRC, DST) __builtin_amdgcn_global_load_lds((const __attribute__((address_space(1))) void*)(SRC), (__attribute__((address_space(3))) void*)(DST), 16, 0, 0)
#define SDMA(k0, bb, vbuf) do { const char* bK = (const char*)kvh + (size_t)(k0) * 8192; const char* bP = (const char*)kph + (size_t)(k0) * 128; \
    GLDS(bK + gv0, V_lds + (vbuf) * SHM_V + tid * 16); GLDS(bK + gv1, V_lds + (vbuf) * SHM_V + (tid + 512) * 16); \
    GLDS(bK + gk0, K_lds + (bb) * SHM_K + tid * 16);   GLDS(bK + gk1, K_lds + (bb) * SHM_K + (tid + 512) * 16); \
    GLDS(bP + gp0, KP_lds + (bb) * SHM_KP + tid * 16); } while (0)
#define SDMA_WAIT() asm volatile("s_waitcnt vmcnt(0)" ::: "memory")
    __syncthreads();
    SDMA(0, 0, 0); SDMA_WAIT(); __syncthreads();
    const bool grpB = wid >= 4;
    bf16x8 pa0, pa1, pa2, pa3;
    int vcur = 0, vprev = 2;
#define PV_ALL(vbuf) do { const int vb_ = vb0 + (vbuf) * SHM_V; \
      pv_one<0>(o[0], vb_, pa0, pa1, pa2, pa3); pv_one<1>(o[1], vb_, pa0, pa1, pa2, pa3); \
      pv_one<2>(o[2], vb_, pa0, pa1, pa2, pa3); pv_one<3>(o[3], vb_, pa0, pa1, pa2, pa3); } while (0)
    for (int j = 0; j < NT; ++j) {
      const int bb = j & 1;
      const int vnext = vcur == 2 ? 0 : vcur + 1;
      if (j + 1 < NT) SDMA((j + 1) * 64, bb ^ 1, vnext);
      SBAR();
      if (grpB && j > 0) PV_ALL(vprev);
      f32x16 p0 = {}, p1 = {};
      {
        const char* Ks = K_lds + bb * SHM_K; const char* Kp = KP_lds + bb * SHM_KP;
#pragma unroll
        for (int d0 = 0; d0 < 8; ++d0) {
          const bf16x8 b0 = *(const bf16x8*)(Ks + kad[d0 & 3] + (d0 >> 2) * 128), b1 = *(const bf16x8*)(Ks + kad[d0 & 3] + (d0 >> 2) * 128 + 8192);
          p0 = __builtin_amdgcn_mfma_f32_32x32x16_bf16(b0, qr[d0], p0, 0, 0, 0);
          p1 = __builtin_amdgcn_mfma_f32_32x32x16_bf16(b1, qr[d0], p1, 0, 0, 0); }
#pragma unroll
        for (int d0 = 0; d0 < 4; ++d0) {
          const bf16x8 b0 = *(const bf16x8*)(Kp + kpd[d0]), b1 = *(const bf16x8*)(Kp + kpd[d0] + 4096);
          p0 = __builtin_amdgcn_mfma_f32_32x32x16_bf16(b0, qr[8 + d0], p0, 0, 0, 0);
          p1 = __builtin_amdgcn_mfma_f32_32x32x16_bf16(b1, qr[8 + d0], p1, 0, 0, 0); }
      }
      float mn, alpha;
      partialSM(p0, p1, m_reg, mn, alpha);
      if (__any(alpha < 1.f)) {
        if (hi == 0) al_l[r32] = alpha;
        lds_wait();
#pragma unroll
        for (int dd = 0; dd < 4; ++dd)
#pragma unroll
          for (int r = 0; r < 16; ++r) o[dd][r] *= al_l[crow(r, hi)];
      }
      finishSM(p0, p1, alpha, l_reg, pa0, pa1, pa2, pa3); SBAR();
      if (!grpB) PV_ALL(vcur);
      SDMA_WAIT();
      vprev = vcur; vcur = vnext;
      __syncthreads();
    }
    if (grpB) PV_ALL(vprev);
#undef PV_ALL
#undef SDMA
#undef SDMA_WAIT
#undef GLDS
    {
      int t2 = threadIdx.x; asm volatile("" : "+v"(t2));
      const int wid2 = t2 >> 6, r2 = t2 & 31, hi2 = (t2 >> 5) & 1;
      float* li2 = (float*)(lds + 3 * SHM_V + 2 * SHM_K + 2 * SHM_KP) + wid2 * 64;
      if (hi2 == 0) li2[r2] = l_reg;
      lds_wait();
      u16* Ow = a.sg + (sbase + qb * 256 + wid2 * 32) * EI + h * 128 + r2;
#pragma unroll
      for (int r = 0; r < 16; ++r) {
        const int orow = crow(r, hi2);
        const float rl = __builtin_amdgcn_rcpf(li2[orow]);
#pragma unroll
        for (int d0 = 0; d0 < 4; ++d0) {
          u16* pp = Ow + (size_t)orow * EI + d0 * 32;
          if (!a.dry) *pp = f2bf(o[d0][r] * rl * bf2f(*pp));
        }
      }
    }
  }
}

#if MEGA
#define GRID_SYNC() gsync(p, lds)
#else
#define GRID_SYNC() do {} while (0)
#endif
struct Grp { const float* xin0; float* xres; int nseq, T; };
DEV Grp get_group(const P& p, int g) {
  Grp r;
  r.xin0 = g == 0 ? p.x_prompt : p.x_sample + (size_t)(g - 1) * GT * DM;
  r.xres = p.out + (size_t)g * GT * DM;
  r.nseq = g == 0 ? 8 : 1; r.T = g == 0 ? 2048 : 16384;
  return r;
}
template <int LT, int ph>
DEV void run_phase(const P& p, int g, int layer, char* lds) {
  const Grp G = get_group(p, g);
  const int j = layer >> 1;
  const float* xin = layer == 0 ? G.xin0 : G.xres;
  size_t zoff = 0; asm volatile("" : "+s"(zoff));
  char* ws = p.ws + zoff;
  u16* hbuf = (u16*)(ws + O_HBUF);
  u16* sg = (u16*)(ws + O_SG);
  if constexpr (LT == 0) {
    u16 *rb = (u16*)(ws + O_RB), *kb = (u16*)(ws + O_KB), *vb = (u16*)(ws + O_VB), *yf = (u16*)(ws + O_YF), *yb = (u16*)(ws + O_YB);
    u16 *twl = (u16*)(ws + O_TWL), *al = (u16*)(ws + O_AL); float* bon = (float*)(ws + O_BON);
    if constexpr (ph == 0) rms_phase(xin, p.ln_g + layer * DM, hbuf);
    else if constexpr (ph == 1) {
      GemmP q{}; q.A = hbuf; q.lda = DM; q.Bt = (const u16*)(ws + O_WRWIN) + (size_t)j * RW_N * DM; q.K = DM; q.NT = 66;
      q.mu = p.rw_mu + (size_t)j * 6 * DM; q.T = G.T; q.o0 = rb; q.o1 = kb; q.o2 = vb; q.o3 = sg; q.o4 = twl; q.o5 = al;
      lerp_phase(hbuf, q.mu, yf, G.T); GRID_SYNC();
      GemmP w = q; w.A = yf; w.astride = (size_t)GT * DM; w.NT = 32; w.nt0 = 0;
      gemm_phase<LOAD_PLAIN, EPI_RWKV, 4>(w, lds);
      q.NT = 2; q.nt0 = 64;
      gemm_phase<LOAD_LERP, EPI_RWKV, 2>(q, lds);
    } else if constexpr (ph == 2) {
      ScanP s{}; s.r = rb; s.k = kb; s.v = vb; s.twl = twl; s.al = al; s.yf = yf; s.yb = yb; s.bonus = bon;
      s.w0 = p.rw_w0 + (size_t)j * 2 * EI; s.w2 = p.rw_w2 + (size_t)j * 2 * 64 * EI; s.a0 = p.rw_a0 + (size_t)j * 2 * EI; s.a2 = p.rw_a2 + (size_t)j * 2 * 64 * EI;
      s.kk = p.rw_kk + (size_t)j * EI; s.ka = p.rw_ka + (size_t)j * EI; s.rk = p.rw_rk + (size_t)j * EI; s.nseq = G.nseq; s.T = G.T;
      s.tbuf = (float*)hbuf;
      if (G.T > 2048) {
        s.nseg = 16;
        scan_phase(s, lds, 0); GRID_SYNC();
        scan_combine_phase(s, lds); GRID_SYNC();
        scan_phase(s, lds, 1);
      } else { s.nseg = 1; scan_phase(s, lds, 1); }
    } else if constexpr (ph == 3) post_phase(yf, yb, vb, sg, bon, p.rw_lnx_g + (size_t)j * EI, p.rw_lnx_b + (size_t)j * EI);
    else {
      GemmP q{}; q.A = yf; q.lda = EI; q.Bt = (const u16*)(ws + O_WRWOUT) + (size_t)j * DM * EI; q.K = EI; q.NT = 4; q.xin = xin; q.xout = G.xres;
      for (int rep = 1; rep < REP_GEMM; ++rep) { q.dry = (gridDim.x != 12345); gemm_phase<LOAD_PLAIN, EPI_RES, 4>(q, lds); } q.dry = 0;
      gemm_phase<LOAD_PLAIN, EPI_RES, 4>(q, lds);
    }
  } else {
    float* cqkv = (float*)(ws + O_CQKV); u16 *cqn = (u16*)(ws + O_CQN), *ckvn = (u16*)(ws + O_CKVN), *kpe = (u16*)(ws + O_KPE), *qq = (u16*)(ws + O_Q), *kv = (u16*)(ws + O_KV);
    const float* ct = (const float*)(ws + O_COS); const float* st = (const float*)(ws + O_SIN);
    if constexpr (ph == 0) rms_phase(xin, p.ln_g + layer * DM, hbuf);
    else if constexpr (ph == 1) {
      GemmP q{}; q.A = hbuf; q.lda = DM; q.Bt = (const u16*)(ws + O_WMLIN) + (size_t)j * ML_NP * DM; q.K = DM; q.NT = 11; q.of = cqkv; q.o0 = sg;
      for (int rep = 1; rep < REP_GEMM; ++rep) { q.dry = (gridDim.x != 12345); gemm_phase<LOAD_PLAIN, EPI_MLAIN, 4>(q, lds); } q.dry = 0;
      gemm_phase<LOAD_PLAIN, EPI_MLAIN, 4>(q, lds);
    } else if constexpr (ph == 2) mla_mid_phase(cqkv, p.ml_qn + j * 384, p.ml_kvn + j * 256, ct, st, cqn, ckvn, kpe, G.T);
    else if constexpr (ph == 3) {
      GemmP q{}; q.A = cqn; q.lda = 384; q.Bt = (const u16*)(ws + O_WUQ) + (size_t)j * 3072 * 384; q.K = 384; q.NT = 12; q.o0 = qq; q.ldc = 3072;
      for (int rep = 1; rep < REP_GEMM; ++rep) { q.dry = (gridDim.x != 12345); gemm_phase<LOAD_PLAIN, EPI_BF16, 4>(q, lds); } q.dry = 0;
      gemm_phase<LOAD_PLAIN, EPI_BF16, 4>(q, lds);
      GemmP r{}; r.A = ckvn; r.lda = 256; r.Bt = (const u16*)(ws + O_WUKV) + (size_t)j * 4096 * 256; r.K = 256; r.NT = 16; r.o0 = kv; r.ldc = 4096;
      for (int rep = 1; rep < REP_GEMM; ++rep) { r.dry = (gridDim.x != 12345); gemm_phase<LOAD_PLAIN, EPI_BF16, 4>(r, lds); } r.dry = 0;
      gemm_phase<LOAD_PLAIN, EPI_BF16, 4>(r, lds);
    } else if constexpr (ph == 4) {
      AttnP a{}; a.q = qq; a.kv = kv; a.kpe = kpe; a.sg = sg; a.ct = ct; a.st = st; a.nseq = G.nseq; a.T = G.T;
      for (int rep = 1; rep < REP_ATTN; ++rep) { a.dry = (gridDim.x != 12345); attn_phase(a, lds); } a.dry = 0;
      attn_phase(a, lds);
    } else {
      GemmP q{}; q.A = sg; q.lda = EI; q.Bt = (const u16*)(ws + O_WMLOUT) + (size_t)j * DM * EI; q.K = EI; q.NT = 4; q.xin = xin; q.xout = G.xres;
      for (int rep = 1; rep < REP_GEMM; ++rep) { q.dry = (gridDim.x != 12345); gemm_phase<LOAD_PLAIN, EPI_RES, 4>(q, lds); } q.dry = 0;
      gemm_phase<LOAD_PLAIN, EPI_RES, 4>(q, lds);
    }
  }
}


template <int LT, int PH>
__global__ __launch_bounds__(512) void k_phase(P p, int g, int layer) {
  extern __shared__ __attribute__((aligned(16))) char lds[];
  if constexpr (LT == 2) { if constexpr (PH == 0) init_phase(p, lds); else final_phase(p.out, p.final_g); }
  else run_phase<LT, PH>(p, g, layer, lds);
}

#if MEGA
__global__ __launch_bounds__(512) void k_mega(P p) {
  extern __shared__ __attribute__((aligned(16))) char lds[];
  cg::grid_group grid = cg::this_grid();
  {
    unsigned* bar = (unsigned*)(p.ws + O_BAR);
    if (blockIdx.x == 0) for (int i = threadIdx.x; i < XCD_BAR_WORDS; i += 512) bar[i] = 0u;
    if (threadIdx.x == 0) { volatile LAS unsigned* st = (volatile LAS unsigned*)(lds + SHM_BYTES - 16); st[0] = 0u; st[1] = 0u; }
  }
  init_phase(p, lds);
  grid.sync();
  if (threadIdx.x == 0) (void)xb_add(&((unsigned*)(p.ws + O_BAR))[XB_XCNT(xb_xcc_id())], 1u);
  for (int g = 0; g < 3; ++g)
    for (int layer = 0; layer < 4; ++layer) {
      if ((layer & 1) == 0) {
        run_phase<0, 0>(p, g, layer, lds); gsync(p, lds); run_phase<0, 1>(p, g, layer, lds); gsync(p, lds); run_phase<0, 2>(p, g, layer, lds); gsync(p, lds);
        run_phase<0, 3>(p, g, layer, lds); gsync(p, lds); run_phase<0, 4>(p, g, layer, lds); gsync(p, lds);
      } else {
        run_phase<1, 0>(p, g, layer, lds); gsync(p, lds); run_phase<1, 1>(p, g, layer, lds); gsync(p, lds); run_phase<1, 2>(p, g, layer, lds); gsync(p, lds);
        run_phase<1, 3>(p, g, layer, lds); gsync(p, lds); run_phase<1, 4>(p, g, layer, lds); gsync(p, lds); run_phase<1, 5>(p, g, layer, lds); gsync(p, lds);
      }
    }
  final_phase(p.out, p.final_g);
}
#endif

extern "C" void kernel_launch(void* const* d_in, const int* in_sizes, int n_in, void* d_out, int out_size, void* d_ws, size_t ws_size, hipStream_t stream) {
  if (n_in != 22 || ws_size < WS_NEED) { fprintf(stderr, "kernel_launch: bad args n_in %d ws %zu need %zu\n", n_in, ws_size, WS_NEED); return; }
  P p{};
  const float** f = (const float**)&p;
  for (int i = 0; i < 22; ++i) f[i] = (const float*)d_in[i];
  p.out = (float*)d_out; p.ws = (char*)d_ws;
#if MEGA
  static int grid_blocks = 0;
  if (!grid_blocks) {
    hipFuncSetAttribute((const void*)k_mega, hipFuncAttributeMaxDynamicSharedMemorySize, SHM_BYTES);
    int dev = 0, cus = 0, per_cu = 0;
    hipGetDevice(&dev);
    hipDeviceGetAttribute(&cus, hipDeviceAttributeMultiprocessorCount, dev);
    hipOccupancyMaxActiveBlocksPerMultiprocessor(&per_cu, k_mega, 512, SHM_BYTES);
    if (per_cu > 1) per_cu = 1;
    grid_blocks = cus * per_cu;
  }
  void* args[] = {&p};
  hipError_t e = hipLaunchCooperativeKernel((void*)k_mega, dim3(grid_blocks), dim3(512), args, SHM_BYTES, stream);
  if (e != hipSuccess) fprintf(stderr, "cooperative launch failed: %s (grid %d)\n", hipGetErrorString(e), grid_blocks);
#else
  const int NB = 256;
#define LAUNCH(LT, PH, g, layer) do { static int inited = 0; if (!inited) { hipFuncSetAttribute((const void*)k_phase<LT, PH>, hipFuncAttributeMaxDynamicSharedMemorySize, SHM_BYTES); inited = 1; } \
    hipLaunchKernelGGL((k_phase<LT, PH>), dim3(NB), dim3(512), SHM_BYTES, stream, p, g, layer); } while (0)
  LAUNCH(2, 0, 0, 0);
  for (int g = 0; g < 3; ++g)
    for (int layer = 0; layer < 4; ++layer) {
      if ((layer & 1) == 0) { LAUNCH(0, 0, g, layer); LAUNCH(0, 1, g, layer); LAUNCH(0, 2, g, layer); LAUNCH(0, 3, g, layer); LAUNCH(0, 4, g, layer); }
      else { LAUNCH(1, 0, g, layer); LAUNCH(1, 1, g, layer); LAUNCH(1, 2, g, layer); LAUNCH(1, 3, g, layer); LAUNCH(1, 4, g, layer); LAUNCH(1, 5, g, layer); }
    }
  LAUNCH(2, 1, 0, 0);
#endif
}
```

```cpp
#include <hip/hip_runtime.h>
#include <hip/hip_bf16.h>
#include <hip/hip_cooperative_groups.h>
#include <cstdio>
namespace cg = cooperative_groups;

#ifndef REP_GEMM
#define REP_GEMM 1
#endif
#ifndef REP_ATTN
#define REP_ATTN 1
#endif
#ifndef REP_SCAN
#define REP_SCAN 1
#endif
#ifndef MEGA
#define MEGA 1
#endif

typedef unsigned short u16;
using bf16x8 = __attribute__((ext_vector_type(8))) short;
using s16x4  = __attribute__((ext_vector_type(4))) short;
using f32x16 = __attribute__((ext_vector_type(16))) float;
using f32x4  = __attribute__((ext_vector_type(4))) float;
using u32x4  = __attribute__((ext_vector_type(4))) unsigned;
using u32x2  = __attribute__((ext_vector_type(2))) unsigned;
#define DEV __device__ __forceinline__
#define SBAR() __builtin_amdgcn_sched_barrier(0)

constexpr int DM = 1024, EI = 2048, GT = 16384;
constexpr int NTOK = 49152;
constexpr int RW_N = 8448, ML_N = 2752, ML_NP = 2816;
constexpr int SHM_BYTES = 158720;

constexpr size_t alup(size_t x) { return (x + 255) / 256 * 256; }
constexpr size_t O_WRWIN  = 0;
constexpr size_t O_WRWOUT = O_WRWIN  + alup((size_t)2 * RW_N * DM * 2);
constexpr size_t O_WMLIN  = O_WRWOUT + alup((size_t)2 * DM * EI * 2);
constexpr size_t O_WUQ    = O_WMLIN  + alup((size_t)2 * ML_NP * DM * 2);
constexpr size_t O_WUKV   = O_WUQ    + alup((size_t)2 * 3072 * 384 * 2);
constexpr size_t O_WMLOUT = O_WUKV   + alup((size_t)2 * 4096 * 256 * 2);
constexpr size_t O_COS    = O_WMLOUT + alup((size_t)2 * DM * EI * 2);
constexpr size_t O_SIN    = O_COS    + alup((size_t)16384 * 32 * 4);
constexpr size_t O_HBUF   = O_SIN    + alup((size_t)16384 * 32 * 4);
constexpr size_t O_R0     = O_HBUF   + alup((size_t)GT * DM * 2);
constexpr size_t SZ_E = (size_t)GT * EI * 2;
constexpr size_t O_SG   = O_R0;
constexpr size_t O_RB   = O_SG + SZ_E;
constexpr size_t O_KB   = O_RB + SZ_E;
constexpr size_t O_VB   = O_KB + SZ_E;
constexpr size_t O_YF   = O_VB + SZ_E;
constexpr size_t O_YB   = O_YF + SZ_E;
constexpr size_t O_TWL  = O_YB + SZ_E;
constexpr size_t O_AL   = O_TWL + alup((size_t)GT * 128 * 2);
constexpr size_t O_BON  = O_AL  + alup((size_t)GT * 128 * 2);
constexpr size_t O_RW_END = O_BON + alup((size_t)GT * 64 * 4);
constexpr size_t O_CQKV = O_SG + SZ_E;
constexpr size_t O_CQN  = O_CQKV + alup((size_t)GT * 704 * 4);
constexpr size_t O_CKVN = O_CQN  + alup((size_t)GT * 384 * 2);
constexpr size_t O_KPE  = O_CKVN + alup((size_t)GT * 256 * 2);
constexpr size_t O_Q    = O_KPE  + alup((size_t)GT * 64 * 2);
constexpr size_t O_KV   = O_Q    + alup((size_t)GT * 3072 * 2);
constexpr size_t O_ML_END = O_KV + alup((size_t)GT * 4096 * 2);
constexpr size_t O_FLAG = O_RW_END > O_ML_END ? O_RW_END : O_ML_END;
constexpr size_t O_BAR = O_FLAG + 256;
constexpr size_t WS_NEED = O_BAR + 16384;

struct P {
  const float* x_prompt; const float* x_sample; const float* ln_g; const float* final_g;
  const float* rw_mu; const float* rw_in; const float* rw_w0; const float* rw_w2; const float* rw_a0; const float* rw_a2;
  const float* rw_kk; const float* rw_ka; const float* rw_rk; const float* rw_lnx_g; const float* rw_lnx_b; const float* rw_out;
  const float* ml_in; const float* ml_qn; const float* ml_kvn; const float* ml_uq; const float* ml_ukv; const float* ml_out;
  float* out; char* ws;
};

typedef __attribute__((ext_vector_type(2))) __bf16 bf16x2_t;
typedef __attribute__((ext_vector_type(2))) float f32x2_t;
DEV unsigned cvtpk(float lo, float hi) { f32x2_t v = {lo, hi}; bf16x2_t b = __builtin_convertvector(v, bf16x2_t); return __builtin_bit_cast(unsigned, b); }
DEV float bf2f(u16 x) { return __uint_as_float(((unsigned)x) << 16); }
DEV float bflo(unsigned x) { return __uint_as_float(x << 16); }
DEV float bfhi(unsigned x) { return __uint_as_float(x & 0xffff0000u); }
DEV u16 f2bf(float x) { __bf16 b = (__bf16)x; return __builtin_bit_cast(u16, b); }
DEV float wsum(float v) {
#pragma unroll
  for (int o = 32; o >= 1; o >>= 1) v += __shfl_xor(v, o, 64);
  return v;
}
DEV float siluf(float x) { return x / (1.f + __expf(-x)); }
DEV int crow(int r, int hi) { return (r & 3) + 8 * (r >> 2) + 4 * hi; }
DEV int ltid() { int t = threadIdx.x; asm volatile("" : "+v"(t)); return t; }
template <typename T> DEV T gld(size_t base, unsigned off) { return *(const __attribute__((address_space(1))) T*)(base + off); }
template <typename T> DEV void gst(size_t base, unsigned off, T v) { *(__attribute__((address_space(1))) T*)(base + off) = v; }
DEV void lds_wait() { asm volatile("s_waitcnt lgkmcnt(0)" ::: "memory"); }


#define XB_TMO      128
#define XB_XCNT(j)  (256  + 64 * (j))
#define XB_XSUB(j)  (1280 + 64 * (j))
#define XB_XGEN(j)  (2304 + 64 * (j))
#define XB_TOP      3328
#define XB_TOPGEN   3392
#define XCD_BAR_WORDS 3456
#define XB_SPIN_CAP (1u << 22)
#define LAS __attribute__((address_space(3)))
DEV unsigned xb_ld(unsigned* p)              { return __hip_atomic_load(p, __ATOMIC_RELAXED, __HIP_MEMORY_SCOPE_AGENT); }
DEV unsigned xb_add(unsigned* p, unsigned v) { return __hip_atomic_fetch_add(p, v, __ATOMIC_RELAXED, __HIP_MEMORY_SCOPE_AGENT); }
DEV unsigned xb_xcc_id() { return (unsigned)__builtin_amdgcn_s_getreg((3 << 11) | 20) & 0xFu; }
#define XB_SPIN(cond, bar) do { unsigned _sp = 0; while (cond) { __builtin_amdgcn_s_sleep(1); \
    if ((++_sp & 255u) == 0u) { if (xb_ld(&(bar)[XB_TMO])) break; if (_sp > XB_SPIN_CAP) { atomicAdd(&(bar)[XB_TMO], 1u); break; } } } } while (0)
struct XcdBarrier { unsigned* bar; unsigned x; volatile LAS unsigned* st; };
DEV void xcd_barrier_complete(unsigned* bar, unsigned x, unsigned& nloc, unsigned& nx) {
  const unsigned G = gridDim.x * gridDim.y * gridDim.z;
  unsigned sum, cnt, mine, sp = 0u;
  for (;;) {
    sum = 0u; cnt = 0u; mine = 0u;
#pragma unroll
    for (unsigned j = 0; j < 16; ++j) { const unsigned c = xb_ld(&bar[XB_XCNT(j)]); sum += c; cnt += (c > 0u) ? 1u : 0u; mine = (j == x) ? c : mine; }
    if (sum == G) break;
    __builtin_amdgcn_s_sleep(1);
    if ((++sp & 255u) == 0u) { if (xb_ld(&bar[XB_TMO])) break; if (sp > XB_SPIN_CAP) { atomicAdd(&bar[XB_TMO], 1u); break; } }
  }
  nloc = mine > 0u ? mine : 1u; nx = cnt > 0u ? cnt : 1u;
}
DEV void xcd_barrier(const XcdBarrier& b) {
  asm volatile("s_waitcnt vmcnt(0)" ::: "memory");
  __syncthreads();
  if (threadIdx.x == 0) {
    unsigned* bar = b.bar;
    __builtin_amdgcn_s_waitcnt(0);
    unsigned nloc = b.st[0], nx = b.st[1];
    if (nloc == 0u) { xcd_barrier_complete(bar, b.x, nloc, nx); b.st[0] = nloc; b.st[1] = nx; }
    const unsigned old = xb_add(&bar[XB_XSUB(b.x)], 1u);
    const unsigned gen = old / nloc;
    if (old + 1u == (gen + 1u) * nloc) {
      __builtin_amdgcn_fence(__ATOMIC_RELEASE, "agent");
      asm volatile("s_waitcnt vmcnt(0)" ::: "memory");
      const unsigned og = xb_add(&bar[XB_TOP], 1u);
      const unsigned tg = og / nx;
      if (og + 1u == (tg + 1u) * nx) xb_add(&bar[XB_TOPGEN], 1u);
      else XB_SPIN(xb_ld(&bar[XB_TOPGEN]) == tg, bar);
      __builtin_amdgcn_fence(__ATOMIC_ACQUIRE, "agent");
      xb_add(&bar[XB_XGEN(b.x)], 1u);
      asm volatile("s_waitcnt vmcnt(0)" ::: "memory");
    } else {
      XB_SPIN(xb_ld(&bar[XB_XGEN(b.x)]) == gen, bar);
      __builtin_amdgcn_fence(__ATOMIC_ACQUIRE, "agent");
      asm volatile("s_waitcnt vmcnt(0)" ::: "memory");
    }
  }
  __syncthreads();
}
DEV void gsync(const P& p, char* lds) {
  XcdBarrier b; b.bar = (unsigned*)(p.ws + O_BAR); b.x = xb_xcc_id(); b.st = (volatile LAS unsigned*)(lds + SHM_BYTES - 16);
  xcd_barrier(b);
}

DEV void convert_T(const float* __restrict__ src, u16* __restrict__ dst, int K, int N, int Npad, char* lds_) {
  float* lds = (float*)lds_;
  const int tid = ltid(), tk = K / 64, tn = Npad / 64;
  for (int t = blockIdx.x; t < tk * tn; t += gridDim.x) {
    const int k0 = (t % tk) * 64, n0 = (t / tk) * 64;
    __syncthreads();
#pragma unroll
    for (int i = 0; i < 2; ++i) {
      const int kr = (tid >> 4) + i * 32, c = (tid & 15) * 4;
      float4 v = make_float4(0.f, 0.f, 0.f, 0.f);
      if (n0 + c < N) v = *(const float4*)(src + (long)(k0 + kr) * N + n0 + c);
      lds[kr * 65 + c + 0] = v.x; lds[kr * 65 + c + 1] = v.y; lds[kr * 65 + c + 2] = v.z; lds[kr * 65 + c + 3] = v.w;
    }
    __syncthreads();
    const int n = tid >> 3, kc = (tid & 7) * 8;
    u32x4 w;
    w[0] = cvtpk(lds[(kc + 0) * 65 + n], lds[(kc + 1) * 65 + n]);
    w[1] = cvtpk(lds[(kc + 2) * 65 + n], lds[(kc + 3) * 65 + n]);
    w[2] = cvtpk(lds[(kc + 4) * 65 + n], lds[(kc + 5) * 65 + n]);
    w[3] = cvtpk(lds[(kc + 6) * 65 + n], lds[(kc + 7) * 65 + n]);
    *(u32x4*)(dst + (long)(n0 + n) * K + k0 + kc) = w;
  }
}

DEV void init_phase(const P& p, char* lds) {
  for (int j = 0; j < 2; ++j) {
    convert_T(p.rw_in  + (size_t)j * DM * RW_N, (u16*)(p.ws + O_WRWIN)  + (size_t)j * RW_N * DM, DM, RW_N, RW_N, lds);
    convert_T(p.rw_out + (size_t)j * EI * DM,   (u16*)(p.ws + O_WRWOUT) + (size_t)j * DM * EI,   EI, DM, DM, lds);
    convert_T(p.ml_in  + (size_t)j * DM * ML_N, (u16*)(p.ws + O_WMLIN)  + (size_t)j * ML_NP * DM, DM, ML_N, ML_NP, lds);
    convert_T(p.ml_uq  + (size_t)j * 384 * 3072, (u16*)(p.ws + O_WUQ)   + (size_t)j * 3072 * 384, 384, 3072, 3072, lds);
    convert_T(p.ml_ukv + (size_t)j * 256 * 4096, (u16*)(p.ws + O_WUKV)  + (size_t)j * 4096 * 256, 256, 4096, 4096, lds);
    convert_T(p.ml_out + (size_t)j * EI * DM,   (u16*)(p.ws + O_WMLOUT) + (size_t)j * DM * EI,   EI, DM, DM, lds);
  }
  float* ct = (float*)(p.ws + O_COS); float* st = (float*)(p.ws + O_SIN);
  const int tid_ = ltid();
  for (int i = blockIdx.x * 512 + tid_; i < 16384 * 32; i += gridDim.x * 512) {
    const int pos = i >> 5, j = i & 31;
    const float invf = 1.0f / powf(10000.0f, (float)(2 * j) / 64.0f);
    const float ang = (float)pos * invf;
    const double a = (double)ang;
    const double n = rint(a * 0.15915494309189535);
    const float r = (float)(a - n * 6.283185307179586);
    ct[i] = cosf(r); st[i] = sinf(r);
  }
}

DEV void rms_phase(const float* __restrict__ x, const float* __restrict__ g, u16* __restrict__ hout) {
  const int tid_ = ltid(); const int lane = tid_ & 63, wid = __builtin_amdgcn_readfirstlane(tid_ >> 6);
  for (int tok = blockIdx.x * 8 + wid; tok < GT; tok += gridDim.x * 8) {
    const float4* xr = (const float4*)(x + (size_t)tok * DM);
    float4 v[4]; float ss = 0.f;
#pragma unroll
    for (int i = 0; i < 4; ++i) { v[i] = xr[lane + i * 64]; ss += v[i].x * v[i].x + v[i].y * v[i].y + v[i].z * v[i].z + v[i].w * v[i].w; }
    ss = wsum(ss);
    const float sc = rsqrtf(ss * (1.f / DM) + 1e-6f);
#pragma unroll
    for (int i = 0; i < 4; ++i) {
      const float4 gg = ((const float4*)g)[lane + i * 64];
      u32x2 w; w[0] = cvtpk(v[i].x * sc * gg.x, v[i].y * sc * gg.y); w[1] = cvtpk(v[i].z * sc * gg.z, v[i].w * sc * gg.w);
      *(u32x2*)(hout + (size_t)tok * DM + (lane + i * 64) * 4) = w;
    }
  }
}

DEV void final_phase(float* __restrict__ x, const float* __restrict__ g) {
  const int tid_ = ltid(); const int lane = tid_ & 63, wid = __builtin_amdgcn_readfirstlane(tid_ >> 6);
  for (int tok = blockIdx.x * 8 + wid; tok < NTOK; tok += gridDim.x * 8) {
    float4* xr = (float4*)(x + (size_t)tok * DM);
    float4 v[4]; float ss = 0.f;
#pragma unroll
    for (int i = 0; i < 4; ++i) { v[i] = xr[lane + i * 64]; ss += v[i].x * v[i].x + v[i].y * v[i].y + v[i].z * v[i].z + v[i].w * v[i].w; }
    ss = wsum(ss);
    const float sc = rsqrtf(ss * (1.f / DM) + 1e-6f);
#pragma unroll
    for (int i = 0; i < 4; ++i) {
      const float4 gg = ((const float4*)g)[lane + i * 64];
      float4 ov = make_float4(v[i].x * sc * gg.x, v[i].y * sc * gg.y, v[i].z * sc * gg.z, v[i].w * sc * gg.w);
      xr[lane + i * 64] = ov;
    }
  }
}


DEV void lerp_phase(const u16* __restrict__ h, const float* __restrict__ mu, u16* __restrict__ out, int T) {
  const int tid_ = ltid(); const int lane = tid_ & 63, wid = __builtin_amdgcn_readfirstlane(tid_ >> 6);
  for (int tok = blockIdx.x * 8 + wid; tok < GT; tok += gridDim.x * 8) {
    const int pos = tok % T;
#pragma unroll
    for (int half = 0; half < 2; ++half) {
      const int c0 = half * 512 + lane * 8;
      const u32x4 c = *(const u32x4*)(h + (size_t)tok * DM + c0);
      u32x4 pv = {0u, 0u, 0u, 0u}, nx = {0u, 0u, 0u, 0u};
      if (pos > 0) pv = *(const u32x4*)(h + (size_t)(tok - 1) * DM + c0);
      if (pos < T - 1) nx = *(const u32x4*)(h + (size_t)(tok + 1) * DM + c0);
      float hh[8], xx[8];
#pragma unroll
      for (int e = 0; e < 4; ++e) {
        hh[2 * e] = bflo(c[e]); hh[2 * e + 1] = bfhi(c[e]);
        xx[2 * e] = 0.5f * (bflo(pv[e]) + bflo(nx[e])) - hh[2 * e]; xx[2 * e + 1] = 0.5f * (bfhi(pv[e]) + bfhi(nx[e])) - hh[2 * e + 1];
      }
#pragma unroll
      for (int st = 0; st < 4; ++st) {
        const int mi = st == 0 ? 0 : st == 1 ? 2 : st == 2 ? 3 : 5;
        const float4 m0v = *(const float4*)(mu + mi * DM + c0), m1v = *(const float4*)(mu + mi * DM + c0 + 4);
        const float m[8] = {m0v.x, m0v.y, m0v.z, m0v.w, m1v.x, m1v.y, m1v.z, m1v.w};
        u32x4 o;
#pragma unroll
        for (int e = 0; e < 4; ++e) o[e] = cvtpk(hh[2 * e] + m[2 * e] * xx[2 * e], hh[2 * e + 1] + m[2 * e + 1] * xx[2 * e + 1]);
        *(u32x4*)(out + (size_t)st * GT * DM + (size_t)tok * DM + c0) = o;
      }
    }
  }
}

#define GSWZ(row, c16) ((row) * 128 + ((((c16) ^ ((row) >> 1)) & 7) << 4))
constexpr int LOAD_PLAIN = 0, LOAD_LERP = 1;
constexpr int EPI_RWKV = 0, EPI_RES = 1, EPI_MLAIN = 2, EPI_BF16 = 3;
struct GemmP {
  const u16* A; int lda; const u16* Bt; int K; int NT;
  const float* mu;
  int T;
  u16* o0; u16* o1; u16* o2; u16* o3; u16* o4; u16* o5;
  int ldc;
  float* of; const float* xin; float* xout; int dry;
  int nt0; size_t astride;
};

template <int LOAD, int EPI, int NI>
DEV void gemm_phase(const GemmP& g, char* lds) {
  constexpr int BN = 64 * NI, SBB = BN * 128;
  const int tid = ltid(), wid = __builtin_amdgcn_readfirstlane(tid >> 6), lane = tid & 63, r32 = lane & 31, hi = lane >> 5;
  const int wm = wid >> 1, wn = wid & 1;
  char* sA = lds; char* sB = lds + 65536;
  int Kv = g.K; asm volatile("" : "+s"(Kv));
  const int nk = Kv / 64, ntiles = 64 * g.NT;
  const int c16 = tid & 7, rowb = tid >> 3;
  for (int t = blockIdx.x; t < ntiles; t += gridDim.x) {
    const int mt = t & 63, nt = g.nt0 + (t >> 6), m0 = mt * 256, n0 = nt * BN;
    const u16* Ab = g.A + (size_t)(n0 >> 11) * g.astride;
    f32x16 acc[2][NI] = {};
    bf16x8 ra[4], rb[NI];
    const float* mup = nullptr;
    if constexpr (LOAD == LOAD_LERP) {
      const int s = n0 < 2048 ? 0 : n0 < 4096 ? 2 : n0 < 6144 ? 3 : n0 < 8192 ? 5 : n0 == 8192 ? 1 : 4;
      mup = g.mu + s * DM;
    }
    auto gload = [&](int kt) {
      const int k0 = kt * 64 + c16 * 8;
#pragma unroll
      for (int i = 0; i < 4; ++i) {
        const int row = rowb + i * 64; const size_t tok = (size_t)(m0 + row);
        if constexpr (LOAD == LOAD_PLAIN) {
          ra[i] = *(const bf16x8*)(Ab + tok * g.lda + k0);
        } else {
          const int pos = (int)(tok % (size_t)g.T);
          const u32x4 c = *(const u32x4*)(g.A + tok * DM + k0);
          u32x4 pv = {0u, 0u, 0u, 0u}, nx = {0u, 0u, 0u, 0u};
          if (pos > 0) pv = *(const u32x4*)(g.A + (tok - 1) * DM + k0);
          if (pos < g.T - 1) nx = *(const u32x4*)(g.A + (tok + 1) * DM + k0);
          const float4 m0v = *(const float4*)(mup + k0), m1v = *(const float4*)(mup + k0 + 4);
          const float mu[8] = {m0v.x, m0v.y, m0v.z, m0v.w, m1v.x, m1v.y, m1v.z, m1v.w};
          u32x4 o;
#pragma unroll
          for (int e = 0; e < 4; ++e) {
            const float h0 = bflo(c[e]), h1 = bfhi(c[e]);
            const float x0 = 0.5f * (bflo(pv[e]) + bflo(nx[e])) - h0, x1 = 0.5f * (bfhi(pv[e]) + bfhi(nx[e])) - h1;
            o[e] = cvtpk(h0 + mu[2 * e] * x0, h1 + mu[2 * e + 1] * x1);
          }
          ra[i] = *(bf16x8*)&o;
        }
      }
#pragma unroll
      for (int i = 0; i < NI; ++i) {
        const int row = rowb + i * 64;
        rb[i] = *(const bf16x8*)(g.Bt + (size_t)(n0 + row) * Kv + k0);
      }
    };
    auto swrite = [&](int b) {
#pragma unroll
      for (int i = 0; i < 4; ++i) { const int row = rowb + i * 64; *(bf16x8*)(sA + b * 32768 + GSWZ(row, c16)) = ra[i]; }
#pragma unroll
      for (int i = 0; i < NI; ++i) { const int row = rowb + i * 64; *(bf16x8*)(sB + b * SBB + GSWZ(row, c16)) = rb[i]; }
    };
    auto gdma = [&](int kt, int b, int m0_, int n0_, const u16* Ab_) {
      const int cl = c16 ^ ((rowb >> 1) & 7);
#pragma unroll
      for (int i = 0; i < 4; ++i) {
        const u16* src = Ab_ + (size_t)(m0_ + rowb + i * 64) * g.lda + kt * 64 + cl * 8;
        __builtin_amdgcn_global_load_lds((const __attribute__((address_space(1))) void*)src, (__attribute__((address_space(3))) void*)(sA + b * 32768 + (tid + i * 512) * 16), 16, 0, 0);
      }
#pragma unroll
      for (int i = 0; i < NI; ++i) {
        const u16* src = g.Bt + (size_t)(n0_ + rowb + i * 64) * Kv + kt * 64 + cl * 8;
        __builtin_amdgcn_global_load_lds((const __attribute__((address_space(1))) void*)src, (__attribute__((address_space(3))) void*)(sB + b * SBB + (tid + i * 512) * 16), 16, 0, 0);
      }
    };
    if constexpr (LOAD == LOAD_PLAIN) { if (t == (int)blockIdx.x) gdma(0, 0, m0, n0, Ab);
      asm volatile("s_waitcnt vmcnt(0)" ::: "memory"); __syncthreads(); }
    else { gload(0); swrite(0); __syncthreads(); }
    for (int kt = 0; kt < nk; ++kt) {
      const int b = kt & 1;
      if constexpr (LOAD == LOAD_PLAIN) { if (kt + 1 < nk) gdma(kt + 1, b ^ 1, m0, n0, Ab); }
      else { if (kt + 1 < nk) gload(kt + 1); }
      const char* a_ = sA + b * 32768; const char* b_ = sB + b * SBB;
#pragma unroll
      for (int ks = 0; ks < 4; ++ks) {
        bf16x8 af[2], bfr[NI];
#pragma unroll
        for (int mi = 0; mi < 2; ++mi) { const int row = wm * 64 + mi * 32 + r32; af[mi] = *(const bf16x8*)(a_ + GSWZ(row, ks * 2 + hi)); }
#pragma unroll
        for (int ni = 0; ni < NI; ++ni) { const int row = wn * (32 * NI) + ni * 32 + r32; bfr[ni] = *(const bf16x8*)(b_ + GSWZ(row, ks * 2 + hi)); }
#pragma unroll
        for (int mi = 0; mi < 2; ++mi)
#pragma unroll
          for (int ni = 0; ni < NI; ++ni) acc[mi][ni] = __builtin_amdgcn_mfma_f32_32x32x16_bf16(af[mi], bfr[ni], acc[mi][ni], 0, 0, 0);
      }
      if constexpr (LOAD == LOAD_PLAIN) asm volatile("s_waitcnt vmcnt(0)" ::: "memory");
      else { if (kt + 1 < nk) swrite(b ^ 1); }
      __syncthreads();
    }
    if constexpr (LOAD == LOAD_PLAIN) {
      const int tn_ = t + (int)gridDim.x;
      if (tn_ < ntiles) { const int ntn = g.nt0 + (tn_ >> 6), m0n = (tn_ & 63) * 256, n0n = ntn * BN; gdma(0, 0, m0n, n0n, g.A + (size_t)(n0n >> 11) * g.astride); }
    }
    bool wide = false; u16* wdst = nullptr; size_t wld = 0; int wcol0 = 0, wmode = 0;
    if constexpr (NI == 4 && LOAD == LOAD_PLAIN) {
      if constexpr (EPI == EPI_RWKV) { if (n0 < 8192) { const int which = n0 >> 11; wide = true; wdst = which == 0 ? g.o0 : which == 1 ? g.o1 : which == 2 ? g.o2 : g.o3; wld = EI; wcol0 = n0 & 2047; wmode = which == 3; } }
      else if constexpr (EPI == EPI_BF16) { wide = true; wdst = g.o0; wld = (size_t)g.ldc; wcol0 = n0; }
      else if constexpr (EPI == EPI_MLAIN) { if (n0 >= 768 && n0 + 256 <= ML_N) { wide = true; wdst = g.o0; wld = EI; wcol0 = n0 - 704; wmode = 1; } }
    }
    if (wide) {
      if (!g.dry) {
        char* wst = (wid < 4 ? sA + 32768 : sB + SBB) + (wid & 3) * 8192;
#pragma unroll
        for (int mi = 0; mi < 2; ++mi) {
#pragma unroll
          for (int ni = 0; ni < NI; ++ni)
#pragma unroll
            for (int r = 0; r < 16; ++r) {
              const float v = acc[mi][ni][r];
              *(u16*)(wst + crow(r, hi) * 256 + (ni * 32 + r32) * 2) = f2bf(wmode ? siluf(v) : v);
            }
          lds_wait();
#pragma unroll
          for (int i2 = 0; i2 < 8; ++i2) {
            const int row = (lane >> 4) + 4 * i2, ch = lane & 15;
            const u32x4 w = *(const u32x4*)(wst + row * 256 + ch * 16);
            *(u32x4*)(wdst + (size_t)(m0 + wm * 64 + mi * 32 + row) * wld + wcol0 + wn * 128 + ch * 8) = w;
          }
          lds_wait();
        }
      }
    } else
    if (!g.dry)
#pragma unroll
    for (int mi = 0; mi < 2; ++mi)
#pragma unroll
      for (int ni = 0; ni < NI; ++ni)
#pragma unroll
        for (int r = 0; r < 16; ++r) {
          const size_t m = (size_t)(m0 + wm * 64 + mi * 32 + crow(r, hi));
          const int nl = wn * (32 * NI) + ni * 32 + r32, n = n0 + nl;
          const float v = acc[mi][ni][r];
          if constexpr (EPI == EPI_RWKV) {
            if (n0 < 8192) {
              const int which = n0 >> 11, col = n & 2047;
              u16* dst = which == 0 ? g.o0 : which == 1 ? g.o1 : which == 2 ? g.o2 : g.o3;
              dst[m * EI + col] = f2bf(which == 3 ? siluf(v) : v);
            } else if (n0 == 8192) g.o4[m * 128 + nl] = f2bf(tanhf(v));
            else g.o5[m * 128 + nl] = f2bf(v);
          } else if constexpr (EPI == EPI_RES) {
            g.xout[m * DM + n] = g.xin[m * DM + n] + v;
          } else if constexpr (EPI == EPI_MLAIN) {
            if (n < 704) g.of[m * 704 + n] = v;
            else if (n < ML_N) g.o0[m * EI + (n - 704)] = f2bf(siluf(v));
          } else {
            g.o0[m * g.ldc + n] = f2bf(v);
          }
        }
  }
}

struct ScanP {
  const u16 *r, *k, *v, *twl, *al; u16 *yf, *yb; float* bonus;
  const float *w0, *w2, *a0, *a2, *kk, *ka, *rk;
  int nseq, T;
  float* tbuf; int nseg;
};
template <int CTRL> DEV float dppf(float x) {
  return __int_as_float(__builtin_amdgcn_update_dpp(0, __float_as_int(x), CTRL, 0xF, 0xF, false));
}
DEV float row_prefix16(float x) {
  x += dppf<0x111>(x); x += dppf<0x112>(x); x += dppf<0x114>(x); x += dppf<0x118>(x); return x;
}
DEV float row_total16(float x) {
  x += dppf<0x128>(x); x += dppf<0x124>(x); x += dppf<0x122>(x); x += dppf<0x121>(x); return x;
}
DEV bf16x8 pack8(float a0, float a1, float a2, float a3, float a4, float a5, float a6, float a7) {
  u32x4 w = {cvtpk(a0, a1), cvtpk(a2, a3), cvtpk(a4, a5), cvtpk(a6, a7)}; return *(bf16x8*)&w;
}
constexpr int SC_BKT = 0, SC_UVT = 5120, SC_AKM = 10240, SC_RR = 10752, SC_ABF = 11776, SC_Z = 12800, SC_PRM = 17152, SC_T = 18944, SC_WAVE = 35328;
constexpr int SC_PRE = SC_UVT;
constexpr int SC_SHARED_AW = 4 * SC_WAVE;
constexpr int SC_NW = 4;
DEV void scan_phase(const ScanP& s, char* lds_, const int pass) {
  const int tid = ltid(), wid = __builtin_amdgcn_readfirstlane(tid >> 6), lane = tid & 63, c16 = lane & 15, q = lane >> 4;
  const int nchain = s.nseq * 64, nseg = s.nseg;
  const int ipc = pass == 0 ? nseg * 2 : nseg;
  const bool shared = nchain <= (int)gridDim.x;
  const int nsb = shared ? (int)gridDim.x / nchain : 1, sbi = shared ? (int)blockIdx.x / nchain : 0;
  const int nwv = shared ? SC_NW : 2;
  if (shared && sbi >= nsb) return;
  char* wl = lds_ + (wid & 3) * SC_WAVE;
  u16* bkt = (u16*)(wl + SC_BKT); u16* uvt = (u16*)(wl + SC_UVT); u16* akm = (u16*)(wl + SC_AKM); u16* rr = (u16*)(wl + SC_RR);
  float* abf = (float*)(wl + SC_ABF); float* zl = (float*)(wl + SC_Z); float* prm = (float*)(wl + SC_PRM); float* p15l = prm + 320;
  bf16x8* awl = (bf16x8*)(shared ? lds_ + SC_SHARED_AW : lds_ + (2 + (wid & 1)) * SC_WAVE); bf16x8* aal = awl + 512;
#define SCAN_LOAD_W(CHAIN, F0, F1) do { const int d_ = (CHAIN) & 1, h_ = ((CHAIN) >> 1) & 31; \
    for (int f = (F0); f < (F1); ++f) { const int ks = f >> 2, mt = f & 3; u32x4 pw, pa; \
      _Pragma("unroll") for (int e = 0; e < 4; ++e) { const int l0 = ks * 32 + q * 8 + 2 * e; \
        const size_t i0 = ((size_t)(d_ * 64 + l0)) * EI + h_ * 64 + mt * 16 + c16; \
        pw[e] = cvtpk(s.w2[i0], s.w2[i0 + EI]); pa[e] = cvtpk(s.a2[i0], s.a2[i0 + EI]); } \
      awl[f * 64 + lane] = *(bf16x8*)&pw; aal[f * 64 + lane] = *(bf16x8*)&pa; } } while (0)
  if (shared) {
    const int chain_b = (int)blockIdx.x % nchain;
    SCAN_LOAD_W(chain_b, wid, wid + 1);
    __syncthreads();
  }
  if (wid >= nwv) return;
  const int nrounds = shared ? (ipc + nsb * SC_NW - 1) / (nsb * SC_NW) : (nchain + 2 * (int)gridDim.x - 1) / (2 * (int)gridDim.x);
  for (int round = 0; round < nrounds; ++round) {
    const int chain = shared ? (int)blockIdx.x % nchain : (round * 2 + wid) * (int)gridDim.x + (int)blockIdx.x;
    const int it = shared ? sbi * SC_NW + wid + round * nsb * SC_NW : 0;
    if (chain >= nchain || it >= ipc) continue;
    const int kind = pass == 0 ? 1 + (it & 1) : 0;
    const int seg = pass == 0 ? it >> 1 : it;
    const int cs = chain * nseg + seg;
    const int d = chain & 1, h = (chain >> 1) & 31, b = chain >> 6;
    {
      const int ch = h * 64 + lane;
      lds_wait();
      prm[lane] = s.w0[d * EI + ch]; prm[64 + lane] = s.a0[d * EI + ch]; prm[128 + lane] = s.kk[ch]; prm[192 + lane] = s.ka[ch]; prm[256 + lane] = s.rk[ch];
      lds_wait();
    }
    if (!shared) { SCAN_LOAD_W(chain, 0, 8); lds_wait(); }
    const unsigned rowi = (unsigned)(d ? 15 - c16 : c16);
    const unsigned off_tw = rowi * 256u + (unsigned)(q * 16);
    const unsigned off_kr = rowi * 4096u + (unsigned)(h * 128 + q * 8);
    const unsigned off_v  = (unsigned)(h * 128 + lane * 2);
    const unsigned off_y0 = (unsigned)(d ? 15 - 4 * q : 4 * q) * 4096u + (unsigned)(h * 128 + c16 * 2);
    const int ystep = d ? -4096 : 4096;
    f32x4* Tl = (f32x4*)(wl + SC_T);
#pragma unroll
    for (int m = 0; m < 16; ++m) {
      f32x4 t0v = {0.f, 0.f, 0.f, 0.f};
      if (kind == 2) {
        const int mt = m >> 2, nt = m & 3;
        if (mt == nt) { t0v[0] = (4 * q + 0 == c16) ? 1.f : 0.f; t0v[1] = (4 * q + 1 == c16) ? 1.f : 0.f; t0v[2] = (4 * q + 2 == c16) ? 1.f : 0.f; t0v[3] = (4 * q + 3 == c16) ? 1.f : 0.f; }
      } else if (kind == 0 && nseg > 1) {
        t0v = *(const f32x4*)(s.tbuf + ((size_t)cs * 2) * 4096 + (m * 64 + lane) * 4);
      }
      Tl[m * 64 + lane] = t0v;
    }
    u16* yout = d ? s.yb : s.yf;
    const size_t sb = (size_t)b * s.T;
    const int cps = s.T / 16 / nseg, cbeg = seg * cps, cend = cbeg + cps;
    bf16x8 n_tw0, n_tw1, n_ta0, n_ta1; u32x2 n_k[4], n_r[4];
#define SCAN_LOAD(CC) do { const int c0n = d ? (s.T - 16 - (CC) * 16) : (CC) * 16; const size_t t0n = sb + c0n; \
      size_t p_tw = (size_t)s.twl + t0n * 256 + d * 128, p_al = (size_t)s.al + t0n * 256 + d * 128, p_k = (size_t)s.k + t0n * 4096, p_r = (size_t)s.r + t0n * 4096 ; \
      asm volatile("" : "+s"(p_tw), "+s"(p_al), "+s"(p_k), "+s"(p_r)); \
      n_tw0 = gld<bf16x8>(p_tw, off_tw); n_tw1 = gld<bf16x8>(p_tw, off_tw + 64); n_ta0 = gld<bf16x8>(p_al, off_tw); n_ta1 = gld<bf16x8>(p_al, off_tw + 64); \
      _Pragma("unroll") for (int mt = 0; mt < 4; ++mt) { n_k[mt] = gld<u32x2>(p_k, off_kr + mt * 32); n_r[mt] = gld<u32x2>(p_r, off_kr + mt * 32); } } while (0)
    SCAN_LOAD(cbeg);
    for (int cc = cbeg; cc < cend; ++cc) {
      const int c0 = d ? (s.T - 16 - cc * 16) : cc * 16;
      const size_t t0 = sb + c0;
      size_t b_y = (size_t)yout + t0 * 4096, b_bon = (size_t)s.bonus + t0 * 256 + (h * 2 + d) * 4;
      asm volatile("" : "+s"(b_y), "+s"(b_bon));
      size_t b_v = (size_t)s.v + t0 * 4096; asm volatile("" : "+s"(b_v));
      u32x2 n_v[4];
#pragma unroll
      for (int mt = 0; mt < 4; ++mt) n_v[mt] = gld<u32x2>(b_v, off_kr + mt * 32);
      {
        f32x4* wpl = (f32x4*)zl; f32x4* apl = (f32x4*)(wl + SC_PRE);
#pragma unroll
        for (int mt = 0; mt < 4; ++mt) {
          f32x4 cw = {0.f, 0.f, 0.f, 0.f}, ca = {0.f, 0.f, 0.f, 0.f};
          cw = __builtin_amdgcn_mfma_f32_16x16x32_bf16(awl[(0 * 4 + mt) * 64 + lane], n_tw0, cw, 0, 0, 0);
          cw = __builtin_amdgcn_mfma_f32_16x16x32_bf16(awl[(1 * 4 + mt) * 64 + lane], n_tw1, cw, 0, 0, 0);
          ca = __builtin_amdgcn_mfma_f32_16x16x32_bf16(aal[(0 * 4 + mt) * 64 + lane], n_ta0, ca, 0, 0, 0);
          ca = __builtin_amdgcn_mfma_f32_16x16x32_bf16(aal[(1 * 4 + mt) * 64 + lane], n_ta1, ca, 0, 0, 0);
          wpl[mt * 64 + lane] = cw; apl[mt * 64 + lane] = ca;
        }
      }
      float n2 = 0.f;
#pragma unroll
      for (int mt = 0; mt < 4; ++mt) {
        const float4 kkp = *(const float4*)(prm + 128 + mt * 16 + q * 4);
        const float t0 = bflo(n_k[mt][0]) * kkp.x, t1 = bfhi(n_k[mt][0]) * kkp.y, t2 = bflo(n_k[mt][1]) * kkp.z, t3 = bfhi(n_k[mt][1]) * kkp.w;
        n2 += t0 * t0 + t1 * t1 + t2 * t2 + t3 * t3;
      }
      n2 += __shfl_xor(n2, 16, 64); n2 += __shfl_xor(n2, 32, 64);
      const float invn = __builtin_amdgcn_rsqf(fmaxf(n2, 1e-24f));
      float bon = 0.f;
      bf16x8 ktf[2], btf[2], kdf[2], rtf[2];
#pragma unroll
      for (int ks = 0; ks < 2; ++ks) {
        float ktl[8], btl[8], kdl[8], rtl[8];
#pragma unroll
        for (int mh = 0; mh < 2; ++mh) {
          const int mt = 2 * ks + mh;
          const f32x4 cw = ((const f32x4*)zl)[mt * 64 + lane], ca = ((const f32x4*)(wl + SC_PRE))[mt * 64 + lane];
          const float4 w0p = *(const float4*)(prm + mt * 16 + q * 4), a0p = *(const float4*)(prm + 64 + mt * 16 + q * 4);
          const float4 kkp = *(const float4*)(prm + 128 + mt * 16 + q * 4), kap = *(const float4*)(prm + 192 + mt * 16 + q * 4), rkp = *(const float4*)(prm + 256 + mt * 16 + q * 4);
          const float w0a[4] = {w0p.x, w0p.y, w0p.z, w0p.w}, a0a[4] = {a0p.x, a0p.y, a0p.z, a0p.w};
          const float kka[4] = {kkp.x, kkp.y, kkp.z, kkp.w}, kaa[4] = {kap.x, kap.y, kap.z, kap.w}, rka[4] = {rkp.x, rkp.y, rkp.z, rkp.w};
          const u32x2 kr_ = n_k[mt], rr_ = n_r[mt];
          const float kxa[4] = {bflo(kr_[0]), bfhi(kr_[0]), bflo(kr_[1]), bfhi(kr_[1])};
          const float rxa[4] = {bflo(rr_[0]), bfhi(rr_[0]), bflo(rr_[1]), bfhi(rr_[1])};
          float4 p15v;
#pragma unroll
          for (int e = 0; e < 4; ++e) {
            const float wp = cw[e] + w0a[e], ap = ca[e] + a0a[e];
            const float ee = 0.6065306597126334f * __builtin_amdgcn_rcpf(1.f + __expf(-wp));
            const float a = __builtin_amdgcn_rcpf(1.f + __expf(-ap));
            const float kkn = kxa[e] * kka[e] * invn;
            const float kd = kxa[e] * (1.f + (a - 1.f) * kaa[e]);
            const float bb = kkn * a;
            bon += rxa[e] * kd * rka[e];
            const float Ei = row_prefix16(ee);
            const float pm = __expf(-Ei), pp = __builtin_amdgcn_rcpf(pm);
            const float pm1s = dppf<0x111>(pm), pm1 = c16 == 0 ? 1.f : pm1s;
            ktl[mh * 4 + e] = kkn * pm1; btl[mh * 4 + e] = bb * pp; kdl[mh * 4 + e] = kd * pp; rtl[mh * 4 + e] = rxa[e] * pm;
            ((float*)&p15v)[e] = pm;
          }
          if (c16 == 15) *(float4*)(p15l + mt * 16 + q * 4) = p15v;
          SBAR();
        }
        ktf[ks] = pack8(ktl[0], ktl[1], ktl[2], ktl[3], ktl[4], ktl[5], ktl[6], ktl[7]);
        btf[ks] = pack8(btl[0], btl[1], btl[2], btl[3], btl[4], btl[5], btl[6], btl[7]);
        kdf[ks] = pack8(kdl[0], kdl[1], kdl[2], kdl[3], kdl[4], kdl[5], kdl[6], kdl[7]);
        rtf[ks] = pack8(rtl[0], rtl[1], rtl[2], rtl[3], rtl[4], rtl[5], rtl[6], rtl[7]);
        {
          const u32x4 bw_ = *(const u32x4*)&btf[ks], kw_ = *(const u32x4*)&kdf[ks];
#pragma unroll
          for (int w = 0; w < 4; ++w) {
            const int j = (2 * ks + (w >> 1)) * 16 + q * 4 + (w & 1) * 2;
            bkt[j * 40 + c16] = (u16)(bw_[w] & 0xffffu); bkt[(j + 1) * 40 + c16] = (u16)(bw_[w] >> 16);
            bkt[j * 40 + 16 + c16] = (u16)(kw_[w] & 0xffffu); bkt[(j + 1) * 40 + 16 + c16] = (u16)(kw_[w] >> 16);
          }
        }
      }
      bon += __shfl_xor(bon, 16, 64); bon += __shfl_xor(bon, 32, 64);
      if (q == 0 && kind == 0) gst<float>(b_bon, off_tw, bon);
      SBAR();
      SBAR();
#pragma unroll
      for (int mt = 0; mt < 4; ++mt) {
        const int vb_ = (mt * 16 + q * 4) * 40 + 16 + c16;
        const unsigned v0_ = kind == 2 ? 0u : n_v[mt][0], v1_ = kind == 2 ? 0u : n_v[mt][1];
        uvt[vb_] = (u16)(v0_ & 0xffffu); uvt[vb_ + 40] = (u16)(v0_ >> 16);
        uvt[vb_ + 80] = (u16)(v1_ & 0xffffu); uvt[vb_ + 120] = (u16)(v1_ >> 16);
      }
      { const int cn = cc + 1 < cend ? cc + 1 : cc; SCAN_LOAD(cn); }
      SBAR();
      {
        f32x4 AB = {0.f, 0.f, 0.f, 0.f}, AK = AB, RB = AB, RK = AB;
        int qm = q; asm volatile("" : "+v"(qm));
#pragma unroll
        for (int ks = 0; ks < 2; ++ks) {
          AB = __builtin_amdgcn_mfma_f32_16x16x32_bf16(ktf[ks], btf[ks], AB, 0, 0, 0);
          AK = __builtin_amdgcn_mfma_f32_16x16x32_bf16(ktf[ks], kdf[ks], AK, 0, 0, 0);
          RB = __builtin_amdgcn_mfma_f32_16x16x32_bf16(rtf[ks], btf[ks], RB, 0, 0, 0);
          RK = __builtin_amdgcn_mfma_f32_16x16x32_bf16(rtf[ks], kdf[ks], RK, 0, 0, 0);
        }
#pragma unroll
        for (int r = 0; r < 4; ++r) {
          const int i = 4 * qm + r;
          const bool lo = c16 < i, le = c16 <= i;
          abf[i * 16 + c16] = lo ? AB[r] : 0.f;
          akm[i * 16 + c16] = f2bf(lo ? AK[r] : 0.f);
          rr[i * 32 + c16] = f2bf(le ? RB[r] : 0.f);
          rr[i * 32 + 16 + c16] = f2bf(le ? RK[r] : 0.f);
        }
      }
#define TFRAG(ks, nt, OUT) do { const f32x4 ta_ = Tl[((2 * (ks)) * 4 + (nt)) * 64 + lane], tb_ = Tl[((2 * (ks) + 1) * 4 + (nt)) * 64 + lane]; \
        OUT = pack8(ta_[0], ta_[1], ta_[2], ta_[3], tb_[0], tb_[1], tb_[2], tb_[3]); } while (0)
      lds_wait();
      {
        bf16x8 akf = {0, 0, 0, 0, 0, 0, 0, 0};
        if (q < 2) akf = *(const bf16x8*)(akm + c16 * 16 + q * 8);
#pragma unroll
        for (int nt = 0; nt < 4; ++nt) {
          f32x4 z = {0.f, 0.f, 0.f, 0.f};
          bf16x8 tf0, tf1; TFRAG(0, nt, tf0); TFRAG(1, nt, tf1);
          z = __builtin_amdgcn_mfma_f32_16x16x32_bf16(ktf[0], tf0, z, 0, 0, 0);
          z = __builtin_amdgcn_mfma_f32_16x16x32_bf16(ktf[1], tf1, z, 0, 0, 0);
          const bf16x8 vf = *(const bf16x8*)(uvt + (nt * 16 + c16) * 40 + 16 + (q & 1) * 8);
          z = __builtin_amdgcn_mfma_f32_16x16x32_bf16(akf, vf, z, 0, 0, 0);
#pragma unroll
          for (int r = 0; r < 4; ++r) zl[(4 * q + r) * 68 + nt * 16 + c16] = z[r];
        }
      }
      lds_wait();
      SBAR();
      {
        float U[16];
#pragma unroll
        for (int i = 0; i < 16; ++i) {
          float acc = -zl[i * 68 + lane];
#pragma unroll
          for (int s4 = 0; s4 < (i + 3) / 4; ++s4) {
            const float4 a4 = *(const float4*)(abf + i * 16 + s4 * 4);
            if (s4 * 4 + 0 < i) acc -= a4.x * U[s4 * 4 + 0];
            if (s4 * 4 + 1 < i) acc -= a4.y * U[s4 * 4 + 1];
            if (s4 * 4 + 2 < i) acc -= a4.z * U[s4 * 4 + 2];
            if (s4 * 4 + 3 < i) acc -= a4.w * U[s4 * 4 + 3];
          }
          U[i] = acc;
          if ((i & 3) == 3) SBAR();
        }
        *(bf16x8*)(uvt + lane * 40) = pack8(U[0], U[1], U[2], U[3], U[4], U[5], U[6], U[7]);
        *(bf16x8*)(uvt + lane * 40 + 8) = pack8(U[8], U[9], U[10], U[11], U[12], U[13], U[14], U[15]);
      }
      lds_wait();
      SBAR();
      {
        const bf16x8 rrf = *(const bf16x8*)(rr + c16 * 32 + q * 8);
        bf16x8 uvf[4];
#pragma unroll
        for (int nt = 0; nt < 4; ++nt) uvf[nt] = *(const bf16x8*)(uvt + (nt * 16 + c16) * 40 + q * 8);
#pragma unroll
        for (int nt = 0; nt < 4; ++nt) {
          f32x4 y = {0.f, 0.f, 0.f, 0.f};
          bf16x8 tf0, tf1; TFRAG(0, nt, tf0); TFRAG(1, nt, tf1);
          y = __builtin_amdgcn_mfma_f32_16x16x32_bf16(rtf[0], tf0, y, 0, 0, 0);
          y = __builtin_amdgcn_mfma_f32_16x16x32_bf16(rtf[1], tf1, y, 0, 0, 0);
          y = __builtin_amdgcn_mfma_f32_16x16x32_bf16(rrf, uvf[nt], y, 0, 0, 0);
#pragma unroll
          for (int r = 0; r < 4; ++r) { if (kind == 0) gst<u16>(b_y, off_y0 + (unsigned)(r * ystep) + nt * 32, f2bf(y[r])); }
        }
#pragma unroll
        for (int mt = 0; mt < 4; ++mt) {
          const bf16x8 bkf = *(const bf16x8*)(bkt + (mt * 16 + c16) * 40 + q * 8);
          const float4 pq = *(const float4*)(p15l + mt * 16 + q * 4);
#pragma unroll
          for (int nt = 0; nt < 4; ++nt) {
            f32x4 t = __builtin_amdgcn_mfma_f32_16x16x32_bf16(bkf, uvf[nt], Tl[(mt * 4 + nt) * 64 + lane], 0, 0, 0);
            t[0] *= pq.x; t[1] *= pq.y; t[2] *= pq.z; t[3] *= pq.w;
            Tl[(mt * 4 + nt) * 64 + lane] = t;
          }
        }
      }
      lds_wait();
    }
    if (pass == 0) {
      float* dst = s.tbuf + ((size_t)cs * 2 + (kind - 1)) * 4096;
#pragma unroll
      for (int m = 0; m < 16; ++m) *(f32x4*)(dst + (m * 64 + lane) * 4) = Tl[m * 64 + lane];
    }
  }
}

DEV void scan_combine_phase(const ScanP& s, char* lds_) {
  const int tid = ltid(), wid = __builtin_amdgcn_readfirstlane(tid >> 6), lane = tid & 63, c16 = lane & 15, q = lane >> 4;
  if (wid >= 2) return;
  float* til = (float*)(lds_ + wid * 16384);
  const int nchain = s.nseq * 64, nseg = s.nseg;
  for (int chain = wid * gridDim.x + blockIdx.x; chain < nchain; chain += 2 * gridDim.x) {
    f32x4 T[16];
#pragma unroll
    for (int m = 0; m < 16; ++m) T[m] = f32x4{0.f, 0.f, 0.f, 0.f};
    for (int seg = 0; seg < nseg; ++seg) {
      float* tn = s.tbuf + ((size_t)(chain * nseg + seg) * 2) * 4096; const float* ti = tn + 4096;
      lds_wait();
#pragma unroll
      for (int m = 0; m < 16; ++m) *(f32x4*)(til + (m * 64 + lane) * 4) = *(const f32x4*)(ti + (m * 64 + lane) * 4);
      lds_wait();
      f32x4 Tn[16];
#pragma unroll
      for (int m = 0; m < 16; ++m) Tn[m] = *(const f32x4*)(tn + (m * 64 + lane) * 4);
#pragma unroll
      for (int nt = 0; nt < 4; ++nt) {
        bf16x8 bh[2], bl[2];
#pragma unroll
        for (int ks = 0; ks < 2; ++ks) {
          const f32x4 ta = T[(2 * ks) * 4 + nt], tb = T[(2 * ks + 1) * 4 + nt];
          const float x[8] = {ta[0], ta[1], ta[2], ta[3], tb[0], tb[1], tb[2], tb[3]};
          float hf[8], lf[8];
#pragma unroll
          for (int e = 0; e < 8; ++e) { hf[e] = bf2f(f2bf(x[e])); lf[e] = x[e] - hf[e]; }
          bh[ks] = pack8(hf[0], hf[1], hf[2], hf[3], hf[4], hf[5], hf[6], hf[7]);
          bl[ks] = pack8(lf[0], lf[1], lf[2], lf[3], lf[4], lf[5], lf[6], lf[7]);
        }
#pragma unroll
        for (int mt = 0; mt < 4; ++mt) {
          f32x4 acc = Tn[mt * 4 + nt];
#pragma unroll
          for (int ks = 0; ks < 2; ++ks) {
            float x[8];
#pragma unroll
            for (int e = 0; e < 8; ++e) x[e] = til[((mt * 4 + 2 * ks + (e >> 2)) * 64 + ((c16 >> 2) & 3) * 16 + 4 * q + (e & 3)) * 4 + (c16 & 3)];
            float hf[8], lf[8];
#pragma unroll
            for (int e = 0; e < 8; ++e) { hf[e] = bf2f(f2bf(x[e])); lf[e] = x[e] - hf[e]; }
            const bf16x8 ah = pack8(hf[0], hf[1], hf[2], hf[3], hf[4], hf[5], hf[6], hf[7]);
            const bf16x8 al = pack8(lf[0], lf[1], lf[2], lf[3], lf[4], lf[5], lf[6], lf[7]);
            acc = __builtin_amdgcn_mfma_f32_16x16x32_bf16(ah, bh[ks], acc, 0, 0, 0);
            acc = __builtin_amdgcn_mfma_f32_16x16x32_bf16(ah, bl[ks], acc, 0, 0, 0);
            acc = __builtin_amdgcn_mfma_f32_16x16x32_bf16(al, bh[ks], acc, 0, 0, 0);
          }
          Tn[mt * 4 + nt] = acc;
        }
      }
#pragma unroll
      for (int m = 0; m < 16; ++m) { *(f32x4*)(tn + (m * 64 + lane) * 4) = T[m]; T[m] = Tn[m]; }
    }
  }
}

DEV void post_phase(u16* __restrict__ yf, const u16* __restrict__ yb, const u16* __restrict__ v, const u16* __restrict__ sg,
                    const float* __restrict__ bonus, const float* __restrict__ lg, const float* __restrict__ lb) {
  const int tid_ = ltid(); const int lane = tid_ & 63, wid = __builtin_amdgcn_readfirstlane(tid_ >> 6);
  for (int tok = blockIdx.x * 8 + wid; tok < GT; tok += gridDim.x * 8) {
#pragma unroll
    for (int it = 0; it < 4; ++it) {
      const int ch0 = it * 512 + lane * 8, h = ch0 >> 6; const size_t i = (size_t)tok * EI + ch0;
      const u32x4 a = *(const u32x4*)(yf + i), bq = *(const u32x4*)(yb + i), vv = *(const u32x4*)(v + i), gg = *(const u32x4*)(sg + i);
      const float2 bo = *(const float2*)(bonus + ((size_t)tok * 32 + h) * 2);
      float y[8]; float sum = 0.f;
#pragma unroll
      for (int e = 0; e < 4; ++e) { y[2 * e] = bflo(a[e]) + bflo(bq[e]); y[2 * e + 1] = bfhi(a[e]) + bfhi(bq[e]); sum += y[2 * e] + y[2 * e + 1]; }
      sum += __shfl_xor(sum, 1, 64); sum += __shfl_xor(sum, 2, 64); sum += __shfl_xor(sum, 4, 64);
      const float mean = sum * (1.f / 64.f);
      float var = 0.f;
#pragma unroll
      for (int e = 0; e < 8; ++e) { y[e] -= mean; var += y[e] * y[e]; }
      var += __shfl_xor(var, 1, 64); var += __shfl_xor(var, 2, 64); var += __shfl_xor(var, 4, 64);
      const float rs = rsqrtf(var * (1.f / 64.f) + 64e-5f), bon = bo.x + bo.y;
      const float4 g0 = *(const float4*)(lg + ch0), g1 = *(const float4*)(lg + ch0 + 4), b0 = *(const float4*)(lb + ch0), b1 = *(const float4*)(lb + ch0 + 4);
      const float ga[8] = {g0.x, g0.y, g0.z, g0.w, g1.x, g1.y, g1.z, g1.w}, ba[8] = {b0.x, b0.y, b0.z, b0.w, b1.x, b1.y, b1.z, b1.w};
      u32x4 o;
#pragma unroll
      for (int e = 0; e < 4; ++e) {
        const float o0 = (y[2 * e] * rs * ga[2 * e] + ba[2 * e] + bon * bflo(vv[e])) * bflo(gg[e]);
        const float o1 = (y[2 * e + 1] * rs * ga[2 * e + 1] + ba[2 * e + 1] + bon * bfhi(vv[e])) * bfhi(gg[e]);
        o[e] = cvtpk(o0, o1);
      }
      *(u32x4*)(yf + i) = o;
    }
  }
}

DEV void mla_mid_phase(const float* __restrict__ cqkv, const float* __restrict__ qn, const float* __restrict__ kvn,
                       const float* __restrict__ ct, const float* __restrict__ st,
                       u16* __restrict__ cqn, u16* __restrict__ ckvn, u16* __restrict__ kpe, int T) {
  const int tid_ = ltid(); const int lane = tid_ & 63, wid = __builtin_amdgcn_readfirstlane(tid_ >> 6);
  for (int tok = blockIdx.x * 8 + wid; tok < GT; tok += gridDim.x * 8) {
    const float* row = cqkv + (size_t)tok * 704;
    float q[6], ss = 0.f;
#pragma unroll
    for (int i = 0; i < 6; ++i) { q[i] = row[lane + i * 64]; ss += q[i] * q[i]; }
    ss = wsum(ss); float sc = rsqrtf(ss * (1.f / 384.f) + 1e-6f);
#pragma unroll
    for (int i = 0; i < 6; ++i) cqn[(size_t)tok * 384 + lane + i * 64] = f2bf(q[i] * sc * qn[lane + i * 64]);
    float c[4]; ss = 0.f;
#pragma unroll
    for (int i = 0; i < 4; ++i) { c[i] = row[384 + lane + i * 64]; ss += c[i] * c[i]; }
    ss = wsum(ss); sc = rsqrtf(ss * (1.f / 256.f) + 1e-6f);
#pragma unroll
    for (int i = 0; i < 4; ++i) ckvn[(size_t)tok * 256 + lane + i * 64] = f2bf(c[i] * sc * kvn[lane + i * 64]);
    const float x = row[640 + lane];
    const float xo = __shfl_xor(x, 32, 64);
    const int pos = tok % T, j = lane & 31;
    const float cs = ct[pos * 32 + j], sn = st[pos * 32 + j];
    const float o = lane < 32 ? x * cs - xo * sn : x * cs + xo * sn;
    kpe[(size_t)tok * 64 + lane] = f2bf(o);
  }
}

constexpr int SHM_V = 16384, SHM_K = 16384, SHM_KP = 8192;
#define KSWZ(row, colB) ((row) * 256 + ((colB) ^ (((row) & 7) << 4)))
#define KPSWZ(row, colB) ((row) * 128 + ((colB) ^ (((row) & 7) << 4)))
constexpr float ATT_SCALE = 0.07216878364870322f;
DEV void partialSM(f32x16& p0, f32x16& p1, float& m_reg, float& mn, float& alpha) {
  constexpr float C = ATT_SCALE * 1.4426950408889634f;
  float pmax = p0[0];
#pragma unroll
  for (int r = 1; r < 16; ++r) pmax = fmaxf(pmax, p0[r]);
#pragma unroll
  for (int r = 0; r < 16; ++r) pmax = fmaxf(pmax, p1[r]);
  { auto rr = __builtin_amdgcn_permlane32_swap(__float_as_uint(pmax), __float_as_uint(pmax), false, false);
    pmax = fmaxf(__uint_as_float(rr[0]), __uint_as_float(rr[1])); }
  if (__builtin_expect(__all(pmax - m_reg <= 8.f / ATT_SCALE), 1)) { mn = m_reg; alpha = 1.f; }
  else { mn = fmaxf(m_reg, pmax); alpha = __builtin_amdgcn_exp2f((m_reg - mn) * C); m_reg = mn; }
  const float mnC = -mn * C;
#pragma unroll
  for (int r = 0; r < 16; ++r) p0[r] = __builtin_amdgcn_exp2f(fmaf(p0[r], C, mnC));
#pragma unroll
  for (int r = 0; r < 16; ++r) p1[r] = __builtin_amdgcn_exp2f(fmaf(p1[r], C, mnC));
}
DEV void finishSM(f32x16& p0, f32x16& p1, float alpha, float& l_reg, bf16x8& pa0, bf16x8& pa1, bf16x8& pa2, bf16x8& pa3) {
  float ps = 0;
#pragma unroll
  for (int r = 0; r < 16; ++r) ps += p0[r];
#pragma unroll
  for (int r = 0; r < 16; ++r) ps += p1[r];
  { auto rr = __builtin_amdgcn_permlane32_swap(__float_as_uint(ps), __float_as_uint(ps), false, false);
    ps = __uint_as_float(rr[0]) + __uint_as_float(rr[1]); }
  l_reg = l_reg * alpha + ps;
#define PK4(PP, BASE, OUT) do { unsigned a0 = cvtpk(PP[BASE + 0], PP[BASE + 1]), a1 = cvtpk(PP[BASE + 2], PP[BASE + 3]);   \
    unsigned b0 = cvtpk(PP[BASE + 4], PP[BASE + 5]), b1 = cvtpk(PP[BASE + 6], PP[BASE + 7]);                              \
    auto r0 = __builtin_amdgcn_permlane32_swap(a0, b0, false, false); auto r1 = __builtin_amdgcn_permlane32_swap(a1, b1, false, false); \
    u32x4 w = {r0[0], r1[0], r0[1], r1[1]}; OUT = *reinterpret_cast<bf16x8*>(&w); } while (0)
  PK4(p0, 0, pa0); PK4(p0, 8, pa1); PK4(p1, 0, pa2); PK4(p1, 8, pa3);
#undef PK4
}
DEV int v_st(int k, int c) { const int kk = (k & ~0xC) | ((k & 4) << 1) | ((k & 8) >> 1); return ((kk >> 3) * 4 + (c >> 5)) * 512 + ((kk & 7) * 32 + (c & 31)) * 2; }
DEV int v_rd_base(int lane) { return ((lane & 3) << 3) | (((lane >> 2) & 3) << 6) | (((lane >> 4) & 1) << 5) | (((lane >> 5) & 1) << 8); }
constexpr int v_rd_off(int d0, int ks, int half) { return d0 * 512 + ks * 4096 + half * 2048; }
template <int OFF> DEV s16x4 tr_read(int vb) {
  s16x4 r; asm volatile("ds_read_b64_tr_b16 %0, %1 offset:%2" : "=&v"(r) : "v"(vb), "i"(OFF) : "memory"); return r;
}
template <int D0> DEV void pv_one(f32x16& od, int vb, bf16x8 pa0, bf16x8 pa1, bf16x8 pa2, bf16x8 pa3) {
  const s16x4 l0 = tr_read<v_rd_off(D0, 0, 0)>(vb), h0 = tr_read<v_rd_off(D0, 0, 1)>(vb), l1 = tr_read<v_rd_off(D0, 1, 0)>(vb), h1 = tr_read<v_rd_off(D0, 1, 1)>(vb);
  const s16x4 l2 = tr_read<v_rd_off(D0, 2, 0)>(vb), h2 = tr_read<v_rd_off(D0, 2, 1)>(vb), l3 = tr_read<v_rd_off(D0, 3, 0)>(vb), h3 = tr_read<v_rd_off(D0, 3, 1)>(vb);
  asm volatile("s_waitcnt lgkmcnt(0)" ::: "memory"); SBAR();
#define PK(L, H) (bf16x8){L[0], L[1], L[2], L[3], H[0], H[1], H[2], H[3]}
  od = __builtin_amdgcn_mfma_f32_32x32x16_bf16(pa0, PK(l0, h0), od, 0, 0, 0);
  od = __builtin_amdgcn_mfma_f32_32x32x16_bf16(pa1, PK(l1, h1), od, 0, 0, 0);
  od = __builtin_amdgcn_mfma_f32_32x32x16_bf16(pa2, PK(l2, h2), od, 0, 0, 0);
  od = __builtin_amdgcn_mfma_f32_32x32x16_bf16(pa3, PK(l3, h3), od, 0, 0, 0);
#undef PK
}

struct AttnP { const u16* q; const u16* kv; const u16* kpe; u16* sg; const float* ct; const float* st; int nseq, T; int dry; };
DEV void attn_phase(const AttnP& a, char* lds) {
  const int tid = ltid(), wid = __builtin_amdgcn_readfirstlane(tid >> 6), lane = tid & 63, r32 = lane & 31, hi = lane >> 5;
  char* V_lds = lds; char* K_lds = lds + 3 * SHM_V; char* KP_lds = lds + 3 * SHM_V + 2 * SHM_K;
  float* wsc = (float*)(lds + 3 * SHM_V + 2 * SHM_K + 2 * SHM_KP) + wid * 64; float* li_l = wsc; float* al_l = wsc + 32;
  const int nqb = a.T / 256, nitems = a.nseq * 16 * nqb, NT = a.T / 64;
  const int sr = tid >> 4, sc = (tid & 15) * 8, vst0 = v_st(sr, sc), vst1 = v_st(32 + sr, sc);
  const int pr = tid >> 3, pc = (tid & 7) * 8;
  const int vb0 = (int)(uintptr_t)V_lds + v_rd_base(lane);
  int kad[4], kpd[4];
#pragma unroll
  for (int q = 0; q < 4; ++q) { kad[q] = KSWZ(r32, q * 32 + hi * 16); kpd[q] = KPSWZ(r32, q * 32 + hi * 16); }
  const int vblk = (gridDim.x & 7) == 0 ? (int)(blockIdx.x & 7) * (int)(gridDim.x >> 3) + (int)(blockIdx.x >> 3) : (int)blockIdx.x;
  for (int it = vblk; it < nitems; it += gridDim.x) {
    const int qb = it % nqb, h = (it / nqb) & 15, b = it / (nqb * 16);
    const size_t sbase = (size_t)b * a.T;
    const int pos = qb * 256 + wid * 32 + r32;
    bf16x8 qr[12];
    {
      const u16* Qw = a.q + (sbase + pos) * 3072 + h * 192 + hi * 8;
#pragma unroll
      for (int d0 = 0; d0 < 12; ++d0) qr[d0] = *(const bf16x8*)(Qw + d0 * 16);
#pragma unroll
      for (int dd = 0; dd < 2; ++dd) {
        const int j0 = dd * 16 + hi * 8;
        const float4 c0 = *(const float4*)(a.ct + pos * 32 + j0), c1 = *(const float4*)(a.ct + pos * 32 + j0 + 4);
        const float4 s0 = *(const float4*)(a.st + pos * 32 + j0), s1 = *(const float4*)(a.st + pos * 32 + j0 + 4);
        const float cs[8] = {c0.x, c0.y, c0.z, c0.w, c1.x, c1.y, c1.z, c1.w};
        const float sn[8] = {s0.x, s0.y, s0.z, s0.w, s1.x, s1.y, s1.z, s1.w};
        u32x4 x1 = *(u32x4*)&qr[8 + dd], x2 = *(u32x4*)&qr[10 + dd], y1, y2;
#pragma unroll
        for (int e = 0; e < 4; ++e) {
          const float a0 = bflo(x1[e]), a1 = bfhi(x1[e]), b0 = bflo(x2[e]), b1 = bfhi(x2[e]);
          y1[e] = cvtpk(a0 * cs[2 * e] - b0 * sn[2 * e], a1 * cs[2 * e + 1] - b1 * sn[2 * e + 1]);
          y2[e] = cvtpk(b0 * cs[2 * e] + a0 * sn[2 * e], b1 * cs[2 * e + 1] + a1 * sn[2 * e + 1]);
        }
        qr[8 + dd] = *(bf16x8*)&y1; qr[10 + dd] = *(bf16x8*)&y2;
      }
    }
    float m_reg = -1e30f, l_reg = 0.f; f32x16 o[4] = {};
    const u16* kvh = a.kv + sbase * 4096 + h * 256;
    const u16* kph = a.kpe + sbase * 64;
    unsigned gv0, gv1, gk0, gk1, gp0;
    {
      auto vsrc = [&](int s_) { const int kk = ((s_ >> 7) << 3) | ((s_ >> 2) & 7); const int k = (kk & ~0xC) | ((kk & 4) << 1) | ((kk & 8) >> 1);
                                const int c = ((s_ >> 5) & 3) * 32 + (s_ & 3) * 8; return (unsigned)(k * 8192 + 256 + c * 2); };
      auto ksrc = [&](int s_) { const int k = s_ >> 4; const int c = (s_ & 15) ^ (k & 7); return (unsigned)(k * 8192 + c * 16); };
      gv0 = vsrc(tid); gv1 = vsrc(tid + 512); gk0 = ksrc(tid); gk1 = ksrc(tid + 512);
      const int kp_ = tid >> 3; gp0 = (unsigned)(kp_ * 128 + (((tid & 7) ^ (kp_ & 7)) * 16));
    }
#define GLDS(SRC, DST) __builtin_amdgcn_global_load_lds((const __attribute__((address_space(1))) void*)(SRC), (__attribute__((address_space(3))) void*)(DST), 16, 0, 0)
#define SDMA(k0, bb, vbuf) do { const char* bK = (const char*)kvh + (size_t)(k0) * 8192; const char* bP = (const char*)kph + (size_t)(k0) * 128; \
    GLDS(bK + gv0, V_lds + (vbuf) * SHM_V + tid * 16); GLDS(bK + gv1, V_lds + (vbuf) * SHM_V + (tid + 512) * 16); \
    GLDS(bK + gk0, K_lds + (bb) * SHM_K + tid * 16);   GLDS(bK + gk1, K_lds + (bb) * SHM_K + (tid + 512) * 16); \
    GLDS(bP + gp0, KP_lds + (bb) * SHM_KP + tid * 16); } while (0)
#define SDMA_WAIT() asm volatile("s_waitcnt vmcnt(0)" ::: "memory")
    __syncthreads();
    SDMA(0, 0, 0); SDMA_WAIT(); __syncthreads();
    const bool grpB = wid >= 4;
    bf16x8 pa0, pa1, pa2, pa3;
    int vcur = 0, vprev = 2;
#define PV_ALL(vbuf) do { const int vb_ = vb0 + (vbuf) * SHM_V; \
      pv_one<0>(o[0], vb_, pa0, pa1, pa2, pa3); pv_one<1>(o[1], vb_, pa0, pa1, pa2, pa3); \
      pv_one<2>(o[2], vb_, pa0, pa1, pa2, pa3); pv_one<3>(o[3], vb_, pa0, pa1, pa2, pa3); } while (0)
    for (int j = 0; j < NT; ++j) {
      const int bb = j & 1;
      const int vnext = vcur == 2 ? 0 : vcur + 1;
      if (j + 1 < NT) SDMA((j + 1) * 64, bb ^ 1, vnext);
      SBAR();
      if (grpB && j > 0) PV_ALL(vprev);
      f32x16 p0 = {}, p1 = {};
      {
        const char* Ks = K_lds + bb * SHM_K; const char* Kp = KP_lds + bb * SHM_KP;
#pragma unroll
        for (int d0 = 0; d0 < 8; ++d0) {
          const bf16x8 b0 = *(const bf16x8*)(Ks + kad[d0 & 3] + (d0 >> 2) * 128), b1 = *(const bf16x8*)(Ks + kad[d0 & 3] + (d0 >> 2) * 128 + 8192);
          p0 = __builtin_amdgcn_mfma_f32_32x32x16_bf16(b0, qr[d0], p0, 0, 0, 0);
          p1 = __builtin_amdgcn_mfma_f32_32x32x16_bf16(b1, qr[d0], p1, 0, 0, 0); }
#pragma unroll
        for (int d0 = 0; d0 < 4; ++d0) {
          const bf16x8 b0 = *(const bf16x8*)(Kp + kpd[d0]), b1 = *(const bf16x8*)(Kp + kpd[d0] + 4096);
          p0 = __builtin_amdgcn_mfma_f32_32x32x16_bf16(b0, qr[8 + d0], p0, 0, 0, 0);
          p1 = __builtin_amdgcn_mfma_f32_32x32x16_bf16(b1, qr[8 + d0], p1, 0, 0, 0); }
      }
      float mn, alpha;
      partialSM(p0, p1, m_reg, mn, alpha);
      if (__any(alpha < 1.f)) {
        if (hi == 0) al_l[r32] = alpha;
        lds_wait();
#pragma unroll
        for (int dd = 0; dd < 4; ++dd)
#pragma unroll
          for (int r = 0; r < 16; ++r) o[dd][r] *= al_l[crow(r, hi)];
      }
      finishSM(p0, p1, alpha, l_reg, pa0, pa1, pa2, pa3); SBAR();
      if (!grpB) PV_ALL(vcur);
      SDMA_WAIT();
      vprev = vcur; vcur = vnext;
      __syncthreads();
    }
    if (grpB) PV_ALL(vprev);
#undef PV_ALL
#undef SDMA
#undef SDMA_WAIT
#undef GLDS
    {
      int t2 = threadIdx.x; asm volatile("" : "+v"(t2));
      const int wid2 = t2 >> 6, r2 = t2 & 31, hi2 = (t2 >> 5) & 1;
      float* li2 = (float*)(lds + 3 * SHM_V + 2 * SHM_K + 2 * SHM_KP) + wid2 * 64;
      if (hi2 == 0) li2[r2] = l_reg;
      lds_wait();
      u16* Ow = a.sg + (sbase + qb * 256 + wid2 * 32) * EI + h * 128 + r2;
#pragma unroll
      for (int r = 0; r < 16; ++r) {
        const int orow = crow(r, hi2);
        const float rl = __builtin_amdgcn_rcpf(li2[orow]);
#pragma unroll
        for (int d0 = 0; d0 < 4; ++d0) {
          u16* pp = Ow + (size_t)orow * EI + d0 * 32;
          if (!a.dry) *pp = f2bf(o[d0][r] * rl * bf2f(*pp));
        }
      }
    }
  }
}

#if MEGA
#define GRID_SYNC() gsync(p, lds)
#else
#define GRID_SYNC() do {} while (0)
#endif
struct Grp { const float* xin0; float* xres; int nseq, T; };
DEV Grp get_group(const P& p, int g) {
  Grp r;
  r.xin0 = g == 0 ? p.x_prompt : p.x_sample + (size_t)(g - 1) * GT * DM;
  r.xres = p.out + (size_t)g * GT * DM;
  r.nseq = g == 0 ? 8 : 1; r.T = g == 0 ? 2048 : 16384;
  return r;
}
template <int LT, int ph>
DEV void run_phase(const P& p, int g, int layer, char* lds) {
  const Grp G = get_group(p, g);
  const int j = layer >> 1;
  const float* xin = layer == 0 ? G.xin0 : G.xres;
  size_t zoff = 0; asm volatile("" : "+s"(zoff));
  char* ws = p.ws + zoff;
  u16* hbuf = (u16*)(ws + O_HBUF);
  u16* sg = (u16*)(ws + O_SG);
  if constexpr (LT == 0) {
    u16 *rb = (u16*)(ws + O_RB), *kb = (u16*)(ws + O_KB), *vb = (u16*)(ws + O_VB), *yf = (u16*)(ws + O_YF), *yb = (u16*)(ws + O_YB);
    u16 *twl = (u16*)(ws + O_TWL), *al = (u16*)(ws + O_AL); float* bon = (float*)(ws + O_BON);
    if constexpr (ph == 0) rms_phase(xin, p.ln_g + layer * DM, hbuf);
    else if constexpr (ph == 1) {
      GemmP q{}; q.A = hbuf; q.lda = DM; q.Bt = (const u16*)(ws + O_WRWIN) + (size_t)j * RW_N * DM; q.K = DM; q.NT = 66;
      q.mu = p.rw_mu + (size_t)j * 6 * DM; q.T = G.T; q.o0 = rb; q.o1 = kb; q.o2 = vb; q.o3 = sg; q.o4 = twl; q.o5 = al;
      lerp_phase(hbuf, q.mu, yf, G.T); GRID_SYNC();
      GemmP w = q; w.A = yf; w.astride = (size_t)GT * DM; w.NT = 32; w.nt0 = 0;
      gemm_phase<LOAD_PLAIN, EPI_RWKV, 4>(w, lds);
      q.NT = 2; q.nt0 = 64;
      gemm_phase<LOAD_LERP, EPI_RWKV, 2>(q, lds);
    } else if constexpr (ph == 2) {
      ScanP s{}; s.r = rb; s.k = kb; s.v = vb; s.twl = twl; s.al = al; s.yf = yf; s.yb = yb; s.bonus = bon;
      s.w0 = p.rw_w0 + (size_t)j * 2 * EI; s.w2 = p.rw_w2 + (size_t)j * 2 * 64 * EI; s.a0 = p.rw_a0 + (size_t)j * 2 * EI; s.a2 = p.rw_a2 + (size_t)j * 2 * 64 * EI;
      s.kk = p.rw_kk + (size_t)j * EI; s.ka = p.rw_ka + (size_t)j * EI; s.rk = p.rw_rk + (size_t)j * EI; s.nseq = G.nseq; s.T = G.T;
      s.tbuf = (float*)hbuf;
      if (G.T > 2048) {
        s.nseg = 16;
        scan_phase(s, lds, 0); GRID_SYNC();
        scan_combine_phase(s, lds); GRID_SYNC();
        scan_phase(s, lds, 1);
      } else { s.nseg = 1; scan_phase(s, lds, 1); }
    } else if constexpr (ph == 3) post_phase(yf, yb, vb, sg, bon, p.rw_lnx_g + (size_t)j * EI, p.rw_lnx_b + (size_t)j * EI);
    else {
      GemmP q{}; q.A = yf; q.lda = EI; q.Bt = (const u16*)(ws + O_WRWOUT) + (size_t)j * DM * EI; q.K = EI; q.NT = 4; q.xin = xin; q.xout = G.xres;
      for (int rep = 1; rep < REP_GEMM; ++rep) { q.dry = (gridDim.x != 12345); gemm_phase<LOAD_PLAIN, EPI_RES, 4>(q, lds); } q.dry = 0;
      gemm_phase<LOAD_PLAIN, EPI_RES, 4>(q, lds);
    }
  } else {
    float* cqkv = (float*)(ws + O_CQKV); u16 *cqn = (u16*)(ws + O_CQN), *ckvn = (u16*)(ws + O_CKVN), *kpe = (u16*)(ws + O_KPE), *qq = (u16*)(ws + O_Q), *kv = (u16*)(ws + O_KV);
    const float* ct = (const float*)(ws + O_COS); const float* st = (const float*)(ws + O_SIN);
    if constexpr (ph == 0) rms_phase(xin, p.ln_g + layer * DM, hbuf);
    else if constexpr (ph == 1) {
      GemmP q{}; q.A = hbuf; q.lda = DM; q.Bt = (const u16*)(ws + O_WMLIN) + (size_t)j * ML_NP * DM; q.K = DM; q.NT = 11; q.of = cqkv; q.o0 = sg;
      for (int rep = 1; rep < REP_GEMM; ++rep) { q.dry = (gridDim.x != 12345); gemm_phase<LOAD_PLAIN, EPI_MLAIN, 4>(q, lds); } q.dry = 0;
      gemm_phase<LOAD_PLAIN, EPI_MLAIN, 4>(q, lds);
    } else if constexpr (ph == 2) mla_mid_phase(cqkv, p.ml_qn + j * 384, p.ml_kvn + j * 256, ct, st, cqn, ckvn, kpe, G.T);
    else if constexpr (ph == 3) {
      GemmP q{}; q.A = cqn; q.lda = 384; q.Bt = (const u16*)(ws + O_WUQ) + (size_t)j * 3072 * 384; q.K = 384; q.NT = 12; q.o0 = qq; q.ldc = 3072;
      for (int rep = 1; rep < REP_GEMM; ++rep) { q.dry = (gridDim.x != 12345); gemm_phase<LOAD_PLAIN, EPI_BF16, 4>(q, lds); } q.dry = 0;
      gemm_phase<LOAD_PLAIN, EPI_BF16, 4>(q, lds);
      GemmP r{}; r.A = ckvn; r.lda = 256; r.Bt = (const u16*)(ws + O_WUKV) + (size_t)j * 4096 * 256; r.K = 256; r.NT = 16; r.o0 = kv; r.ldc = 4096;
      for (int rep = 1; rep < REP_GEMM; ++rep) { r.dry = (gridDim.x != 12345); gemm_phase<LOAD_PLAIN, EPI_BF16, 4>(r, lds); } r.dry = 0;
      gemm_phase<LOAD_PLAIN, EPI_BF16, 4>(r, lds);
    } else if constexpr (ph == 4) {
      AttnP a{}; a.q = qq; a.kv = kv; a.kpe = kpe; a.sg = sg; a.ct = ct; a.st = st; a.nseq = G.nseq; a.T = G.T;
      for (int rep = 1; rep < REP_ATTN; ++rep) { a.dry = (gridDim.x != 12345); attn_phase(a, lds); } a.dry = 0;
      attn_phase(a, lds);
    } else {
      GemmP q{}; q.A = sg; q.lda = EI; q.Bt = (const u16*)(ws + O_WMLOUT) + (size_t)j * DM * EI; q.K = EI; q.NT = 4; q.xin = xin; q.xout = G.xres;
      for (int rep = 1; rep < REP_GEMM; ++rep) { q.dry = (gridDim.x != 12345); gemm_phase<LOAD_PLAIN, EPI_RES, 4>(q, lds); } q.dry = 0;
      gemm_phase<LOAD_PLAIN, EPI_RES, 4>(q, lds);
    }
  }
}


template <int LT, int PH>
__global__ __launch_bounds__(512) void k_phase(P p, int g, int layer) {
  extern __shared__ __attribute__((aligned(16))) char lds[];
  if constexpr (LT == 2) { if constexpr (PH == 0) init_phase(p, lds); else final_phase(p.out, p.final_g); }
  else run_phase<LT, PH>(p, g, layer, lds);
}

#if MEGA
__global__ __launch_bounds__(512) void k_mega(P p) {
  extern __shared__ __attribute__((aligned(16))) char lds[];
  cg::grid_group grid = cg::this_grid();
  {
    unsigned* bar = (unsigned*)(p.ws + O_BAR);
    if (blockIdx.x == 0) for (int i = threadIdx.x; i < XCD_BAR_WORDS; i += 512) bar[i] = 0u;
    if (threadIdx.x == 0) { volatile LAS unsigned* st = (volatile LAS unsigned*)(lds + SHM_BYTES - 16); st[0] = 0u; st[1] = 0u; }
  }
  init_phase(p, lds);
  grid.sync();
  if (threadIdx.x == 0) (void)xb_add(&((unsigned*)(p.ws + O_BAR))[XB_XCNT(xb_xcc_id())], 1u);
  for (int g = 0; g < 3; ++g)
    for (int layer = 0; layer < 4; ++layer) {
      if ((layer & 1) == 0) {
        run_phase<0, 0>(p, g, layer, lds); gsync(p, lds); run_phase<0, 1>(p, g, layer, lds); gsync(p, lds); run_phase<0, 2>(p, g, layer, lds); gsync(p, lds);
        run_phase<0, 3>(p, g, layer, lds); gsync(p, lds); run_phase<0, 4>(p, g, layer, lds); gsync(p, lds);
      } else {
        run_phase<1, 0>(p, g, layer, lds); gsync(p, lds); run_phase<1, 1>(p, g, layer, lds); gsync(p, lds); run_phase<1, 2>(p, g, layer, lds); gsync(p, lds);
        run_phase<1, 3>(p, g, layer, lds); gsync(p, lds); run_phase<1, 4>(p, g, layer, lds); gsync(p, lds); run_phase<1, 5>(p, g, layer, lds); gsync(p, lds);
      }
    }
  final_phase(p.out, p.final_g);
}
#endif

extern "C" void kernel_launch(void* const* d_in, const int* in_sizes, int n_in, void* d_out, int out_size, void* d_ws, size_t ws_size, hipStream_t stream) {
  if (n_in != 22 || ws_size < WS_NEED) { fprintf(stderr, "kernel_launch: bad args n_in %d ws %zu need %zu\n", n_in, ws_size, WS_NEED); return; }
  P p{};
  const float** f = (const float**)&p;
  for (int i = 0; i < 22; ++i) f[i] = (const float*)d_in[i];
  p.out = (float*)d_out; p.ws = (char*)d_ws;
#if MEGA
  static int grid_blocks = 0;
  if (!grid_blocks) {
    hipFuncSetAttribute((const void*)k_mega, hipFuncAttributeMaxDynamicSharedMemorySize, SHM_BYTES);
    int dev = 0, cus = 0, per_cu = 0;
    hipGetDevice(&dev);
    hipDeviceGetAttribute(&cus, hipDeviceAttributeMultiprocessorCount, dev);
    hipOccupancyMaxActiveBlocksPerMultiprocessor(&per_cu, k_mega, 512, SHM_BYTES);
    if (per_cu > 1) per_cu = 1;
    grid_blocks = cus * per_cu;
  }
  void* args[] = {&p};
  hipError_t e = hipLaunchCooperativeKernel((void*)k_mega, dim3(grid_blocks), dim3(512), args, SHM_BYTES, stream);
  if (e != hipSuccess) fprintf(stderr, "cooperative launch failed: %s (grid %d)\n", hipGetErrorString(e), grid_blocks);
#else
  const int NB = 256;
#define LAUNCH(LT, PH, g, layer) do { static int inited = 0; if (!inited) { hipFuncSetAttribute((const void*)k_phase<LT, PH>, hipFuncAttributeMaxDynamicSharedMemorySize, SHM_BYTES); inited = 1; } \
    hipLaunchKernelGGL((k_phase<LT, PH>), dim3(NB), dim3(512), SHM_BYTES, stream, p, g, layer); } while (0)
  LAUNCH(2, 0, 0, 0);
  for (int g = 0; g < 3; ++g)
    for (int layer = 0; layer < 4; ++layer) {
      if ((layer & 1) == 0) { LAUNCH(0, 0, g, layer); LAUNCH(0, 1, g, layer); LAUNCH(0, 2, g, layer); LAUNCH(0, 3, g, layer); LAUNCH(0, 4, g, layer); }
      else { LAUNCH(1, 0, g, layer); LAUNCH(1, 1, g, layer); LAUNCH(1, 2, g, layer); LAUNCH(1, 3, g, layer); LAUNCH(1, 4, g, layer); LAUNCH(1, 5, g, layer); }
    }
  LAUNCH(2, 1, 0, 0);
#endif
}
```

```cpp
#include <hip/hip_runtime.h>
#include <hip/hip_bf16.h>
#include <hip/hip_cooperative_groups.h>
#include <cstdio>
namespace cg = cooperative_groups;

#ifndef REP_GEMM
#define REP_GEMM 1
#endif
#ifndef REP_ATTN
#define REP_ATTN 1
#endif
#ifndef REP_SCAN
#define REP_SCAN 1
#endif
#ifndef MEGA
#define MEGA 1
#endif

typedef unsigned short u16;
using bf16x8 = __attribute__((ext_vector_type(8))) short;
using s16x4  = __attribute__((ext_vector_type(4))) short;
using f32x16 = __attribute__((ext_vector_type(16))) float;
using f32x4  = __attribute__((ext_vector_type(4))) float;
using u32x4  = __attribute__((ext_vector_type(4))) unsigned;
using u32x2  = __attribute__((ext_vector_type(2))) unsigned;
#define DEV __device__ __forceinline__
#define SBAR() __builtin_amdgcn_sched_barrier(0)

constexpr int DM = 1024, EI = 2048, GT = 16384;
constexpr int NTOK = 49152;
constexpr int RW_N = 8448, ML_N = 2752, ML_NP = 2816;
constexpr int SHM_BYTES = 158720;

constexpr size_t alup(size_t x) { return (x + 255) / 256 * 256; }
constexpr size_t O_WRWIN  = 0;
constexpr size_t O_WRWOUT = O_WRWIN  + alup((size_t)2 * RW_N * DM * 2);
constexpr size_t O_WMLIN  = O_WRWOUT + alup((size_t)2 * DM * EI * 2);
constexpr size_t O_WUQ    = O_WMLIN  + alup((size_t)2 * ML_NP * DM * 2);
constexpr size_t O_WUKV   = O_WUQ    + alup((size_t)2 * 3072 * 384 * 2);
constexpr size_t O_WMLOUT = O_WUKV   + alup((size_t)2 * 4096 * 256 * 2);
constexpr size_t O_COS    = O_WMLOUT + alup((size_t)2 * DM * EI * 2);
constexpr size_t O_SIN    = O_COS    + alup((size_t)16384 * 32 * 4);
constexpr size_t O_HBUF   = O_SIN    + alup((size_t)16384 * 32 * 4);
constexpr size_t O_R0     = O_HBUF   + alup((size_t)GT * DM * 2);
constexpr size_t SZ_E = (size_t)GT * EI * 2;
constexpr size_t O_SG   = O_R0;
constexpr size_t O_RB   = O_SG + SZ_E;
constexpr size_t O_KB   = O_RB + SZ_E;
constexpr size_t O_VB   = O_KB + SZ_E;
constexpr size_t O_YF   = O_VB + SZ_E;
constexpr size_t O_YB   = O_YF + SZ_E;
constexpr size_t O_TWL  = O_YB + SZ_E;
constexpr size_t O_AL   = O_TWL + alup((size_t)GT * 128 * 2);
constexpr size_t O_BON  = O_AL  + alup((size_t)GT * 128 * 2);
constexpr size_t O_RW_END = O_BON + alup((size_t)GT * 64 * 4);
constexpr size_t O_CQKV = O_SG + SZ_E;
constexpr size_t O_CQN  = O_CQKV + alup((size_t)GT * 704 * 4);
constexpr size_t O_CKVN = O_CQN  + alup((size_t)GT * 384 * 2);
constexpr size_t O_KPE  = O_CKVN + alup((size_t)GT * 256 * 2);
constexpr size_t O_Q    = O_KPE  + alup((size_t)GT * 64 * 2);
constexpr size_t O_KV   = O_Q    + alup((size_t)GT * 3072 * 2);
constexpr size_t O_ML_END = O_KV + alup((size_t)GT * 4096 * 2);
constexpr size_t O_FLAG = O_RW_END > O_ML_END ? O_RW_END : O_ML_END;
constexpr size_t O_BAR = O_FLAG + 256;
constexpr size_t WS_NEED = O_BAR + 16384;

struct P {
  const float* x_prompt; const float* x_sample; const float* ln_g; const float* final_g;
  const float* rw_mu; const float* rw_in; const float* rw_w0; const float* rw_w2; const float* rw_a0; const float* rw_a2;
  const float* rw_kk; const float* rw_ka; const float* rw_rk; const float* rw_lnx_g; const float* rw_lnx_b; const float* rw_out;
  const float* ml_in; const float* ml_qn; const float* ml_kvn; const float* ml_uq; const float* ml_ukv; const float* ml_out;
  float* out; char* ws;
};

typedef __attribute__((ext_vector_type(2))) __bf16 bf16x2_t;
typedef __attribute__((ext_vector_type(2))) float f32x2_t;
DEV unsigned cvtpk(float lo, float hi) { f32x2_t v = {lo, hi}; bf16x2_t b = __builtin_convertvector(v, bf16x2_t); return __builtin_bit_cast(unsigned, b); }
DEV float bf2f(u16 x) { return __uint_as_float(((unsigned)x) << 16); }
DEV float bflo(unsigned x) { return __uint_as_float(x << 16); }
DEV float bfhi(unsigned x) { return __uint_as_float(x & 0xffff0000u); }
DEV u16 f2bf(float x) { __bf16 b = (__bf16)x; return __builtin_bit_cast(u16, b); }
DEV float wsum(float v) {
#pragma unroll
  for (int o = 32; o >= 1; o >>= 1) v += __shfl_xor(v, o, 64);
  return v;
}
DEV float siluf(float x) { return x / (1.f + __expf(-x)); }
DEV int crow(int r, int hi) { return (r & 3) + 8 * (r >> 2) + 4 * hi; }
DEV int ltid() { int t = threadIdx.x; asm volatile("" : "+v"(t)); return t; }
template <typename T> DEV T gld(size_t base, unsigned off) { return *(const __attribute__((address_space(1))) T*)(base + off); }
template <typename T> DEV void gst(size_t base, unsigned off, T v) { *(__attribute__((address_space(1))) T*)(base + off) = v; }
DEV void lds_wait() { asm volatile("s_waitcnt lgkmcnt(0)" ::: "memory"); }


#define XB_TMO      128
#define XB_XCNT(j)  (256  + 64 * (j))
#define XB_XSUB(j)  (1280 + 64 * (j))
#define XB_XGEN(j)  (2304 + 64 * (j))
#define XB_TOP      3328
#define XB_TOPGEN   3392
#define XCD_BAR_WORDS 3456
#define XB_SPIN_CAP (1u << 22)
#define LAS __attribute__((address_space(3)))
DEV unsigned xb_ld(unsigned* p)              { return __hip_atomic_load(p, __ATOMIC_RELAXED, __HIP_MEMORY_SCOPE_AGENT); }
DEV unsigned xb_add(unsigned* p, unsigned v) { return __hip_atomic_fetch_add(p, v, __ATOMIC_RELAXED, __HIP_MEMORY_SCOPE_AGENT); }
DEV unsigned xb_xcc_id() { return (unsigned)__builtin_amdgcn_s_getreg((3 << 11) | 20) & 0xFu; }
#define XB_SPIN(cond, bar) do { unsigned _sp = 0; while (cond) { __builtin_amdgcn_s_sleep(1); \
    if ((++_sp & 255u) == 0u) { if (xb_ld(&(bar)[XB_TMO])) break; if (_sp > XB_SPIN_CAP) { atomicAdd(&(bar)[XB_TMO], 1u); break; } } } } while (0)
struct XcdBarrier { unsigned* bar; unsigned x; volatile LAS unsigned* st; };
DEV void xcd_barrier_complete(unsigned* bar, unsigned x, unsigned& nloc, unsigned& nx) {
  const unsigned G = gridDim.x * gridDim.y * gridDim.z;
  unsigned sum, cnt, mine, sp = 0u;
  for (;;) {
    sum = 0u; cnt = 0u; mine = 0u;
#pragma unroll
    for (unsigned j = 0; j < 16; ++j) { const unsigned c = xb_ld(&bar[XB_XCNT(j)]); sum += c; cnt += (c > 0u) ? 1u : 0u; mine = (j == x) ? c : mine; }
    if (sum == G) break;
    __builtin_amdgcn_s_sleep(1);
    if ((++sp & 255u) == 0u) { if (xb_ld(&bar[XB_TMO])) break; if (sp > XB_SPIN_CAP) { atomicAdd(&bar[XB_TMO], 1u); break; } }
  }
  nloc = mine > 0u ? mine : 1u; nx = cnt > 0u ? cnt : 1u;
}
DEV void xcd_barrier(const XcdBarrier& b) {
  asm volatile("s_waitcnt vmcnt(0)" ::: "memory");
  __syncthreads();
  if (threadIdx.x == 0) {
    unsigned* bar = b.bar;
    __builtin_amdgcn_s_waitcnt(0);
    unsigned nloc = b.st[0], nx = b.st[1];
    if (nloc == 0u) { xcd_barrier_complete(bar, b.x, nloc, nx); b.st[0] = nloc; b.st[1] = nx; }
    const unsigned old = xb_add(&bar[XB_XSUB(b.x)], 1u);
    const unsigned gen = old / nloc;
    if (old + 1u == (gen + 1u) * nloc) {
      __builtin_amdgcn_fence(__ATOMIC_RELEASE, "agent");
      asm volatile("s_waitcnt vmcnt(0)" ::: "memory");
      const unsigned og = xb_add(&bar[XB_TOP], 1u);
      const unsigned tg = og / nx;
      if (og + 1u == (tg + 1u) * nx) xb_add(&bar[XB_TOPGEN], 1u);
      else XB_SPIN(xb_ld(&bar[XB_TOPGEN]) == tg, bar);
      __builtin_amdgcn_fence(__ATOMIC_ACQUIRE, "agent");
      xb_add(&bar[XB_XGEN(b.x)], 1u);
      asm volatile("s_waitcnt vmcnt(0)" ::: "memory");
    } else {
      XB_SPIN(xb_ld(&bar[XB_XGEN(b.x)]) == gen, bar);
      __builtin_amdgcn_fence(__ATOMIC_ACQUIRE, "agent");
      asm volatile("s_waitcnt vmcnt(0)" ::: "memory");
    }
  }
  __syncthreads();
}
DEV void gsync(const P& p, char* lds) {
  XcdBarrier b; b.bar = (unsigned*)(p.ws + O_BAR); b.x = xb_xcc_id(); b.st = (volatile LAS unsigned*)(lds + SHM_BYTES - 16);
  xcd_barrier(b);
}

DEV void convert_T(const float* __restrict__ src, u16* __restrict__ dst, int K, int N, int Npad, char* lds_) {
  float* lds = (float*)lds_;
  const int tid = ltid(), tk = K / 64, tn = Npad / 64;
  for (int t = blockIdx.x; t < tk * tn; t += gridDim.x) {
    const int k0 = (t % tk) * 64, n0 = (t / tk) * 64;
    __syncthreads();
#pragma unroll
    for (int i = 0; i < 2; ++i) {
      const int kr = (tid >> 4) + i * 32, c = (tid & 15) * 4;
      float4 v = make_float4(0.f, 0.f, 0.f, 0.f);
      if (n0 + c < N) v = *(const float4*)(src + (long)(k0 + kr) * N + n0 + c);
      lds[kr * 65 + c + 0] = v.x; lds[kr * 65 + c + 1] = v.y; lds[kr * 65 + c + 2] = v.z; lds[kr * 65 + c + 3] = v.w;
    }
    __syncthreads();
    const int n = tid >> 3, kc = (tid & 7) * 8;
    u32x4 w;
    w[0] = cvtpk(lds[(kc + 0) * 65 + n], lds[(kc + 1) * 65 + n]);
    w[1] = cvtpk(lds[(kc + 2) * 65 + n], lds[(kc + 3) * 65 + n]);
    w[2] = cvtpk(lds[(kc + 4) * 65 + n], lds[(kc + 5) * 65 + n]);
    w[3] = cvtpk(lds[(kc + 6) * 65 + n], lds[(kc + 7) * 65 + n]);
    *(u32x4*)(dst + (long)(n0 + n) * K + k0 + kc) = w;
  }
}

DEV void init_phase(const P& p, char* lds) {
  for (int j = 0; j < 2; ++j) {
    convert_T(p.rw_in  + (size_t)j * DM * RW_N, (u16*)(p.ws + O_WRWIN)  + (size_t)j * RW_N * DM, DM, RW_N, RW_N, lds);
    convert_T(p.rw_out + (size_t)j * EI * DM,   (u16*)(p.ws + O_WRWOUT) + (size_t)j * DM * EI,   EI, DM, DM, lds);
    convert_T(p.ml_in  + (size_t)j * DM * ML_N, (u16*)(p.ws + O_WMLIN)  + (size_t)j * ML_NP * DM, DM, ML_N, ML_NP, lds);
    convert_T(p.ml_uq  + (size_t)j * 384 * 3072, (u16*)(p.ws + O_WUQ)   + (size_t)j * 3072 * 384, 384, 3072, 3072, lds);
    convert_T(p.ml_ukv + (size_t)j * 256 * 4096, (u16*)(p.ws + O_WUKV)  + (size_t)j * 4096 * 256, 256, 4096, 4096, lds);
    convert_T(p.ml_out + (size_t)j * EI * DM,   (u16*)(p.ws + O_WMLOUT) + (size_t)j * DM * EI,   EI, DM, DM, lds);
  }
  float* ct = (float*)(p.ws + O_COS); float* st = (float*)(p.ws + O_SIN);
  const int tid_ = ltid();
  for (int i = blockIdx.x * 512 + tid_; i < 16384 * 32; i += gridDim.x * 512) {
    const int pos = i >> 5, j = i & 31;
    const float invf = 1.0f / powf(10000.0f, (float)(2 * j) / 64.0f);
    const float ang = (float)pos * invf;
    const double a = (double)ang;
    const double n = rint(a * 0.15915494309189535);
    const float r = (float)(a - n * 6.283185307179586);
    ct[i] = cosf(r); st[i] = sinf(r);
  }
}

DEV void rms_phase(const float* __restrict__ x, const float* __restrict__ g, u16* __restrict__ hout) {
  const int tid_ = ltid(); const int lane = tid_ & 63, wid = __builtin_amdgcn_readfirstlane(tid_ >> 6);
  for (int tok = blockIdx.x * 8 + wid; tok < GT; tok += gridDim.x * 8) {
    const float4* xr = (const float4*)(x + (size_t)tok * DM);
    float4 v[4]; float ss = 0.f;
#pragma unroll
    for (int i = 0; i < 4; ++i) { v[i] = xr[lane + i * 64]; ss += v[i].x * v[i].x + v[i].y * v[i].y + v[i].z * v[i].z + v[i].w * v[i].w; }
    ss = wsum(ss);
    const float sc = rsqrtf(ss * (1.f / DM) + 1e-6f);
#pragma unroll
    for (int i = 0; i < 4; ++i) {
      const float4 gg = ((const float4*)g)[lane + i * 64];
      u32x2 w; w[0] = cvtpk(v[i].x * sc * gg.x, v[i].y * sc * gg.y); w[1] = cvtpk(v[i].z * sc * gg.z, v[i].w * sc * gg.w);
      *(u32x2*)(hout + (size_t)tok * DM + (lane + i * 64) * 4) = w;
    }
  }
}

DEV void final_phase(float* __restrict__ x, const float* __restrict__ g) {
  const int tid_ = ltid(); const int lane = tid_ & 63, wid = __builtin_amdgcn_readfirstlane(tid_ >> 6);
  for (int tok = blockIdx.x * 8 + wid; tok < NTOK; tok += gridDim.x * 8) {
    float4* xr = (float4*)(x + (size_t)tok * DM);
    float4 v[4]; float ss = 0.f;
#pragma unroll
    for (int i = 0; i < 4; ++i) { v[i] = xr[lane + i * 64]; ss += v[i].x * v[i].x + v[i].y * v[i].y + v[i].z * v[i].z + v[i].w * v[i].w; }
    ss = wsum(ss);
    const float sc = rsqrtf(ss * (1.f / DM) + 1e-6f);
#pragma unroll
    for (int i = 0; i < 4; ++i) {
      const float4 gg = ((const float4*)g)[lane + i * 64];
      float4 ov = make_float4(v[i].x * sc * gg.x, v[i].y * sc * gg.y, v[i].z * sc * gg.z, v[i].w * sc * gg.w);
      xr[lane + i * 64] = ov;
    }
  }
}


DEV void lerp_phase(const u16* __restrict__ h, const float* __restrict__ mu, u16* __restrict__ out, int T) {
  const int tid_ = ltid(); const int lane = tid_ & 63, wid = __builtin_amdgcn_readfirstlane(tid_ >> 6);
  for (int tok = blockIdx.x * 8 + wid; tok < GT; tok += gridDim.x * 8) {
    const int pos = tok % T;
#pragma unroll
    for (int half = 0; half < 2; ++half) {
      const int c0 = half * 512 + lane * 8;
      const u32x4 c = *(const u32x4*)(h + (size_t)tok * DM + c0);
      u32x4 pv = {0u, 0u, 0u, 0u}, nx = {0u, 0u, 0u, 0u};
      if (pos > 0) pv = *(const u32x4*)(h + (size_t)(tok - 1) * DM + c0);
      if (pos < T - 1) nx = *(const u32x4*)(h + (size_t)(tok + 1) * DM + c0);
      float hh[8], xx[8];
#pragma unroll
      for (int e = 0; e < 4; ++e) {
        hh[2 * e] = bflo(c[e]); hh[2 * e + 1] = bfhi(c[e]);
        xx[2 * e] = 0.5f * (bflo(pv[e]) + bflo(nx[e])) - hh[2 * e]; xx[2 * e + 1] = 0.5f * (bfhi(pv[e]) + bfhi(nx[e])) - hh[2 * e + 1];
      }
#pragma unroll
      for (int st = 0; st < 4; ++st) {
        const int mi = st == 0 ? 0 : st == 1 ? 2 : st == 2 ? 3 : 5;
        const float4 m0v = *(const float4*)(mu + mi * DM + c0), m1v = *(const float4*)(mu + mi * DM + c0 + 4);
        const float m[8] = {m0v.x, m0v.y, m0v.z, m0v.w, m1v.x, m1v.y, m1v.z, m1v.w};
        u32x4 o;
#pragma unroll
        for (int e = 0; e < 4; ++e) o[e] = cvtpk(hh[2 * e] + m[2 * e] * xx[2 * e], hh[2 * e + 1] + m[2 * e + 1] * xx[2 * e + 1]);
        *(u32x4*)(out + (size_t)st * GT * DM + (size_t)tok * DM + c0) = o;
      }
    }
  }
}

#define GSWZ(row, c16) ((row) * 128 + ((((c16) ^ ((row) >> 1)) & 7) << 4))
constexpr int LOAD_PLAIN = 0, LOAD_LERP = 1;
constexpr int EPI_RWKV = 0, EPI_RES = 1, EPI_MLAIN = 2, EPI_BF16 = 3;
struct GemmP {
  const u16* A; int lda; const u16* Bt; int K; int NT;
  const float* mu;
  int T;
  u16* o0; u16* o1; u16* o2; u16* o3; u16* o4; u16* o5;
  int ldc;
  float* of; const float* xin; float* xout; int dry;
  int nt0; size_t astride;
};

template <int LOAD, int EPI, int NI>
DEV void gemm_phase(const GemmP& g, char* lds) {
  constexpr int BN = 64 * NI, SBB = BN * 128;
  const int tid = ltid(), wid = __builtin_amdgcn_readfirstlane(tid >> 6), lane = tid & 63, r32 = lane & 31, hi = lane >> 5;
  const int wm = wid >> 1, wn = wid & 1;
  char* sA = lds; char* sB = lds + 65536;
  int Kv = g.K; asm volatile("" : "+s"(Kv));
  const int nk = Kv / 64, ntiles = 64 * g.NT;
  const int c16 = tid & 7, rowb = tid >> 3;
  for (int t = blockIdx.x; t < ntiles; t += gridDim.x) {
    const int mt = t & 63, nt = g.nt0 + (t >> 6), m0 = mt * 256, n0 = nt * BN;
    const u16* Ab = g.A + (size_t)(n0 >> 11) * g.astride;
    f32x16 acc[2][NI] = {};
    bf16x8 ra[4], rb[NI];
    const float* mup = nullptr;
    if constexpr (LOAD == LOAD_LERP) {
      const int s = n0 < 2048 ? 0 : n0 < 4096 ? 2 : n0 < 6144 ? 3 : n0 < 8192 ? 5 : n0 == 8192 ? 1 : 4;
      mup = g.mu + s * DM;
    }
    auto gload = [&](int kt) {
      const int k0 = kt * 64 + c16 * 8;
#pragma unroll
      for (int i = 0; i < 4; ++i) {
        const int row = rowb + i * 64; const size_t tok = (size_t)(m0 + row);
        if constexpr (LOAD == LOAD_PLAIN) {
          ra[i] = *(const bf16x8*)(Ab + tok * g.lda + k0);
        } else {
          const int pos = (int)(tok % (size_t)g.T);
          const u32x4 c = *(const u32x4*)(g.A + tok * DM + k0);
          u32x4 pv = {0u, 0u, 0u, 0u}, nx = {0u, 0u, 0u, 0u};
          if (pos > 0) pv = *(const u32x4*)(g.A + (tok - 1) * DM + k0);
          if (pos < g.T - 1) nx = *(const u32x4*)(g.A + (tok + 1) * DM + k0);
          const float4 m0v = *(const float4*)(mup + k0), m1v = *(const float4*)(mup + k0 + 4);
          const float mu[8] = {m0v.x, m0v.y, m0v.z, m0v.w, m1v.x, m1v.y, m1v.z, m1v.w};
          u32x4 o;
#pragma unroll
          for (int e = 0; e < 4; ++e) {
            const float h0 = bflo(c[e]), h1 = bfhi(c[e]);
            const float x0 = 0.5f * (bflo(pv[e]) + bflo(nx[e])) - h0, x1 = 0.5f * (bfhi(pv[e]) + bfhi(nx[e])) - h1;
            o[e] = cvtpk(h0 + mu[2 * e] * x0, h1 + mu[2 * e + 1] * x1);
          }
          ra[i] = *(bf16x8*)&o;
        }
      }
#pragma unroll
      for (int i = 0; i < NI; ++i) {
        const int row = rowb + i * 64;
        rb[i] = *(const bf16x8*)(g.Bt + (size_t)(n0 + row) * Kv + k0);
      }
    };
    auto swrite = [&](int b) {
#pragma unroll
      for (int i = 0; i < 4; ++i) { const int row = rowb + i * 64; *(bf16x8*)(sA + b * 32768 + GSWZ(row, c16)) = ra[i]; }
#pragma unroll
      for (int i = 0; i < NI; ++i) { const int row = rowb + i * 64; *(bf16x8*)(sB + b * SBB + GSWZ(row, c16)) = rb[i]; }
    };
    auto gdma = [&](int kt, int b, int m0_, int n0_, const u16* Ab_) {
      const int cl = c16 ^ ((rowb >> 1) & 7);
#pragma unroll
      for (int i = 0; i < 4; ++i) {
        const u16* src = Ab_ + (size_t)(m0_ + rowb + i * 64) * g.lda + kt * 64 + cl * 8;
        __builtin_amdgcn_global_load_lds((const __attribute__((address_space(1))) void*)src, (__attribute__((address_space(3))) void*)(sA + b * 32768 + (tid + i * 512) * 16), 16, 0, 0);
      }
#pragma unroll
      for (int i = 0; i < NI; ++i) {
        const u16* src = g.Bt + (size_t)(n0_ + rowb + i * 64) * Kv + kt * 64 + cl * 8;
        __builtin_amdgcn_global_load_lds((const __attribute__((address_space(1))) void*)src, (__attribute__((address_space(3))) void*)(sB + b * SBB + (tid + i * 512) * 16), 16, 0, 0);
      }
    };
    if constexpr (LOAD == LOAD_PLAIN) { if (t == (int)blockIdx.x) gdma(0, 0, m0, n0, Ab);
      asm volatile("s_waitcnt vmcnt(0)" ::: "memory"); __syncthreads(); }
    else { gload(0); swrite(0); __syncthreads(); }
    for (int kt = 0; kt < nk; ++kt) {
      const int b = kt & 1;
      if constexpr (LOAD == LOAD_PLAIN) { if (kt + 1 < nk) gdma(kt + 1, b ^ 1, m0, n0, Ab); }
      else { if (kt + 1 < nk) gload(kt + 1); }
      const char* a_ = sA + b * 32768; const char* b_ = sB + b * SBB;
#pragma unroll
      for (int ks = 0; ks < 4; ++ks) {
        bf16x8 af[2], bfr[NI];
#pragma unroll
        for (int mi = 0; mi < 2; ++mi) { const int row = wm * 64 + mi * 32 + r32; af[mi] = *(const bf16x8*)(a_ + GSWZ(row, ks * 2 + hi)); }
#pragma unroll
        for (int ni = 0; ni < NI; ++ni) { const int row = wn * (32 * NI) + ni * 32 + r32; bfr[ni] = *(const bf16x8*)(b_ + GSWZ(row, ks * 2 + hi)); }
#pragma unroll
        for (int mi = 0; mi < 2; ++mi)
#pragma unroll
          for (int ni = 0; ni < NI; ++ni) acc[mi][ni] = __builtin_amdgcn_mfma_f32_32x32x16_bf16(af[mi], bfr[ni], acc[mi][ni], 0, 0, 0);
      }
      if constexpr (LOAD == LOAD_PLAIN) asm volatile("s_waitcnt vmcnt(0)" ::: "memory");
      else { if (kt + 1 < nk) swrite(b ^ 1); }
      __syncthreads();
    }
    if constexpr (LOAD == LOAD_PLAIN) {
      const int tn_ = t + (int)gridDim.x;
      if (tn_ < ntiles) { const int ntn = g.nt0 + (tn_ >> 6), m0n = (tn_ & 63) * 256, n0n = ntn * BN; gdma(0, 0, m0n, n0n, g.A + (size_t)(n0n >> 11) * g.astride); }
    }
    bool wide = false; u16* wdst = nullptr; size_t wld = 0; int wcol0 = 0, wmode = 0;
    if constexpr (NI == 4 && LOAD == LOAD_PLAIN) {
      if constexpr (EPI == EPI_RWKV) { if (n0 < 8192) { const int which = n0 >> 11; wide = true; wdst = which == 0 ? g.o0 : which == 1 ? g.o1 : which == 2 ? g.o2 : g.o3; wld = EI; wcol0 = n0 & 2047; wmode = which == 3; } }
      else if constexpr (EPI == EPI_BF16) { wide = true; wdst = g.o0; wld = (size_t)g.ldc; wcol0 = n0; }
      else if constexpr (EPI == EPI_MLAIN) { if (n0 >= 768 && n0 + 256 <= ML_N) { wide = true; wdst = g.o0; wld = EI; wcol0 = n0 - 704; wmode = 1; } }
    }
    if (wide) {
      if (!g.dry) {
        char* wst = (wid < 4 ? sA + 32768 : sB + SBB) + (wid & 3) * 8192;
#pragma unroll
        for (int mi = 0; mi < 2; ++mi) {
#pragma unroll
          for (int ni = 0; ni < NI; ++ni)
#pragma unroll
            for (int r = 0; r < 16; ++r) {
              const float v = acc[mi][ni][r];
              *(u16*)(wst + crow(r, hi) * 256 + (ni * 32 + r32) * 2) = f2bf(wmode ? siluf(v) : v);
            }
          lds_wait();
#pragma unroll
          for (int i2 = 0; i2 < 8; ++i2) {
            const int row = (lane >> 4) + 4 * i2, ch = lane & 15;
            const u32x4 w = *(const u32x4*)(wst + row * 256 + ch * 16);
            *(u32x4*)(wdst + (size_t)(m0 + wm * 64 + mi * 32 + row) * wld + wcol0 + wn * 128 + ch * 8) = w;
          }
          lds_wait();
        }
      }
    } else
    if (!g.dry)
#pragma unroll
    for (int mi = 0; mi < 2; ++mi)
#pragma unroll
      for (int ni = 0; ni < NI; ++ni)
#pragma unroll
        for (int r = 0; r < 16; ++r) {
          const size_t m = (size_t)(m0 + wm * 64 + mi * 32 + crow(r, hi));
          const int nl = wn * (32 * NI) + ni * 32 + r32, n = n0 + nl;
          const float v = acc[mi][ni][r];
          if constexpr (EPI == EPI_RWKV) {
            if (n0 < 8192) {
              const int which = n0 >> 11, col = n & 2047;
              u16* dst = which == 0 ? g.o0 : which == 1 ? g.o1 : which == 2 ? g.o2 : g.o3;
              dst[m * EI + col] = f2bf(which == 3 ? siluf(v) : v);
            } else if (n0 == 8192) g.o4[m * 128 + nl] = f2bf(tanhf(v));
            else g.o5[m * 128 + nl] = f2bf(v);
          } else if constexpr (EPI == EPI_RES) {
            g.xout[m * DM + n] = g.xin[m * DM + n] + v;
          } else if constexpr (EPI == EPI_MLAIN) {
            if (n < 704) g.of[m * 704 + n] = v;
            else if (n < ML_N) g.o0[m * EI + (n - 704)] = f2bf(siluf(v));
          } else {
            g.o0[m * g.ldc + n] = f2bf(v);
          }
        }
  }
}

struct ScanP {
  const u16 *r, *k, *v, *twl, *al; u16 *yf, *yb; float* bonus;
  const float *w0, *w2, *a0, *a2, *kk, *ka, *rk;
  int nseq, T;
  float* tbuf; int nseg;
};
template <int CTRL> DEV float dppf(float x) {
  return __int_as_float(__builtin_amdgcn_update_dpp(0, __float_as_int(x), CTRL, 0xF, 0xF, false));
}
DEV float row_prefix16(float x) {
  x += dppf<0x111>(x); x += dppf<0x112>(x); x += dppf<0x114>(x); x += dppf<0x118>(x); return x;
}
DEV float row_total16(float x) {
  x += dppf<0x128>(x); x += dppf<0x124>(x); x += dppf<0x122>(x); x += dppf<0x121>(x); return x;
}
DEV bf16x8 pack8(float a0, float a1, float a2, float a3, float a4, float a5, float a6, float a7) {
  u32x4 w = {cvtpk(a0, a1), cvtpk(a2, a3), cvtpk(a4, a5), cvtpk(a6, a7)}; return *(bf16x8*)&w;
}
constexpr int SC_BKT = 0, SC_UVT = 5120, SC_AKM = 10240, SC_RR = 10752, SC_ABF = 11776, SC_Z = 12800, SC_PRM = 17152, SC_T = 18944, SC_WAVE = 35328;
constexpr int SC_PRE = SC_UVT;
constexpr int SC_SHARED_AW = 4 * SC_WAVE;
constexpr int SC_NW = 4;
DEV void scan_phase(const ScanP& s, char* lds_, const int pass) {
  const int tid = ltid(), wid = __builtin_amdgcn_readfirstlane(tid >> 6), lane = tid & 63, c16 = lane & 15, q = lane >> 4;
  const int nchain = s.nseq * 64, nseg = s.nseg;
  const int ipc = pass == 0 ? nseg * 2 : nseg;
  const bool shared = nchain <= (int)gridDim.x;
  const int nsb = shared ? (int)gridDim.x / nchain : 1, sbi = shared ? (int)blockIdx.x / nchain : 0;
  const int nwv = shared ? SC_NW : 2;
  if (shared && sbi >= nsb) return;
  char* wl = lds_ + (wid & 3) * SC_WAVE;
  u16* bkt = (u16*)(wl + SC_BKT); u16* uvt = (u16*)(wl + SC_UVT); u16* akm = (u16*)(wl + SC_AKM); u16* rr = (u16*)(wl + SC_RR);
  float* abf = (float*)(wl + SC_ABF); float* zl = (float*)(wl + SC_Z); float* prm = (float*)(wl + SC_PRM); float* p15l = prm + 320;
  bf16x8* awl = (bf16x8*)(shared ? lds_ + SC_SHARED_AW : lds_ + (2 + (wid & 1)) * SC_WAVE); bf16x8* aal = awl + 512;
#define SCAN_LOAD_W(CHAIN, F0, F1) do { const int d_ = (CHAIN) & 1, h_ = ((CHAIN) >> 1) & 31; \
    for (int f = (F0); f < (F1); ++f) { const int ks = f >> 2, mt = f & 3; u32x4 pw, pa; \
      _Pragma("unroll") for (int e = 0; e < 4; ++e) { const int l0 = ks * 32 + q * 8 + 2 * e; \
        const size_t i0 = ((size_t)(d_ * 64 + l0)) * EI + h_ * 64 + mt * 16 + c16; \
        pw[e] = cvtpk(s.w2[i0], s.w2[i0 + EI]); pa[e] = cvtpk(s.a2[i0], s.a2[i0 + EI]); } \
      awl[f * 64 + lane] = *(bf16x8*)&pw; aal[f * 64 + lane] = *(bf16x8*)&pa; } } while (0)
  if (shared) {
    const int chain_b = (int)blockIdx.x % nchain;
    SCAN_LOAD_W(chain_b, wid, wid + 1);
    __syncthreads();
  }
  if (wid >= nwv) return;
  const int nrounds = shared ? (ipc + nsb * SC_NW - 1) / (nsb * SC_NW) : (nchain + 2 * (int)gridDim.x - 1) / (2 * (int)gridDim.x);
  for (int round = 0; round < nrounds; ++round) {
    const int chain = shared ? (int)blockIdx.x % nchain : (round * 2 + wid) * (int)gridDim.x + (int)blockIdx.x;
    const int it = shared ? sbi * SC_NW + wid + round * nsb * SC_NW : 0;
    if (chain >= nchain || it >= ipc) continue;
    const int kind = pass == 0 ? 1 + (it & 1) : 0;
    const int seg = pass == 0 ? it >> 1 : it;
    const int cs = chain * nseg + seg;
    const int d = chain & 1, h = (chain >> 1) & 31, b = chain >> 6;
    {
      const int ch = h * 64 + lane;
      lds_wait();
      prm[lane] = s.w0[d * EI + ch]; prm[64 + lane] = s.a0[d * EI + ch]; prm[128 + lane] = s.kk[ch]; prm[192 + lane] = s.ka[ch]; prm[256 + lane] = s.rk[ch];
      lds_wait();
    }
    if (!shared) { SCAN_LOAD_W(chain, 0, 8); lds_wait(); }
    const unsigned rowi = (unsigned)(d ? 15 - c16 : c16);
    const unsigned off_tw = rowi * 256u + (unsigned)(q * 16);
    const unsigned off_kr = rowi * 4096u + (unsigned)(h * 128 + q * 8);
    const unsigned off_v  = (unsigned)(h * 128 + lane * 2);
    const unsigned off_y0 = (unsigned)(d ? 15 - 4 * q : 4 * q) * 4096u + (unsigned)(h * 128 + c16 * 2);
    const int ystep = d ? -4096 : 4096;
    f32x4* Tl = (f32x4*)(wl + SC_T);
#pragma unroll
    for (int m = 0; m < 16; ++m) {
      f32x4 t0v = {0.f, 0.f, 0.f, 0.f};
      if (kind == 2) {
        const int mt = m >> 2, nt = m & 3;
        if (mt == nt) { t0v[0] = (4 * q + 0 == c16) ? 1.f : 0.f; t0v[1] = (4 * q + 1 == c16) ? 1.f : 0.f; t0v[2] = (4 * q + 2 == c16) ? 1.f : 0.f; t0v[3] = (4 * q + 3 == c16) ? 1.f : 0.f; }
      } else if (kind == 0 && nseg > 1) {
        t0v = *(const f32x4*)(s.tbuf + ((size_t)cs * 2) * 4096 + (m * 64 + lane) * 4);
      }
      Tl[m * 64 + lane] = t0v;
    }
    u16* yout = d ? s.yb : s.yf;
    const size_t sb = (size_t)b * s.T;
    const int cps = s.T / 16 / nseg, cbeg = seg * cps, cend = cbeg + cps;
    bf16x8 n_tw0, n_tw1, n_ta0, n_ta1; u32x2 n_k[4], n_r[4];
#define SCAN_LOAD(CC) do { const int c0n = d ? (s.T - 16 - (CC) * 16) : (CC) * 16; const size_t t0n = sb + c0n; \
      size_t p_tw = (size_t)s.twl + t0n * 256 + d * 128, p_al = (size_t)s.al + t0n * 256 + d * 128, p_k = (size_t)s.k + t0n * 4096, p_r = (size_t)s.r + t0n * 4096 ; \
      asm volatile("" : "+s"(p_tw), "+s"(p_al), "+s"(p_k), "+s"(p_r)); \
      n_tw0 = gld<bf16x8>(p_tw, off_tw); n_tw1 = gld<bf16x8>(p_tw, off_tw + 64); n_ta0 = gld<bf16x8>(p_al, off_tw); n_ta1 = gld<bf16x8>(p_al, off_tw + 64); \
      _Pragma("unroll") for (int mt = 0; mt < 4; ++mt) { n_k[mt] = gld<u32x2>(p_k, off_kr + mt * 32); n_r[mt] = gld<u32x2>(p_r, off_kr + mt * 32); } } while (0)
    SCAN_LOAD(cbeg);
    for (int cc = cbeg; cc < cend; ++cc) {
      const int c0 = d ? (s.T - 16 - cc * 16) : cc * 16;
      const size_t t0 = sb + c0;
      size_t b_y = (size_t)yout + t0 * 4096, b_bon = (size_t)s.bonus + t0 * 256 + (h * 2 + d) * 4;
      asm volatile("" : "+s"(b_y), "+s"(b_bon));
      size_t b_v = (size_t)s.v + t0 * 4096; asm volatile("" : "+s"(b_v));
      u32x2 n_v[4];
#pragma unroll
      for (int mt = 0; mt < 4; ++mt) n_v[mt] = gld<u32x2>(b_v, off_kr + mt * 32);
      {
        f32x4* wpl = (f32x4*)zl; f32x4* apl = (f32x4*)(wl + SC_PRE);
#pragma unroll
        for (int mt = 0; mt < 4; ++mt) {
          f32x4 cw = {0.f, 0.f, 0.f, 0.f}, ca = {0.f, 0.f, 0.f, 0.f};
          cw = __builtin_amdgcn_mfma_f32_16x16x32_bf16(awl[(0 * 4 + mt) * 64 + lane], n_tw0, cw, 0, 0, 0);
          cw = __builtin_amdgcn_mfma_f32_16x16x32_bf16(awl[(1 * 4 + mt) * 64 + lane], n_tw1, cw, 0, 0, 0);
          ca = __builtin_amdgcn_mfma_f32_16x16x32_bf16(aal[(0 * 4 + mt) * 64 + lane], n_ta0, ca, 0, 0, 0);
          ca = __builtin_amdgcn_mfma_f32_16x16x32_bf16(aal[(1 * 4 + mt) * 64 + lane], n_ta1, ca, 0, 0, 0);
          wpl[mt * 64 + lane] = cw; apl[mt * 64 + lane] = ca;
        }
      }
      float n2 = 0.f;
#pragma unroll
      for (int mt = 0; mt < 4; ++mt) {
        const float4 kkp = *(const float4*)(prm + 128 + mt * 16 + q * 4);
        const float t0 = bflo(n_k[mt][0]) * kkp.x, t1 = bfhi(n_k[mt][0]) * kkp.y, t2 = bflo(n_k[mt][1]) * kkp.z, t3 = bfhi(n_k[mt][1]) * kkp.w;
        n2 += t0 * t0 + t1 * t1 + t2 * t2 + t3 * t3;
      }
      n2 += __shfl_xor(n2, 16, 64); n2 += __shfl_xor(n2, 32, 64);
      const float invn = __builtin_amdgcn_rsqf(fmaxf(n2, 1e-24f));
      float bon = 0.f;
      bf16x8 ktf[2], btf[2], kdf[2], rtf[2];
#pragma unroll
      for (int ks = 0; ks < 2; ++ks) {
        float ktl[8], btl[8], kdl[8], rtl[8];
#pragma unroll
        for (int mh = 0; mh < 2; ++mh) {
          const int mt = 2 * ks + mh;
          const f32x4 cw = ((const f32x4*)zl)[mt * 64 + lane], ca = ((const f32x4*)(wl + SC_PRE))[mt * 64 + lane];
          const float4 w0p = *(const float4*)(prm + mt * 16 + q * 4), a0p = *(const float4*)(prm + 64 + mt * 16 + q * 4);
          const float4 kkp = *(const float4*)(prm + 128 + mt * 16 + q * 4), kap = *(const float4*)(prm + 192 + mt * 16 + q * 4), rkp = *(const float4*)(prm + 256 + mt * 16 + q * 4);
          const float w0a[4] = {w0p.x, w0p.y, w0p.z, w0p.w}, a0a[4] = {a0p.x, a0p.y, a0p.z, a0p.w};
          const float kka[4] = {kkp.x, kkp.y, kkp.z, kkp.w}, kaa[4] = {kap.x, kap.y, kap.z, kap.w}, rka[4] = {rkp.x, rkp.y, rkp.z, rkp.w};
          const u32x2 kr_ = n_k[mt], rr_ = n_r[mt];
          const float kxa[4] = {bflo(kr_[0]), bfhi(kr_[0]), bflo(kr_[1]), bfhi(kr_[1])};
          const float rxa[4] = {bflo(rr_[0]), bfhi(rr_[0]), bflo(rr_[1]), bfhi(rr_[1])};
          float4 p15v;
#pragma unroll
          for (int e = 0; e < 4; ++e) {
            const float wp = cw[e] + w0a[e], ap = ca[e] + a0a[e];
            const float ee = 0.6065306597126334f * __builtin_amdgcn_rcpf(1.f + __expf(-wp));
            const float a = __builtin_amdgcn_rcpf(1.f + __expf(-ap));
            const float kkn = kxa[e] * kka[e] * invn;
            const float kd = kxa[e] * (1.f + (a - 1.f) * kaa[e]);
            const float bb = kkn * a;
            bon += rxa[e] * kd * rka[e];
            const float Ei = row_prefix16(ee);
            const float pm = __expf(-Ei), pp = __builtin_amdgcn_rcpf(pm);
            const float pm1s = dppf<0x111>(pm), pm1 = c16 == 0 ? 1.f : pm1s;
            ktl[mh * 4 + e] = kkn * pm1; btl[mh * 4 + e] = bb * pp; kdl[mh * 4 + e] = kd * pp; rtl[mh * 4 + e] = rxa[e] * pm;
            ((float*)&p15v)[e] = pm;
          }
          if (c16 == 15) *(float4*)(p15l + mt * 16 + q * 4) = p15v;
          SBAR();
        }
        ktf[ks] = pack8(ktl[0], ktl[1], ktl[2], ktl[3], ktl[4], ktl[5], ktl[6], ktl[7]);
        btf[ks] = pack8(btl[0], btl[1], btl[2], btl[3], btl[4], btl[5], btl[6], btl[7]);
        kdf[ks] = pack8(kdl[0], kdl[1], kdl[2], kdl[3], kdl[4], kdl[5], kdl[6], kdl[7]);
        rtf[ks] = pack8(rtl[0], rtl[1], rtl[2], rtl[3], rtl[4], rtl[5], rtl[6], rtl[7]);
        {
          const u32x4 bw_ = *(const u32x4*)&btf[ks], kw_ = *(const u32x4*)&kdf[ks];
#pragma unroll
          for (int w = 0; w < 4; ++w) {
            const int j = (2 * ks + (w >> 1)) * 16 + q * 4 + (w & 1) * 2;
            bkt[j * 40 + c16] = (u16)(bw_[w] & 0xffffu); bkt[(j + 1) * 40 + c16] = (u16)(bw_[w] >> 16);
            bkt[j * 40 + 16 + c16] = (u16)(kw_[w] & 0xffffu); bkt[(j + 1) * 40 + 16 + c16] = (u16)(kw_[w] >> 16);
          }
        }
      }
      bon += __shfl_xor(bon, 16, 64); bon += __shfl_xor(bon, 32, 64);
      if (q == 0 && kind == 0) gst<float>(b_bon, off_tw, bon);
      SBAR();
      SBAR();
#pragma unroll
      for (int mt = 0; mt < 4; ++mt) {
        const int vb_ = (mt * 16 + q * 4) * 40 + 16 + c16;
        const unsigned v0_ = kind == 2 ? 0u : n_v[mt][0], v1_ = kind == 2 ? 0u : n_v[mt][1];
        uvt[vb_] = (u16)(v0_ & 0xffffu); uvt[vb_ + 40] = (u16)(v0_ >> 16);
        uvt[vb_ + 80] = (u16)(v1_ & 0xffffu); uvt[vb_ + 120] = (u16)(v1_ >> 16);
      }
      { const int cn = cc + 1 < cend ? cc + 1 : cc; SCAN_LOAD(cn); }
      SBAR();
      {
        f32x4 AB = {0.f, 0.f, 0.f, 0.f}, AK = AB, RB = AB, RK = AB;
        int qm = q; asm volatile("" : "+v"(qm));
#pragma unroll
        for (int ks = 0; ks < 2; ++ks) {
          AB = __builtin_amdgcn_mfma_f32_16x16x32_bf16(ktf[ks], btf[ks], AB, 0, 0, 0);
          AK = __builtin_amdgcn_mfma_f32_16x16x32_bf16(ktf[ks], kdf[ks], AK, 0, 0, 0);
          RB = __builtin_amdgcn_mfma_f32_16x16x32_bf16(rtf[ks], btf[ks], RB, 0, 0, 0);
          RK = __builtin_amdgcn_mfma_f32_16x16x32_bf16(rtf[ks], kdf[ks], RK, 0, 0, 0);
        }
#pragma unroll
        for (int r = 0; r < 4; ++r) {
          const int i = 4 * qm + r;
          const bool lo = c16 < i, le = c16 <= i;
          abf[i * 16 + c16] = lo ? AB[r] : 0.f;
          akm[i * 16 + c16] = f2bf(lo ? AK[r] : 0.f);
          rr[i * 32 + c16] = f2bf(le ? RB[r] : 0.f);
          rr[i * 32 + 16 + c16] = f2bf(le ? RK[r] : 0.f);
        }
      }
#define TFRAG(ks, nt, OUT) do { const f32x4 ta_ = Tl[((2 * (ks)) * 4 + (nt)) * 64 + lane], tb_ = Tl[((2 * (ks) + 1) * 4 + (nt)) * 64 + lane]; \
        OUT = pack8(ta_[0], ta_[1], ta_[2], ta_[3], tb_[0], tb_[1], tb_[2], tb_[3]); } while (0)
      lds_wait();
      {
        bf16x8 akf = {0, 0, 0, 0, 0, 0, 0, 0};
        if (q < 2) akf = *(const bf16x8*)(akm + c16 * 16 + q * 8);
#pragma unroll
        for (int nt = 0; nt < 4; ++nt) {
          f32x4 z = {0.f, 0.f, 0.f, 0.f};
          bf16x8 tf0, tf1; TFRAG(0, nt, tf0); TFRAG(1, nt, tf1);
          z = __builtin_amdgcn_mfma_f32_16x16x32_bf16(ktf[0], tf0, z, 0, 0, 0);
          z = __builtin_amdgcn_mfma_f32_16x16x32_bf16(ktf[1], tf1, z, 0, 0, 0);
          const bf16x8 vf = *(const bf16x8*)(uvt + (nt * 16 + c16) * 40 + 16 + (q & 1) * 8);
          z = __builtin_amdgcn_mfma_f32_16x16x32_bf16(akf, vf, z, 0, 0, 0);
#pragma unroll
          for (int r = 0; r < 4; ++r) zl[(4 * q + r) * 68 + nt * 16 + c16] = z[r];
        }
      }
      lds_wait();
      SBAR();
      {
        float U[16];
#pragma unroll
        for (int i = 0; i < 16; ++i) {
          float acc = -zl[i * 68 + lane];
#pragma unroll
          for (int s4 = 0; s4 < (i + 3) / 4; ++s4) {
            const float4 a4 = *(const float4*)(abf + i * 16 + s4 * 4);
            if (s4 * 4 + 0 < i) acc -= a4.x * U[s4 * 4 + 0];
            if (s4 * 4 + 1 < i) acc -= a4.y * U[s4 * 4 + 1];
            if (s4 * 4 + 2 < i) acc -= a4.z * U[s4 * 4 + 2];
            if (s4 * 4 + 3 < i) acc -= a4.w * U[s4 * 4 + 3];
          }
          U[i] = acc;
          if ((i & 3) == 3) SBAR();
        }
        *(bf16x8*)(uvt + lane * 40) = pack8(U[0], U[1], U[2], U[3], U[4], U[5], U[6], U[7]);
        *(bf16x8*)(uvt + lane * 40 + 8) = pack8(U[8], U[9], U[10], U[11], U[12], U[13], U[14], U[15]);
      }
      lds_wait();
      SBAR();
      {
        const bf16x8 rrf = *(const bf16x8*)(rr + c16 * 32 + q * 8);
        bf16x8 uvf[4];
#pragma unroll
        for (int nt = 0; nt < 4; ++nt) uvf[nt] = *(const bf16x8*)(uvt + (nt * 16 + c16) * 40 + q * 8);
#pragma unroll
        for (int nt = 0; nt < 4; ++nt) {
          f32x4 y = {0.f, 0.f, 0.f, 0.f};
          bf16x8 tf0, tf1; TFRAG(0, nt, tf0); TFRAG(1, nt, tf1);
          y = __builtin_amdgcn_mfma_f32_16x16x32_bf16(rtf[0], tf0, y, 0, 0, 0);
          y = __builtin_amdgcn_mfma_f32_16x16x32_bf16(rtf[1], tf1, y, 0, 0, 0);
          y = __builtin_amdgcn_mfma_f32_16x16x32_bf16(rrf, uvf[nt], y, 0, 0, 0);
#pragma unroll
          for (int r = 0; r < 4; ++r) { if (kind == 0) gst<u16>(b_y, off_y0 + (unsigned)(r * ystep) + nt * 32, f2bf(y[r])); }
        }
#pragma unroll
        for (int mt = 0; mt < 4; ++mt) {
          const bf16x8 bkf = *(const bf16x8*)(bkt + (mt * 16 + c16) * 40 + q * 8);
          const float4 pq = *(const float4*)(p15l + mt * 16 + q * 4);
#pragma unroll
          for (int nt = 0; nt < 4; ++nt) {
            f32x4 t = __builtin_amdgcn_mfma_f32_16x16x32_bf16(bkf, uvf[nt], Tl[(mt * 4 + nt) * 64 + lane], 0, 0, 0);
            t[0] *= pq.x; t[1] *= pq.y; t[2] *= pq.z; t[3] *= pq.w;
            Tl[(mt * 4 + nt) * 64 + lane] = t;
          }
        }
      }
      lds_wait();
    }
    if (pass == 0) {
      float* dst = s.tbuf + ((size_t)cs * 2 + (kind - 1)) * 4096;
#pragma unroll
      for (int m = 0; m < 16; ++m) *(f32x4*)(dst + (m * 64 + lane) * 4) = Tl[m * 64 + lane];
    }
  }
}

DEV void scan_combine_phase(const ScanP& s, char* lds_) {
  const int tid = ltid(), wid = __builtin_amdgcn_readfirstlane(tid >> 6), lane = tid & 63, c16 = lane & 15, q = lane >> 4;
  if (wid >= 2) return;
  float* til = (float*)(lds_ + wid * 16384);
  const int nchain = s.nseq * 64, nseg = s.nseg;
  for (int chain = wid * gridDim.x + blockIdx.x; chain < nchain; chain += 2 * gridDim.x) {
    f32x4 T[16];
#pragma unroll
    for (int m = 0; m < 16; ++m) T[m] = f32x4{0.f, 0.f, 0.f, 0.f};
    for (int seg = 0; seg < nseg; ++seg) {
      float* tn = s.tbuf + ((size_t)(chain * nseg + seg) * 2) * 4096; const float* ti = tn + 4096;
      lds_wait();
#pragma unroll
      for (int m = 0; m < 16; ++m) *(f32x4*)(til + (m * 64 + lane) * 4) = *(const f32x4*)(ti + (m * 64 + lane) * 4);
      lds_wait();
      f32x4 Tn[16];
#pragma unroll
      for (int m = 0; m < 16; ++m) Tn[m] = *(const f32x4*)(tn + (m * 64 + lane) * 4);
#pragma unroll
      for (int nt = 0; nt < 4; ++nt) {
        bf16x8 bh[2], bl[2];
#pragma unroll
        for (int ks = 0; ks < 2; ++ks) {
          const f32x4 ta = T[(2 * ks) * 4 + nt], tb = T[(2 * ks + 1) * 4 + nt];
          const float x[8] = {ta[0], ta[1], ta[2], ta[3], tb[0], tb[1], tb[2], tb[3]};
          float hf[8], lf[8];
#pragma unroll
          for (int e = 0; e < 8; ++e) { hf[e] = bf2f(f2bf(x[e])); lf[e] = x[e] - hf[e]; }
          bh[ks] = pack8(hf[0], hf[1], hf[2], hf[3], hf[4], hf[5], hf[6], hf[7]);
          bl[ks] = pack8(lf[0], lf[1], lf[2], lf[3], lf[4], lf[5], lf[6], lf[7]);
        }
#pragma unroll
        for (int mt = 0; mt < 4; ++mt) {
          f32x4 acc = Tn[mt * 4 + nt];
#pragma unroll
          for (int ks = 0; ks < 2; ++ks) {
            float x[8];
#pragma unroll
            for (int e = 0; e < 8; ++e) x[e] = til[((mt * 4 + 2 * ks + (e >> 2)) * 64 + ((c16 >> 2) & 3) * 16 + 4 * q + (e & 3)) * 4 + (c16 & 3)];
            float hf[8], lf[8];
#pragma unroll
            for (int e = 0; e < 8; ++e) { hf[e] = bf2f(f2bf(x[e])); lf[e] = x[e] - hf[e]; }
            const bf16x8 ah = pack8(hf[0], hf[1], hf[2], hf[3], hf[4], hf[5], hf[6], hf[7]);
            const bf16x8 al = pack8(lf[0], lf[1], lf[2], lf[3], lf[4], lf[5], lf[6], lf[7]);
            acc = __builtin_amdgcn_mfma_f32_16x16x32_bf16(ah, bh[ks], acc, 0, 0, 0);
            acc = __builtin_amdgcn_mfma_f32_16x16x32_bf16(ah, bl[ks], acc, 0, 0, 0);
            acc = __builtin_amdgcn_mfma_f32_16x16x32_bf16(al, bh[ks], acc, 0, 0, 0);
          }
          Tn[mt * 4 + nt] = acc;
        }
      }
#pragma unroll
      for (int m = 0; m < 16; ++m) { *(f32x4*)(tn + (m * 64 + lane) * 4) = T[m]; T[m] = Tn[m]; }
    }
  }
}

DEV void post_phase(u16* __restrict__ yf, const u16* __restrict__ yb, const u16* __restrict__ v, const u16* __restrict__ sg,
                    const float* __restrict__ bonus, const float* __restrict__ lg, const float* __restrict__ lb) {
  const int tid_ = ltid(); const int lane = tid_ & 63, wid = __builtin_amdgcn_readfirstlane(tid_ >> 6);
  for (int tok = blockIdx.x * 8 + wid; tok < GT; tok += gridDim.x * 8) {
#pragma unroll
    for (int it = 0; it < 4; ++it) {
      const int ch0 = it * 512 + lane * 8, h = ch0 >> 6; const size_t i = (size_t)tok * EI + ch0;
      const u32x4 a = *(const u32x4*)(yf + i), bq = *(const u32x4*)(yb + i), vv = *(const u32x4*)(v + i), gg = *(const u32x4*)(sg + i);
      const float2 bo = *(const float2*)(bonus + ((size_t)tok * 32 + h) * 2);
      float y[8]; float sum = 0.f;
#pragma unroll
      for (int e = 0; e < 4; ++e) { y[2 * e] = bflo(a[e]) + bflo(bq[e]); y[2 * e + 1] = bfhi(a[e]) + bfhi(bq[e]); sum += y[2 * e] + y[2 * e + 1]; }
      sum += __shfl_xor(sum, 1, 64); sum += __shfl_xor(sum, 2, 64); sum += __shfl_xor(sum, 4, 64);
      const float mean = sum * (1.f / 64.f);
      float var = 0.f;
#pragma unroll
      for (int e = 0; e < 8; ++e) { y[e] -= mean; var += y[e] * y[e]; }
      var += __shfl_xor(var, 1, 64); var += __shfl_xor(var, 2, 64); var += __shfl_xor(var, 4, 64);
      const float rs = rsqrtf(var * (1.f / 64.f) + 64e-5f), bon = bo.x + bo.y;
      const float4 g0 = *(const float4*)(lg + ch0), g1 = *(const float4*)(lg + ch0 + 4), b0 = *(const float4*)(lb + ch0), b1 = *(const float4*)(lb + ch0 + 4);
      const float ga[8] = {g0.x, g0.y, g0.z, g0.w, g1.x, g1.y, g1.z, g1.w}, ba[8] = {b0.x, b0.y, b0.z, b0.w, b1.x, b1.y, b1.z, b1.w};
      u32x4 o;
#pragma unroll
      for (int e = 0; e < 4; ++e) {
        const float o0 = (y[2 * e] * rs * ga[2 * e] + ba[2 * e] + bon * bflo(vv[e])) * bflo(gg[e]);
        const float o1 = (y[2 * e + 1] * rs * ga[2 * e + 1] + ba[2 * e + 1] + bon * bfhi(vv[e])) * bfhi(gg[e]);
        o[e] = cvtpk(o0, o1);
      }
      *(u32x4*)(yf + i) = o;
    }
  }
}

DEV void mla_mid_phase(const float* __restrict__ cqkv, const float* __restrict__ qn, const float* __restrict__ kvn,
                       const float* __restrict__ ct, const float* __restrict__ st,
                       u16* __restrict__ cqn, u16* __restrict__ ckvn, u16* __restrict__ kpe, int T) {
  const int tid_ = ltid(); const int lane = tid_ & 63, wid = __builtin_amdgcn_readfirstlane(tid_ >> 6);
  for (int tok = blockIdx.x * 8 + wid; tok < GT; tok += gridDim.x * 8) {
    const float* row = cqkv + (size_t)tok * 704;
    float q[6], ss = 0.f;
#pragma unroll
    for (int i = 0; i < 6; ++i) { q[i] = row[lane + i * 64]; ss += q[i] * q[i]; }
    ss = wsum(ss); float sc = rsqrtf(ss * (1.f / 384.f) + 1e-6f);
#pragma unroll
    for (int i = 0; i < 6; ++i) cqn[(size_t)tok * 384 + lane + i * 64] = f2bf(q[i] * sc * qn[lane + i * 64]);
    float c[4]; ss = 0.f;
#pragma unroll
    for (int i = 0; i < 4; ++i) { c[i] = row[384 + lane + i * 64]; ss += c[i] * c[i]; }
    ss = wsum(ss); sc = rsqrtf(ss * (1.f / 256.f) + 1e-6f);
#pragma unroll
    for (int i = 0; i < 4; ++i) ckvn[(size_t)tok * 256 + lane + i * 64] = f2bf(c[i] * sc * kvn[lane + i * 64]);
    const float x = row[640 + lane];
    const float xo = __shfl_xor(x, 32, 64);
    const int pos = tok % T, j = lane & 31;
    const float cs = ct[pos * 32 + j], sn = st[pos * 32 + j];
    const float o = lane < 32 ? x * cs - xo * sn : x * cs + xo * sn;
    kpe[(size_t)tok * 64 + lane] = f2bf(o);
  }
}

constexpr int SHM_V = 16384, SHM_K = 16384, SHM_KP = 8192;
#define KSWZ(row, colB) ((row) * 256 + ((colB) ^ (((row) & 7) << 4)))
#define KPSWZ(row, colB) ((row) * 128 + ((colB) ^ (((row) & 7) << 4)))
constexpr float ATT_SCALE = 0.07216878364870322f;
DEV void partialSM(f32x16& p0, f32x16& p1, float& m_reg, float& mn, float& alpha) {
  constexpr float C = ATT_SCALE * 1.4426950408889634f;
  float pmax = p0[0];
#pragma unroll
  for (int r = 1; r < 16; ++r) pmax = fmaxf(pmax, p0[r]);
#pragma unroll
  for (int r = 0; r < 16; ++r) pmax = fmaxf(pmax, p1[r]);
  { auto rr = __builtin_amdgcn_permlane32_swap(__float_as_uint(pmax), __float_as_uint(pmax), false, false);
    pmax = fmaxf(__uint_as_float(rr[0]), __uint_as_float(rr[1])); }
  if (__builtin_expect(__all(pmax - m_reg <= 8.f / ATT_SCALE), 1)) { mn = m_reg; alpha = 1.f; }
  else { mn = fmaxf(m_reg, pmax); alpha = __builtin_amdgcn_exp2f((m_reg - mn) * C); m_reg = mn; }
  const float mnC = -mn * C;
#pragma unroll
  for (int r = 0; r < 16; ++r) p0[r] = __builtin_amdgcn_exp2f(fmaf(p0[r], C, mnC));
#pragma unroll
  for (int r = 0; r < 16; ++r) p1[r] = __builtin_amdgcn_exp2f(fmaf(p1[r], C, mnC));
}
DEV void finishSM(f32x16& p0, f32x16& p1, float alpha, float& l_reg, bf16x8& pa0, bf16x8& pa1, bf16x8& pa2, bf16x8& pa3) {
  float ps = 0;
#pragma unroll
  for (int r = 0; r < 16; ++r) ps += p0[r];
#pragma unroll
  for (int r = 0; r < 16; ++r) ps += p1[r];
  { auto rr = __builtin_amdgcn_permlane32_swap(__float_as_uint(ps), __float_as_uint(ps), false, false);
    ps = __uint_as_float(rr[0]) + __uint_as_float(rr[1]); }
  l_reg = l_reg * alpha + ps;
#define PK4(PP, BASE, OUT) do { unsigned a0 = cvtpk(PP[BASE + 0], PP[BASE + 1]), a1 = cvtpk(PP[BASE + 2], PP[BASE + 3]);   \
    unsigned b0 = cvtpk(PP[BASE + 4], PP[BASE + 5]), b1 = cvtpk(PP[BASE + 6], PP[BASE + 7]);                              \
    auto r0 = __builtin_amdgcn_permlane32_swap(a0, b0, false, false); auto r1 = __builtin_amdgcn_permlane32_swap(a1, b1, false, false); \
    u32x4 w = {r0[0], r1[0], r0[1], r1[1]}; OUT = *reinterpret_cast<bf16x8*>(&w); } while (0)
  PK4(p0, 0, pa0); PK4(p0, 8, pa1); PK4(p1, 0, pa2); PK4(p1, 8, pa3);
#undef PK4
}
DEV int v_st(int k, int c) { const int kk = (k & ~0xC) | ((k & 4) << 1) | ((k & 8) >> 1); return ((kk >> 3) * 4 + (c >> 5)) * 512 + ((kk & 7) * 32 + (c & 31)) * 2; }
DEV int v_rd_base(int lane) { return ((lane & 3) << 3) | (((lane >> 2) & 3) << 6) | (((lane >> 4) & 1) << 5) | (((lane >> 5) & 1) << 8); }
constexpr int v_rd_off(int d0, int ks, int half) { return d0 * 512 + ks * 4096 + half * 2048; }
template <int OFF> DEV s16x4 tr_read(int vb) {
  s16x4 r; asm volatile("ds_read_b64_tr_b16 %0, %1 offset:%2" : "=&v"(r) : "v"(vb), "i"(OFF) : "memory"); return r;
}
template <int D0> DEV void pv_one(f32x16& od, int vb, bf16x8 pa0, bf16x8 pa1, bf16x8 pa2, bf16x8 pa3) {
  const s16x4 l0 = tr_read<v_rd_off(D0, 0, 0)>(vb), h0 = tr_read<v_rd_off(D0, 0, 1)>(vb), l1 = tr_read<v_rd_off(D0, 1, 0)>(vb), h1 = tr_read<v_rd_off(D0, 1, 1)>(vb);
  const s16x4 l2 = tr_read<v_rd_off(D0, 2, 0)>(vb), h2 = tr_read<v_rd_off(D0, 2, 1)>(vb), l3 = tr_read<v_rd_off(D0, 3, 0)>(vb), h3 = tr_read<v_rd_off(D0, 3, 1)>(vb);
  asm volatile("s_waitcnt lgkmcnt(0)" ::: "memory"); SBAR();
#define PK(L, H) (bf16x8){L[0], L[1], L[2], L[3], H[0], H[1], H[2], H[3]}
  od = __builtin_amdgcn_mfma_f32_32x32x16_bf16(pa0, PK(l0, h0), od, 0, 0, 0);
  od = __builtin_amdgcn_mfma_f32_32x32x16_bf16(pa1, PK(l1, h1), od, 0, 0, 0);
  od = __builtin_amdgcn_mfma_f32_32x32x16_bf16(pa2, PK(l2, h2), od, 0, 0, 0);
  od = __builtin_amdgcn_mfma_f32_32x32x16_bf16(pa3, PK(l3, h3), od, 0, 0, 0);
#undef PK
}

struct AttnP { const u16* q; const u16* kv; const u16* kpe; u16* sg; const float* ct; const float* st; int nseq, T; int dry; };
DEV void attn_phase(const AttnP& a, char* lds) {
  const int tid = ltid(), wid = __builtin_amdgcn_readfirstlane(tid >> 6), lane = tid & 63, r32 = lane & 31, hi = lane >> 5;
  char* V_lds = lds; char* K_lds = lds + 3 * SHM_V; char* KP_lds = lds + 3 * SHM_V + 2 * SHM_K;
  float* wsc = (float*)(lds + 3 * SHM_V + 2 * SHM_K + 2 * SHM_KP) + wid * 64; float* li_l = wsc; float* al_l = wsc + 32;
  const int nqb = a.T / 256, nitems = a.nseq * 16 * nqb, NT = a.T / 64;
  const int sr = tid >> 4, sc = (tid & 15) * 8, vst0 = v_st(sr, sc), vst1 = v_st(32 + sr, sc);
  const int pr = tid >> 3, pc = (tid & 7) * 8;
  const int vb0 = (int)(uintptr_t)V_lds + v_rd_base(lane);
  int kad[4], kpd[4];
#pragma unroll
  for (int q = 0; q < 4; ++q) { kad[q] = KSWZ(r32, q * 32 + hi * 16); kpd[q] = KPSWZ(r32, q * 32 + hi * 16); }
  const int vblk = (gridDim.x & 7) == 0 ? (int)(blockIdx.x & 7) * (int)(gridDim.x >> 3) + (int)(blockIdx.x >> 3) : (int)blockIdx.x;
  for (int it = vblk; it < nitems; it += gridDim.x) {
    const int qb = it % nqb, h = (it / nqb) & 15, b = it / (nqb * 16);
    const size_t sbase = (size_t)b * a.T;
    const int pos = qb * 256 + wid * 32 + r32;
    bf16x8 qr[12];
    {
      const u16* Qw = a.q + (sbase + pos) * 3072 + h * 192 + hi * 8;
#pragma unroll
      for (int d0 = 0; d0 < 12; ++d0) qr[d0] = *(const bf16x8*)(Qw + d0 * 16);
#pragma unroll
      for (int dd = 0; dd < 2; ++dd) {
        const int j0 = dd * 16 + hi * 8;
        const float4 c0 = *(const float4*)(a.ct + pos * 32 + j0), c1 = *(const float4*)(a.ct + pos * 32 + j0 + 4);
        const float4 s0 = *(const float4*)(a.st + pos * 32 + j0), s1 = *(const float4*)(a.st + pos * 32 + j0 + 4);
        const float cs[8] = {c0.x, c0.y, c0.z, c0.w, c1.x, c1.y, c1.z, c1.w};
        const float sn[8] = {s0.x, s0.y, s0.z, s0.w, s1.x, s1.y, s1.z, s1.w};
        u32x4 x1 = *(u32x4*)&qr[8 + dd], x2 = *(u32x4*)&qr[10 + dd], y1, y2;
#pragma unroll
        for (int e = 0; e < 4; ++e) {
          const float a0 = bflo(x1[e]), a1 = bfhi(x1[e]), b0 = bflo(x2[e]), b1 = bfhi(x2[e]);
          y1[e] = cvtpk(a0 * cs[2 * e] - b0 * sn[2 * e], a1 * cs[2 * e + 1] - b1 * sn[2 * e + 1]);
          y2[e] = cvtpk(b0 * cs[2 * e] + a0 * sn[2 * e], b1 * cs[2 * e + 1] + a1 * sn[2 * e + 1]);
        }
        qr[8 + dd] = *(bf16x8*)&y1; qr[10 + dd] = *(bf16x8*)&y2;
      }
    }
    float m_reg = -1e30f, l_reg = 0.f; f32x16 o[4] = {};
    const u16* kvh = a.kv + sbase * 4096 + h * 256;
    const u16* kph = a.kpe + sbase * 64;
    unsigned gv0, gv1, gk0, gk1, gp0;
    {
      auto vsrc = [&](int s_) { const int kk = ((s_ >> 7) << 3) | ((s_ >> 2) & 7); const int k = (kk & ~0xC) | ((kk & 4) << 1) | ((kk & 8) >> 1);
                                const int c = ((s_ >> 5) & 3) * 32 + (s_ & 3) * 8; return (unsigned)(k * 8192 + 256 + c * 2); };
      auto ksrc = [&](int s_) { const int k = s_ >> 4; const int c = (s_ & 15) ^ (k & 7); return (unsigned)(k * 8192 + c * 16); };
      gv0 = vsrc(tid); gv1 = vsrc(tid + 512); gk0 = ksrc(tid); gk1 = ksrc(tid + 512);
      const int kp_ = tid >> 3; gp0 = (unsigned)(kp_ * 128 + (((tid & 7) ^ (kp_ & 7)) * 16));
    }
#define GLDS(SRC, DST) __builtin_amdgcn_global_load_lds((const __attribute__((address_space(1))) void*)(SRC), (__attribute__((address_space(3))) void*)(DST), 16, 0, 0)
#define SDMA(k0, bb, vbuf) do { const char* bK = (const char*)kvh + (size_t)(k0) * 8192; const char* bP = (const char*)kph + (size_t)(k0) * 128; \
    GLDS(bK + gv0, V_lds + (vbuf) * SHM_V + tid * 16); GLDS(bK + gv1, V_lds + (vbuf) * SHM_V + (tid + 512) * 16); \
    GLDS(bK + gk0, K_lds + (bb) * SHM_K + tid * 16);   GLDS(bK + gk1, K_lds + (bb) * SHM_K + (tid + 512) * 16); \
    GLDS(bP + gp0, KP_lds + (bb) * SHM_KP + tid * 16); } while (0)
#define SDMA_WAIT() asm volatile("s_waitcnt vmcnt(0)" ::: "memory")
    __syncthreads();
    SDMA(0, 0, 0); SDMA_WAIT(); __syncthreads();
    const bool grpB = wid >= 4;
    bf16x8 pa0, pa1, pa2, pa3;
    int vcur = 0, vprev = 2;
#define PV_ALL(vbuf) do { const int vb_ = vb0 + (vbuf) * SHM_V; \
      pv_one<0>(o[0], vb_, pa0, pa1, pa2, pa3); pv_one<1>(o[1], vb_, pa0, pa1, pa2, pa3); \
      pv_one<2>(o[2], vb_, pa0, pa1, pa2, pa3); pv_one<3>(o[3], vb_, pa0, pa1, pa2, pa3); } while (0)
    for (int j = 0; j < NT; ++j) {
      const int bb = j & 1;
      const int vnext = vcur == 2 ? 0 : vcur + 1;
      if (j + 1 < NT) SDMA((j + 1) * 64, bb ^ 1, vnext);
      SBAR();
      if (grpB && j > 0) PV_ALL(vprev);
      f32x16 p0 = {}, p1 = {};
      {
        const char* Ks = K_lds + bb * SHM_K; const char* Kp = KP_lds + bb * SHM_KP;
        bf16x8 kf0[4], kf1[4];
#pragma unroll
        for (int q4 = 0; q4 < 4; ++q4) { kf0[q4] = *(const bf16x8*)(Ks + kad[q4]); kf1[q4] = *(const bf16x8*)(Ks + kad[q4] + 8192); }
        SBAR();
#pragma unroll
        for (int q4 = 0; q4 < 4; ++q4) { p0 = __builtin_amdgcn_mfma_f32_32x32x16_bf16(kf0[q4], qr[q4], p0, 0, 0, 0); p1 = __builtin_amdgcn_mfma_f32_32x32x16_bf16(kf1[q4], qr[q4], p1, 0, 0, 0);
          kf0[q4] = *(const bf16x8*)(Ks + kad[q4] + 128); kf1[q4] = *(const bf16x8*)(Ks + kad[q4] + 128 + 8192); }
        SBAR();
#pragma unroll
        for (int q4 = 0; q4 < 4; ++q4) { p0 = __builtin_amdgcn_mfma_f32_32x32x16_bf16(kf0[q4], qr[4 + q4], p0, 0, 0, 0); p1 = __builtin_amdgcn_mfma_f32_32x32x16_bf16(kf1[q4], qr[4 + q4], p1, 0, 0, 0);
          kf0[q4] = *(const bf16x8*)(Kp + kpd[q4]); kf1[q4] = *(const bf16x8*)(Kp + kpd[q4] + 4096); }
        SBAR();
#pragma unroll
        for (int q4 = 0; q4 < 4; ++q4) { p0 = __builtin_amdgcn_mfma_f32_32x32x16_bf16(kf0[q4], qr[8 + q4], p0, 0, 0, 0); p1 = __builtin_amdgcn_mfma_f32_32x32x16_bf16(kf1[q4], qr[8 + q4], p1, 0, 0, 0); }
      }
      float mn, alpha;
      partialSM(p0, p1, m_reg, mn, alpha);
      if (__any(alpha < 1.f)) {
        if (hi == 0) al_l[r32] = alpha;
        lds_wait();
#pragma unroll
        for (int dd = 0; dd < 4; ++dd)
#pragma unroll
          for (int r = 0; r < 16; ++r) o[dd][r] *= al_l[crow(r, hi)];
      }
      finishSM(p0, p1, alpha, l_reg, pa0, pa1, pa2, pa3); SBAR();
      if (!grpB) PV_ALL(vcur);
      SDMA_WAIT();
      vprev = vcur; vcur = vnext;
      __syncthreads();
    }
    if (grpB) PV_ALL(vprev);
#undef PV_ALL
#undef SDMA
#undef SDMA_WAIT
#undef GLDS
    {
      int t2 = threadIdx.x; asm volatile("" : "+v"(t2));
      const int wid2 = t2 >> 6, r2 = t2 & 31, hi2 = (t2 >> 5) & 1;
      float* li2 = (float*)(lds + 3 * SHM_V + 2 * SHM_K + 2 * SHM_KP) + wid2 * 64;
      if (hi2 == 0) li2[r2] = l_reg;
      lds_wait();
      u16* Ow = a.sg + (sbase + qb * 256 + wid2 * 32) * EI + h * 128 + r2;
#pragma unroll
      for (int r = 0; r < 16; ++r) {
        const int orow = crow(r, hi2);
        const float rl = __builtin_amdgcn_rcpf(li2[orow]);
#pragma unroll
        for (int d0 = 0; d0 < 4; ++d0) {
          u16* pp = Ow + (size_t)orow * EI + d0 * 32;
          if (!a.dry) *pp = f2bf(o[d0][r] * rl * bf2f(*pp));
        }
      }
    }
  }
}

#if MEGA
#define GRID_SYNC() gsync(p, lds)
#else
#define GRID_SYNC() do {} while (0)
#endif
struct Grp { const float* xin0; float* xres; int nseq, T; };
DEV Grp get_group(const P& p, int g) {
  Grp r;
  r.xin0 = g == 0 ? p.x_prompt : p.x_sample + (size_t)(g - 1) * GT * DM;
  r.xres = p.out + (size_t)g * GT * DM;
  r.nseq = g == 0 ? 8 : 1; r.T = g == 0 ? 2048 : 16384;
  return r;
}
template <int LT, int ph>
DEV void run_phase(const P& p, int g, int layer, char* lds) {
  const Grp G = get_group(p, g);
  const int j = layer >> 1;
  const float* xin = layer == 0 ? G.xin0 : G.xres;
  size_t zoff = 0; asm volatile("" : "+s"(zoff));
  char* ws = p.ws + zoff;
  u16* hbuf = (u16*)(ws + O_HBUF);
  u16* sg = (u16*)(ws + O_SG);
  if constexpr (LT == 0) {
    u16 *rb = (u16*)(ws + O_RB), *kb = (u16*)(ws + O_KB), *vb = (u16*)(ws + O_VB), *yf = (u16*)(ws + O_YF), *yb = (u16*)(ws + O_YB);
    u16 *twl = (u16*)(ws + O_TWL), *al = (u16*)(ws + O_AL); float* bon = (float*)(ws + O_BON);
    if constexpr (ph == 0) rms_phase(xin, p.ln_g + layer * DM, hbuf);
    else if constexpr (ph == 1) {
      GemmP q{}; q.A = hbuf; q.lda = DM; q.Bt = (const u16*)(ws + O_WRWIN) + (size_t)j * RW_N * DM; q.K = DM; q.NT = 66;
      q.mu = p.rw_mu + (size_t)j * 6 * DM; q.T = G.T; q.o0 = rb; q.o1 = kb; q.o2 = vb; q.o3 = sg; q.o4 = twl; q.o5 = al;
      lerp_phase(hbuf, q.mu, yf, G.T); GRID_SYNC();
      GemmP w = q; w.A = yf; w.astride = (size_t)GT * DM; w.NT = 32; w.nt0 = 0;
      gemm_phase<LOAD_PLAIN, EPI_RWKV, 4>(w, lds);
      q.NT = 2; q.nt0 = 64;
      gemm_phase<LOAD_LERP, EPI_RWKV, 2>(q, lds);
    } else if constexpr (ph == 2) {
      ScanP s{}; s.r = rb; s.k = kb; s.v = vb; s.twl = twl; s.al = al; s.yf = yf; s.yb = yb; s.bonus = bon;
      s.w0 = p.rw_w0 + (size_t)j * 2 * EI; s.w2 = p.rw_w2 + (size_t)j * 2 * 64 * EI; s.a0 = p.rw_a0 + (size_t)j * 2 * EI; s.a2 = p.rw_a2 + (size_t)j * 2 * 64 * EI;
      s.kk = p.rw_kk + (size_t)j * EI; s.ka = p.rw_ka + (size_t)j * EI; s.rk = p.rw_rk + (size_t)j * EI; s.nseq = G.nseq; s.T = G.T;
      s.tbuf = (float*)hbuf;
      if (G.T > 2048) {
        s.nseg = 16;
        scan_phase(s, lds, 0); GRID_SYNC();
        scan_combine_phase(s, lds); GRID_SYNC();
        scan_phase(s, lds, 1);
      } else { s.nseg = 1; scan_phase(s, lds, 1); }
    } else if constexpr (ph == 3) post_phase(yf, yb, vb, sg, bon, p.rw_lnx_g + (size_t)j * EI, p.rw_lnx_b + (size_t)j * EI);
    else {
      GemmP q{}; q.A = yf; q.lda = EI; q.Bt = (const u16*)(ws + O_WRWOUT) + (size_t)j * DM * EI; q.K = EI; q.NT = 4; q.xin = xin; q.xout = G.xres;
      for (int rep = 1; rep < REP_GEMM; ++rep) { q.dry = (gridDim.x != 12345); gemm_phase<LOAD_PLAIN, EPI_RES, 4>(q, lds); } q.dry = 0;
      gemm_phase<LOAD_PLAIN, EPI_RES, 4>(q, lds);
    }
  } else {
    float* cqkv = (float*)(ws + O_CQKV); u16 *cqn = (u16*)(ws + O_CQN), *ckvn = (u16*)(ws + O_CKVN), *kpe = (u16*)(ws + O_KPE), *qq = (u16*)(ws + O_Q), *kv = (u16*)(ws + O_KV);
    const float* ct = (const float*)(ws + O_COS); const float* st = (const float*)(ws + O_SIN);
    if constexpr (ph == 0) rms_phase(xin, p.ln_g + layer * DM, hbuf);
    else if constexpr (ph == 1) {
      GemmP q{}; q.A = hbuf; q.lda = DM; q.Bt = (const u16*)(ws + O_WMLIN) + (size_t)j * ML_NP * DM; q.K = DM; q.NT = 11; q.of = cqkv; q.o0 = sg;
      for (int rep = 1; rep < REP_GEMM; ++rep) { q.dry = (gridDim.x != 12345); gemm_phase<LOAD_PLAIN, EPI_MLAIN, 4>(q, lds); } q.dry = 0;
      gemm_phase<LOAD_PLAIN, EPI_MLAIN, 4>(q, lds);
    } else if constexpr (ph == 2) mla_mid_phase(cqkv, p.ml_qn + j * 384, p.ml_kvn + j * 256, ct, st, cqn, ckvn, kpe, G.T);
    else if constexpr (ph == 3) {
      GemmP q{}; q.A = cqn; q.lda = 384; q.Bt = (const u16*)(ws + O_WUQ) + (size_t)j * 3072 * 384; q.K = 384; q.NT = 12; q.o0 = qq; q.ldc = 3072;
      for (int rep = 1; rep < REP_GEMM; ++rep) { q.dry = (gridDim.x != 12345); gemm_phase<LOAD_PLAIN, EPI_BF16, 4>(q, lds); } q.dry = 0;
      gemm_phase<LOAD_PLAIN, EPI_BF16, 4>(q, lds);
      GemmP r{}; r.A = ckvn; r.lda = 256; r.Bt = (const u16*)(ws + O_WUKV) + (size_t)j * 4096 * 256; r.K = 256; r.NT = 16; r.o0 = kv; r.ldc = 4096;
      for (int rep = 1; rep < REP_GEMM; ++rep) { r.dry = (gridDim.x != 12345); gemm_phase<LOAD_PLAIN, EPI_BF16, 4>(r, lds); } r.dry = 0;
      gemm_phase<LOAD_PLAIN, EPI_BF16, 4>(r, lds);
    } else if constexpr (ph == 4) {
      AttnP a{}; a.q = qq; a.kv = kv; a.kpe = kpe; a.sg = sg; a.ct = ct; a.st = st; a.nseq = G.nseq; a.T = G.T;
      for (int rep = 1; rep < REP_ATTN; ++rep) { a.dry = (gridDim.x != 12345); attn_phase(a, lds); } a.dry = 0;
      attn_phase(a, lds);
    } else {
      GemmP q{}; q.A = sg; q.lda = EI; q.Bt = (const u16*)(ws + O_WMLOUT) + (size_t)j * DM * EI; q.K = EI; q.NT = 4; q.xin = xin; q.xout = G.xres;
      for (int rep = 1; rep < REP_GEMM; ++rep) { q.dry = (gridDim.x != 12345); gemm_phase<LOAD_PLAIN, EPI_RES, 4>(q, lds); } q.dry = 0;
      gemm_phase<LOAD_PLAIN, EPI_RES, 4>(q, lds);
    }
  }
}


template <int LT, int PH>
__global__ __launch_bounds__(512) void k_phase(P p, int g, int layer) {
  extern __shared__ __attribute__((aligned(16))) char lds[];
  if constexpr (LT == 2) { if constexpr (PH == 0) init_phase(p, lds); else final_phase(p.out, p.final_g); }
  else run_phase<LT, PH>(p, g, layer, lds);
}

#if MEGA
__global__ __launch_bounds__(512) void k_mega(P p) {
  extern __shared__ __attribute__((aligned(16))) char lds[];
  cg::grid_group grid = cg::this_grid();
  {
    unsigned* bar = (unsigned*)(p.ws + O_BAR);
    if (blockIdx.x == 0) for (int i = threadIdx.x; i < XCD_BAR_WORDS; i += 512) bar[i] = 0u;
    if (threadIdx.x == 0) { volatile LAS unsigned* st = (volatile LAS unsigned*)(lds + SHM_BYTES - 16); st[0] = 0u; st[1] = 0u; }
  }
  init_phase(p, lds);
  grid.sync();
  if (threadIdx.x == 0) (void)xb_add(&((unsigned*)(p.ws + O_BAR))[XB_XCNT(xb_xcc_id())], 1u);
  for (int g = 0; g < 3; ++g)
    for (int layer = 0; layer < 4; ++layer) {
      if ((layer & 1) == 0) {
        run_phase<0, 0>(p, g, layer, lds); gsync(p, lds); run_phase<0, 1>(p, g, layer, lds); gsync(p, lds); run_phase<0, 2>(p, g, layer, lds); gsync(p, lds);
        run_phase<0, 3>(p, g, layer, lds); gsync(p, lds); run_phase<0, 4>(p, g, layer, lds); gsync(p, lds);
      } else {
        run_phase<1, 0>(p, g, layer, lds); gsync(p, lds); run_phase<1, 1>(p, g, layer, lds); gsync(p, lds); run_phase<1, 2>(p, g, layer, lds); gsync(p, lds);
        run_phase<1, 3>(p, g, layer, lds); gsync(p, lds); run_phase<1, 4>(p, g, layer, lds); gsync(p, lds); run_phase<1, 5>(p, g, layer, lds); gsync(p, lds);
      }
    }
  final_phase(p.out, p.final_g);
}
#endif

extern "C" void kernel_launch(void* const* d_in, const int* in_sizes, int n_in, void* d_out, int out_size, void* d_ws, size_t ws_size, hipStream_t stream) {
  if (n_in != 22 || ws_size < WS_NEED) { fprintf(stderr, "kernel_launch: bad args n_in %d ws %zu need %zu\n", n_in, ws_size, WS_NEED); return; }
  P p{};
  const float** f = (const float**)&p;
  for (int i = 0; i < 22; ++i) f[i] = (const float*)d_in[i];
  p.out = (float*)d_out; p.ws = (char*)d_ws;
#if MEGA
  static int grid_blocks = 0;
  if (!grid_blocks) {
    hipFuncSetAttribute((const void*)k_mega, hipFuncAttributeMaxDynamicSharedMemorySize, SHM_BYTES);
    int dev = 0, cus = 0, per_cu = 0;
    hipGetDevice(&dev);
    hipDeviceGetAttribute(&cus, hipDeviceAttributeMultiprocessorCount, dev);
    hipOccupancyMaxActiveBlocksPerMultiprocessor(&per_cu, k_mega, 512, SHM_BYTES);
    if (per_cu > 1) per_cu = 1;
    grid_blocks = cus * per_cu;
  }
  void* args[] = {&p};
  hipError_t e = hipLaunchCooperativeKernel((void*)k_mega, dim3(grid_blocks), dim3(512), args, SHM_BYTES, stream);
  if (e != hipSuccess) fprintf(stderr, "cooperative launch failed: %s (grid %d)\n", hipGetErrorString(e), grid_blocks);
#else
  const int NB = 256;
#define LAUNCH(LT, PH, g, layer) do { static int inited = 0; if (!inited) { hipFuncSetAttribute((const void*)k_phase<LT, PH>, hipFuncAttributeMaxDynamicSharedMemorySize, SHM_BYTES); inited = 1; } \
    hipLaunchKernelGGL((k_phase<LT, PH>), dim3(NB), dim3(512), SHM_BYTES, stream, p, g, layer); } while (0)
  LAUNCH(2, 0, 0, 0);
  for (int g = 0; g < 3; ++g)
    for (int layer = 0; layer < 4; ++layer) {
      if ((layer & 1) == 0) { LAUNCH(0, 0, g, layer); LAUNCH(0, 1, g, layer); LAUNCH(0, 2, g, layer); LAUNCH(0, 3, g, layer); LAUNCH(0, 4, g, layer); }
      else { LAUNCH(1, 0, g, layer); LAUNCH(1, 1, g, layer); LAUNCH(1, 2, g, layer); LAUNCH(1, 3, g, layer); LAUNCH(1, 4, g, layer); LAUNCH(1, 5, g, layer); }
    }
  LAUNCH(2, 1, 0, 0);
#endif
}
```
